# Optimizing an MI355X kernel written in HIP

```python
import math
import jax, jax.numpy as jnp
from jax import lax
import numpy as np

D_MODEL = 1024
BATCH = 32
SEQ = 256
DEPTH = 1
DEC_BATCH = 8
DEC_SEQ = 2048
PAST_LEN = 256

GRID_W = 64
D_FF = 2816
N_DIR = 2
EPS = 1e-6
M_HEADS = 4
M_DK = 128
M_DV = 128
M_WIDTH = M_HEADS * M_DV
M_CHUNK = 64
M_COLS = 4 * M_WIDTH + 2 * N_DIR * M_HEADS
R_HEADS = 8
R_HEAD = 64
R_WIDTH = R_HEADS * R_HEAD
R_DECAY_LORA = 64
R_AAA_LORA = 64
R_GATE_LORA = 128
R_LN_EPS = 64e-5
R_COLS = 3 * R_WIDTH + N_DIR * R_DECAY_LORA + N_DIR * R_AAA_LORA + R_GATE_LORA
MIX_WIDTH = M_WIDTH + R_WIDTH
P_IN = M_COLS + R_COLS

kernel_name = 'hybrid_mlstm_rwkv7_diffusion_step'


def rmsnorm(x, g):
    xf = x.astype(jnp.float32)
    y = xf * lax.rsqrt(jnp.mean(xf * xf, axis=-1, keepdims=True) + EPS)
    return (y * g).astype(x.dtype)


def modulate(h, shift, scale):
    return h * (1.0 + scale) + shift


def swiglu(h, w_in, w_out):
    gate, up = jnp.split(h @ w_in, 2, axis=-1)
    return (jax.nn.silu(gate) * up) @ w_out


def shift_along(u, axis, offset):
    pad = [(0, 0)] * u.ndim
    n = u.shape[axis]
    if offset > 0:
        pad[axis] = (1, 0)
        return lax.slice_in_dim(jnp.pad(u, pad), 0, n, axis=axis)
    pad[axis] = (0, 1)
    return lax.slice_in_dim(jnp.pad(u, pad), 1, n + 1, axis=axis)


def centred_conv3(u, w, b):
    return w[0] * shift_along(u, 1, 1) + w[1] * u + w[2] * shift_along(u, 1, -1) + b


def token_shift(u, mu, grid):
    if grid:
        B, T, C = u.shape
        rows = T // GRID_W
        g = u.reshape(B, rows, GRID_W, C)
        out = (g + mu[0] * (shift_along(g, 2, 1) - g) + mu[1] * (shift_along(g, 2, -1) - g)
               + mu[2] * (shift_along(g, 1, 1) - g) + mu[3] * (shift_along(g, 1, -1) - g))
        return out.reshape(B, T, C)
    return u + mu[0] * (shift_along(u, 1, 1) - u) + mu[1] * (shift_along(u, 1, -1) - u)


def mlstm_chunkwise(q, k, v, i_pre, logf, C0, n0, m0):
    B, H, T, _ = q.shape
    L = M_CHUNK
    nc = T // L
    k = k * (M_DK ** -0.5)

    def to_chunks(a):
        return jnp.moveaxis(a.reshape((B, H, nc, L) + a.shape[3:]), 2, 0)

    qc, kc, vc, ic = to_chunks(q), to_chunks(k), to_chunks(v), to_chunks(i_pre)
    bc = jnp.cumsum(to_chunks(logf), axis=-1)
    causal = jnp.tril(jnp.ones((L, L), dtype=bool))

    def step(carry, xs):
        C, n, m = carry
        qt, kt, vt, it, bt = xs
        D = bt[..., :, None] - bt[..., None, :] + it[..., None, :]
        D = jnp.where(causal, D, -jnp.inf)
        m_inter = bt + m[..., None]
        m_t = jnp.maximum(m_inter, jnp.max(D, axis=-1))
        S = jnp.einsum('bhtd,bhsd->bhts', qt, kt) * jnp.exp(D - m_t[..., None])
        sc = jnp.exp(m_inter - m_t)
        num = jnp.einsum('bhts,bhse->bhte', S, vt) + sc[..., None] * jnp.einsum('bhtd,bhde->bhte', qt, C)
        den = jnp.sum(S, axis=-1) + sc * jnp.einsum('bhtd,bhd->bht', qt, n)
        h = num / jnp.maximum(jnp.abs(den), jnp.exp(-m_t))[..., None]
        bL = bt[..., -1]
        gs = bL[..., None] - bt + it
        m_new = jnp.maximum(bL + m, jnp.max(gs, axis=-1))
        wk = jnp.exp(gs - m_new[..., None])
        decay = jnp.exp(bL + m - m_new)
        C_new = decay[..., None, None] * C + jnp.einsum('bhs,bhsd,bhse->bhde', wk, kt, vt)
        n_new = decay[..., None] * n + jnp.einsum('bhs,bhsd->bhd', wk, kt)
        return (C_new, n_new, m_new), h

    (C, n, m), h = lax.scan(step, (C0, n0, m0), (qc, kc, vc, ic, bc))
    h = jnp.moveaxis(h, 0, 2).reshape(B, H, T, M_DV)
    return h, C, n, m


def mlstm_group(u, conv_w, conv_b, gate_b, head_g, C0, n0, m0):
    B, T, _ = u.shape
    qk = jax.nn.silu(centred_conv3(u[..., :2 * M_WIDTH], conv_w, conv_b))
    q = qk[..., :M_WIDTH].reshape(B, T, M_HEADS, M_DK).transpose(0, 2, 1, 3)
    k = qk[..., M_WIDTH:].reshape(B, T, M_HEADS, M_DK).transpose(0, 2, 1, 3)
    v = u[..., 2 * M_WIDTH:3 * M_WIDTH].reshape(B, T, M_HEADS, M_DV).transpose(0, 2, 1, 3)
    o = jax.nn.sigmoid(u[..., 3 * M_WIDTH:4 * M_WIDTH]).reshape(B, T, M_HEADS, M_DV)
    gates = u[..., 4 * M_WIDTH:].reshape(B, T, 2, N_DIR, M_HEADS) + gate_b
    gates = gates.transpose(2, 3, 0, 4, 1)
    i_pre = gates[0]
    logf = jax.nn.log_sigmoid(gates[1])
    hs, Cs, ns, ms = [], [], [], []
    for d in range(N_DIR):
        args = (q, k, v, i_pre[d], logf[d])
        if d == 1:
            args = tuple(jnp.flip(a, axis=2) for a in args)
        h, C, n, m = mlstm_chunkwise(*args, C0[:, d], n0[:, d], m0[:, d])
        if d == 1:
            h = jnp.flip(h, axis=2)
        hs.append(h)
        Cs.append(C)
        ns.append(n)
        ms.append(m)
    h = o * (hs[0] + hs[1]).transpose(0, 2, 1, 3)
    h = h * lax.rsqrt(jnp.mean(h * h, axis=-1, keepdims=True) + EPS)
    out = h.reshape(B, T, M_WIDTH) * head_g
    return out, jnp.stack(Cs, axis=1), jnp.stack(ns, axis=1), jnp.stack(ms, axis=1)


def rwkv7_scan(r, w, k, v, kk, a, S0, reverse):
    xs = tuple(jnp.moveaxis(t, 1, 0) for t in (r, w, k, v, kk, a))

    def step(S, x):
        r_t, w_t, k_t, v_t, kk_t, a_t = x
        sa = jnp.einsum('bhij,bhj->bhi', S, -kk_t)
        S = S * w_t[:, :, None, :] + sa[..., None] * (kk_t * a_t)[:, :, None, :] + v_t[..., None] * k_t[:, :, None, :]
        y = jnp.einsum('bhij,bhj->bhi', S, r_t)
        return S, y

    S, y = lax.scan(step, S0, xs, reverse=reverse)
    return jnp.moveaxis(y, 0, 1), S


def rwkv_group(u, mu, w0, w2, a0, a2, g2, k_k, k_a, r_k, ln_g, ln_b, S0, grid):
    B, T, _ = u.shape
    u = token_shift(u, mu, grid)

    def heads(t):
        return t.reshape(B, T, R_HEADS, R_HEAD)

    r = u[..., :R_WIDTH]
    k = u[..., R_WIDTH:2 * R_WIDTH]
    v = u[..., 2 * R_WIDTH:3 * R_WIDTH]
    off = 3 * R_WIDTH
    wd = u[..., off:off + N_DIR * R_DECAY_LORA].reshape(B, T, N_DIR, R_DECAY_LORA)
    off += N_DIR * R_DECAY_LORA
    ad = u[..., off:off + N_DIR * R_AAA_LORA].reshape(B, T, N_DIR, R_AAA_LORA)
    off += N_DIR * R_AAA_LORA
    g = jax.nn.sigmoid(u[..., off:off + R_GATE_LORA]) @ g2
    kk = heads(k * k_k)
    kk = kk / jnp.maximum(jnp.sqrt(jnp.sum(kk * kk, axis=-1, keepdims=True)), 1e-12)
    ys, Ss, ks = [], [], []
    for d in range(N_DIR):
        w = -jax.nn.softplus(-(w0[d] + jnp.tanh(wd[:, :, d]) @ w2[d])) - 0.5
        decay = jnp.exp(-jnp.exp(w))
        a = jax.nn.sigmoid(a0[d] + ad[:, :, d] @ a2[d])
        kd = k * (1.0 + (a - 1.0) * k_a)
        y, S = rwkv7_scan(heads(r), heads(decay), heads(kd), heads(v), kk, heads(a), S0[:, d], d == 1)
        ys.append(y)
        Ss.append(S)
        ks.append(kd)
    y = ys[0] + ys[1]
    mean = jnp.mean(y, axis=-1, keepdims=True)
    var = jnp.mean((y - mean) ** 2, axis=-1, keepdims=True)
    y = ((y - mean) * lax.rsqrt(var + R_LN_EPS)).reshape(B, T, R_WIDTH) * ln_g + ln_b
    k_bar = heads(0.5 * (ks[0] + ks[1]))
    bonus = jnp.sum(heads(r) * k_bar * r_k, axis=-1, keepdims=True) * heads(v)
    out = (y + bonus.reshape(B, T, R_WIDTH)) * g
    return out, jnp.stack(Ss, axis=1)


def token_mix(h, p, init, grid):
    C0, n0, m0, S0 = init
    u = (h @ p['mix_w_in']).astype(jnp.float32)
    m_out, C, n, m = mlstm_group(u[..., :M_COLS], p['m_conv_w'], p['m_conv_b'], p['m_gate_b'],
                                 p['m_head_g'], C0, n0, m0)
    r_out, S = rwkv_group(u[..., M_COLS:], p['r_mu'], p['r_w0'], p['r_w2'], p['r_a0'], p['r_a2'],
                          p['r_g2'], p['r_k_k'], p['r_k_a'], p['r_r_k'], p['r_ln_g'], p['r_ln_b'], S0, grid)
    y = jnp.concatenate([m_out, r_out], axis=-1).astype(h.dtype) @ p['mix_w_out']
    return y, (C, n, m, S)


def trunk_layer(x, cond, grid, init, p):
    mod = (jax.nn.silu(cond) @ p['ada_w'] + p['ada_b']).reshape(-1, 1, 9 * D_MODEL)
    sh1, sc1, ga1, sh2, sc2, ga2, sh3, sc3, ga3 = jnp.split(mod, 9, axis=-1)
    h = modulate(rmsnorm(x, p['norm_ffn1']), sh1, sc1)
    x = x + 0.5 * ga1 * swiglu(h, p['ffn1_w_in'], p['ffn1_w_out'])
    h = modulate(rmsnorm(x, p['norm_mix']), sh2, sc2)
    mix, states = token_mix(h, p, init, grid)
    x = x + ga2 * mix
    h = modulate(rmsnorm(x, p['norm_ffn2']), sh3, sc3)
    x = x + 0.5 * ga3 * swiglu(h, p['ffn2_w_in'], p['ffn2_w_out'])
    return x, states


def setup_inputs(seed: int = 0) -> dict:
    key = jax.random.key(seed)
    keys = iter(jax.random.split(key, 64))

    def nrm(shape, scale):
        return scale * jax.random.normal(next(keys), shape, jnp.float32)

    def gain(shape):
        return 1.0 + 0.01 * jax.random.normal(next(keys), shape, jnp.float32)

    L, D = DEPTH, D_MODEL
    m_gate_b = jnp.stack([nrm((L, N_DIR, M_HEADS), 0.1), 3.0 + nrm((L, N_DIR, M_HEADS), 0.5)], axis=1)
    return {
        'x_prompt': nrm((BATCH, SEQ, D), 1.0),
        'x_sample': nrm((DEC_BATCH, DEC_SEQ, D), 1.0),
        'c': nrm((DEC_BATCH, D), 1.0),
        'state_mlstm_C': nrm((DEC_BATCH, L, N_DIR, M_HEADS, M_DK, M_DV), 0.1),
        'state_mlstm_n': jnp.abs(nrm((DEC_BATCH, L, N_DIR, M_HEADS, M_DK), 0.5)),
        'state_mlstm_m': nrm((DEC_BATCH, L, N_DIR, M_HEADS), 0.5),
        'state_rwkv_S': nrm((DEC_BATCH, L, N_DIR, R_HEADS, R_HEAD, R_HEAD), 0.1),
        'c_ctx': nrm((D,), 1.0),
        'ada_w': nrm((L, D, 9 * D), 0.5 * D ** -0.5),
        'ada_b': nrm((L, 9 * D), 0.01),
        'norm_ffn1': gain((L, D)),
        'ffn1_w_in': nrm((L, D, 2 * D_FF), D ** -0.5),
        'ffn1_w_out': nrm((L, D_FF, D), D_FF ** -0.5),
        'norm_mix': gain((L, D)),
        'mix_w_in': nrm((L, D, P_IN), D ** -0.5),
        'mix_w_out': nrm((L, MIX_WIDTH, D), MIX_WIDTH ** -0.5),
        'm_conv_w': nrm((L, 3, 2 * M_WIDTH), 3 ** -0.5),
        'm_conv_b': nrm((L, 2 * M_WIDTH), 0.01),
        'm_gate_b': m_gate_b,
        'm_head_g': gain((L, M_WIDTH)),
        'r_mu': jax.random.uniform(next(keys), (L, 4, R_COLS), jnp.float32, 0.0, 0.5),
        'r_w0': -2.0 + nrm((L, N_DIR, R_WIDTH), 0.5),
        'r_w2': nrm((L, N_DIR, R_DECAY_LORA, R_WIDTH), 0.5 * R_DECAY_LORA ** -0.5),
        'r_a0': nrm((L, N_DIR, R_WIDTH), 0.5),
        'r_a2': nrm((L, N_DIR, R_AAA_LORA, R_WIDTH), R_AAA_LORA ** -0.5),
        'r_g2': nrm((L, R_GATE_LORA, R_WIDTH), R_GATE_LORA ** -0.5),
        'r_k_k': 0.85 + nrm((L, R_WIDTH), 0.1),
        'r_k_a': 1.0 + nrm((L, R_WIDTH), 0.1),
        'r_r_k': nrm((L, R_HEADS, R_HEAD), 0.1),
        'r_ln_g': gain((L, R_WIDTH)),
        'r_ln_b': nrm((L, R_WIDTH), 0.01),
        'norm_ffn2': gain((L, D)),
        'ffn2_w_in': nrm((L, D, 2 * D_FF), D ** -0.5),
        'ffn2_w_out': nrm((L, D_FF, D), D_FF ** -0.5),
        'norm_final': gain((D,)),
    }


def reference(x_prompt, x_sample, c, state_mlstm_C, state_mlstm_n, state_mlstm_m, state_rwkv_S, c_ctx,
              ada_w, ada_b, norm_ffn1, ffn1_w_in, ffn1_w_out, norm_mix, mix_w_in, mix_w_out,
              m_conv_w, m_conv_b, m_gate_b, m_head_g, r_mu, r_w0, r_w2, r_a0, r_a2, r_g2,
              r_k_k, r_k_a, r_r_k, r_ln_g, r_ln_b, norm_ffn2, ffn2_w_in, ffn2_w_out, norm_final):
    layers = [dict(ada_w=ada_w[l], ada_b=ada_b[l], norm_ffn1=norm_ffn1[l], ffn1_w_in=ffn1_w_in[l],
                   ffn1_w_out=ffn1_w_out[l], norm_mix=norm_mix[l], mix_w_in=mix_w_in[l],
                   mix_w_out=mix_w_out[l], m_conv_w=m_conv_w[l], m_conv_b=m_conv_b[l],
                   m_gate_b=m_gate_b[l], m_head_g=m_head_g[l], r_mu=r_mu[l], r_w0=r_w0[l],
                   r_w2=r_w2[l], r_a0=r_a0[l], r_a2=r_a2[l], r_g2=r_g2[l], r_k_k=r_k_k[l],
                   r_k_a=r_k_a[l], r_r_k=r_r_k[l], r_ln_g=r_ln_g[l], r_ln_b=r_ln_b[l],
                   norm_ffn2=norm_ffn2[l], ffn2_w_in=ffn2_w_in[l], ffn2_w_out=ffn2_w_out[l])
              for l in range(DEPTH)]

    Bp = x_prompt.shape[0]
    f32 = jnp.float32
    h = x_prompt
    Cl, nl, ml, Sl = [], [], [], []
    for l in range(DEPTH):
        init = (jnp.zeros((Bp, N_DIR, M_HEADS, M_DK, M_DV), f32), jnp.zeros((Bp, N_DIR, M_HEADS, M_DK), f32),
                jnp.zeros((Bp, N_DIR, M_HEADS), f32), jnp.zeros((Bp, N_DIR, R_HEADS, R_HEAD, R_HEAD), f32))
        h, (C, n, m, S) = trunk_layer(h, c_ctx, False, init, layers[l])
        Cl.append(C)
        nl.append(n)
        ml.append(m)
        Sl.append(S)
    y_prompt = rmsnorm(h, norm_final)
    new_mlstm_C = jnp.stack(Cl, axis=1)
    new_mlstm_n = jnp.stack(nl, axis=1)
    new_mlstm_m = jnp.stack(ml, axis=1)
    new_rwkv_S = jnp.stack(Sl, axis=1)

    h = x_sample
    for l in range(DEPTH):
        init = (state_mlstm_C[:, l].astype(f32), state_mlstm_n[:, l].astype(f32),
                state_mlstm_m[:, l].astype(f32), state_rwkv_S[:, l].astype(f32))
        h, _ = trunk_layer(h, c, True, init, layers[l])
    y_sample = rmsnorm(h, norm_final)
    return (y_prompt, y_sample, new_mlstm_C, new_mlstm_n, new_mlstm_m, new_rwkv_S)
```

```cpp
#include <hip/hip_runtime.h>
#include <hip/hip_cooperative_groups.h>
#include <cstdio>
#include <cstdint>
namespace cg = cooperative_groups;

#ifndef ONE_LAUNCH
#define ONE_LAUNCH 0
#endif

namespace pg8 {
#define PG8_LAS __attribute__((address_space(3)))
typedef unsigned short bf16_t;
typedef short bf16x8 __attribute__((ext_vector_type(8)));
typedef float f32x4 __attribute__((ext_vector_type(4)));
typedef unsigned u32x4 __attribute__((ext_vector_type(4)));
constexpr int BM = 256, BK = 64, HALF = 128, HTB = HALF * BK * 2, STAGE_BYTES = 8 * HTB, NXCD = 8, WGM = 8;

__host__ __device__ __forceinline__ int lds_byte(int r, int c) { const int st = (r >> 4) * 2 + (c >> 5), rr = r & 15, cc = c & 31, ob = rr * 64 + cc * 2; return st * 1024 + (ob ^ (((ob >> 9) & 1) << 5)); }
__host__ __device__ __forceinline__ void stage_rc(int b, int& R, int& C) { const int st = b / 1024, sb = b % 1024, swz = sb ^ (((sb >> 9) & 1) << 5); R = (st >> 1) * 16 + swz / 64; C = (st & 1) * 32 + (swz % 64) / 2; }
__host__ __device__ __forceinline__ int perm32(int rho) { const int n = rho >> 4, i = rho & 15; return 8 * (i >> 2) + 4 * n + (i & 3); }

struct Unit { int pm, pn; };
struct Gemm { const bf16_t* A; const bf16_t* Bt; int M, N, K; };

struct StaticOrder {
    int nM, nN, nwg, G, c;
    __host__ __device__ void init(int M, int N, int G_, int c_) { nM = M / BM; nN = N / BM; nwg = nM * nN; G = G_; c = c_; }
    __host__ __device__ bool next(int i, Unit& u) const {
        const long L = (long)i * G + c; if (L >= nwg) return false;
        int wgid = (int)L; { const int q = nwg / NXCD, r = nwg % NXCD, xcd = wgid % NXCD, off = wgid / NXCD; wgid = (xcd < r ? xcd * (q + 1) : r * (q + 1) + (xcd - r) * q) + off; }
        const int nig = WGM * nN, gid = wgid / nig, fm = gid * WGM, gsz = (nM - fm) < WGM ? (nM - fm) : WGM;
        u.pm = fm + ((wgid % nig) % gsz); u.pn = (wgid % nig) / gsz; return true;
    }
    __device__ __forceinline__ void a_ready(const Unit&) const {}
    __device__ __forceinline__ void done(const Unit&) const {}
};

__device__ __forceinline__ unsigned cvt_pk_bf16(float lo, float hi) { unsigned r; asm volatile("v_cvt_pk_bf16_f32 %0, %1, %2" : "=v"(r) : "v"(lo), "v"(hi)); return r; }

template <class Epi, class Sched, bool ALIGN_EPI = false, bool SP2 = false>
__device__ __forceinline__ void gemm_phase(PG8_LAS unsigned char* lds, const Gemm g, const Sched& S, const Epi& E) {
    const int tid = threadIdx.x, wid = __builtin_amdgcn_readfirstlane(tid >> 6), lane = tid & 63, wr = wid >> 2, wc = wid & 3, fr = lane & 15, fq = lane >> 4;
    const int K = g.K, nt = K / BK;
    unsigned voffA[2], voffB[2];
#pragma unroll
    for (int i = 0; i < 2; ++i) { int R, C; stage_rc(tid * 16 + i * 8192, R, C); const int Rb = Epi::PERM ? ((R & ~31) + perm32(R & 31)) : R;
        voffA[i] = (unsigned)(R * K + C) * 2u; voffB[i] = (unsigned)(Rb * K + C) * 2u; }
    const size_t kstep = (size_t)(BK * 2);
    const size_t hstep = (size_t)HALF * K * 2;
    const size_t tstep = 2 * hstep;
    const unsigned ldsw = (unsigned)wid * 1024u;
    const int aoff = lds_byte(wr * 64 + fr, fq * 8), boff = lds_byte(wc * 32 + fr, fq * 8);
#define PG8_SA(b, h) (((b) * 2 + (h)) * HTB)
#define PG8_SB(b, h) ((4 + (b) * 2 + (h)) * HTB)
#define PG8_STAGE(bufoff, gbase, voff) do { _Pragma("unroll") for (int _i = 0; _i < 2; ++_i) \
        __builtin_amdgcn_global_load_lds((const unsigned*)((const char*)(gbase) + (voff)[_i]), (PG8_LAS unsigned*)(lds + (bufoff) + ldsw + _i * 8192), 16, 0, 0); } while (0)
#define PG8_LDA(dst, b, h) do { _Pragma("unroll") for (int m = 0; m < 4; ++m) _Pragma("unroll") for (int k = 0; k < 2; ++k) dst[m][k] = *(const PG8_LAS bf16x8*)(lds + PG8_SA(b, h) + aoff + m * 2048 + k * 1024); } while (0)
#define PG8_LDB(dst, b, h) do { _Pragma("unroll") for (int n = 0; n < 2; ++n) _Pragma("unroll") for (int k = 0; k < 2; ++k) dst[n][k] = *(const PG8_LAS bf16x8*)(lds + PG8_SB(b, h) + boff + n * 2048 + k * 1024); } while (0)
#define PG8_MMA(ai, bj, At, Bt) do { __builtin_amdgcn_s_setprio(1); _Pragma("unroll") for (int m = 0; m < 4; ++m) _Pragma("unroll") for (int n = 0; n < 2; ++n) _Pragma("unroll") for (int k = 0; k < 2; ++k) \
        acc[ai][bj][m][n] = __builtin_amdgcn_mfma_f32_16x16x32_bf16(Bt[n][k], At[m][k], acc[ai][bj][m][n], 0, 0, 0); __builtin_amdgcn_s_setprio(0); } while (0)
#define PG8_WAIT_V(n) asm volatile("s_waitcnt vmcnt(" #n ")" ::: "memory")
#define PG8_WAIT_L(n) asm volatile("s_waitcnt lgkmcnt(" #n ")" ::: "memory")
#define PG8_BAR __builtin_amdgcn_s_barrier()
#define PG8_SCHED __builtin_amdgcn_sched_barrier(0)
    Unit cur, nxt; int ui = 0;
    if (!S.next(0, cur)) return;
    f32x4 acc[2][2][4][2];
#pragma unroll
    for (int a = 0; a < 2; ++a)
#pragma unroll
        for (int b = 0; b < 2; ++b)
#pragma unroll
            for (int m = 0; m < 4; ++m)
#pragma unroll
                for (int n = 0; n < 2; ++n) acc[a][b][m][n] = (f32x4){0.f, 0.f, 0.f, 0.f};
    bf16x8 At[4][2], B0[2][2], B1[2][2];
    const char* cA = (const char*)g.A + (size_t)cur.pm * tstep; const char* cB = (const char*)g.Bt + (size_t)cur.pn * tstep;
    S.a_ready(cur);
    if constexpr (SP2) {
        PG8_STAGE(PG8_SB(0, 0), cB, voffB); PG8_STAGE(PG8_SB(0, 1), cB + hstep, voffB); PG8_STAGE(PG8_SA(0, 0), cA, voffA); PG8_STAGE(PG8_SA(0, 1), cA + hstep, voffA);
        if (wr == 1) PG8_BAR;
        PG8_WAIT_V(2); PG8_BAR;
        PG8_STAGE(PG8_SB(1, 0), cB + kstep, voffB); PG8_STAGE(PG8_SA(1, 0), cA + kstep, voffA); PG8_STAGE(PG8_SB(1, 1), cB + hstep + kstep, voffB);
        PG8_WAIT_V(6); PG8_BAR;
    } else {
        PG8_STAGE(PG8_SB(0, 0), cB, voffB); PG8_STAGE(PG8_SA(0, 0), cA, voffA); PG8_STAGE(PG8_SB(0, 1), cB + hstep, voffB); PG8_STAGE(PG8_SA(0, 1), cA + hstep, voffA);
        if (wr == 1) PG8_BAR;
        PG8_WAIT_V(4); PG8_BAR;
        PG8_STAGE(PG8_SB(1, 0), cB + kstep, voffB); PG8_STAGE(PG8_SA(1, 0), cA + kstep, voffA); PG8_STAGE(PG8_SB(1, 1), cB + hstep + kstep, voffB);
        PG8_WAIT_V(6); PG8_BAR;
    }
    for (;;) {
        const bool has_next = S.next(ui + 1, nxt);
        const char* nA = has_next ? (const char*)g.A + (size_t)nxt.pm * tstep : cA; const char* nB = has_next ? (const char*)g.Bt + (size_t)nxt.pn * tstep : cB;
        for (int t = 0; t < nt; t += 2) {
            const bool last = (t == nt - 2);
            const char* a1 = cA + (size_t)(t + 1) * kstep;
            const char* a2 = last ? nA : cA + (size_t)(t + 2) * kstep; const char* b2 = last ? nB : cB + (size_t)(t + 2) * kstep;
            const char* a3 = a2 + kstep; const char* b3 = b2 + kstep;
            if (last && has_next) S.a_ready(nxt);
            if constexpr (SP2) {
            PG8_LDB(B0, 0, 0); PG8_LDB(B1, 0, 1); PG8_SCHED; PG8_LDA(At, 0, 0); PG8_STAGE(PG8_SA(1, 1), a1 + hstep, voffA);
            PG8_WAIT_V(8); PG8_WAIT_L(0); PG8_BAR; PG8_MMA(0, 0, At, B0); PG8_MMA(0, 1, At, B1); PG8_BAR; PG8_SCHED;
            PG8_LDA(At, 0, 1); PG8_STAGE(PG8_SB(0, 0), b2, voffB); PG8_STAGE(PG8_SB(0, 1), b2 + hstep, voffB); PG8_STAGE(PG8_SA(0, 0), a2, voffA);
            PG8_WAIT_V(8); PG8_WAIT_L(0); PG8_BAR; PG8_MMA(1, 0, At, B0); PG8_MMA(1, 1, At, B1); PG8_BAR; PG8_SCHED;
            PG8_LDB(B0, 1, 0); PG8_LDB(B1, 1, 1); PG8_SCHED; PG8_LDA(At, 1, 0); PG8_STAGE(PG8_SA(0, 1), a2 + hstep, voffA);
            PG8_WAIT_V(8); PG8_WAIT_L(0); PG8_BAR; PG8_MMA(0, 0, At, B0); PG8_MMA(0, 1, At, B1); PG8_BAR; PG8_SCHED;
            PG8_LDA(At, 1, 1); PG8_STAGE(PG8_SB(1, 0), b3, voffB); PG8_STAGE(PG8_SB(1, 1), b3 + hstep, voffB); PG8_STAGE(PG8_SA(1, 0), a3, voffA);
            PG8_WAIT_V(8); PG8_WAIT_L(0); PG8_BAR; PG8_MMA(1, 0, At, B0); PG8_MMA(1, 1, At, B1); PG8_BAR; PG8_SCHED;
            } else {
            PG8_LDB(B0, 0, 0); PG8_SCHED; PG8_LDA(At, 0, 0); PG8_STAGE(PG8_SA(1, 1), a1 + hstep, voffA);
            PG8_WAIT_L(8); PG8_BAR; PG8_WAIT_L(0); PG8_MMA(0, 0, At, B0); PG8_BAR; PG8_SCHED;
            PG8_LDB(B1, 0, 1); PG8_STAGE(PG8_SB(0, 0), b2, voffB);
            PG8_BAR; PG8_WAIT_L(0); PG8_MMA(0, 1, At, B1); PG8_BAR;
            PG8_LDA(At, 0, 1); PG8_STAGE(PG8_SA(0, 0), a2, voffA);
            PG8_BAR; PG8_WAIT_L(0); PG8_MMA(1, 0, At, B0); PG8_BAR; PG8_SCHED;
            PG8_STAGE(PG8_SB(0, 1), b2 + hstep, voffB);
            PG8_WAIT_V(6); PG8_BAR; PG8_MMA(1, 1, At, B1); PG8_BAR;
            PG8_LDB(B0, 1, 0); PG8_SCHED; PG8_LDA(At, 1, 0); PG8_STAGE(PG8_SA(0, 1), a2 + hstep, voffA);
            PG8_WAIT_L(8); PG8_BAR; PG8_WAIT_L(0); PG8_MMA(0, 0, At, B0); PG8_BAR; PG8_SCHED;
            PG8_LDB(B1, 1, 1); PG8_STAGE(PG8_SB(1, 0), b3, voffB);
            PG8_BAR; PG8_WAIT_L(0); PG8_MMA(0, 1, At, B1); PG8_BAR;
            PG8_LDA(At, 1, 1); PG8_STAGE(PG8_SA(1, 0), a3, voffA);
            PG8_BAR; PG8_WAIT_L(0); PG8_MMA(1, 0, At, B0); PG8_BAR; PG8_SCHED;
            PG8_STAGE(PG8_SB(1, 1), b3 + hstep, voffB);
            PG8_WAIT_V(6); PG8_BAR; PG8_MMA(1, 1, At, B1); PG8_BAR;
            }
        }
        if constexpr (ALIGN_EPI) { if (wr == 0) PG8_BAR; }
        E(acc, cur, wr, wc, fr, fq); S.done(cur);
        if (!has_next) break;
#pragma unroll
        for (int a = 0; a < 2; ++a)
#pragma unroll
            for (int b = 0; b < 2; ++b)
#pragma unroll
                for (int m = 0; m < 4; ++m)
#pragma unroll
                    for (int n = 0; n < 2; ++n) acc[a][b][m][n] = (f32x4){0.f, 0.f, 0.f, 0.f};
        cur = nxt; cA = nA; cB = nB; ++ui;
        if constexpr (ALIGN_EPI) { if (wr == 1) PG8_BAR; }
    }
    PG8_WAIT_V(0);
    if constexpr (!ALIGN_EPI) { if (wr == 0) PG8_BAR; }
    PG8_BAR;
#undef PG8_SA
#undef PG8_SB
#undef PG8_STAGE
#undef PG8_LDA
#undef PG8_LDB
#undef PG8_MMA
#undef PG8_WAIT_V
#undef PG8_WAIT_L
#undef PG8_BAR
#undef PG8_SCHED
}
}

using pg8::bf16_t; using pg8::bf16x8; using pg8::f32x4;

constexpr int MT = 24576, DM = 1024, DFF = 2816, NCTX = 8192;
constexpr int UW = 3984;
constexpr int NCOND = 9, MODW = 9216;
constexpr size_t MiB = 1ull << 20;
constexpr size_t WS_A = 0, WS_U = 48 * MiB, WS_W1 = WS_U + 132 * MiB, WS_W1B = WS_W1 + (size_t)5632 * 1024 * 2,
                 WS_BT3 = 235 * MiB, WS_BT4 = 243 * MiB, WS_MOD = 245 * MiB, WS_GATES = 246 * MiB;
constexpr int OUT_C = 25165824, OUT_N = 29360128, OUT_MM = 29392896, OUT_S = 29393152;
constexpr int LDS_BYTES = 163840;
constexpr int NTHR = 512;

struct P {
    const float *xp, *xs, *c, *sC, *sn, *sm, *sS, *cctx, *ada_w, *ada_b, *n1, *w1in, *w1out, *nmix, *wmin, *wmout,
        *cw, *cb, *gb, *hg, *mu, *w0, *w2, *a0, *a2, *g2, *kk, *ka, *rk, *lng, *lnb, *n2, *w2in, *w2out, *nf;
    float* out; unsigned char* ws;
};

__device__ __forceinline__ unsigned short f2bf(float f) { unsigned u = __float_as_uint(f); u += 0x7FFFu + ((u >> 16) & 1u); return (unsigned short)(u >> 16); }
__device__ __forceinline__ float bf2f(unsigned short b) { return __uint_as_float(((unsigned)b) << 16); }
__device__ __forceinline__ unsigned pk2(float a, float b) { return (unsigned)f2bf(a) | ((unsigned)f2bf(b) << 16); }
__device__ __forceinline__ int cond_of(int row) { return row < NCTX ? 0 : 1 + ((row - NCTX) >> 11); }
__device__ __forceinline__ float siluf(float x) { return x * __builtin_amdgcn_rcpf(1.f + __expf(-x)); }
__device__ __forceinline__ float sigmf(float x) { return __builtin_amdgcn_rcpf(1.f + __expf(-x)); }
__device__ __forceinline__ const float* xrow(const P& p, int row) { return row < NCTX ? p.xp + (size_t)row * DM : p.xs + (size_t)(row - NCTX) * DM; }
__device__ __forceinline__ f32x4 mfma16(bf16x8 a, bf16x8 b, f32x4 c) { return __builtin_amdgcn_mfma_f32_16x16x32_bf16(a, b, c, 0, 0, 0); }
__device__ __forceinline__ void unpack8(uint4 v, float* f) {
    f[0] = __uint_as_float(v.x << 16); f[1] = __uint_as_float(v.x & 0xffff0000u); f[2] = __uint_as_float(v.y << 16); f[3] = __uint_as_float(v.y & 0xffff0000u);
    f[4] = __uint_as_float(v.z << 16); f[5] = __uint_as_float(v.z & 0xffff0000u); f[6] = __uint_as_float(v.w << 16); f[7] = __uint_as_float(v.w & 0xffff0000u);
}

__device__ __forceinline__ int colmap(int kind, int n) {
    if (kind == 0) return n;
    if (kind == 1) { const int t = n >> 8, bj = (n >> 7) & 1, c = n & 127; return bj * DFF + t * 128 + c; }
    if (n < 2048) return n; if (n < 3968) return n + 16; if (n < 3984) return n - 3968 + 2048; return -1;
}
__device__ void convert_tile(const float* __restrict__ src, bf16_t* __restrict__ dst, int K, int Nsrc, int kind, int k0, int n0, float* tile) {
    const int tid = threadIdx.x;
    { const int n = tid & 63, kr = tid >> 6; const int sc = colmap(kind, n0 + n);
#pragma unroll
      for (int i = 0; i < 8; ++i) { const int k = kr + 8 * i; tile[k * 65 + n] = sc >= 0 ? src[(size_t)(k0 + k) * Nsrc + sc] : 0.f; } }
    __syncthreads();
    { const int nn = tid >> 3, kg = tid & 7; unsigned w[4];
#pragma unroll
      for (int j = 0; j < 4; ++j) w[j] = pk2(tile[(kg * 8 + 2 * j) * 65 + nn], tile[(kg * 8 + 2 * j + 1) * 65 + nn]);
      *(uint4*)(dst + (size_t)(n0 + nn) * K + k0 + kg * 8) = make_uint4(w[0], w[1], w[2], w[3]); }
    __syncthreads();
}
__device__ void convert_jobs(const P& p, int first, int njobs_sel, unsigned char* lds, int item0, int nitems_before) {}

__device__ void do_convert(const float* src, bf16_t* dst, int K, int Nsrc, int Ndst, int kind, int t, float* tile) {
    const int nkt = K / 64; const int kt = t % nkt, ntile = t / nkt; (void)Ndst;
    convert_tile(src, dst, K, Nsrc, kind, kt * 64, ntile * 64, tile);
}

__device__ void phase0(const P& p, unsigned char* lds) {
    float* tile = (float*)lds;
    const int tid = threadIdx.x;
    const int n_ada = 36 * 8;
    const int t1 = 16 * 88, t2 = 44 * 16, t3 = 16 * 64, t4 = 16 * 16;
    const int total = n_ada + t1 + t2 + t3 + t4;
    for (int it = blockIdx.x; it < total; it += gridDim.x) {
        if (it < n_ada) {
            const int cgp = it % 36, kc = it / 36;
            float* sc = tile;
            __syncthreads();
            for (int i = tid; i < NCOND * 128; i += NTHR) { const int c = i >> 7, k = i & 127; const float v = c == 0 ? p.cctx[kc * 128 + k] : p.c[(c - 1) * DM + kc * 128 + k]; sc[i] = siluf(v); }
            __syncthreads();
            const int col = cgp * 256 + (tid & 255), kh = tid >> 8;
            float acc[NCOND];
#pragma unroll
            for (int c = 0; c < NCOND; ++c) acc[c] = 0.f;
            const float* w = p.ada_w + (size_t)(kc * 128 + kh * 64) * MODW + col;
#pragma unroll 4
            for (int k = 0; k < 64; ++k) { const float wv = w[(size_t)k * MODW];
#pragma unroll
                for (int c = 0; c < NCOND; ++c) acc[c] += sc[c * 128 + kh * 64 + k] * wv; }
            float* mod = (float*)(p.ws + WS_MOD);
            const float bias = (kc == 0 && kh == 0) ? p.ada_b[col] : 0.f;
#pragma unroll
            for (int c = 0; c < NCOND; ++c) atomicAdd(mod + c * MODW + col, acc[c] + bias);
            __syncthreads();
        } else {
            int t = it - n_ada;
            if (t < t1) do_convert(p.w1in, (bf16_t*)(p.ws + WS_W1), 1024, 5632, 5632, 1, t, tile);
            else if ((t -= t1) < t2) do_convert(p.w1out, (bf16_t*)(p.ws + WS_W1B), 2816, 1024, 1024, 0, t, tile);
            else if ((t -= t2) < t3) do_convert(p.wmin, (bf16_t*)(p.ws + WS_BT3), 1024, 3984, 4096, 2, t, tile);
            else { t -= t3; do_convert(p.wmout, (bf16_t*)(p.ws + WS_BT4), 1024, 1024, 1024, 0, t, tile); }
        }
    }
}

__device__ void phase_normmod(const P& p, int which) {
    const int lane = threadIdx.x & 63, wave = threadIdx.x >> 6;
    const float* gain = which == 0 ? p.n1 : (which == 1 ? p.nmix : p.n2);
    const float* mod = (const float*)(p.ws + WS_MOD);
    bf16_t* A = (bf16_t*)(p.ws + WS_A);
    for (int row = blockIdx.x * 8 + wave; row < MT; row += gridDim.x * 8) {
        const float* src = which == 0 ? xrow(p, row) : p.out + (size_t)row * DM;
        float4 v[4]; float ss = 0.f;
#pragma unroll
        for (int i = 0; i < 4; ++i) { v[i] = *(const float4*)(src + lane * 4 + 256 * i); ss += v[i].x * v[i].x + v[i].y * v[i].y + v[i].z * v[i].z + v[i].w * v[i].w; }
#pragma unroll
        for (int o = 32; o >= 1; o >>= 1) ss += __shfl_xor(ss, o);
        const float rstd = rsqrtf(ss * (1.f / 1024.f) + 1e-6f);
        const float* sh = mod + cond_of(row) * MODW + which * 3072; const float* sc = sh + 1024;
#pragma unroll
        for (int i = 0; i < 4; ++i) { const int col = lane * 4 + 256 * i;
            const float4 g = *(const float4*)(gain + col), s4 = *(const float4*)(sh + col), c4 = *(const float4*)(sc + col);
            const float o0 = v[i].x * rstd * g.x * (1.f + c4.x) + s4.x, o1 = v[i].y * rstd * g.y * (1.f + c4.y) + s4.y,
                        o2 = v[i].z * rstd * g.z * (1.f + c4.z) + s4.z, o3 = v[i].w * rstd * g.w * (1.f + c4.w) + s4.w;
            *(uint2*)(A + (size_t)row * DM + col) = make_uint2(pk2(o0, o1), pk2(o2, o3)); }
    }
}
__device__ void phase_finalnorm(const P& p) {
    const int lane = threadIdx.x & 63, wave = threadIdx.x >> 6;
    for (int row = blockIdx.x * 8 + wave; row < MT; row += gridDim.x * 8) {
        float* src = p.out + (size_t)row * DM;
        float4 v[4]; float ss = 0.f;
#pragma unroll
        for (int i = 0; i < 4; ++i) { v[i] = *(const float4*)(src + lane * 4 + 256 * i); ss += v[i].x * v[i].x + v[i].y * v[i].y + v[i].z * v[i].z + v[i].w * v[i].w; }
#pragma unroll
        for (int o = 32; o >= 1; o >>= 1) ss += __shfl_xor(ss, o);
        const float rstd = rsqrtf(ss * (1.f / 1024.f) + 1e-6f);
#pragma unroll
        for (int i = 0; i < 4; ++i) { const int col = lane * 4 + 256 * i; const float4 g = *(const float4*)(p.nf + col);
            *(float4*)(src + col) = make_float4(v[i].x * rstd * g.x, v[i].y * rstd * g.y, v[i].z * rstd * g.z, v[i].w * rstd * g.w); }
    }
}

struct EpiSwiglu {
    static constexpr bool PERM = true;
    bf16_t* O;
    __device__ __forceinline__ void operator()(const f32x4 (&acc)[2][2][4][2], const pg8::Unit& u, int wr, int wc, int fr, int fq) const {
        const int row0 = u.pm * 256 + wr * 64 + fr, col0 = u.pn * 128 + wc * 32 + 8 * fq;
#pragma unroll
        for (int ai = 0; ai < 2; ++ai)
#pragma unroll
            for (int m = 0; m < 4; ++m) { bf16_t* rowp = O + (size_t)(row0 + ai * 128 + m * 16) * DFF + col0;
                float r[8];
#pragma unroll
                for (int n = 0; n < 2; ++n)
#pragma unroll
                    for (int j = 0; j < 4; ++j) r[n * 4 + j] = siluf(acc[ai][0][m][n][j]) * acc[ai][1][m][n][j];
                pg8::u32x4 w; w.x = pg8::cvt_pk_bf16(r[0], r[1]); w.y = pg8::cvt_pk_bf16(r[2], r[3]); w.z = pg8::cvt_pk_bf16(r[4], r[5]); w.w = pg8::cvt_pk_bf16(r[6], r[7]);
                *(pg8::u32x4*)rowp = w; }
    }
};
struct EpiResid {
    static constexpr bool PERM = false;
    const float* xp; const float* xs; float* out; const float* ga; float coef; int inplace;
    __device__ __forceinline__ void operator()(const f32x4 (&acc)[2][2][4][2], const pg8::Unit& u, int wr, int wc, int fr, int fq) const {
        const int row0 = u.pm * 256 + wr * 64 + fr, col0 = u.pn * 256 + wc * 32 + 4 * fq;
        const float* gap = ga + cond_of(u.pm * 256) * MODW;
        f32x4 gv[2][2];
#pragma unroll
        for (int bj = 0; bj < 2; ++bj)
#pragma unroll
            for (int n = 0; n < 2; ++n) gv[bj][n] = *(const f32x4*)(gap + col0 + bj * 128 + n * 16) * coef;
#pragma unroll
        for (int ai = 0; ai < 2; ++ai)
#pragma unroll
            for (int m = 0; m < 4; ++m) { const int row = row0 + ai * 128 + m * 16;
                const float* base = inplace ? out + (size_t)row * DM : (row < NCTX ? xp + (size_t)row * DM : xs + (size_t)(row - NCTX) * DM);
                float* op = out + (size_t)row * DM;
#pragma unroll
                for (int bj = 0; bj < 2; ++bj)
#pragma unroll
                    for (int n = 0; n < 2; ++n) { const int c = col0 + bj * 128 + n * 16; const f32x4 b4 = *(const f32x4*)(base + c);
                        *(f32x4*)(op + c) = b4 + gv[bj][n] * acc[ai][bj][m][n]; } }
    }
};
struct EpiU {
    static constexpr bool PERM = true;
    bf16_t* U; float* gates;
    __device__ __forceinline__ void operator()(const f32x4 (&acc)[2][2][4][2], const pg8::Unit& u, int wr, int wc, int fr, int fq) const {
        const int row0 = u.pm * 256 + wr * 64 + fr;
#pragma unroll
        for (int bj = 0; bj < 2; ++bj) { const int col0 = u.pn * 256 + bj * 128 + wc * 32 + 8 * fq;
            if (col0 < UW) {
#pragma unroll
                for (int ai = 0; ai < 2; ++ai)
#pragma unroll
                    for (int m = 0; m < 4; ++m) { const int row = row0 + ai * 128 + m * 16; const f32x4 v0 = acc[ai][bj][m][0], v1 = acc[ai][bj][m][1];
                        pg8::u32x4 w; w.x = pg8::cvt_pk_bf16(v0[0], v0[1]); w.y = pg8::cvt_pk_bf16(v0[2], v0[3]); w.z = pg8::cvt_pk_bf16(v1[0], v1[1]); w.w = pg8::cvt_pk_bf16(v1[2], v1[3]);
                        *(pg8::u32x4*)(U + (size_t)row * UW + col0) = w;
                        if (col0 >= 3968) { float* gp = gates + (size_t)row * 16 + (col0 - 3968); *(f32x4*)gp = v0; *(f32x4*)(gp + 4) = v1; } } } }
    }
};

template <class Epi>
__device__ __forceinline__ void run_gemm(unsigned char* lds, const bf16_t* A, const bf16_t* Bt, int N, int K, const Epi& E) {
    pg8::Gemm g{A, Bt, MT, N, K}; pg8::StaticOrder S; S.init(MT, N, (int)gridDim.x, (int)blockIdx.x);
    pg8::gemm_phase<Epi, pg8::StaticOrder, true, true>((PG8_LAS unsigned char*)lds, g, S, E);
}

constexpr int ML_SK = 0, ML_KWT = 17408, ML_VT = ML_KWT + 18432, ML_CB = ML_VT + 20736, ML_F = ML_CB + 21760, ML_CW = ML_F + 2048, ML_END = ML_CW + 4096;
static_assert(ML_END <= LDS_BYTES, "mlstm lds");

__device__ __forceinline__ unsigned short ld_u16_agent(const bf16_t* p) { return __hip_atomic_load(p, __ATOMIC_RELAXED, __HIP_MEMORY_SCOPE_AGENT); }

__device__ __forceinline__ void mlstm_task(const P& p, unsigned char* lds, int bg, int h) {
    const int wv = __builtin_amdgcn_readfirstlane((int)threadIdx.x >> 6), rw = wv & 3, cw = wv >> 2;
    const bool ctx = bg < 32; const int T = ctx ? 256 : 2048, nc = T / 64; const int row0 = ctx ? bg * 256 : NCTX + (bg - 32) * 2048;
    bf16_t* sK = (bf16_t*)(lds + ML_SK); bf16_t* sKwT = (bf16_t*)(lds + ML_KWT); bf16_t* sVT = (bf16_t*)(lds + ML_VT); bf16_t* sCb = (bf16_t*)(lds + ML_CB); bf16_t* sS = sCb;
    float* sA = (float*)(lds + ML_F); float* sM = sA + 64; float* sBb = sM + 64; float* sDen = sBb + 64; float* sScal = sDen + 64; float* sRed = sScal + 16;
    float* sCW = (float*)(lds + ML_CW);
    const bf16_t* U = (const bf16_t*)(p.ws + WS_U); const float* GATES = (const float*)(p.ws + WS_GATES); bf16_t* HB = (bf16_t*)(p.ws + WS_A);
    const int ct_a = cw ? 3 : 0;
    const int ct_b = cw ? 7 : 5;
    const int n_a = cw ? 2 : 3;

    __syncthreads();
    { const int tid = threadIdx.x;
      for (int i = tid; i < 1024; i += NTHR) { const int a = i >> 8, cc = i & 255, gch = (cc >> 7) * 512 + h * 128 + (cc & 127); sCW[i] = a < 3 ? p.cw[a * 1024 + gch] : p.cb[gch]; }
      for (int i = tid; i < 16 * 72; i += NTHR) { const int r = 128 + i / 72; sVT[r * 72 + (i % 72)] = (r == 128) ? (bf16_t)0x3F80 : (bf16_t)0; } }

#pragma unroll 1
    for (int dir = 0; dir < 2; ++dir) {
        f32x4 Cacc[9]; float m_prev = 0.f;
        { int z0 = 0; asm volatile("" : "+v"(z0)); const int tid = (int)threadIdx.x + z0, fr = tid & 15, fq = (tid >> 4) & 3;
#pragma unroll
          for (int ct = 0; ct < 9; ++ct) Cacc[ct] = (f32x4){0.f, 0.f, 0.f, 0.f};
          if (!ctx) { const int sidx = ((bg - 32) * 2 + dir) * 4 + h; const float* C0 = p.sC + (size_t)sidx * 16384; const float* n0 = p.sn + (size_t)sidx * 128;
#pragma unroll
              for (int j = 0; j < 4; ++j) { const int d = 16 * wv + 4 * fq + j;
#pragma unroll
                  for (int ct = 0; ct < 8; ++ct) Cacc[ct][j] = C0[d * 128 + 16 * ct + fr];
                  Cacc[8][j] = fr == 0 ? n0[d] : 0.f; }
              m_prev = p.sm[sidx]; } }
        const float gbi = p.gb[dir * 4 + h], gbf = p.gb[8 + dir * 4 + h];
        const bool second = dir == 1;
#pragma unroll 1
        for (int s = 0; s < nc; ++s) {
            const int c = dir ? nc - 1 - s : s;
            int zz = 0; asm volatile("" : "+v"(zz));
            const int tid = (int)threadIdx.x + zz, lane = tid & 63, fr = tid & 15, fq = (tid >> 4) & 3;
            __syncthreads();
            if (wv == 0) {
                const int tl = dir ? 63 - lane : lane; const size_t row = (size_t)row0 + c * 64 + tl;
                const float ip = GATES[row * 16 + dir * 4 + h] + gbi, fp = GATES[row * 16 + 8 + dir * 4 + h] + gbf;
                const float lf = fminf(fp, 0.f) - log1pf(__expf(-fabsf(fp)));
                float bs = lf;
#pragma unroll
                for (int o = 1; o < 64; o <<= 1) { const float t = __shfl_up(bs, o); if (lane >= o) bs += t; }
                const float a = ip - bs; float pm = a;
#pragma unroll
                for (int o = 1; o < 64; o <<= 1) { const float t = __shfl_up(pm, o); if (lane >= o) pm = fmaxf(pm, t); }
                const float Mt = fmaxf(m_prev, pm);
                sA[lane] = a; sM[lane] = Mt; sBb[lane] = bs;
                if (lane == 63) { sScal[0] = Mt; sScal[1] = bs; }
            }
            __syncthreads();
            const float M63 = sScal[0], bL = sScal[1];
#pragma unroll 1
            for (int g = 0; g < 2; ++g) {
                const int idx = tid + 512 * g, sl = idx >> 4, d0 = (idx & 15) * 8;
                const int tl = dir ? 63 - sl : sl, tok = c * 64 + tl; const size_t row = (size_t)row0 + tok;
                const int ch = 512 + h * 128 + d0;
                float cur[8], prv[8], nxt[8];
                unpack8(*(const uint4*)(U + row * UW + ch), cur);
                if (tok > 0) unpack8(*(const uint4*)(U + (row - 1) * UW + ch), prv); else {
#pragma unroll
                    for (int i = 0; i < 8; ++i) prv[i] = 0.f; }
                if (tok < T - 1) unpack8(*(const uint4*)(U + (row + 1) * UW + ch), nxt); else {
#pragma unroll
                    for (int i = 0; i < 8; ++i) nxt[i] = 0.f; }
                const float wk = __expf(sA[sl] - M63);
                float kv[8];
#pragma unroll
                for (int i = 0; i < 8; ++i) { const float* cwp = sCW + 128 + d0 + i; const float x = cwp[0] * prv[i] + cwp[256] * cur[i] + cwp[512] * nxt[i] + cwp[768]; kv[i] = siluf(x) * 0.08838834764831845f; }
                *(uint4*)(sK + sl * 136 + d0) = make_uint4(pk2(kv[0], kv[1]), pk2(kv[2], kv[3]), pk2(kv[4], kv[5]), pk2(kv[6], kv[7]));
#pragma unroll
                for (int i = 0; i < 8; ++i) sKwT[(d0 + i) * 72 + sl] = f2bf(kv[i] * wk);
                const uint4 vv = *(const uint4*)(U + row * UW + 1024 + h * 128 + d0);
                const unsigned vw[4] = {vv.x, vv.y, vv.z, vv.w};
#pragma unroll
                for (int i = 0; i < 8; ++i) sVT[(d0 + i) * 72 + sl] = (bf16_t)((vw[i >> 1] >> ((i & 1) * 16)) & 0xffffu);
            }
            bf16x8 qf[4];
            { const int t_ = 16 * rw + fr, tl = dir ? 63 - t_ : t_, tok = c * 64 + tl; const size_t row = (size_t)row0 + tok;
#pragma unroll
              for (int kk = 0; kk < 4; ++kk) { const int ch = h * 128 + 32 * kk + 8 * fq;
                  float cur[8], prv[8], nxt[8];
                  unpack8(*(const uint4*)(U + row * UW + ch), cur);
                  if (tok > 0) unpack8(*(const uint4*)(U + (row - 1) * UW + ch), prv); else {
#pragma unroll
                      for (int i = 0; i < 8; ++i) prv[i] = 0.f; }
                  if (tok < T - 1) unpack8(*(const uint4*)(U + (row + 1) * UW + ch), nxt); else {
#pragma unroll
                      for (int i = 0; i < 8; ++i) nxt[i] = 0.f; }
                  float qv[8];
#pragma unroll
                  for (int i = 0; i < 8; ++i) { const float* cwp = sCW + 32 * kk + 8 * fq + i; const float x = cwp[0] * prv[i] + cwp[256] * cur[i] + cwp[512] * nxt[i] + cwp[768]; qv[i] = siluf(x); }
                  union { uint4 u; bf16x8 v; } cv; cv.u = make_uint4(pk2(qv[0], qv[1]), pk2(qv[2], qv[3]), pk2(qv[4], qv[5]), pk2(qv[6], qv[7])); qf[kk] = cv.v; } }
            f32x4 num[5];
#pragma unroll
            for (int k = 0; k < 5; ++k) num[k] = (f32x4){0.f, 0.f, 0.f, 0.f};
#pragma unroll
            for (int ci = 0; ci < 5; ++ci) { const f32x4 v = Cacc[ci]; *(uint2*)(sCb + (16 * ci + fr) * 136 + 16 * wv + 4 * fq) = make_uint2(pk2(v[0], v[1]), pk2(v[2], v[3])); }
            __syncthreads();
#pragma unroll
            for (int k = 0; k < 3; ++k) if (k < n_a) {
#pragma unroll
                for (int kk = 0; kk < 4; ++kk) { const bf16x8 b = *(const bf16x8*)(sCb + (16 * (ct_a + k) + fr) * 136 + 32 * kk + 8 * fq); num[k] = mfma16(qf[kk], b, num[k]); } }
            __syncthreads();
#pragma unroll
            for (int ci = 0; ci < 4; ++ci) { const f32x4 v = Cacc[5 + ci]; *(uint2*)(sCb + (16 * ci + fr) * 136 + 16 * wv + 4 * fq) = make_uint2(pk2(v[0], v[1]), pk2(v[2], v[3])); }
            __syncthreads();
#pragma unroll
            for (int k = 3; k < 5; ++k) {
#pragma unroll
                for (int kk = 0; kk < 4; ++kk) { const bf16x8 b = *(const bf16x8*)(sCb + (16 * (ct_b + k - 3 - 5) + fr) * 136 + 32 * kk + 8 * fq); num[k] = mfma16(qf[kk], b, num[k]); } }
            {
                float scv[4];
#pragma unroll
                for (int j = 0; j < 4; ++j) scv[j] = __expf(m_prev - sM[16 * rw + 4 * fq + j]);
#pragma unroll
                for (int k = 0; k < 5; ++k)
#pragma unroll
                    for (int j = 0; j < 4; ++j) num[k][j] *= scv[j];
            }
            __syncthreads();
#pragma unroll
            for (int si = 0; si < 2; ++si) { const int st = 2 * cw + si;
                f32x4 sacc = (f32x4){0.f, 0.f, 0.f, 0.f};
                if (st <= rw) {
#pragma unroll
                    for (int kk = 0; kk < 4; ++kk) { const bf16x8 b = *(const bf16x8*)(sK + (16 * st + fr) * 136 + 32 * kk + 8 * fq); sacc = mfma16(qf[kk], b, sacc); } }
                const int sp = 16 * st + fr; const float as = sA[sp];
#pragma unroll
                for (int j = 0; j < 4; ++j) { const int tp = 16 * rw + 4 * fq + j; const float val = (sp <= tp) ? sacc[j] * __expf(as - sM[tp]) : 0.f; sS[tp * 72 + sp] = f2bf(val); }
            }
            __syncthreads();
#pragma unroll
            for (int ks = 0; ks < 2; ++ks) { const bf16x8 a = *(const bf16x8*)(sS + (16 * rw + fr) * 72 + 32 * ks + 8 * fq);
#pragma unroll
                for (int k = 0; k < 5; ++k) { const int ct = k < 3 ? ct_a + k : ct_b + k - 3;
                    if (k != 2 || cw == 0) { const bf16x8 b = *(const bf16x8*)(sVT + (16 * ct + fr) * 72 + 32 * ks + 8 * fq); num[k] = mfma16(a, b, num[k]); } } }
            if (cw == 1 && fr == 0) {
#pragma unroll
                for (int j = 0; j < 4; ++j) sDen[16 * rw + 4 * fq + j] = num[4][j]; }
            __syncthreads();
            float inv[4];
#pragma unroll
            for (int j = 0; j < 4; ++j) { const int tp = 16 * rw + 4 * fq + j; const float den = sDen[tp]; inv[j] = 1.f / fmaxf(fabsf(den), __expf(-(sBb[tp] + sM[tp]))); }
            if (!second) {
#pragma unroll
                for (int j = 0; j < 4; ++j) { const int tp = 16 * rw + 4 * fq + j, tl = dir ? 63 - tp : tp; const size_t row = (size_t)row0 + c * 64 + tl;
                    bf16_t* hb = HB + row * DM + h * 128;
#pragma unroll
                    for (int k = 0; k < 5; ++k) { const int ct = k < 3 ? ct_a + k : ct_b + k - 3; if ((k != 2 || cw == 0) && ct < 8) hb[16 * ct + fr] = f2bf(num[k][j] * inv[j]); } }
            } else {
                float ssr[4];
#pragma unroll
                for (int j = 0; j < 4; ++j) { const int tp = 16 * rw + 4 * fq + j, tl = dir ? 63 - tp : tp; const size_t row = (size_t)row0 + c * 64 + tl;
                    const bf16_t* hb = HB + row * DM + h * 128; float ss = 0.f;
#pragma unroll
                    for (int k = 0; k < 5; ++k) { const int ct = k < 3 ? ct_a + k : ct_b + k - 3;
                        if ((k != 2 || cw == 0) && ct < 8) { const int e = 16 * ct + fr; const float other = bf2f(ld_u16_agent(hb + e)); const float hs = num[k][j] * inv[j] + other;
                            const float o = sigmf(bf2f(U[row * UW + 1536 + h * 128 + e])); const float v = o * hs; ss += v * v; num[k][j] = v; } }
                    ss += __shfl_xor(ss, 1); ss += __shfl_xor(ss, 2); ss += __shfl_xor(ss, 4); ss += __shfl_xor(ss, 8);
                    ssr[j] = ss; if (fr == 0) sRed[cw * 64 + tp] = ss; }
                __syncthreads();
#pragma unroll
                for (int j = 0; j < 4; ++j) { const int tp = 16 * rw + 4 * fq + j, tl = dir ? 63 - tp : tp; const size_t row = (size_t)row0 + c * 64 + tl;
                    bf16_t* hb = HB + row * DM + h * 128; const float rms = rsqrtf((ssr[j] + sRed[(1 - cw) * 64 + tp]) * (1.f / 128.f) + 1e-6f);
#pragma unroll
                    for (int k = 0; k < 5; ++k) { const int ct = k < 3 ? ct_a + k : ct_b + k - 3;
                        if ((k != 2 || cw == 0) && ct < 8) { const int e = 16 * ct + fr; hb[e] = f2bf(num[k][j] * rms * p.hg[h * 128 + e]); } } }
            }
            const float decay = __expf(m_prev - M63);
#pragma unroll
            for (int ct = 0; ct < 9; ++ct) Cacc[ct] = Cacc[ct] * decay;
#pragma unroll
            for (int ks = 0; ks < 2; ++ks) { const bf16x8 a = *(const bf16x8*)(sKwT + (16 * wv + fr) * 72 + 32 * ks + 8 * fq);
#pragma unroll
                for (int ct = 0; ct < 9; ++ct) { const bf16x8 b = *(const bf16x8*)(sVT + (16 * ct + fr) * 72 + 32 * ks + 8 * fq); Cacc[ct] = mfma16(a, b, Cacc[ct]); } }
            m_prev = bL + M63;
        }
        if (ctx) { const int sidx = (bg * 2 + dir) * 4 + h; float* Co = p.out + OUT_C + (size_t)sidx * 16384;
            int z1 = 0; asm volatile("" : "+v"(z1)); const int tid1 = (int)threadIdx.x + z1, fr1 = tid1 & 15, fq1 = (tid1 >> 4) & 3;
#pragma unroll
            for (int j = 0; j < 4; ++j) { const int d = 16 * wv + 4 * fq1 + j;
#pragma unroll
                for (int ct = 0; ct < 8; ++ct) Co[d * 128 + 16 * ct + fr1] = Cacc[ct][j];
                if (fr1 == 0) p.out[OUT_N + sidx * 128 + d] = Cacc[8][j]; }
            if (tid1 == 0) p.out[OUT_MM + sidx] = m_prev; }
        __syncthreads();
    }
}

constexpr int RW_TC = 16;
constexpr int RW_DIR_FLOATS = 16 * 6 * 64 + 16 * 64 * 3 + 16 * 128 + 16 * 64 * 5;
constexpr int RW_DIR = RW_DIR_FLOATS * 4;
static_assert(2 * RW_DIR <= LDS_BYTES, "rwkv lds");

__device__ __forceinline__ float shifted_u(const bf16_t* U, const float* mu, size_t row0, int tok, int T, bool grid, int col) {
    const int rc = col - 2048; const bf16_t* b = U + (row0 + tok) * UW + col;
    const float x = bf2f(b[0]);
    const bool hl = grid ? (tok & 63) != 0 : tok > 0, hr = grid ? (tok & 63) != 63 : tok < T - 1;
    const float Lv = hl ? bf2f(*(b - UW)) : 0.f, Rv = hr ? bf2f(*(b + UW)) : 0.f;
    float o = x + mu[rc] * (Lv - x) + mu[1920 + rc] * (Rv - x);
    if (grid) { const float Uv = tok >= 64 ? bf2f(*(b - 64 * (long)UW)) : 0.f, Dv = tok < T - 64 ? bf2f(*(b + 64 * (long)UW)) : 0.f;
        o += mu[3840 + rc] * (Uv - x) + mu[5760 + rc] * (Dv - x); }
    return o;
}

__device__ __forceinline__ void rwkv_task(const P& p, unsigned char* lds, int bg, int h) {
    int z0 = 0; asm volatile("" : "+v"(z0));
    const int dir = __builtin_amdgcn_readfirstlane((int)threadIdx.x >> 8); const int tid = (int)threadIdx.x + z0, ltid = tid & 255;
    const bool ctx = bg < 32; const int T = ctx ? 256 : 2048, nc = T / RW_TC; const size_t row0 = ctx ? (size_t)bg * 256 : (size_t)NCTX + (size_t)(bg - 32) * 2048;
    const bool grid = !ctx;
    float* L = (float*)lds + dir * RW_DIR_FLOATS;
    float* sVec = L; float* sXw = sVec + 16 * 6 * 64; float* sXa = sXw + 1024; float* sXo = sXa + 1024; float* sXg = sXo + 1024; float* sKr = sXg + 2048; float* sY = sKr + 1024; float* sAown = sY + 1024;
    const bf16_t* U = (const bf16_t*)(p.ws + WS_U); bf16_t* HB = (bf16_t*)(p.ws + WS_A);
    const int ri = ltid >> 2, jq = ltid & 3;
    float st[16];
    if (ctx) {
#pragma unroll
        for (int j = 0; j < 16; ++j) st[j] = 0.f;
    } else { const float* S0 = p.sS + ((size_t)(((bg - 32) * 2 + dir) * 8 + h)) * 4096 + ri * 64 + jq * 16;
#pragma unroll
        for (int j = 0; j < 16; ++j) st[j] = S0[j]; }
    const int hc = h * 64;
    const int tlm = ltid >> 4, j0 = (ltid & 15) * 4;
    for (int s = 0; s < nc; ++s) {
        const int c = dir ? nc - 1 - s : s; const int tok0 = c * RW_TC;
        const bool second = s >= (nc >> 1);
        __syncthreads();
#pragma unroll 1
        for (int it = 0; it < 32; ++it) { const int idx = ltid + 256 * it, tl = idx >> 9, ci = idx & 511; const int tok = tok0 + tl;
            if (ci < 64) sVec[tl * 384 + 0 * 64 + ci] = shifted_u(U, p.mu, row0, tok, T, grid, 2048 + hc + ci);
            else if (ci < 128) sKr[tl * 64 + ci - 64] = shifted_u(U, p.mu, row0, tok, T, grid, 2048 + 512 + hc + ci - 64);
            else if (ci < 192) sVec[tl * 384 + 3 * 64 + ci - 128] = shifted_u(U, p.mu, row0, tok, T, grid, 2048 + 1024 + hc + ci - 128);
            else if (ci < 256) sXw[tl * 64 + ci - 192] = tanhf(shifted_u(U, p.mu, row0, tok, T, grid, 2048 + 1536 + dir * 64 + ci - 192));
            else if (ci < 320) sXa[tl * 64 + ci - 256] = shifted_u(U, p.mu, row0, tok, T, grid, 2048 + 1664 + dir * 64 + ci - 256);
            else if (ci < 384) { if (second) sXo[tl * 64 + ci - 320] = shifted_u(U, p.mu, row0, tok, T, grid, 2048 + 1664 + (1 - dir) * 64 + ci - 320); }
            else { if (second) sXg[tl * 128 + ci - 384] = sigmf(shifted_u(U, p.mu, row0, tok, T, grid, 2048 + 1792 + ci - 384)); } }
        __syncthreads();
        {
            float wp[4], ap[4];
#pragma unroll
            for (int q = 0; q < 4; ++q) { wp[q] = p.w0[dir * 512 + hc + j0 + q]; ap[q] = p.a0[dir * 512 + hc + j0 + q]; }
            const float* w2p = p.w2 + (size_t)(dir * 64) * 512 + hc + j0; const float* a2p = p.a2 + (size_t)(dir * 64) * 512 + hc + j0;
#pragma unroll 4
            for (int l = 0; l < 64; ++l) { const float xw = sXw[tlm * 64 + l], xa = sXa[tlm * 64 + l]; const float4 w4 = *(const float4*)(w2p + l * 512), a4 = *(const float4*)(a2p + l * 512);
                wp[0] += xw * w4.x; wp[1] += xw * w4.y; wp[2] += xw * w4.z; wp[3] += xw * w4.w; ap[0] += xa * a4.x; ap[1] += xa * a4.y; ap[2] += xa * a4.z; ap[3] += xa * a4.w; }
            float kr[4], kkv[4]; float ssq = 0.f;
#pragma unroll
            for (int q = 0; q < 4; ++q) { kr[q] = sKr[tlm * 64 + j0 + q]; kkv[q] = kr[q] * p.kk[hc + j0 + q]; ssq += kkv[q] * kkv[q]; }
            ssq += __shfl_xor(ssq, 1); ssq += __shfl_xor(ssq, 2); ssq += __shfl_xor(ssq, 4); ssq += __shfl_xor(ssq, 8);
            const float rn = 1.f / fmaxf(sqrtf(ssq), 1e-12f);
#pragma unroll
            for (int q = 0; q < 4; ++q) { const float z = -wp[q]; const float sp = fmaxf(z, 0.f) + log1pf(__expf(-fabsf(z))); const float w = -sp - 0.5f; const float dec = __expf(-__expf(w));
                const float a = sigmf(ap[q]); const float kn = kkv[q] * rn; const float kd = kr[q] * (1.f + (a - 1.f) * p.ka[hc + j0 + q]);
                float* V = sVec + tlm * 384 + j0 + q; V[64] = dec; V[128] = kd; V[256] = kn; V[320] = kn * a; sAown[tlm * 64 + j0 + q] = a; }
        }
        __syncthreads();
#pragma unroll 1
        for (int step = 0; step < RW_TC; ++step) { const int tl = dir ? RW_TC - 1 - step : step; const float* V = sVec + tl * 384 + jq * 16;
            float sa = 0.f;
#pragma unroll
            for (int q4 = 0; q4 < 4; ++q4) { const float4 k4 = *(const float4*)(V + 256 + q4 * 4); sa += st[q4 * 4] * k4.x + st[q4 * 4 + 1] * k4.y + st[q4 * 4 + 2] * k4.z + st[q4 * 4 + 3] * k4.w; }
            sa += __shfl_xor(sa, 1); sa += __shfl_xor(sa, 2); sa = -sa;
            const float vi = sVec[tl * 384 + 192 + ri];
            float y = 0.f;
#pragma unroll
            for (int q4 = 0; q4 < 4; ++q4) { const float4 w4 = *(const float4*)(V + 64 + q4 * 4), b4 = *(const float4*)(V + 320 + q4 * 4), k4 = *(const float4*)(V + 128 + q4 * 4), r4 = *(const float4*)(V + q4 * 4);
                st[q4 * 4 + 0] = st[q4 * 4 + 0] * w4.x + sa * b4.x + vi * k4.x; st[q4 * 4 + 1] = st[q4 * 4 + 1] * w4.y + sa * b4.y + vi * k4.y;
                st[q4 * 4 + 2] = st[q4 * 4 + 2] * w4.z + sa * b4.z + vi * k4.z; st[q4 * 4 + 3] = st[q4 * 4 + 3] * w4.w + sa * b4.w + vi * k4.w;
                y += st[q4 * 4] * r4.x + st[q4 * 4 + 1] * r4.y + st[q4 * 4 + 2] * r4.z + st[q4 * 4 + 3] * r4.w; }
            y += __shfl_xor(y, 1); y += __shfl_xor(y, 2);
            if (jq == 0) sY[tl * 64 + ri] = y; }
        __syncthreads();
        { const size_t row = row0 + tok0 + tlm; bf16_t* hb = HB + row * DM + 512 + hc + j0;
          float y4[4];
#pragma unroll
          for (int q = 0; q < 4; ++q) y4[q] = sY[tlm * 64 + j0 + q];
          if (!second) { *(uint2*)hb = make_uint2(pk2(y4[0], y4[1]), pk2(y4[2], y4[3])); }
          else {
              const unsigned long long ov = __hip_atomic_load((const unsigned long long*)hb, __ATOMIC_RELAXED, __HIP_MEMORY_SCOPE_AGENT);
              y4[0] += __uint_as_float(((unsigned)ov) << 16); y4[1] += __uint_as_float(((unsigned)ov) & 0xffff0000u);
              y4[2] += __uint_as_float(((unsigned)(ov >> 32)) << 16); y4[3] += __uint_as_float(((unsigned)(ov >> 32)) & 0xffff0000u);
              float sm = y4[0] + y4[1] + y4[2] + y4[3];
              sm += __shfl_xor(sm, 1); sm += __shfl_xor(sm, 2); sm += __shfl_xor(sm, 4); sm += __shfl_xor(sm, 8);
              const float mean = sm * (1.f / 64.f); float vs = 0.f;
#pragma unroll
              for (int q = 0; q < 4; ++q) { const float d = y4[q] - mean; vs += d * d; }
              vs += __shfl_xor(vs, 1); vs += __shfl_xor(vs, 2); vs += __shfl_xor(vs, 4); vs += __shfl_xor(vs, 8);
              const float rstd = rsqrtf(vs * (1.f / 64.f) + 64e-5f);
              float ao[4], gg[4];
#pragma unroll
              for (int q = 0; q < 4; ++q) { ao[q] = p.a0[(1 - dir) * 512 + hc + j0 + q]; gg[q] = 0.f; }
              const float* a2o = p.a2 + (size_t)((1 - dir) * 64) * 512 + hc + j0; const float* g2p = p.g2 + hc + j0;
#pragma unroll 4
              for (int l = 0; l < 64; ++l) { const float xo = sXo[tlm * 64 + l]; const float4 a4 = *(const float4*)(a2o + l * 512);
                  ao[0] += xo * a4.x; ao[1] += xo * a4.y; ao[2] += xo * a4.z; ao[3] += xo * a4.w; }
#pragma unroll 4
              for (int l = 0; l < 128; ++l) { const float xg = sXg[tlm * 128 + l]; const float4 g4 = *(const float4*)(g2p + l * 512);
                  gg[0] += xg * g4.x; gg[1] += xg * g4.y; gg[2] += xg * g4.z; gg[3] += xg * g4.w; }
              float bs = 0.f;
#pragma unroll
              for (int q = 0; q < 4; ++q) { const int j = j0 + q; const float am = 0.5f * (sigmf(ao[q]) + sAown[tlm * 64 + j]);
                  const float kbar = sKr[tlm * 64 + j] * (1.f + (am - 1.f) * p.ka[hc + j]); bs += sVec[tlm * 384 + j] * kbar * p.rk[hc + j]; }
              bs += __shfl_xor(bs, 1); bs += __shfl_xor(bs, 2); bs += __shfl_xor(bs, 4); bs += __shfl_xor(bs, 8);
              float o4[4];
#pragma unroll
              for (int q = 0; q < 4; ++q) { const int j = j0 + q; const float yn = (y4[q] - mean) * rstd * p.lng[hc + j] + p.lnb[hc + j]; o4[q] = (yn + bs * sVec[tlm * 384 + 192 + j]) * gg[q]; }
              *(uint2*)hb = make_uint2(pk2(o4[0], o4[1]), pk2(o4[2], o4[3]));
          } }
    }
    if (ctx) { float* So = p.out + OUT_S + ((size_t)((bg * 2 + dir) * 8 + h)) * 4096 + ri * 64 + jq * 16;
#pragma unroll
        for (int j = 0; j < 16; ++j) So[j] = st[j]; }
    __syncthreads();
}

__device__ __forceinline__ void scan_decode_task(int t, int& kind, int& bg, int& h) {
    if (t < 32) { kind = 0; bg = 32 + t / 4; h = t % 4; }
    else if (t < 96) { kind = 1; bg = 32 + (t - 32) / 8; h = (t - 32) % 8; }
    else if (t < 352) { kind = 1; bg = (t - 96) / 8; h = (t - 96) % 8; }
    else { kind = 0; bg = (t - 352) / 4; h = (t - 352) % 4; }
}
__device__ __forceinline__ void phase_scan(const P& p, unsigned char* lds) {
    const int nb = gridDim.x, bid = blockIdx.x;
    int t, step;
    if (nb >= 128) { if (bid < 96) { t = bid; step = 1000; } else { t = bid; step = nb - 96; } }
    else { t = bid; step = nb; }
#pragma unroll 1
    for (; t < 480; t += step) {
        int kind, bg, h; scan_decode_task(t, kind, bg, h);
        if (kind == 0) mlstm_task(p, lds, bg, h); else rwkv_task(p, lds, bg, h);
    }
}

__device__ void phase_convert_w2(const P& p, unsigned char* lds) {
    float* tile = (float*)lds;
    const int t1 = 16 * 88, t2 = 44 * 16;
    for (int it = blockIdx.x; it < t1 + t2; it += gridDim.x) {
        if (it < t1) do_convert(p.w2in, (bf16_t*)(p.ws + WS_W1), 1024, 5632, 5632, 1, it, tile);
        else do_convert(p.w2out, (bf16_t*)(p.ws + WS_W1B), 2816, 1024, 1024, 0, it - t1, tile);
    }
}

constexpr int NPHASE = 12;
template <int PH>
__device__ __forceinline__ void run_phase(const P& p, unsigned char* lds) {
    const float* mod = (const float*)(p.ws + WS_MOD);
    if constexpr (PH == 0) phase0(p, lds);
    if constexpr (PH == 1) phase_normmod(p, 0);
    if constexpr (PH == 2) { EpiSwiglu E{(bf16_t*)(p.ws + WS_U)}; run_gemm(lds, (const bf16_t*)(p.ws + WS_A), (const bf16_t*)(p.ws + WS_W1), 5632, 1024, E); }
    if constexpr (PH == 3) { EpiResid E{p.xp, p.xs, p.out, mod + 2048, 0.5f, 0}; run_gemm(lds, (const bf16_t*)(p.ws + WS_U), (const bf16_t*)(p.ws + WS_W1B), 1024, 2816, E); }
    if constexpr (PH == 4) phase_normmod(p, 1);
    if constexpr (PH == 5) { EpiU E{(bf16_t*)(p.ws + WS_U), (float*)(p.ws + WS_GATES)}; run_gemm(lds, (const bf16_t*)(p.ws + WS_A), (const bf16_t*)(p.ws + WS_BT3), 4096, 1024, E); }
    if constexpr (PH == 6) phase_scan(p, lds);
    if constexpr (PH == 7) { EpiResid E{p.xp, p.xs, p.out, mod + 5120, 1.0f, 1}; run_gemm(lds, (const bf16_t*)(p.ws + WS_A), (const bf16_t*)(p.ws + WS_BT4), 1024, 1024, E); }
    if constexpr (PH == 8) { phase_normmod(p, 2); phase_convert_w2(p, lds); }
    if constexpr (PH == 9) { EpiSwiglu E{(bf16_t*)(p.ws + WS_U)}; run_gemm(lds, (const bf16_t*)(p.ws + WS_A), (const bf16_t*)(p.ws + WS_W1), 5632, 1024, E); }
    if constexpr (PH == 10) { EpiResid E{p.xp, p.xs, p.out, mod + 8192, 0.5f, 1}; run_gemm(lds, (const bf16_t*)(p.ws + WS_U), (const bf16_t*)(p.ws + WS_W1B), 1024, 2816, E); }
    if constexpr (PH == 11) phase_finalnorm(p);
}

#if !ONE_LAUNCH
template <int PH>
__global__ void __launch_bounds__(NTHR, 2) k_phase(P p) {
    extern __shared__ __attribute__((aligned(16))) unsigned char lds[];
    run_phase<PH>(p, lds);
}
#endif

#if ONE_LAUNCH
__global__ void __launch_bounds__(NTHR, 2) k_mega(P p) {
    extern __shared__ __attribute__((aligned(16))) unsigned char lds[];
    cg::grid_group grid = cg::this_grid();
    run_phase<0>(p, lds); grid.sync();
    run_phase<1>(p, lds); grid.sync();
    run_phase<2>(p, lds); grid.sync();
    run_phase<3>(p, lds); grid.sync();
    run_phase<4>(p, lds); grid.sync();
    run_phase<5>(p, lds); grid.sync();
    run_phase<6>(p, lds); grid.sync();
    run_phase<7>(p, lds); grid.sync();
    run_phase<8>(p, lds); grid.sync();
    run_phase<9>(p, lds); grid.sync();
    run_phase<10>(p, lds); grid.sync();
    run_phase<11>(p, lds);
}
#endif

#if !ONE_LAUNCH
template <int PH> static void launch_phase(const P& p, int grid, hipStream_t stream) {
    static bool attr = false;
    if (!attr) { (void)hipFuncSetAttribute((const void*)k_phase<PH>, hipFuncAttributeMaxDynamicSharedMemorySize, LDS_BYTES); attr = true; }
    hipLaunchKernelGGL(k_phase<PH>, dim3(grid), dim3(NTHR), LDS_BYTES, stream, p);
}
#endif

extern "C" void kernel_launch(void* const* d_in, const int* in_sizes, int n_in, void* d_out, int out_size, void* d_ws, size_t ws_size, hipStream_t stream) {
    (void)in_sizes; (void)n_in; (void)out_size; (void)ws_size;
    static int grid = 0;
    if (grid == 0) {
        int dev = 0, cus = 0;
        if (hipGetDevice(&dev) != hipSuccess || hipDeviceGetAttribute(&cus, hipDeviceAttributeMultiprocessorCount, dev) != hipSuccess || cus <= 0) cus = 256;
#if ONE_LAUNCH
        (void)hipFuncSetAttribute((const void*)k_mega, hipFuncAttributeMaxDynamicSharedMemorySize, LDS_BYTES);
        int per_cu = 0;
        if (hipOccupancyMaxActiveBlocksPerMultiprocessor(&per_cu, (const void*)k_mega, NTHR, LDS_BYTES) != hipSuccess || per_cu < 1) per_cu = 1;
        (void)hipGetLastError();
#endif
        grid = cus;
    }
    P p{};
    const float** f = (const float**)&p;
    for (int i = 0; i < 35; ++i) f[i] = (const float*)d_in[i];
    p.out = (float*)d_out; p.ws = (unsigned char*)d_ws;
    (void)hipMemsetAsync((char*)d_ws + WS_MOD, 0, NCOND * MODW * sizeof(float), stream);
#if ONE_LAUNCH
    void* args[] = {&p};
    hipError_t e = hipLaunchCooperativeKernel((const void*)k_mega, dim3(grid), dim3(NTHR), args, LDS_BYTES, stream);
    if (e != hipSuccess) fprintf(stderr, "cooperative launch failed: %s (grid %d)\n", hipGetErrorString(e), grid);
#else
    launch_phase<0>(p, grid, stream); launch_phase<1>(p, grid, stream); launch_phase<2>(p, grid, stream); launch_phase<3>(p, grid, stream);
    launch_phase<4>(p, grid, stream); launch_phase<5>(p, grid, stream); launch_phase<6>(p, grid, stream); launch_phase<7>(p, grid, stream);
    launch_phase<8>(p, grid, stream); launch_phase<9>(p, grid, stream); launch_phase<10>(p, grid, stream); launch_phase<11>(p, grid, stream);
#endif
}
```

```cpp
#include <hip/hip_runtime.h>
#include <hip/hip_cooperative_groups.h>
#include <cstdio>
#include <cstdint>
namespace cg = cooperative_groups;

#ifndef ONE_LAUNCH
#define ONE_LAUNCH 1
#endif

__device__ __forceinline__ int opaque_tid() { int z = 0; asm volatile("" : "+v"(z)); return (int)threadIdx.x + z; }

namespace pg8 {
#define PG8_LAS __attribute__((address_space(3)))
typedef unsigned short bf16_t;
typedef short bf16x8 __attribute__((ext_vector_type(8)));
typedef float f32x4 __attribute__((ext_vector_type(4)));
typedef unsigned u32x4 __attribute__((ext_vector_type(4)));
constexpr int BM = 256, BK = 64, HALF = 128, HTB = HALF * BK * 2, STAGE_BYTES = 8 * HTB, NXCD = 8, WGM = 8;

__host__ __device__ __forceinline__ int lds_byte(int r, int c) { const int st = (r >> 4) * 2 + (c >> 5), rr = r & 15, cc = c & 31, ob = rr * 64 + cc * 2; return st * 1024 + (ob ^ (((ob >> 9) & 1) << 5)); }
__host__ __device__ __forceinline__ void stage_rc(int b, int& R, int& C) { const int st = b / 1024, sb = b % 1024, swz = sb ^ (((sb >> 9) & 1) << 5); R = (st >> 1) * 16 + swz / 64; C = (st & 1) * 32 + (swz % 64) / 2; }
__host__ __device__ __forceinline__ int perm32(int rho) { const int n = rho >> 4, i = rho & 15; return 8 * (i >> 2) + 4 * n + (i & 3); }

struct Unit { int pm, pn; };
struct Gemm { const bf16_t* A; const bf16_t* Bt; int M, N, K; };

struct StaticOrder {
    int nM, nN, nwg, G, c;
    __host__ __device__ void init(int M, int N, int G_, int c_) { nM = M / BM; nN = N / BM; nwg = nM * nN; G = G_; c = c_; }
    __host__ __device__ bool next(int i, Unit& u) const {
        const long L = (long)i * G + c; if (L >= nwg) return false;
        int wgid = (int)L; { const int q = nwg / NXCD, r = nwg % NXCD, xcd = wgid % NXCD, off = wgid / NXCD; wgid = (xcd < r ? xcd * (q + 1) : r * (q + 1) + (xcd - r) * q) + off; }
        const int nig = WGM * nN, gid = wgid / nig, fm = gid * WGM, gsz = (nM - fm) < WGM ? (nM - fm) : WGM;
        u.pm = fm + ((wgid % nig) % gsz); u.pn = (wgid % nig) / gsz; return true;
    }
    __device__ __forceinline__ void a_ready(const Unit&) const {}
    __device__ __forceinline__ void done(const Unit&) const {}
};

__device__ __forceinline__ unsigned cvt_pk_bf16(float lo, float hi) { unsigned r; asm volatile("v_cvt_pk_bf16_f32 %0, %1, %2" : "=v"(r) : "v"(lo), "v"(hi)); return r; }

template <class Epi, class Sched, bool ALIGN_EPI = false, bool SP2 = false>
__device__ __forceinline__ void gemm_phase(PG8_LAS unsigned char* lds, const Gemm g, const Sched& S, const Epi& E) {
    const int tid = opaque_tid(), wid = __builtin_amdgcn_readfirstlane((int)threadIdx.x >> 6), lane = tid & 63, wr = wid >> 2, wc = wid & 3, fr = lane & 15, fq = lane >> 4;
    const int K = g.K, nt = K / BK;
    unsigned voffA[2], voffB[2];
#pragma unroll
    for (int i = 0; i < 2; ++i) { int R, C; stage_rc(tid * 16 + i * 8192, R, C); const int Rb = Epi::PERM ? ((R & ~31) + perm32(R & 31)) : R;
        voffA[i] = (unsigned)(R * K + C) * 2u; voffB[i] = (unsigned)(Rb * K + C) * 2u; }
    const size_t kstep = (size_t)(BK * 2);
    const size_t hstep = (size_t)HALF * K * 2;
    const size_t tstep = 2 * hstep;
    const unsigned ldsw = (unsigned)wid * 1024u;
    const int aoff = lds_byte(wr * 64 + fr, fq * 8), boff = lds_byte(wc * 32 + fr, fq * 8);
#define PG8_SA(b, h) (((b) * 2 + (h)) * HTB)
#define PG8_SB(b, h) ((4 + (b) * 2 + (h)) * HTB)
#define PG8_STAGE(bufoff, gbase, voff) do { _Pragma("unroll") for (int _i = 0; _i < 2; ++_i) \
        __builtin_amdgcn_global_load_lds((const unsigned*)((const char*)(gbase) + (voff)[_i]), (PG8_LAS unsigned*)(lds + (bufoff) + ldsw + _i * 8192), 16, 0, 0); } while (0)
#define PG8_LDA(dst, b, h) do { _Pragma("unroll") for (int m = 0; m < 4; ++m) _Pragma("unroll") for (int k = 0; k < 2; ++k) dst[m][k] = *(const PG8_LAS bf16x8*)(lds + PG8_SA(b, h) + aoff + m * 2048 + k * 1024); } while (0)
#define PG8_LDB(dst, b, h) do { _Pragma("unroll") for (int n = 0; n < 2; ++n) _Pragma("unroll") for (int k = 0; k < 2; ++k) dst[n][k] = *(const PG8_LAS bf16x8*)(lds + PG8_SB(b, h) + boff + n * 2048 + k * 1024); } while (0)
#define PG8_MMA(ai, bj, At, Bt) do { __builtin_amdgcn_s_setprio(1); _Pragma("unroll") for (int m = 0; m < 4; ++m) _Pragma("unroll") for (int n = 0; n < 2; ++n) _Pragma("unroll") for (int k = 0; k < 2; ++k) \
        acc[ai][bj][m][n] = __builtin_amdgcn_mfma_f32_16x16x32_bf16(Bt[n][k], At[m][k], acc[ai][bj][m][n], 0, 0, 0); __builtin_amdgcn_s_setprio(0); } while (0)
#define PG8_WAIT_V(n) asm volatile("s_waitcnt vmcnt(" #n ")" ::: "memory")
#define PG8_WAIT_L(n) asm volatile("s_waitcnt lgkmcnt(" #n ")" ::: "memory")
#define PG8_BAR __builtin_amdgcn_s_barrier()
#define PG8_SCHED __builtin_amdgcn_sched_barrier(0)
    Unit cur, nxt; int ui = 0;
    if (!S.next(0, cur)) return;
    f32x4 acc[2][2][4][2];
#pragma unroll
    for (int a = 0; a < 2; ++a)
#pragma unroll
        for (int b = 0; b < 2; ++b)
#pragma unroll
            for (int m = 0; m < 4; ++m)
#pragma unroll
                for (int n = 0; n < 2; ++n) acc[a][b][m][n] = (f32x4){0.f, 0.f, 0.f, 0.f};
    bf16x8 At[4][2], B0[2][2], B1[2][2];
    const char* cA = (const char*)g.A + (size_t)cur.pm * tstep; const char* cB = (const char*)g.Bt + (size_t)cur.pn * tstep;
    S.a_ready(cur);
    if constexpr (SP2) {
        PG8_STAGE(PG8_SB(0, 0), cB, voffB); PG8_STAGE(PG8_SB(0, 1), cB + hstep, voffB); PG8_STAGE(PG8_SA(0, 0), cA, voffA); PG8_STAGE(PG8_SA(0, 1), cA + hstep, voffA);
        if (wr == 1) PG8_BAR;
        PG8_WAIT_V(2); PG8_BAR;
        PG8_STAGE(PG8_SB(1, 0), cB + kstep, voffB); PG8_STAGE(PG8_SA(1, 0), cA + kstep, voffA); PG8_STAGE(PG8_SB(1, 1), cB + hstep + kstep, voffB);
        PG8_WAIT_V(6); PG8_BAR;
    } else {
        PG8_STAGE(PG8_SB(0, 0), cB, voffB); PG8_STAGE(PG8_SA(0, 0), cA, voffA); PG8_STAGE(PG8_SB(0, 1), cB + hstep, voffB); PG8_STAGE(PG8_SA(0, 1), cA + hstep, voffA);
        if (wr == 1) PG8_BAR;
        PG8_WAIT_V(4); PG8_BAR;
        PG8_STAGE(PG8_SB(1, 0), cB + kstep, voffB); PG8_STAGE(PG8_SA(1, 0), cA + kstep, voffA); PG8_STAGE(PG8_SB(1, 1), cB + hstep + kstep, voffB);
        PG8_WAIT_V(6); PG8_BAR;
    }
    for (;;) {
        const bool has_next = S.next(ui + 1, nxt);
        const char* nA = has_next ? (const char*)g.A + (size_t)nxt.pm * tstep : cA; const char* nB = has_next ? (const char*)g.Bt + (size_t)nxt.pn * tstep : cB;
        for (int t = 0; t < nt; t += 2) {
            const bool last = (t == nt - 2);
            const char* a1 = cA + (size_t)(t + 1) * kstep;
            const char* a2 = last ? nA : cA + (size_t)(t + 2) * kstep; const char* b2 = last ? nB : cB + (size_t)(t + 2) * kstep;
            const char* a3 = a2 + kstep; const char* b3 = b2 + kstep;
            if (last && has_next) S.a_ready(nxt);
            if constexpr (SP2) {
            PG8_LDB(B0, 0, 0); PG8_LDB(B1, 0, 1); PG8_SCHED; PG8_LDA(At, 0, 0); PG8_STAGE(PG8_SA(1, 1), a1 + hstep, voffA);
            PG8_WAIT_V(8); PG8_WAIT_L(0); PG8_BAR; PG8_MMA(0, 0, At, B0); PG8_MMA(0, 1, At, B1); PG8_BAR; PG8_SCHED;
            PG8_LDA(At, 0, 1); PG8_STAGE(PG8_SB(0, 0), b2, voffB); PG8_STAGE(PG8_SB(0, 1), b2 + hstep, voffB); PG8_STAGE(PG8_SA(0, 0), a2, voffA);
            PG8_WAIT_V(8); PG8_WAIT_L(0); PG8_BAR; PG8_MMA(1, 0, At, B0); PG8_MMA(1, 1, At, B1); PG8_BAR; PG8_SCHED;
            PG8_LDB(B0, 1, 0); PG8_LDB(B1, 1, 1); PG8_SCHED; PG8_LDA(At, 1, 0); PG8_STAGE(PG8_SA(0, 1), a2 + hstep, voffA);
            PG8_WAIT_V(8); PG8_WAIT_L(0); PG8_BAR; PG8_MMA(0, 0, At, B0); PG8_MMA(0, 1, At, B1); PG8_BAR; PG8_SCHED;
            PG8_LDA(At, 1, 1); PG8_STAGE(PG8_SB(1, 0), b3, voffB); PG8_STAGE(PG8_SB(1, 1), b3 + hstep, voffB); PG8_STAGE(PG8_SA(1, 0), a3, voffA);
            PG8_WAIT_V(8); PG8_WAIT_L(0); PG8_BAR; PG8_MMA(1, 0, At, B0); PG8_MMA(1, 1, At, B1); PG8_BAR; PG8_SCHED;
            } else {
            PG8_LDB(B0, 0, 0); PG8_SCHED; PG8_LDA(At, 0, 0); PG8_STAGE(PG8_SA(1, 1), a1 + hstep, voffA);
            PG8_WAIT_L(8); PG8_BAR; PG8_WAIT_L(0); PG8_MMA(0, 0, At, B0); PG8_BAR; PG8_SCHED;
            PG8_LDB(B1, 0, 1); PG8_STAGE(PG8_SB(0, 0), b2, voffB);
            PG8_BAR; PG8_WAIT_L(0); PG8_MMA(0, 1, At, B1); PG8_BAR;
            PG8_LDA(At, 0, 1); PG8_STAGE(PG8_SA(0, 0), a2, voffA);
            PG8_BAR; PG8_WAIT_L(0); PG8_MMA(1, 0, At, B0); PG8_BAR; PG8_SCHED;
            PG8_STAGE(PG8_SB(0, 1), b2 + hstep, voffB);
            PG8_WAIT_V(6); PG8_BAR; PG8_MMA(1, 1, At, B1); PG8_BAR;
            PG8_LDB(B0, 1, 0); PG8_SCHED; PG8_LDA(At, 1, 0); PG8_STAGE(PG8_SA(0, 1), a2 + hstep, voffA);
            PG8_WAIT_L(8); PG8_BAR; PG8_WAIT_L(0); PG8_MMA(0, 0, At, B0); PG8_BAR; PG8_SCHED;
            PG8_LDB(B1, 1, 1); PG8_STAGE(PG8_SB(1, 0), b3, voffB);
            PG8_BAR; PG8_WAIT_L(0); PG8_MMA(0, 1, At, B1); PG8_BAR;
            PG8_LDA(At, 1, 1); PG8_STAGE(PG8_SA(1, 0), a3, voffA);
            PG8_BAR; PG8_WAIT_L(0); PG8_MMA(1, 0, At, B0); PG8_BAR; PG8_SCHED;
            PG8_STAGE(PG8_SB(1, 1), b3 + hstep, voffB);
            PG8_WAIT_V(6); PG8_BAR; PG8_MMA(1, 1, At, B1); PG8_BAR;
            }
        }
        if constexpr (ALIGN_EPI) { if (wr == 0) PG8_BAR; }
        E(acc, cur, wr, wc, fr, fq); S.done(cur);
        if (!has_next) break;
#pragma unroll
        for (int a = 0; a < 2; ++a)
#pragma unroll
            for (int b = 0; b < 2; ++b)
#pragma unroll
                for (int m = 0; m < 4; ++m)
#pragma unroll
                    for (int n = 0; n < 2; ++n) acc[a][b][m][n] = (f32x4){0.f, 0.f, 0.f, 0.f};
        cur = nxt; cA = nA; cB = nB; ++ui;
        if constexpr (ALIGN_EPI) { if (wr == 1) PG8_BAR; }
    }
    PG8_WAIT_V(0);
    if constexpr (!ALIGN_EPI) { if (wr == 0) PG8_BAR; }
    PG8_BAR;
#undef PG8_SA
#undef PG8_SB
#undef PG8_STAGE
#undef PG8_LDA
#undef PG8_LDB
#undef PG8_MMA
#undef PG8_WAIT_V
#undef PG8_WAIT_L
#undef PG8_BAR
#undef PG8_SCHED
}
}

using pg8::bf16_t; using pg8::bf16x8; using pg8::f32x4;

constexpr int MT = 24576, DM = 1024, DFF = 2816, NCTX = 8192;
constexpr int UW = 3984;
constexpr int NCOND = 9, MODW = 9216;
constexpr size_t MiB = 1ull << 20;
constexpr size_t WS_A = 0, WS_U = 48 * MiB, WS_W1 = WS_U + 132 * MiB, WS_W1B = WS_W1 + (size_t)5632 * 1024 * 2,
                 WS_BT3 = 235 * MiB, WS_BT4 = 243 * MiB, WS_MOD = 245 * MiB, WS_GATES = 246 * MiB;
constexpr int OUT_C = 25165824, OUT_N = 29360128, OUT_MM = 29392896, OUT_S = 29393152;
constexpr int LDS_BYTES = 163840;
constexpr int NTHR = 512;

struct P {
    const float *xp, *xs, *c, *sC, *sn, *sm, *sS, *cctx, *ada_w, *ada_b, *n1, *w1in, *w1out, *nmix, *wmin, *wmout,
        *cw, *cb, *gb, *hg, *mu, *w0, *w2, *a0, *a2, *g2, *kk, *ka, *rk, *lng, *lnb, *n2, *w2in, *w2out, *nf;
    float* out; unsigned char* ws;
};

__device__ __forceinline__ unsigned short f2bf(float f) { unsigned u = __float_as_uint(f); u += 0x7FFFu + ((u >> 16) & 1u); return (unsigned short)(u >> 16); }
__device__ __forceinline__ float bf2f(unsigned short b) { return __uint_as_float(((unsigned)b) << 16); }
__device__ __forceinline__ unsigned pk2(float a, float b) { return (unsigned)f2bf(a) | ((unsigned)f2bf(b) << 16); }
__device__ __forceinline__ int cond_of(int row) { return row < NCTX ? 0 : 1 + ((row - NCTX) >> 11); }
__device__ __forceinline__ float siluf(float x) { return x * __builtin_amdgcn_rcpf(1.f + __expf(-x)); }
__device__ __forceinline__ float sigmf(float x) { return __builtin_amdgcn_rcpf(1.f + __expf(-x)); }
__device__ __forceinline__ const float* xrow(const P& p, int row) { return row < NCTX ? p.xp + (size_t)row * DM : p.xs + (size_t)(row - NCTX) * DM; }
__device__ __forceinline__ f32x4 mfma16(bf16x8 a, bf16x8 b, f32x4 c) { return __builtin_amdgcn_mfma_f32_16x16x32_bf16(a, b, c, 0, 0, 0); }
__device__ __forceinline__ void unpack8(uint4 v, float* f) {
    f[0] = __uint_as_float(v.x << 16); f[1] = __uint_as_float(v.x & 0xffff0000u); f[2] = __uint_as_float(v.y << 16); f[3] = __uint_as_float(v.y & 0xffff0000u);
    f[4] = __uint_as_float(v.z << 16); f[5] = __uint_as_float(v.z & 0xffff0000u); f[6] = __uint_as_float(v.w << 16); f[7] = __uint_as_float(v.w & 0xffff0000u);
}

__device__ __forceinline__ int colmap(int kind, int n) {
    if (kind == 0) return n;
    if (kind == 1) { const int t = n >> 8, bj = (n >> 7) & 1, c = n & 127; return bj * DFF + t * 128 + c; }
    if (n < 2048) return n; if (n < 3968) return n + 16; if (n < 3984) return n - 3968 + 2048; return -1;
}
__device__ void convert_tile(const float* __restrict__ src, bf16_t* __restrict__ dst, int K, int Nsrc, int kind, int k0, int n0, float* tile) {
    const int tid = opaque_tid();
    { const int n = tid & 63, kr = tid >> 6; const int sc = colmap(kind, n0 + n);
#pragma unroll
      for (int i = 0; i < 8; ++i) { const int k = kr + 8 * i; tile[k * 65 + n] = sc >= 0 ? src[(size_t)(k0 + k) * Nsrc + sc] : 0.f; } }
    __syncthreads();
    { const int nn = tid >> 3, kg = tid & 7; unsigned w[4];
#pragma unroll
      for (int j = 0; j < 4; ++j) w[j] = pk2(tile[(kg * 8 + 2 * j) * 65 + nn], tile[(kg * 8 + 2 * j + 1) * 65 + nn]);
      *(uint4*)(dst + (size_t)(n0 + nn) * K + k0 + kg * 8) = make_uint4(w[0], w[1], w[2], w[3]); }
    __syncthreads();
}
__device__ void convert_jobs(const P& p, int first, int njobs_sel, unsigned char* lds, int item0, int nitems_before) {}

__device__ void do_convert(const float* src, bf16_t* dst, int K, int Nsrc, int Ndst, int kind, int t, float* tile) {
    const int nkt = K / 64; const int kt = t % nkt, ntile = t / nkt; (void)Ndst;
    convert_tile(src, dst, K, Nsrc, kind, kt * 64, ntile * 64, tile);
}

__device__ void phase0(const P& p, unsigned char* lds) {
    float* tile = (float*)lds;
    const int tid = opaque_tid();
    const int n_ada = 36 * 8;
    const int t1 = 16 * 88, t2 = 44 * 16, t3 = 16 * 64, t4 = 16 * 16;
    const int total = n_ada + t1 + t2 + t3 + t4;
    for (int it = blockIdx.x; it < total; it += gridDim.x) {
        if (it < n_ada) {
            const int cgp = it % 36, kc = it / 36;
            float* sc = tile;
            __syncthreads();
            for (int i = tid; i < NCOND * 128; i += NTHR) { const int c = i >> 7, k = i & 127; const float v = c == 0 ? p.cctx[kc * 128 + k] : p.c[(c - 1) * DM + kc * 128 + k]; sc[i] = siluf(v); }
            __syncthreads();
            const int col = cgp * 256 + (tid & 255), kh = tid >> 8;
            float acc[NCOND];
#pragma unroll
            for (int c = 0; c < NCOND; ++c) acc[c] = 0.f;
            const float* w = p.ada_w + (size_t)(kc * 128 + kh * 64) * MODW + col;
#pragma unroll 4
            for (int k = 0; k < 64; ++k) { const float wv = w[(size_t)k * MODW];
#pragma unroll
                for (int c = 0; c < NCOND; ++c) acc[c] += sc[c * 128 + kh * 64 + k] * wv; }
            float* mod = (float*)(p.ws + WS_MOD);
            const float bias = (kc == 0 && kh == 0) ? p.ada_b[col] : 0.f;
#pragma unroll
            for (int c = 0; c < NCOND; ++c) atomicAdd(mod + c * MODW + col, acc[c] + bias);
            __syncthreads();
        } else {
            int t = it - n_ada;
            if (t < t1) do_convert(p.w1in, (bf16_t*)(p.ws + WS_W1), 1024, 5632, 5632, 1, t, tile);
            else if ((t -= t1) < t2) do_convert(p.w1out, (bf16_t*)(p.ws + WS_W1B), 2816, 1024, 1024, 0, t, tile);
            else if ((t -= t2) < t3) do_convert(p.wmin, (bf16_t*)(p.ws + WS_BT3), 1024, 3984, 4096, 2, t, tile);
            else { t -= t3; do_convert(p.wmout, (bf16_t*)(p.ws + WS_BT4), 1024, 1024, 1024, 0, t, tile); }
        }
    }
}

__device__ void phase_normmod(const P& p, int which) {
    const int lane = opaque_tid() & 63, wave = threadIdx.x >> 6;
    const float* gain = which == 0 ? p.n1 : (which == 1 ? p.nmix : p.n2);
    const float* mod = (const float*)(p.ws + WS_MOD);
    bf16_t* A = (bf16_t*)(p.ws + WS_A);
    for (int row = blockIdx.x * 8 + wave; row < MT; row += gridDim.x * 8) {
        const float* src = which == 0 ? xrow(p, row) : p.out + (size_t)row * DM;
        float4 v[4]; float ss = 0.f;
#pragma unroll
        for (int i = 0; i < 4; ++i) { v[i] = *(const float4*)(src + lane * 4 + 256 * i); ss += v[i].x * v[i].x + v[i].y * v[i].y + v[i].z * v[i].z + v[i].w * v[i].w; }
#pragma unroll
        for (int o = 32; o >= 1; o >>= 1) ss += __shfl_xor(ss, o);
        const float rstd = rsqrtf(ss * (1.f / 1024.f) + 1e-6f);
        const float* sh = mod + cond_of(row) * MODW + which * 3072; const float* sc = sh + 1024;
#pragma unroll
        for (int i = 0; i < 4; ++i) { const int col = lane * 4 + 256 * i;
            const float4 g = *(const float4*)(gain + col), s4 = *(const float4*)(sh + col), c4 = *(const float4*)(sc + col);
            const float o0 = v[i].x * rstd * g.x * (1.f + c4.x) + s4.x, o1 = v[i].y * rstd * g.y * (1.f + c4.y) + s4.y,
                        o2 = v[i].z * rstd * g.z * (1.f + c4.z) + s4.z, o3 = v[i].w * rstd * g.w * (1.f + c4.w) + s4.w;
            *(uint2*)(A + (size_t)row * DM + col) = make_uint2(pk2(o0, o1), pk2(o2, o3)); }
    }
}
__device__ void phase_finalnorm(const P& p) {
    const int lane = opaque_tid() & 63, wave = threadIdx.x >> 6;
    for (int row = blockIdx.x * 8 + wave; row < MT; row += gridDim.x * 8) {
        float* src = p.out + (size_t)row * DM;
        float4 v[4]; float ss = 0.f;
#pragma unroll
        for (int i = 0; i < 4; ++i) { v[i] = *(const float4*)(src + lane * 4 + 256 * i); ss += v[i].x * v[i].x + v[i].y * v[i].y + v[i].z * v[i].z + v[i].w * v[i].w; }
#pragma unroll
        for (int o = 32; o >= 1; o >>= 1) ss += __shfl_xor(ss, o);
        const float rstd = rsqrtf(ss * (1.f / 1024.f) + 1e-6f);
#pragma unroll
        for (int i = 0; i < 4; ++i) { const int col = lane * 4 + 256 * i; const float4 g = *(const float4*)(p.nf + col);
            *(float4*)(src + col) = make_float4(v[i].x * rstd * g.x, v[i].y * rstd * g.y, v[i].z * rstd * g.z, v[i].w * rstd * g.w); }
    }
}

struct EpiSwiglu {
    static constexpr bool PERM = true;
    bf16_t* O;
    __device__ __forceinline__ void operator()(const f32x4 (&acc)[2][2][4][2], const pg8::Unit& u, int wr, int wc, int fr, int fq) const {
        const int row0 = u.pm * 256 + wr * 64 + fr, col0 = u.pn * 128 + wc * 32 + 8 * fq;
#pragma unroll
        for (int ai = 0; ai < 2; ++ai)
#pragma unroll
            for (int m = 0; m < 4; ++m) { bf16_t* rowp = O + (size_t)(row0 + ai * 128 + m * 16) * DFF + col0;
                float r[8];
#pragma unroll
                for (int n = 0; n < 2; ++n)
#pragma unroll
                    for (int j = 0; j < 4; ++j) r[n * 4 + j] = siluf(acc[ai][0][m][n][j]) * acc[ai][1][m][n][j];
                pg8::u32x4 w; w.x = pg8::cvt_pk_bf16(r[0], r[1]); w.y = pg8::cvt_pk_bf16(r[2], r[3]); w.z = pg8::cvt_pk_bf16(r[4], r[5]); w.w = pg8::cvt_pk_bf16(r[6], r[7]);
                *(pg8::u32x4*)rowp = w; }
    }
};
struct EpiResid {
    static constexpr bool PERM = false;
    const float* xp; const float* xs; float* out; const float* ga; float coef; int inplace;
    __device__ __forceinline__ void operator()(const f32x4 (&acc)[2][2][4][2], const pg8::Unit& u, int wr, int wc, int fr, int fq) const {
        const int row0 = u.pm * 256 + wr * 64 + fr, col0 = u.pn * 256 + wc * 32 + 4 * fq;
        const float* gap = ga + cond_of(u.pm * 256) * MODW;
        f32x4 gv[2][2];
#pragma unroll
        for (int bj = 0; bj < 2; ++bj)
#pragma unroll
            for (int n = 0; n < 2; ++n) gv[bj][n] = *(const f32x4*)(gap + col0 + bj * 128 + n * 16) * coef;
#pragma unroll
        for (int ai = 0; ai < 2; ++ai)
#pragma unroll
            for (int m = 0; m < 4; ++m) { const int row = row0 + ai * 128 + m * 16;
                const float* base = inplace ? out + (size_t)row * DM : (row < NCTX ? xp + (size_t)row * DM : xs + (size_t)(row - NCTX) * DM);
                float* op = out + (size_t)row * DM;
#pragma unroll
                for (int bj = 0; bj < 2; ++bj)
#pragma unroll
                    for (int n = 0; n < 2; ++n) { const int c = col0 + bj * 128 + n * 16; const f32x4 b4 = *(const f32x4*)(base + c);
                        *(f32x4*)(op + c) = b4 + gv[bj][n] * acc[ai][bj][m][n]; } }
    }
};
struct EpiU {
    static constexpr bool PERM = true;
    bf16_t* U; float* gates;
    __device__ __forceinline__ void operator()(const f32x4 (&acc)[2][2][4][2], const pg8::Unit& u, int wr, int wc, int fr, int fq) const {
        const int row0 = u.pm * 256 + wr * 64 + fr;
#pragma unroll
        for (int bj = 0; bj < 2; ++bj) { const int col0 = u.pn * 256 + bj * 128 + wc * 32 + 8 * fq;
            if (col0 < UW) {
#pragma unroll
                for (int ai = 0; ai < 2; ++ai)
#pragma unroll
                    for (int m = 0; m < 4; ++m) { const int row = row0 + ai * 128 + m * 16; const f32x4 v0 = acc[ai][bj][m][0], v1 = acc[ai][bj][m][1];
                        pg8::u32x4 w; w.x = pg8::cvt_pk_bf16(v0[0], v0[1]); w.y = pg8::cvt_pk_bf16(v0[2], v0[3]); w.z = pg8::cvt_pk_bf16(v1[0], v1[1]); w.w = pg8::cvt_pk_bf16(v1[2], v1[3]);
                        *(pg8::u32x4*)(U + (size_t)row * UW + col0) = w;
                        if (col0 >= 3968) { float* gp = gates + (size_t)row * 16 + (col0 - 3968); *(f32x4*)gp = v0; *(f32x4*)(gp + 4) = v1; } } } }
    }
};

template <class Epi>
__device__ __forceinline__ void run_gemm(unsigned char* lds, const bf16_t* A, const bf16_t* Bt, int N, int K, const Epi& E) {
    pg8::Gemm g{A, Bt, MT, N, K}; pg8::StaticOrder S; S.init(MT, N, (int)gridDim.x, (int)blockIdx.x);
    pg8::gemm_phase<Epi, pg8::StaticOrder, true, true>((PG8_LAS unsigned char*)lds, g, S, E);
}

constexpr int ML_SK = 0, ML_KWT = 17408, ML_VT = ML_KWT + 18432, ML_CB = ML_VT + 20736, ML_F = ML_CB + 21760, ML_CW = ML_F + 2048, ML_END = ML_CW + 4096;
static_assert(ML_END <= LDS_BYTES, "mlstm lds");

__device__ __forceinline__ unsigned short ld_u16_agent(const bf16_t* p) { return __hip_atomic_load(p, __ATOMIC_RELAXED, __HIP_MEMORY_SCOPE_AGENT); }

__device__ __forceinline__ void conv3_row8(const bf16_t* up, bool hasp, bool hasn, const float* cwp, float* x) {
    float t[8];
    unpack8(*(const uint4*)up, t);
#pragma unroll
    for (int i = 0; i < 8; ++i) x[i] = cwp[768 + i] + cwp[256 + i] * t[i];
    if (hasp) { unpack8(*(const uint4*)(up - UW), t);
#pragma unroll
        for (int i = 0; i < 8; ++i) x[i] += cwp[i] * t[i]; }
    if (hasn) { unpack8(*(const uint4*)(up + UW), t);
#pragma unroll
        for (int i = 0; i < 8; ++i) x[i] += cwp[512 + i] * t[i]; }
}

__device__ __forceinline__ void mlstm_task(const P& p, unsigned char* lds, int bg, int h) {
    const int wv = __builtin_amdgcn_readfirstlane((int)threadIdx.x >> 6), rw = wv & 3, cw = wv >> 2;
    const bool ctx = bg < 32; const int T = ctx ? 256 : 2048, nc = T / 64; const int row0 = ctx ? bg * 256 : NCTX + (bg - 32) * 2048;
    bf16_t* sK = (bf16_t*)(lds + ML_SK); bf16_t* sKwT = (bf16_t*)(lds + ML_KWT); bf16_t* sVT = (bf16_t*)(lds + ML_VT); bf16_t* sCb = (bf16_t*)(lds + ML_CB); bf16_t* sS = sCb;
    float* sA = (float*)(lds + ML_F); float* sM = sA + 64; float* sBb = sM + 64; float* sDen = sBb + 64; float* sScal = sDen + 64; float* sRed = sScal + 16;
    float* sCW = (float*)(lds + ML_CW);
    const bf16_t* U = (const bf16_t*)(p.ws + WS_U); const float* GATES = (const float*)(p.ws + WS_GATES); bf16_t* HB = (bf16_t*)(p.ws + WS_A);
    const int ct_a = cw ? 3 : 0;
    const int ct_b = cw ? 7 : 5;
    const int n_a = cw ? 2 : 3;

    __syncthreads();
    { const int tid = threadIdx.x;
      for (int i = tid; i < 1024; i += NTHR) { const int a = i >> 8, cc = i & 255, gch = (cc >> 7) * 512 + h * 128 + (cc & 127); sCW[i] = a < 3 ? p.cw[a * 1024 + gch] : p.cb[gch]; }
      for (int i = tid; i < 16 * 72; i += NTHR) { const int r = 128 + i / 72; sVT[r * 72 + (i % 72)] = (r == 128) ? (bf16_t)0x3F80 : (bf16_t)0; } }

#pragma unroll 1
    for (int dir = 0; dir < 2; ++dir) {
        f32x4 Cacc[9]; float m_prev = 0.f;
        { int z0 = 0; asm volatile("" : "+v"(z0)); const int tid = (int)threadIdx.x + z0, fr = tid & 15, fq = (tid >> 4) & 3;
#pragma unroll
          for (int ct = 0; ct < 9; ++ct) Cacc[ct] = (f32x4){0.f, 0.f, 0.f, 0.f};
          if (!ctx) { const int sidx = ((bg - 32) * 2 + dir) * 4 + h; const float* C0 = p.sC + (size_t)sidx * 16384; const float* n0 = p.sn + (size_t)sidx * 128;
#pragma unroll
              for (int j = 0; j < 4; ++j) { const int d = 16 * wv + 4 * fq + j;
#pragma unroll
                  for (int ct = 0; ct < 8; ++ct) Cacc[ct][j] = C0[d * 128 + 16 * ct + fr];
                  Cacc[8][j] = fr == 0 ? n0[d] : 0.f; }
              m_prev = p.sm[sidx]; } }
        const float gbi = p.gb[dir * 4 + h], gbf = p.gb[8 + dir * 4 + h];
        const bool second = dir == 1;
#pragma unroll 1
        for (int s = 0; s < nc; ++s) {
            const int c = dir ? nc - 1 - s : s;
            int zz = 0; asm volatile("" : "+v"(zz));
            const int tid = (int)threadIdx.x + zz, lane = tid & 63, fr = tid & 15, fq = (tid >> 4) & 3;
            __syncthreads();
            if (wv == 0) {
                const int tl = dir ? 63 - lane : lane; const size_t row = (size_t)row0 + c * 64 + tl;
                const float ip = GATES[row * 16 + dir * 4 + h] + gbi, fp = GATES[row * 16 + 8 + dir * 4 + h] + gbf;
                const float lf = fminf(fp, 0.f) - log1pf(__expf(-fabsf(fp)));
                float bs = lf;
#pragma unroll
                for (int o = 1; o < 64; o <<= 1) { const float t = __shfl_up(bs, o); if (lane >= o) bs += t; }
                const float a = ip - bs; float pm = a;
#pragma unroll
                for (int o = 1; o < 64; o <<= 1) { const float t = __shfl_up(pm, o); if (lane >= o) pm = fmaxf(pm, t); }
                const float Mt = fmaxf(m_prev, pm);
                sA[lane] = a; sM[lane] = Mt; sBb[lane] = bs;
                if (lane == 63) { sScal[0] = Mt; sScal[1] = bs; }
            }
            __syncthreads();
            const float M63 = sScal[0], bL = sScal[1];
#pragma unroll 1
            for (int g = 0; g < 2; ++g) {
                const int idx = tid + 512 * g, sl = idx >> 4, d0 = (idx & 15) * 8;
                const int tl = dir ? 63 - sl : sl, tok = c * 64 + tl; const size_t row = (size_t)row0 + tok;
                const int ch = 512 + h * 128 + d0;
                const float wk = __expf(sA[sl] - M63);
                float kv[8];
                conv3_row8(U + row * UW + ch, tok > 0, tok < T - 1, sCW + 128 + d0, kv);
#pragma unroll
                for (int i = 0; i < 8; ++i) kv[i] = siluf(kv[i]) * 0.08838834764831845f;
                *(uint4*)(sK + sl * 136 + d0) = make_uint4(pk2(kv[0], kv[1]), pk2(kv[2], kv[3]), pk2(kv[4], kv[5]), pk2(kv[6], kv[7]));
#pragma unroll
                for (int i = 0; i < 8; ++i) sKwT[(d0 + i) * 72 + sl] = f2bf(kv[i] * wk);
                const uint4 vv = *(const uint4*)(U + row * UW + 1024 + h * 128 + d0);
                const unsigned vw[4] = {vv.x, vv.y, vv.z, vv.w};
#pragma unroll
                for (int i = 0; i < 8; ++i) sVT[(d0 + i) * 72 + sl] = (bf16_t)((vw[i >> 1] >> ((i & 1) * 16)) & 0xffffu);
            }
            bf16x8 qf[4];
            { const int t_ = 16 * rw + fr, tl = dir ? 63 - t_ : t_, tok = c * 64 + tl; const size_t row = (size_t)row0 + tok;
#pragma unroll
              for (int kk = 0; kk < 4; ++kk) { const int ch = h * 128 + 32 * kk + 8 * fq;
                  float qv[8];
                  conv3_row8(U + row * UW + ch, tok > 0, tok < T - 1, sCW + 32 * kk + 8 * fq, qv);
#pragma unroll
                  for (int i = 0; i < 8; ++i) qv[i] = siluf(qv[i]);
                  union { uint4 u; bf16x8 v; } cv; cv.u = make_uint4(pk2(qv[0], qv[1]), pk2(qv[2], qv[3]), pk2(qv[4], qv[5]), pk2(qv[6], qv[7])); qf[kk] = cv.v; } }
            f32x4 num[5];
#pragma unroll
            for (int k = 0; k < 5; ++k) num[k] = (f32x4){0.f, 0.f, 0.f, 0.f};
#pragma unroll
            for (int ci = 0; ci < 5; ++ci) { const f32x4 v = Cacc[ci]; *(uint2*)(sCb + (16 * ci + fr) * 136 + 16 * wv + 4 * fq) = make_uint2(pk2(v[0], v[1]), pk2(v[2], v[3])); }
            __syncthreads();
#pragma unroll
            for (int k = 0; k < 3; ++k) if (k < n_a) {
#pragma unroll
                for (int kk = 0; kk < 4; ++kk) { const bf16x8 b = *(const bf16x8*)(sCb + (16 * (ct_a + k) + fr) * 136 + 32 * kk + 8 * fq); num[k] = mfma16(qf[kk], b, num[k]); } }
            __syncthreads();
#pragma unroll
            for (int ci = 0; ci < 4; ++ci) { const f32x4 v = Cacc[5 + ci]; *(uint2*)(sCb + (16 * ci + fr) * 136 + 16 * wv + 4 * fq) = make_uint2(pk2(v[0], v[1]), pk2(v[2], v[3])); }
            __syncthreads();
#pragma unroll
            for (int k = 3; k < 5; ++k) {
#pragma unroll
                for (int kk = 0; kk < 4; ++kk) { const bf16x8 b = *(const bf16x8*)(sCb + (16 * (ct_b + k - 3 - 5) + fr) * 136 + 32 * kk + 8 * fq); num[k] = mfma16(qf[kk], b, num[k]); } }
            {
                float scv[4];
#pragma unroll
                for (int j = 0; j < 4; ++j) scv[j] = __expf(m_prev - sM[16 * rw + 4 * fq + j]);
#pragma unroll
                for (int k = 0; k < 5; ++k)
#pragma unroll
                    for (int j = 0; j < 4; ++j) num[k][j] *= scv[j];
            }
            __syncthreads();
#pragma unroll
            for (int si = 0; si < 2; ++si) { const int st = 2 * cw + si;
                f32x4 sacc = (f32x4){0.f, 0.f, 0.f, 0.f};
                if (st <= rw) {
#pragma unroll
                    for (int kk = 0; kk < 4; ++kk) { const bf16x8 b = *(const bf16x8*)(sK + (16 * st + fr) * 136 + 32 * kk + 8 * fq); sacc = mfma16(qf[kk], b, sacc); } }
                const int sp = 16 * st + fr; const float as = sA[sp];
#pragma unroll
                for (int j = 0; j < 4; ++j) { const int tp = 16 * rw + 4 * fq + j; const float val = (sp <= tp) ? sacc[j] * __expf(as - sM[tp]) : 0.f; sS[tp * 72 + sp] = f2bf(val); }
            }
            __syncthreads();
#pragma unroll
            for (int ks = 0; ks < 2; ++ks) { const bf16x8 a = *(const bf16x8*)(sS + (16 * rw + fr) * 72 + 32 * ks + 8 * fq);
#pragma unroll
                for (int k = 0; k < 5; ++k) { const int ct = k < 3 ? ct_a + k : ct_b + k - 3;
                    if (k != 2 || cw == 0) { const bf16x8 b = *(const bf16x8*)(sVT + (16 * ct + fr) * 72 + 32 * ks + 8 * fq); num[k] = mfma16(a, b, num[k]); } } }
            if (cw == 1 && fr == 0) {
#pragma unroll
                for (int j = 0; j < 4; ++j) sDen[16 * rw + 4 * fq + j] = num[4][j]; }
            __syncthreads();
            float inv[4];
#pragma unroll
            for (int j = 0; j < 4; ++j) { const int tp = 16 * rw + 4 * fq + j; const float den = sDen[tp]; inv[j] = 1.f / fmaxf(fabsf(den), __expf(-(sBb[tp] + sM[tp]))); }
            if (!second) {
#pragma unroll
                for (int j = 0; j < 4; ++j) { const int tp = 16 * rw + 4 * fq + j, tl = dir ? 63 - tp : tp; const size_t row = (size_t)row0 + c * 64 + tl;
                    bf16_t* hb = HB + row * DM + h * 128;
#pragma unroll
                    for (int k = 0; k < 5; ++k) { const int ct = k < 3 ? ct_a + k : ct_b + k - 3; if ((k != 2 || cw == 0) && ct < 8) hb[16 * ct + fr] = f2bf(num[k][j] * inv[j]); } }
            } else {
                float ssr[4];
#pragma unroll
                for (int j = 0; j < 4; ++j) { const int tp = 16 * rw + 4 * fq + j, tl = dir ? 63 - tp : tp; const size_t row = (size_t)row0 + c * 64 + tl;
                    const bf16_t* hb = HB + row * DM + h * 128; float ss = 0.f;
#pragma unroll
                    for (int k = 0; k < 5; ++k) { const int ct = k < 3 ? ct_a + k : ct_b + k - 3;
                        if ((k != 2 || cw == 0) && ct < 8) { const int e = 16 * ct + fr; const float other = bf2f(ld_u16_agent(hb + e)); const float hs = num[k][j] * inv[j] + other;
                            const float o = sigmf(bf2f(U[row * UW + 1536 + h * 128 + e])); const float v = o * hs; ss += v * v; num[k][j] = v; } }
                    ss += __shfl_xor(ss, 1); ss += __shfl_xor(ss, 2); ss += __shfl_xor(ss, 4); ss += __shfl_xor(ss, 8);
                    ssr[j] = ss; if (fr == 0) sRed[cw * 64 + tp] = ss; }
                __syncthreads();
#pragma unroll
                for (int j = 0; j < 4; ++j) { const int tp = 16 * rw + 4 * fq + j, tl = dir ? 63 - tp : tp; const size_t row = (size_t)row0 + c * 64 + tl;
                    bf16_t* hb = HB + row * DM + h * 128; const float rms = rsqrtf((ssr[j] + sRed[(1 - cw) * 64 + tp]) * (1.f / 128.f) + 1e-6f);
#pragma unroll
                    for (int k = 0; k < 5; ++k) { const int ct = k < 3 ? ct_a + k : ct_b + k - 3;
                        if ((k != 2 || cw == 0) && ct < 8) { const int e = 16 * ct + fr; hb[e] = f2bf(num[k][j] * rms * p.hg[h * 128 + e]); } } }
            }
            const float decay = __expf(m_prev - M63);
#pragma unroll
            for (int ct = 0; ct < 9; ++ct) Cacc[ct] = Cacc[ct] * decay;
#pragma unroll
            for (int ks = 0; ks < 2; ++ks) { const bf16x8 a = *(const bf16x8*)(sKwT + (16 * wv + fr) * 72 + 32 * ks + 8 * fq);
#pragma unroll
                for (int ct = 0; ct < 9; ++ct) { const bf16x8 b = *(const bf16x8*)(sVT + (16 * ct + fr) * 72 + 32 * ks + 8 * fq); Cacc[ct] = mfma16(a, b, Cacc[ct]); } }
            m_prev = bL + M63;
        }
        if (ctx) { const int sidx = (bg * 2 + dir) * 4 + h; float* Co = p.out + OUT_C + (size_t)sidx * 16384;
            int z1 = 0; asm volatile("" : "+v"(z1)); const int tid1 = (int)threadIdx.x + z1, fr1 = tid1 & 15, fq1 = (tid1 >> 4) & 3;
#pragma unroll
            for (int j = 0; j < 4; ++j) { const int d = 16 * wv + 4 * fq1 + j;
#pragma unroll
                for (int ct = 0; ct < 8; ++ct) Co[d * 128 + 16 * ct + fr1] = Cacc[ct][j];
                if (fr1 == 0) p.out[OUT_N + sidx * 128 + d] = Cacc[8][j]; }
            if (tid1 == 0) p.out[OUT_MM + sidx] = m_prev; }
        __syncthreads();
    }
}

constexpr int RW_TC = 16;
constexpr int RW_DIR_FLOATS = 16 * 6 * 64 + 16 * 64 * 3 + 16 * 128 + 16 * 64 * 5;
constexpr int RW_DIR = RW_DIR_FLOATS * 4;
static_assert(2 * RW_DIR <= LDS_BYTES, "rwkv lds");

__device__ __forceinline__ float shifted_u(const bf16_t* U, const float* mu, size_t row0, int tok, int T, bool grid, int col) {
    const int rc = col - 2048; const bf16_t* b = U + (row0 + tok) * UW + col;
    const float x = bf2f(b[0]);
    const bool hl = grid ? (tok & 63) != 0 : tok > 0, hr = grid ? (tok & 63) != 63 : tok < T - 1;
    const float Lv = hl ? bf2f(*(b - UW)) : 0.f, Rv = hr ? bf2f(*(b + UW)) : 0.f;
    float o = x + mu[rc] * (Lv - x) + mu[1920 + rc] * (Rv - x);
    if (grid) { const float Uv = tok >= 64 ? bf2f(*(b - 64 * (long)UW)) : 0.f, Dv = tok < T - 64 ? bf2f(*(b + 64 * (long)UW)) : 0.f;
        o += mu[3840 + rc] * (Uv - x) + mu[5760 + rc] * (Dv - x); }
    return o;
}

__device__ __forceinline__ void rwkv_task(const P& p, unsigned char* lds, int bg, int h) {
    int z0 = 0; asm volatile("" : "+v"(z0));
    const int dir = __builtin_amdgcn_readfirstlane((int)threadIdx.x >> 8); const int tid = (int)threadIdx.x + z0, ltid = tid & 255;
    const bool ctx = bg < 32; const int T = ctx ? 256 : 2048, nc = T / RW_TC; const size_t row0 = ctx ? (size_t)bg * 256 : (size_t)NCTX + (size_t)(bg - 32) * 2048;
    const bool grid = !ctx;
    float* L = (float*)lds + dir * RW_DIR_FLOATS;
    float* sVec = L; float* sXw = sVec + 16 * 6 * 64; float* sXa = sXw + 1024; float* sXo = sXa + 1024; float* sXg = sXo + 1024; float* sKr = sXg + 2048; float* sY = sKr + 1024; float* sAown = sY + 1024;
    const bf16_t* U = (const bf16_t*)(p.ws + WS_U); bf16_t* HB = (bf16_t*)(p.ws + WS_A);
    const int ri = ltid >> 2, jq = ltid & 3;
    float st[16];
    if (ctx) {
#pragma unroll
        for (int j = 0; j < 16; ++j) st[j] = 0.f;
    } else { const float* S0 = p.sS + ((size_t)(((bg - 32) * 2 + dir) * 8 + h)) * 4096 + ri * 64 + jq * 16;
#pragma unroll
        for (int j = 0; j < 16; ++j) st[j] = S0[j]; }
    const int hc = h * 64;
    const int tlm = ltid >> 4, j0 = (ltid & 15) * 4;
    for (int s = 0; s < nc; ++s) {
        const int c = dir ? nc - 1 - s : s; const int tok0 = c * RW_TC;
        const bool second = s >= (nc >> 1);
        __syncthreads();
#pragma unroll 1
        for (int it = 0; it < 32; ++it) { const int idx = ltid + 256 * it, tl = idx >> 9, ci = idx & 511; const int tok = tok0 + tl;
            if (ci < 64) sVec[tl * 384 + 0 * 64 + ci] = shifted_u(U, p.mu, row0, tok, T, grid, 2048 + hc + ci);
            else if (ci < 128) sKr[tl * 64 + ci - 64] = shifted_u(U, p.mu, row0, tok, T, grid, 2048 + 512 + hc + ci - 64);
            else if (ci < 192) sVec[tl * 384 + 3 * 64 + ci - 128] = shifted_u(U, p.mu, row0, tok, T, grid, 2048 + 1024 + hc + ci - 128);
            else if (ci < 256) sXw[tl * 64 + ci - 192] = tanhf(shifted_u(U, p.mu, row0, tok, T, grid, 2048 + 1536 + dir * 64 + ci - 192));
            else if (ci < 320) sXa[tl * 64 + ci - 256] = shifted_u(U, p.mu, row0, tok, T, grid, 2048 + 1664 + dir * 64 + ci - 256);
            else if (ci < 384) { if (second) sXo[tl * 64 + ci - 320] = shifted_u(U, p.mu, row0, tok, T, grid, 2048 + 1664 + (1 - dir) * 64 + ci - 320); }
            else { if (second) sXg[tl * 128 + ci - 384] = sigmf(shifted_u(U, p.mu, row0, tok, T, grid, 2048 + 1792 + ci - 384)); } }
        __syncthreads();
        {
            float wp[4], ap[4];
#pragma unroll
            for (int q = 0; q < 4; ++q) { wp[q] = p.w0[dir * 512 + hc + j0 + q]; ap[q] = p.a0[dir * 512 + hc + j0 + q]; }
            const float* w2p = p.w2 + (size_t)(dir * 64) * 512 + hc + j0; const float* a2p = p.a2 + (size_t)(dir * 64) * 512 + hc + j0;
#pragma unroll 4
            for (int l = 0; l < 64; ++l) { const float xw = sXw[tlm * 64 + l], xa = sXa[tlm * 64 + l]; const float4 w4 = *(const float4*)(w2p + l * 512), a4 = *(const float4*)(a2p + l * 512);
                wp[0] += xw * w4.x; wp[1] += xw * w4.y; wp[2] += xw * w4.z; wp[3] += xw * w4.w; ap[0] += xa * a4.x; ap[1] += xa * a4.y; ap[2] += xa * a4.z; ap[3] += xa * a4.w; }
            float kr[4], kkv[4]; float ssq = 0.f;
#pragma unroll
            for (int q = 0; q < 4; ++q) { kr[q] = sKr[tlm * 64 + j0 + q]; kkv[q] = kr[q] * p.kk[hc + j0 + q]; ssq += kkv[q] * kkv[q]; }
            ssq += __shfl_xor(ssq, 1); ssq += __shfl_xor(ssq, 2); ssq += __shfl_xor(ssq, 4); ssq += __shfl_xor(ssq, 8);
            const float rn = 1.f / fmaxf(sqrtf(ssq), 1e-12f);
#pragma unroll
            for (int q = 0; q < 4; ++q) { const float z = -wp[q]; const float sp = fmaxf(z, 0.f) + log1pf(__expf(-fabsf(z))); const float w = -sp - 0.5f; const float dec = __expf(-__expf(w));
                const float a = sigmf(ap[q]); const float kn = kkv[q] * rn; const float kd = kr[q] * (1.f + (a - 1.f) * p.ka[hc + j0 + q]);
                float* V = sVec + tlm * 384 + j0 + q; V[64] = dec; V[128] = kd; V[256] = kn; V[320] = kn * a; sAown[tlm * 64 + j0 + q] = a; }
        }
        __syncthreads();
#pragma unroll 1
        for (int step = 0; step < RW_TC; ++step) { const int tl = dir ? RW_TC - 1 - step : step; const float* V = sVec + tl * 384 + jq * 16;
            float sa = 0.f;
#pragma unroll
            for (int q4 = 0; q4 < 4; ++q4) { const float4 k4 = *(const float4*)(V + 256 + q4 * 4); sa += st[q4 * 4] * k4.x + st[q4 * 4 + 1] * k4.y + st[q4 * 4 + 2] * k4.z + st[q4 * 4 + 3] * k4.w; }
            sa += __shfl_xor(sa, 1); sa += __shfl_xor(sa, 2); sa = -sa;
            const float vi = sVec[tl * 384 + 192 + ri];
            float y = 0.f;
#pragma unroll
            for (int q4 = 0; q4 < 4; ++q4) { const float4 w4 = *(const float4*)(V + 64 + q4 * 4), b4 = *(const float4*)(V + 320 + q4 * 4), k4 = *(const float4*)(V + 128 + q4 * 4), r4 = *(const float4*)(V + q4 * 4);
                st[q4 * 4 + 0] = st[q4 * 4 + 0] * w4.x + sa * b4.x + vi * k4.x; st[q4 * 4 + 1] = st[q4 * 4 + 1] * w4.y + sa * b4.y + vi * k4.y;
                st[q4 * 4 + 2] = st[q4 * 4 + 2] * w4.z + sa * b4.z + vi * k4.z; st[q4 * 4 + 3] = st[q4 * 4 + 3] * w4.w + sa * b4.w + vi * k4.w;
                y += st[q4 * 4] * r4.x + st[q4 * 4 + 1] * r4.y + st[q4 * 4 + 2] * r4.z + st[q4 * 4 + 3] * r4.w; }
            y += __shfl_xor(y, 1); y += __shfl_xor(y, 2);
            if (jq == 0) sY[tl * 64 + ri] = y; }
        __syncthreads();
        { const size_t row = row0 + tok0 + tlm; bf16_t* hb = HB + row * DM + 512 + hc + j0;
          float y4[4];
#pragma unroll
          for (int q = 0; q < 4; ++q) y4[q] = sY[tlm * 64 + j0 + q];
          if (!second) { *(uint2*)hb = make_uint2(pk2(y4[0], y4[1]), pk2(y4[2], y4[3])); }
          else {
              const unsigned long long ov = __hip_atomic_load((const unsigned long long*)hb, __ATOMIC_RELAXED, __HIP_MEMORY_SCOPE_AGENT);
              y4[0] += __uint_as_float(((unsigned)ov) << 16); y4[1] += __uint_as_float(((unsigned)ov) & 0xffff0000u);
              y4[2] += __uint_as_float(((unsigned)(ov >> 32)) << 16); y4[3] += __uint_as_float(((unsigned)(ov >> 32)) & 0xffff0000u);
              float sm = y4[0] + y4[1] + y4[2] + y4[3];
              sm += __shfl_xor(sm, 1); sm += __shfl_xor(sm, 2); sm += __shfl_xor(sm, 4); sm += __shfl_xor(sm, 8);
              const float mean = sm * (1.f / 64.f); float vs = 0.f;
#pragma unroll
              for (int q = 0; q < 4; ++q) { const float d = y4[q] - mean; vs += d * d; }
              vs += __shfl_xor(vs, 1); vs += __shfl_xor(vs, 2); vs += __shfl_xor(vs, 4); vs += __shfl_xor(vs, 8);
              const float rstd = rsqrtf(vs * (1.f / 64.f) + 64e-5f);
              float ao[4], gg[4];
#pragma unroll
              for (int q = 0; q < 4; ++q) { ao[q] = p.a0[(1 - dir) * 512 + hc + j0 + q]; gg[q] = 0.f; }
              const float* a2o = p.a2 + (size_t)((1 - dir) * 64) * 512 + hc + j0; const float* g2p = p.g2 + hc + j0;
#pragma unroll 4
              for (int l = 0; l < 64; ++l) { const float xo = sXo[tlm * 64 + l]; const float4 a4 = *(const float4*)(a2o + l * 512);
                  ao[0] += xo * a4.x; ao[1] += xo * a4.y; ao[2] += xo * a4.z; ao[3] += xo * a4.w; }
#pragma unroll 4
              for (int l = 0; l < 128; ++l) { const float xg = sXg[tlm * 128 + l]; const float4 g4 = *(const float4*)(g2p + l * 512);
                  gg[0] += xg * g4.x; gg[1] += xg * g4.y; gg[2] += xg * g4.z; gg[3] += xg * g4.w; }
              float bs = 0.f;
#pragma unroll
              for (int q = 0; q < 4; ++q) { const int j = j0 + q; const float am = 0.5f * (sigmf(ao[q]) + sAown[tlm * 64 + j]);
                  const float kbar = sKr[tlm * 64 + j] * (1.f + (am - 1.f) * p.ka[hc + j]); bs += sVec[tlm * 384 + j] * kbar * p.rk[hc + j]; }
              bs += __shfl_xor(bs, 1); bs += __shfl_xor(bs, 2); bs += __shfl_xor(bs, 4); bs += __shfl_xor(bs, 8);
              float o4[4];
#pragma unroll
              for (int q = 0; q < 4; ++q) { const int j = j0 + q; const float yn = (y4[q] - mean) * rstd * p.lng[hc + j] + p.lnb[hc + j]; o4[q] = (yn + bs * sVec[tlm * 384 + 192 + j]) * gg[q]; }
              *(uint2*)hb = make_uint2(pk2(o4[0], o4[1]), pk2(o4[2], o4[3]));
          } }
    }
    if (ctx) { float* So = p.out + OUT_S + ((size_t)((bg * 2 + dir) * 8 + h)) * 4096 + ri * 64 + jq * 16;
#pragma unroll
        for (int j = 0; j < 16; ++j) So[j] = st[j]; }
    __syncthreads();
}

__device__ __forceinline__ void scan_decode_task(int t, int& kind, int& bg, int& h) {
    if (t < 32) { kind = 0; bg = 32 + t / 4; h = t % 4; }
    else if (t < 96) { kind = 1; bg = 32 + (t - 32) / 8; h = (t - 32) % 8; }
    else if (t < 352) { kind = 1; bg = (t - 96) / 8; h = (t - 96) % 8; }
    else { kind = 0; bg = (t - 352) / 4; h = (t - 352) % 4; }
}
__device__ __forceinline__ void phase_scan(const P& p, unsigned char* lds) {
    const int nb = gridDim.x, bid = blockIdx.x;
    int t, step;
    if (nb >= 128) { if (bid < 96) { t = bid; step = 1000; } else { t = bid; step = nb - 96; } }
    else { t = bid; step = nb; }
#pragma unroll 1
    for (; t < 480; t += step) {
        int kind, bg, h; scan_decode_task(t, kind, bg, h);
        if (kind == 0) mlstm_task(p, lds, bg, h); else rwkv_task(p, lds, bg, h);
    }
}

__device__ void phase_convert_w2(const P& p, unsigned char* lds) {
    float* tile = (float*)lds;
    const int t1 = 16 * 88, t2 = 44 * 16;
    for (int it = blockIdx.x; it < t1 + t2; it += gridDim.x) {
        if (it < t1) do_convert(p.w2in, (bf16_t*)(p.ws + WS_W1), 1024, 5632, 5632, 1, it, tile);
        else do_convert(p.w2out, (bf16_t*)(p.ws + WS_W1B), 2816, 1024, 1024, 0, it - t1, tile);
    }
}

constexpr int NPHASE = 12;
template <int PH>
__device__ __forceinline__ void run_phase(const P& p, unsigned char* lds) {
    const float* mod = (const float*)(p.ws + WS_MOD);
    if constexpr (PH == 0) phase0(p, lds);
    if constexpr (PH == 1) phase_normmod(p, 0);
    if constexpr (PH == 2) { EpiSwiglu E{(bf16_t*)(p.ws + WS_U)}; run_gemm(lds, (const bf16_t*)(p.ws + WS_A), (const bf16_t*)(p.ws + WS_W1), 5632, 1024, E); }
    if constexpr (PH == 3) { EpiResid E{p.xp, p.xs, p.out, mod + 2048, 0.5f, 0}; run_gemm(lds, (const bf16_t*)(p.ws + WS_U), (const bf16_t*)(p.ws + WS_W1B), 1024, 2816, E); }
    if constexpr (PH == 4) phase_normmod(p, 1);
    if constexpr (PH == 5) { EpiU E{(bf16_t*)(p.ws + WS_U), (float*)(p.ws + WS_GATES)}; run_gemm(lds, (const bf16_t*)(p.ws + WS_A), (const bf16_t*)(p.ws + WS_BT3), 4096, 1024, E); }
    if constexpr (PH == 6) phase_scan(p, lds);
    if constexpr (PH == 7) { EpiResid E{p.xp, p.xs, p.out, mod + 5120, 1.0f, 1}; run_gemm(lds, (const bf16_t*)(p.ws + WS_A), (const bf16_t*)(p.ws + WS_BT4), 1024, 1024, E); }
    if constexpr (PH == 8) { phase_normmod(p, 2); phase_convert_w2(p, lds); }
    if constexpr (PH == 9) { EpiSwiglu E{(bf16_t*)(p.ws + WS_U)}; run_gemm(lds, (const bf16_t*)(p.ws + WS_A), (const bf16_t*)(p.ws + WS_W1), 5632, 1024, E); }
    if constexpr (PH == 10) { EpiResid E{p.xp, p.xs, p.out, mod + 8192, 0.5f, 1}; run_gemm(lds, (const bf16_t*)(p.ws + WS_U), (const bf16_t*)(p.ws + WS_W1B), 1024, 2816, E); }
    if constexpr (PH == 11) phase_finalnorm(p);
}

#if !ONE_LAUNCH
template <int PH>
__global__ void __launch_bounds__(NTHR, 2) k_phase(P p) {
    extern __shared__ __attribute__((aligned(16))) unsigned char lds[];
    run_phase<PH>(p, lds);
}
#endif

#if ONE_LAUNCH
__global__ void __launch_bounds__(NTHR, 2) k_mega(P p) {
    extern __shared__ __attribute__((aligned(16))) unsigned char lds[];
    cg::grid_group grid = cg::this_grid();
    run_phase<0>(p, lds); grid.sync();
    run_phase<1>(p, lds); grid.sync();
    run_phase<2>(p, lds); grid.sync();
    run_phase<3>(p, lds); grid.sync();
    run_phase<4>(p, lds); grid.sync();
    run_phase<5>(p, lds); grid.sync();
    run_phase<6>(p, lds); grid.sync();
    run_phase<7>(p, lds); grid.sync();
    run_phase<8>(p, lds); grid.sync();
    run_phase<9>(p, lds); grid.sync();
    run_phase<10>(p, lds); grid.sync();
    run_phase<11>(p, lds);
}
#endif

#if !ONE_LAUNCH
template <int PH> static void launch_phase(const P& p, int grid, hipStream_t stream) {
    static bool attr = false;
    if (!attr) { (void)hipFuncSetAttribute((const void*)k_phase<PH>, hipFuncAttributeMaxDynamicSharedMemorySize, LDS_BYTES); attr = true; }
    hipLaunchKernelGGL(k_phase<PH>, dim3(grid), dim3(NTHR), LDS_BYTES, stream, p);
}
#endif

extern "C" void kernel_launch(void* const* d_in, const int* in_sizes, int n_in, void* d_out, int out_size, void* d_ws, size_t ws_size, hipStream_t stream) {
    (void)in_sizes; (void)n_in; (void)out_size; (void)ws_size;
    static int grid = 0;
    if (grid == 0) {
        int dev = 0, cus = 0;
        if (hipGetDevice(&dev) != hipSuccess || hipDeviceGetAttribute(&cus, hipDeviceAttributeMultiprocessorCount, dev) != hipSuccess || cus <= 0) cus = 256;
#if ONE_LAUNCH
        (void)hipFuncSetAttribute((const void*)k_mega, hipFuncAttributeMaxDynamicSharedMemorySize, LDS_BYTES);
        int per_cu = 0;
        if (hipOccupancyMaxActiveBlocksPerMultiprocessor(&per_cu, (const void*)k_mega, NTHR, LDS_BYTES) != hipSuccess || per_cu < 1) per_cu = 1;
        (void)hipGetLastError();
#endif
        grid = cus;
    }
    P p{};
    const float** f = (const float**)&p;
    for (int i = 0; i < 35; ++i) f[i] = (const float*)d_in[i];
    p.out = (float*)d_out; p.ws = (unsigned char*)d_ws;
    (void)hipMemsetAsync((char*)d_ws + WS_MOD, 0, NCOND * MODW * sizeof(float), stream);
#if ONE_LAUNCH
    void* args[] = {&p};
    hipError_t e = hipLaunchCooperativeKernel((const void*)k_mega, dim3(grid), dim3(NTHR), args, LDS_BYTES, stream);
    if (e != hipSuccess) fprintf(stderr, "cooperative launch failed: %s (grid %d)\n", hipGetErrorString(e), grid);
#else
    launch_phase<0>(p, grid, stream); launch_phase<1>(p, grid, stream); launch_phase<2>(p, grid, stream); launch_phase<3>(p, grid, stream);
    launch_phase<4>(p, grid, stream); launch_phase<5>(p, grid, stream); launch_phase<6>(p, grid, stream); launch_phase<7>(p, grid, stream);
    launch_phase<8>(p, grid, stream); launch_phase<9>(p, grid, stream); launch_phase<10>(p, grid, stream); launch_phase<11>(p, grid, stream);
#endif
}
```

```cpp
#include <hip/hip_runtime.h>
#include <hip/hip_cooperative_groups.h>
#include <cstdio>
#include <cstdint>
namespace cg = cooperative_groups;

#ifndef PROBE_DUP
#define PROBE_DUP -1
#endif
#ifndef ONE_LAUNCH
#define ONE_LAUNCH 1
#endif

__device__ __forceinline__ int opaque_tid() { int z = 0; asm volatile("" : "+v"(z)); return (int)threadIdx.x + z; }

namespace pg8 {
#define PG8_LAS __attribute__((address_space(3)))
typedef unsigned short bf16_t;
typedef short bf16x8 __attribute__((ext_vector_type(8)));
typedef float f32x4 __attribute__((ext_vector_type(4)));
typedef unsigned u32x4 __attribute__((ext_vector_type(4)));
constexpr int BM = 256, BK = 64, HALF = 128, HTB = HALF * BK * 2, STAGE_BYTES = 8 * HTB, NXCD = 8, WGM = 8;

__host__ __device__ __forceinline__ int lds_byte(int r, int c) { const int st = (r >> 4) * 2 + (c >> 5), rr = r & 15, cc = c & 31, ob = rr * 64 + cc * 2; return st * 1024 + (ob ^ (((ob >> 9) & 1) << 5)); }
__host__ __device__ __forceinline__ void stage_rc(int b, int& R, int& C) { const int st = b / 1024, sb = b % 1024, swz = sb ^ (((sb >> 9) & 1) << 5); R = (st >> 1) * 16 + swz / 64; C = (st & 1) * 32 + (swz % 64) / 2; }
__host__ __device__ __forceinline__ int perm32(int rho) { const int n = rho >> 4, i = rho & 15; return 8 * (i >> 2) + 4 * n + (i & 3); }

struct Unit { int pm, pn; };
struct Gemm { const bf16_t* A; const bf16_t* Bt; int M, N, K; };

struct StaticOrder {
    int nM, nN, nwg, G, c;
    __host__ __device__ void init(int M, int N, int G_, int c_) { nM = M / BM; nN = N / BM; nwg = nM * nN; G = G_; c = c_; }
    __host__ __device__ bool next(int i, Unit& u) const {
        const long L = (long)i * G + c; if (L >= nwg) return false;
        int wgid = (int)L; { const int q = nwg / NXCD, r = nwg % NXCD, xcd = wgid % NXCD, off = wgid / NXCD; wgid = (xcd < r ? xcd * (q + 1) : r * (q + 1) + (xcd - r) * q) + off; }
        const int nig = WGM * nN, gid = wgid / nig, fm = gid * WGM, gsz = (nM - fm) < WGM ? (nM - fm) : WGM;
        u.pm = fm + ((wgid % nig) % gsz); u.pn = (wgid % nig) / gsz; return true;
    }
    __device__ __forceinline__ void a_ready(const Unit&) const {}
    __device__ __forceinline__ void done(const Unit&) const {}
};

__device__ __forceinline__ unsigned cvt_pk_bf16(float lo, float hi) { unsigned r; asm volatile("v_cvt_pk_bf16_f32 %0, %1, %2" : "=v"(r) : "v"(lo), "v"(hi)); return r; }

template <class Epi, class Sched, bool ALIGN_EPI = false, bool SP2 = false>
__device__ __forceinline__ void gemm_phase(PG8_LAS unsigned char* lds, const Gemm g, const Sched& S, const Epi& E) {
    const int tid = opaque_tid(), wid = __builtin_amdgcn_readfirstlane((int)threadIdx.x >> 6), lane = tid & 63, wr = wid >> 2, wc = wid & 3, fr = lane & 15, fq = lane >> 4;
    const int K = g.K, nt = K / BK;
    unsigned voffA[2], voffB[2];
#pragma unroll
    for (int i = 0; i < 2; ++i) { int R, C; stage_rc(tid * 16 + i * 8192, R, C); const int Rb = Epi::PERM ? ((R & ~31) + perm32(R & 31)) : R;
        voffA[i] = (unsigned)(R * K + C) * 2u; voffB[i] = (unsigned)(Rb * K + C) * 2u; }
    const size_t kstep = (size_t)(BK * 2);
    const size_t hstep = (size_t)HALF * K * 2;
    const size_t tstep = 2 * hstep;
    const unsigned ldsw = (unsigned)wid * 1024u;
    const int aoff = lds_byte(wr * 64 + fr, fq * 8), boff = lds_byte(wc * 32 + fr, fq * 8);
#define PG8_SA(b, h) (((b) * 2 + (h)) * HTB)
#define PG8_SB(b, h) ((4 + (b) * 2 + (h)) * HTB)
#define PG8_STAGE(bufoff, gbase, voff) do { _Pragma("unroll") for (int _i = 0; _i < 2; ++_i) \
        __builtin_amdgcn_global_load_lds((const unsigned*)((const char*)(gbase) + (voff)[_i]), (PG8_LAS unsigned*)(lds + (bufoff) + ldsw + _i * 8192), 16, 0, 0); } while (0)
#define PG8_LDA(dst, b, h) do { _Pragma("unroll") for (int m = 0; m < 4; ++m) _Pragma("unroll") for (int k = 0; k < 2; ++k) dst[m][k] = *(const PG8_LAS bf16x8*)(lds + PG8_SA(b, h) + aoff + m * 2048 + k * 1024); } while (0)
#define PG8_LDB(dst, b, h) do { _Pragma("unroll") for (int n = 0; n < 2; ++n) _Pragma("unroll") for (int k = 0; k < 2; ++k) dst[n][k] = *(const PG8_LAS bf16x8*)(lds + PG8_SB(b, h) + boff + n * 2048 + k * 1024); } while (0)
#define PG8_MMA(ai, bj, At, Bt) do { __builtin_amdgcn_s_setprio(1); _Pragma("unroll") for (int m = 0; m < 4; ++m) _Pragma("unroll") for (int n = 0; n < 2; ++n) _Pragma("unroll") for (int k = 0; k < 2; ++k) \
        acc[ai][bj][m][n] = __builtin_amdgcn_mfma_f32_16x16x32_bf16(Bt[n][k], At[m][k], acc[ai][bj][m][n], 0, 0, 0); __builtin_amdgcn_s_setprio(0); } while (0)
#define PG8_WAIT_V(n) asm volatile("s_waitcnt vmcnt(" #n ")" ::: "memory")
#define PG8_WAIT_L(n) asm volatile("s_waitcnt lgkmcnt(" #n ")" ::: "memory")
#define PG8_BAR __builtin_amdgcn_s_barrier()
#define PG8_SCHED __builtin_amdgcn_sched_barrier(0)
    Unit cur, nxt; int ui = 0;
    if (!S.next(0, cur)) return;
    f32x4 acc[2][2][4][2];
#pragma unroll
    for (int a = 0; a < 2; ++a)
#pragma unroll
        for (int b = 0; b < 2; ++b)
#pragma unroll
            for (int m = 0; m < 4; ++m)
#pragma unroll
                for (int n = 0; n < 2; ++n) acc[a][b][m][n] = (f32x4){0.f, 0.f, 0.f, 0.f};
    bf16x8 At[4][2], B0[2][2], B1[2][2];
    const char* cA = (const char*)g.A + (size_t)cur.pm * tstep; const char* cB = (const char*)g.Bt + (size_t)cur.pn * tstep;
    S.a_ready(cur);
    if constexpr (SP2) {
        PG8_STAGE(PG8_SB(0, 0), cB, voffB); PG8_STAGE(PG8_SB(0, 1), cB + hstep, voffB); PG8_STAGE(PG8_SA(0, 0), cA, voffA); PG8_STAGE(PG8_SA(0, 1), cA + hstep, voffA);
        if (wr == 1) PG8_BAR;
        PG8_WAIT_V(2); PG8_BAR;
        PG8_STAGE(PG8_SB(1, 0), cB + kstep, voffB); PG8_STAGE(PG8_SA(1, 0), cA + kstep, voffA); PG8_STAGE(PG8_SB(1, 1), cB + hstep + kstep, voffB);
        PG8_WAIT_V(6); PG8_BAR;
    } else {
        PG8_STAGE(PG8_SB(0, 0), cB, voffB); PG8_STAGE(PG8_SA(0, 0), cA, voffA); PG8_STAGE(PG8_SB(0, 1), cB + hstep, voffB); PG8_STAGE(PG8_SA(0, 1), cA + hstep, voffA);
        if (wr == 1) PG8_BAR;
        PG8_WAIT_V(4); PG8_BAR;
        PG8_STAGE(PG8_SB(1, 0), cB + kstep, voffB); PG8_STAGE(PG8_SA(1, 0), cA + kstep, voffA); PG8_STAGE(PG8_SB(1, 1), cB + hstep + kstep, voffB);
        PG8_WAIT_V(6); PG8_BAR;
    }
    for (;;) {
        const bool has_next = S.next(ui + 1, nxt);
        const char* nA = has_next ? (const char*)g.A + (size_t)nxt.pm * tstep : cA; const char* nB = has_next ? (const char*)g.Bt + (size_t)nxt.pn * tstep : cB;
        for (int t = 0; t < nt; t += 2) {
            const bool last = (t == nt - 2);
            const char* a1 = cA + (size_t)(t + 1) * kstep;
            const char* a2 = last ? nA : cA + (size_t)(t + 2) * kstep; const char* b2 = last ? nB : cB + (size_t)(t + 2) * kstep;
            const char* a3 = a2 + kstep; const char* b3 = b2 + kstep;
            if (last && has_next) S.a_ready(nxt);
            if constexpr (SP2) {
            PG8_LDB(B0, 0, 0); PG8_LDB(B1, 0, 1); PG8_SCHED; PG8_LDA(At, 0, 0); PG8_STAGE(PG8_SA(1, 1), a1 + hstep, voffA);
            PG8_WAIT_V(8); PG8_WAIT_L(0); PG8_BAR; PG8_MMA(0, 0, At, B0); PG8_MMA(0, 1, At, B1); PG8_BAR; PG8_SCHED;
            PG8_LDA(At, 0, 1); PG8_STAGE(PG8_SB(0, 0), b2, voffB); PG8_STAGE(PG8_SB(0, 1), b2 + hstep, voffB); PG8_STAGE(PG8_SA(0, 0), a2, voffA);
            PG8_WAIT_V(8); PG8_WAIT_L(0); PG8_BAR; PG8_MMA(1, 0, At, B0); PG8_MMA(1, 1, At, B1); PG8_BAR; PG8_SCHED;
            PG8_LDB(B0, 1, 0); PG8_LDB(B1, 1, 1); PG8_SCHED; PG8_LDA(At, 1, 0); PG8_STAGE(PG8_SA(0, 1), a2 + hstep, voffA);
            PG8_WAIT_V(8); PG8_WAIT_L(0); PG8_BAR; PG8_MMA(0, 0, At, B0); PG8_MMA(0, 1, At, B1); PG8_BAR; PG8_SCHED;
            PG8_LDA(At, 1, 1); PG8_STAGE(PG8_SB(1, 0), b3, voffB); PG8_STAGE(PG8_SB(1, 1), b3 + hstep, voffB); PG8_STAGE(PG8_SA(1, 0), a3, voffA);
            PG8_WAIT_V(8); PG8_WAIT_L(0); PG8_BAR; PG8_MMA(1, 0, At, B0); PG8_MMA(1, 1, At, B1); PG8_BAR; PG8_SCHED;
            } else {
            PG8_LDB(B0, 0, 0); PG8_SCHED; PG8_LDA(At, 0, 0); PG8_STAGE(PG8_SA(1, 1), a1 + hstep, voffA);
            PG8_WAIT_L(8); PG8_BAR; PG8_WAIT_L(0); PG8_MMA(0, 0, At, B0); PG8_BAR; PG8_SCHED;
            PG8_LDB(B1, 0, 1); PG8_STAGE(PG8_SB(0, 0), b2, voffB);
            PG8_BAR; PG8_WAIT_L(0); PG8_MMA(0, 1, At, B1); PG8_BAR;
            PG8_LDA(At, 0, 1); PG8_STAGE(PG8_SA(0, 0), a2, voffA);
            PG8_BAR; PG8_WAIT_L(0); PG8_MMA(1, 0, At, B0); PG8_BAR; PG8_SCHED;
            PG8_STAGE(PG8_SB(0, 1), b2 + hstep, voffB);
            PG8_WAIT_V(6); PG8_BAR; PG8_MMA(1, 1, At, B1); PG8_BAR;
            PG8_LDB(B0, 1, 0); PG8_SCHED; PG8_LDA(At, 1, 0); PG8_STAGE(PG8_SA(0, 1), a2 + hstep, voffA);
            PG8_WAIT_L(8); PG8_BAR; PG8_WAIT_L(0); PG8_MMA(0, 0, At, B0); PG8_BAR; PG8_SCHED;
            PG8_LDB(B1, 1, 1); PG8_STAGE(PG8_SB(1, 0), b3, voffB);
            PG8_BAR; PG8_WAIT_L(0); PG8_MMA(0, 1, At, B1); PG8_BAR;
            PG8_LDA(At, 1, 1); PG8_STAGE(PG8_SA(1, 0), a3, voffA);
            PG8_BAR; PG8_WAIT_L(0); PG8_MMA(1, 0, At, B0); PG8_BAR; PG8_SCHED;
            PG8_STAGE(PG8_SB(1, 1), b3 + hstep, voffB);
            PG8_WAIT_V(6); PG8_BAR; PG8_MMA(1, 1, At, B1); PG8_BAR;
            }
        }
        if constexpr (ALIGN_EPI) { if (wr == 0) PG8_BAR; }
        E(acc, cur, wr, wc, fr, fq); S.done(cur);
        if (!has_next) break;
#pragma unroll
        for (int a = 0; a < 2; ++a)
#pragma unroll
            for (int b = 0; b < 2; ++b)
#pragma unroll
                for (int m = 0; m < 4; ++m)
#pragma unroll
                    for (int n = 0; n < 2; ++n) acc[a][b][m][n] = (f32x4){0.f, 0.f, 0.f, 0.f};
        cur = nxt; cA = nA; cB = nB; ++ui;
        if constexpr (ALIGN_EPI) { if (wr == 1) PG8_BAR; }
    }
    PG8_WAIT_V(0);
    if constexpr (!ALIGN_EPI) { if (wr == 0) PG8_BAR; }
    PG8_BAR;
#undef PG8_SA
#undef PG8_SB
#undef PG8_STAGE
#undef PG8_LDA
#undef PG8_LDB
#undef PG8_MMA
#undef PG8_WAIT_V
#undef PG8_WAIT_L
#undef PG8_BAR
#undef PG8_SCHED
}
}

using pg8::bf16_t; using pg8::bf16x8; using pg8::f32x4;

constexpr int MT = 24576, DM = 1024, DFF = 2816, NCTX = 8192;
constexpr int UW = 3984;
constexpr int NCOND = 9, MODW = 9216;
constexpr size_t MiB = 1ull << 20;
constexpr size_t WS_A = 0, WS_U = 48 * MiB, WS_W1 = WS_U + 132 * MiB, WS_W1B = WS_W1 + (size_t)5632 * 1024 * 2,
                 WS_BT3 = 235 * MiB, WS_BT4 = 243 * MiB, WS_MOD = 245 * MiB, WS_GATES = 246 * MiB;
constexpr size_t WS_A2BF = 248 * MiB, WS_G2BF = WS_A2BF + 2 * 512 * 64 * 2;
constexpr int OUT_C = 25165824, OUT_N = 29360128, OUT_MM = 29392896, OUT_S = 29393152;
constexpr int LDS_BYTES = 163840;
constexpr int NTHR = 512;

struct P {
    const float *xp, *xs, *c, *sC, *sn, *sm, *sS, *cctx, *ada_w, *ada_b, *n1, *w1in, *w1out, *nmix, *wmin, *wmout,
        *cw, *cb, *gb, *hg, *mu, *w0, *w2, *a0, *a2, *g2, *kk, *ka, *rk, *lng, *lnb, *n2, *w2in, *w2out, *nf;
    float* out; unsigned char* ws;
};

__device__ __forceinline__ unsigned short f2bf(float f) { unsigned u = __float_as_uint(f); u += 0x7FFFu + ((u >> 16) & 1u); return (unsigned short)(u >> 16); }
__device__ __forceinline__ float bf2f(unsigned short b) { return __uint_as_float(((unsigned)b) << 16); }
__device__ __forceinline__ unsigned pk2(float a, float b) { return (unsigned)f2bf(a) | ((unsigned)f2bf(b) << 16); }
__device__ __forceinline__ int cond_of(int row) { return row < NCTX ? 0 : 1 + ((row - NCTX) >> 11); }
__device__ __forceinline__ float siluf(float x) { return x * __builtin_amdgcn_rcpf(1.f + __expf(-x)); }
__device__ __forceinline__ float sigmf(float x) { return __builtin_amdgcn_rcpf(1.f + __expf(-x)); }
__device__ __forceinline__ const float* xrow(const P& p, int row) { return row < NCTX ? p.xp + (size_t)row * DM : p.xs + (size_t)(row - NCTX) * DM; }
__device__ __forceinline__ f32x4 mfma16(bf16x8 a, bf16x8 b, f32x4 c) { return __builtin_amdgcn_mfma_f32_16x16x32_bf16(a, b, c, 0, 0, 0); }
__device__ __forceinline__ void unpack8(uint4 v, float* f) {
    f[0] = __uint_as_float(v.x << 16); f[1] = __uint_as_float(v.x & 0xffff0000u); f[2] = __uint_as_float(v.y << 16); f[3] = __uint_as_float(v.y & 0xffff0000u);
    f[4] = __uint_as_float(v.z << 16); f[5] = __uint_as_float(v.z & 0xffff0000u); f[6] = __uint_as_float(v.w << 16); f[7] = __uint_as_float(v.w & 0xffff0000u);
}

__device__ __forceinline__ int colmap(int kind, int n) {
    if (kind == 0) return n;
    if (kind == 1) { const int t = n >> 8, bj = (n >> 7) & 1, c = n & 127; return bj * DFF + t * 128 + c; }
    if (n < 2048) return n; if (n < 3968) return n + 16; if (n < 3984) return n - 3968 + 2048; return -1;
}
__device__ void convert_tile(const float* __restrict__ src, bf16_t* __restrict__ dst, int K, int Nsrc, int kind, int k0, int n0, float* tile) {
    const int tid = opaque_tid();
    { const int n = tid & 63, kr = tid >> 6; const int sc = colmap(kind, n0 + n);
#pragma unroll
      for (int i = 0; i < 8; ++i) { const int k = kr + 8 * i; tile[k * 65 + n] = sc >= 0 ? src[(size_t)(k0 + k) * Nsrc + sc] : 0.f; } }
    __syncthreads();
    { const int nn = tid >> 3, kg = tid & 7; unsigned w[4];
#pragma unroll
      for (int j = 0; j < 4; ++j) w[j] = pk2(tile[(kg * 8 + 2 * j) * 65 + nn], tile[(kg * 8 + 2 * j + 1) * 65 + nn]);
      *(uint4*)(dst + (size_t)(n0 + nn) * K + k0 + kg * 8) = make_uint4(w[0], w[1], w[2], w[3]); }
    __syncthreads();
}
__device__ void convert_jobs(const P& p, int first, int njobs_sel, unsigned char* lds, int item0, int nitems_before) {}

__device__ void do_convert(const float* src, bf16_t* dst, int K, int Nsrc, int Ndst, int kind, int t, float* tile) {
    const int nkt = K / 64; const int kt = t % nkt, ntile = t / nkt; (void)Ndst;
    convert_tile(src, dst, K, Nsrc, kind, kt * 64, ntile * 64, tile);
}

__device__ void phase0(const P& p, unsigned char* lds) {
    float* tile = (float*)lds;
    const int tid = opaque_tid();
    const int n_ada = 36 * 8;
    const int t1 = 16 * 88, t2 = 44 * 16, t3 = 16 * 64, t4 = 16 * 16, t5 = 8, t6 = 8, t7 = 16;
    const int total = n_ada + t1 + t2 + t3 + t4 + t5 + t6 + t7;
    for (int it = blockIdx.x; it < total; it += gridDim.x) {
        if (it < n_ada) {
            const int cgp = it % 36, kc = it / 36;
            float* sc = tile;
            __syncthreads();
            for (int i = tid; i < NCOND * 128; i += NTHR) { const int c = i >> 7, k = i & 127; const float v = c == 0 ? p.cctx[kc * 128 + k] : p.c[(c - 1) * DM + kc * 128 + k]; sc[i] = siluf(v); }
            __syncthreads();
            const int col = cgp * 256 + (tid & 255), kh = tid >> 8;
            float acc[NCOND];
#pragma unroll
            for (int c = 0; c < NCOND; ++c) acc[c] = 0.f;
            const float* w = p.ada_w + (size_t)(kc * 128 + kh * 64) * MODW + col;
#pragma unroll 4
            for (int k = 0; k < 64; ++k) { const float wv = w[(size_t)k * MODW];
#pragma unroll
                for (int c = 0; c < NCOND; ++c) acc[c] += sc[c * 128 + kh * 64 + k] * wv; }
            float* mod = (float*)(p.ws + WS_MOD);
            const float bias = (kc == 0 && kh == 0) ? p.ada_b[col] : 0.f;
#pragma unroll
            for (int c = 0; c < NCOND; ++c) atomicAdd(mod + c * MODW + col, acc[c] + bias);
            __syncthreads();
        } else {
            int t = it - n_ada;
            if (t < t1) do_convert(p.w1in, (bf16_t*)(p.ws + WS_W1), 1024, 5632, 5632, 1, t, tile);
            else if ((t -= t1) < t2) do_convert(p.w1out, (bf16_t*)(p.ws + WS_W1B), 2816, 1024, 1024, 0, t, tile);
            else if ((t -= t2) < t3) do_convert(p.wmin, (bf16_t*)(p.ws + WS_BT3), 1024, 3984, 4096, 2, t, tile);
            else if ((t -= t3) < t4) do_convert(p.wmout, (bf16_t*)(p.ws + WS_BT4), 1024, 1024, 1024, 0, t, tile);
            else if ((t -= t4) < t5) do_convert(p.a2, (bf16_t*)(p.ws + WS_A2BF), 64, 512, 512, 0, t, tile);
            else if ((t -= t5) < t6) do_convert(p.a2 + 64 * 512, (bf16_t*)(p.ws + WS_A2BF) + 512 * 64, 64, 512, 512, 0, t, tile);
            else { t -= t6; do_convert(p.g2, (bf16_t*)(p.ws + WS_G2BF), 128, 512, 512, 0, t, tile); }
        }
    }
}

__device__ void phase_normmod(const P& p, int which) {
    const int lane = opaque_tid() & 63, wave = threadIdx.x >> 6;
    const float* gain = which == 0 ? p.n1 : (which == 1 ? p.nmix : p.n2);
    const float* mod = (const float*)(p.ws + WS_MOD);
    bf16_t* A = (bf16_t*)(p.ws + WS_A);
    for (int row = blockIdx.x * 8 + wave; row < MT; row += gridDim.x * 8) {
        const float* src = which == 0 ? xrow(p, row) : p.out + (size_t)row * DM;
        float4 v[4]; float ss = 0.f;
#pragma unroll
        for (int i = 0; i < 4; ++i) { v[i] = *(const float4*)(src + lane * 4 + 256 * i); ss += v[i].x * v[i].x + v[i].y * v[i].y + v[i].z * v[i].z + v[i].w * v[i].w; }
#pragma unroll
        for (int o = 32; o >= 1; o >>= 1) ss += __shfl_xor(ss, o);
        const float rstd = rsqrtf(ss * (1.f / 1024.f) + 1e-6f);
        const float* sh = mod + cond_of(row) * MODW + which * 3072; const float* sc = sh + 1024;
#pragma unroll
        for (int i = 0; i < 4; ++i) { const int col = lane * 4 + 256 * i;
            const float4 g = *(const float4*)(gain + col), s4 = *(const float4*)(sh + col), c4 = *(const float4*)(sc + col);
            const float o0 = v[i].x * rstd * g.x * (1.f + c4.x) + s4.x, o1 = v[i].y * rstd * g.y * (1.f + c4.y) + s4.y,
                        o2 = v[i].z * rstd * g.z * (1.f + c4.z) + s4.z, o3 = v[i].w * rstd * g.w * (1.f + c4.w) + s4.w;
            *(uint2*)(A + (size_t)row * DM + col) = make_uint2(pk2(o0, o1), pk2(o2, o3)); }
    }
}
__device__ void phase_finalnorm(const P& p) {
    const int lane = opaque_tid() & 63, wave = threadIdx.x >> 6;
    for (int row = blockIdx.x * 8 + wave; row < MT; row += gridDim.x * 8) {
        float* src = p.out + (size_t)row * DM;
        float4 v[4]; float ss = 0.f;
#pragma unroll
        for (int i = 0; i < 4; ++i) { v[i] = *(const float4*)(src + lane * 4 + 256 * i); ss += v[i].x * v[i].x + v[i].y * v[i].y + v[i].z * v[i].z + v[i].w * v[i].w; }
#pragma unroll
        for (int o = 32; o >= 1; o >>= 1) ss += __shfl_xor(ss, o);
        const float rstd = rsqrtf(ss * (1.f / 1024.f) + 1e-6f);
#pragma unroll
        for (int i = 0; i < 4; ++i) { const int col = lane * 4 + 256 * i; const float4 g = *(const float4*)(p.nf + col);
            *(float4*)(src + col) = make_float4(v[i].x * rstd * g.x, v[i].y * rstd * g.y, v[i].z * rstd * g.z, v[i].w * rstd * g.w); }
    }
}

struct EpiSwiglu {
    static constexpr bool PERM = true;
    bf16_t* O;
    __device__ __forceinline__ void operator()(const f32x4 (&acc)[2][2][4][2], const pg8::Unit& u, int wr, int wc, int fr, int fq) const {
        const int row0 = u.pm * 256 + wr * 64 + fr, col0 = u.pn * 128 + wc * 32 + 8 * fq;
#pragma unroll
        for (int ai = 0; ai < 2; ++ai)
#pragma unroll
            for (int m = 0; m < 4; ++m) { bf16_t* rowp = O + (size_t)(row0 + ai * 128 + m * 16) * DFF + col0;
                float r[8];
#pragma unroll
                for (int n = 0; n < 2; ++n)
#pragma unroll
                    for (int j = 0; j < 4; ++j) r[n * 4 + j] = siluf(acc[ai][0][m][n][j]) * acc[ai][1][m][n][j];
                pg8::u32x4 w; w.x = pg8::cvt_pk_bf16(r[0], r[1]); w.y = pg8::cvt_pk_bf16(r[2], r[3]); w.z = pg8::cvt_pk_bf16(r[4], r[5]); w.w = pg8::cvt_pk_bf16(r[6], r[7]);
                *(pg8::u32x4*)rowp = w; }
    }
};
struct EpiResid {
    static constexpr bool PERM = false;
    const float* xp; const float* xs; float* out; const float* ga; float coef; int inplace;
    __device__ __forceinline__ void operator()(const f32x4 (&acc)[2][2][4][2], const pg8::Unit& u, int wr, int wc, int fr, int fq) const {
        const int row0 = u.pm * 256 + wr * 64 + fr, col0 = u.pn * 256 + wc * 32 + 4 * fq;
        const float* gap = ga + cond_of(u.pm * 256) * MODW;
        f32x4 gv[2][2];
#pragma unroll
        for (int bj = 0; bj < 2; ++bj)
#pragma unroll
            for (int n = 0; n < 2; ++n) gv[bj][n] = *(const f32x4*)(gap + col0 + bj * 128 + n * 16) * coef;
#pragma unroll
        for (int ai = 0; ai < 2; ++ai)
#pragma unroll
            for (int m = 0; m < 4; ++m) { const int row = row0 + ai * 128 + m * 16;
                const float* base = inplace ? out + (size_t)row * DM : (row < NCTX ? xp + (size_t)row * DM : xs + (size_t)(row - NCTX) * DM);
                float* op = out + (size_t)row * DM;
#pragma unroll
                for (int bj = 0; bj < 2; ++bj)
#pragma unroll
                    for (int n = 0; n < 2; ++n) { const int c = col0 + bj * 128 + n * 16; const f32x4 b4 = *(const f32x4*)(base + c);
                        *(f32x4*)(op + c) = b4 + gv[bj][n] * acc[ai][bj][m][n]; } }
    }
};
struct EpiU {
    static constexpr bool PERM = true;
    bf16_t* U; float* gates;
    __device__ __forceinline__ void operator()(const f32x4 (&acc)[2][2][4][2], const pg8::Unit& u, int wr, int wc, int fr, int fq) const {
        const int row0 = u.pm * 256 + wr * 64 + fr;
#pragma unroll
        for (int bj = 0; bj < 2; ++bj) { const int col0 = u.pn * 256 + bj * 128 + wc * 32 + 8 * fq;
            if (col0 < UW) {
#pragma unroll
                for (int ai = 0; ai < 2; ++ai)
#pragma unroll
                    for (int m = 0; m < 4; ++m) { const int row = row0 + ai * 128 + m * 16; const f32x4 v0 = acc[ai][bj][m][0], v1 = acc[ai][bj][m][1];
                        pg8::u32x4 w; w.x = pg8::cvt_pk_bf16(v0[0], v0[1]); w.y = pg8::cvt_pk_bf16(v0[2], v0[3]); w.z = pg8::cvt_pk_bf16(v1[0], v1[1]); w.w = pg8::cvt_pk_bf16(v1[2], v1[3]);
                        *(pg8::u32x4*)(U + (size_t)row * UW + col0) = w;
                        if (col0 >= 3968) { float* gp = gates + (size_t)row * 16 + (col0 - 3968); *(f32x4*)gp = v0; *(f32x4*)(gp + 4) = v1; } } } }
    }
};

template <class Epi>
__device__ __forceinline__ void run_gemm(unsigned char* lds, const bf16_t* A, const bf16_t* Bt, int N, int K, const Epi& E) {
    pg8::Gemm g{A, Bt, MT, N, K}; pg8::StaticOrder S; S.init(MT, N, (int)gridDim.x, (int)blockIdx.x);
    pg8::gemm_phase<Epi, pg8::StaticOrder, true, true>((PG8_LAS unsigned char*)lds, g, S, E);
}

constexpr int ML_SK = 0, ML_KWT = 17408, ML_VT = ML_KWT + 18432, ML_CB = ML_VT + 20736, ML_F = ML_CB + 21760, ML_CW = ML_F + 2048, ML_END = ML_CW + 4096;
static_assert(ML_END <= LDS_BYTES, "mlstm lds");

__device__ __forceinline__ unsigned short ld_u16_agent(const bf16_t* p) { return __hip_atomic_load(p, __ATOMIC_RELAXED, __HIP_MEMORY_SCOPE_AGENT); }

__device__ __forceinline__ void conv3_row8(const bf16_t* up, bool hasp, bool hasn, const float* cwp, float* x) {
    float t[8];
    unpack8(*(const uint4*)up, t);
#pragma unroll
    for (int i = 0; i < 8; ++i) x[i] = cwp[768 + i] + cwp[256 + i] * t[i];
    if (hasp) { unpack8(*(const uint4*)(up - UW), t);
#pragma unroll
        for (int i = 0; i < 8; ++i) x[i] += cwp[i] * t[i]; }
    if (hasn) { unpack8(*(const uint4*)(up + UW), t);
#pragma unroll
        for (int i = 0; i < 8; ++i) x[i] += cwp[512 + i] * t[i]; }
}

__device__ __forceinline__ void mlstm_task(const P& p, unsigned char* lds, int bg, int h) {
    const int wv = __builtin_amdgcn_readfirstlane((int)threadIdx.x >> 6), rw = wv & 3, cw = wv >> 2;
    const bool ctx = bg < 32; const int T = ctx ? 256 : 2048, nc = T / 64; const int row0 = ctx ? bg * 256 : NCTX + (bg - 32) * 2048;
    bf16_t* sK = (bf16_t*)(lds + ML_SK); bf16_t* sKwT = (bf16_t*)(lds + ML_KWT); bf16_t* sVT = (bf16_t*)(lds + ML_VT); bf16_t* sCb = (bf16_t*)(lds + ML_CB); bf16_t* sS = sCb;
    float* sA = (float*)(lds + ML_F); float* sM = sA + 64; float* sBb = sM + 64; float* sDen = sBb + 64; float* sScal = sDen + 64; float* sRed = sScal + 16;
    float* sCW = (float*)(lds + ML_CW);
    const bf16_t* U = (const bf16_t*)(p.ws + WS_U); const float* GATES = (const float*)(p.ws + WS_GATES); bf16_t* HB = (bf16_t*)(p.ws + WS_A);
    const int ct_a = cw ? 3 : 0;
    const int ct_b = cw ? 7 : 5;
    const int n_a = cw ? 2 : 3;

    __syncthreads();
    { const int tid = threadIdx.x;
      for (int i = tid; i < 1024; i += NTHR) { const int a = i >> 8, cc = i & 255, gch = (cc >> 7) * 512 + h * 128 + (cc & 127); sCW[i] = a < 3 ? p.cw[a * 1024 + gch] : p.cb[gch]; }
      for (int i = tid; i < 16 * 72; i += NTHR) { const int r = 128 + i / 72; sVT[r * 72 + (i % 72)] = (r == 128) ? (bf16_t)0x3F80 : (bf16_t)0; } }

#pragma unroll 1
    for (int dir = 0; dir < 2; ++dir) {
        f32x4 Cacc[9]; float m_prev = 0.f;
        { int z0 = 0; asm volatile("" : "+v"(z0)); const int tid = (int)threadIdx.x + z0, fr = tid & 15, fq = (tid >> 4) & 3;
#pragma unroll
          for (int ct = 0; ct < 9; ++ct) Cacc[ct] = (f32x4){0.f, 0.f, 0.f, 0.f};
          if (!ctx) { const int sidx = ((bg - 32) * 2 + dir) * 4 + h; const float* C0 = p.sC + (size_t)sidx * 16384; const float* n0 = p.sn + (size_t)sidx * 128;
#pragma unroll
              for (int j = 0; j < 4; ++j) { const int d = 16 * wv + 4 * fq + j;
#pragma unroll
                  for (int ct = 0; ct < 8; ++ct) Cacc[ct][j] = C0[d * 128 + 16 * ct + fr];
                  Cacc[8][j] = fr == 0 ? n0[d] : 0.f; }
              m_prev = p.sm[sidx]; } }
        const float gbi = p.gb[dir * 4 + h], gbf = p.gb[8 + dir * 4 + h];
        const bool second = dir == 1;
#pragma unroll 1
        for (int s = 0; s < nc; ++s) {
            const int c = dir ? nc - 1 - s : s;
            int zz = 0; asm volatile("" : "+v"(zz));
            const int tid = (int)threadIdx.x + zz, lane = tid & 63, fr = tid & 15, fq = (tid >> 4) & 3;
            __syncthreads();
            if (wv == 0) {
                const int tl = dir ? 63 - lane : lane; const size_t row = (size_t)row0 + c * 64 + tl;
                const float ip = GATES[row * 16 + dir * 4 + h] + gbi, fp = GATES[row * 16 + 8 + dir * 4 + h] + gbf;
                const float lf = fminf(fp, 0.f) - log1pf(__expf(-fabsf(fp)));
                float bs = lf;
#pragma unroll
                for (int o = 1; o < 64; o <<= 1) { const float t = __shfl_up(bs, o); if (lane >= o) bs += t; }
                const float a = ip - bs; float pm = a;
#pragma unroll
                for (int o = 1; o < 64; o <<= 1) { const float t = __shfl_up(pm, o); if (lane >= o) pm = fmaxf(pm, t); }
                const float Mt = fmaxf(m_prev, pm);
                sA[lane] = a; sM[lane] = Mt; sBb[lane] = bs;
                if (lane == 63) { sScal[0] = Mt; sScal[1] = bs; }
            }
            __syncthreads();
            const float M63 = sScal[0], bL = sScal[1];
#pragma unroll 1
            for (int g = 0; g < 2; ++g) {
                const int idx = tid + 512 * g, sl = idx >> 4, d0 = (idx & 15) * 8;
                const int tl = dir ? 63 - sl : sl, tok = c * 64 + tl; const size_t row = (size_t)row0 + tok;
                const int ch = 512 + h * 128 + d0;
                const float wk = __expf(sA[sl] - M63);
                float kv[8];
                conv3_row8(U + row * UW + ch, tok > 0, tok < T - 1, sCW + 128 + d0, kv);
#pragma unroll
                for (int i = 0; i < 8; ++i) kv[i] = siluf(kv[i]) * 0.08838834764831845f;
                *(uint4*)(sK + sl * 136 + d0) = make_uint4(pk2(kv[0], kv[1]), pk2(kv[2], kv[3]), pk2(kv[4], kv[5]), pk2(kv[6], kv[7]));
#pragma unroll
                for (int i = 0; i < 8; ++i) sKwT[(d0 + i) * 72 + sl] = f2bf(kv[i] * wk);
                const uint4 vv = *(const uint4*)(U + row * UW + 1024 + h * 128 + d0);
                const unsigned vw[4] = {vv.x, vv.y, vv.z, vv.w};
#pragma unroll
                for (int i = 0; i < 8; ++i) sVT[(d0 + i) * 72 + sl] = (bf16_t)((vw[i >> 1] >> ((i & 1) * 16)) & 0xffffu);
            }
            bf16x8 qf[4];
            { const int t_ = 16 * rw + fr, tl = dir ? 63 - t_ : t_, tok = c * 64 + tl; const size_t row = (size_t)row0 + tok;
#pragma unroll
              for (int kk = 0; kk < 4; ++kk) { const int ch = h * 128 + 32 * kk + 8 * fq;
                  float qv[8];
                  conv3_row8(U + row * UW + ch, tok > 0, tok < T - 1, sCW + 32 * kk + 8 * fq, qv);
#pragma unroll
                  for (int i = 0; i < 8; ++i) qv[i] = siluf(qv[i]);
                  union { uint4 u; bf16x8 v; } cv; cv.u = make_uint4(pk2(qv[0], qv[1]), pk2(qv[2], qv[3]), pk2(qv[4], qv[5]), pk2(qv[6], qv[7])); qf[kk] = cv.v; } }
            f32x4 num[5];
#pragma unroll
            for (int k = 0; k < 5; ++k) num[k] = (f32x4){0.f, 0.f, 0.f, 0.f};
#pragma unroll
            for (int ci = 0; ci < 5; ++ci) { const f32x4 v = Cacc[ci]; *(uint2*)(sCb + (16 * ci + fr) * 136 + 16 * wv + 4 * fq) = make_uint2(pk2(v[0], v[1]), pk2(v[2], v[3])); }
            __syncthreads();
#pragma unroll
            for (int k = 0; k < 3; ++k) if (k < n_a) {
#pragma unroll
                for (int kk = 0; kk < 4; ++kk) { const bf16x8 b = *(const bf16x8*)(sCb + (16 * (ct_a + k) + fr) * 136 + 32 * kk + 8 * fq); num[k] = mfma16(qf[kk], b, num[k]); } }
            __syncthreads();
#pragma unroll
            for (int ci = 0; ci < 4; ++ci) { const f32x4 v = Cacc[5 + ci]; *(uint2*)(sCb + (16 * ci + fr) * 136 + 16 * wv + 4 * fq) = make_uint2(pk2(v[0], v[1]), pk2(v[2], v[3])); }
            __syncthreads();
#pragma unroll
            for (int k = 3; k < 5; ++k) {
#pragma unroll
                for (int kk = 0; kk < 4; ++kk) { const bf16x8 b = *(const bf16x8*)(sCb + (16 * (ct_b + k - 3 - 5) + fr) * 136 + 32 * kk + 8 * fq); num[k] = mfma16(qf[kk], b, num[k]); } }
            {
                float scv[4];
#pragma unroll
                for (int j = 0; j < 4; ++j) scv[j] = __expf(m_prev - sM[16 * rw + 4 * fq + j]);
#pragma unroll
                for (int k = 0; k < 5; ++k)
#pragma unroll
                    for (int j = 0; j < 4; ++j) num[k][j] *= scv[j];
            }
            __syncthreads();
#pragma unroll
            for (int si = 0; si < 2; ++si) { const int st = 2 * cw + si;
                f32x4 sacc = (f32x4){0.f, 0.f, 0.f, 0.f};
                if (st <= rw) {
#pragma unroll
                    for (int kk = 0; kk < 4; ++kk) { const bf16x8 b = *(const bf16x8*)(sK + (16 * st + fr) * 136 + 32 * kk + 8 * fq); sacc = mfma16(qf[kk], b, sacc); } }
                const int sp = 16 * st + fr; const float as = sA[sp];
#pragma unroll
                for (int j = 0; j < 4; ++j) { const int tp = 16 * rw + 4 * fq + j; const float val = (sp <= tp) ? sacc[j] * __expf(as - sM[tp]) : 0.f; sS[tp * 72 + sp] = f2bf(val); }
            }
            __syncthreads();
#pragma unroll
            for (int ks = 0; ks < 2; ++ks) { const bf16x8 a = *(const bf16x8*)(sS + (16 * rw + fr) * 72 + 32 * ks + 8 * fq);
#pragma unroll
                for (int k = 0; k < 5; ++k) { const int ct = k < 3 ? ct_a + k : ct_b + k - 3;
                    if (k != 2 || cw == 0) { const bf16x8 b = *(const bf16x8*)(sVT + (16 * ct + fr) * 72 + 32 * ks + 8 * fq); num[k] = mfma16(a, b, num[k]); } } }
            if (cw == 1 && fr == 0) {
#pragma unroll
                for (int j = 0; j < 4; ++j) sDen[16 * rw + 4 * fq + j] = num[4][j]; }
            __syncthreads();
            float inv[4];
#pragma unroll
            for (int j = 0; j < 4; ++j) { const int tp = 16 * rw + 4 * fq + j; const float den = sDen[tp]; inv[j] = 1.f / fmaxf(fabsf(den), __expf(-(sBb[tp] + sM[tp]))); }
            if (!second) {
#pragma unroll
                for (int j = 0; j < 4; ++j) { const int tp = 16 * rw + 4 * fq + j, tl = dir ? 63 - tp : tp; const size_t row = (size_t)row0 + c * 64 + tl;
                    bf16_t* hb = HB + row * DM + h * 128;
#pragma unroll
                    for (int k = 0; k < 5; ++k) { const int ct = k < 3 ? ct_a + k : ct_b + k - 3; if ((k != 2 || cw == 0) && ct < 8) hb[16 * ct + fr] = f2bf(num[k][j] * inv[j]); } }
            } else {
                float ssr[4];
#pragma unroll
                for (int j = 0; j < 4; ++j) { const int tp = 16 * rw + 4 * fq + j, tl = dir ? 63 - tp : tp; const size_t row = (size_t)row0 + c * 64 + tl;
                    const bf16_t* hb = HB + row * DM + h * 128; float ss = 0.f;
#pragma unroll
                    for (int k = 0; k < 5; ++k) { const int ct = k < 3 ? ct_a + k : ct_b + k - 3;
                        if ((k != 2 || cw == 0) && ct < 8) { const int e = 16 * ct + fr; const float other = bf2f(ld_u16_agent(hb + e)); const float hs = num[k][j] * inv[j] + other;
                            const float o = sigmf(bf2f(U[row * UW + 1536 + h * 128 + e])); const float v = o * hs; ss += v * v; num[k][j] = v; } }
                    ss += __shfl_xor(ss, 1); ss += __shfl_xor(ss, 2); ss += __shfl_xor(ss, 4); ss += __shfl_xor(ss, 8);
                    ssr[j] = ss; if (fr == 0) sRed[cw * 64 + tp] = ss; }
                __syncthreads();
#pragma unroll
                for (int j = 0; j < 4; ++j) { const int tp = 16 * rw + 4 * fq + j, tl = dir ? 63 - tp : tp; const size_t row = (size_t)row0 + c * 64 + tl;
                    bf16_t* hb = HB + row * DM + h * 128; const float rms = rsqrtf((ssr[j] + sRed[(1 - cw) * 64 + tp]) * (1.f / 128.f) + 1e-6f);
#pragma unroll
                    for (int k = 0; k < 5; ++k) { const int ct = k < 3 ? ct_a + k : ct_b + k - 3;
                        if ((k != 2 || cw == 0) && ct < 8) { const int e = 16 * ct + fr; hb[e] = f2bf(num[k][j] * rms * p.hg[h * 128 + e]); } } }
            }
            const float decay = __expf(m_prev - M63);
#pragma unroll
            for (int ct = 0; ct < 9; ++ct) Cacc[ct] = Cacc[ct] * decay;
#pragma unroll
            for (int ks = 0; ks < 2; ++ks) { const bf16x8 a = *(const bf16x8*)(sKwT + (16 * wv + fr) * 72 + 32 * ks + 8 * fq);
#pragma unroll
                for (int ct = 0; ct < 9; ++ct) { const bf16x8 b = *(const bf16x8*)(sVT + (16 * ct + fr) * 72 + 32 * ks + 8 * fq); Cacc[ct] = mfma16(a, b, Cacc[ct]); } }
            m_prev = bL + M63;
        }
        if (ctx) { const int sidx = (bg * 2 + dir) * 4 + h; float* Co = p.out + OUT_C + (size_t)sidx * 16384;
            int z1 = 0; asm volatile("" : "+v"(z1)); const int tid1 = (int)threadIdx.x + z1, fr1 = tid1 & 15, fq1 = (tid1 >> 4) & 3;
#pragma unroll
            for (int j = 0; j < 4; ++j) { const int d = 16 * wv + 4 * fq1 + j;
#pragma unroll
                for (int ct = 0; ct < 8; ++ct) Co[d * 128 + 16 * ct + fr1] = Cacc[ct][j];
                if (fr1 == 0) p.out[OUT_N + sidx * 128 + d] = Cacc[8][j]; }
            if (tid1 == 0) p.out[OUT_MM + sidx] = m_prev; }
        __syncthreads();
    }
}

constexpr int RW_TC = 16;
constexpr int RW_VEC = 0, RW_V = RW_VEC + 16 * 320 * 4, RW_KR = RW_V + 16 * 32 * 4, RW_XW = RW_KR + 16 * 64 * 4, RW_XA = RW_XW + 16 * 72 * 2, RW_Y = RW_XA + 16 * 72 * 2,
              RW_MU = RW_Y + 16 * 32 * 4, RW_DIR = RW_MU + 4 * 288 * 4;
static_assert(2 * RW_DIR <= LDS_BYTES && RW_DIR % 16 == 0, "rwkv lds");

__device__ __forceinline__ float dppf(float x, const int ctrl) { return x; }
#define DPP_ADD(x, ctrl) ((x) + __int_as_float(__builtin_amdgcn_update_dpp(0, __float_as_int(x), (ctrl), 0xf, 0xf, true)))
__device__ __forceinline__ float red8(float x) { x = DPP_ADD(x, 0xB1); x = DPP_ADD(x, 0x4E); x = DPP_ADD(x, 0x141); return x; }
__device__ __forceinline__ float red16(float x) { x = red8(x); x = DPP_ADD(x, 0x140); return x; }

__device__ __forceinline__ void shifted8(const bf16_t* U, size_t row0, int tok, int T, bool grid, int c0, const float* mu4, int mustride, float* o) {
    const bf16_t* b = U + (row0 + tok) * UW + c0;
    float x[8], t[8];
    unpack8(*(const uint4*)b, x);
    const bool hl = grid ? (tok & 63) != 0 : tok > 0, hr = grid ? (tok & 63) != 63 : tok < T - 1;
    float msum[8];
#pragma unroll
    for (int i = 0; i < 8; ++i) { o[i] = 0.f; msum[i] = mu4[i] + mu4[mustride + i]; }
    if (hl) { unpack8(*(const uint4*)(b - UW), t);
#pragma unroll
        for (int i = 0; i < 8; ++i) o[i] += mu4[i] * t[i]; }
    if (hr) { unpack8(*(const uint4*)(b + UW), t);
#pragma unroll
        for (int i = 0; i < 8; ++i) o[i] += mu4[mustride + i] * t[i]; }
    if (grid) {
#pragma unroll
        for (int i = 0; i < 8; ++i) msum[i] += mu4[2 * mustride + i] + mu4[3 * mustride + i];
        if (tok >= 64) { unpack8(*(const uint4*)(b - 64 * (long)UW), t);
#pragma unroll
            for (int i = 0; i < 8; ++i) o[i] += mu4[2 * mustride + i] * t[i]; }
        if (tok < T - 64) { unpack8(*(const uint4*)(b + 64 * (long)UW), t);
#pragma unroll
            for (int i = 0; i < 8; ++i) o[i] += mu4[3 * mustride + i] * t[i]; }
    }
#pragma unroll
    for (int i = 0; i < 8; ++i) o[i] += x[i] * (1.f - msum[i]);
}

__device__ __forceinline__ void rwkv_task(const P& p, unsigned char* lds, int bg, int h, int rh) {
    const int wv = __builtin_amdgcn_readfirstlane((int)threadIdx.x >> 6), dir = wv >> 2, lw = wv & 3;
    const bool ctx = bg < 32; const int T = ctx ? 256 : 2048, nc = T / RW_TC; const size_t row0 = ctx ? (size_t)bg * 256 : (size_t)NCTX + (size_t)(bg - 32) * 2048;
    const bool grid = !ctx;
    unsigned char* L = lds + dir * RW_DIR;
    float* sVec = (float*)(L + RW_VEC); float* sV = (float*)(L + RW_V); float* sKr = (float*)(L + RW_KR); bf16_t* sXw = (bf16_t*)(L + RW_XW); bf16_t* sXa = (bf16_t*)(L + RW_XA);
    float* sY = (float*)(L + RW_Y); float* sMu = (float*)(L + RW_MU);
    const bf16_t* U = (const bf16_t*)(p.ws + WS_U); bf16_t* HB = (bf16_t*)(p.ws + WS_A);
    const int hc = h * 64;
    float st[8]; bf16x8 wfrag[2], afrag[2]; float w0v, a0v, kav;
    {
        const int tid = opaque_tid(), ltid = tid & 255, ri = ltid >> 3, jq = ltid & 7, fr = tid & 15, fq = (tid >> 4) & 3;
        __syncthreads();
        for (int i = ltid; i < 4 * 288; i += 256) { const int a = i / 288, mc = i % 288;
            const int rc = mc < 64 ? hc + mc : (mc < 128 ? 512 + hc + mc - 64 : (mc < 160 ? 1024 + hc + 32 * rh + mc - 128 : (mc < 224 ? 1536 + dir * 64 + mc - 160 : 1664 + dir * 64 + mc - 224)));
            sMu[i] = p.mu[a * 1920 + rc]; }
        if (ctx) {
#pragma unroll
            for (int q = 0; q < 8; ++q) st[q] = 0.f;
        } else { const float* S0 = p.sS + ((size_t)(((bg - 32) * 2 + dir) * 8 + h)) * 4096 + (32 * rh + ri) * 64 + jq * 8;
#pragma unroll
            for (int q = 0; q < 8; ++q) st[q] = S0[q]; }
        const int jcol = hc + 16 * lw + fr;
#pragma unroll
        for (int ks = 0; ks < 2; ++ks) { float wf[8], af[8];
#pragma unroll
            for (int i = 0; i < 8; ++i) { const int l = 32 * ks + 8 * fq + i; wf[i] = p.w2[(size_t)(dir * 64 + l) * 512 + jcol]; af[i] = p.a2[(size_t)(dir * 64 + l) * 512 + jcol]; }
            union { uint4 u; bf16x8 v; } c1, c2; c1.u = make_uint4(pk2(wf[0], wf[1]), pk2(wf[2], wf[3]), pk2(wf[4], wf[5]), pk2(wf[6], wf[7])); c2.u = make_uint4(pk2(af[0], af[1]), pk2(af[2], af[3]), pk2(af[4], af[5]), pk2(af[6], af[7]));
            wfrag[ks] = c1.v; afrag[ks] = c2.v; }
        w0v = p.w0[dir * 512 + jcol]; a0v = p.a0[dir * 512 + jcol]; kav = p.ka[jcol];
    }
#pragma unroll 1
    for (int s = 0; s < nc; ++s) {
        const int c = dir ? nc - 1 - s : s; const int tok0 = c * RW_TC;
        const bool second = s >= (nc >> 1);
        const int tid = opaque_tid(), ltid = tid & 255, ri = ltid >> 3, jq = ltid & 7, fr = tid & 15, fq = (tid >> 4) & 3;
        __syncthreads();
        { const int tl = (ltid & 127) >> 3, g = ltid & 7, tok = tok0 + tl; float o[8];
          if (lw < 2) {
              shifted8(U, row0, tok, T, grid, 2048 + hc + 8 * g, sMu + 8 * g, 288, o);
              *(float4*)(sVec + tl * 320 + 8 * g) = make_float4(o[0], o[1], o[2], o[3]); *(float4*)(sVec + tl * 320 + 8 * g + 4) = make_float4(o[4], o[5], o[6], o[7]);
          } else {
              shifted8(U, row0, tok, T, grid, 2048 + 512 + hc + 8 * g, sMu + 64 + 8 * g, 288, o);
              float kkr[8]; float ss = 0.f;
#pragma unroll
              for (int i = 0; i < 8; ++i) { kkr[i] = o[i] * p.kk[hc + 8 * g + i]; ss += kkr[i] * kkr[i]; }
              ss = red8(ss); const float rn = 1.f / fmaxf(sqrtf(ss), 1e-12f);
              *(float4*)(sKr + tl * 64 + 8 * g) = make_float4(o[0], o[1], o[2], o[3]); *(float4*)(sKr + tl * 64 + 8 * g + 4) = make_float4(o[4], o[5], o[6], o[7]);
              *(float4*)(sVec + tl * 320 + 192 + 8 * g) = make_float4(kkr[0] * rn, kkr[1] * rn, kkr[2] * rn, kkr[3] * rn); *(float4*)(sVec + tl * 320 + 192 + 8 * g + 4) = make_float4(kkr[4] * rn, kkr[5] * rn, kkr[6] * rn, kkr[7] * rn);
          }
          if (lw < 2) {
              shifted8(U, row0, tok, T, grid, 2048 + 1536 + dir * 64 + 8 * g, sMu + 160 + 8 * g, 288, o);
#pragma unroll
              for (int i = 0; i < 8; ++i) o[i] = tanhf(o[i]);
              *(uint4*)(sXw + tl * 72 + 8 * g) = make_uint4(pk2(o[0], o[1]), pk2(o[2], o[3]), pk2(o[4], o[5]), pk2(o[6], o[7]));
          } else {
              shifted8(U, row0, tok, T, grid, 2048 + 1664 + dir * 64 + 8 * g, sMu + 224 + 8 * g, 288, o);
              *(uint4*)(sXa + tl * 72 + 8 * g) = make_uint4(pk2(o[0], o[1]), pk2(o[2], o[3]), pk2(o[4], o[5]), pk2(o[6], o[7]));
          }
          if (lw == 0) {
              const int tl2 = ltid >> 2, g2 = ltid & 3;
              shifted8(U, row0, tok0 + tl2, T, grid, 2048 + 1024 + hc + 32 * rh + 8 * g2, sMu + 128 + 8 * g2, 288, o);
              *(float4*)(sV + tl2 * 32 + 8 * g2) = make_float4(o[0], o[1], o[2], o[3]); *(float4*)(sV + tl2 * 32 + 8 * g2 + 4) = make_float4(o[4], o[5], o[6], o[7]);
          } }
        __syncthreads();
        { f32x4 aw = (f32x4){0.f, 0.f, 0.f, 0.f}, aa = (f32x4){0.f, 0.f, 0.f, 0.f};
#pragma unroll
          for (int ks = 0; ks < 2; ++ks) { const bf16x8 xw = *(const bf16x8*)(sXw + fr * 72 + 32 * ks + 8 * fq), xa = *(const bf16x8*)(sXa + fr * 72 + 32 * ks + 8 * fq);
              aw = mfma16(xw, wfrag[ks], aw); aa = mfma16(xa, afrag[ks], aa); }
          const int j = 16 * lw + fr;
#pragma unroll
          for (int jj = 0; jj < 4; ++jj) { const int tl = 4 * fq + jj;
              const float z = -(w0v + aw[jj]); const float sp = fmaxf(z, 0.f) + log1pf(__expf(-fabsf(z))); const float dec = __expf(-__expf(-sp - 0.5f));
              const float a = sigmf(a0v + aa[jj]); const float k = sKr[tl * 64 + j], kn = sVec[tl * 320 + 192 + j];
              float* V = sVec + tl * 320 + j; V[64] = dec; V[128] = k * (1.f + (a - 1.f) * kav); V[256] = kn * a; } }
        __syncthreads();
#pragma unroll 2
        for (int step = 0; step < RW_TC; ++step) { const int tl = dir ? RW_TC - 1 - step : step; const float* V = sVec + tl * 320 + jq * 8;
            const float4 ka4 = *(const float4*)(V + 192), kb4 = *(const float4*)(V + 196);
            float sa = (st[0] * ka4.x + st[1] * ka4.y) + (st[2] * ka4.z + st[3] * ka4.w) + (st[4] * kb4.x + st[5] * kb4.y) + (st[6] * kb4.z + st[7] * kb4.w);
            sa = -red8(sa);
            const float vi = sV[tl * 32 + ri];
            const float4 wa = *(const float4*)(V + 64), wb = *(const float4*)(V + 68), ba = *(const float4*)(V + 256), bb = *(const float4*)(V + 260),
                         da = *(const float4*)(V + 128), db = *(const float4*)(V + 132), ra = *(const float4*)(V), rb = *(const float4*)(V + 4);
            st[0] = st[0] * wa.x + sa * ba.x + vi * da.x; st[1] = st[1] * wa.y + sa * ba.y + vi * da.y; st[2] = st[2] * wa.z + sa * ba.z + vi * da.z; st[3] = st[3] * wa.w + sa * ba.w + vi * da.w;
            st[4] = st[4] * wb.x + sa * bb.x + vi * db.x; st[5] = st[5] * wb.y + sa * bb.y + vi * db.y; st[6] = st[6] * wb.z + sa * bb.z + vi * db.z; st[7] = st[7] * wb.w + sa * bb.w + vi * db.w;
            float y = (st[0] * ra.x + st[1] * ra.y) + (st[2] * ra.z + st[3] * ra.w) + (st[4] * rb.x + st[5] * rb.y) + (st[6] * rb.z + st[7] * rb.w);
            y = red8(y);
            if (jq == 0) sY[tl * 32 + ri] = y; }
        __syncthreads();
        { const int tl = ltid >> 4, pr = ltid & 15; const size_t row = row0 + tok0 + tl; unsigned* hb = (unsigned*)(HB + row * DM + 512 + hc + 32 * rh + 2 * pr);
          float y0 = sY[tl * 32 + 2 * pr], y1 = sY[tl * 32 + 2 * pr + 1];
          if (second) { const unsigned ov = __hip_atomic_load(hb, __ATOMIC_RELAXED, __HIP_MEMORY_SCOPE_AGENT); y0 += __uint_as_float(ov << 16); y1 += __uint_as_float(ov & 0xffff0000u); }
          *hb = pk2(y0, y1); }
    }
    if (ctx) { const int tid = opaque_tid(), ltid = tid & 255, ri = ltid >> 3, jq = ltid & 7;
        float* So = p.out + OUT_S + ((size_t)((bg * 2 + dir) * 8 + h)) * 4096 + (32 * rh + ri) * 64 + jq * 8;
#pragma unroll
        for (int q = 0; q < 8; ++q) So[q] = st[q]; }
    __syncthreads();
}

constexpr int FZ_ROW = 1800;
constexpr int FZ_X = 0, FZ_MU = 32 * FZ_ROW * 2, FZ_END = FZ_MU + 4 * 1792 * 4;
static_assert(FZ_END <= LDS_BYTES && FZ_MU % 16 == 0, "finalize lds");

__device__ __forceinline__ void phase_rwkv_finalize(const P& p, unsigned char* lds) {
    bf16_t* sX = (bf16_t*)(lds + FZ_X); float* sMu = (float*)(lds + FZ_MU);
    const bf16_t* U = (const bf16_t*)(p.ws + WS_U); bf16_t* HB = (bf16_t*)(p.ws + WS_A);
    const bf16_t* A2 = (const bf16_t*)(p.ws + WS_A2BF); const bf16_t* G2 = (const bf16_t*)(p.ws + WS_G2BF);
    const int wv = __builtin_amdgcn_readfirstlane((int)threadIdx.x >> 6), hc = wv * 64;
    { const int tid = opaque_tid();
      __syncthreads();
      for (int i = tid; i < 4 * 1792; i += NTHR) { const int a = i / 1792, c = i % 1792; const int rc = c < 1536 ? c : c + 128; sMu[i] = p.mu[a * 1920 + rc]; } }
#pragma unroll 1
    for (int tile = blockIdx.x; tile < MT / 32; tile += gridDim.x) {
        const int tid = opaque_tid(), fr = tid & 15, fq = (tid >> 4) & 3;
        const int rowt = tile * 32; const bool ctx = rowt < NCTX; const int T = ctx ? 256 : 2048; const size_t row0 = ctx ? (size_t)(rowt & ~255) : (size_t)NCTX + (size_t)((rowt - NCTX) & ~2047);
        const int tokt = rowt - (int)row0;
        __syncthreads();
#pragma unroll 1
        for (int it = 0; it < 14; ++it) { const int item = it * NTHR + tid, tl = item / 224, gi = item % 224; float o[8];
            const int c0 = gi < 192 ? 2048 + 8 * gi : 2048 + 1664 + 8 * (gi - 192);
            shifted8(U, row0, tokt + tl, T, !ctx, c0, sMu + 8 * gi, 1792, o);
            if (gi >= 208) {
#pragma unroll
                for (int i = 0; i < 8; ++i) o[i] = sigmf(o[i]); }
            *(uint4*)(sX + tl * FZ_ROW + 8 * gi) = make_uint4(pk2(o[0], o[1]), pk2(o[2], o[3]), pk2(o[4], o[5]), pk2(o[6], o[7])); }
        __syncthreads();
#pragma unroll 1
        for (int rt = 0; rt < 2; ++rt) {
            f32x4 af[4], ab[4], gg[4];
#pragma unroll
            for (int ct = 0; ct < 4; ++ct) { af[ct] = (f32x4){0.f, 0.f, 0.f, 0.f}; ab[ct] = af[ct]; gg[ct] = af[ct]; }
            const bf16_t* xr = sX + (16 * rt + fr) * FZ_ROW;
#pragma unroll
            for (int ks = 0; ks < 2; ++ks) { const bf16x8 xf = *(const bf16x8*)(xr + 1536 + 32 * ks + 8 * fq), xb = *(const bf16x8*)(xr + 1600 + 32 * ks + 8 * fq);
#pragma unroll
                for (int ct = 0; ct < 4; ++ct) { const int n = hc + 16 * ct + fr;
                    af[ct] = mfma16(xf, *(const bf16x8*)(A2 + (size_t)n * 64 + 32 * ks + 8 * fq), af[ct]);
                    ab[ct] = mfma16(xb, *(const bf16x8*)(A2 + (size_t)(512 + n) * 64 + 32 * ks + 8 * fq), ab[ct]); } }
#pragma unroll
            for (int ks = 0; ks < 4; ++ks) { const bf16x8 xg = *(const bf16x8*)(xr + 1664 + 32 * ks + 8 * fq);
#pragma unroll
                for (int ct = 0; ct < 4; ++ct) { const int n = hc + 16 * ct + fr; gg[ct] = mfma16(xg, *(const bf16x8*)(G2 + (size_t)n * 128 + 32 * ks + 8 * fq), gg[ct]); } }
#pragma unroll
            for (int jj = 0; jj < 4; ++jj) { const int tl = 16 * rt + 4 * fq + jj; const size_t row = (size_t)rowt + tl; const bf16_t* xt = sX + tl * FZ_ROW;
                bf16_t* hb = HB + row * DM + 512 + hc;
                float y[4], vv[4]; float sy = 0.f, sb = 0.f;
#pragma unroll
                for (int ct = 0; ct < 4; ++ct) { const int ch = hc + 16 * ct + fr;
                    const float am = 0.5f * (sigmf(p.a0[ch] + af[ct][jj]) + sigmf(p.a0[512 + ch] + ab[ct][jj]));
                    const float r = bf2f(xt[ch]), k = bf2f(xt[512 + ch]); vv[ct] = bf2f(xt[1024 + ch]);
                    sb += r * k * (1.f + (am - 1.f) * p.ka[ch]) * p.rk[ch];
                    y[ct] = bf2f(hb[16 * ct + fr]); sy += y[ct]; }
                sy = red16(sy); sb = red16(sb);
                const float mean = sy * (1.f / 64.f); float vs = 0.f;
#pragma unroll
                for (int ct = 0; ct < 4; ++ct) { const float d = y[ct] - mean; vs += d * d; }
                vs = red16(vs); const float rstd = rsqrtf(vs * (1.f / 64.f) + 64e-5f);
#pragma unroll
                for (int ct = 0; ct < 4; ++ct) { const int ch = hc + 16 * ct + fr; const float yn = (y[ct] - mean) * rstd * p.lng[ch] + p.lnb[ch];
                    hb[16 * ct + fr] = f2bf((yn + sb * vv[ct]) * gg[ct][jj]); } }
        }
    }
}

__device__ __forceinline__ void scan_decode_task(int t, int& kind, int& bg, int& h, int& rh) {
    rh = 0;
    if (t < 32) { kind = 0; bg = 32 + t / 4; h = t % 4; }
    else if (t < 160) { const int q = t - 32; kind = 1; bg = 32 + q / 16; h = (q >> 1) & 7; rh = q & 1; }
    else if (t < 672) { const int q = t - 160; kind = 1; bg = q / 16; h = (q >> 1) & 7; rh = q & 1; }
    else { kind = 0; bg = (t - 672) / 4; h = (t - 672) % 4; }
}
__device__ __forceinline__ void phase_scan(const P& p, unsigned char* lds) {
    const int nb = gridDim.x, bid = blockIdx.x;
    int t = bid, step = nb;
    if (nb >= 200) { if (bid < 160) step = 100000; else step = nb - 160; }
#pragma unroll 1
    for (; t < 800; t += step) {
        int kind, bg, h, rh; scan_decode_task(t, kind, bg, h, rh);
        if (kind == 0) mlstm_task(p, lds, bg, h); else rwkv_task(p, lds, bg, h, rh);
    }
}

__device__ void phase_convert_w2(const P& p, unsigned char* lds) {
    float* tile = (float*)lds;
    const int t1 = 16 * 88, t2 = 44 * 16;
    for (int it = blockIdx.x; it < t1 + t2; it += gridDim.x) {
        if (it < t1) do_convert(p.w2in, (bf16_t*)(p.ws + WS_W1), 1024, 5632, 5632, 1, it, tile);
        else do_convert(p.w2out, (bf16_t*)(p.ws + WS_W1B), 2816, 1024, 1024, 0, it - t1, tile);
    }
}

constexpr int NPHASE = 12;
template <int PH>
__device__ __forceinline__ void run_phase(const P& p, unsigned char* lds) {
    const float* mod = (const float*)(p.ws + WS_MOD);
    if constexpr (PH == 0) phase0(p, lds);
    if constexpr (PH == 1) phase_normmod(p, 0);
    if constexpr (PH == 2) { EpiSwiglu E{(bf16_t*)(p.ws + WS_U)}; run_gemm(lds, (const bf16_t*)(p.ws + WS_A), (const bf16_t*)(p.ws + WS_W1), 5632, 1024, E); }
    if constexpr (PH == 3) { EpiResid E{p.xp, p.xs, p.out, mod + 2048, 0.5f, 0}; run_gemm(lds, (const bf16_t*)(p.ws + WS_U), (const bf16_t*)(p.ws + WS_W1B), 1024, 2816, E); }
    if constexpr (PH == 4) phase_normmod(p, 1);
    if constexpr (PH == 5) { EpiU E{(bf16_t*)(p.ws + WS_U), (float*)(p.ws + WS_GATES)}; run_gemm(lds, (const bf16_t*)(p.ws + WS_A), (const bf16_t*)(p.ws + WS_BT3), 4096, 1024, E); }
    if constexpr (PH == 6) phase_scan(p, lds);
    if constexpr (PH == 12) phase_rwkv_finalize(p, lds);
    if constexpr (PH == 7) { EpiResid E{p.xp, p.xs, p.out, mod + 5120, 1.0f, 1}; run_gemm(lds, (const bf16_t*)(p.ws + WS_A), (const bf16_t*)(p.ws + WS_BT4), 1024, 1024, E); }
    if constexpr (PH == 8) { phase_normmod(p, 2); phase_convert_w2(p, lds); }
    if constexpr (PH == 9) { EpiSwiglu E{(bf16_t*)(p.ws + WS_U)}; run_gemm(lds, (const bf16_t*)(p.ws + WS_A), (const bf16_t*)(p.ws + WS_W1), 5632, 1024, E); }
    if constexpr (PH == 10) { EpiResid E{p.xp, p.xs, p.out, mod + 8192, 0.5f, 1}; run_gemm(lds, (const bf16_t*)(p.ws + WS_U), (const bf16_t*)(p.ws + WS_W1B), 1024, 2816, E); }
    if constexpr (PH == 11) phase_finalnorm(p);
}

#if !ONE_LAUNCH
template <int PH>
__global__ void __launch_bounds__(NTHR, 2) k_phase(P p) {
    extern __shared__ __attribute__((aligned(16))) unsigned char lds[];
    run_phase<PH>(p, lds);
}
#endif

#if ONE_LAUNCH
__global__ void __launch_bounds__(NTHR, 2) k_mega(P p) {
    extern __shared__ __attribute__((aligned(16))) unsigned char lds[];
    cg::grid_group grid = cg::this_grid();
    run_phase<0>(p, lds); grid.sync();
    if (PROBE_DUP == 0) { run_phase<0>(p, lds); grid.sync(); }
    run_phase<1>(p, lds); grid.sync();
    if (PROBE_DUP == 1) { run_phase<1>(p, lds); grid.sync(); }
    run_phase<2>(p, lds); grid.sync();
    if (PROBE_DUP == 2) { run_phase<2>(p, lds); grid.sync(); }
    run_phase<3>(p, lds); grid.sync();
    if (PROBE_DUP == 3) { run_phase<3>(p, lds); grid.sync(); }
    run_phase<4>(p, lds); grid.sync();
    if (PROBE_DUP == 4) { run_phase<4>(p, lds); grid.sync(); }
    run_phase<5>(p, lds); grid.sync();
    if (PROBE_DUP == 5) { run_phase<5>(p, lds); grid.sync(); }
    run_phase<6>(p, lds); grid.sync();
    if (PROBE_DUP == 6) { run_phase<6>(p, lds); grid.sync(); }
    run_phase<12>(p, lds); grid.sync();
    run_phase<7>(p, lds); grid.sync();
    if (PROBE_DUP == 7) { run_phase<7>(p, lds); grid.sync(); }
    run_phase<8>(p, lds); grid.sync();
    if (PROBE_DUP == 8) { run_phase<8>(p, lds); grid.sync(); }
    run_phase<9>(p, lds); grid.sync();
    if (PROBE_DUP == 9) { run_phase<9>(p, lds); grid.sync(); }
    run_phase<10>(p, lds); grid.sync();
    if (PROBE_DUP == 10) { run_phase<10>(p, lds); grid.sync(); }
    run_phase<11>(p, lds);
}
#endif

#if !ONE_LAUNCH
template <int PH> static void launch_phase(const P& p, int grid, hipStream_t stream) {
    static bool attr = false;
    if (!attr) { (void)hipFuncSetAttribute((const void*)k_phase<PH>, hipFuncAttributeMaxDynamicSharedMemorySize, LDS_BYTES); attr = true; }
    hipLaunchKernelGGL(k_phase<PH>, dim3(grid), dim3(NTHR), LDS_BYTES, stream, p);
}
#endif

extern "C" void kernel_launch(void* const* d_in, const int* in_sizes, int n_in, void* d_out, int out_size, void* d_ws, size_t ws_size, hipStream_t stream) {
    (void)in_sizes; (void)n_in; (void)out_size; (void)ws_size;
    static int grid = 0;
    if (grid == 0) {
        int dev = 0, cus = 0;
        if (hipGetDevice(&dev) != hipSuccess || hipDeviceGetAttribute(&cus, hipDeviceAttributeMultiprocessorCount, dev) != hipSuccess || cus <= 0) cus = 256;
#if ONE_LAUNCH
        (void)hipFuncSetAttribute((const void*)k_mega, hipFuncAttributeMaxDynamicSharedMemorySize, LDS_BYTES);
        int per_cu = 0;
        if (hipOccupancyMaxActiveBlocksPerMultiprocessor(&per_cu, (const void*)k_mega, NTHR, LDS_BYTES) != hipSuccess || per_cu < 1) per_cu = 1;
        (void)hipGetLastError();
#endif
        grid = cus;
    }
    P p{};
    const float** f = (const float**)&p;
    for (int i = 0; i < 35; ++i) f[i] = (const float*)d_in[i];
    p.out = (float*)d_out; p.ws = (unsigned char*)d_ws;
    (void)hipMemsetAsync((char*)d_ws + WS_MOD, 0, NCOND * MODW * sizeof(float), stream);
#if ONE_LAUNCH
    void* args[] = {&p};
    hipError_t e = hipLaunchCooperativeKernel((const void*)k_mega, dim3(grid), dim3(NTHR), args, LDS_BYTES, stream);
    if (e != hipSuccess) fprintf(stderr, "cooperative launch failed: %s (grid %d)\n", hipGetErrorString(e), grid);
#else
    launch_phase<0>(p, grid, stream); launch_phase<1>(p, grid, stream); launch_phase<2>(p, grid, stream); launch_phase<3>(p, grid, stream);
    launch_phase<4>(p, grid, stream); launch_phase<5>(p, grid, stream); launch_phase<6>(p, grid, stream); launch_phase<12>(p, grid, stream); launch_phase<7>(p, grid, stream);
    launch_phase<8>(p, grid, stream); launch_phase<9>(p, grid, stream); launch_phase<10>(p, grid, stream); launch_phase<11>(p, grid, stream);
#endif
}
```

```cpp
#include <hip/hip_runtime.h>
#include <hip/hip_cooperative_groups.h>
#include <cstdio>
#include <cstdint>
namespace cg = cooperative_groups;

#ifndef PROBE_DUP
#define PROBE_DUP -1
#endif
#ifndef ONE_LAUNCH
#define ONE_LAUNCH 1
#endif

__device__ __forceinline__ int opaque_tid() { int z = 0; asm volatile("" : "+v"(z)); return (int)threadIdx.x + z; }

namespace pg8 {
#define PG8_LAS __attribute__((address_space(3)))
typedef unsigned short bf16_t;
typedef short bf16x8 __attribute__((ext_vector_type(8)));
typedef float f32x4 __attribute__((ext_vector_type(4)));
typedef unsigned u32x4 __attribute__((ext_vector_type(4)));
constexpr int BM = 256, BK = 64, HALF = 128, HTB = HALF * BK * 2, STAGE_BYTES = 8 * HTB, NXCD = 8, WGM = 8;

__host__ __device__ __forceinline__ int lds_byte(int r, int c) { const int st = (r >> 4) * 2 + (c >> 5), rr = r & 15, cc = c & 31, ob = rr * 64 + cc * 2; return st * 1024 + (ob ^ (((ob >> 9) & 1) << 5)); }
__host__ __device__ __forceinline__ void stage_rc(int b, int& R, int& C) { const int st = b / 1024, sb = b % 1024, swz = sb ^ (((sb >> 9) & 1) << 5); R = (st >> 1) * 16 + swz / 64; C = (st & 1) * 32 + (swz % 64) / 2; }
__host__ __device__ __forceinline__ int perm32(int rho) { const int n = rho >> 4, i = rho & 15; return 8 * (i >> 2) + 4 * n + (i & 3); }

struct Unit { int pm, pn; };
struct Gemm { const bf16_t* A; const bf16_t* Bt; int M, N, K; };

struct StaticOrder {
    int nM, nN, nwg, G, c;
    __host__ __device__ void init(int M, int N, int G_, int c_) { nM = M / BM; nN = N / BM; nwg = nM * nN; G = G_; c = c_; }
    __host__ __device__ bool next(int i, Unit& u) const {
        const long L = (long)i * G + c; if (L >= nwg) return false;
        int wgid = (int)L; { const int q = nwg / NXCD, r = nwg % NXCD, xcd = wgid % NXCD, off = wgid / NXCD; wgid = (xcd < r ? xcd * (q + 1) : r * (q + 1) + (xcd - r) * q) + off; }
        const int nig = WGM * nN, gid = wgid / nig, fm = gid * WGM, gsz = (nM - fm) < WGM ? (nM - fm) : WGM;
        u.pm = fm + ((wgid % nig) % gsz); u.pn = (wgid % nig) / gsz; return true;
    }
    __device__ __forceinline__ void a_ready(const Unit&) const {}
    __device__ __forceinline__ void done(const Unit&) const {}
};

__device__ __forceinline__ unsigned cvt_pk_bf16(float lo, float hi) { unsigned r; asm volatile("v_cvt_pk_bf16_f32 %0, %1, %2" : "=v"(r) : "v"(lo), "v"(hi)); return r; }

template <class Epi, class Sched, bool ALIGN_EPI = false, bool SP2 = false>
__device__ __forceinline__ void gemm_phase(PG8_LAS unsigned char* lds, const Gemm g, const Sched& S, const Epi& E) {
    const int tid = opaque_tid(), wid = __builtin_amdgcn_readfirstlane((int)threadIdx.x >> 6), lane = tid & 63, wr = wid >> 2, wc = wid & 3, fr = lane & 15, fq = lane >> 4;
    const int K = g.K, nt = K / BK;
    unsigned voffA[2], voffB[2];
#pragma unroll
    for (int i = 0; i < 2; ++i) { int R, C; stage_rc(tid * 16 + i * 8192, R, C); const int Rb = Epi::PERM ? ((R & ~31) + perm32(R & 31)) : R;
        voffA[i] = (unsigned)(R * K + C) * 2u; voffB[i] = (unsigned)(Rb * K + C) * 2u; }
    const size_t kstep = (size_t)(BK * 2);
    const size_t hstep = (size_t)HALF * K * 2;
    const size_t tstep = 2 * hstep;
    const unsigned ldsw = (unsigned)wid * 1024u;
    const int aoff = lds_byte(wr * 64 + fr, fq * 8), boff = lds_byte(wc * 32 + fr, fq * 8);
#define PG8_SA(b, h) (((b) * 2 + (h)) * HTB)
#define PG8_SB(b, h) ((4 + (b) * 2 + (h)) * HTB)
#define PG8_STAGE(bufoff, gbase, voff) do { _Pragma("unroll") for (int _i = 0; _i < 2; ++_i) \
        __builtin_amdgcn_global_load_lds((const unsigned*)((const char*)(gbase) + (voff)[_i]), (PG8_LAS unsigned*)(lds + (bufoff) + ldsw + _i * 8192), 16, 0, 0); } while (0)
#define PG8_LDA(dst, b, h) do { _Pragma("unroll") for (int m = 0; m < 4; ++m) _Pragma("unroll") for (int k = 0; k < 2; ++k) dst[m][k] = *(const PG8_LAS bf16x8*)(lds + PG8_SA(b, h) + aoff + m * 2048 + k * 1024); } while (0)
#define PG8_LDB(dst, b, h) do { _Pragma("unroll") for (int n = 0; n < 2; ++n) _Pragma("unroll") for (int k = 0; k < 2; ++k) dst[n][k] = *(const PG8_LAS bf16x8*)(lds + PG8_SB(b, h) + boff + n * 2048 + k * 1024); } while (0)
#define PG8_MMA(ai, bj, At, Bt) do { __builtin_amdgcn_s_setprio(1); _Pragma("unroll") for (int m = 0; m < 4; ++m) _Pragma("unroll") for (int n = 0; n < 2; ++n) _Pragma("unroll") for (int k = 0; k < 2; ++k) \
        acc[ai][bj][m][n] = __builtin_amdgcn_mfma_f32_16x16x32_bf16(Bt[n][k], At[m][k], acc[ai][bj][m][n], 0, 0, 0); __builtin_amdgcn_s_setprio(0); } while (0)
#define PG8_WAIT_V(n) asm volatile("s_waitcnt vmcnt(" #n ")" ::: "memory")
#define PG8_WAIT_L(n) asm volatile("s_waitcnt lgkmcnt(" #n ")" ::: "memory")
#define PG8_BAR __builtin_amdgcn_s_barrier()
#define PG8_SCHED __builtin_amdgcn_sched_barrier(0)
    Unit cur, nxt; int ui = 0;
    if (!S.next(0, cur)) return;
    f32x4 acc[2][2][4][2];
#pragma unroll
    for (int a = 0; a < 2; ++a)
#pragma unroll
        for (int b = 0; b < 2; ++b)
#pragma unroll
            for (int m = 0; m < 4; ++m)
#pragma unroll
                for (int n = 0; n < 2; ++n) acc[a][b][m][n] = (f32x4){0.f, 0.f, 0.f, 0.f};
    bf16x8 At[4][2], B0[2][2], B1[2][2];
    const char* cA = (const char*)g.A + (size_t)cur.pm * tstep; const char* cB = (const char*)g.Bt + (size_t)cur.pn * tstep;
    S.a_ready(cur);
    if constexpr (SP2) {
        PG8_STAGE(PG8_SB(0, 0), cB, voffB); PG8_STAGE(PG8_SB(0, 1), cB + hstep, voffB); PG8_STAGE(PG8_SA(0, 0), cA, voffA); PG8_STAGE(PG8_SA(0, 1), cA + hstep, voffA);
        if (wr == 1) PG8_BAR;
        PG8_WAIT_V(2); PG8_BAR;
        PG8_STAGE(PG8_SB(1, 0), cB + kstep, voffB); PG8_STAGE(PG8_SA(1, 0), cA + kstep, voffA); PG8_STAGE(PG8_SB(1, 1), cB + hstep + kstep, voffB);
        PG8_WAIT_V(6); PG8_BAR;
    } else {
        PG8_STAGE(PG8_SB(0, 0), cB, voffB); PG8_STAGE(PG8_SA(0, 0), cA, voffA); PG8_STAGE(PG8_SB(0, 1), cB + hstep, voffB); PG8_STAGE(PG8_SA(0, 1), cA + hstep, voffA);
        if (wr == 1) PG8_BAR;
        PG8_WAIT_V(4); PG8_BAR;
        PG8_STAGE(PG8_SB(1, 0), cB + kstep, voffB); PG8_STAGE(PG8_SA(1, 0), cA + kstep, voffA); PG8_STAGE(PG8_SB(1, 1), cB + hstep + kstep, voffB);
        PG8_WAIT_V(6); PG8_BAR;
    }
    for (;;) {
        const bool has_next = S.next(ui + 1, nxt);
        const char* nA = has_next ? (const char*)g.A + (size_t)nxt.pm * tstep : cA; const char* nB = has_next ? (const char*)g.Bt + (size_t)nxt.pn * tstep : cB;
        for (int t = 0; t < nt; t += 2) {
            const bool last = (t == nt - 2);
            const char* a1 = cA + (size_t)(t + 1) * kstep;
            const char* a2 = last ? nA : cA + (size_t)(t + 2) * kstep; const char* b2 = last ? nB : cB + (size_t)(t + 2) * kstep;
            const char* a3 = a2 + kstep; const char* b3 = b2 + kstep;
            if (last && has_next) S.a_ready(nxt);
            if constexpr (SP2) {
            PG8_LDB(B0, 0, 0); PG8_LDB(B1, 0, 1); PG8_SCHED; PG8_LDA(At, 0, 0); PG8_STAGE(PG8_SA(1, 1), a1 + hstep, voffA);
            PG8_WAIT_V(8); PG8_WAIT_L(0); PG8_BAR; PG8_MMA(0, 0, At, B0); PG8_MMA(0, 1, At, B1); PG8_BAR; PG8_SCHED;
            PG8_LDA(At, 0, 1); PG8_STAGE(PG8_SB(0, 0), b2, voffB); PG8_STAGE(PG8_SB(0, 1), b2 + hstep, voffB); PG8_STAGE(PG8_SA(0, 0), a2, voffA);
            PG8_WAIT_V(8); PG8_WAIT_L(0); PG8_BAR; PG8_MMA(1, 0, At, B0); PG8_MMA(1, 1, At, B1); PG8_BAR; PG8_SCHED;
            PG8_LDB(B0, 1, 0); PG8_LDB(B1, 1, 1); PG8_SCHED; PG8_LDA(At, 1, 0); PG8_STAGE(PG8_SA(0, 1), a2 + hstep, voffA);
            PG8_WAIT_V(8); PG8_WAIT_L(0); PG8_BAR; PG8_MMA(0, 0, At, B0); PG8_MMA(0, 1, At, B1); PG8_BAR; PG8_SCHED;
            PG8_LDA(At, 1, 1); PG8_STAGE(PG8_SB(1, 0), b3, voffB); PG8_STAGE(PG8_SB(1, 1), b3 + hstep, voffB); PG8_STAGE(PG8_SA(1, 0), a3, voffA);
            PG8_WAIT_V(8); PG8_WAIT_L(0); PG8_BAR; PG8_MMA(1, 0, At, B0); PG8_MMA(1, 1, At, B1); PG8_BAR; PG8_SCHED;
            } else {
            PG8_LDB(B0, 0, 0); PG8_SCHED; PG8_LDA(At, 0, 0); PG8_STAGE(PG8_SA(1, 1), a1 + hstep, voffA);
            PG8_WAIT_L(8); PG8_BAR; PG8_WAIT_L(0); PG8_MMA(0, 0, At, B0); PG8_BAR; PG8_SCHED;
            PG8_LDB(B1, 0, 1); PG8_STAGE(PG8_SB(0, 0), b2, voffB);
            PG8_BAR; PG8_WAIT_L(0); PG8_MMA(0, 1, At, B1); PG8_BAR;
            PG8_LDA(At, 0, 1); PG8_STAGE(PG8_SA(0, 0), a2, voffA);
            PG8_BAR; PG8_WAIT_L(0); PG8_MMA(1, 0, At, B0); PG8_BAR; PG8_SCHED;
            PG8_STAGE(PG8_SB(0, 1), b2 + hstep, voffB);
            PG8_WAIT_V(6); PG8_BAR; PG8_MMA(1, 1, At, B1); PG8_BAR;
            PG8_LDB(B0, 1, 0); PG8_SCHED; PG8_LDA(At, 1, 0); PG8_STAGE(PG8_SA(0, 1), a2 + hstep, voffA);
            PG8_WAIT_L(8); PG8_BAR; PG8_WAIT_L(0); PG8_MMA(0, 0, At, B0); PG8_BAR; PG8_SCHED;
            PG8_LDB(B1, 1, 1); PG8_STAGE(PG8_SB(1, 0), b3, voffB);
            PG8_BAR; PG8_WAIT_L(0); PG8_MMA(0, 1, At, B1); PG8_BAR;
            PG8_LDA(At, 1, 1); PG8_STAGE(PG8_SA(1, 0), a3, voffA);
            PG8_BAR; PG8_WAIT_L(0); PG8_MMA(1, 0, At, B0); PG8_BAR; PG8_SCHED;
            PG8_STAGE(PG8_SB(1, 1), b3 + hstep, voffB);
            PG8_WAIT_V(6); PG8_BAR; PG8_MMA(1, 1, At, B1); PG8_BAR;
            }
        }
        if constexpr (ALIGN_EPI) { if (wr == 0) PG8_BAR; }
        E(acc, cur, wr, wc, fr, fq); S.done(cur);
        if (!has_next) break;
#pragma unroll
        for (int a = 0; a < 2; ++a)
#pragma unroll
            for (int b = 0; b < 2; ++b)
#pragma unroll
                for (int m = 0; m < 4; ++m)
#pragma unroll
                    for (int n = 0; n < 2; ++n) acc[a][b][m][n] = (f32x4){0.f, 0.f, 0.f, 0.f};
        cur = nxt; cA = nA; cB = nB; ++ui;
        if constexpr (ALIGN_EPI) { if (wr == 1) PG8_BAR; }
    }
    PG8_WAIT_V(0);
    if constexpr (!ALIGN_EPI) { if (wr == 0) PG8_BAR; }
    PG8_BAR;
#undef PG8_SA
#undef PG8_SB
#undef PG8_STAGE
#undef PG8_LDA
#undef PG8_LDB
#undef PG8_MMA
#undef PG8_WAIT_V
#undef PG8_WAIT_L
#undef PG8_BAR
#undef PG8_SCHED
}
}

using pg8::bf16_t; using pg8::bf16x8; using pg8::f32x4;

constexpr int MT = 24576, DM = 1024, DFF = 2816, NCTX = 8192;
constexpr int UW = 3984;
constexpr int NCOND = 9, MODW = 9216;
constexpr size_t MiB = 1ull << 20;
constexpr size_t WS_A = 0, WS_U = 48 * MiB, WS_W1 = WS_U + 132 * MiB, WS_W1B = WS_W1 + (size_t)5632 * 1024 * 2,
                 WS_BT3 = 235 * MiB, WS_BT4 = 243 * MiB, WS_MOD = 245 * MiB, WS_GATES = 246 * MiB;
constexpr size_t WS_A2BF = 248 * MiB, WS_G2BF = WS_A2BF + 2 * 512 * 64 * 2;
constexpr int OUT_C = 25165824, OUT_N = 29360128, OUT_MM = 29392896, OUT_S = 29393152;
constexpr int LDS_BYTES = 163840;
constexpr int NTHR = 512;

struct P {
    const float *xp, *xs, *c, *sC, *sn, *sm, *sS, *cctx, *ada_w, *ada_b, *n1, *w1in, *w1out, *nmix, *wmin, *wmout,
        *cw, *cb, *gb, *hg, *mu, *w0, *w2, *a0, *a2, *g2, *kk, *ka, *rk, *lng, *lnb, *n2, *w2in, *w2out, *nf;
    float* out; unsigned char* ws;
};

__device__ __forceinline__ unsigned short f2bf(float f) { unsigned u = __float_as_uint(f); u += 0x7FFFu + ((u >> 16) & 1u); return (unsigned short)(u >> 16); }
__device__ __forceinline__ float bf2f(unsigned short b) { return __uint_as_float(((unsigned)b) << 16); }
__device__ __forceinline__ unsigned pk2(float a, float b) { return (unsigned)f2bf(a) | ((unsigned)f2bf(b) << 16); }
__device__ __forceinline__ int cond_of(int row) { return row < NCTX ? 0 : 1 + ((row - NCTX) >> 11); }
__device__ __forceinline__ float siluf(float x) { return x * __builtin_amdgcn_rcpf(1.f + __expf(-x)); }
__device__ __forceinline__ float sigmf(float x) { return __builtin_amdgcn_rcpf(1.f + __expf(-x)); }
__device__ __forceinline__ float tanh_fast(float x) { return 1.f - 2.f * __builtin_amdgcn_rcpf(1.f + __expf(2.f * x)); }
__device__ __forceinline__ float softplus_fast(float z) { return fmaxf(z, 0.f) + __logf(1.f + __expf(-fabsf(z))); }
__device__ __forceinline__ const float* xrow(const P& p, int row) { return row < NCTX ? p.xp + (size_t)row * DM : p.xs + (size_t)(row - NCTX) * DM; }
__device__ __forceinline__ f32x4 mfma16(bf16x8 a, bf16x8 b, f32x4 c) { return __builtin_amdgcn_mfma_f32_16x16x32_bf16(a, b, c, 0, 0, 0); }
__device__ __forceinline__ void unpack8(uint4 v, float* f) {
    f[0] = __uint_as_float(v.x << 16); f[1] = __uint_as_float(v.x & 0xffff0000u); f[2] = __uint_as_float(v.y << 16); f[3] = __uint_as_float(v.y & 0xffff0000u);
    f[4] = __uint_as_float(v.z << 16); f[5] = __uint_as_float(v.z & 0xffff0000u); f[6] = __uint_as_float(v.w << 16); f[7] = __uint_as_float(v.w & 0xffff0000u);
}

__device__ __forceinline__ int colmap(int kind, int n) {
    if (kind == 0) return n;
    if (kind == 1) { const int t = n >> 8, bj = (n >> 7) & 1, c = n & 127; return bj * DFF + t * 128 + c; }
    if (n < 2048) return n; if (n < 3968) return n + 16; if (n < 3984) return n - 3968 + 2048; return -1;
}
__device__ void convert_tile(const float* __restrict__ src, bf16_t* __restrict__ dst, int K, int Nsrc, int kind, int k0, int n0, float* tile) {
    const int tid = opaque_tid();
    { const int n = tid & 63, kr = tid >> 6; const int sc = colmap(kind, n0 + n);
#pragma unroll
      for (int i = 0; i < 8; ++i) { const int k = kr + 8 * i; tile[k * 65 + n] = sc >= 0 ? src[(size_t)(k0 + k) * Nsrc + sc] : 0.f; } }
    __syncthreads();
    { const int nn = tid >> 3, kg = tid & 7; unsigned w[4];
#pragma unroll
      for (int j = 0; j < 4; ++j) w[j] = pk2(tile[(kg * 8 + 2 * j) * 65 + nn], tile[(kg * 8 + 2 * j + 1) * 65 + nn]);
      *(uint4*)(dst + (size_t)(n0 + nn) * K + k0 + kg * 8) = make_uint4(w[0], w[1], w[2], w[3]); }
    __syncthreads();
}
__device__ void convert_jobs(const P& p, int first, int njobs_sel, unsigned char* lds, int item0, int nitems_before) {}

__device__ void do_convert(const float* src, bf16_t* dst, int K, int Nsrc, int Ndst, int kind, int t, float* tile) {
    const int nkt = K / 64; const int kt = t % nkt, ntile = t / nkt; (void)Ndst;
    convert_tile(src, dst, K, Nsrc, kind, kt * 64, ntile * 64, tile);
}

__device__ void phase0(const P& p, unsigned char* lds) {
    float* tile = (float*)lds;
    const int tid = opaque_tid();
    const int n_ada = 36 * 8;
    const int t1 = 16 * 88, t2 = 44 * 16, t3 = 16 * 64, t4 = 16 * 16, t5 = 8, t6 = 8, t7 = 16;
    const int total = n_ada + t1 + t2 + t3 + t4 + t5 + t6 + t7;
    for (int it = blockIdx.x; it < total; it += gridDim.x) {
        if (it < n_ada) {
            const int cgp = it % 36, kc = it / 36;
            float* sc = tile;
            __syncthreads();
            for (int i = tid; i < NCOND * 128; i += NTHR) { const int c = i >> 7, k = i & 127; const float v = c == 0 ? p.cctx[kc * 128 + k] : p.c[(c - 1) * DM + kc * 128 + k]; sc[i] = siluf(v); }
            __syncthreads();
            const int col = cgp * 256 + (tid & 255), kh = tid >> 8;
            float acc[NCOND];
#pragma unroll
            for (int c = 0; c < NCOND; ++c) acc[c] = 0.f;
            const float* w = p.ada_w + (size_t)(kc * 128 + kh * 64) * MODW + col;
#pragma unroll 4
            for (int k = 0; k < 64; ++k) { const float wv = w[(size_t)k * MODW];
#pragma unroll
                for (int c = 0; c < NCOND; ++c) acc[c] += sc[c * 128 + kh * 64 + k] * wv; }
            float* mod = (float*)(p.ws + WS_MOD);
            const float bias = (kc == 0 && kh == 0) ? p.ada_b[col] : 0.f;
#pragma unroll
            for (int c = 0; c < NCOND; ++c) atomicAdd(mod + c * MODW + col, acc[c] + bias);
            __syncthreads();
        } else {
            int t = it - n_ada;
            if (t < t1) do_convert(p.w1in, (bf16_t*)(p.ws + WS_W1), 1024, 5632, 5632, 1, t, tile);
            else if ((t -= t1) < t2) do_convert(p.w1out, (bf16_t*)(p.ws + WS_W1B), 2816, 1024, 1024, 0, t, tile);
            else if ((t -= t2) < t3) do_convert(p.wmin, (bf16_t*)(p.ws + WS_BT3), 1024, 3984, 4096, 2, t, tile);
            else if ((t -= t3) < t4) do_convert(p.wmout, (bf16_t*)(p.ws + WS_BT4), 1024, 1024, 1024, 0, t, tile);
            else if ((t -= t4) < t5) do_convert(p.a2, (bf16_t*)(p.ws + WS_A2BF), 64, 512, 512, 0, t, tile);
            else if ((t -= t5) < t6) do_convert(p.a2 + 64 * 512, (bf16_t*)(p.ws + WS_A2BF) + 512 * 64, 64, 512, 512, 0, t, tile);
            else { t -= t6; do_convert(p.g2, (bf16_t*)(p.ws + WS_G2BF), 128, 512, 512, 0, t, tile); }
        }
    }
}

__device__ void phase_normmod(const P& p, int which) {
    const int lane = opaque_tid() & 63, wave = threadIdx.x >> 6;
    const float* gain = which == 0 ? p.n1 : (which == 1 ? p.nmix : p.n2);
    const float* mod = (const float*)(p.ws + WS_MOD);
    bf16_t* A = (bf16_t*)(p.ws + WS_A);
    for (int row = blockIdx.x * 8 + wave; row < MT; row += gridDim.x * 8) {
        const float* src = which == 0 ? xrow(p, row) : p.out + (size_t)row * DM;
        float4 v[4]; float ss = 0.f;
#pragma unroll
        for (int i = 0; i < 4; ++i) { v[i] = *(const float4*)(src + lane * 4 + 256 * i); ss += v[i].x * v[i].x + v[i].y * v[i].y + v[i].z * v[i].z + v[i].w * v[i].w; }
#pragma unroll
        for (int o = 32; o >= 1; o >>= 1) ss += __shfl_xor(ss, o);
        const float rstd = rsqrtf(ss * (1.f / 1024.f) + 1e-6f);
        const float* sh = mod + cond_of(row) * MODW + which * 3072; const float* sc = sh + 1024;
#pragma unroll
        for (int i = 0; i < 4; ++i) { const int col = lane * 4 + 256 * i;
            const float4 g = *(const float4*)(gain + col), s4 = *(const float4*)(sh + col), c4 = *(const float4*)(sc + col);
            const float o0 = v[i].x * rstd * g.x * (1.f + c4.x) + s4.x, o1 = v[i].y * rstd * g.y * (1.f + c4.y) + s4.y,
                        o2 = v[i].z * rstd * g.z * (1.f + c4.z) + s4.z, o3 = v[i].w * rstd * g.w * (1.f + c4.w) + s4.w;
            *(uint2*)(A + (size_t)row * DM + col) = make_uint2(pk2(o0, o1), pk2(o2, o3)); }
    }
}
__device__ void phase_finalnorm(const P& p) {
    const int lane = opaque_tid() & 63, wave = threadIdx.x >> 6;
    for (int row = blockIdx.x * 8 + wave; row < MT; row += gridDim.x * 8) {
        float* src = p.out + (size_t)row * DM;
        float4 v[4]; float ss = 0.f;
#pragma unroll
        for (int i = 0; i < 4; ++i) { v[i] = *(const float4*)(src + lane * 4 + 256 * i); ss += v[i].x * v[i].x + v[i].y * v[i].y + v[i].z * v[i].z + v[i].w * v[i].w; }
#pragma unroll
        for (int o = 32; o >= 1; o >>= 1) ss += __shfl_xor(ss, o);
        const float rstd = rsqrtf(ss * (1.f / 1024.f) + 1e-6f);
#pragma unroll
        for (int i = 0; i < 4; ++i) { const int col = lane * 4 + 256 * i; const float4 g = *(const float4*)(p.nf + col);
            *(float4*)(src + col) = make_float4(v[i].x * rstd * g.x, v[i].y * rstd * g.y, v[i].z * rstd * g.z, v[i].w * rstd * g.w); }
    }
}

struct EpiSwiglu {
    static constexpr bool PERM = true;
    bf16_t* O;
    __device__ __forceinline__ void operator()(const f32x4 (&acc)[2][2][4][2], const pg8::Unit& u, int wr, int wc, int fr, int fq) const {
        const int row0 = u.pm * 256 + wr * 64 + fr, col0 = u.pn * 128 + wc * 32 + 8 * fq;
#pragma unroll
        for (int ai = 0; ai < 2; ++ai)
#pragma unroll
            for (int m = 0; m < 4; ++m) { bf16_t* rowp = O + (size_t)(row0 + ai * 128 + m * 16) * DFF + col0;
                float r[8];
#pragma unroll
                for (int n = 0; n < 2; ++n)
#pragma unroll
                    for (int j = 0; j < 4; ++j) r[n * 4 + j] = siluf(acc[ai][0][m][n][j]) * acc[ai][1][m][n][j];
                pg8::u32x4 w; w.x = pg8::cvt_pk_bf16(r[0], r[1]); w.y = pg8::cvt_pk_bf16(r[2], r[3]); w.z = pg8::cvt_pk_bf16(r[4], r[5]); w.w = pg8::cvt_pk_bf16(r[6], r[7]);
                *(pg8::u32x4*)rowp = w; }
    }
};
struct EpiResid {
    static constexpr bool PERM = false;
    const float* xp; const float* xs; float* out; const float* ga; float coef; int inplace;
    __device__ __forceinline__ void operator()(const f32x4 (&acc)[2][2][4][2], const pg8::Unit& u, int wr, int wc, int fr, int fq) const {
        const int row0 = u.pm * 256 + wr * 64 + fr, col0 = u.pn * 256 + wc * 32 + 4 * fq;
        const float* gap = ga + cond_of(u.pm * 256) * MODW;
        f32x4 gv[2][2];
#pragma unroll
        for (int bj = 0; bj < 2; ++bj)
#pragma unroll
            for (int n = 0; n < 2; ++n) gv[bj][n] = *(const f32x4*)(gap + col0 + bj * 128 + n * 16) * coef;
#pragma unroll
        for (int ai = 0; ai < 2; ++ai)
#pragma unroll
            for (int m = 0; m < 4; ++m) { const int row = row0 + ai * 128 + m * 16;
                const float* base = inplace ? out + (size_t)row * DM : (row < NCTX ? xp + (size_t)row * DM : xs + (size_t)(row - NCTX) * DM);
                float* op = out + (size_t)row * DM;
#pragma unroll
                for (int bj = 0; bj < 2; ++bj)
#pragma unroll
                    for (int n = 0; n < 2; ++n) { const int c = col0 + bj * 128 + n * 16; const f32x4 b4 = *(const f32x4*)(base + c);
                        *(f32x4*)(op + c) = b4 + gv[bj][n] * acc[ai][bj][m][n]; } }
    }
};
struct EpiU {
    static constexpr bool PERM = true;
    bf16_t* U; float* gates;
    __device__ __forceinline__ void operator()(const f32x4 (&acc)[2][2][4][2], const pg8::Unit& u, int wr, int wc, int fr, int fq) const {
        const int row0 = u.pm * 256 + wr * 64 + fr;
#pragma unroll
        for (int bj = 0; bj < 2; ++bj) { const int col0 = u.pn * 256 + bj * 128 + wc * 32 + 8 * fq;
            if (col0 < UW) {
#pragma unroll
                for (int ai = 0; ai < 2; ++ai)
#pragma unroll
                    for (int m = 0; m < 4; ++m) { const int row = row0 + ai * 128 + m * 16; const f32x4 v0 = acc[ai][bj][m][0], v1 = acc[ai][bj][m][1];
                        pg8::u32x4 w; w.x = pg8::cvt_pk_bf16(v0[0], v0[1]); w.y = pg8::cvt_pk_bf16(v0[2], v0[3]); w.z = pg8::cvt_pk_bf16(v1[0], v1[1]); w.w = pg8::cvt_pk_bf16(v1[2], v1[3]);
                        *(pg8::u32x4*)(U + (size_t)row * UW + col0) = w;
                        if (col0 >= 3968) { float* gp = gates + (size_t)row * 16 + (col0 - 3968); *(f32x4*)gp = v0; *(f32x4*)(gp + 4) = v1; } } } }
    }
};

template <class Epi>
__device__ __forceinline__ void run_gemm(unsigned char* lds, const bf16_t* A, const bf16_t* Bt, int N, int K, const Epi& E) {
    pg8::Gemm g{A, Bt, MT, N, K}; pg8::StaticOrder S; S.init(MT, N, (int)gridDim.x, (int)blockIdx.x);
    pg8::gemm_phase<Epi, pg8::StaticOrder, true, true>((PG8_LAS unsigned char*)lds, g, S, E);
}

constexpr int ML_SK = 0, ML_KWT = 17408, ML_VT = ML_KWT + 18432, ML_CB = ML_VT + 20736, ML_F = ML_CB + 21760, ML_CW = ML_F + 2048, ML_END = ML_CW + 4096;
static_assert(ML_END <= LDS_BYTES, "mlstm lds");

__device__ __forceinline__ unsigned short ld_u16_agent(const bf16_t* p) { return __hip_atomic_load(p, __ATOMIC_RELAXED, __HIP_MEMORY_SCOPE_AGENT); }

__device__ __forceinline__ void conv3_row8(const bf16_t* up, bool hasp, bool hasn, const float* cwp, float* x) {
    float t[8];
    unpack8(*(const uint4*)up, t);
#pragma unroll
    for (int i = 0; i < 8; ++i) x[i] = cwp[768 + i] + cwp[256 + i] * t[i];
    if (hasp) { unpack8(*(const uint4*)(up - UW), t);
#pragma unroll
        for (int i = 0; i < 8; ++i) x[i] += cwp[i] * t[i]; }
    if (hasn) { unpack8(*(const uint4*)(up + UW), t);
#pragma unroll
        for (int i = 0; i < 8; ++i) x[i] += cwp[512 + i] * t[i]; }
}

__device__ __forceinline__ void mlstm_task(const P& p, unsigned char* lds, int bg, int h) {
    const int wv = __builtin_amdgcn_readfirstlane((int)threadIdx.x >> 6), rw = wv & 3, cw = wv >> 2;
    const bool ctx = bg < 32; const int T = ctx ? 256 : 2048, nc = T / 64; const int row0 = ctx ? bg * 256 : NCTX + (bg - 32) * 2048;
    bf16_t* sK = (bf16_t*)(lds + ML_SK); bf16_t* sKwT = (bf16_t*)(lds + ML_KWT); bf16_t* sVT = (bf16_t*)(lds + ML_VT); bf16_t* sCb = (bf16_t*)(lds + ML_CB); bf16_t* sS = sCb;
    float* sA = (float*)(lds + ML_F); float* sM = sA + 64; float* sBb = sM + 64; float* sDen = sBb + 64; float* sScal = sDen + 64; float* sRed = sScal + 16;
    float* sCW = (float*)(lds + ML_CW);
    const bf16_t* U = (const bf16_t*)(p.ws + WS_U); const float* GATES = (const float*)(p.ws + WS_GATES); bf16_t* HB = (bf16_t*)(p.ws + WS_A);
    const int ct_a = cw ? 3 : 0;
    const int ct_b = cw ? 7 : 5;
    const int n_a = cw ? 2 : 3;

    __syncthreads();
    { const int tid = threadIdx.x;
      for (int i = tid; i < 1024; i += NTHR) { const int a = i >> 8, cc = i & 255, gch = (cc >> 7) * 512 + h * 128 + (cc & 127); sCW[i] = a < 3 ? p.cw[a * 1024 + gch] : p.cb[gch]; }
      for (int i = tid; i < 16 * 72; i += NTHR) { const int r = 128 + i / 72; sVT[r * 72 + (i % 72)] = (r == 128) ? (bf16_t)0x3F80 : (bf16_t)0; } }

#pragma unroll 1
    for (int dir = 0; dir < 2; ++dir) {
        f32x4 Cacc[9]; float m_prev = 0.f;
        { int z0 = 0; asm volatile("" : "+v"(z0)); const int tid = (int)threadIdx.x + z0, fr = tid & 15, fq = (tid >> 4) & 3;
#pragma unroll
          for (int ct = 0; ct < 9; ++ct) Cacc[ct] = (f32x4){0.f, 0.f, 0.f, 0.f};
          if (!ctx) { const int sidx = ((bg - 32) * 2 + dir) * 4 + h; const float* C0 = p.sC + (size_t)sidx * 16384; const float* n0 = p.sn + (size_t)sidx * 128;
#pragma unroll
              for (int j = 0; j < 4; ++j) { const int d = 16 * wv + 4 * fq + j;
#pragma unroll
                  for (int ct = 0; ct < 8; ++ct) Cacc[ct][j] = C0[d * 128 + 16 * ct + fr];
                  Cacc[8][j] = fr == 0 ? n0[d] : 0.f; }
              m_prev = p.sm[sidx]; } }
        const float gbi = p.gb[dir * 4 + h], gbf = p.gb[8 + dir * 4 + h];
        const bool second = dir == 1;
#pragma unroll 1
        for (int s = 0; s < nc; ++s) {
            const int c = dir ? nc - 1 - s : s;
            int zz = 0; asm volatile("" : "+v"(zz));
            const int tid = (int)threadIdx.x + zz, lane = tid & 63, fr = tid & 15, fq = (tid >> 4) & 3;
            __syncthreads();
            if (wv == 0) {
                const int tl = dir ? 63 - lane : lane; const size_t row = (size_t)row0 + c * 64 + tl;
                const float ip = GATES[row * 16 + dir * 4 + h] + gbi, fp = GATES[row * 16 + 8 + dir * 4 + h] + gbf;
                const float lf = -softplus_fast(-fp);
                float bs = lf;
#pragma unroll
                for (int o = 1; o < 64; o <<= 1) { const float t = __shfl_up(bs, o); if (lane >= o) bs += t; }
                const float a = ip - bs; float pm = a;
#pragma unroll
                for (int o = 1; o < 64; o <<= 1) { const float t = __shfl_up(pm, o); if (lane >= o) pm = fmaxf(pm, t); }
                const float Mt = fmaxf(m_prev, pm);
                sA[lane] = a; sM[lane] = Mt; sBb[lane] = bs;
                if (lane == 63) { sScal[0] = Mt; sScal[1] = bs; }
            }
            __syncthreads();
            const float M63 = sScal[0], bL = sScal[1];
#pragma unroll 1
            for (int g = 0; g < 2; ++g) {
                const int idx = tid + 512 * g, sl = idx >> 4, d0 = (idx & 15) * 8;
                const int tl = dir ? 63 - sl : sl, tok = c * 64 + tl; const size_t row = (size_t)row0 + tok;
                const int ch = 512 + h * 128 + d0;
                const float wk = __expf(sA[sl] - M63);
                float kv[8];
                conv3_row8(U + row * UW + ch, tok > 0, tok < T - 1, sCW + 128 + d0, kv);
#pragma unroll
                for (int i = 0; i < 8; ++i) kv[i] = siluf(kv[i]) * 0.08838834764831845f;
                *(uint4*)(sK + sl * 136 + d0) = make_uint4(pk2(kv[0], kv[1]), pk2(kv[2], kv[3]), pk2(kv[4], kv[5]), pk2(kv[6], kv[7]));
#pragma unroll
                for (int i = 0; i < 8; ++i) sKwT[(d0 + i) * 72 + sl] = f2bf(kv[i] * wk);
                const uint4 vv = *(const uint4*)(U + row * UW + 1024 + h * 128 + d0);
                const unsigned vw[4] = {vv.x, vv.y, vv.z, vv.w};
#pragma unroll
                for (int i = 0; i < 8; ++i) sVT[(d0 + i) * 72 + sl] = (bf16_t)((vw[i >> 1] >> ((i & 1) * 16)) & 0xffffu);
            }
            bf16x8 qf[4];
            { const int t_ = 16 * rw + fr, tl = dir ? 63 - t_ : t_, tok = c * 64 + tl; const size_t row = (size_t)row0 + tok;
#pragma unroll
              for (int kk = 0; kk < 4; ++kk) { const int ch = h * 128 + 32 * kk + 8 * fq;
                  float qv[8];
                  conv3_row8(U + row * UW + ch, tok > 0, tok < T - 1, sCW + 32 * kk + 8 * fq, qv);
#pragma unroll
                  for (int i = 0; i < 8; ++i) qv[i] = siluf(qv[i]);
                  union { uint4 u; bf16x8 v; } cv; cv.u = make_uint4(pk2(qv[0], qv[1]), pk2(qv[2], qv[3]), pk2(qv[4], qv[5]), pk2(qv[6], qv[7])); qf[kk] = cv.v; } }
            f32x4 num[5];
#pragma unroll
            for (int k = 0; k < 5; ++k) num[k] = (f32x4){0.f, 0.f, 0.f, 0.f};
#pragma unroll
            for (int ci = 0; ci < 5; ++ci) { const f32x4 v = Cacc[ci]; *(uint2*)(sCb + (16 * ci + fr) * 136 + 16 * wv + 4 * fq) = make_uint2(pk2(v[0], v[1]), pk2(v[2], v[3])); }
            __syncthreads();
#pragma unroll
            for (int k = 0; k < 3; ++k) if (k < n_a) {
#pragma unroll
                for (int kk = 0; kk < 4; ++kk) { const bf16x8 b = *(const bf16x8*)(sCb + (16 * (ct_a + k) + fr) * 136 + 32 * kk + 8 * fq); num[k] = mfma16(qf[kk], b, num[k]); } }
            __syncthreads();
#pragma unroll
            for (int ci = 0; ci < 4; ++ci) { const f32x4 v = Cacc[5 + ci]; *(uint2*)(sCb + (16 * ci + fr) * 136 + 16 * wv + 4 * fq) = make_uint2(pk2(v[0], v[1]), pk2(v[2], v[3])); }
            __syncthreads();
#pragma unroll
            for (int k = 3; k < 5; ++k) {
#pragma unroll
                for (int kk = 0; kk < 4; ++kk) { const bf16x8 b = *(const bf16x8*)(sCb + (16 * (ct_b + k - 3 - 5) + fr) * 136 + 32 * kk + 8 * fq); num[k] = mfma16(qf[kk], b, num[k]); } }
            {
                float scv[4];
#pragma unroll
                for (int j = 0; j < 4; ++j) scv[j] = __expf(m_prev - sM[16 * rw + 4 * fq + j]);
#pragma unroll
                for (int k = 0; k < 5; ++k)
#pragma unroll
                    for (int j = 0; j < 4; ++j) num[k][j] *= scv[j];
            }
            __syncthreads();
#pragma unroll
            for (int si = 0; si < 2; ++si) { const int st = 2 * cw + si;
                f32x4 sacc = (f32x4){0.f, 0.f, 0.f, 0.f};
                if (st <= rw) {
#pragma unroll
                    for (int kk = 0; kk < 4; ++kk) { const bf16x8 b = *(const bf16x8*)(sK + (16 * st + fr) * 136 + 32 * kk + 8 * fq); sacc = mfma16(qf[kk], b, sacc); } }
                const int sp = 16 * st + fr; const float as = sA[sp];
#pragma unroll
                for (int j = 0; j < 4; ++j) { const int tp = 16 * rw + 4 * fq + j; const float val = (sp <= tp) ? sacc[j] * __expf(as - sM[tp]) : 0.f; sS[tp * 72 + sp] = f2bf(val); }
            }
            __syncthreads();
#pragma unroll
            for (int ks = 0; ks < 2; ++ks) { const bf16x8 a = *(const bf16x8*)(sS + (16 * rw + fr) * 72 + 32 * ks + 8 * fq);
#pragma unroll
                for (int k = 0; k < 5; ++k) { const int ct = k < 3 ? ct_a + k : ct_b + k - 3;
                    if (k != 2 || cw == 0) { const bf16x8 b = *(const bf16x8*)(sVT + (16 * ct + fr) * 72 + 32 * ks + 8 * fq); num[k] = mfma16(a, b, num[k]); } } }
            if (cw == 1 && fr == 0) {
#pragma unroll
                for (int j = 0; j < 4; ++j) sDen[16 * rw + 4 * fq + j] = num[4][j]; }
            __syncthreads();
            float inv[4];
#pragma unroll
            for (int j = 0; j < 4; ++j) { const int tp = 16 * rw + 4 * fq + j; const float den = sDen[tp]; inv[j] = __builtin_amdgcn_rcpf(fmaxf(fabsf(den), __expf(-(sBb[tp] + sM[tp])))); }
            if (!second) {
#pragma unroll
                for (int j = 0; j < 4; ++j) { const int tp = 16 * rw + 4 * fq + j, tl = dir ? 63 - tp : tp; const size_t row = (size_t)row0 + c * 64 + tl;
                    bf16_t* hb = HB + row * DM + h * 128;
#pragma unroll
                    for (int k = 0; k < 5; ++k) { const int ct = k < 3 ? ct_a + k : ct_b + k - 3; if ((k != 2 || cw == 0) && ct < 8) hb[16 * ct + fr] = f2bf(num[k][j] * inv[j]); } }
            } else {
                float ssr[4];
#pragma unroll
                for (int j = 0; j < 4; ++j) { const int tp = 16 * rw + 4 * fq + j, tl = dir ? 63 - tp : tp; const size_t row = (size_t)row0 + c * 64 + tl;
                    const bf16_t* hb = HB + row * DM + h * 128; float ss = 0.f;
#pragma unroll
                    for (int k = 0; k < 5; ++k) { const int ct = k < 3 ? ct_a + k : ct_b + k - 3;
                        if ((k != 2 || cw == 0) && ct < 8) { const int e = 16 * ct + fr; const float other = bf2f(ld_u16_agent(hb + e)); const float hs = num[k][j] * inv[j] + other;
                            const float o = sigmf(bf2f(U[row * UW + 1536 + h * 128 + e])); const float v = o * hs; ss += v * v; num[k][j] = v; } }
                    ss += __shfl_xor(ss, 1); ss += __shfl_xor(ss, 2); ss += __shfl_xor(ss, 4); ss += __shfl_xor(ss, 8);
                    ssr[j] = ss; if (fr == 0) sRed[cw * 64 + tp] = ss; }
                __syncthreads();
#pragma unroll
                for (int j = 0; j < 4; ++j) { const int tp = 16 * rw + 4 * fq + j, tl = dir ? 63 - tp : tp; const size_t row = (size_t)row0 + c * 64 + tl;
                    bf16_t* hb = HB + row * DM + h * 128; const float rms = rsqrtf((ssr[j] + sRed[(1 - cw) * 64 + tp]) * (1.f / 128.f) + 1e-6f);
#pragma unroll
                    for (int k = 0; k < 5; ++k) { const int ct = k < 3 ? ct_a + k : ct_b + k - 3;
                        if ((k != 2 || cw == 0) && ct < 8) { const int e = 16 * ct + fr; hb[e] = f2bf(num[k][j] * rms * p.hg[h * 128 + e]); } } }
            }
            const float decay = __expf(m_prev - M63);
#pragma unroll
            for (int ct = 0; ct < 9; ++ct) Cacc[ct] = Cacc[ct] * decay;
#pragma unroll
            for (int ks = 0; ks < 2; ++ks) { const bf16x8 a = *(const bf16x8*)(sKwT + (16 * wv + fr) * 72 + 32 * ks + 8 * fq);
#pragma unroll
                for (int ct = 0; ct < 9; ++ct) { const bf16x8 b = *(const bf16x8*)(sVT + (16 * ct + fr) * 72 + 32 * ks + 8 * fq); Cacc[ct] = mfma16(a, b, Cacc[ct]); } }
            m_prev = bL + M63;
        }
        if (ctx) { const int sidx = (bg * 2 + dir) * 4 + h; float* Co = p.out + OUT_C + (size_t)sidx * 16384;
            int z1 = 0; asm volatile("" : "+v"(z1)); const int tid1 = (int)threadIdx.x + z1, fr1 = tid1 & 15, fq1 = (tid1 >> 4) & 3;
#pragma unroll
            for (int j = 0; j < 4; ++j) { const int d = 16 * wv + 4 * fq1 + j;
#pragma unroll
                for (int ct = 0; ct < 8; ++ct) Co[d * 128 + 16 * ct + fr1] = Cacc[ct][j];
                if (fr1 == 0) p.out[OUT_N + sidx * 128 + d] = Cacc[8][j]; }
            if (tid1 == 0) p.out[OUT_MM + sidx] = m_prev; }
        __syncthreads();
    }
}

constexpr int RW_TC = 16;
constexpr int RW_VEC = 0, RW_V = RW_VEC + 16 * 320 * 4, RW_KR = RW_V + 16 * 32 * 4, RW_XW = RW_KR + 16 * 64 * 4, RW_XA = RW_XW + 16 * 72 * 2, RW_Y = RW_XA + 16 * 72 * 2,
              RW_MU = RW_Y + 16 * 32 * 4, RW_DIR = RW_MU + 4 * 288 * 4;
static_assert(2 * RW_DIR <= LDS_BYTES && RW_DIR % 16 == 0, "rwkv lds");

__device__ __forceinline__ float dppf(float x, const int ctrl) { return x; }
#define DPP_ADD(x, ctrl) ((x) + __int_as_float(__builtin_amdgcn_update_dpp(0, __float_as_int(x), (ctrl), 0xf, 0xf, true)))
__device__ __forceinline__ float red8(float x) { x = DPP_ADD(x, 0xB1); x = DPP_ADD(x, 0x4E); x = DPP_ADD(x, 0x141); return x; }
__device__ __forceinline__ float red16(float x) { x = red8(x); x = DPP_ADD(x, 0x140); return x; }

struct Sh8 { uint4 x, l, r, u, d; };
__device__ __forceinline__ void sh8_load(Sh8& q, const bf16_t* U, size_t row0, int tok, int T, bool grid, int c0) {
    const bf16_t* b = U + (row0 + tok) * UW + c0; const uint4 z = make_uint4(0u, 0u, 0u, 0u);
    const bool hl = grid ? (tok & 63) != 0 : tok > 0, hr = grid ? (tok & 63) != 63 : tok < T - 1;
    q.x = *(const uint4*)b;
    q.l = hl ? *(const uint4*)(b - UW) : z; q.r = hr ? *(const uint4*)(b + UW) : z;
    q.u = (grid && tok >= 64) ? *(const uint4*)(b - 64 * (long)UW) : z; q.d = (grid && tok < T - 64) ? *(const uint4*)(b + 64 * (long)UW) : z;
}
__device__ __forceinline__ void sh8_mix(const Sh8& q, bool grid, const float* mu4, int mustride, float* o) {
    float x[8], t[8], m[8], ms[8];
    unpack8(q.x, x);
    { const float4 a = *(const float4*)mu4, b = *(const float4*)(mu4 + 4); m[0] = a.x; m[1] = a.y; m[2] = a.z; m[3] = a.w; m[4] = b.x; m[5] = b.y; m[6] = b.z; m[7] = b.w; }
    unpack8(q.l, t);
#pragma unroll
    for (int i = 0; i < 8; ++i) { o[i] = m[i] * t[i]; ms[i] = m[i]; }
    { const float4 a = *(const float4*)(mu4 + mustride), b = *(const float4*)(mu4 + mustride + 4); m[0] = a.x; m[1] = a.y; m[2] = a.z; m[3] = a.w; m[4] = b.x; m[5] = b.y; m[6] = b.z; m[7] = b.w; }
    unpack8(q.r, t);
#pragma unroll
    for (int i = 0; i < 8; ++i) { o[i] += m[i] * t[i]; ms[i] += m[i]; }
    if (grid) {
        { const float4 a = *(const float4*)(mu4 + 2 * mustride), b = *(const float4*)(mu4 + 2 * mustride + 4); m[0] = a.x; m[1] = a.y; m[2] = a.z; m[3] = a.w; m[4] = b.x; m[5] = b.y; m[6] = b.z; m[7] = b.w; }
        unpack8(q.u, t);
#pragma unroll
        for (int i = 0; i < 8; ++i) { o[i] += m[i] * t[i]; ms[i] += m[i]; }
        { const float4 a = *(const float4*)(mu4 + 3 * mustride), b = *(const float4*)(mu4 + 3 * mustride + 4); m[0] = a.x; m[1] = a.y; m[2] = a.z; m[3] = a.w; m[4] = b.x; m[5] = b.y; m[6] = b.z; m[7] = b.w; }
        unpack8(q.d, t);
#pragma unroll
        for (int i = 0; i < 8; ++i) { o[i] += m[i] * t[i]; ms[i] += m[i]; }
    }
#pragma unroll
    for (int i = 0; i < 8; ++i) o[i] += x[i] * (1.f - ms[i]);
}
__device__ __forceinline__ void shifted8(const bf16_t* U, size_t row0, int tok, int T, bool grid, int c0, const float* mu4, int mustride, float* o) {
    Sh8 q; sh8_load(q, U, row0, tok, T, grid, c0); sh8_mix(q, grid, mu4, mustride, o);
}
typedef float f32x2 __attribute__((ext_vector_type(2)));

__device__ __forceinline__ void rwkv_task(const P& p, unsigned char* lds, int bg, int h, int rh) {
    const int wv = __builtin_amdgcn_readfirstlane((int)threadIdx.x >> 6), dir = wv >> 2, lw = wv & 3;
    const bool ctx = bg < 32; const int T = ctx ? 256 : 2048, nc = T / RW_TC; const size_t row0 = ctx ? (size_t)bg * 256 : (size_t)NCTX + (size_t)(bg - 32) * 2048;
    const bool grid = !ctx;
    unsigned char* L = lds + dir * RW_DIR;
    float* sVec = (float*)(L + RW_VEC); float* sV = (float*)(L + RW_V); float* sKr = (float*)(L + RW_KR); bf16_t* sXw = (bf16_t*)(L + RW_XW); bf16_t* sXa = (bf16_t*)(L + RW_XA);
    float* sY = (float*)(L + RW_Y); float* sMu = (float*)(L + RW_MU);
    const bf16_t* U = (const bf16_t*)(p.ws + WS_U); bf16_t* HB = (bf16_t*)(p.ws + WS_A);
    const int hc = h * 64;
    float st[8]; bf16x8 wfrag[2], afrag[2]; float w0v, a0v, kav;
    {
        const int tid = opaque_tid(), ltid = tid & 255, ri = ltid >> 3, jq = ltid & 7, fr = tid & 15, fq = (tid >> 4) & 3;
        __syncthreads();
        for (int i = ltid; i < 4 * 288; i += 256) { const int a = i / 288, mc = i % 288;
            const int rc = mc < 64 ? hc + mc : (mc < 128 ? 512 + hc + mc - 64 : (mc < 160 ? 1024 + hc + 32 * rh + mc - 128 : (mc < 224 ? 1536 + dir * 64 + mc - 160 : 1664 + dir * 64 + mc - 224)));
            sMu[i] = p.mu[a * 1920 + rc]; }
        if (ctx) {
#pragma unroll
            for (int q = 0; q < 8; ++q) st[q] = 0.f;
        } else { const float* S0 = p.sS + ((size_t)(((bg - 32) * 2 + dir) * 8 + h)) * 4096 + (32 * rh + ri) * 64 + jq * 8;
#pragma unroll
            for (int q = 0; q < 8; ++q) st[q] = S0[q]; }
        const int jcol = hc + 16 * lw + fr;
#pragma unroll
        for (int ks = 0; ks < 2; ++ks) { float wf[8], af[8];
#pragma unroll
            for (int i = 0; i < 8; ++i) { const int l = 32 * ks + 8 * fq + i; wf[i] = p.w2[(size_t)(dir * 64 + l) * 512 + jcol]; af[i] = p.a2[(size_t)(dir * 64 + l) * 512 + jcol]; }
            union { uint4 u; bf16x8 v; } c1, c2; c1.u = make_uint4(pk2(wf[0], wf[1]), pk2(wf[2], wf[3]), pk2(wf[4], wf[5]), pk2(wf[6], wf[7])); c2.u = make_uint4(pk2(af[0], af[1]), pk2(af[2], af[3]), pk2(af[4], af[5]), pk2(af[6], af[7]));
            wfrag[ks] = c1.v; afrag[ks] = c2.v; }
        w0v = p.w0[dir * 512 + jcol]; a0v = p.a0[dir * 512 + jcol]; kav = p.ka[jcol];
    }
    Sh8 q1, q2, q3;
    { const int tid = opaque_tid(), ltid = tid & 255; const int c = dir ? nc - 1 : 0, tok0 = c * RW_TC; const int tl = (ltid & 127) >> 3, g = ltid & 7;
      sh8_load(q1, U, row0, tok0 + tl, T, grid, (lw < 2 ? 2048 : 2048 + 512) + hc + 8 * g);
      sh8_load(q2, U, row0, tok0 + tl, T, grid, (lw < 2 ? 2048 + 1536 : 2048 + 1664) + dir * 64 + 8 * g);
      if (lw == 0) sh8_load(q3, U, row0, tok0 + (ltid >> 2), T, grid, 2048 + 1024 + hc + 32 * rh + 8 * (ltid & 3)); }
    f32x2 st2[4];
#pragma unroll
    for (int q = 0; q < 4; ++q) st2[q] = (f32x2){st[2 * q], st[2 * q + 1]};
#pragma unroll 1
    for (int s = 0; s < nc; ++s) {
        const int c = dir ? nc - 1 - s : s; const int tok0 = c * RW_TC;
        const bool second = s >= (nc >> 1);
        const int tid = opaque_tid(), ltid = tid & 255, ri = ltid >> 3, jq = ltid & 7, fr = tid & 15, fq = (tid >> 4) & 3;
        __syncthreads();
        { const int tl = (ltid & 127) >> 3, g = ltid & 7; float o[8];
          if (lw < 2) {
              sh8_mix(q1, grid, sMu + 8 * g, 288, o);
              *(float4*)(sVec + tl * 320 + 8 * g) = make_float4(o[0], o[1], o[2], o[3]); *(float4*)(sVec + tl * 320 + 8 * g + 4) = make_float4(o[4], o[5], o[6], o[7]);
          } else {
              sh8_mix(q1, grid, sMu + 64 + 8 * g, 288, o);
              float kkr[8]; float ss = 0.f;
#pragma unroll
              for (int i = 0; i < 8; ++i) { kkr[i] = o[i] * p.kk[hc + 8 * g + i]; ss += kkr[i] * kkr[i]; }
              ss = red8(ss); const float rn = __builtin_amdgcn_rsqf(fmaxf(ss, 1e-24f));
              *(float4*)(sKr + tl * 64 + 8 * g) = make_float4(o[0], o[1], o[2], o[3]); *(float4*)(sKr + tl * 64 + 8 * g + 4) = make_float4(o[4], o[5], o[6], o[7]);
              *(float4*)(sVec + tl * 320 + 192 + 8 * g) = make_float4(kkr[0] * rn, kkr[1] * rn, kkr[2] * rn, kkr[3] * rn); *(float4*)(sVec + tl * 320 + 192 + 8 * g + 4) = make_float4(kkr[4] * rn, kkr[5] * rn, kkr[6] * rn, kkr[7] * rn);
          }
          if (lw < 2) {
              sh8_mix(q2, grid, sMu + 160 + 8 * g, 288, o);
#pragma unroll
              for (int i = 0; i < 8; ++i) o[i] = tanh_fast(o[i]);
              *(uint4*)(sXw + tl * 72 + 8 * g) = make_uint4(pk2(o[0], o[1]), pk2(o[2], o[3]), pk2(o[4], o[5]), pk2(o[6], o[7]));
          } else {
              sh8_mix(q2, grid, sMu + 224 + 8 * g, 288, o);
              *(uint4*)(sXa + tl * 72 + 8 * g) = make_uint4(pk2(o[0], o[1]), pk2(o[2], o[3]), pk2(o[4], o[5]), pk2(o[6], o[7]));
          }
          if (lw == 0) {
              const int tl2 = ltid >> 2, g2 = ltid & 3;
              sh8_mix(q3, grid, sMu + 128 + 8 * g2, 288, o);
              *(float4*)(sV + tl2 * 32 + 8 * g2) = make_float4(o[0], o[1], o[2], o[3]); *(float4*)(sV + tl2 * 32 + 8 * g2 + 4) = make_float4(o[4], o[5], o[6], o[7]);
          } }
        __syncthreads();
        { f32x4 aw = (f32x4){0.f, 0.f, 0.f, 0.f}, aa = (f32x4){0.f, 0.f, 0.f, 0.f};
#pragma unroll
          for (int ks = 0; ks < 2; ++ks) { const bf16x8 xw = *(const bf16x8*)(sXw + fr * 72 + 32 * ks + 8 * fq), xa = *(const bf16x8*)(sXa + fr * 72 + 32 * ks + 8 * fq);
              aw = mfma16(xw, wfrag[ks], aw); aa = mfma16(xa, afrag[ks], aa); }
          const int j = 16 * lw + fr;
#pragma unroll
          for (int jj = 0; jj < 4; ++jj) { const int tl = 4 * fq + jj;
              const float dec = __expf(-__expf(-softplus_fast(-(w0v + aw[jj])) - 0.5f));
              const float a = sigmf(a0v + aa[jj]); const float k = sKr[tl * 64 + j], kn = sVec[tl * 320 + 192 + j];
              float* V = sVec + tl * 320 + j; V[64] = dec; V[128] = k * (1.f + (a - 1.f) * kav); V[256] = kn * a; } }
        const int otl = ltid >> 4, opr = ltid & 15; unsigned* hb = (unsigned*)(HB + (row0 + tok0 + otl) * DM + 512 + hc + 32 * rh + 2 * opr);
        unsigned ov = 0u;
        if (second) ov = __hip_atomic_load(hb, __ATOMIC_RELAXED, __HIP_MEMORY_SCOPE_AGENT);
        if (s + 1 < nc) { const int cn = dir ? nc - 2 - s : s + 1, tokn = cn * RW_TC; const int tl = (ltid & 127) >> 3, g = ltid & 7;
            sh8_load(q1, U, row0, tokn + tl, T, grid, (lw < 2 ? 2048 : 2048 + 512) + hc + 8 * g);
            sh8_load(q2, U, row0, tokn + tl, T, grid, (lw < 2 ? 2048 + 1536 : 2048 + 1664) + dir * 64 + 8 * g);
            if (lw == 0) sh8_load(q3, U, row0, tokn + (ltid >> 2), T, grid, 2048 + 1024 + hc + 32 * rh + 8 * (ltid & 3)); }
        __syncthreads();
        f32x2 sv_[4];
#pragma unroll
        for (int q = 0; q < 4; ++q) sv_[q] = st2[q];
#pragma unroll 1
        for (int rep = 0; rep < (PROBE_DUP == 102 ? 2 : 1); ++rep) {
        if (PROBE_DUP == 102) {
#pragma unroll
            for (int q = 0; q < 4; ++q) st2[q] = sv_[q]; }
#pragma unroll 2
        for (int step = 0; step < RW_TC; ++step) { const int tl = dir ? RW_TC - 1 - step : step; const float* V = sVec + tl * 320 + jq * 8;
            const float4 ka4 = *(const float4*)(V + 192), kb4 = *(const float4*)(V + 196);
            f32x2 acc = st2[0] * (f32x2){ka4.x, ka4.y}; acc = st2[1] * (f32x2){ka4.z, ka4.w} + acc; acc = st2[2] * (f32x2){kb4.x, kb4.y} + acc; acc = st2[3] * (f32x2){kb4.z, kb4.w} + acc;
            const float sa = -red8(acc.x + acc.y);
            const float vi = sV[tl * 32 + ri];
            const float4 wa = *(const float4*)(V + 64), wb = *(const float4*)(V + 68), ba = *(const float4*)(V + 256), bb = *(const float4*)(V + 260),
                         da = *(const float4*)(V + 128), db = *(const float4*)(V + 132), ra = *(const float4*)(V), rb = *(const float4*)(V + 4);
            const f32x2 sa2 = (f32x2){sa, sa}, vi2 = (f32x2){vi, vi};
            st2[0] = st2[0] * (f32x2){wa.x, wa.y} + (sa2 * (f32x2){ba.x, ba.y} + vi2 * (f32x2){da.x, da.y});
            st2[1] = st2[1] * (f32x2){wa.z, wa.w} + (sa2 * (f32x2){ba.z, ba.w} + vi2 * (f32x2){da.z, da.w});
            st2[2] = st2[2] * (f32x2){wb.x, wb.y} + (sa2 * (f32x2){bb.x, bb.y} + vi2 * (f32x2){db.x, db.y});
            st2[3] = st2[3] * (f32x2){wb.z, wb.w} + (sa2 * (f32x2){bb.z, bb.w} + vi2 * (f32x2){db.z, db.w});
            f32x2 ya = st2[0] * (f32x2){ra.x, ra.y}; ya = st2[1] * (f32x2){ra.z, ra.w} + ya; ya = st2[2] * (f32x2){rb.x, rb.y} + ya; ya = st2[3] * (f32x2){rb.z, rb.w} + ya;
            const float y = red8(ya.x + ya.y);
            if (jq == 0) sY[tl * 32 + ri] = y; }
        }
        __syncthreads();
        { float y0 = sY[otl * 32 + 2 * opr], y1 = sY[otl * 32 + 2 * opr + 1];
          if (second) { y0 += __uint_as_float(ov << 16); y1 += __uint_as_float(ov & 0xffff0000u); }
          *hb = pk2(y0, y1); }
    }
#pragma unroll
    for (int q = 0; q < 4; ++q) { st[2 * q] = st2[q].x; st[2 * q + 1] = st2[q].y; }
    if (ctx) { const int tid = opaque_tid(), ltid = tid & 255, ri = ltid >> 3, jq = ltid & 7;
        float* So = p.out + OUT_S + ((size_t)((bg * 2 + dir) * 8 + h)) * 4096 + (32 * rh + ri) * 64 + jq * 8;
#pragma unroll
        for (int q = 0; q < 8; ++q) So[q] = st[q]; }
    __syncthreads();
}

constexpr int FZ_ROW = 1800;
constexpr int FZ_X = 0, FZ_MU = 32 * FZ_ROW * 2, FZ_END = FZ_MU + 4 * 1792 * 4;
static_assert(FZ_END <= LDS_BYTES && FZ_MU % 16 == 0, "finalize lds");

__device__ __forceinline__ void phase_rwkv_finalize(const P& p, unsigned char* lds) {
    bf16_t* sX = (bf16_t*)(lds + FZ_X); float* sMu = (float*)(lds + FZ_MU);
    const bf16_t* U = (const bf16_t*)(p.ws + WS_U); bf16_t* HB = (bf16_t*)(p.ws + WS_A);
    const bf16_t* A2 = (const bf16_t*)(p.ws + WS_A2BF); const bf16_t* G2 = (const bf16_t*)(p.ws + WS_G2BF);
    const int wv = __builtin_amdgcn_readfirstlane((int)threadIdx.x >> 6), hc = wv * 64;
    { const int tid = opaque_tid();
      __syncthreads();
      for (int i = tid; i < 4 * 1792; i += NTHR) { const int a = i / 1792, c = i % 1792; const int rc = c < 1536 ? c : c + 128; sMu[i] = p.mu[a * 1920 + rc]; } }
#pragma unroll 1
    for (int tile = blockIdx.x; tile < MT / 32; tile += gridDim.x) {
        const int tid = opaque_tid(), fr = tid & 15, fq = (tid >> 4) & 3;
        const int rowt = tile * 32; const bool ctx = rowt < NCTX; const int T = ctx ? 256 : 2048; const size_t row0 = ctx ? (size_t)(rowt & ~255) : (size_t)NCTX + (size_t)((rowt - NCTX) & ~2047);
        const int tokt = rowt - (int)row0;
        __syncthreads();
#pragma unroll 1
        for (int it = 0; it < 14; ++it) { const int item = it * NTHR + tid, tl = item / 224, gi = item % 224; float o[8];
            const int c0 = gi < 192 ? 2048 + 8 * gi : 2048 + 1664 + 8 * (gi - 192);
            shifted8(U, row0, tokt + tl, T, !ctx, c0, sMu + 8 * gi, 1792, o);
            if (gi >= 208) {
#pragma unroll
                for (int i = 0; i < 8; ++i) o[i] = sigmf(o[i]); }
            *(uint4*)(sX + tl * FZ_ROW + 8 * gi) = make_uint4(pk2(o[0], o[1]), pk2(o[2], o[3]), pk2(o[4], o[5]), pk2(o[6], o[7])); }
        __syncthreads();
#pragma unroll 1
        for (int rt = 0; rt < 2; ++rt) {
            f32x4 af[4], ab[4], gg[4];
#pragma unroll
            for (int ct = 0; ct < 4; ++ct) { af[ct] = (f32x4){0.f, 0.f, 0.f, 0.f}; ab[ct] = af[ct]; gg[ct] = af[ct]; }
            const bf16_t* xr = sX + (16 * rt + fr) * FZ_ROW;
#pragma unroll
            for (int ks = 0; ks < 2; ++ks) { const bf16x8 xf = *(const bf16x8*)(xr + 1536 + 32 * ks + 8 * fq), xb = *(const bf16x8*)(xr + 1600 + 32 * ks + 8 * fq);
#pragma unroll
                for (int ct = 0; ct < 4; ++ct) { const int n = hc + 16 * ct + fr;
                    af[ct] = mfma16(xf, *(const bf16x8*)(A2 + (size_t)n * 64 + 32 * ks + 8 * fq), af[ct]);
                    ab[ct] = mfma16(xb, *(const bf16x8*)(A2 + (size_t)(512 + n) * 64 + 32 * ks + 8 * fq), ab[ct]); } }
#pragma unroll
            for (int ks = 0; ks < 4; ++ks) { const bf16x8 xg = *(const bf16x8*)(xr + 1664 + 32 * ks + 8 * fq);
#pragma unroll
                for (int ct = 0; ct < 4; ++ct) { const int n = hc + 16 * ct + fr; gg[ct] = mfma16(xg, *(const bf16x8*)(G2 + (size_t)n * 128 + 32 * ks + 8 * fq), gg[ct]); } }
#pragma unroll
            for (int jj = 0; jj < 4; ++jj) { const int tl = 16 * rt + 4 * fq + jj; const size_t row = (size_t)rowt + tl; const bf16_t* xt = sX + tl * FZ_ROW;
                bf16_t* hb = HB + row * DM + 512 + hc;
                float y[4], vv[4]; float sy = 0.f, sb = 0.f;
#pragma unroll
                for (int ct = 0; ct < 4; ++ct) { const int ch = hc + 16 * ct + fr;
                    const float am = 0.5f * (sigmf(p.a0[ch] + af[ct][jj]) + sigmf(p.a0[512 + ch] + ab[ct][jj]));
                    const float r = bf2f(xt[ch]), k = bf2f(xt[512 + ch]); vv[ct] = bf2f(xt[1024 + ch]);
                    sb += r * k * (1.f + (am - 1.f) * p.ka[ch]) * p.rk[ch];
                    y[ct] = bf2f(hb[16 * ct + fr]); sy += y[ct]; }
                sy = red16(sy); sb = red16(sb);
                const float mean = sy * (1.f / 64.f); float vs = 0.f;
#pragma unroll
                for (int ct = 0; ct < 4; ++ct) { const float d = y[ct] - mean; vs += d * d; }
                vs = red16(vs); const float rstd = rsqrtf(vs * (1.f / 64.f) + 64e-5f);
#pragma unroll
                for (int ct = 0; ct < 4; ++ct) { const int ch = hc + 16 * ct + fr; const float yn = (y[ct] - mean) * rstd * p.lng[ch] + p.lnb[ch];
                    hb[16 * ct + fr] = f2bf((yn + sb * vv[ct]) * gg[ct][jj]); } }
        }
    }
}

__device__ __forceinline__ void scan_decode_task(int t, int& kind, int& bg, int& h, int& rh) {
    rh = 0;
    if (t < 32) { kind = 0; bg = 32 + t / 4; h = t % 4; }
    else if (t < 160) { const int q = t - 32; kind = 1; bg = 32 + q / 16; h = (q >> 1) & 7; rh = q & 1; }
    else if (t < 672) { const int q = t - 160; kind = 1; bg = q / 16; h = (q >> 1) & 7; rh = q & 1; }
    else { kind = 0; bg = (t - 672) / 4; h = (t - 672) % 4; }
}
__device__ __forceinline__ void phase_scan(const P& p, unsigned char* lds) {
    const int nb = gridDim.x, bid = blockIdx.x;
    int t = bid, step = nb;
    if (nb >= 200) { if (bid < 160) step = 100000; else step = nb - 160; }
#pragma unroll 1
    for (; t < 800; t += step) {
        int kind, bg, h, rh; scan_decode_task(t, kind, bg, h, rh);
        if (kind == 0) { mlstm_task(p, lds, bg, h); if (PROBE_DUP == 100) mlstm_task(p, lds, bg, h); } else { rwkv_task(p, lds, bg, h, rh); if (PROBE_DUP == 101) rwkv_task(p, lds, bg, h, rh); }
    }
}

__device__ void phase_convert_w2(const P& p, unsigned char* lds) {
    float* tile = (float*)lds;
    const int t1 = 16 * 88, t2 = 44 * 16;
    for (int it = blockIdx.x; it < t1 + t2; it += gridDim.x) {
        if (it < t1) do_convert(p.w2in, (bf16_t*)(p.ws + WS_W1), 1024, 5632, 5632, 1, it, tile);
        else do_convert(p.w2out, (bf16_t*)(p.ws + WS_W1B), 2816, 1024, 1024, 0, it - t1, tile);
    }
}

constexpr int NPHASE = 12;
template <int PH>
__device__ __forceinline__ void run_phase(const P& p, unsigned char* lds) {
    const float* mod = (const float*)(p.ws + WS_MOD);
    if constexpr (PH == 0) phase0(p, lds);
    if constexpr (PH == 1) phase_normmod(p, 0);
    if constexpr (PH == 2) { EpiSwiglu E{(bf16_t*)(p.ws + WS_U)}; run_gemm(lds, (const bf16_t*)(p.ws + WS_A), (const bf16_t*)(p.ws + WS_W1), 5632, 1024, E); }
    if constexpr (PH == 3) { EpiResid E{p.xp, p.xs, p.out, mod + 2048, 0.5f, 0}; run_gemm(lds, (const bf16_t*)(p.ws + WS_U), (const bf16_t*)(p.ws + WS_W1B), 1024, 2816, E); }
    if constexpr (PH == 4) phase_normmod(p, 1);
    if constexpr (PH == 5) { EpiU E{(bf16_t*)(p.ws + WS_U), (float*)(p.ws + WS_GATES)}; run_gemm(lds, (const bf16_t*)(p.ws + WS_A), (const bf16_t*)(p.ws + WS_BT3), 4096, 1024, E); }
    if constexpr (PH == 6) phase_scan(p, lds);
    if constexpr (PH == 12) phase_rwkv_finalize(p, lds);
    if constexpr (PH == 7) { EpiResid E{p.xp, p.xs, p.out, mod + 5120, 1.0f, 1}; run_gemm(lds, (const bf16_t*)(p.ws + WS_A), (const bf16_t*)(p.ws + WS_BT4), 1024, 1024, E); }
    if constexpr (PH == 8) { phase_normmod(p, 2); phase_convert_w2(p, lds); }
    if constexpr (PH == 9) { EpiSwiglu E{(bf16_t*)(p.ws + WS_U)}; run_gemm(lds, (const bf16_t*)(p.ws + WS_A), (const bf16_t*)(p.ws + WS_W1), 5632, 1024, E); }
    if constexpr (PH == 10) { EpiResid E{p.xp, p.xs, p.out, mod + 8192, 0.5f, 1}; run_gemm(lds, (const bf16_t*)(p.ws + WS_U), (const bf16_t*)(p.ws + WS_W1B), 1024, 2816, E); }
    if constexpr (PH == 11) phase_finalnorm(p);
}

#if !ONE_LAUNCH
template <int PH>
__global__ void __launch_bounds__(NTHR, 2) k_phase(P p) {
    extern __shared__ __attribute__((aligned(16))) unsigned char lds[];
    run_phase<PH>(p, lds);
}
#endif

#if ONE_LAUNCH
__global__ void __launch_bounds__(NTHR, 2) k_mega(P p) {
    extern __shared__ __attribute__((aligned(16))) unsigned char lds[];
    cg::grid_group grid = cg::this_grid();
    run_phase<0>(p, lds); grid.sync();
    if (PROBE_DUP == 0) { run_phase<0>(p, lds); grid.sync(); }
    run_phase<1>(p, lds); grid.sync();
    if (PROBE_DUP == 1) { run_phase<1>(p, lds); grid.sync(); }
    run_phase<2>(p, lds); grid.sync();
    if (PROBE_DUP == 2) { run_phase<2>(p, lds); grid.sync(); }
    run_phase<3>(p, lds); grid.sync();
    if (PROBE_DUP == 3) { run_phase<3>(p, lds); grid.sync(); }
    run_phase<4>(p, lds); grid.sync();
    if (PROBE_DUP == 4) { run_phase<4>(p, lds); grid.sync(); }
    run_phase<5>(p, lds); grid.sync();
    if (PROBE_DUP == 5) { run_phase<5>(p, lds); grid.sync(); }
    run_phase<6>(p, lds); grid.sync();
    if (PROBE_DUP == 6) { run_phase<6>(p, lds); grid.sync(); }
    run_phase<12>(p, lds); grid.sync();
    run_phase<7>(p, lds); grid.sync();
    if (PROBE_DUP == 7) { run_phase<7>(p, lds); grid.sync(); }
    run_phase<8>(p, lds); grid.sync();
    if (PROBE_DUP == 8) { run_phase<8>(p, lds); grid.sync(); }
    run_phase<9>(p, lds); grid.sync();
    if (PROBE_DUP == 9) { run_phase<9>(p, lds); grid.sync(); }
    run_phase<10>(p, lds); grid.sync();
    if (PROBE_DUP == 10) { run_phase<10>(p, lds); grid.sync(); }
    run_phase<11>(p, lds);
}
#endif

#if !ONE_LAUNCH
template <int PH> static void launch_phase(const P& p, int grid, hipStream_t stream) {
    static bool attr = false;
    if (!attr) { (void)hipFuncSetAttribute((const void*)k_phase<PH>, hipFuncAttributeMaxDynamicSharedMemorySize, LDS_BYTES); attr = true; }
    hipLaunchKernelGGL(k_phase<PH>, dim3(grid), dim3(NTHR), LDS_BYTES, stream, p);
}
#endif

extern "C" void kernel_launch(void* const* d_in, const int* in_sizes, int n_in, void* d_out, int out_size, void* d_ws, size_t ws_size, hipStream_t stream) {
    (void)in_sizes; (void)n_in; (void)out_size; (void)ws_size;
    static int grid = 0;
    if (grid == 0) {
        int dev = 0, cus = 0;
        if (hipGetDevice(&dev) != hipSuccess || hipDeviceGetAttribute(&cus, hipDeviceAttributeMultiprocessorCount, dev) != hipSuccess || cus <= 0) cus = 256;
#if ONE_LAUNCH
        (void)hipFuncSetAttribute((const void*)k_mega, hipFuncAttributeMaxDynamicSharedMemorySize, LDS_BYTES);
        int per_cu = 0;
        if (hipOccupancyMaxActiveBlocksPerMultiprocessor(&per_cu, (const void*)k_mega, NTHR, LDS_BYTES) != hipSuccess || per_cu < 1) per_cu = 1;
        (void)hipGetLastError();
#endif
        grid = cus;
    }
    P p{};
    const float** f = (const float**)&p;
    for (int i = 0; i < 35; ++i) f[i] = (const float*)d_in[i];
    p.out = (float*)d_out; p.ws = (unsigned char*)d_ws;
    (void)hipMemsetAsync((char*)d_ws + WS_MOD, 0, NCOND * MODW * sizeof(float), stream);
#if ONE_LAUNCH
    void* args[] = {&p};
    hipError_t e = hipLaunchCooperativeKernel((const void*)k_mega, dim3(grid), dim3(NTHR), args, LDS_BYTES, stream);
    if (e != hipSuccess) fprintf(stderr, "cooperative launch failed: %s (grid %d)\n", hipGetErrorString(e), grid);
#else
    launch_phase<0>(p, grid, stream); launch_phase<1>(p, grid, stream); launch_phase<2>(p, grid, stream); launch_phase<3>(p, grid, stream);
    launch_phase<4>(p, grid, stream); launch_phase<5>(p, grid, stream); launch_phase<6>(p, grid, stream); launch_phase<12>(p, grid, stream); launch_phase<7>(p, grid, stream);
    launch_phase<8>(p, grid, stream); launch_phase<9>(p, grid, stream); launch_phase<10>(p, grid, stream); launch_phase<11>(p, grid, stream);
#endif
}
```

```cpp
#include <hip/hip_runtime.h>
#include <hip/hip_cooperative_groups.h>
#include <cstdio>
#include <cstdint>
namespace cg = cooperative_groups;

#ifndef PROBE_DUP
#define PROBE_DUP -1
#endif
#ifndef ONE_LAUNCH
#define ONE_LAUNCH 1
#endif

#define LDS_BARRIER() do { asm volatile("s_waitcnt lgkmcnt(0)" ::: "memory"); __builtin_amdgcn_s_barrier(); asm volatile("" ::: "memory"); } while (0)
__device__ __forceinline__ int opaque_tid() { int z = 0; asm volatile("" : "+v"(z)); return (int)threadIdx.x + z; }

namespace pg8 {
#define PG8_LAS __attribute__((address_space(3)))
typedef unsigned short bf16_t;
typedef short bf16x8 __attribute__((ext_vector_type(8)));
typedef float f32x4 __attribute__((ext_vector_type(4)));
typedef unsigned u32x4 __attribute__((ext_vector_type(4)));
constexpr int BM = 256, BK = 64, HALF = 128, HTB = HALF * BK * 2, STAGE_BYTES = 8 * HTB, NXCD = 8, WGM = 8;

__host__ __device__ __forceinline__ int lds_byte(int r, int c) { const int st = (r >> 4) * 2 + (c >> 5), rr = r & 15, cc = c & 31, ob = rr * 64 + cc * 2; return st * 1024 + (ob ^ (((ob >> 9) & 1) << 5)); }
__host__ __device__ __forceinline__ void stage_rc(int b, int& R, int& C) { const int st = b / 1024, sb = b % 1024, swz = sb ^ (((sb >> 9) & 1) << 5); R = (st >> 1) * 16 + swz / 64; C = (st & 1) * 32 + (swz % 64) / 2; }
__host__ __device__ __forceinline__ int perm32(int rho) { const int n = rho >> 4, i = rho & 15; return 8 * (i >> 2) + 4 * n + (i & 3); }

struct Unit { int pm, pn; };
struct Gemm { const bf16_t* A; const bf16_t* Bt; int M, N, K; };

struct StaticOrder {
    int nM, nN, nwg, G, c;
    __host__ __device__ void init(int M, int N, int G_, int c_) { nM = M / BM; nN = N / BM; nwg = nM * nN; G = G_; c = c_; }
    __host__ __device__ bool next(int i, Unit& u) const {
        const long L = (long)i * G + c; if (L >= nwg) return false;
        int wgid = (int)L; { const int q = nwg / NXCD, r = nwg % NXCD, xcd = wgid % NXCD, off = wgid / NXCD; wgid = (xcd < r ? xcd * (q + 1) : r * (q + 1) + (xcd - r) * q) + off; }
        const int nig = WGM * nN, gid = wgid / nig, fm = gid * WGM, gsz = (nM - fm) < WGM ? (nM - fm) : WGM;
        u.pm = fm + ((wgid % nig) % gsz); u.pn = (wgid % nig) / gsz; return true;
    }
    __device__ __forceinline__ void a_ready(const Unit&) const {}
    __device__ __forceinline__ void done(const Unit&) const {}
};

__device__ __forceinline__ unsigned cvt_pk_bf16(float lo, float hi) { unsigned r; asm volatile("v_cvt_pk_bf16_f32 %0, %1, %2" : "=v"(r) : "v"(lo), "v"(hi)); return r; }

template <class Epi, class Sched, bool ALIGN_EPI = false, bool SP2 = false>
__device__ __forceinline__ void gemm_phase(PG8_LAS unsigned char* lds, const Gemm g, const Sched& S, const Epi& E) {
    const int tid = opaque_tid(), wid = __builtin_amdgcn_readfirstlane((int)threadIdx.x >> 6), lane = tid & 63, wr = wid >> 2, wc = wid & 3, fr = lane & 15, fq = lane >> 4;
    const int K = g.K, nt = K / BK;
    unsigned voffA[2], voffB[2];
#pragma unroll
    for (int i = 0; i < 2; ++i) { int R, C; stage_rc(tid * 16 + i * 8192, R, C); const int Rb = Epi::PERM ? ((R & ~31) + perm32(R & 31)) : R;
        voffA[i] = (unsigned)(R * K + C) * 2u; voffB[i] = (unsigned)(Rb * K + C) * 2u; }
    const size_t kstep = (size_t)(BK * 2);
    const size_t hstep = (size_t)HALF * K * 2;
    const size_t tstep = 2 * hstep;
    const unsigned ldsw = (unsigned)wid * 1024u;
    const int aoff = lds_byte(wr * 64 + fr, fq * 8), boff = lds_byte(wc * 32 + fr, fq * 8);
#define PG8_SA(b, h) (((b) * 2 + (h)) * HTB)
#define PG8_SB(b, h) ((4 + (b) * 2 + (h)) * HTB)
#define PG8_STAGE(bufoff, gbase, voff) do { _Pragma("unroll") for (int _i = 0; _i < 2; ++_i) \
        __builtin_amdgcn_global_load_lds((const unsigned*)((const char*)(gbase) + (voff)[_i]), (PG8_LAS unsigned*)(lds + (bufoff) + ldsw + _i * 8192), 16, 0, 0); } while (0)
#define PG8_LDA(dst, b, h) do { _Pragma("unroll") for (int m = 0; m < 4; ++m) _Pragma("unroll") for (int k = 0; k < 2; ++k) dst[m][k] = *(const PG8_LAS bf16x8*)(lds + PG8_SA(b, h) + aoff + m * 2048 + k * 1024); } while (0)
#define PG8_LDB(dst, b, h) do { _Pragma("unroll") for (int n = 0; n < 2; ++n) _Pragma("unroll") for (int k = 0; k < 2; ++k) dst[n][k] = *(const PG8_LAS bf16x8*)(lds + PG8_SB(b, h) + boff + n * 2048 + k * 1024); } while (0)
#define PG8_MMA(ai, bj, At, Bt) do { __builtin_amdgcn_s_setprio(1); _Pragma("unroll") for (int m = 0; m < 4; ++m) _Pragma("unroll") for (int n = 0; n < 2; ++n) _Pragma("unroll") for (int k = 0; k < 2; ++k) \
        acc[ai][bj][m][n] = __builtin_amdgcn_mfma_f32_16x16x32_bf16(Bt[n][k], At[m][k], acc[ai][bj][m][n], 0, 0, 0); __builtin_amdgcn_s_setprio(0); } while (0)
#define PG8_WAIT_V(n) asm volatile("s_waitcnt vmcnt(" #n ")" ::: "memory")
#define PG8_WAIT_L(n) asm volatile("s_waitcnt lgkmcnt(" #n ")" ::: "memory")
#define PG8_BAR __builtin_amdgcn_s_barrier()
#define PG8_SCHED __builtin_amdgcn_sched_barrier(0)
    Unit cur, nxt; int ui = 0;
    if (!S.next(0, cur)) return;
    f32x4 acc[2][2][4][2];
#pragma unroll
    for (int a = 0; a < 2; ++a)
#pragma unroll
        for (int b = 0; b < 2; ++b)
#pragma unroll
            for (int m = 0; m < 4; ++m)
#pragma unroll
                for (int n = 0; n < 2; ++n) acc[a][b][m][n] = (f32x4){0.f, 0.f, 0.f, 0.f};
    bf16x8 At[4][2], B0[2][2], B1[2][2];
    const char* cA = (const char*)g.A + (size_t)cur.pm * tstep; const char* cB = (const char*)g.Bt + (size_t)cur.pn * tstep;
    S.a_ready(cur);
    if constexpr (SP2) {
        PG8_STAGE(PG8_SB(0, 0), cB, voffB); PG8_STAGE(PG8_SB(0, 1), cB + hstep, voffB); PG8_STAGE(PG8_SA(0, 0), cA, voffA); PG8_STAGE(PG8_SA(0, 1), cA + hstep, voffA);
        if (wr == 1) PG8_BAR;
        PG8_WAIT_V(2); PG8_BAR;
        PG8_STAGE(PG8_SB(1, 0), cB + kstep, voffB); PG8_STAGE(PG8_SA(1, 0), cA + kstep, voffA); PG8_STAGE(PG8_SB(1, 1), cB + hstep + kstep, voffB);
        PG8_WAIT_V(6); PG8_BAR;
    } else {
        PG8_STAGE(PG8_SB(0, 0), cB, voffB); PG8_STAGE(PG8_SA(0, 0), cA, voffA); PG8_STAGE(PG8_SB(0, 1), cB + hstep, voffB); PG8_STAGE(PG8_SA(0, 1), cA + hstep, voffA);
        if (wr == 1) PG8_BAR;
        PG8_WAIT_V(4); PG8_BAR;
        PG8_STAGE(PG8_SB(1, 0), cB + kstep, voffB); PG8_STAGE(PG8_SA(1, 0), cA + kstep, voffA); PG8_STAGE(PG8_SB(1, 1), cB + hstep + kstep, voffB);
        PG8_WAIT_V(6); PG8_BAR;
    }
    for (;;) {
        const bool has_next = S.next(ui + 1, nxt);
        const char* nA = has_next ? (const char*)g.A + (size_t)nxt.pm * tstep : cA; const char* nB = has_next ? (const char*)g.Bt + (size_t)nxt.pn * tstep : cB;
        for (int t = 0; t < nt; t += 2) {
            const bool last = (t == nt - 2);
            const char* a1 = cA + (size_t)(t + 1) * kstep;
            const char* a2 = last ? nA : cA + (size_t)(t + 2) * kstep; const char* b2 = last ? nB : cB + (size_t)(t + 2) * kstep;
            const char* a3 = a2 + kstep; const char* b3 = b2 + kstep;
            if (last && has_next) S.a_ready(nxt);
            if constexpr (SP2) {
            PG8_LDB(B0, 0, 0); PG8_LDB(B1, 0, 1); PG8_SCHED; PG8_LDA(At, 0, 0); PG8_STAGE(PG8_SA(1, 1), a1 + hstep, voffA);
            PG8_WAIT_V(8); PG8_WAIT_L(0); PG8_BAR; PG8_MMA(0, 0, At, B0); PG8_MMA(0, 1, At, B1); PG8_BAR; PG8_SCHED;
            PG8_LDA(At, 0, 1); PG8_STAGE(PG8_SB(0, 0), b2, voffB); PG8_STAGE(PG8_SB(0, 1), b2 + hstep, voffB); PG8_STAGE(PG8_SA(0, 0), a2, voffA);
            PG8_WAIT_V(8); PG8_WAIT_L(0); PG8_BAR; PG8_MMA(1, 0, At, B0); PG8_MMA(1, 1, At, B1); PG8_BAR; PG8_SCHED;
            PG8_LDB(B0, 1, 0); PG8_LDB(B1, 1, 1); PG8_SCHED; PG8_LDA(At, 1, 0); PG8_STAGE(PG8_SA(0, 1), a2 + hstep, voffA);
            PG8_WAIT_V(8); PG8_WAIT_L(0); PG8_BAR; PG8_MMA(0, 0, At, B0); PG8_MMA(0, 1, At, B1); PG8_BAR; PG8_SCHED;
            PG8_LDA(At, 1, 1); PG8_STAGE(PG8_SB(1, 0), b3, voffB); PG8_STAGE(PG8_SB(1, 1), b3 + hstep, voffB); PG8_STAGE(PG8_SA(1, 0), a3, voffA);
            PG8_WAIT_V(8); PG8_WAIT_L(0); PG8_BAR; PG8_MMA(1, 0, At, B0); PG8_MMA(1, 1, At, B1); PG8_BAR; PG8_SCHED;
            } else {
            PG8_LDB(B0, 0, 0); PG8_SCHED; PG8_LDA(At, 0, 0); PG8_STAGE(PG8_SA(1, 1), a1 + hstep, voffA);
            PG8_WAIT_L(8); PG8_BAR; PG8_WAIT_L(0); PG8_MMA(0, 0, At, B0); PG8_BAR; PG8_SCHED;
            PG8_LDB(B1, 0, 1); PG8_STAGE(PG8_SB(0, 0), b2, voffB);
            PG8_BAR; PG8_WAIT_L(0); PG8_MMA(0, 1, At, B1); PG8_BAR;
            PG8_LDA(At, 0, 1); PG8_STAGE(PG8_SA(0, 0), a2, voffA);
            PG8_BAR; PG8_WAIT_L(0); PG8_MMA(1, 0, At, B0); PG8_BAR; PG8_SCHED;
            PG8_STAGE(PG8_SB(0, 1), b2 + hstep, voffB);
            PG8_WAIT_V(6); PG8_BAR; PG8_MMA(1, 1, At, B1); PG8_BAR;
            PG8_LDB(B0, 1, 0); PG8_SCHED; PG8_LDA(At, 1, 0); PG8_STAGE(PG8_SA(0, 1), a2 + hstep, voffA);
            PG8_WAIT_L(8); PG8_BAR; PG8_WAIT_L(0); PG8_MMA(0, 0, At, B0); PG8_BAR; PG8_SCHED;
            PG8_LDB(B1, 1, 1); PG8_STAGE(PG8_SB(1, 0), b3, voffB);
            PG8_BAR; PG8_WAIT_L(0); PG8_MMA(0, 1, At, B1); PG8_BAR;
            PG8_LDA(At, 1, 1); PG8_STAGE(PG8_SA(1, 0), a3, voffA);
            PG8_BAR; PG8_WAIT_L(0); PG8_MMA(1, 0, At, B0); PG8_BAR; PG8_SCHED;
            PG8_STAGE(PG8_SB(1, 1), b3 + hstep, voffB);
            PG8_WAIT_V(6); PG8_BAR; PG8_MMA(1, 1, At, B1); PG8_BAR;
            }
        }
        if constexpr (ALIGN_EPI) { if (wr == 0) PG8_BAR; }
        E(acc, cur, wr, wc, fr, fq); S.done(cur);
        if (!has_next) break;
#pragma unroll
        for (int a = 0; a < 2; ++a)
#pragma unroll
            for (int b = 0; b < 2; ++b)
#pragma unroll
                for (int m = 0; m < 4; ++m)
#pragma unroll
                    for (int n = 0; n < 2; ++n) acc[a][b][m][n] = (f32x4){0.f, 0.f, 0.f, 0.f};
        cur = nxt; cA = nA; cB = nB; ++ui;
        if constexpr (ALIGN_EPI) { if (wr == 1) PG8_BAR; }
    }
    PG8_WAIT_V(0);
    if constexpr (!ALIGN_EPI) { if (wr == 0) PG8_BAR; }
    PG8_BAR;
#undef PG8_SA
#undef PG8_SB
#undef PG8_STAGE
#undef PG8_LDA
#undef PG8_LDB
#undef PG8_MMA
#undef PG8_WAIT_V
#undef PG8_WAIT_L
#undef PG8_BAR
#undef PG8_SCHED
}
}

using pg8::bf16_t; using pg8::bf16x8; using pg8::f32x4;

constexpr int MT = 24576, DM = 1024, DFF = 2816, NCTX = 8192;
constexpr int UW = 3984;
constexpr int NCOND = 9, MODW = 9216;
constexpr size_t MiB = 1ull << 20;
constexpr size_t WS_A = 0, WS_U = 48 * MiB, WS_W1 = WS_U + 132 * MiB, WS_W1B = WS_W1 + (size_t)5632 * 1024 * 2,
                 WS_BT3 = 235 * MiB, WS_HB2 = 235 * MiB  ,
                 WS_BT4 = 251 * MiB, WS_MOD = 253 * MiB, WS_CTR = WS_MOD + 9 * 9216 * 4  , WS_GATES = 254 * MiB;
constexpr size_t WS_A2BF = 255 * MiB + 512 * 1024, WS_G2BF = WS_A2BF + 2 * 512 * 64 * 2;
constexpr int OUT_C = 25165824, OUT_N = 29360128, OUT_MM = 29392896, OUT_S = 29393152;
constexpr int LDS_BYTES = 163840;
constexpr int NTHR = 512;

struct P {
    const float *xp, *xs, *c, *sC, *sn, *sm, *sS, *cctx, *ada_w, *ada_b, *n1, *w1in, *w1out, *nmix, *wmin, *wmout,
        *cw, *cb, *gb, *hg, *mu, *w0, *w2, *a0, *a2, *g2, *kk, *ka, *rk, *lng, *lnb, *n2, *w2in, *w2out, *nf;
    float* out; unsigned char* ws;
};

__device__ __forceinline__ unsigned short f2bf(float f) { unsigned u = __float_as_uint(f); u += 0x7FFFu + ((u >> 16) & 1u); return (unsigned short)(u >> 16); }
__device__ __forceinline__ float bf2f(unsigned short b) { return __uint_as_float(((unsigned)b) << 16); }
__device__ __forceinline__ unsigned pk2(float a, float b) { return (unsigned)f2bf(a) | ((unsigned)f2bf(b) << 16); }
__device__ __forceinline__ int cond_of(int row) { return row < NCTX ? 0 : 1 + ((row - NCTX) >> 11); }
__device__ __forceinline__ float fexp(float x) { return __builtin_amdgcn_exp2f(x * 1.4426950408889634f); }
__device__ __forceinline__ float flog(float x) { return __builtin_amdgcn_logf(x) * 0.6931471805599453f; }
__device__ __forceinline__ float siluf(float x) { return x * __builtin_amdgcn_rcpf(1.f + fexp(-x)); }
__device__ __forceinline__ float sigmf(float x) { return __builtin_amdgcn_rcpf(1.f + fexp(-x)); }
__device__ __forceinline__ float tanh_fast(float x) { return 1.f - 2.f * __builtin_amdgcn_rcpf(1.f + fexp(2.f * x)); }
__device__ __forceinline__ float softplus_fast(float z) { return fmaxf(z, 0.f) + flog(1.f + fexp(-fabsf(z))); }
__device__ __forceinline__ const float* xrow(const P& p, int row) { return row < NCTX ? p.xp + (size_t)row * DM : p.xs + (size_t)(row - NCTX) * DM; }
__device__ __forceinline__ f32x4 mfma16(bf16x8 a, bf16x8 b, f32x4 c) { return __builtin_amdgcn_mfma_f32_16x16x32_bf16(a, b, c, 0, 0, 0); }
__device__ __forceinline__ void unpack8(uint4 v, float* f) {
    f[0] = __uint_as_float(v.x << 16); f[1] = __uint_as_float(v.x & 0xffff0000u); f[2] = __uint_as_float(v.y << 16); f[3] = __uint_as_float(v.y & 0xffff0000u);
    f[4] = __uint_as_float(v.z << 16); f[5] = __uint_as_float(v.z & 0xffff0000u); f[6] = __uint_as_float(v.w << 16); f[7] = __uint_as_float(v.w & 0xffff0000u);
}

__device__ __forceinline__ int colmap(int kind, int n) {
    if (kind == 0) return n;
    if (kind == 1) { const int t = n >> 8, bj = (n >> 7) & 1, c = n & 127; return bj * DFF + t * 128 + c; }
    if (n < 2048) return n; if (n < 3968) return n + 16; if (n < 3984) return n - 3968 + 2048; return -1;
}
__device__ void convert_tile(const float* __restrict__ src, bf16_t* __restrict__ dst, int K, int Nsrc, int kind, int k0, int n0, float* tile) {
    const int tid = opaque_tid();
    { const int n = tid & 63, kr = tid >> 6; const int sc = colmap(kind, n0 + n);
#pragma unroll
      for (int i = 0; i < 8; ++i) { const int k = kr + 8 * i; tile[k * 65 + n] = sc >= 0 ? src[(size_t)(k0 + k) * Nsrc + sc] : 0.f; } }
    __syncthreads();
    { const int nn = tid >> 3, kg = tid & 7; unsigned w[4];
#pragma unroll
      for (int j = 0; j < 4; ++j) w[j] = pk2(tile[(kg * 8 + 2 * j) * 65 + nn], tile[(kg * 8 + 2 * j + 1) * 65 + nn]);
      *(uint4*)(dst + (size_t)(n0 + nn) * K + k0 + kg * 8) = make_uint4(w[0], w[1], w[2], w[3]); }
    __syncthreads();
}
__device__ void convert_jobs(const P& p, int first, int njobs_sel, unsigned char* lds, int item0, int nitems_before) {}

__device__ void do_convert(const float* src, bf16_t* dst, int K, int Nsrc, int Ndst, int kind, int t, float* tile) {
    const int nkt = K / 64; const int kt = t % nkt, ntile = t / nkt; (void)Ndst;
    convert_tile(src, dst, K, Nsrc, kind, kt * 64, ntile * 64, tile);
}

__device__ void phase0(const P& p, unsigned char* lds) {
    float* tile = (float*)lds;
    const int tid = opaque_tid();
    const int n_ada = 36 * 8;
    const int t1 = 16 * 88, t2 = 44 * 16, t3 = 16 * 64, t4 = 16 * 16, t5 = 8, t6 = 8, t7 = 16;
    const int total = n_ada + t1 + t2 + t3 + t4 + t5 + t6 + t7;
    for (int it = blockIdx.x; it < total; it += gridDim.x) {
        if (it < n_ada) {
            const int cgp = it % 36, kc = it / 36;
            float* sc = tile;
            __syncthreads();
            for (int i = tid; i < NCOND * 128; i += NTHR) { const int c = i >> 7, k = i & 127; const float v = c == 0 ? p.cctx[kc * 128 + k] : p.c[(c - 1) * DM + kc * 128 + k]; sc[i] = siluf(v); }
            __syncthreads();
            const int col = cgp * 256 + (tid & 255), kh = tid >> 8;
            float acc[NCOND];
#pragma unroll
            for (int c = 0; c < NCOND; ++c) acc[c] = 0.f;
            const float* w = p.ada_w + (size_t)(kc * 128 + kh * 64) * MODW + col;
#pragma unroll 4
            for (int k = 0; k < 64; ++k) { const float wv = w[(size_t)k * MODW];
#pragma unroll
                for (int c = 0; c < NCOND; ++c) acc[c] += sc[c * 128 + kh * 64 + k] * wv; }
            float* mod = (float*)(p.ws + WS_MOD);
            const float bias = (kc == 0 && kh == 0) ? p.ada_b[col] : 0.f;
#pragma unroll
            for (int c = 0; c < NCOND; ++c) atomicAdd(mod + c * MODW + col, acc[c] + bias);
            __syncthreads();
        } else {
            int t = it - n_ada;
            if (t < t1) do_convert(p.w1in, (bf16_t*)(p.ws + WS_W1), 1024, 5632, 5632, 1, t, tile);
            else if ((t -= t1) < t2) do_convert(p.w1out, (bf16_t*)(p.ws + WS_W1B), 2816, 1024, 1024, 0, t, tile);
            else if ((t -= t2) < t3) do_convert(p.wmin, (bf16_t*)(p.ws + WS_BT3), 1024, 3984, 4096, 2, t, tile);
            else if ((t -= t3) < t4) do_convert(p.wmout, (bf16_t*)(p.ws + WS_BT4), 1024, 1024, 1024, 0, t, tile);
            else if ((t -= t4) < t5) do_convert(p.a2, (bf16_t*)(p.ws + WS_A2BF), 64, 512, 512, 0, t, tile);
            else if ((t -= t5) < t6) do_convert(p.a2 + 64 * 512, (bf16_t*)(p.ws + WS_A2BF) + 512 * 64, 64, 512, 512, 0, t, tile);
            else { t -= t6; do_convert(p.g2, (bf16_t*)(p.ws + WS_G2BF), 128, 512, 512, 0, t, tile); }
        }
    }
}

__device__ void phase_normmod(const P& p, int which) {
    const int lane = opaque_tid() & 63, wave = threadIdx.x >> 6;
    const float* gain = which == 0 ? p.n1 : (which == 1 ? p.nmix : p.n2);
    const float* mod = (const float*)(p.ws + WS_MOD);
    bf16_t* A = (bf16_t*)(p.ws + WS_A);
    for (int row = blockIdx.x * 8 + wave; row < MT; row += gridDim.x * 8) {
        const float* src = which == 0 ? xrow(p, row) : p.out + (size_t)row * DM;
        float4 v[4]; float ss = 0.f;
#pragma unroll
        for (int i = 0; i < 4; ++i) { v[i] = *(const float4*)(src + lane * 4 + 256 * i); ss += v[i].x * v[i].x + v[i].y * v[i].y + v[i].z * v[i].z + v[i].w * v[i].w; }
#pragma unroll
        for (int o = 32; o >= 1; o >>= 1) ss += __shfl_xor(ss, o);
        const float rstd = rsqrtf(ss * (1.f / 1024.f) + 1e-6f);
        const float* sh = mod + cond_of(row) * MODW + which * 3072; const float* sc = sh + 1024;
#pragma unroll
        for (int i = 0; i < 4; ++i) { const int col = lane * 4 + 256 * i;
            const float4 g = *(const float4*)(gain + col), s4 = *(const float4*)(sh + col), c4 = *(const float4*)(sc + col);
            const float o0 = v[i].x * rstd * g.x * (1.f + c4.x) + s4.x, o1 = v[i].y * rstd * g.y * (1.f + c4.y) + s4.y,
                        o2 = v[i].z * rstd * g.z * (1.f + c4.z) + s4.z, o3 = v[i].w * rstd * g.w * (1.f + c4.w) + s4.w;
            *(uint2*)(A + (size_t)row * DM + col) = make_uint2(pk2(o0, o1), pk2(o2, o3)); }
    }
}
__device__ void phase_finalnorm(const P& p) {
    const int lane = opaque_tid() & 63, wave = threadIdx.x >> 6;
    for (int row = blockIdx.x * 8 + wave; row < MT; row += gridDim.x * 8) {
        float* src = p.out + (size_t)row * DM;
        float4 v[4]; float ss = 0.f;
#pragma unroll
        for (int i = 0; i < 4; ++i) { v[i] = *(const float4*)(src + lane * 4 + 256 * i); ss += v[i].x * v[i].x + v[i].y * v[i].y + v[i].z * v[i].z + v[i].w * v[i].w; }
#pragma unroll
        for (int o = 32; o >= 1; o >>= 1) ss += __shfl_xor(ss, o);
        const float rstd = rsqrtf(ss * (1.f / 1024.f) + 1e-6f);
#pragma unroll
        for (int i = 0; i < 4; ++i) { const int col = lane * 4 + 256 * i; const float4 g = *(const float4*)(p.nf + col);
            *(float4*)(src + col) = make_float4(v[i].x * rstd * g.x, v[i].y * rstd * g.y, v[i].z * rstd * g.z, v[i].w * rstd * g.w); }
    }
}

struct EpiSwiglu {
    static constexpr bool PERM = true;
    bf16_t* O;
    __device__ __forceinline__ void operator()(const f32x4 (&acc)[2][2][4][2], const pg8::Unit& u, int wr, int wc, int fr, int fq) const {
        const int row0 = u.pm * 256 + wr * 64 + fr, col0 = u.pn * 128 + wc * 32 + 8 * fq;
#pragma unroll
        for (int ai = 0; ai < 2; ++ai)
#pragma unroll
            for (int m = 0; m < 4; ++m) { bf16_t* rowp = O + (size_t)(row0 + ai * 128 + m * 16) * DFF + col0;
                float r[8];
#pragma unroll
                for (int n = 0; n < 2; ++n)
#pragma unroll
                    for (int j = 0; j < 4; ++j) r[n * 4 + j] = siluf(acc[ai][0][m][n][j]) * acc[ai][1][m][n][j];
                pg8::u32x4 w; w.x = pg8::cvt_pk_bf16(r[0], r[1]); w.y = pg8::cvt_pk_bf16(r[2], r[3]); w.z = pg8::cvt_pk_bf16(r[4], r[5]); w.w = pg8::cvt_pk_bf16(r[6], r[7]);
                *(pg8::u32x4*)rowp = w; }
    }
};
struct EpiResid {
    static constexpr bool PERM = false;
    const float* xp; const float* xs; float* out; const float* ga; float coef; int inplace;
    __device__ __forceinline__ void operator()(const f32x4 (&acc)[2][2][4][2], const pg8::Unit& u, int wr, int wc, int fr, int fq) const {
        const int row0 = u.pm * 256 + wr * 64 + fr, col0 = u.pn * 256 + wc * 32 + 4 * fq;
        const float* gap = ga + cond_of(u.pm * 256) * MODW;
        f32x4 gv[2][2];
#pragma unroll
        for (int bj = 0; bj < 2; ++bj)
#pragma unroll
            for (int n = 0; n < 2; ++n) gv[bj][n] = *(const f32x4*)(gap + col0 + bj * 128 + n * 16) * coef;
#pragma unroll
        for (int ai = 0; ai < 2; ++ai)
#pragma unroll
            for (int m = 0; m < 4; ++m) { const int row = row0 + ai * 128 + m * 16;
                const float* base = inplace ? out + (size_t)row * DM : (row < NCTX ? xp + (size_t)row * DM : xs + (size_t)(row - NCTX) * DM);
                float* op = out + (size_t)row * DM;
#pragma unroll
                for (int bj = 0; bj < 2; ++bj)
#pragma unroll
                    for (int n = 0; n < 2; ++n) { const int c = col0 + bj * 128 + n * 16; const f32x4 b4 = *(const f32x4*)(base + c);
                        *(f32x4*)(op + c) = b4 + gv[bj][n] * acc[ai][bj][m][n]; } }
    }
};
struct EpiU {
    static constexpr bool PERM = true;
    bf16_t* U; float* gates;
    __device__ __forceinline__ void operator()(const f32x4 (&acc)[2][2][4][2], const pg8::Unit& u, int wr, int wc, int fr, int fq) const {
        const int row0 = u.pm * 256 + wr * 64 + fr;
#pragma unroll
        for (int bj = 0; bj < 2; ++bj) { const int col0 = u.pn * 256 + bj * 128 + wc * 32 + 8 * fq;
            if (col0 < UW) {
#pragma unroll
                for (int ai = 0; ai < 2; ++ai)
#pragma unroll
                    for (int m = 0; m < 4; ++m) { const int row = row0 + ai * 128 + m * 16; const f32x4 v0 = acc[ai][bj][m][0], v1 = acc[ai][bj][m][1];
                        pg8::u32x4 w; w.x = pg8::cvt_pk_bf16(v0[0], v0[1]); w.y = pg8::cvt_pk_bf16(v0[2], v0[3]); w.z = pg8::cvt_pk_bf16(v1[0], v1[1]); w.w = pg8::cvt_pk_bf16(v1[2], v1[3]);
                        *(pg8::u32x4*)(U + (size_t)row * UW + col0) = w;
                        if (col0 >= 3968) { float* gp = gates + (size_t)row * 16 + (col0 - 3968); *(f32x4*)gp = v0; *(f32x4*)(gp + 4) = v1; } } } }
    }
};

template <class Epi>
__device__ __forceinline__ void run_gemm(unsigned char* lds, const bf16_t* A, const bf16_t* Bt, int N, int K, const Epi& E) {
    pg8::Gemm g{A, Bt, MT, N, K}; pg8::StaticOrder S; S.init(MT, N, (int)gridDim.x, (int)blockIdx.x);
    pg8::gemm_phase<Epi, pg8::StaticOrder, true, true>((PG8_LAS unsigned char*)lds, g, S, E);
}

constexpr int ML_SK = 0, ML_KWT = 17408, ML_VT = ML_KWT + 18432, ML_CB = ML_VT + 20736, ML_F = ML_CB + 21760, ML_CW = ML_F + 2048, ML_END = ML_CW + 4096;
static_assert(ML_END <= LDS_BYTES, "mlstm lds");

__device__ __forceinline__ unsigned short ld_u16_agent(const bf16_t* p) { return __hip_atomic_load(p, __ATOMIC_RELAXED, __HIP_MEMORY_SCOPE_AGENT); }

__device__ __forceinline__ void conv3_row8(const bf16_t* up, bool hasp, bool hasn, const float* cwp, float* x) {
    float t[8];
    unpack8(*(const uint4*)up, t);
#pragma unroll
    for (int i = 0; i < 8; ++i) x[i] = cwp[768 + i] + cwp[256 + i] * t[i];
    if (hasp) { unpack8(*(const uint4*)(up - UW), t);
#pragma unroll
        for (int i = 0; i < 8; ++i) x[i] += cwp[i] * t[i]; }
    if (hasn) { unpack8(*(const uint4*)(up + UW), t);
#pragma unroll
        for (int i = 0; i < 8; ++i) x[i] += cwp[512 + i] * t[i]; }
}

__device__ __forceinline__ void mlstm_task(const P& p, unsigned char* lds, int bg, int h, int dsel) {
    const int wv = __builtin_amdgcn_readfirstlane((int)threadIdx.x >> 6), rw = wv & 3, cw = wv >> 2;
    const bool ctx = bg < 32; const int T = ctx ? 256 : 2048, nc = T / 64; const int row0 = ctx ? bg * 256 : NCTX + (bg - 32) * 2048;
    bf16_t* sK = (bf16_t*)(lds + ML_SK); bf16_t* sKwT = (bf16_t*)(lds + ML_KWT); bf16_t* sVT = (bf16_t*)(lds + ML_VT); bf16_t* sCb = (bf16_t*)(lds + ML_CB); bf16_t* sS = sCb;
    float* sA = (float*)(lds + ML_F); float* sM = sA + 64; float* sBb = sM + 64; float* sDen = sBb + 64; float* sScal = sDen + 64; float* sRed = sScal + 16;
    float* sCW = (float*)(lds + ML_CW);
    const bf16_t* U = (const bf16_t*)(p.ws + WS_U); const float* GATES = (const float*)(p.ws + WS_GATES); bf16_t* HB = (bf16_t*)(p.ws + WS_A); bf16_t* HB2 = (bf16_t*)(p.ws + WS_HB2);
    const int d_lo = dsel < 0 ? 0 : dsel, d_hi = dsel < 0 ? 2 : dsel + 1;
    const int ct_a = cw ? 3 : 0;
    const int ct_b = cw ? 7 : 5;
    const int n_a = cw ? 2 : 3;

    __syncthreads();
    { const int tid = threadIdx.x;
      for (int i = tid; i < 1024; i += NTHR) { const int a = i >> 8, cc = i & 255, gch = (cc >> 7) * 512 + h * 128 + (cc & 127); sCW[i] = a < 3 ? p.cw[a * 1024 + gch] : p.cb[gch]; }
      for (int i = tid; i < 16 * 72; i += NTHR) { const int r = 128 + i / 72; sVT[r * 72 + (i % 72)] = (r == 128) ? (bf16_t)0x3F80 : (bf16_t)0; } }

#pragma unroll 1
    for (int dir = d_lo; dir < d_hi; ++dir) {
        f32x4 Cacc[9]; float m_prev = 0.f;
        { int z0 = 0; asm volatile("" : "+v"(z0)); const int tid = (int)threadIdx.x + z0, fr = tid & 15, fq = (tid >> 4) & 3;
#pragma unroll
          for (int ct = 0; ct < 9; ++ct) Cacc[ct] = (f32x4){0.f, 0.f, 0.f, 0.f};
          if (!ctx) { const int sidx = ((bg - 32) * 2 + dir) * 4 + h; const float* C0 = p.sC + (size_t)sidx * 16384; const float* n0 = p.sn + (size_t)sidx * 128;
#pragma unroll
              for (int j = 0; j < 4; ++j) { const int d = 16 * wv + 4 * fq + j;
#pragma unroll
                  for (int ct = 0; ct < 8; ++ct) Cacc[ct][j] = C0[d * 128 + 16 * ct + fr];
                  Cacc[8][j] = fr == 0 ? n0[d] : 0.f; }
              m_prev = p.sm[sidx]; } }
        const float gbi = p.gb[dir * 4 + h], gbf = p.gb[8 + dir * 4 + h];
        const bool second = dsel < 0 && dir == 1;
#pragma unroll 1
        for (int s = 0; s < nc; ++s) {
            const int c = dir ? nc - 1 - s : s;
            int zz = 0; asm volatile("" : "+v"(zz));
            const int tid = (int)threadIdx.x + zz, lane = tid & 63, fr = tid & 15, fq = (tid >> 4) & 3;
            __syncthreads();
            if (wv == 0) {
                const int tl = dir ? 63 - lane : lane; const size_t row = (size_t)row0 + c * 64 + tl;
                const float ip = GATES[row * 16 + dir * 4 + h] + gbi, fp = GATES[row * 16 + 8 + dir * 4 + h] + gbf;
                const float lf = -softplus_fast(-fp);
                float bs = lf;
#pragma unroll
                for (int o = 1; o < 64; o <<= 1) { const float t = __shfl_up(bs, o); if (lane >= o) bs += t; }
                const float a = ip - bs; float pm = a;
#pragma unroll
                for (int o = 1; o < 64; o <<= 1) { const float t = __shfl_up(pm, o); if (lane >= o) pm = fmaxf(pm, t); }
                const float Mt = fmaxf(m_prev, pm);
                sA[lane] = a; sM[lane] = Mt; sBb[lane] = bs;
                if (lane == 63) { sScal[0] = Mt; sScal[1] = bs; }
            }
            __syncthreads();
            const float M63 = sScal[0], bL = sScal[1];
#pragma unroll 1
            for (int g = 0; g < 2; ++g) {
                const int idx = tid + 512 * g, sl = idx >> 4, d0 = (idx & 15) * 8;
                const int tl = dir ? 63 - sl : sl, tok = c * 64 + tl; const size_t row = (size_t)row0 + tok;
                const int ch = 512 + h * 128 + d0;
                const float wk = fexp(sA[sl] - M63);
                float kv[8];
                conv3_row8(U + row * UW + ch, tok > 0, tok < T - 1, sCW + 128 + d0, kv);
#pragma unroll
                for (int i = 0; i < 8; ++i) kv[i] = siluf(kv[i]) * 0.08838834764831845f;
                *(uint4*)(sK + sl * 136 + d0) = make_uint4(pk2(kv[0], kv[1]), pk2(kv[2], kv[3]), pk2(kv[4], kv[5]), pk2(kv[6], kv[7]));
#pragma unroll
                for (int i = 0; i < 8; ++i) sKwT[(d0 + i) * 72 + sl] = f2bf(kv[i] * wk);
                const uint4 vv = *(const uint4*)(U + row * UW + 1024 + h * 128 + d0);
                const unsigned vw[4] = {vv.x, vv.y, vv.z, vv.w};
#pragma unroll
                for (int i = 0; i < 8; ++i) sVT[(d0 + i) * 72 + sl] = (bf16_t)((vw[i >> 1] >> ((i & 1) * 16)) & 0xffffu);
            }
            bf16x8 qf[4];
            { const int t_ = 16 * rw + fr, tl = dir ? 63 - t_ : t_, tok = c * 64 + tl; const size_t row = (size_t)row0 + tok;
#pragma unroll
              for (int kk = 0; kk < 4; ++kk) { const int ch = h * 128 + 32 * kk + 8 * fq;
                  float qv[8];
                  conv3_row8(U + row * UW + ch, tok > 0, tok < T - 1, sCW + 32 * kk + 8 * fq, qv);
#pragma unroll
                  for (int i = 0; i < 8; ++i) qv[i] = siluf(qv[i]);
                  union { uint4 u; bf16x8 v; } cv; cv.u = make_uint4(pk2(qv[0], qv[1]), pk2(qv[2], qv[3]), pk2(qv[4], qv[5]), pk2(qv[6], qv[7])); qf[kk] = cv.v; } }
            f32x4 num[5];
#pragma unroll
            for (int k = 0; k < 5; ++k) num[k] = (f32x4){0.f, 0.f, 0.f, 0.f};
#pragma unroll
            for (int ci = 0; ci < 5; ++ci) { const f32x4 v = Cacc[ci]; *(uint2*)(sCb + (16 * ci + fr) * 136 + 16 * wv + 4 * fq) = make_uint2(pk2(v[0], v[1]), pk2(v[2], v[3])); }
            __syncthreads();
#pragma unroll
            for (int k = 0; k < 3; ++k) if (k < n_a) {
#pragma unroll
                for (int kk = 0; kk < 4; ++kk) { const bf16x8 b = *(const bf16x8*)(sCb + (16 * (ct_a + k) + fr) * 136 + 32 * kk + 8 * fq); num[k] = mfma16(qf[kk], b, num[k]); } }
            __syncthreads();
#pragma unroll
            for (int ci = 0; ci < 4; ++ci) { const f32x4 v = Cacc[5 + ci]; *(uint2*)(sCb + (16 * ci + fr) * 136 + 16 * wv + 4 * fq) = make_uint2(pk2(v[0], v[1]), pk2(v[2], v[3])); }
            __syncthreads();
#pragma unroll
            for (int k = 3; k < 5; ++k) {
#pragma unroll
                for (int kk = 0; kk < 4; ++kk) { const bf16x8 b = *(const bf16x8*)(sCb + (16 * (ct_b + k - 3 - 5) + fr) * 136 + 32 * kk + 8 * fq); num[k] = mfma16(qf[kk], b, num[k]); } }
            {
                float scv[4];
#pragma unroll
                for (int j = 0; j < 4; ++j) scv[j] = fexp(m_prev - sM[16 * rw + 4 * fq + j]);
#pragma unroll
                for (int k = 0; k < 5; ++k)
#pragma unroll
                    for (int j = 0; j < 4; ++j) num[k][j] *= scv[j];
            }
            __syncthreads();
#pragma unroll
            for (int si = 0; si < 2; ++si) { const int st = 2 * cw + si;
                f32x4 sacc = (f32x4){0.f, 0.f, 0.f, 0.f};
                if (st <= rw) {
#pragma unroll
                    for (int kk = 0; kk < 4; ++kk) { const bf16x8 b = *(const bf16x8*)(sK + (16 * st + fr) * 136 + 32 * kk + 8 * fq); sacc = mfma16(qf[kk], b, sacc); } }
                const int sp = 16 * st + fr; const float as = sA[sp];
#pragma unroll
                for (int j = 0; j < 4; ++j) { const int tp = 16 * rw + 4 * fq + j; const float val = (sp <= tp) ? sacc[j] * fexp(as - sM[tp]) : 0.f; sS[tp * 72 + sp] = f2bf(val); }
            }
            __syncthreads();
#pragma unroll
            for (int ks = 0; ks < 2; ++ks) { const bf16x8 a = *(const bf16x8*)(sS + (16 * rw + fr) * 72 + 32 * ks + 8 * fq);
#pragma unroll
                for (int k = 0; k < 5; ++k) { const int ct = k < 3 ? ct_a + k : ct_b + k - 3;
                    if (k != 2 || cw == 0) { const bf16x8 b = *(const bf16x8*)(sVT + (16 * ct + fr) * 72 + 32 * ks + 8 * fq); num[k] = mfma16(a, b, num[k]); } } }
            if (cw == 1 && fr == 0) {
#pragma unroll
                for (int j = 0; j < 4; ++j) sDen[16 * rw + 4 * fq + j] = num[4][j]; }
            __syncthreads();
            float inv[4];
#pragma unroll
            for (int j = 0; j < 4; ++j) { const int tp = 16 * rw + 4 * fq + j; const float den = sDen[tp]; inv[j] = __builtin_amdgcn_rcpf(fmaxf(fabsf(den), fexp(-(sBb[tp] + sM[tp])))); }
            if (!second) {
#pragma unroll
                for (int j = 0; j < 4; ++j) { const int tp = 16 * rw + 4 * fq + j, tl = dir ? 63 - tp : tp; const size_t row = (size_t)row0 + c * 64 + tl;
                    bf16_t* hb = dsel == 1 ? HB2 + (row - NCTX) * 512 + h * 128 : HB + row * DM + h * 128;
#pragma unroll
                    for (int k = 0; k < 5; ++k) { const int ct = k < 3 ? ct_a + k : ct_b + k - 3; if ((k != 2 || cw == 0) && ct < 8) hb[16 * ct + fr] = f2bf(num[k][j] * inv[j]); } }
            } else {
                float ssr[4];
#pragma unroll
                for (int j = 0; j < 4; ++j) { const int tp = 16 * rw + 4 * fq + j, tl = dir ? 63 - tp : tp; const size_t row = (size_t)row0 + c * 64 + tl;
                    const bf16_t* hb = HB + row * DM + h * 128; float ss = 0.f;
#pragma unroll
                    for (int k = 0; k < 5; ++k) { const int ct = k < 3 ? ct_a + k : ct_b + k - 3;
                        if ((k != 2 || cw == 0) && ct < 8) { const int e = 16 * ct + fr; const float other = bf2f(ld_u16_agent(hb + e)); const float hs = num[k][j] * inv[j] + other;
                            const float o = sigmf(bf2f(U[row * UW + 1536 + h * 128 + e])); const float v = o * hs; ss += v * v; num[k][j] = v; } }
                    ss += __shfl_xor(ss, 1); ss += __shfl_xor(ss, 2); ss += __shfl_xor(ss, 4); ss += __shfl_xor(ss, 8);
                    ssr[j] = ss; if (fr == 0) sRed[cw * 64 + tp] = ss; }
                __syncthreads();
#pragma unroll
                for (int j = 0; j < 4; ++j) { const int tp = 16 * rw + 4 * fq + j, tl = dir ? 63 - tp : tp; const size_t row = (size_t)row0 + c * 64 + tl;
                    bf16_t* hb = HB + row * DM + h * 128; const float rms = rsqrtf((ssr[j] + sRed[(1 - cw) * 64 + tp]) * (1.f / 128.f) + 1e-6f);
#pragma unroll
                    for (int k = 0; k < 5; ++k) { const int ct = k < 3 ? ct_a + k : ct_b + k - 3;
                        if ((k != 2 || cw == 0) && ct < 8) { const int e = 16 * ct + fr; hb[e] = f2bf(num[k][j] * rms * p.hg[h * 128 + e]); } } }
            }
            const float decay = fexp(m_prev - M63);
#pragma unroll
            for (int ct = 0; ct < 9; ++ct) Cacc[ct] = Cacc[ct] * decay;
#pragma unroll
            for (int ks = 0; ks < 2; ++ks) { const bf16x8 a = *(const bf16x8*)(sKwT + (16 * wv + fr) * 72 + 32 * ks + 8 * fq);
#pragma unroll
                for (int ct = 0; ct < 9; ++ct) { const bf16x8 b = *(const bf16x8*)(sVT + (16 * ct + fr) * 72 + 32 * ks + 8 * fq); Cacc[ct] = mfma16(a, b, Cacc[ct]); } }
            m_prev = bL + M63;
        }
        if (ctx) { const int sidx = (bg * 2 + dir) * 4 + h; float* Co = p.out + OUT_C + (size_t)sidx * 16384;
            int z1 = 0; asm volatile("" : "+v"(z1)); const int tid1 = (int)threadIdx.x + z1, fr1 = tid1 & 15, fq1 = (tid1 >> 4) & 3;
#pragma unroll
            for (int j = 0; j < 4; ++j) { const int d = 16 * wv + 4 * fq1 + j;
#pragma unroll
                for (int ct = 0; ct < 8; ++ct) Co[d * 128 + 16 * ct + fr1] = Cacc[ct][j];
                if (fr1 == 0) p.out[OUT_N + sidx * 128 + d] = Cacc[8][j]; }
            if (tid1 == 0) p.out[OUT_MM + sidx] = m_prev; }
        __syncthreads();
    }
}

__device__ __forceinline__ void phase_shift(bf16_t* U, const float* pmu, uint4* sRow) {
#pragma unroll 1
    for (int item = blockIdx.x; item < 1200; item += gridDim.x) {
        const int tid = opaque_tid(), tl = tid >> 3, g = tid & 7;
        const bool grid = item < 240; const int seq = grid ? item / 30 : (item - 240) / 30, sl = grid ? item % 30 : (item - 240) % 30;
        const int T = grid ? 2048 : 256, nst = T / 64; const size_t row0 = grid ? (size_t)NCTX + (size_t)seq * 2048 : (size_t)seq * 256;
        const int rc = sl * 64 + g * 8;
        char* base = (char*)(U + row0 * UW + 2048 + rc);
        const int act = (rc >= 1536 && rc < 1664) ? 1 : (rc >= 1792 ? 2 : 0);
        unsigned z0_ = 0u; asm volatile("" : "+v"(z0_));
        uint4 prv = make_uint4(z0_, z0_, z0_, z0_), cur = *(const uint4*)(base + (size_t)tl * (UW * 2)), nxt;
        __syncthreads();
#pragma unroll 1
        for (int k = 0; k < nst; ++k) {
            unsigned zr = 0u; asm volatile("" : "+v"(zr)); const uint4 z4 = make_uint4(zr, zr, zr, zr);
            nxt = z4; if (k + 1 < nst) nxt = *(const uint4*)(base + (size_t)((k + 1) * 64 + tl) * (UW * 2));
            sRow[(1 + tl) * 8 + g] = cur;
            if (tl == 0) sRow[65 * 8 + g] = nxt;
            LDS_BARRIER();
            uint4 lf = sRow[tl * 8 + g], rt = sRow[(2 + tl) * 8 + g];
            if (tl == 0 && (grid || k == 0)) lf = z4;
            if (tl == 63 && (grid || k == nst - 1)) rt = z4;
            float x[8], t[8], o[8], ms[8], m[8];
            int zz = 0; asm volatile("" : "+v"(zz)); const float* mup = pmu + rc + zz;
#define LD_MU8(a) do { const float4 m0 = *(const float4*)(mup + (a) * 1920), m1 = *(const float4*)(mup + (a) * 1920 + 4); m[0] = m0.x; m[1] = m0.y; m[2] = m0.z; m[3] = m0.w; m[4] = m1.x; m[5] = m1.y; m[6] = m1.z; m[7] = m1.w; } while (0)
            unpack8(cur, x);
            LD_MU8(0); unpack8(lf, t);
#pragma unroll
            for (int i = 0; i < 8; ++i) { o[i] = m[i] * t[i]; ms[i] = m[i]; }
            LD_MU8(1); unpack8(rt, t);
#pragma unroll
            for (int i = 0; i < 8; ++i) { o[i] += m[i] * t[i]; ms[i] += m[i]; }
            if (grid) {
                LD_MU8(2); unpack8(prv, t);
#pragma unroll
                for (int i = 0; i < 8; ++i) { o[i] += m[i] * t[i]; ms[i] += m[i]; }
                LD_MU8(3); unpack8(nxt, t);
#pragma unroll
                for (int i = 0; i < 8; ++i) { o[i] += m[i] * t[i]; ms[i] += m[i]; }
            }
#undef LD_MU8
#pragma unroll
            for (int i = 0; i < 8; ++i) o[i] += x[i] * (1.f - ms[i]);
            if (act == 1) {
#pragma unroll
                for (int i = 0; i < 8; ++i) o[i] = tanh_fast(o[i]); }
            if (act == 2) {
#pragma unroll
                for (int i = 0; i < 8; ++i) o[i] = sigmf(o[i]); }
            *(uint4*)(base + (size_t)(k * 64 + tl) * (UW * 2)) = make_uint4(pk2(o[0], o[1]), pk2(o[2], o[3]), pk2(o[4], o[5]), pk2(o[6], o[7]));
            LDS_BARRIER();
            if (tl == 63) sRow[g] = cur;
            prv = cur; cur = nxt;
        }
    }
}

constexpr int RW_TC = 16;
constexpr int RW_VEC = 0, RW_V = RW_VEC + 16 * 320 * 4, RW_KR = RW_V + 16 * 32 * 4, RW_XW = RW_KR + 16 * 64 * 4, RW_XA = RW_XW + 16 * 72 * 2, RW_Y = RW_XA + 16 * 72 * 2,
              RW_MU = RW_Y + 16 * 32 * 4, RW_DIR = RW_MU + 4 * 288 * 4;
static_assert(2 * RW_DIR <= LDS_BYTES && RW_DIR % 16 == 0, "rwkv lds");

__device__ __forceinline__ float dppf(float x, const int ctrl) { return x; }
#define DPP_ADD(x, ctrl) ((x) + __int_as_float(__builtin_amdgcn_update_dpp(0, __float_as_int(x), (ctrl), 0xf, 0xf, true)))
__device__ __forceinline__ float red8(float x) { x = DPP_ADD(x, 0xB1); x = DPP_ADD(x, 0x4E); x = DPP_ADD(x, 0x141); return x; }
__device__ __forceinline__ float red16(float x) { x = red8(x); x = DPP_ADD(x, 0x140); return x; }

struct Sh8 { uint4 x, l, r, u, d; };
__device__ __forceinline__ void sh8_load(Sh8& q, const bf16_t* U, size_t row0, int tok, int T, bool grid, int c0) {
    const char* Ub = (const char*)(U + row0 * UW);
    const int off = (tok * UW + c0) * 2; const uint4 z = make_uint4(0u, 0u, 0u, 0u);
    const bool hl = grid ? (tok & 63) != 0 : tok > 0, hr = grid ? (tok & 63) != 63 : tok < T - 1;
    q.x = *(const uint4*)(Ub + off);
    q.l = hl ? *(const uint4*)(Ub + (off - UW * 2)) : z; q.r = hr ? *(const uint4*)(Ub + (off + UW * 2)) : z;
    q.u = (grid && tok >= 64) ? *(const uint4*)(Ub + (off - 64 * UW * 2)) : z; q.d = (grid && tok < T - 64) ? *(const uint4*)(Ub + (off + 64 * UW * 2)) : z;
}
__device__ __forceinline__ void sh8_mix(const Sh8& q, bool grid, const float* mu4, int mustride, float* o) {
    float x[8], t[8], m[8], ms[8];
    unpack8(q.x, x);
    { const float4 a = *(const float4*)mu4, b = *(const float4*)(mu4 + 4); m[0] = a.x; m[1] = a.y; m[2] = a.z; m[3] = a.w; m[4] = b.x; m[5] = b.y; m[6] = b.z; m[7] = b.w; }
    unpack8(q.l, t);
#pragma unroll
    for (int i = 0; i < 8; ++i) { o[i] = m[i] * t[i]; ms[i] = m[i]; }
    { const float4 a = *(const float4*)(mu4 + mustride), b = *(const float4*)(mu4 + mustride + 4); m[0] = a.x; m[1] = a.y; m[2] = a.z; m[3] = a.w; m[4] = b.x; m[5] = b.y; m[6] = b.z; m[7] = b.w; }
    unpack8(q.r, t);
#pragma unroll
    for (int i = 0; i < 8; ++i) { o[i] += m[i] * t[i]; ms[i] += m[i]; }
    if (grid) {
        { const float4 a = *(const float4*)(mu4 + 2 * mustride), b = *(const float4*)(mu4 + 2 * mustride + 4); m[0] = a.x; m[1] = a.y; m[2] = a.z; m[3] = a.w; m[4] = b.x; m[5] = b.y; m[6] = b.z; m[7] = b.w; }
        unpack8(q.u, t);
#pragma unroll
        for (int i = 0; i < 8; ++i) { o[i] += m[i] * t[i]; ms[i] += m[i]; }
        { const float4 a = *(const float4*)(mu4 + 3 * mustride), b = *(const float4*)(mu4 + 3 * mustride + 4); m[0] = a.x; m[1] = a.y; m[2] = a.z; m[3] = a.w; m[4] = b.x; m[5] = b.y; m[6] = b.z; m[7] = b.w; }
        unpack8(q.d, t);
#pragma unroll
        for (int i = 0; i < 8; ++i) { o[i] += m[i] * t[i]; ms[i] += m[i]; }
    }
#pragma unroll
    for (int i = 0; i < 8; ++i) o[i] += x[i] * (1.f - ms[i]);
}
__device__ __forceinline__ void shifted8(const bf16_t* U, size_t row0, int tok, int T, bool grid, int c0, const float* mu4, int mustride, float* o) {
    Sh8 q; sh8_load(q, U, row0, tok, T, grid, c0); sh8_mix(q, grid, mu4, mustride, o);
}
typedef float f32x2 __attribute__((ext_vector_type(2)));

__device__ __forceinline__ void rwkv_task(const P& p, unsigned char* lds, int bg, int h, int rh) {
    const int wv = __builtin_amdgcn_readfirstlane((int)threadIdx.x >> 6), dir = wv >> 2, lw = wv & 3;
    const bool ctx = bg < 32; const int T = ctx ? 256 : 2048, nc = T / RW_TC; const size_t row0 = ctx ? (size_t)bg * 256 : (size_t)NCTX + (size_t)(bg - 32) * 2048;
    const bool grid = !ctx;
    unsigned char* L = lds + dir * RW_DIR;
    float* sVec = (float*)(L + RW_VEC); float* sV = (float*)(L + RW_V); float* sKr = (float*)(L + RW_KR); bf16_t* sXw = (bf16_t*)(L + RW_XW); bf16_t* sXa = (bf16_t*)(L + RW_XA);
    float* sY = (float*)(L + RW_Y); float* sMu = (float*)(L + RW_MU);
    const bf16_t* U = (const bf16_t*)(p.ws + WS_U); bf16_t* HB = (bf16_t*)(p.ws + WS_A);
    const int hc = h * 64;
    float st[8]; bf16x8 wfrag[2], afrag[2]; float w0v, a0v, kav;
    {
        const int tid = opaque_tid(), ltid = tid & 255, ri = ltid >> 3, jq = ltid & 7, fr = tid & 15, fq = (tid >> 4) & 3;
        __syncthreads();
        if (ctx) {
#pragma unroll
            for (int q = 0; q < 8; ++q) st[q] = 0.f;
        } else { const float* S0 = p.sS + ((size_t)(((bg - 32) * 2 + dir) * 8 + h)) * 4096 + (32 * rh + ri) * 64 + jq * 8;
#pragma unroll
            for (int q = 0; q < 8; ++q) st[q] = S0[q]; }
        const int jcol = hc + 16 * lw + fr;
#pragma unroll
        for (int ks = 0; ks < 2; ++ks) { float wf[8], af[8];
#pragma unroll
            for (int i = 0; i < 8; ++i) { const int l = 32 * ks + 8 * fq + i; wf[i] = p.w2[(size_t)(dir * 64 + l) * 512 + jcol]; af[i] = p.a2[(size_t)(dir * 64 + l) * 512 + jcol]; }
            union { uint4 u; bf16x8 v; } c1, c2; c1.u = make_uint4(pk2(wf[0], wf[1]), pk2(wf[2], wf[3]), pk2(wf[4], wf[5]), pk2(wf[6], wf[7])); c2.u = make_uint4(pk2(af[0], af[1]), pk2(af[2], af[3]), pk2(af[4], af[5]), pk2(af[6], af[7]));
            wfrag[ks] = c1.v; afrag[ks] = c2.v; }
        w0v = p.w0[dir * 512 + jcol]; a0v = p.a0[dir * 512 + jcol]; kav = p.ka[jcol];
    }
    uint4 q1, q2, q3 = make_uint4(0u, 0u, 0u, 0u);
    const char* Ub = (const char*)(U + row0 * UW);
    { const int tid = opaque_tid(), ltid = tid & 255; const int c = dir ? nc - 1 : 0, tok0 = c * RW_TC; const int tl = (ltid & 127) >> 3, g = ltid & 7;
      q1 = *(const uint4*)(Ub + ((tok0 + tl) * UW + (lw < 2 ? 2048 : 2048 + 512) + hc + 8 * g) * 2);
      q2 = *(const uint4*)(Ub + ((tok0 + tl) * UW + (lw < 2 ? 2048 + 1536 : 2048 + 1664) + dir * 64 + 8 * g) * 2);
      if (lw == 0) q3 = *(const uint4*)(Ub + ((tok0 + (ltid >> 2)) * UW + 2048 + 1024 + hc + 32 * rh + 8 * (ltid & 3)) * 2); }
    f32x2 st2[4];
#pragma unroll
    for (int q = 0; q < 4; ++q) st2[q] = (f32x2){st[2 * q], st[2 * q + 1]};
#pragma unroll 1
    for (int s = 0; s < nc; ++s) {
        const int c = dir ? nc - 1 - s : s; const int tok0 = c * RW_TC;
        const bool second = s >= (nc >> 1);
        const int tid = opaque_tid(), ltid = tid & 255, ri = ltid >> 3, jq = ltid & 7, fr = tid & 15, fq = (tid >> 4) & 3;
        { const int tl = (ltid & 127) >> 3, g = ltid & 7; float o[8];
          if (lw < 2) {
              unpack8(q1, o);
              *(float4*)(sVec + tl * 320 + 8 * g) = make_float4(o[0], o[1], o[2], o[3]); *(float4*)(sVec + tl * 320 + 8 * g + 4) = make_float4(o[4], o[5], o[6], o[7]);
              *(uint4*)(sXw + tl * 72 + 8 * g) = q2;
          } else {
              unpack8(q1, o);
              float kkr[8]; float ss = 0.f;
#pragma unroll
              for (int i = 0; i < 8; ++i) { kkr[i] = o[i] * p.kk[hc + 8 * g + i]; ss += kkr[i] * kkr[i]; }
              ss = red8(ss); const float rn = __builtin_amdgcn_rsqf(fmaxf(ss, 1e-24f));
              *(float4*)(sKr + tl * 64 + 8 * g) = make_float4(o[0], o[1], o[2], o[3]); *(float4*)(sKr + tl * 64 + 8 * g + 4) = make_float4(o[4], o[5], o[6], o[7]);
              *(float4*)(sVec + tl * 320 + 192 + 8 * g) = make_float4(kkr[0] * rn, kkr[1] * rn, kkr[2] * rn, kkr[3] * rn); *(float4*)(sVec + tl * 320 + 192 + 8 * g + 4) = make_float4(kkr[4] * rn, kkr[5] * rn, kkr[6] * rn, kkr[7] * rn);
              *(uint4*)(sXa + tl * 72 + 8 * g) = q2;
          }
          if (lw == 0) {
              const int tl2 = ltid >> 2, g2 = ltid & 3;
              unpack8(q3, o);
              *(float4*)(sV + tl2 * 32 + 8 * g2) = make_float4(o[0], o[1], o[2], o[3]); *(float4*)(sV + tl2 * 32 + 8 * g2 + 4) = make_float4(o[4], o[5], o[6], o[7]);
          } }
        __syncthreads();
        { f32x4 aw = (f32x4){0.f, 0.f, 0.f, 0.f}, aa = (f32x4){0.f, 0.f, 0.f, 0.f};
#pragma unroll
          for (int ks = 0; ks < 2; ++ks) { const bf16x8 xw = *(const bf16x8*)(sXw + fr * 72 + 32 * ks + 8 * fq), xa = *(const bf16x8*)(sXa + fr * 72 + 32 * ks + 8 * fq);
              aw = mfma16(xw, wfrag[ks], aw); aa = mfma16(xa, afrag[ks], aa); }
          const int j = 16 * lw + fr;
#pragma unroll
          for (int jj = 0; jj < 4; ++jj) { const int tl = 4 * fq + jj;
              const float dec = fexp(-fexp(-softplus_fast(-(w0v + aw[jj])) - 0.5f));
              const float a = sigmf(a0v + aa[jj]); const float k = sKr[tl * 64 + j], kn = sVec[tl * 320 + 192 + j];
              float* V = sVec + tl * 320 + j; V[64] = dec; V[128] = k * (1.f + (a - 1.f) * kav); V[256] = kn * a; } }
        const int otl = ltid >> 4, opr = ltid & 15; unsigned* hb = (unsigned*)(HB + (row0 + tok0 + otl) * DM + 512 + hc + 32 * rh + 2 * opr);
        unsigned ov = 0u;
        if (second) ov = __hip_atomic_load(hb, __ATOMIC_RELAXED, __HIP_MEMORY_SCOPE_AGENT);
        if (s + 1 < nc) { const int cn = dir ? nc - 2 - s : s + 1, tokn = cn * RW_TC; const int tl = (ltid & 127) >> 3, g = ltid & 7;
            q1 = *(const uint4*)(Ub + ((tokn + tl) * UW + (lw < 2 ? 2048 : 2048 + 512) + hc + 8 * g) * 2);
            q2 = *(const uint4*)(Ub + ((tokn + tl) * UW + (lw < 2 ? 2048 + 1536 : 2048 + 1664) + dir * 64 + 8 * g) * 2);
            if (lw == 0) q3 = *(const uint4*)(Ub + ((tokn + (ltid >> 2)) * UW + 2048 + 1024 + hc + 32 * rh + 8 * (ltid & 3)) * 2); }
        LDS_BARRIER();
        f32x2 sv_[4];
#pragma unroll
        for (int q = 0; q < 4; ++q) sv_[q] = st2[q];
#pragma unroll 1
        for (int rep = 0; rep < (PROBE_DUP == 102 ? 2 : 1); ++rep) {
        if (PROBE_DUP == 102) {
#pragma unroll
            for (int q = 0; q < 4; ++q) st2[q] = sv_[q]; }
#pragma unroll 2
        for (int step = 0; step < RW_TC; ++step) { const int tl = dir ? RW_TC - 1 - step : step; const float* V = sVec + tl * 320 + jq * 8;
            const float4 ka4 = *(const float4*)(V + 192), kb4 = *(const float4*)(V + 196);
            f32x2 acc = st2[0] * (f32x2){ka4.x, ka4.y}; acc = st2[1] * (f32x2){ka4.z, ka4.w} + acc; acc = st2[2] * (f32x2){kb4.x, kb4.y} + acc; acc = st2[3] * (f32x2){kb4.z, kb4.w} + acc;
            const float sa = -red8(acc.x + acc.y);
            const float vi = sV[tl * 32 + ri];
            const float4 wa = *(const float4*)(V + 64), wb = *(const float4*)(V + 68), ba = *(const float4*)(V + 256), bb = *(const float4*)(V + 260),
                         da = *(const float4*)(V + 128), db = *(const float4*)(V + 132), ra = *(const float4*)(V), rb = *(const float4*)(V + 4);
            const f32x2 sa2 = (f32x2){sa, sa}, vi2 = (f32x2){vi, vi};
            st2[0] = st2[0] * (f32x2){wa.x, wa.y} + (sa2 * (f32x2){ba.x, ba.y} + vi2 * (f32x2){da.x, da.y});
            st2[1] = st2[1] * (f32x2){wa.z, wa.w} + (sa2 * (f32x2){ba.z, ba.w} + vi2 * (f32x2){da.z, da.w});
            st2[2] = st2[2] * (f32x2){wb.x, wb.y} + (sa2 * (f32x2){bb.x, bb.y} + vi2 * (f32x2){db.x, db.y});
            st2[3] = st2[3] * (f32x2){wb.z, wb.w} + (sa2 * (f32x2){bb.z, bb.w} + vi2 * (f32x2){db.z, db.w});
            f32x2 ya = st2[0] * (f32x2){ra.x, ra.y}; ya = st2[1] * (f32x2){ra.z, ra.w} + ya; ya = st2[2] * (f32x2){rb.x, rb.y} + ya; ya = st2[3] * (f32x2){rb.z, rb.w} + ya;
            const float y = red8(ya.x + ya.y);
            if (jq == 0) sY[tl * 32 + ri] = y; }
        }
        LDS_BARRIER();
        { float y0 = sY[otl * 32 + 2 * opr], y1 = sY[otl * 32 + 2 * opr + 1];
          if (second) { y0 += __uint_as_float(ov << 16); y1 += __uint_as_float(ov & 0xffff0000u); }
          *hb = pk2(y0, y1); }
    }
#pragma unroll
    for (int q = 0; q < 4; ++q) { st[2 * q] = st2[q].x; st[2 * q + 1] = st2[q].y; }
    if (ctx) { const int tid = opaque_tid(), ltid = tid & 255, ri = ltid >> 3, jq = ltid & 7;
        float* So = p.out + OUT_S + ((size_t)((bg * 2 + dir) * 8 + h)) * 4096 + (32 * rh + ri) * 64 + jq * 8;
#pragma unroll
        for (int q = 0; q < 8; ++q) So[q] = st[q]; }
    __syncthreads();
}

constexpr int FZ_ROW = 1800;
constexpr int FZ_X = 0, FZ_MU = 32 * FZ_ROW * 2, FZ_END = FZ_MU + 4 * 1792 * 4;
static_assert(FZ_END <= LDS_BYTES && FZ_MU % 16 == 0, "finalize lds");

__device__ __forceinline__ void phase_rwkv_finalize(const P& p, unsigned char* lds) {
    bf16_t* sX = (bf16_t*)(lds + FZ_X); float* sMu = (float*)(lds + FZ_MU);
    const bf16_t* U = (const bf16_t*)(p.ws + WS_U); bf16_t* HB = (bf16_t*)(p.ws + WS_A);
    { const bf16_t* HB2 = (const bf16_t*)(p.ws + WS_HB2); const int tid0 = opaque_tid(), lane = tid0 & 63, wave = (int)threadIdx.x >> 6;
#pragma unroll 1
      for (int row = NCTX + blockIdx.x * 8 + wave; row < MT; row += gridDim.x * 8) {
          float hf[8], hb[8], og[8], v[8]; float ss = 0.f;
          unpack8(*(const uint4*)(HB + (size_t)row * DM + lane * 8), hf); unpack8(*(const uint4*)(HB2 + (size_t)(row - NCTX) * 512 + lane * 8), hb); unpack8(*(const uint4*)(U + (size_t)row * UW + 1536 + lane * 8), og);
#pragma unroll
          for (int i = 0; i < 8; ++i) { v[i] = sigmf(og[i]) * (hf[i] + hb[i]); ss += v[i] * v[i]; }
          ss = red16(ss); const float rms = rsqrtf(ss * (1.f / 128.f) + 1e-6f);
          const float4 g0 = *(const float4*)(p.hg + lane * 8), g1 = *(const float4*)(p.hg + lane * 8 + 4);
          *(uint4*)(HB + (size_t)row * DM + lane * 8) = make_uint4(pk2(v[0] * rms * g0.x, v[1] * rms * g0.y), pk2(v[2] * rms * g0.z, v[3] * rms * g0.w), pk2(v[4] * rms * g1.x, v[5] * rms * g1.y), pk2(v[6] * rms * g1.z, v[7] * rms * g1.w)); } }
    const bf16_t* A2 = (const bf16_t*)(p.ws + WS_A2BF); const bf16_t* G2 = (const bf16_t*)(p.ws + WS_G2BF);
    const int wv = __builtin_amdgcn_readfirstlane((int)threadIdx.x >> 6), hc = wv * 64;
#pragma unroll 1
    for (int tile = blockIdx.x; tile < MT / 32; tile += gridDim.x) {
        const int tid = opaque_tid(), fr = tid & 15, fq = (tid >> 4) & 3;
        const int rowt = tile * 32; const bool ctx = rowt < NCTX; const int T = ctx ? 256 : 2048; const size_t row0 = ctx ? (size_t)(rowt & ~255) : (size_t)NCTX + (size_t)((rowt - NCTX) & ~2047);
        const int tokt = rowt - (int)row0;
        __syncthreads();
#pragma unroll 2
        for (int it = 0; it < 14; ++it) { const int item = it * NTHR + tid, tl = item / 224, gi = item % 224;
            const int c0 = gi < 192 ? 2048 + 8 * gi : 2048 + 1664 + 8 * (gi - 192);
            *(uint4*)(sX + tl * FZ_ROW + 8 * gi) = *(const uint4*)(U + (row0 + tokt + tl) * UW + c0); }
        __syncthreads();
#pragma unroll 1
        for (int rt = 0; rt < 2; ++rt) {
            f32x4 af[4], ab[4], gg[4];
#pragma unroll
            for (int ct = 0; ct < 4; ++ct) { af[ct] = (f32x4){0.f, 0.f, 0.f, 0.f}; ab[ct] = af[ct]; gg[ct] = af[ct]; }
            const bf16_t* xr = sX + (16 * rt + fr) * FZ_ROW;
#pragma unroll
            for (int ks = 0; ks < 2; ++ks) { const bf16x8 xf = *(const bf16x8*)(xr + 1536 + 32 * ks + 8 * fq), xb = *(const bf16x8*)(xr + 1600 + 32 * ks + 8 * fq);
#pragma unroll
                for (int ct = 0; ct < 4; ++ct) { const int n = hc + 16 * ct + fr;
                    af[ct] = mfma16(xf, *(const bf16x8*)(A2 + (size_t)n * 64 + 32 * ks + 8 * fq), af[ct]);
                    ab[ct] = mfma16(xb, *(const bf16x8*)(A2 + (size_t)(512 + n) * 64 + 32 * ks + 8 * fq), ab[ct]); } }
#pragma unroll
            for (int ks = 0; ks < 4; ++ks) { const bf16x8 xg = *(const bf16x8*)(xr + 1664 + 32 * ks + 8 * fq);
#pragma unroll
                for (int ct = 0; ct < 4; ++ct) { const int n = hc + 16 * ct + fr; gg[ct] = mfma16(xg, *(const bf16x8*)(G2 + (size_t)n * 128 + 32 * ks + 8 * fq), gg[ct]); } }
#pragma unroll
            for (int jj = 0; jj < 4; ++jj) { const int tl = 16 * rt + 4 * fq + jj; const size_t row = (size_t)rowt + tl; const bf16_t* xt = sX + tl * FZ_ROW;
                bf16_t* hb = HB + row * DM + 512 + hc;
                float y[4], vv[4]; float sy = 0.f, sb = 0.f;
#pragma unroll
                for (int ct = 0; ct < 4; ++ct) { const int ch = hc + 16 * ct + fr;
                    const float am = 0.5f * (sigmf(p.a0[ch] + af[ct][jj]) + sigmf(p.a0[512 + ch] + ab[ct][jj]));
                    const float r = bf2f(xt[ch]), k = bf2f(xt[512 + ch]); vv[ct] = bf2f(xt[1024 + ch]);
                    sb += r * k * (1.f + (am - 1.f) * p.ka[ch]) * p.rk[ch];
                    y[ct] = bf2f(hb[16 * ct + fr]); sy += y[ct]; }
                sy = red16(sy); sb = red16(sb);
                const float mean = sy * (1.f / 64.f); float vs = 0.f;
#pragma unroll
                for (int ct = 0; ct < 4; ++ct) { const float d = y[ct] - mean; vs += d * d; }
                vs = red16(vs); const float rstd = rsqrtf(vs * (1.f / 64.f) + 64e-5f);
#pragma unroll
                for (int ct = 0; ct < 4; ++ct) { const int ch = hc + 16 * ct + fr; const float yn = (y[ct] - mean) * rstd * p.lng[ch] + p.lnb[ch];
                    hb[16 * ct + fr] = f2bf((yn + sb * vv[ct]) * gg[ct][jj]); } }
        }
    }
}

__device__ __forceinline__ void phase_scan(const P& p, unsigned char* lds, int round = 0) {
    unsigned* ctr = (unsigned*)(p.ws + WS_CTR) + round;
    volatile int* sTask = (volatile int*)(lds + LDS_BYTES - 16);
#pragma unroll 1
    for (;;) {
        __syncthreads();
        if (threadIdx.x == 0) *sTask = (int)atomicAdd(ctr, 1u);
        __syncthreads();
        const int t = __builtin_amdgcn_readfirstlane(*sTask);
        if (t >= 832) break;
#pragma unroll 1
        for (int rep = 0; rep < ((PROBE_DUP == 100 && (t < 64 || (t >= 192 && t < 320))) || (PROBE_DUP == 101 && !(t < 64 || (t >= 192 && t < 320))) ? 2 : 1); ++rep) {
        if (t < 64) mlstm_task(p, lds, 32 + (t >> 3), (t >> 1) & 3, t & 1);
        else if (t < 192) { const int q = t - 64; rwkv_task(p, lds, 32 + (q >> 4), (q >> 1) & 7, q & 1); }
        else if (t < 320) { const int q = t - 192; mlstm_task(p, lds, q >> 2, q & 3, -1); }
        else { const int q = t - 320; rwkv_task(p, lds, q >> 4, (q >> 1) & 7, q & 1); }
        }
    }
}

__device__ void phase_convert_w2(const P& p, unsigned char* lds) {
    float* tile = (float*)lds;
    const int t1 = 16 * 88, t2 = 44 * 16;
    for (int it = blockIdx.x; it < t1 + t2; it += gridDim.x) {
        if (it < t1) do_convert(p.w2in, (bf16_t*)(p.ws + WS_W1), 1024, 5632, 5632, 1, it, tile);
        else do_convert(p.w2out, (bf16_t*)(p.ws + WS_W1B), 2816, 1024, 1024, 0, it - t1, tile);
    }
}

constexpr int NPHASE = 12;
template <int PH>
__device__ __forceinline__ void run_phase(const P& p, unsigned char* lds) {
    const float* mod = (const float*)(p.ws + WS_MOD);
    if constexpr (PH == 0) phase0(p, lds);
    if constexpr (PH == 1) phase_normmod(p, 0);
    if constexpr (PH == 2) { EpiSwiglu E{(bf16_t*)(p.ws + WS_U)}; run_gemm(lds, (const bf16_t*)(p.ws + WS_A), (const bf16_t*)(p.ws + WS_W1), 5632, 1024, E); }
    if constexpr (PH == 3) { EpiResid E{p.xp, p.xs, p.out, mod + 2048, 0.5f, 0}; run_gemm(lds, (const bf16_t*)(p.ws + WS_U), (const bf16_t*)(p.ws + WS_W1B), 1024, 2816, E); }
    if constexpr (PH == 4) phase_normmod(p, 1);
    if constexpr (PH == 5) { EpiU E{(bf16_t*)(p.ws + WS_U), (float*)(p.ws + WS_GATES)}; run_gemm(lds, (const bf16_t*)(p.ws + WS_A), (const bf16_t*)(p.ws + WS_BT3), 4096, 1024, E); }
    if constexpr (PH == 6) phase_scan(p, lds);
    if constexpr (PH == 12) phase_rwkv_finalize(p, lds);
    if constexpr (PH == 13) phase_shift((bf16_t*)(p.ws + WS_U), p.mu, (uint4*)lds);
    if constexpr (PH == 7) { EpiResid E{p.xp, p.xs, p.out, mod + 5120, 1.0f, 1}; run_gemm(lds, (const bf16_t*)(p.ws + WS_A), (const bf16_t*)(p.ws + WS_BT4), 1024, 1024, E); }
    if constexpr (PH == 8) { phase_normmod(p, 2); phase_convert_w2(p, lds); }
    if constexpr (PH == 9) { EpiSwiglu E{(bf16_t*)(p.ws + WS_U)}; run_gemm(lds, (const bf16_t*)(p.ws + WS_A), (const bf16_t*)(p.ws + WS_W1), 5632, 1024, E); }
    if constexpr (PH == 10) { EpiResid E{p.xp, p.xs, p.out, mod + 8192, 0.5f, 1}; run_gemm(lds, (const bf16_t*)(p.ws + WS_U), (const bf16_t*)(p.ws + WS_W1B), 1024, 2816, E); }
    if constexpr (PH == 11) phase_finalnorm(p);
}

#if !ONE_LAUNCH
template <int PH>
__global__ void __launch_bounds__(NTHR, 2) k_phase(P p) {
    extern __shared__ __attribute__((aligned(16))) unsigned char lds[];
    run_phase<PH>(p, lds);
}
#endif

#if ONE_LAUNCH
__global__ void __launch_bounds__(NTHR, 2) k_mega(P p) {
    extern __shared__ __attribute__((aligned(16))) unsigned char lds[];
    cg::grid_group grid = cg::this_grid();
    run_phase<0>(p, lds); grid.sync();
    if (PROBE_DUP == 0) { run_phase<0>(p, lds); grid.sync(); }
    run_phase<1>(p, lds); grid.sync();
    if (PROBE_DUP == 1) { run_phase<1>(p, lds); grid.sync(); }
    run_phase<2>(p, lds); grid.sync();
    if (PROBE_DUP == 2 || PROBE_DUP == 235) { run_phase<2>(p, lds); grid.sync(); }
    run_phase<3>(p, lds); grid.sync();
    if (PROBE_DUP == 3 || PROBE_DUP == 235) { run_phase<3>(p, lds); grid.sync(); }
    run_phase<4>(p, lds); grid.sync();
    if (PROBE_DUP == 4) { run_phase<4>(p, lds); grid.sync(); }
    run_phase<5>(p, lds); grid.sync();
    if (PROBE_DUP == 5 || PROBE_DUP == 235) { run_phase<5>(p, lds); grid.sync(); }
    run_phase<13>(p, lds); grid.sync();
    run_phase<6>(p, lds); grid.sync();
    if (PROBE_DUP == 6) { phase_scan(p, lds, 1); grid.sync(); }
    run_phase<12>(p, lds); grid.sync();
    run_phase<7>(p, lds); grid.sync();
    if (PROBE_DUP == 7) { run_phase<7>(p, lds); grid.sync(); }
    run_phase<8>(p, lds); grid.sync();
    if (PROBE_DUP == 8) { run_phase<8>(p, lds); grid.sync(); }
    run_phase<9>(p, lds); grid.sync();
    if (PROBE_DUP == 9) { run_phase<9>(p, lds); grid.sync(); }
    run_phase<10>(p, lds); grid.sync();
    if (PROBE_DUP == 10) { run_phase<10>(p, lds); grid.sync(); }
    run_phase<11>(p, lds);
}
#endif

#if !ONE_LAUNCH
template <int PH> static void launch_phase(const P& p, int grid, hipStream_t stream) {
    static bool attr = false;
    if (!attr) { (void)hipFuncSetAttribute((const void*)k_phase<PH>, hipFuncAttributeMaxDynamicSharedMemorySize, LDS_BYTES); attr = true; }
    hipLaunchKernelGGL(k_phase<PH>, dim3(grid), dim3(NTHR), LDS_BYTES, stream, p);
}
#endif

extern "C" void kernel_launch(void* const* d_in, const int* in_sizes, int n_in, void* d_out, int out_size, void* d_ws, size_t ws_size, hipStream_t stream) {
    (void)in_sizes; (void)n_in; (void)out_size; (void)ws_size;
    static int grid = 0;
    if (grid == 0) {
        int dev = 0, cus = 0;
        if (hipGetDevice(&dev) != hipSuccess || hipDeviceGetAttribute(&cus, hipDeviceAttributeMultiprocessorCount, dev) != hipSuccess || cus <= 0) cus = 256;
#if ONE_LAUNCH
        (void)hipFuncSetAttribute((const void*)k_mega, hipFuncAttributeMaxDynamicSharedMemorySize, LDS_BYTES);
        int per_cu = 0;
        if (hipOccupancyMaxActiveBlocksPerMultiprocessor(&per_cu, (const void*)k_mega, NTHR, LDS_BYTES) != hipSuccess || per_cu < 1) per_cu = 1;
        (void)hipGetLastError();
#endif
        grid = cus;
    }
    P p{};
    const float** f = (const float**)&p;
    for (int i = 0; i < 35; ++i) f[i] = (const float*)d_in[i];
    p.out = (float*)d_out; p.ws = (unsigned char*)d_ws;
    (void)hipMemsetAsync((char*)d_ws + WS_MOD, 0, NCOND * MODW * sizeof(float) + 256, stream);
#if ONE_LAUNCH
    void* args[] = {&p};
    hipError_t e = hipLaunchCooperativeKernel((const void*)k_mega, dim3(grid), dim3(NTHR), args, LDS_BYTES, stream);
    if (e != hipSuccess) fprintf(stderr, "cooperative launch failed: %s (grid %d)\n", hipGetErrorString(e), grid);
#else
    launch_phase<0>(p, grid, stream); launch_phase<1>(p, grid, stream); launch_phase<2>(p, grid, stream); launch_phase<3>(p, grid, stream);
    launch_phase<4>(p, grid, stream); launch_phase<5>(p, grid, stream); launch_phase<13>(p, grid, stream); launch_phase<6>(p, grid, stream); launch_phase<12>(p, grid, stream); launch_phase<7>(p, grid, stream);
    launch_phase<8>(p, grid, stream); launch_phase<9>(p, grid, stream); launch_phase<10>(p, grid, stream); launch_phase<11>(p, grid, stream);
#endif
}
```

```cpp
#include <hip/hip_runtime.h>
#include <hip/hip_cooperative_groups.h>
#include <cstdio>
#include <cstdint>
namespace cg = cooperative_groups;

#ifndef PROBE_DUP
#define PROBE_DUP -1
#endif
#ifndef ONE_LAUNCH
#define ONE_LAUNCH 1
#endif

#define LDS_BARRIER() do { asm volatile("s_waitcnt lgkmcnt(0)" ::: "memory"); __builtin_amdgcn_s_barrier(); asm volatile("" ::: "memory"); } while (0)
__device__ __forceinline__ int opaque_tid() { int z = 0; asm volatile("" : "+v"(z)); return (int)threadIdx.x + z; }

namespace pg8 {
#define PG8_LAS __attribute__((address_space(3)))
typedef unsigned short bf16_t;
typedef short bf16x8 __attribute__((ext_vector_type(8)));
typedef float f32x4 __attribute__((ext_vector_type(4)));
typedef unsigned u32x4 __attribute__((ext_vector_type(4)));
constexpr int BM = 256, BK = 64, HALF = 128, HTB = HALF * BK * 2, STAGE_BYTES = 8 * HTB, NXCD = 8, WGM = 8;

__host__ __device__ __forceinline__ int lds_byte(int r, int c) { const int st = (r >> 4) * 2 + (c >> 5), rr = r & 15, cc = c & 31, ob = rr * 64 + cc * 2; return st * 1024 + (ob ^ (((ob >> 9) & 1) << 5)); }
__host__ __device__ __forceinline__ void stage_rc(int b, int& R, int& C) { const int st = b / 1024, sb = b % 1024, swz = sb ^ (((sb >> 9) & 1) << 5); R = (st >> 1) * 16 + swz / 64; C = (st & 1) * 32 + (swz % 64) / 2; }
__host__ __device__ __forceinline__ int perm32(int rho) { const int n = rho >> 4, i = rho & 15; return 8 * (i >> 2) + 4 * n + (i & 3); }

struct Unit { int pm, pn; };
struct Gemm { const bf16_t* A; const bf16_t* Bt; int M, N, K; };

struct StaticOrder {
    int nM, nN, nwg, G, c;
    __host__ __device__ void init(int M, int N, int G_, int c_) { nM = M / BM; nN = N / BM; nwg = nM * nN; G = G_; c = c_; }
    __host__ __device__ bool next(int i, Unit& u) const {
        const long L = (long)i * G + c; if (L >= nwg) return false;
        int wgid = (int)L; { const int q = nwg / NXCD, r = nwg % NXCD, xcd = wgid % NXCD, off = wgid / NXCD; wgid = (xcd < r ? xcd * (q + 1) : r * (q + 1) + (xcd - r) * q) + off; }
        const int nig = WGM * nN, gid = wgid / nig, fm = gid * WGM, gsz = (nM - fm) < WGM ? (nM - fm) : WGM;
        u.pm = fm + ((wgid % nig) % gsz); u.pn = (wgid % nig) / gsz; return true;
    }
    __device__ __forceinline__ void a_ready(const Unit&) const {}
    __device__ __forceinline__ void done(const Unit&) const {}
};

__device__ __forceinline__ unsigned cvt_pk_bf16(float lo, float hi) { unsigned r; asm volatile("v_cvt_pk_bf16_f32 %0, %1, %2" : "=v"(r) : "v"(lo), "v"(hi)); return r; }

template <class Epi, class Sched, bool ALIGN_EPI = false, bool SP2 = false>
__device__ __forceinline__ void gemm_phase(PG8_LAS unsigned char* lds, const Gemm g, const Sched& S, const Epi& E) {
    const int tid = opaque_tid(), wid = __builtin_amdgcn_readfirstlane((int)threadIdx.x >> 6), lane = tid & 63, wr = wid >> 2, wc = wid & 3, fr = lane & 15, fq = lane >> 4;
    const int K = g.K, nt = K / BK;
    unsigned voffA[2], voffB[2];
#pragma unroll
    for (int i = 0; i < 2; ++i) { int R, C; stage_rc(tid * 16 + i * 8192, R, C); const int Rb = Epi::PERM ? ((R & ~31) + perm32(R & 31)) : R;
        voffA[i] = (unsigned)(R * K + C) * 2u; voffB[i] = (unsigned)(Rb * K + C) * 2u; }
    const size_t kstep = (size_t)(BK * 2);
    const size_t hstep = (size_t)HALF * K * 2;
    const size_t tstep = 2 * hstep;
    const unsigned ldsw = (unsigned)wid * 1024u;
    const int aoff = lds_byte(wr * 64 + fr, fq * 8), boff = lds_byte(wc * 32 + fr, fq * 8);
#define PG8_SA(b, h) (((b) * 2 + (h)) * HTB)
#define PG8_SB(b, h) ((4 + (b) * 2 + (h)) * HTB)
#define PG8_STAGE(bufoff, gbase, voff) do { _Pragma("unroll") for (int _i = 0; _i < 2; ++_i) \
        __builtin_amdgcn_global_load_lds((const unsigned*)((const char*)(gbase) + (voff)[_i]), (PG8_LAS unsigned*)(lds + (bufoff) + ldsw + _i * 8192), 16, 0, 0); } while (0)
#define PG8_LDA(dst, b, h) do { _Pragma("unroll") for (int m = 0; m < 4; ++m) _Pragma("unroll") for (int k = 0; k < 2; ++k) dst[m][k] = *(const PG8_LAS bf16x8*)(lds + PG8_SA(b, h) + aoff + m * 2048 + k * 1024); } while (0)
#define PG8_LDB(dst, b, h) do { _Pragma("unroll") for (int n = 0; n < 2; ++n) _Pragma("unroll") for (int k = 0; k < 2; ++k) dst[n][k] = *(const PG8_LAS bf16x8*)(lds + PG8_SB(b, h) + boff + n * 2048 + k * 1024); } while (0)
#define PG8_MMA(ai, bj, At, Bt) do { __builtin_amdgcn_s_setprio(1); _Pragma("unroll") for (int m = 0; m < 4; ++m) _Pragma("unroll") for (int n = 0; n < 2; ++n) _Pragma("unroll") for (int k = 0; k < 2; ++k) \
        acc[ai][bj][m][n] = __builtin_amdgcn_mfma_f32_16x16x32_bf16(Bt[n][k], At[m][k], acc[ai][bj][m][n], 0, 0, 0); __builtin_amdgcn_s_setprio(0); } while (0)
#define PG8_WAIT_V(n) asm volatile("s_waitcnt vmcnt(" #n ")" ::: "memory")
#define PG8_WAIT_L(n) asm volatile("s_waitcnt lgkmcnt(" #n ")" ::: "memory")
#define PG8_BAR __builtin_amdgcn_s_barrier()
#define PG8_SCHED __builtin_amdgcn_sched_barrier(0)
    Unit cur, nxt; int ui = 0;
    if (!S.next(0, cur)) return;
    f32x4 acc[2][2][4][2];
#pragma unroll
    for (int a = 0; a < 2; ++a)
#pragma unroll
        for (int b = 0; b < 2; ++b)
#pragma unroll
            for (int m = 0; m < 4; ++m)
#pragma unroll
                for (int n = 0; n < 2; ++n) acc[a][b][m][n] = (f32x4){0.f, 0.f, 0.f, 0.f};
    bf16x8 At[4][2], B0[2][2], B1[2][2];
    const char* cA = (const char*)g.A + (size_t)cur.pm * tstep; const char* cB = (const char*)g.Bt + (size_t)cur.pn * tstep;
    S.a_ready(cur);
    if constexpr (SP2) {
        PG8_STAGE(PG8_SB(0, 0), cB, voffB); PG8_STAGE(PG8_SB(0, 1), cB + hstep, voffB); PG8_STAGE(PG8_SA(0, 0), cA, voffA); PG8_STAGE(PG8_SA(0, 1), cA + hstep, voffA);
        if (wr == 1) PG8_BAR;
        PG8_WAIT_V(2); PG8_BAR;
        PG8_STAGE(PG8_SB(1, 0), cB + kstep, voffB); PG8_STAGE(PG8_SA(1, 0), cA + kstep, voffA); PG8_STAGE(PG8_SB(1, 1), cB + hstep + kstep, voffB);
        PG8_WAIT_V(6); PG8_BAR;
    } else {
        PG8_STAGE(PG8_SB(0, 0), cB, voffB); PG8_STAGE(PG8_SA(0, 0), cA, voffA); PG8_STAGE(PG8_SB(0, 1), cB + hstep, voffB); PG8_STAGE(PG8_SA(0, 1), cA + hstep, voffA);
        if (wr == 1) PG8_BAR;
        PG8_WAIT_V(4); PG8_BAR;
        PG8_STAGE(PG8_SB(1, 0), cB + kstep, voffB); PG8_STAGE(PG8_SA(1, 0), cA + kstep, voffA); PG8_STAGE(PG8_SB(1, 1), cB + hstep + kstep, voffB);
        PG8_WAIT_V(6); PG8_BAR;
    }
    for (;;) {
        const bool has_next = S.next(ui + 1, nxt);
        const char* nA = has_next ? (const char*)g.A + (size_t)nxt.pm * tstep : cA; const char* nB = has_next ? (const char*)g.Bt + (size_t)nxt.pn * tstep : cB;
        for (int t = 0; t < nt; t += 2) {
            const bool last = (t == nt - 2);
            const char* a1 = cA + (size_t)(t + 1) * kstep;
            const char* a2 = last ? nA : cA + (size_t)(t + 2) * kstep; const char* b2 = last ? nB : cB + (size_t)(t + 2) * kstep;
            const char* a3 = a2 + kstep; const char* b3 = b2 + kstep;
            if (last && has_next) S.a_ready(nxt);
            if constexpr (SP2) {
            PG8_LDB(B0, 0, 0); PG8_LDB(B1, 0, 1); PG8_SCHED; PG8_LDA(At, 0, 0); PG8_STAGE(PG8_SA(1, 1), a1 + hstep, voffA);
            PG8_WAIT_V(8); PG8_WAIT_L(0); PG8_BAR; PG8_MMA(0, 0, At, B0); PG8_MMA(0, 1, At, B1); PG8_BAR; PG8_SCHED;
            PG8_LDA(At, 0, 1); PG8_STAGE(PG8_SB(0, 0), b2, voffB); PG8_STAGE(PG8_SB(0, 1), b2 + hstep, voffB); PG8_STAGE(PG8_SA(0, 0), a2, voffA);
            PG8_WAIT_V(8); PG8_WAIT_L(0); PG8_BAR; PG8_MMA(1, 0, At, B0); PG8_MMA(1, 1, At, B1); PG8_BAR; PG8_SCHED;
            PG8_LDB(B0, 1, 0); PG8_LDB(B1, 1, 1); PG8_SCHED; PG8_LDA(At, 1, 0); PG8_STAGE(PG8_SA(0, 1), a2 + hstep, voffA);
            PG8_WAIT_V(8); PG8_WAIT_L(0); PG8_BAR; PG8_MMA(0, 0, At, B0); PG8_MMA(0, 1, At, B1); PG8_BAR; PG8_SCHED;
            PG8_LDA(At, 1, 1); PG8_STAGE(PG8_SB(1, 0), b3, voffB); PG8_STAGE(PG8_SB(1, 1), b3 + hstep, voffB); PG8_STAGE(PG8_SA(1, 0), a3, voffA);
            PG8_WAIT_V(8); PG8_WAIT_L(0); PG8_BAR; PG8_MMA(1, 0, At, B0); PG8_MMA(1, 1, At, B1); PG8_BAR; PG8_SCHED;
            } else {
            PG8_LDB(B0, 0, 0); PG8_SCHED; PG8_LDA(At, 0, 0); PG8_STAGE(PG8_SA(1, 1), a1 + hstep, voffA);
            PG8_WAIT_L(8); PG8_BAR; PG8_WAIT_L(0); PG8_MMA(0, 0, At, B0); PG8_BAR; PG8_SCHED;
            PG8_LDB(B1, 0, 1); PG8_STAGE(PG8_SB(0, 0), b2, voffB);
            PG8_BAR; PG8_WAIT_L(0); PG8_MMA(0, 1, At, B1); PG8_BAR;
            PG8_LDA(At, 0, 1); PG8_STAGE(PG8_SA(0, 0), a2, voffA);
            PG8_BAR; PG8_WAIT_L(0); PG8_MMA(1, 0, At, B0); PG8_BAR; PG8_SCHED;
            PG8_STAGE(PG8_SB(0, 1), b2 + hstep, voffB);
            PG8_WAIT_V(6); PG8_BAR; PG8_MMA(1, 1, At, B1); PG8_BAR;
            PG8_LDB(B0, 1, 0); PG8_SCHED; PG8_LDA(At, 1, 0); PG8_STAGE(PG8_SA(0, 1), a2 + hstep, voffA);
            PG8_WAIT_L(8); PG8_BAR; PG8_WAIT_L(0); PG8_MMA(0, 0, At, B0); PG8_BAR; PG8_SCHED;
            PG8_LDB(B1, 1, 1); PG8_STAGE(PG8_SB(1, 0), b3, voffB);
            PG8_BAR; PG8_WAIT_L(0); PG8_MMA(0, 1, At, B1); PG8_BAR;
            PG8_LDA(At, 1, 1); PG8_STAGE(PG8_SA(1, 0), a3, voffA);
            PG8_BAR; PG8_WAIT_L(0); PG8_MMA(1, 0, At, B0); PG8_BAR; PG8_SCHED;
            PG8_STAGE(PG8_SB(1, 1), b3 + hstep, voffB);
            PG8_WAIT_V(6); PG8_BAR; PG8_MMA(1, 1, At, B1); PG8_BAR;
            }
        }
        if constexpr (ALIGN_EPI) { if (wr == 0) PG8_BAR; }
        E(acc, cur, wr, wc, fr, fq); S.done(cur);
        if (!has_next) break;
#pragma unroll
        for (int a = 0; a < 2; ++a)
#pragma unroll
            for (int b = 0; b < 2; ++b)
#pragma unroll
                for (int m = 0; m < 4; ++m)
#pragma unroll
                    for (int n = 0; n < 2; ++n) acc[a][b][m][n] = (f32x4){0.f, 0.f, 0.f, 0.f};
        cur = nxt; cA = nA; cB = nB; ++ui;
        if constexpr (ALIGN_EPI) { if (wr == 1) PG8_BAR; }
    }
    PG8_WAIT_V(0);
    if constexpr (!ALIGN_EPI) { if (wr == 0) PG8_BAR; }
    PG8_BAR;
#undef PG8_SA
#undef PG8_SB
#undef PG8_STAGE
#undef PG8_LDA
#undef PG8_LDB
#undef PG8_MMA
#undef PG8_WAIT_V
#undef PG8_WAIT_L
#undef PG8_BAR
#undef PG8_SCHED
}
}

using pg8::bf16_t; using pg8::bf16x8; using pg8::f32x4;

constexpr int MT = 24576, DM = 1024, DFF = 2816, NCTX = 8192;
constexpr int UW = 3984;
constexpr int NCOND = 9, MODW = 9216;
constexpr size_t MiB = 1ull << 20;
constexpr size_t WS_A = 0, WS_U = 48 * MiB, WS_W1 = WS_U + 132 * MiB, WS_W1B = WS_W1 + (size_t)5632 * 1024 * 2,
                 WS_BT3 = 235 * MiB, WS_HB2 = 235 * MiB  ,
                 WS_BT4 = 251 * MiB, WS_MOD = 253 * MiB, WS_CTR = WS_MOD + 9 * 9216 * 4  , WS_GATES = 254 * MiB;
constexpr size_t WS_A2BF = 255 * MiB + 512 * 1024, WS_G2BF = WS_A2BF + 2 * 512 * 64 * 2;
constexpr int OUT_C = 25165824, OUT_N = 29360128, OUT_MM = 29392896, OUT_S = 29393152;
constexpr int LDS_BYTES = 163840;
constexpr int NTHR = 512;

struct P {
    const float *xp, *xs, *c, *sC, *sn, *sm, *sS, *cctx, *ada_w, *ada_b, *n1, *w1in, *w1out, *nmix, *wmin, *wmout,
        *cw, *cb, *gb, *hg, *mu, *w0, *w2, *a0, *a2, *g2, *kk, *ka, *rk, *lng, *lnb, *n2, *w2in, *w2out, *nf;
    float* out; unsigned char* ws;
};

__device__ __forceinline__ unsigned short f2bf(float f) { unsigned u = __float_as_uint(f); u += 0x7FFFu + ((u >> 16) & 1u); return (unsigned short)(u >> 16); }
__device__ __forceinline__ float bf2f(unsigned short b) { return __uint_as_float(((unsigned)b) << 16); }
__device__ __forceinline__ unsigned pk2(float a, float b) { return (unsigned)f2bf(a) | ((unsigned)f2bf(b) << 16); }
__device__ __forceinline__ int cond_of(int row) { return row < NCTX ? 0 : 1 + ((row - NCTX) >> 11); }
__device__ __forceinline__ float fexp(float x) { return __builtin_amdgcn_exp2f(x * 1.4426950408889634f); }
__device__ __forceinline__ float flog(float x) { return __builtin_amdgcn_logf(x) * 0.6931471805599453f; }
__device__ __forceinline__ float siluf(float x) { return x * __builtin_amdgcn_rcpf(1.f + fexp(-x)); }
__device__ __forceinline__ float sigmf(float x) { return __builtin_amdgcn_rcpf(1.f + fexp(-x)); }
__device__ __forceinline__ float tanh_fast(float x) { return 1.f - 2.f * __builtin_amdgcn_rcpf(1.f + fexp(2.f * x)); }
__device__ __forceinline__ float softplus_fast(float z) { return fmaxf(z, 0.f) + flog(1.f + fexp(-fabsf(z))); }
__device__ __forceinline__ const float* xrow(const P& p, int row) { return row < NCTX ? p.xp + (size_t)row * DM : p.xs + (size_t)(row - NCTX) * DM; }
__device__ __forceinline__ f32x4 mfma16(bf16x8 a, bf16x8 b, f32x4 c) { return __builtin_amdgcn_mfma_f32_16x16x32_bf16(a, b, c, 0, 0, 0); }
__device__ __forceinline__ void unpack8(uint4 v, float* f) {
    f[0] = __uint_as_float(v.x << 16); f[1] = __uint_as_float(v.x & 0xffff0000u); f[2] = __uint_as_float(v.y << 16); f[3] = __uint_as_float(v.y & 0xffff0000u);
    f[4] = __uint_as_float(v.z << 16); f[5] = __uint_as_float(v.z & 0xffff0000u); f[6] = __uint_as_float(v.w << 16); f[7] = __uint_as_float(v.w & 0xffff0000u);
}

__device__ __forceinline__ int colmap(int kind, int n) {
    if (kind == 0) return n;
    if (kind == 1) { const int t = n >> 8, bj = (n >> 7) & 1, c = n & 127; return bj * DFF + t * 128 + c; }
    if (n < 2048) return n; if (n < 3968) return n + 16; if (n < 3984) return n - 3968 + 2048; return -1;
}
__device__ void convert_tile(const float* __restrict__ src, bf16_t* __restrict__ dst, int K, int Nsrc, int kind, int k0, int n0, float* tile) {
    const int tid = opaque_tid();
    { const int n = tid & 63, kr = tid >> 6; const int sc = colmap(kind, n0 + n);
#pragma unroll
      for (int i = 0; i < 8; ++i) { const int k = kr + 8 * i; tile[k * 65 + n] = sc >= 0 ? src[(size_t)(k0 + k) * Nsrc + sc] : 0.f; } }
    __syncthreads();
    { const int nn = tid >> 3, kg = tid & 7; unsigned w[4];
#pragma unroll
      for (int j = 0; j < 4; ++j) w[j] = pk2(tile[(kg * 8 + 2 * j) * 65 + nn], tile[(kg * 8 + 2 * j + 1) * 65 + nn]);
      *(uint4*)(dst + (size_t)(n0 + nn) * K + k0 + kg * 8) = make_uint4(w[0], w[1], w[2], w[3]); }
    __syncthreads();
}
__device__ void convert_jobs(const P& p, int first, int njobs_sel, unsigned char* lds, int item0, int nitems_before) {}

__device__ void do_convert(const float* src, bf16_t* dst, int K, int Nsrc, int Ndst, int kind, int t, float* tile) {
    const int nkt = K / 64; const int kt = t % nkt, ntile = t / nkt; (void)Ndst;
    convert_tile(src, dst, K, Nsrc, kind, kt * 64, ntile * 64, tile);
}

__device__ void phase0(const P& p, unsigned char* lds) {
    float* tile = (float*)lds;
    const int tid = opaque_tid();
    const int n_ada = 36 * 8;
    const int t1 = 16 * 88, t2 = 44 * 16, t3 = 16 * 64, t4 = 16 * 16, t5 = 8, t6 = 8, t7 = 16;
    const int total = n_ada + t1 + t2 + t3 + t4 + t5 + t6 + t7;
    for (int it = blockIdx.x; it < total; it += gridDim.x) {
        if (it < n_ada) {
            const int cgp = it % 36, kc = it / 36;
            float* sc = tile;
            __syncthreads();
            for (int i = tid; i < NCOND * 128; i += NTHR) { const int c = i >> 7, k = i & 127; const float v = c == 0 ? p.cctx[kc * 128 + k] : p.c[(c - 1) * DM + kc * 128 + k]; sc[i] = siluf(v); }
            __syncthreads();
            const int col = cgp * 256 + (tid & 255), kh = tid >> 8;
            float acc[NCOND];
#pragma unroll
            for (int c = 0; c < NCOND; ++c) acc[c] = 0.f;
            const float* w = p.ada_w + (size_t)(kc * 128 + kh * 64) * MODW + col;
#pragma unroll 4
            for (int k = 0; k < 64; ++k) { const float wv = w[(size_t)k * MODW];
#pragma unroll
                for (int c = 0; c < NCOND; ++c) acc[c] += sc[c * 128 + kh * 64 + k] * wv; }
            float* mod = (float*)(p.ws + WS_MOD);
            const float bias = (kc == 0 && kh == 0) ? p.ada_b[col] : 0.f;
#pragma unroll
            for (int c = 0; c < NCOND; ++c) atomicAdd(mod + c * MODW + col, acc[c] + bias);
            __syncthreads();
        } else {
            int t = it - n_ada;
            if (t < t1) do_convert(p.w1in, (bf16_t*)(p.ws + WS_W1), 1024, 5632, 5632, 1, t, tile);
            else if ((t -= t1) < t2) do_convert(p.w1out, (bf16_t*)(p.ws + WS_W1B), 2816, 1024, 1024, 0, t, tile);
            else if ((t -= t2) < t3) do_convert(p.wmin, (bf16_t*)(p.ws + WS_BT3), 1024, 3984, 4096, 2, t, tile);
            else if ((t -= t3) < t4) do_convert(p.wmout, (bf16_t*)(p.ws + WS_BT4), 1024, 1024, 1024, 0, t, tile);
            else if ((t -= t4) < t5) do_convert(p.a2, (bf16_t*)(p.ws + WS_A2BF), 64, 512, 512, 0, t, tile);
            else if ((t -= t5) < t6) do_convert(p.a2 + 64 * 512, (bf16_t*)(p.ws + WS_A2BF) + 512 * 64, 64, 512, 512, 0, t, tile);
            else { t -= t6; do_convert(p.g2, (bf16_t*)(p.ws + WS_G2BF), 128, 512, 512, 0, t, tile); }
        }
    }
}

__device__ void phase_normmod(const P& p, int which) {
    const int lane = opaque_tid() & 63, wave = threadIdx.x >> 6;
    const float* gain = which == 0 ? p.n1 : (which == 1 ? p.nmix : p.n2);
    const float* mod = (const float*)(p.ws + WS_MOD);
    bf16_t* A = (bf16_t*)(p.ws + WS_A);
    for (int row = blockIdx.x * 8 + wave; row < MT; row += gridDim.x * 8) {
        const float* src = which == 0 ? xrow(p, row) : p.out + (size_t)row * DM;
        float4 v[4]; float ss = 0.f;
#pragma unroll
        for (int i = 0; i < 4; ++i) { v[i] = *(const float4*)(src + lane * 4 + 256 * i); ss += v[i].x * v[i].x + v[i].y * v[i].y + v[i].z * v[i].z + v[i].w * v[i].w; }
#pragma unroll
        for (int o = 32; o >= 1; o >>= 1) ss += __shfl_xor(ss, o);
        const float rstd = rsqrtf(ss * (1.f / 1024.f) + 1e-6f);
        const float* sh = mod + cond_of(row) * MODW + which * 3072; const float* sc = sh + 1024;
#pragma unroll
        for (int i = 0; i < 4; ++i) { const int col = lane * 4 + 256 * i;
            const float4 g = *(const float4*)(gain + col), s4 = *(const float4*)(sh + col), c4 = *(const float4*)(sc + col);
            const float o0 = v[i].x * rstd * g.x * (1.f + c4.x) + s4.x, o1 = v[i].y * rstd * g.y * (1.f + c4.y) + s4.y,
                        o2 = v[i].z * rstd * g.z * (1.f + c4.z) + s4.z, o3 = v[i].w * rstd * g.w * (1.f + c4.w) + s4.w;
            *(uint2*)(A + (size_t)row * DM + col) = make_uint2(pk2(o0, o1), pk2(o2, o3)); }
    }
}
__device__ void phase_finalnorm(const P& p) {
    const int lane = opaque_tid() & 63, wave = threadIdx.x >> 6;
    for (int row = blockIdx.x * 8 + wave; row < MT; row += gridDim.x * 8) {
        float* src = p.out + (size_t)row * DM;
        float4 v[4]; float ss = 0.f;
#pragma unroll
        for (int i = 0; i < 4; ++i) { v[i] = *(const float4*)(src + lane * 4 + 256 * i); ss += v[i].x * v[i].x + v[i].y * v[i].y + v[i].z * v[i].z + v[i].w * v[i].w; }
#pragma unroll
        for (int o = 32; o >= 1; o >>= 1) ss += __shfl_xor(ss, o);
        const float rstd = rsqrtf(ss * (1.f / 1024.f) + 1e-6f);
#pragma unroll
        for (int i = 0; i < 4; ++i) { const int col = lane * 4 + 256 * i; const float4 g = *(const float4*)(p.nf + col);
            *(float4*)(src + col) = make_float4(v[i].x * rstd * g.x, v[i].y * rstd * g.y, v[i].z * rstd * g.z, v[i].w * rstd * g.w); }
    }
}

struct EpiSwiglu {
    static constexpr bool PERM = true;
    bf16_t* O;
    __device__ __forceinline__ void operator()(const f32x4 (&acc)[2][2][4][2], const pg8::Unit& u, int wr, int wc, int fr, int fq) const {
        const int row0 = u.pm * 256 + wr * 64 + fr, col0 = u.pn * 128 + wc * 32 + 8 * fq;
#pragma unroll
        for (int ai = 0; ai < 2; ++ai)
#pragma unroll
            for (int m = 0; m < 4; ++m) { bf16_t* rowp = O + (size_t)(row0 + ai * 128 + m * 16) * DFF + col0;
                float r[8];
#pragma unroll
                for (int n = 0; n < 2; ++n)
#pragma unroll
                    for (int j = 0; j < 4; ++j) r[n * 4 + j] = siluf(acc[ai][0][m][n][j]) * acc[ai][1][m][n][j];
                pg8::u32x4 w; w.x = pg8::cvt_pk_bf16(r[0], r[1]); w.y = pg8::cvt_pk_bf16(r[2], r[3]); w.z = pg8::cvt_pk_bf16(r[4], r[5]); w.w = pg8::cvt_pk_bf16(r[6], r[7]);
                *(pg8::u32x4*)rowp = w; }
    }
};
struct EpiResid {
    static constexpr bool PERM = false;
    const float* xp; const float* xs; float* out; const float* ga; float coef; int inplace;
    __device__ __forceinline__ void operator()(const f32x4 (&acc)[2][2][4][2], const pg8::Unit& u, int wr, int wc, int fr, int fq) const {
        const int row0 = u.pm * 256 + wr * 64 + fr, col0 = u.pn * 256 + wc * 32 + 4 * fq;
        const float* gap = ga + cond_of(u.pm * 256) * MODW;
        f32x4 gv[2][2];
#pragma unroll
        for (int bj = 0; bj < 2; ++bj)
#pragma unroll
            for (int n = 0; n < 2; ++n) gv[bj][n] = *(const f32x4*)(gap + col0 + bj * 128 + n * 16) * coef;
#pragma unroll
        for (int ai = 0; ai < 2; ++ai)
#pragma unroll
            for (int m = 0; m < 4; ++m) { const int row = row0 + ai * 128 + m * 16;
                const float* base = inplace ? out + (size_t)row * DM : (row < NCTX ? xp + (size_t)row * DM : xs + (size_t)(row - NCTX) * DM);
                float* op = out + (size_t)row * DM;
#pragma unroll
                for (int bj = 0; bj < 2; ++bj)
#pragma unroll
                    for (int n = 0; n < 2; ++n) { const int c = col0 + bj * 128 + n * 16; const f32x4 b4 = *(const f32x4*)(base + c);
                        *(f32x4*)(op + c) = b4 + gv[bj][n] * acc[ai][bj][m][n]; } }
    }
};
struct EpiU {
    static constexpr bool PERM = true;
    bf16_t* U; float* gates;
    __device__ __forceinline__ void operator()(const f32x4 (&acc)[2][2][4][2], const pg8::Unit& u, int wr, int wc, int fr, int fq) const {
        const int row0 = u.pm * 256 + wr * 64 + fr;
#pragma unroll
        for (int bj = 0; bj < 2; ++bj) { const int col0 = u.pn * 256 + bj * 128 + wc * 32 + 8 * fq;
            if (col0 < UW) {
#pragma unroll
                for (int ai = 0; ai < 2; ++ai)
#pragma unroll
                    for (int m = 0; m < 4; ++m) { const int row = row0 + ai * 128 + m * 16; const f32x4 v0 = acc[ai][bj][m][0], v1 = acc[ai][bj][m][1];
                        pg8::u32x4 w; w.x = pg8::cvt_pk_bf16(v0[0], v0[1]); w.y = pg8::cvt_pk_bf16(v0[2], v0[3]); w.z = pg8::cvt_pk_bf16(v1[0], v1[1]); w.w = pg8::cvt_pk_bf16(v1[2], v1[3]);
                        *(pg8::u32x4*)(U + (size_t)row * UW + col0) = w;
                        if (col0 >= 3968) { float* gp = gates + (size_t)row * 16 + (col0 - 3968); *(f32x4*)gp = v0; *(f32x4*)(gp + 4) = v1; } } } }
    }
};

template <class Epi>
__device__ __forceinline__ void run_gemm(unsigned char* lds, const bf16_t* A, const bf16_t* Bt, int N, int K, const Epi& E) {
    pg8::Gemm g{A, Bt, MT, N, K}; pg8::StaticOrder S; S.init(MT, N, (int)gridDim.x, (int)blockIdx.x);
    pg8::gemm_phase<Epi, pg8::StaticOrder, true, true>((PG8_LAS unsigned char*)lds, g, S, E);
}

constexpr int ML_SK = 0, ML_KWT = 17408, ML_VT = ML_KWT + 18432, ML_CB = ML_VT + 20736, ML_F = ML_CB + 21760, ML_CW = ML_F + 2048, ML_END = ML_CW + 4096;
static_assert(ML_END <= LDS_BYTES, "mlstm lds");

__device__ __forceinline__ unsigned short ld_u16_agent(const bf16_t* p) { return __hip_atomic_load(p, __ATOMIC_RELAXED, __HIP_MEMORY_SCOPE_AGENT); }

__device__ __forceinline__ void conv3_row8(const bf16_t* up, bool hasp, bool hasn, const float* cwp, float* x) {
    float t[8];
    unpack8(*(const uint4*)up, t);
#pragma unroll
    for (int i = 0; i < 8; ++i) x[i] = cwp[768 + i] + cwp[256 + i] * t[i];
    if (hasp) { unpack8(*(const uint4*)(up - UW), t);
#pragma unroll
        for (int i = 0; i < 8; ++i) x[i] += cwp[i] * t[i]; }
    if (hasn) { unpack8(*(const uint4*)(up + UW), t);
#pragma unroll
        for (int i = 0; i < 8; ++i) x[i] += cwp[512 + i] * t[i]; }
}

__device__ __forceinline__ void mlstm_task(const P& p, unsigned char* lds, int bg, int h, int dsel) {
    const int wv = __builtin_amdgcn_readfirstlane((int)threadIdx.x >> 6), rw = wv & 3, cw = wv >> 2;
    const bool ctx = bg < 32; const int T = ctx ? 256 : 2048, nc = T / 64; const int row0 = ctx ? bg * 256 : NCTX + (bg - 32) * 2048;
    bf16_t* sK = (bf16_t*)(lds + ML_SK); bf16_t* sKwT = (bf16_t*)(lds + ML_KWT); bf16_t* sVT = (bf16_t*)(lds + ML_VT); bf16_t* sCb = (bf16_t*)(lds + ML_CB); bf16_t* sS = sCb;
    float* sA = (float*)(lds + ML_F); float* sM = sA + 64; float* sBb = sM + 64; float* sDen = sBb + 64; float* sScal = sDen + 64; float* sRed = sScal + 16;
    float* sCW = (float*)(lds + ML_CW);
    const bf16_t* U = (const bf16_t*)(p.ws + WS_U); const float* GATES = (const float*)(p.ws + WS_GATES); bf16_t* HB = (bf16_t*)(p.ws + WS_A); bf16_t* HB2 = (bf16_t*)(p.ws + WS_HB2);
    const int d_lo = dsel < 0 ? 0 : dsel, d_hi = dsel < 0 ? 2 : dsel + 1;
    const int ct_a = cw ? 3 : 0;
    const int ct_b = cw ? 7 : 5;
    const int n_a = cw ? 2 : 3;

    __syncthreads();
    { const int tid = threadIdx.x;
      for (int i = tid; i < 1024; i += NTHR) { const int a = i >> 8, cc = i & 255, gch = (cc >> 7) * 512 + h * 128 + (cc & 127); sCW[i] = a < 3 ? p.cw[a * 1024 + gch] : p.cb[gch]; }
      for (int i = tid; i < 16 * 72; i += NTHR) { const int r = 128 + i / 72; sVT[r * 72 + (i % 72)] = (r == 128) ? (bf16_t)0x3F80 : (bf16_t)0; } }

#pragma unroll 1
    for (int dir = d_lo; dir < d_hi; ++dir) {
        f32x4 Cacc[9]; float m_prev = 0.f;
        { int z0 = 0; asm volatile("" : "+v"(z0)); const int tid = (int)threadIdx.x + z0, fr = tid & 15, fq = (tid >> 4) & 3;
#pragma unroll
          for (int ct = 0; ct < 9; ++ct) Cacc[ct] = (f32x4){0.f, 0.f, 0.f, 0.f};
          if (!ctx) { const int sidx = ((bg - 32) * 2 + dir) * 4 + h; const float* C0 = p.sC + (size_t)sidx * 16384; const float* n0 = p.sn + (size_t)sidx * 128;
#pragma unroll
              for (int j = 0; j < 4; ++j) { const int d = 16 * wv + 4 * fq + j;
#pragma unroll
                  for (int ct = 0; ct < 8; ++ct) Cacc[ct][j] = C0[d * 128 + 16 * ct + fr];
                  Cacc[8][j] = fr == 0 ? n0[d] : 0.f; }
              m_prev = p.sm[sidx]; } }
        const float gbi = p.gb[dir * 4 + h], gbf = p.gb[8 + dir * 4 + h];
        const bool second = dsel < 0 && dir == 1;
#pragma unroll 1
        for (int s = 0; s < nc; ++s) {
            const int c = dir ? nc - 1 - s : s;
            int zz = 0; asm volatile("" : "+v"(zz));
            const int tid = (int)threadIdx.x + zz, lane = tid & 63, fr = tid & 15, fq = (tid >> 4) & 3;
            uint4 kc[2], kp[2], kn[2], vv[2];
#pragma unroll
            for (int g = 0; g < 2; ++g) { const int idx = tid + 512 * g, sl = idx >> 4, d0 = (idx & 15) * 8; const int tl = dir ? 63 - sl : sl, tok = c * 64 + tl;
                const bf16_t* up = U + ((size_t)row0 + tok) * UW + 512 + h * 128 + d0;
                kc[g] = *(const uint4*)up; kp[g] = make_uint4(0u, 0u, 0u, 0u); kn[g] = kp[g];
                if (tok > 0) kp[g] = *(const uint4*)(up - UW);
                if (tok < T - 1) kn[g] = *(const uint4*)(up + UW);
                vv[g] = *(const uint4*)(up + 512); }
            LDS_BARRIER();
            if (wv == 0) {
                const int tl = dir ? 63 - lane : lane; const size_t row = (size_t)row0 + c * 64 + tl;
                const float ip = GATES[row * 16 + dir * 4 + h] + gbi, fp = GATES[row * 16 + 8 + dir * 4 + h] + gbf;
                const float lf = -softplus_fast(-fp);
                float bs = lf;
#pragma unroll
                for (int o = 1; o < 64; o <<= 1) { const float t = __shfl_up(bs, o); if (lane >= o) bs += t; }
                const float a = ip - bs; float pm = a;
#pragma unroll
                for (int o = 1; o < 64; o <<= 1) { const float t = __shfl_up(pm, o); if (lane >= o) pm = fmaxf(pm, t); }
                const float Mt = fmaxf(m_prev, pm);
                sA[lane] = a; sM[lane] = Mt; sBb[lane] = bs;
                if (lane == 63) { sScal[0] = Mt; sScal[1] = bs; }
            }
            LDS_BARRIER();
            const float M63 = sScal[0], bL = sScal[1];
            uint4 qc[4], qp[4], qn[4];
            { const int t_ = 16 * rw + fr, tl = dir ? 63 - t_ : t_, tok = c * 64 + tl; const bf16_t* up = U + ((size_t)row0 + tok) * UW + h * 128 + 8 * fq;
#pragma unroll
              for (int kk = 0; kk < 4; ++kk) { qc[kk] = *(const uint4*)(up + 32 * kk); qp[kk] = make_uint4(0u, 0u, 0u, 0u); qn[kk] = qp[kk];
                  if (tok > 0) qp[kk] = *(const uint4*)(up + 32 * kk - UW);
                  if (tok < T - 1) qn[kk] = *(const uint4*)(up + 32 * kk + UW); } }
#pragma unroll
            for (int g = 0; g < 2; ++g) {
                const int idx = tid + 512 * g, sl = idx >> 4, d0 = (idx & 15) * 8;
                const float wk = fexp(sA[sl] - M63);
                const float* cwp = sCW + 128 + d0;
                float kv[8], t[8];
                unpack8(kc[g], t);
#pragma unroll
                for (int i = 0; i < 8; ++i) kv[i] = cwp[768 + i] + cwp[256 + i] * t[i];
                unpack8(kp[g], t);
#pragma unroll
                for (int i = 0; i < 8; ++i) kv[i] += cwp[i] * t[i];
                unpack8(kn[g], t);
#pragma unroll
                for (int i = 0; i < 8; ++i) kv[i] += cwp[512 + i] * t[i];
#pragma unroll
                for (int i = 0; i < 8; ++i) kv[i] = siluf(kv[i]) * 0.08838834764831845f;
                *(uint4*)(sK + sl * 136 + d0) = make_uint4(pk2(kv[0], kv[1]), pk2(kv[2], kv[3]), pk2(kv[4], kv[5]), pk2(kv[6], kv[7]));
#pragma unroll
                for (int i = 0; i < 8; ++i) sKwT[(d0 + i) * 72 + sl] = f2bf(kv[i] * wk);
                const unsigned vw[4] = {vv[g].x, vv[g].y, vv[g].z, vv[g].w};
#pragma unroll
                for (int i = 0; i < 8; ++i) sVT[(d0 + i) * 72 + sl] = (bf16_t)((vw[i >> 1] >> ((i & 1) * 16)) & 0xffffu);
            }
            bf16x8 qf[4];
#pragma unroll
            for (int kk = 0; kk < 4; ++kk) { const float* cwp = sCW + 32 * kk + 8 * fq; float qv[8], t[8];
                unpack8(qc[kk], t);
#pragma unroll
                for (int i = 0; i < 8; ++i) qv[i] = cwp[768 + i] + cwp[256 + i] * t[i];
                unpack8(qp[kk], t);
#pragma unroll
                for (int i = 0; i < 8; ++i) qv[i] += cwp[i] * t[i];
                unpack8(qn[kk], t);
#pragma unroll
                for (int i = 0; i < 8; ++i) qv[i] += cwp[512 + i] * t[i];
#pragma unroll
                for (int i = 0; i < 8; ++i) qv[i] = siluf(qv[i]);
                union { uint4 u; bf16x8 v; } cv; cv.u = make_uint4(pk2(qv[0], qv[1]), pk2(qv[2], qv[3]), pk2(qv[4], qv[5]), pk2(qv[6], qv[7])); qf[kk] = cv.v; }
            f32x4 num[5];
#pragma unroll
            for (int k = 0; k < 5; ++k) num[k] = (f32x4){0.f, 0.f, 0.f, 0.f};
#pragma unroll
            for (int ci = 0; ci < 5; ++ci) { const f32x4 v = Cacc[ci]; *(uint2*)(sCb + (16 * ci + fr) * 136 + 16 * wv + 4 * fq) = make_uint2(pk2(v[0], v[1]), pk2(v[2], v[3])); }
            LDS_BARRIER();
#pragma unroll
            for (int k = 0; k < 3; ++k) if (k < n_a) {
#pragma unroll
                for (int kk = 0; kk < 4; ++kk) { const bf16x8 b = *(const bf16x8*)(sCb + (16 * (ct_a + k) + fr) * 136 + 32 * kk + 8 * fq); num[k] = mfma16(qf[kk], b, num[k]); } }
            LDS_BARRIER();
#pragma unroll
            for (int ci = 0; ci < 4; ++ci) { const f32x4 v = Cacc[5 + ci]; *(uint2*)(sCb + (16 * ci + fr) * 136 + 16 * wv + 4 * fq) = make_uint2(pk2(v[0], v[1]), pk2(v[2], v[3])); }
            LDS_BARRIER();
#pragma unroll
            for (int k = 3; k < 5; ++k) {
#pragma unroll
                for (int kk = 0; kk < 4; ++kk) { const bf16x8 b = *(const bf16x8*)(sCb + (16 * (ct_b + k - 3 - 5) + fr) * 136 + 32 * kk + 8 * fq); num[k] = mfma16(qf[kk], b, num[k]); } }
            {
                float scv[4];
#pragma unroll
                for (int j = 0; j < 4; ++j) scv[j] = fexp(m_prev - sM[16 * rw + 4 * fq + j]);
#pragma unroll
                for (int k = 0; k < 5; ++k)
#pragma unroll
                    for (int j = 0; j < 4; ++j) num[k][j] *= scv[j];
            }
            LDS_BARRIER();
#pragma unroll
            for (int si = 0; si < 2; ++si) { const int st = 2 * cw + si;
                f32x4 sacc = (f32x4){0.f, 0.f, 0.f, 0.f};
                if (st <= rw) {
#pragma unroll
                    for (int kk = 0; kk < 4; ++kk) { const bf16x8 b = *(const bf16x8*)(sK + (16 * st + fr) * 136 + 32 * kk + 8 * fq); sacc = mfma16(qf[kk], b, sacc); } }
                const int sp = 16 * st + fr; const float as = sA[sp];
#pragma unroll
                for (int j = 0; j < 4; ++j) { const int tp = 16 * rw + 4 * fq + j; const float val = (sp <= tp) ? sacc[j] * fexp(as - sM[tp]) : 0.f; sS[tp * 72 + sp] = f2bf(val); }
            }
            LDS_BARRIER();
#pragma unroll
            for (int ks = 0; ks < 2; ++ks) { const bf16x8 a = *(const bf16x8*)(sS + (16 * rw + fr) * 72 + 32 * ks + 8 * fq);
#pragma unroll
                for (int k = 0; k < 5; ++k) { const int ct = k < 3 ? ct_a + k : ct_b + k - 3;
                    if (k != 2 || cw == 0) { const bf16x8 b = *(const bf16x8*)(sVT + (16 * ct + fr) * 72 + 32 * ks + 8 * fq); num[k] = mfma16(a, b, num[k]); } } }
            if (cw == 1 && fr == 0) {
#pragma unroll
                for (int j = 0; j < 4; ++j) sDen[16 * rw + 4 * fq + j] = num[4][j]; }
            LDS_BARRIER();
            float inv[4];
#pragma unroll
            for (int j = 0; j < 4; ++j) { const int tp = 16 * rw + 4 * fq + j; const float den = sDen[tp]; inv[j] = __builtin_amdgcn_rcpf(fmaxf(fabsf(den), fexp(-(sBb[tp] + sM[tp])))); }
            if (!second) {
#pragma unroll
                for (int j = 0; j < 4; ++j) { const int tp = 16 * rw + 4 * fq + j, tl = dir ? 63 - tp : tp; const size_t row = (size_t)row0 + c * 64 + tl;
                    bf16_t* hb = dsel == 1 ? HB2 + (row - NCTX) * 512 + h * 128 : HB + row * DM + h * 128;
#pragma unroll
                    for (int k = 0; k < 5; ++k) { const int ct = k < 3 ? ct_a + k : ct_b + k - 3; if ((k != 2 || cw == 0) && ct < 8) hb[16 * ct + fr] = f2bf(num[k][j] * inv[j]); } }
            } else {
                float ssr[4];
#pragma unroll
                for (int j = 0; j < 4; ++j) { const int tp = 16 * rw + 4 * fq + j, tl = dir ? 63 - tp : tp; const size_t row = (size_t)row0 + c * 64 + tl;
                    const bf16_t* hb = HB + row * DM + h * 128; float ss = 0.f;
#pragma unroll
                    for (int k = 0; k < 5; ++k) { const int ct = k < 3 ? ct_a + k : ct_b + k - 3;
                        if ((k != 2 || cw == 0) && ct < 8) { const int e = 16 * ct + fr; const float other = bf2f(ld_u16_agent(hb + e)); const float hs = num[k][j] * inv[j] + other;
                            const float o = sigmf(bf2f(U[row * UW + 1536 + h * 128 + e])); const float v = o * hs; ss += v * v; num[k][j] = v; } }
                    ss += __shfl_xor(ss, 1); ss += __shfl_xor(ss, 2); ss += __shfl_xor(ss, 4); ss += __shfl_xor(ss, 8);
                    ssr[j] = ss; if (fr == 0) sRed[cw * 64 + tp] = ss; }
                LDS_BARRIER();
#pragma unroll
                for (int j = 0; j < 4; ++j) { const int tp = 16 * rw + 4 * fq + j, tl = dir ? 63 - tp : tp; const size_t row = (size_t)row0 + c * 64 + tl;
                    bf16_t* hb = HB + row * DM + h * 128; const float rms = rsqrtf((ssr[j] + sRed[(1 - cw) * 64 + tp]) * (1.f / 128.f) + 1e-6f);
#pragma unroll
                    for (int k = 0; k < 5; ++k) { const int ct = k < 3 ? ct_a + k : ct_b + k - 3;
                        if ((k != 2 || cw == 0) && ct < 8) { const int e = 16 * ct + fr; hb[e] = f2bf(num[k][j] * rms * p.hg[h * 128 + e]); } } }
            }
            const float decay = fexp(m_prev - M63);
#pragma unroll
            for (int ct = 0; ct < 9; ++ct) Cacc[ct] = Cacc[ct] * decay;
#pragma unroll
            for (int ks = 0; ks < 2; ++ks) { const bf16x8 a = *(const bf16x8*)(sKwT + (16 * wv + fr) * 72 + 32 * ks + 8 * fq);
#pragma unroll
                for (int ct = 0; ct < 9; ++ct) { const bf16x8 b = *(const bf16x8*)(sVT + (16 * ct + fr) * 72 + 32 * ks + 8 * fq); Cacc[ct] = mfma16(a, b, Cacc[ct]); } }
            m_prev = bL + M63;
        }
        if (ctx) { const int sidx = (bg * 2 + dir) * 4 + h; float* Co = p.out + OUT_C + (size_t)sidx * 16384;
            int z1 = 0; asm volatile("" : "+v"(z1)); const int tid1 = (int)threadIdx.x + z1, fr1 = tid1 & 15, fq1 = (tid1 >> 4) & 3;
#pragma unroll
            for (int j = 0; j < 4; ++j) { const int d = 16 * wv + 4 * fq1 + j;
#pragma unroll
                for (int ct = 0; ct < 8; ++ct) Co[d * 128 + 16 * ct + fr1] = Cacc[ct][j];
                if (fr1 == 0) p.out[OUT_N + sidx * 128 + d] = Cacc[8][j]; }
            if (tid1 == 0) p.out[OUT_MM + sidx] = m_prev; }
        __syncthreads();
    }
}

__device__ __forceinline__ void phase_shift(bf16_t* U, const float* pmu, uint4* sRow) {
#pragma unroll 1
    for (int item = blockIdx.x; item < 1200; item += gridDim.x) {
        const int tid = opaque_tid(), tl = tid >> 3, g = tid & 7;
        const bool grid = item < 240; const int seq = grid ? item / 30 : (item - 240) / 30, sl = grid ? item % 30 : (item - 240) % 30;
        const int T = grid ? 2048 : 256, nst = T / 64; const size_t row0 = grid ? (size_t)NCTX + (size_t)seq * 2048 : (size_t)seq * 256;
        const int rc = sl * 64 + g * 8;
        char* base = (char*)(U + row0 * UW + 2048 + rc);
        const int act = (rc >= 1536 && rc < 1664) ? 1 : (rc >= 1792 ? 2 : 0);
        unsigned z0_ = 0u; asm volatile("" : "+v"(z0_));
        uint4 prv = make_uint4(z0_, z0_, z0_, z0_), cur = *(const uint4*)(base + (size_t)tl * (UW * 2)), nxt;
        __syncthreads();
#pragma unroll 1
        for (int k = 0; k < nst; ++k) {
            unsigned zr = 0u; asm volatile("" : "+v"(zr)); const uint4 z4 = make_uint4(zr, zr, zr, zr);
            nxt = z4; if (k + 1 < nst) nxt = *(const uint4*)(base + (size_t)((k + 1) * 64 + tl) * (UW * 2));
            sRow[(1 + tl) * 8 + g] = cur;
            if (tl == 0) sRow[65 * 8 + g] = nxt;
            LDS_BARRIER();
            uint4 lf = sRow[tl * 8 + g], rt = sRow[(2 + tl) * 8 + g];
            if (tl == 0 && (grid || k == 0)) lf = z4;
            if (tl == 63 && (grid || k == nst - 1)) rt = z4;
            float x[8], t[8], o[8], ms[8], m[8];
            int zz = 0; asm volatile("" : "+v"(zz)); const float* mup = pmu + rc + zz;
#define LD_MU8(a) do { const float4 m0 = *(const float4*)(mup + (a) * 1920), m1 = *(const float4*)(mup + (a) * 1920 + 4); m[0] = m0.x; m[1] = m0.y; m[2] = m0.z; m[3] = m0.w; m[4] = m1.x; m[5] = m1.y; m[6] = m1.z; m[7] = m1.w; } while (0)
            unpack8(cur, x);
            LD_MU8(0); unpack8(lf, t);
#pragma unroll
            for (int i = 0; i < 8; ++i) { o[i] = m[i] * t[i]; ms[i] = m[i]; }
            LD_MU8(1); unpack8(rt, t);
#pragma unroll
            for (int i = 0; i < 8; ++i) { o[i] += m[i] * t[i]; ms[i] += m[i]; }
            if (grid) {
                LD_MU8(2); unpack8(prv, t);
#pragma unroll
                for (int i = 0; i < 8; ++i) { o[i] += m[i] * t[i]; ms[i] += m[i]; }
                LD_MU8(3); unpack8(nxt, t);
#pragma unroll
                for (int i = 0; i < 8; ++i) { o[i] += m[i] * t[i]; ms[i] += m[i]; }
            }
#undef LD_MU8
#pragma unroll
            for (int i = 0; i < 8; ++i) o[i] += x[i] * (1.f - ms[i]);
            if (act == 1) {
#pragma unroll
                for (int i = 0; i < 8; ++i) o[i] = tanh_fast(o[i]); }
            if (act == 2) {
#pragma unroll
                for (int i = 0; i < 8; ++i) o[i] = sigmf(o[i]); }
            *(uint4*)(base + (size_t)(k * 64 + tl) * (UW * 2)) = make_uint4(pk2(o[0], o[1]), pk2(o[2], o[3]), pk2(o[4], o[5]), pk2(o[6], o[7]));
            LDS_BARRIER();
            if (tl == 63) sRow[g] = cur;
            prv = cur; cur = nxt;
        }
    }
}

constexpr int RW_TC = 16;
constexpr int RW_VEC = 0, RW_V = RW_VEC + 16 * 320 * 4, RW_KR = RW_V + 16 * 32 * 4, RW_XW = RW_KR + 16 * 64 * 4, RW_XA = RW_XW + 16 * 72 * 2, RW_Y = RW_XA + 16 * 72 * 2,
              RW_MU = RW_Y + 16 * 32 * 4, RW_DIR = RW_MU + 4 * 288 * 4;
static_assert(2 * RW_DIR <= LDS_BYTES && RW_DIR % 16 == 0, "rwkv lds");

__device__ __forceinline__ float dppf(float x, const int ctrl) { return x; }
#define DPP_ADD(x, ctrl) ((x) + __int_as_float(__builtin_amdgcn_update_dpp(0, __float_as_int(x), (ctrl), 0xf, 0xf, true)))
__device__ __forceinline__ float red8(float x) { x = DPP_ADD(x, 0xB1); x = DPP_ADD(x, 0x4E); x = DPP_ADD(x, 0x141); return x; }
__device__ __forceinline__ float red16(float x) { x = red8(x); x = DPP_ADD(x, 0x140); return x; }

struct Sh8 { uint4 x, l, r, u, d; };
__device__ __forceinline__ void sh8_load(Sh8& q, const bf16_t* U, size_t row0, int tok, int T, bool grid, int c0) {
    const char* Ub = (const char*)(U + row0 * UW);
    const int off = (tok * UW + c0) * 2; const uint4 z = make_uint4(0u, 0u, 0u, 0u);
    const bool hl = grid ? (tok & 63) != 0 : tok > 0, hr = grid ? (tok & 63) != 63 : tok < T - 1;
    q.x = *(const uint4*)(Ub + off);
    q.l = hl ? *(const uint4*)(Ub + (off - UW * 2)) : z; q.r = hr ? *(const uint4*)(Ub + (off + UW * 2)) : z;
    q.u = (grid && tok >= 64) ? *(const uint4*)(Ub + (off - 64 * UW * 2)) : z; q.d = (grid && tok < T - 64) ? *(const uint4*)(Ub + (off + 64 * UW * 2)) : z;
}
__device__ __forceinline__ void sh8_mix(const Sh8& q, bool grid, const float* mu4, int mustride, float* o) {
    float x[8], t[8], m[8], ms[8];
    unpack8(q.x, x);
    { const float4 a = *(const float4*)mu4, b = *(const float4*)(mu4 + 4); m[0] = a.x; m[1] = a.y; m[2] = a.z; m[3] = a.w; m[4] = b.x; m[5] = b.y; m[6] = b.z; m[7] = b.w; }
    unpack8(q.l, t);
#pragma unroll
    for (int i = 0; i < 8; ++i) { o[i] = m[i] * t[i]; ms[i] = m[i]; }
    { const float4 a = *(const float4*)(mu4 + mustride), b = *(const float4*)(mu4 + mustride + 4); m[0] = a.x; m[1] = a.y; m[2] = a.z; m[3] = a.w; m[4] = b.x; m[5] = b.y; m[6] = b.z; m[7] = b.w; }
    unpack8(q.r, t);
#pragma unroll
    for (int i = 0; i < 8; ++i) { o[i] += m[i] * t[i]; ms[i] += m[i]; }
    if (grid) {
        { const float4 a = *(const float4*)(mu4 + 2 * mustride), b = *(const float4*)(mu4 + 2 * mustride + 4); m[0] = a.x; m[1] = a.y; m[2] = a.z; m[3] = a.w; m[4] = b.x; m[5] = b.y; m[6] = b.z; m[7] = b.w; }
        unpack8(q.u, t);
#pragma unroll
        for (int i = 0; i < 8; ++i) { o[i] += m[i] * t[i]; ms[i] += m[i]; }
        { const float4 a = *(const float4*)(mu4 + 3 * mustride), b = *(const float4*)(mu4 + 3 * mustride + 4); m[0] = a.x; m[1] = a.y; m[2] = a.z; m[3] = a.w; m[4] = b.x; m[5] = b.y; m[6] = b.z; m[7] = b.w; }
        unpack8(q.d, t);
#pragma unroll
        for (int i = 0; i < 8; ++i) { o[i] += m[i] * t[i]; ms[i] += m[i]; }
    }
#pragma unroll
    for (int i = 0; i < 8; ++i) o[i] += x[i] * (1.f - ms[i]);
}
__device__ __forceinline__ void shifted8(const bf16_t* U, size_t row0, int tok, int T, bool grid, int c0, const float* mu4, int mustride, float* o) {
    Sh8 q; sh8_load(q, U, row0, tok, T, grid, c0); sh8_mix(q, grid, mu4, mustride, o);
}
typedef float f32x2 __attribute__((ext_vector_type(2)));

__device__ __forceinline__ void rwkv_task(const P& p, unsigned char* lds, int bg, int h, int rh) {
    const int wv = __builtin_amdgcn_readfirstlane((int)threadIdx.x >> 6), dir = wv >> 2, lw = wv & 3;
    const bool ctx = bg < 32; const int T = ctx ? 256 : 2048, nc = T / RW_TC; const size_t row0 = ctx ? (size_t)bg * 256 : (size_t)NCTX + (size_t)(bg - 32) * 2048;
    const bool grid = !ctx;
    unsigned char* L = lds + dir * RW_DIR;
    float* sVec = (float*)(L + RW_VEC); float* sV = (float*)(L + RW_V); float* sKr = (float*)(L + RW_KR); bf16_t* sXw = (bf16_t*)(L + RW_XW); bf16_t* sXa = (bf16_t*)(L + RW_XA);
    float* sY = (float*)(L + RW_Y); float* sMu = (float*)(L + RW_MU);
    const bf16_t* U = (const bf16_t*)(p.ws + WS_U); bf16_t* HB = (bf16_t*)(p.ws + WS_A);
    const int hc = h * 64;
    float st[8]; bf16x8 wfrag[2], afrag[2]; float w0v, a0v, kav;
    {
        const int tid = opaque_tid(), ltid = tid & 255, ri = ltid >> 3, jq = ltid & 7, fr = tid & 15, fq = (tid >> 4) & 3;
        __syncthreads();
        if (ctx) {
#pragma unroll
            for (int q = 0; q < 8; ++q) st[q] = 0.f;
        } else { const float* S0 = p.sS + ((size_t)(((bg - 32) * 2 + dir) * 8 + h)) * 4096 + (32 * rh + ri) * 64 + jq * 8;
#pragma unroll
            for (int q = 0; q < 8; ++q) st[q] = S0[q]; }
        const int jcol = hc + 16 * lw + fr;
#pragma unroll
        for (int ks = 0; ks < 2; ++ks) { float wf[8], af[8];
#pragma unroll
            for (int i = 0; i < 8; ++i) { const int l = 32 * ks + 8 * fq + i; wf[i] = p.w2[(size_t)(dir * 64 + l) * 512 + jcol]; af[i] = p.a2[(size_t)(dir * 64 + l) * 512 + jcol]; }
            union { uint4 u; bf16x8 v; } c1, c2; c1.u = make_uint4(pk2(wf[0], wf[1]), pk2(wf[2], wf[3]), pk2(wf[4], wf[5]), pk2(wf[6], wf[7])); c2.u = make_uint4(pk2(af[0], af[1]), pk2(af[2], af[3]), pk2(af[4], af[5]), pk2(af[6], af[7]));
            wfrag[ks] = c1.v; afrag[ks] = c2.v; }
        w0v = p.w0[dir * 512 + jcol]; a0v = p.a0[dir * 512 + jcol]; kav = p.ka[jcol];
    }
    uint4 q1, q2, q3 = make_uint4(0u, 0u, 0u, 0u);
    const char* Ub = (const char*)(U + row0 * UW);
    { const int tid = opaque_tid(), ltid = tid & 255; const int c = dir ? nc - 1 : 0, tok0 = c * RW_TC; const int tl = (ltid & 127) >> 3, g = ltid & 7;
      q1 = *(const uint4*)(Ub + ((tok0 + tl) * UW + (lw < 2 ? 2048 : 2048 + 512) + hc + 8 * g) * 2);
      q2 = *(const uint4*)(Ub + ((tok0 + tl) * UW + (lw < 2 ? 2048 + 1536 : 2048 + 1664) + dir * 64 + 8 * g) * 2);
      if (lw == 0) q3 = *(const uint4*)(Ub + ((tok0 + (ltid >> 2)) * UW + 2048 + 1024 + hc + 32 * rh + 8 * (ltid & 3)) * 2); }
    f32x2 st2[4];
#pragma unroll
    for (int q = 0; q < 4; ++q) st2[q] = (f32x2){st[2 * q], st[2 * q + 1]};
#pragma unroll 1
    for (int s = 0; s < nc; ++s) {
        const int c = dir ? nc - 1 - s : s; const int tok0 = c * RW_TC;
        const bool second = s >= (nc >> 1);
        const int tid = opaque_tid(), ltid = tid & 255, ri = ltid >> 3, jq = ltid & 7, fr = tid & 15, fq = (tid >> 4) & 3;
        { const int tl = (ltid & 127) >> 3, g = ltid & 7; float o[8];
          if (lw < 2) {
              unpack8(q1, o);
              *(float4*)(sVec + tl * 320 + 8 * g) = make_float4(o[0], o[1], o[2], o[3]); *(float4*)(sVec + tl * 320 + 8 * g + 4) = make_float4(o[4], o[5], o[6], o[7]);
              *(uint4*)(sXw + tl * 72 + 8 * g) = q2;
          } else {
              unpack8(q1, o);
              float kkr[8]; float ss = 0.f;
#pragma unroll
              for (int i = 0; i < 8; ++i) { kkr[i] = o[i] * p.kk[hc + 8 * g + i]; ss += kkr[i] * kkr[i]; }
              ss = red8(ss); const float rn = __builtin_amdgcn_rsqf(fmaxf(ss, 1e-24f));
              *(float4*)(sKr + tl * 64 + 8 * g) = make_float4(o[0], o[1], o[2], o[3]); *(float4*)(sKr + tl * 64 + 8 * g + 4) = make_float4(o[4], o[5], o[6], o[7]);
              *(float4*)(sVec + tl * 320 + 192 + 8 * g) = make_float4(kkr[0] * rn, kkr[1] * rn, kkr[2] * rn, kkr[3] * rn); *(float4*)(sVec + tl * 320 + 192 + 8 * g + 4) = make_float4(kkr[4] * rn, kkr[5] * rn, kkr[6] * rn, kkr[7] * rn);
              *(uint4*)(sXa + tl * 72 + 8 * g) = q2;
          }
          if (lw == 0) {
              const int tl2 = ltid >> 2, g2 = ltid & 3;
              unpack8(q3, o);
              *(float4*)(sV + tl2 * 32 + 8 * g2) = make_float4(o[0], o[1], o[2], o[3]); *(float4*)(sV + tl2 * 32 + 8 * g2 + 4) = make_float4(o[4], o[5], o[6], o[7]);
          } }
        __syncthreads();
        { f32x4 aw = (f32x4){0.f, 0.f, 0.f, 0.f}, aa = (f32x4){0.f, 0.f, 0.f, 0.f};
#pragma unroll
          for (int ks = 0; ks < 2; ++ks) { const bf16x8 xw = *(const bf16x8*)(sXw + fr * 72 + 32 * ks + 8 * fq), xa = *(const bf16x8*)(sXa + fr * 72 + 32 * ks + 8 * fq);
              aw = mfma16(xw, wfrag[ks], aw); aa = mfma16(xa, afrag[ks], aa); }
          const int j = 16 * lw + fr;
#pragma unroll
          for (int jj = 0; jj < 4; ++jj) { const int tl = 4 * fq + jj;
              const float dec = fexp(-fexp(-softplus_fast(-(w0v + aw[jj])) - 0.5f));
              const float a = sigmf(a0v + aa[jj]); const float k = sKr[tl * 64 + j], kn = sVec[tl * 320 + 192 + j];
              float* V = sVec + tl * 320 + j; V[64] = dec; V[128] = k * (1.f + (a - 1.f) * kav); V[256] = kn * a; } }
        const int otl = ltid >> 4, opr = ltid & 15; unsigned* hb = (unsigned*)(HB + (row0 + tok0 + otl) * DM + 512 + hc + 32 * rh + 2 * opr);
        unsigned ov = 0u;
        if (second) ov = __hip_atomic_load(hb, __ATOMIC_RELAXED, __HIP_MEMORY_SCOPE_AGENT);
        if (s + 1 < nc) { const int cn = dir ? nc - 2 - s : s + 1, tokn = cn * RW_TC; const int tl = (ltid & 127) >> 3, g = ltid & 7;
            q1 = *(const uint4*)(Ub + ((tokn + tl) * UW + (lw < 2 ? 2048 : 2048 + 512) + hc + 8 * g) * 2);
            q2 = *(const uint4*)(Ub + ((tokn + tl) * UW + (lw < 2 ? 2048 + 1536 : 2048 + 1664) + dir * 64 + 8 * g) * 2);
            if (lw == 0) q3 = *(const uint4*)(Ub + ((tokn + (ltid >> 2)) * UW + 2048 + 1024 + hc + 32 * rh + 8 * (ltid & 3)) * 2); }
        LDS_BARRIER();
        f32x2 sv_[4];
#pragma unroll
        for (int q = 0; q < 4; ++q) sv_[q] = st2[q];
#pragma unroll 1
        for (int rep = 0; rep < (PROBE_DUP == 102 ? 2 : 1); ++rep) {
        if (PROBE_DUP == 102) {
#pragma unroll
            for (int q = 0; q < 4; ++q) st2[q] = sv_[q]; }
float ys[RW_TC];
#pragma unroll
        for (int step = 0; step < RW_TC; ++step) { const int tl = dir ? RW_TC - 1 - step : step; const float* V = sVec + tl * 320 + jq * 8;
            const float4 ka4 = *(const float4*)(V + 192), kb4 = *(const float4*)(V + 196);
            f32x2 acc = st2[0] * (f32x2){ka4.x, ka4.y}; acc = st2[1] * (f32x2){ka4.z, ka4.w} + acc; acc = st2[2] * (f32x2){kb4.x, kb4.y} + acc; acc = st2[3] * (f32x2){kb4.z, kb4.w} + acc;
            const float sa = -red8(acc.x + acc.y);
            const float vi = sV[tl * 32 + ri];
            const float4 wa = *(const float4*)(V + 64), wb = *(const float4*)(V + 68), ba = *(const float4*)(V + 256), bb = *(const float4*)(V + 260),
                         da = *(const float4*)(V + 128), db = *(const float4*)(V + 132), ra = *(const float4*)(V), rb = *(const float4*)(V + 4);
            const f32x2 sa2 = (f32x2){sa, sa}, vi2 = (f32x2){vi, vi};
            st2[0] = st2[0] * (f32x2){wa.x, wa.y} + (sa2 * (f32x2){ba.x, ba.y} + vi2 * (f32x2){da.x, da.y});
            st2[1] = st2[1] * (f32x2){wa.z, wa.w} + (sa2 * (f32x2){ba.z, ba.w} + vi2 * (f32x2){da.z, da.w});
            st2[2] = st2[2] * (f32x2){wb.x, wb.y} + (sa2 * (f32x2){bb.x, bb.y} + vi2 * (f32x2){db.x, db.y});
            st2[3] = st2[3] * (f32x2){wb.z, wb.w} + (sa2 * (f32x2){bb.z, bb.w} + vi2 * (f32x2){db.z, db.w});
            f32x2 ya = st2[0] * (f32x2){ra.x, ra.y}; ya = st2[1] * (f32x2){ra.z, ra.w} + ya; ya = st2[2] * (f32x2){rb.x, rb.y} + ya; ya = st2[3] * (f32x2){rb.z, rb.w} + ya;
            const float y = red8(ya.x + ya.y);
            ys[step] = y; }
        if (jq == 0) {
#pragma unroll
            for (int step = 0; step < RW_TC; ++step) sY[(dir ? RW_TC - 1 - step : step) * 32 + ri] = ys[step]; }
        }
        LDS_BARRIER();
        { float y0 = sY[otl * 32 + 2 * opr], y1 = sY[otl * 32 + 2 * opr + 1];
          if (second) { y0 += __uint_as_float(ov << 16); y1 += __uint_as_float(ov & 0xffff0000u); }
          *hb = pk2(y0, y1); }
    }
#pragma unroll
    for (int q = 0; q < 4; ++q) { st[2 * q] = st2[q].x; st[2 * q + 1] = st2[q].y; }
    if (ctx) { const int tid = opaque_tid(), ltid = tid & 255, ri = ltid >> 3, jq = ltid & 7;
        float* So = p.out + OUT_S + ((size_t)((bg * 2 + dir) * 8 + h)) * 4096 + (32 * rh + ri) * 64 + jq * 8;
#pragma unroll
        for (int q = 0; q < 8; ++q) So[q] = st[q]; }
    __syncthreads();
}

constexpr int FZ_ROW = 1800;
constexpr int FZ_X = 0, FZ_MU = 32 * FZ_ROW * 2, FZ_END = FZ_MU + 4 * 1792 * 4;
static_assert(FZ_END <= LDS_BYTES && FZ_MU % 16 == 0, "finalize lds");

__device__ __forceinline__ void phase_rwkv_finalize(const P& p, unsigned char* lds) {
    bf16_t* sX = (bf16_t*)(lds + FZ_X); float* sMu = (float*)(lds + FZ_MU);
    const bf16_t* U = (const bf16_t*)(p.ws + WS_U); bf16_t* HB = (bf16_t*)(p.ws + WS_A);
    { const bf16_t* HB2 = (const bf16_t*)(p.ws + WS_HB2); const int tid0 = opaque_tid(), lane = tid0 & 63, wave = (int)threadIdx.x >> 6;
#pragma unroll 1
      for (int row = NCTX + blockIdx.x * 8 + wave; row < MT; row += gridDim.x * 8) {
          float hf[8], hb[8], og[8], v[8]; float ss = 0.f;
          unpack8(*(const uint4*)(HB + (size_t)row * DM + lane * 8), hf); unpack8(*(const uint4*)(HB2 + (size_t)(row - NCTX) * 512 + lane * 8), hb); unpack8(*(const uint4*)(U + (size_t)row * UW + 1536 + lane * 8), og);
#pragma unroll
          for (int i = 0; i < 8; ++i) { v[i] = sigmf(og[i]) * (hf[i] + hb[i]); ss += v[i] * v[i]; }
          ss = red16(ss); const float rms = rsqrtf(ss * (1.f / 128.f) + 1e-6f);
          const float4 g0 = *(const float4*)(p.hg + lane * 8), g1 = *(const float4*)(p.hg + lane * 8 + 4);
          *(uint4*)(HB + (size_t)row * DM + lane * 8) = make_uint4(pk2(v[0] * rms * g0.x, v[1] * rms * g0.y), pk2(v[2] * rms * g0.z, v[3] * rms * g0.w), pk2(v[4] * rms * g1.x, v[5] * rms * g1.y), pk2(v[6] * rms * g1.z, v[7] * rms * g1.w)); } }
    const bf16_t* A2 = (const bf16_t*)(p.ws + WS_A2BF); const bf16_t* G2 = (const bf16_t*)(p.ws + WS_G2BF);
    const int wv = __builtin_amdgcn_readfirstlane((int)threadIdx.x >> 6), hc = wv * 64;
#pragma unroll 1
    for (int tile = blockIdx.x; tile < MT / 32; tile += gridDim.x) {
        const int tid = opaque_tid(), fr = tid & 15, fq = (tid >> 4) & 3;
        const int rowt = tile * 32; const bool ctx = rowt < NCTX; const int T = ctx ? 256 : 2048; const size_t row0 = ctx ? (size_t)(rowt & ~255) : (size_t)NCTX + (size_t)((rowt - NCTX) & ~2047);
        const int tokt = rowt - (int)row0;
        __syncthreads();
#pragma unroll 2
        for (int it = 0; it < 14; ++it) { const int item = it * NTHR + tid, tl = item / 224, gi = item % 224;
            const int c0 = gi < 192 ? 2048 + 8 * gi : 2048 + 1664 + 8 * (gi - 192);
            *(uint4*)(sX + tl * FZ_ROW + 8 * gi) = *(const uint4*)(U + (row0 + tokt + tl) * UW + c0); }
        __syncthreads();
#pragma unroll 1
        for (int rt = 0; rt < 2; ++rt) {
            f32x4 af[4], ab[4], gg[4];
#pragma unroll
            for (int ct = 0; ct < 4; ++ct) { af[ct] = (f32x4){0.f, 0.f, 0.f, 0.f}; ab[ct] = af[ct]; gg[ct] = af[ct]; }
            const bf16_t* xr = sX + (16 * rt + fr) * FZ_ROW;
#pragma unroll
            for (int ks = 0; ks < 2; ++ks) { const bf16x8 xf = *(const bf16x8*)(xr + 1536 + 32 * ks + 8 * fq), xb = *(const bf16x8*)(xr + 1600 + 32 * ks + 8 * fq);
#pragma unroll
                for (int ct = 0; ct < 4; ++ct) { const int n = hc + 16 * ct + fr;
                    af[ct] = mfma16(xf, *(const bf16x8*)(A2 + (size_t)n * 64 + 32 * ks + 8 * fq), af[ct]);
                    ab[ct] = mfma16(xb, *(const bf16x8*)(A2 + (size_t)(512 + n) * 64 + 32 * ks + 8 * fq), ab[ct]); } }
#pragma unroll
            for (int ks = 0; ks < 4; ++ks) { const bf16x8 xg = *(const bf16x8*)(xr + 1664 + 32 * ks + 8 * fq);
#pragma unroll
                for (int ct = 0; ct < 4; ++ct) { const int n = hc + 16 * ct + fr; gg[ct] = mfma16(xg, *(const bf16x8*)(G2 + (size_t)n * 128 + 32 * ks + 8 * fq), gg[ct]); } }
#pragma unroll
            for (int jj = 0; jj < 4; ++jj) { const int tl = 16 * rt + 4 * fq + jj; const size_t row = (size_t)rowt + tl; const bf16_t* xt = sX + tl * FZ_ROW;
                bf16_t* hb = HB + row * DM + 512 + hc;
                float y[4], vv[4]; float sy = 0.f, sb = 0.f;
#pragma unroll
                for (int ct = 0; ct < 4; ++ct) { const int ch = hc + 16 * ct + fr;
                    const float am = 0.5f * (sigmf(p.a0[ch] + af[ct][jj]) + sigmf(p.a0[512 + ch] + ab[ct][jj]));
                    const float r = bf2f(xt[ch]), k = bf2f(xt[512 + ch]); vv[ct] = bf2f(xt[1024 + ch]);
                    sb += r * k * (1.f + (am - 1.f) * p.ka[ch]) * p.rk[ch];
                    y[ct] = bf2f(hb[16 * ct + fr]); sy += y[ct]; }
                sy = red16(sy); sb = red16(sb);
                const float mean = sy * (1.f / 64.f); float vs = 0.f;
#pragma unroll
                for (int ct = 0; ct < 4; ++ct) { const float d = y[ct] - mean; vs += d * d; }
                vs = red16(vs); const float rstd = rsqrtf(vs * (1.f / 64.f) + 64e-5f);
#pragma unroll
                for (int ct = 0; ct < 4; ++ct) { const int ch = hc + 16 * ct + fr; const float yn = (y[ct] - mean) * rstd * p.lng[ch] + p.lnb[ch];
                    hb[16 * ct + fr] = f2bf((yn + sb * vv[ct]) * gg[ct][jj]); } }
        }
    }
}

__device__ __forceinline__ void phase_scan(const P& p, unsigned char* lds, int round = 0) {
    unsigned* ctr = (unsigned*)(p.ws + WS_CTR) + round;
    volatile int* sTask = (volatile int*)(lds + LDS_BYTES - 16);
#pragma unroll 1
    for (;;) {
        __syncthreads();
        if (threadIdx.x == 0) *sTask = (int)atomicAdd(ctr, 1u);
        __syncthreads();
        const int t = __builtin_amdgcn_readfirstlane(*sTask);
        if (t >= 832) break;
#pragma unroll 1
        for (int rep = 0; rep < ((PROBE_DUP == 100 && (t < 64 || (t >= 192 && t < 320))) || (PROBE_DUP == 101 && !(t < 64 || (t >= 192 && t < 320))) ? 2 : 1); ++rep) {
        if (t < 64) mlstm_task(p, lds, 32 + (t >> 3), (t >> 1) & 3, t & 1);
        else if (t < 192) { const int q = t - 64; rwkv_task(p, lds, 32 + (q >> 4), (q >> 1) & 7, q & 1); }
        else if (t < 320) { const int q = t - 192; mlstm_task(p, lds, q >> 2, q & 3, -1); }
        else { const int q = t - 320; rwkv_task(p, lds, q >> 4, (q >> 1) & 7, q & 1); }
        }
    }
}

__device__ void phase_convert_w2(const P& p, unsigned char* lds) {
    float* tile = (float*)lds;
    const int t1 = 16 * 88, t2 = 44 * 16;
    for (int it = blockIdx.x; it < t1 + t2; it += gridDim.x) {
        if (it < t1) do_convert(p.w2in, (bf16_t*)(p.ws + WS_W1), 1024, 5632, 5632, 1, it, tile);
        else do_convert(p.w2out, (bf16_t*)(p.ws + WS_W1B), 2816, 1024, 1024, 0, it - t1, tile);
    }
}

constexpr int NPHASE = 12;
template <int PH>
__device__ __forceinline__ void run_phase(const P& p, unsigned char* lds) {
    const float* mod = (const float*)(p.ws + WS_MOD);
    if constexpr (PH == 0) phase0(p, lds);
    if constexpr (PH == 1) phase_normmod(p, 0);
    if constexpr (PH == 2) { EpiSwiglu E{(bf16_t*)(p.ws + WS_U)}; run_gemm(lds, (const bf16_t*)(p.ws + WS_A), (const bf16_t*)(p.ws + WS_W1), 5632, 1024, E); }
    if constexpr (PH == 3) { EpiResid E{p.xp, p.xs, p.out, mod + 2048, 0.5f, 0}; run_gemm(lds, (const bf16_t*)(p.ws + WS_U), (const bf16_t*)(p.ws + WS_W1B), 1024, 2816, E); }
    if constexpr (PH == 4) phase_normmod(p, 1);
    if constexpr (PH == 5) { EpiU E{(bf16_t*)(p.ws + WS_U), (float*)(p.ws + WS_GATES)}; run_gemm(lds, (const bf16_t*)(p.ws + WS_A), (const bf16_t*)(p.ws + WS_BT3), 4096, 1024, E); }
    if constexpr (PH == 6) phase_scan(p, lds);
    if constexpr (PH == 12) phase_rwkv_finalize(p, lds);
    if constexpr (PH == 13) phase_shift((bf16_t*)(p.ws + WS_U), p.mu, (uint4*)lds);
    if constexpr (PH == 7) { EpiResid E{p.xp, p.xs, p.out, mod + 5120, 1.0f, 1}; run_gemm(lds, (const bf16_t*)(p.ws + WS_A), (const bf16_t*)(p.ws + WS_BT4), 1024, 1024, E); }
    if constexpr (PH == 8) { phase_normmod(p, 2); phase_convert_w2(p, lds); }
    if constexpr (PH == 9) { EpiSwiglu E{(bf16_t*)(p.ws + WS_U)}; run_gemm(lds, (const bf16_t*)(p.ws + WS_A), (const bf16_t*)(p.ws + WS_W1), 5632, 1024, E); }
    if constexpr (PH == 10) { EpiResid E{p.xp, p.xs, p.out, mod + 8192, 0.5f, 1}; run_gemm(lds, (const bf16_t*)(p.ws + WS_U), (const bf16_t*)(p.ws + WS_W1B), 1024, 2816, E); }
    if constexpr (PH == 11) phase_finalnorm(p);
}

#if !ONE_LAUNCH
template <int PH>
__global__ void __launch_bounds__(NTHR, 2) k_phase(P p) {
    extern __shared__ __attribute__((aligned(16))) unsigned char lds[];
    run_phase<PH>(p, lds);
}
#endif

#if ONE_LAUNCH
__global__ void __launch_bounds__(NTHR, 2) k_mega(P p) {
    extern __shared__ __attribute__((aligned(16))) unsigned char lds[];
    cg::grid_group grid = cg::this_grid();
    run_phase<0>(p, lds); grid.sync();
    if (PROBE_DUP == 0) { run_phase<0>(p, lds); grid.sync(); }
    run_phase<1>(p, lds); grid.sync();
    if (PROBE_DUP == 1) { run_phase<1>(p, lds); grid.sync(); }
    run_phase<2>(p, lds); grid.sync();
    if (PROBE_DUP == 2 || PROBE_DUP == 235) { run_phase<2>(p, lds); grid.sync(); }
    run_phase<3>(p, lds); grid.sync();
    if (PROBE_DUP == 3 || PROBE_DUP == 235) { run_phase<3>(p, lds); grid.sync(); }
    run_phase<4>(p, lds); grid.sync();
    if (PROBE_DUP == 4) { run_phase<4>(p, lds); grid.sync(); }
    run_phase<5>(p, lds); grid.sync();
    if (PROBE_DUP == 5 || PROBE_DUP == 235) { run_phase<5>(p, lds); grid.sync(); }
    run_phase<13>(p, lds); grid.sync();
    run_phase<6>(p, lds); grid.sync();
    if (PROBE_DUP == 6) { phase_scan(p, lds, 1); grid.sync(); }
    run_phase<12>(p, lds); grid.sync();
    run_phase<7>(p, lds); grid.sync();
    if (PROBE_DUP == 7) { run_phase<7>(p, lds); grid.sync(); }
    run_phase<8>(p, lds); grid.sync();
    if (PROBE_DUP == 8) { run_phase<8>(p, lds); grid.sync(); }
    run_phase<9>(p, lds); grid.sync();
    if (PROBE_DUP == 9) { run_phase<9>(p, lds); grid.sync(); }
    run_phase<10>(p, lds); grid.sync();
    if (PROBE_DUP == 10) { run_phase<10>(p, lds); grid.sync(); }
    run_phase<11>(p, lds);
}
#endif

#if !ONE_LAUNCH
template <int PH> static void launch_phase(const P& p, int grid, hipStream_t stream) {
    static bool attr = false;
    if (!attr) { (void)hipFuncSetAttribute((const void*)k_phase<PH>, hipFuncAttributeMaxDynamicSharedMemorySize, LDS_BYTES); attr = true; }
    hipLaunchKernelGGL(k_phase<PH>, dim3(grid), dim3(NTHR), LDS_BYTES, stream, p);
}
#endif

extern "C" void kernel_launch(void* const* d_in, const int* in_sizes, int n_in, void* d_out, int out_size, void* d_ws, size_t ws_size, hipStream_t stream) {
    (void)in_sizes; (void)n_in; (void)out_size; (void)ws_size;
    static int grid = 0;
    if (grid == 0) {
        int dev = 0, cus = 0;
        if (hipGetDevice(&dev) != hipSuccess || hipDeviceGetAttribute(&cus, hipDeviceAttributeMultiprocessorCount, dev) != hipSuccess || cus <= 0) cus = 256;
#if ONE_LAUNCH
        (void)hipFuncSetAttribute((const void*)k_mega, hipFuncAttributeMaxDynamicSharedMemorySize, LDS_BYTES);
        int per_cu = 0;
        if (hipOccupancyMaxActiveBlocksPerMultiprocessor(&per_cu, (const void*)k_mega, NTHR, LDS_BYTES) != hipSuccess || per_cu < 1) per_cu = 1;
        (void)hipGetLastError();
#endif
        grid = cus;
    }
    P p{};
    const float** f = (const float**)&p;
    for (int i = 0; i < 35; ++i) f[i] = (const float*)d_in[i];
    p.out = (float*)d_out; p.ws = (unsigned char*)d_ws;
    (void)hipMemsetAsync((char*)d_ws + WS_MOD, 0, NCOND * MODW * sizeof(float) + 256, stream);
#if ONE_LAUNCH
    void* args[] = {&p};
    hipError_t e = hipLaunchCooperativeKernel((const void*)k_mega, dim3(grid), dim3(NTHR), args, LDS_BYTES, stream);
    if (e != hipSuccess) fprintf(stderr, "cooperative launch failed: %s (grid %d)\n", hipGetErrorString(e), grid);
#else
    launch_phase<0>(p, grid, stream); launch_phase<1>(p, grid, stream); launch_phase<2>(p, grid, stream); launch_phase<3>(p, grid, stream);
    launch_phase<4>(p, grid, stream); launch_phase<5>(p, grid, stream); launch_phase<13>(p, grid, stream); launch_phase<6>(p, grid, stream); launch_phase<12>(p, grid, stream); launch_phase<7>(p, grid, stream);
    launch_phase<8>(p, grid, stream); launch_phase<9>(p, grid, stream); launch_phase<10>(p, grid, stream); launch_phase<11>(p, grid, stream);
#endif
}
```

```cpp
#include <hip/hip_runtime.h>
#include <hip/hip_cooperative_groups.h>
#include <cstdio>
#include <cstdint>
namespace cg = cooperative_groups;

#ifndef PROBE_DUP
#define PROBE_DUP -1
#endif
#ifndef ONE_LAUNCH
#define ONE_LAUNCH 1
#endif

#define LDS_BARRIER() do { asm volatile("s_waitcnt lgkmcnt(0)" ::: "memory"); __builtin_amdgcn_s_barrier(); asm volatile("" ::: "memory"); } while (0)
__device__ __forceinline__ int opaque_tid() { int z = 0; asm volatile("" : "+v"(z)); return (int)threadIdx.x + z; }

namespace pg8 {
#define PG8_LAS __attribute__((address_space(3)))
typedef unsigned short bf16_t;
typedef short bf16x8 __attribute__((ext_vector_type(8)));
typedef float f32x4 __attribute__((ext_vector_type(4)));
typedef unsigned u32x4 __attribute__((ext_vector_type(4)));
constexpr int BM = 256, BK = 64, HALF = 128, HTB = HALF * BK * 2, STAGE_BYTES = 8 * HTB, NXCD = 8, WGM = 8;

__host__ __device__ __forceinline__ int lds_byte(int r, int c) { const int st = (r >> 4) * 2 + (c >> 5), rr = r & 15, cc = c & 31, ob = rr * 64 + cc * 2; return st * 1024 + (ob ^ (((ob >> 9) & 1) << 5)); }
__host__ __device__ __forceinline__ void stage_rc(int b, int& R, int& C) { const int st = b / 1024, sb = b % 1024, swz = sb ^ (((sb >> 9) & 1) << 5); R = (st >> 1) * 16 + swz / 64; C = (st & 1) * 32 + (swz % 64) / 2; }
__host__ __device__ __forceinline__ int perm32(int rho) { const int n = rho >> 4, i = rho & 15; return 8 * (i >> 2) + 4 * n + (i & 3); }

struct Unit { int pm, pn; };
struct Gemm { const bf16_t* A; const bf16_t* Bt; int M, N, K; };

struct StaticOrder {
    int nM, nN, nwg, G, c;
    __host__ __device__ void init(int M, int N, int G_, int c_) { nM = M / BM; nN = N / BM; nwg = nM * nN; G = G_; c = c_; }
    __host__ __device__ bool next(int i, Unit& u) const {
        const long L = (long)i * G + c; if (L >= nwg) return false;
        int wgid = (int)L; { const int q = nwg / NXCD, r = nwg % NXCD, xcd = wgid % NXCD, off = wgid / NXCD; wgid = (xcd < r ? xcd * (q + 1) : r * (q + 1) + (xcd - r) * q) + off; }
        const int nig = WGM * nN, gid = wgid / nig, fm = gid * WGM, gsz = (nM - fm) < WGM ? (nM - fm) : WGM;
        u.pm = fm + ((wgid % nig) % gsz); u.pn = (wgid % nig) / gsz; return true;
    }
    __device__ __forceinline__ void a_ready(const Unit&) const {}
    __device__ __forceinline__ void done(const Unit&) const {}
};

__device__ __forceinline__ unsigned cvt_pk_bf16(float lo, float hi) { unsigned r; asm volatile("v_cvt_pk_bf16_f32 %0, %1, %2" : "=v"(r) : "v"(lo), "v"(hi)); return r; }

template <class Epi, class Sched, bool ALIGN_EPI = false, bool SP2 = false>
__device__ __forceinline__ void gemm_phase(PG8_LAS unsigned char* lds, const Gemm g, const Sched& S, const Epi& E) {
    const int tid = opaque_tid(), wid = __builtin_amdgcn_readfirstlane((int)threadIdx.x >> 6), lane = tid & 63, wr = wid >> 2, wc = wid & 3, fr = lane & 15, fq = lane >> 4;
    const int K = g.K, nt = K / BK;
    unsigned voffA[2], voffB[2];
#pragma unroll
    for (int i = 0; i < 2; ++i) { int R, C; stage_rc(tid * 16 + i * 8192, R, C); const int Rb = Epi::PERM ? ((R & ~31) + perm32(R & 31)) : R;
        voffA[i] = (unsigned)(R * K + C) * 2u; voffB[i] = (unsigned)(Rb * K + C) * 2u; }
    const size_t kstep = (size_t)(BK * 2);
    const size_t hstep = (size_t)HALF * K * 2;
    const size_t tstep = 2 * hstep;
    const unsigned ldsw = (unsigned)wid * 1024u;
    const int aoff = lds_byte(wr * 64 + fr, fq * 8), boff = lds_byte(wc * 32 + fr, fq * 8);
#define PG8_SA(b, h) (((b) * 2 + (h)) * HTB)
#define PG8_SB(b, h) ((4 + (b) * 2 + (h)) * HTB)
#define PG8_STAGE(bufoff, gbase, voff) do { _Pragma("unroll") for (int _i = 0; _i < 2; ++_i) \
        __builtin_amdgcn_global_load_lds((const unsigned*)((const char*)(gbase) + (voff)[_i]), (PG8_LAS unsigned*)(lds + (bufoff) + ldsw + _i * 8192), 16, 0, 0); } while (0)
#define PG8_LDA(dst, b, h) do { _Pragma("unroll") for (int m = 0; m < 4; ++m) _Pragma("unroll") for (int k = 0; k < 2; ++k) dst[m][k] = *(const PG8_LAS bf16x8*)(lds + PG8_SA(b, h) + aoff + m * 2048 + k * 1024); } while (0)
#define PG8_LDB(dst, b, h) do { _Pragma("unroll") for (int n = 0; n < 2; ++n) _Pragma("unroll") for (int k = 0; k < 2; ++k) dst[n][k] = *(const PG8_LAS bf16x8*)(lds + PG8_SB(b, h) + boff + n * 2048 + k * 1024); } while (0)
#define PG8_MMA(ai, bj, At, Bt) do { __builtin_amdgcn_s_setprio(1); _Pragma("unroll") for (int m = 0; m < 4; ++m) _Pragma("unroll") for (int n = 0; n < 2; ++n) _Pragma("unroll") for (int k = 0; k < 2; ++k) \
        acc[ai][bj][m][n] = __builtin_amdgcn_mfma_f32_16x16x32_bf16(Bt[n][k], At[m][k], acc[ai][bj][m][n], 0, 0, 0); __builtin_amdgcn_s_setprio(0); } while (0)
#define PG8_WAIT_V(n) asm volatile("s_waitcnt vmcnt(" #n ")" ::: "memory")
#define PG8_WAIT_L(n) asm volatile("s_waitcnt lgkmcnt(" #n ")" ::: "memory")
#define PG8_BAR __builtin_amdgcn_s_barrier()
#define PG8_SCHED __builtin_amdgcn_sched_barrier(0)
    Unit cur, nxt; int ui = 0;
    if (!S.next(0, cur)) return;
    f32x4 acc[2][2][4][2];
#pragma unroll
    for (int a = 0; a < 2; ++a)
#pragma unroll
        for (int b = 0; b < 2; ++b)
#pragma unroll
            for (int m = 0; m < 4; ++m)
#pragma unroll
                for (int n = 0; n < 2; ++n) acc[a][b][m][n] = (f32x4){0.f, 0.f, 0.f, 0.f};
    bf16x8 At[4][2], B0[2][2], B1[2][2];
    const char* cA = (const char*)g.A + (size_t)cur.pm * tstep; const char* cB = (const char*)g.Bt + (size_t)cur.pn * tstep;
    S.a_ready(cur);
    if constexpr (SP2) {
        PG8_STAGE(PG8_SB(0, 0), cB, voffB); PG8_STAGE(PG8_SB(0, 1), cB + hstep, voffB); PG8_STAGE(PG8_SA(0, 0), cA, voffA); PG8_STAGE(PG8_SA(0, 1), cA + hstep, voffA);
        if (wr == 1) PG8_BAR;
        PG8_WAIT_V(2); PG8_BAR;
        PG8_STAGE(PG8_SB(1, 0), cB + kstep, voffB); PG8_STAGE(PG8_SA(1, 0), cA + kstep, voffA); PG8_STAGE(PG8_SB(1, 1), cB + hstep + kstep, voffB);
        PG8_WAIT_V(6); PG8_BAR;
    } else {
        PG8_STAGE(PG8_SB(0, 0), cB, voffB); PG8_STAGE(PG8_SA(0, 0), cA, voffA); PG8_STAGE(PG8_SB(0, 1), cB + hstep, voffB); PG8_STAGE(PG8_SA(0, 1), cA + hstep, voffA);
        if (wr == 1) PG8_BAR;
        PG8_WAIT_V(4); PG8_BAR;
        PG8_STAGE(PG8_SB(1, 0), cB + kstep, voffB); PG8_STAGE(PG8_SA(1, 0), cA + kstep, voffA); PG8_STAGE(PG8_SB(1, 1), cB + hstep + kstep, voffB);
        PG8_WAIT_V(6); PG8_BAR;
    }
    for (;;) {
        const bool has_next = S.next(ui + 1, nxt);
        const char* nA = has_next ? (const char*)g.A + (size_t)nxt.pm * tstep : cA; const char* nB = has_next ? (const char*)g.Bt + (size_t)nxt.pn * tstep : cB;
        for (int t = 0; t < nt; t += 2) {
            const bool last = (t == nt - 2);
            const char* a1 = cA + (size_t)(t + 1) * kstep;
            const char* a2 = last ? nA : cA + (size_t)(t + 2) * kstep; const char* b2 = last ? nB : cB + (size_t)(t + 2) * kstep;
            const char* a3 = a2 + kstep; const char* b3 = b2 + kstep;
            if (last && has_next) S.a_ready(nxt);
            if constexpr (SP2) {
            PG8_LDB(B0, 0, 0); PG8_LDB(B1, 0, 1); PG8_SCHED; PG8_LDA(At, 0, 0); PG8_STAGE(PG8_SA(1, 1), a1 + hstep, voffA);
            PG8_WAIT_V(8); PG8_WAIT_L(0); PG8_BAR; PG8_MMA(0, 0, At, B0); PG8_MMA(0, 1, At, B1); PG8_BAR; PG8_SCHED;
            PG8_LDA(At, 0, 1); PG8_STAGE(PG8_SB(0, 0), b2, voffB); PG8_STAGE(PG8_SB(0, 1), b2 + hstep, voffB); PG8_STAGE(PG8_SA(0, 0), a2, voffA);
            PG8_WAIT_V(8); PG8_WAIT_L(0); PG8_BAR; PG8_MMA(1, 0, At, B0); PG8_MMA(1, 1, At, B1); PG8_BAR; PG8_SCHED;
            PG8_LDB(B0, 1, 0); PG8_LDB(B1, 1, 1); PG8_SCHED; PG8_LDA(At, 1, 0); PG8_STAGE(PG8_SA(0, 1), a2 + hstep, voffA);
            PG8_WAIT_V(8); PG8_WAIT_L(0); PG8_BAR; PG8_MMA(0, 0, At, B0); PG8_MMA(0, 1, At, B1); PG8_BAR; PG8_SCHED;
            PG8_LDA(At, 1, 1); PG8_STAGE(PG8_SB(1, 0), b3, voffB); PG8_STAGE(PG8_SB(1, 1), b3 + hstep, voffB); PG8_STAGE(PG8_SA(1, 0), a3, voffA);
            PG8_WAIT_V(8); PG8_WAIT_L(0); PG8_BAR; PG8_MMA(1, 0, At, B0); PG8_MMA(1, 1, At, B1); PG8_BAR; PG8_SCHED;
            } else {
            PG8_LDB(B0, 0, 0); PG8_SCHED; PG8_LDA(At, 0, 0); PG8_STAGE(PG8_SA(1, 1), a1 + hstep, voffA);
            PG8_WAIT_L(8); PG8_BAR; PG8_WAIT_L(0); PG8_MMA(0, 0, At, B0); PG8_BAR; PG8_SCHED;
            PG8_LDB(B1, 0, 1); PG8_STAGE(PG8_SB(0, 0), b2, voffB);
            PG8_BAR; PG8_WAIT_L(0); PG8_MMA(0, 1, At, B1); PG8_BAR;
            PG8_LDA(At, 0, 1); PG8_STAGE(PG8_SA(0, 0), a2, voffA);
            PG8_BAR; PG8_WAIT_L(0); PG8_MMA(1, 0, At, B0); PG8_BAR; PG8_SCHED;
            PG8_STAGE(PG8_SB(0, 1), b2 + hstep, voffB);
            PG8_WAIT_V(6); PG8_BAR; PG8_MMA(1, 1, At, B1); PG8_BAR;
            PG8_LDB(B0, 1, 0); PG8_SCHED; PG8_LDA(At, 1, 0); PG8_STAGE(PG8_SA(0, 1), a2 + hstep, voffA);
            PG8_WAIT_L(8); PG8_BAR; PG8_WAIT_L(0); PG8_MMA(0, 0, At, B0); PG8_BAR; PG8_SCHED;
            PG8_LDB(B1, 1, 1); PG8_STAGE(PG8_SB(1, 0), b3, voffB);
            PG8_BAR; PG8_WAIT_L(0); PG8_MMA(0, 1, At, B1); PG8_BAR;
            PG8_LDA(At, 1, 1); PG8_STAGE(PG8_SA(1, 0), a3, voffA);
            PG8_BAR; PG8_WAIT_L(0); PG8_MMA(1, 0, At, B0); PG8_BAR; PG8_SCHED;
            PG8_STAGE(PG8_SB(1, 1), b3 + hstep, voffB);
            PG8_WAIT_V(6); PG8_BAR; PG8_MMA(1, 1, At, B1); PG8_BAR;
            }
        }
        if constexpr (ALIGN_EPI) { if (wr == 0) PG8_BAR; }
        E(acc, cur, wr, wc, fr, fq); S.done(cur);
        if (!has_next) break;
#pragma unroll
        for (int a = 0; a < 2; ++a)
#pragma unroll
            for (int b = 0; b < 2; ++b)
#pragma unroll
                for (int m = 0; m < 4; ++m)
#pragma unroll
                    for (int n = 0; n < 2; ++n) acc[a][b][m][n] = (f32x4){0.f, 0.f, 0.f, 0.f};
        cur = nxt; cA = nA; cB = nB; ++ui;
        if constexpr (ALIGN_EPI) { if (wr == 1) PG8_BAR; }
    }
    PG8_WAIT_V(0);
    if constexpr (!ALIGN_EPI) { if (wr == 0) PG8_BAR; }
    PG8_BAR;
#undef PG8_SA
#undef PG8_SB
#undef PG8_STAGE
#undef PG8_LDA
#undef PG8_LDB
#undef PG8_MMA
#undef PG8_WAIT_V
#undef PG8_WAIT_L
#undef PG8_BAR
#undef PG8_SCHED
}
}

using pg8::bf16_t; using pg8::bf16x8; using pg8::f32x4;

constexpr int MT = 24576, DM = 1024, DFF = 2816, NCTX = 8192;
constexpr int UW = 3984;
constexpr int NCOND = 9, MODW = 9216;
constexpr size_t MiB = 1ull << 20;
constexpr size_t WS_A = 0, WS_U = 48 * MiB, WS_W1 = WS_U + 132 * MiB, WS_W1B = WS_W1 + (size_t)5632 * 1024 * 2,
                 WS_BT3 = 235 * MiB, WS_HB2 = 235 * MiB  ,
                 WS_BT4 = 251 * MiB, WS_MOD = 253 * MiB, WS_CTR = WS_MOD + 9 * 9216 * 4  , WS_BAR = WS_CTR + 256  , WS_GATES = 254 * MiB;
constexpr size_t WS_A2BF = 255 * MiB + 512 * 1024, WS_G2BF = WS_A2BF + 2 * 512 * 64 * 2;
constexpr int OUT_C = 25165824, OUT_N = 29360128, OUT_MM = 29392896, OUT_S = 29393152;
constexpr int LDS_BYTES = 163840;
constexpr int NTHR = 512;

struct P {
    const float *xp, *xs, *c, *sC, *sn, *sm, *sS, *cctx, *ada_w, *ada_b, *n1, *w1in, *w1out, *nmix, *wmin, *wmout,
        *cw, *cb, *gb, *hg, *mu, *w0, *w2, *a0, *a2, *g2, *kk, *ka, *rk, *lng, *lnb, *n2, *w2in, *w2out, *nf;
    float* out; unsigned char* ws;
};

__device__ __forceinline__ unsigned short f2bf(float f) { unsigned u = __float_as_uint(f); u += 0x7FFFu + ((u >> 16) & 1u); return (unsigned short)(u >> 16); }
__device__ __forceinline__ float bf2f(unsigned short b) { return __uint_as_float(((unsigned)b) << 16); }
__device__ __forceinline__ unsigned pk2(float a, float b) { return (unsigned)f2bf(a) | ((unsigned)f2bf(b) << 16); }
__device__ __forceinline__ int cond_of(int row) { return row < NCTX ? 0 : 1 + ((row - NCTX) >> 11); }
__device__ __forceinline__ float fexp(float x) { return __builtin_amdgcn_exp2f(x * 1.4426950408889634f); }
__device__ __forceinline__ float flog(float x) { return __builtin_amdgcn_logf(x) * 0.6931471805599453f; }
__device__ __forceinline__ float siluf(float x) { return x * __builtin_amdgcn_rcpf(1.f + fexp(-x)); }
__device__ __forceinline__ float sigmf(float x) { return __builtin_amdgcn_rcpf(1.f + fexp(-x)); }
__device__ __forceinline__ float tanh_fast(float x) { return 1.f - 2.f * __builtin_amdgcn_rcpf(1.f + fexp(2.f * x)); }
__device__ __forceinline__ float softplus_fast(float z) { return fmaxf(z, 0.f) + flog(1.f + fexp(-fabsf(z))); }
__device__ __forceinline__ const float* xrow(const P& p, int row) { return row < NCTX ? p.xp + (size_t)row * DM : p.xs + (size_t)(row - NCTX) * DM; }
__device__ __forceinline__ f32x4 mfma16(bf16x8 a, bf16x8 b, f32x4 c) { return __builtin_amdgcn_mfma_f32_16x16x32_bf16(a, b, c, 0, 0, 0); }
__device__ __forceinline__ void unpack8(uint4 v, float* f) {
    f[0] = __uint_as_float(v.x << 16); f[1] = __uint_as_float(v.x & 0xffff0000u); f[2] = __uint_as_float(v.y << 16); f[3] = __uint_as_float(v.y & 0xffff0000u);
    f[4] = __uint_as_float(v.z << 16); f[5] = __uint_as_float(v.z & 0xffff0000u); f[6] = __uint_as_float(v.w << 16); f[7] = __uint_as_float(v.w & 0xffff0000u);
}

__device__ __forceinline__ int colmap(int kind, int n) {
    if (kind == 0) return n;
    if (kind == 1) { const int t = n >> 8, bj = (n >> 7) & 1, c = n & 127; return bj * DFF + t * 128 + c; }
    if (n < 2048) return n; if (n < 3968) return n + 16; if (n < 3984) return n - 3968 + 2048; return -1;
}
__device__ void convert_tile(const float* __restrict__ src, bf16_t* __restrict__ dst, int K, int Nsrc, int kind, int k0, int n0, float* tile) {
    const int tid = opaque_tid();
    { const int n = tid & 63, kr = tid >> 6; const int sc = colmap(kind, n0 + n);
#pragma unroll
      for (int i = 0; i < 8; ++i) { const int k = kr + 8 * i; tile[k * 65 + n] = sc >= 0 ? src[(size_t)(k0 + k) * Nsrc + sc] : 0.f; } }
    __syncthreads();
    { const int nn = tid >> 3, kg = tid & 7; unsigned w[4];
#pragma unroll
      for (int j = 0; j < 4; ++j) w[j] = pk2(tile[(kg * 8 + 2 * j) * 65 + nn], tile[(kg * 8 + 2 * j + 1) * 65 + nn]);
      *(uint4*)(dst + (size_t)(n0 + nn) * K + k0 + kg * 8) = make_uint4(w[0], w[1], w[2], w[3]); }
    __syncthreads();
}
__device__ void convert_jobs(const P& p, int first, int njobs_sel, unsigned char* lds, int item0, int nitems_before) {}

__device__ void do_convert(const float* src, bf16_t* dst, int K, int Nsrc, int Ndst, int kind, int t, float* tile) {
    const int nkt = K / 64; const int kt = t % nkt, ntile = t / nkt; (void)Ndst;
    convert_tile(src, dst, K, Nsrc, kind, kt * 64, ntile * 64, tile);
}

__device__ void phase0(const P& p, unsigned char* lds) {
    float* tile = (float*)lds;
    const int tid = opaque_tid();
    const int n_ada = 36 * 8;
    const int t1 = 16 * 88, t2 = 44 * 16, t3 = 16 * 64, t4 = 16 * 16, t5 = 8, t6 = 8, t7 = 16;
    const int total = n_ada + t1 + t2 + t3 + t4 + t5 + t6 + t7;
    for (int it = blockIdx.x; it < total; it += gridDim.x) {
        if (it < n_ada) {
            const int cgp = it % 36, kc = it / 36;
            float* sc = tile;
            __syncthreads();
            for (int i = tid; i < NCOND * 128; i += NTHR) { const int c = i >> 7, k = i & 127; const float v = c == 0 ? p.cctx[kc * 128 + k] : p.c[(c - 1) * DM + kc * 128 + k]; sc[i] = siluf(v); }
            __syncthreads();
            const int col = cgp * 256 + (tid & 255), kh = tid >> 8;
            float acc[NCOND];
#pragma unroll
            for (int c = 0; c < NCOND; ++c) acc[c] = 0.f;
            const float* w = p.ada_w + (size_t)(kc * 128 + kh * 64) * MODW + col;
#pragma unroll 4
            for (int k = 0; k < 64; ++k) { const float wv = w[(size_t)k * MODW];
#pragma unroll
                for (int c = 0; c < NCOND; ++c) acc[c] += sc[c * 128 + kh * 64 + k] * wv; }
            float* mod = (float*)(p.ws + WS_MOD);
            const float bias = (kc == 0 && kh == 0) ? p.ada_b[col] : 0.f;
#pragma unroll
            for (int c = 0; c < NCOND; ++c) atomicAdd(mod + c * MODW + col, acc[c] + bias);
            __syncthreads();
        } else {
            int t = it - n_ada;
            if (t < t1) do_convert(p.w1in, (bf16_t*)(p.ws + WS_W1), 1024, 5632, 5632, 1, t, tile);
            else if ((t -= t1) < t2) do_convert(p.w1out, (bf16_t*)(p.ws + WS_W1B), 2816, 1024, 1024, 0, t, tile);
            else if ((t -= t2) < t3) do_convert(p.wmin, (bf16_t*)(p.ws + WS_BT3), 1024, 3984, 4096, 2, t, tile);
            else if ((t -= t3) < t4) do_convert(p.wmout, (bf16_t*)(p.ws + WS_BT4), 1024, 1024, 1024, 0, t, tile);
            else if ((t -= t4) < t5) do_convert(p.a2, (bf16_t*)(p.ws + WS_A2BF), 64, 512, 512, 0, t, tile);
            else if ((t -= t5) < t6) do_convert(p.a2 + 64 * 512, (bf16_t*)(p.ws + WS_A2BF) + 512 * 64, 64, 512, 512, 0, t, tile);
            else { t -= t6; do_convert(p.g2, (bf16_t*)(p.ws + WS_G2BF), 128, 512, 512, 0, t, tile); }
        }
    }
}

__device__ void phase_normmod(const P& p, int which) {
    const int lane = opaque_tid() & 63, wave = threadIdx.x >> 6;
    const float* gain = which == 0 ? p.n1 : (which == 1 ? p.nmix : p.n2);
    const float* mod = (const float*)(p.ws + WS_MOD);
    bf16_t* A = (bf16_t*)(p.ws + WS_A);
    for (int row = blockIdx.x * 8 + wave; row < MT; row += gridDim.x * 8) {
        const float* src = which == 0 ? xrow(p, row) : p.out + (size_t)row * DM;
        float4 v[4]; float ss = 0.f;
#pragma unroll
        for (int i = 0; i < 4; ++i) { v[i] = *(const float4*)(src + lane * 4 + 256 * i); ss += v[i].x * v[i].x + v[i].y * v[i].y + v[i].z * v[i].z + v[i].w * v[i].w; }
#pragma unroll
        for (int o = 32; o >= 1; o >>= 1) ss += __shfl_xor(ss, o);
        const float rstd = rsqrtf(ss * (1.f / 1024.f) + 1e-6f);
        const float* sh = mod + cond_of(row) * MODW + which * 3072; const float* sc = sh + 1024;
#pragma unroll
        for (int i = 0; i < 4; ++i) { const int col = lane * 4 + 256 * i;
            const float4 g = *(const float4*)(gain + col), s4 = *(const float4*)(sh + col), c4 = *(const float4*)(sc + col);
            const float o0 = v[i].x * rstd * g.x * (1.f + c4.x) + s4.x, o1 = v[i].y * rstd * g.y * (1.f + c4.y) + s4.y,
                        o2 = v[i].z * rstd * g.z * (1.f + c4.z) + s4.z, o3 = v[i].w * rstd * g.w * (1.f + c4.w) + s4.w;
            *(uint2*)(A + (size_t)row * DM + col) = make_uint2(pk2(o0, o1), pk2(o2, o3)); }
    }
}
__device__ void phase_finalnorm(const P& p) {
    const int lane = opaque_tid() & 63, wave = threadIdx.x >> 6;
    for (int row = blockIdx.x * 8 + wave; row < MT; row += gridDim.x * 8) {
        float* src = p.out + (size_t)row * DM;
        float4 v[4]; float ss = 0.f;
#pragma unroll
        for (int i = 0; i < 4; ++i) { v[i] = *(const float4*)(src + lane * 4 + 256 * i); ss += v[i].x * v[i].x + v[i].y * v[i].y + v[i].z * v[i].z + v[i].w * v[i].w; }
#pragma unroll
        for (int o = 32; o >= 1; o >>= 1) ss += __shfl_xor(ss, o);
        const float rstd = rsqrtf(ss * (1.f / 1024.f) + 1e-6f);
#pragma unroll
        for (int i = 0; i < 4; ++i) { const int col = lane * 4 + 256 * i; const float4 g = *(const float4*)(p.nf + col);
            *(float4*)(src + col) = make_float4(v[i].x * rstd * g.x, v[i].y * rstd * g.y, v[i].z * rstd * g.z, v[i].w * rstd * g.w); }
    }
}

struct EpiSwiglu {
    static constexpr bool PERM = true;
    bf16_t* O;
    __device__ __forceinline__ void operator()(const f32x4 (&acc)[2][2][4][2], const pg8::Unit& u, int wr, int wc, int fr, int fq) const {
        const int row0 = u.pm * 256 + wr * 64 + fr, col0 = u.pn * 128 + wc * 32 + 8 * fq;
#pragma unroll
        for (int ai = 0; ai < 2; ++ai)
#pragma unroll
            for (int m = 0; m < 4; ++m) { bf16_t* rowp = O + (size_t)(row0 + ai * 128 + m * 16) * DFF + col0;
                float r[8];
#pragma unroll
                for (int n = 0; n < 2; ++n)
#pragma unroll
                    for (int j = 0; j < 4; ++j) r[n * 4 + j] = siluf(acc[ai][0][m][n][j]) * acc[ai][1][m][n][j];
                pg8::u32x4 w; w.x = pg8::cvt_pk_bf16(r[0], r[1]); w.y = pg8::cvt_pk_bf16(r[2], r[3]); w.z = pg8::cvt_pk_bf16(r[4], r[5]); w.w = pg8::cvt_pk_bf16(r[6], r[7]);
                *(pg8::u32x4*)rowp = w; }
    }
};
struct EpiResid {
    static constexpr bool PERM = false;
    const float* xp; const float* xs; float* out; const float* ga; float coef; int inplace;
    __device__ __forceinline__ void operator()(const f32x4 (&acc)[2][2][4][2], const pg8::Unit& u, int wr, int wc, int fr, int fq) const {
        const int row0 = u.pm * 256 + wr * 64 + fr, col0 = u.pn * 256 + wc * 32 + 4 * fq;
        const float* gap = ga + cond_of(u.pm * 256) * MODW;
        f32x4 gv[2][2];
#pragma unroll
        for (int bj = 0; bj < 2; ++bj)
#pragma unroll
            for (int n = 0; n < 2; ++n) gv[bj][n] = *(const f32x4*)(gap + col0 + bj * 128 + n * 16) * coef;
#pragma unroll
        for (int ai = 0; ai < 2; ++ai)
#pragma unroll
            for (int m = 0; m < 4; ++m) { const int row = row0 + ai * 128 + m * 16;
                const float* base = inplace ? out + (size_t)row * DM : (row < NCTX ? xp + (size_t)row * DM : xs + (size_t)(row - NCTX) * DM);
                float* op = out + (size_t)row * DM;
#pragma unroll
                for (int bj = 0; bj < 2; ++bj)
#pragma unroll
                    for (int n = 0; n < 2; ++n) { const int c = col0 + bj * 128 + n * 16; const f32x4 b4 = *(const f32x4*)(base + c);
                        *(f32x4*)(op + c) = b4 + gv[bj][n] * acc[ai][bj][m][n]; } }
    }
};
struct EpiU {
    static constexpr bool PERM = true;
    bf16_t* U; float* gates;
    __device__ __forceinline__ void operator()(const f32x4 (&acc)[2][2][4][2], const pg8::Unit& u, int wr, int wc, int fr, int fq) const {
        const int row0 = u.pm * 256 + wr * 64 + fr;
#pragma unroll
        for (int bj = 0; bj < 2; ++bj) { const int col0 = u.pn * 256 + bj * 128 + wc * 32 + 8 * fq;
            if (col0 < UW) {
#pragma unroll
                for (int ai = 0; ai < 2; ++ai)
#pragma unroll
                    for (int m = 0; m < 4; ++m) { const int row = row0 + ai * 128 + m * 16; const f32x4 v0 = acc[ai][bj][m][0], v1 = acc[ai][bj][m][1];
                        pg8::u32x4 w; w.x = pg8::cvt_pk_bf16(v0[0], v0[1]); w.y = pg8::cvt_pk_bf16(v0[2], v0[3]); w.z = pg8::cvt_pk_bf16(v1[0], v1[1]); w.w = pg8::cvt_pk_bf16(v1[2], v1[3]);
                        *(pg8::u32x4*)(U + (size_t)row * UW + col0) = w;
                        if (col0 >= 3968) { float* gp = gates + (size_t)row * 16 + (col0 - 3968); *(f32x4*)gp = v0; *(f32x4*)(gp + 4) = v1; } } } }
    }
};

template <class Epi>
__device__ __forceinline__ void run_gemm(unsigned char* lds, const bf16_t* A, const bf16_t* Bt, int N, int K, const Epi& E) {
    pg8::Gemm g{A, Bt, MT, N, K}; pg8::StaticOrder S; S.init(MT, N, (int)gridDim.x, (int)blockIdx.x);
    pg8::gemm_phase<Epi, pg8::StaticOrder, true, true>((PG8_LAS unsigned char*)lds, g, S, E);
}

constexpr int ML_SK = 0, ML_KWT = 17408, ML_VT = ML_KWT + 18432, ML_CB = ML_VT + 20736, ML_F = ML_CB + 21760, ML_CW = ML_F + 2048, ML_END = ML_CW + 4096;
static_assert(ML_END <= LDS_BYTES, "mlstm lds");

__device__ __forceinline__ unsigned short ld_u16_agent(const bf16_t* p) { return __hip_atomic_load(p, __ATOMIC_RELAXED, __HIP_MEMORY_SCOPE_AGENT); }

__device__ __forceinline__ void conv3_row8(const bf16_t* up, bool hasp, bool hasn, const float* cwp, float* x) {
    float t[8];
    unpack8(*(const uint4*)up, t);
#pragma unroll
    for (int i = 0; i < 8; ++i) x[i] = cwp[768 + i] + cwp[256 + i] * t[i];
    if (hasp) { unpack8(*(const uint4*)(up - UW), t);
#pragma unroll
        for (int i = 0; i < 8; ++i) x[i] += cwp[i] * t[i]; }
    if (hasn) { unpack8(*(const uint4*)(up + UW), t);
#pragma unroll
        for (int i = 0; i < 8; ++i) x[i] += cwp[512 + i] * t[i]; }
}

__device__ __forceinline__ void mlstm_task(const P& p, unsigned char* lds, int bg, int h, int dsel) {
    const int wv = __builtin_amdgcn_readfirstlane((int)threadIdx.x >> 6), rw = wv & 3, cw = wv >> 2;
    const bool ctx = bg < 32; const int T = ctx ? 256 : 2048, nc = T / 64; const int row0 = ctx ? bg * 256 : NCTX + (bg - 32) * 2048;
    bf16_t* sK = (bf16_t*)(lds + ML_SK); bf16_t* sKwT = (bf16_t*)(lds + ML_KWT); bf16_t* sVT = (bf16_t*)(lds + ML_VT); bf16_t* sCb = (bf16_t*)(lds + ML_CB); bf16_t* sS = sCb;
    float* sA = (float*)(lds + ML_F); float* sM = sA + 64; float* sBb = sM + 64; float* sDen = sBb + 64; float* sScal = sDen + 64; float* sRed = sScal + 16;
    float* sCW = (float*)(lds + ML_CW);
    const bf16_t* U = (const bf16_t*)(p.ws + WS_U); const float* GATES = (const float*)(p.ws + WS_GATES); bf16_t* HB = (bf16_t*)(p.ws + WS_A); bf16_t* HB2 = (bf16_t*)(p.ws + WS_HB2);
    const int d_lo = dsel < 0 ? 0 : dsel, d_hi = dsel < 0 ? 2 : dsel + 1;
    const int ct_a = cw ? 3 : 0;
    const int ct_b = cw ? 7 : 5;
    const int n_a = cw ? 2 : 3;

    __syncthreads();
    { const int tid = threadIdx.x;
      for (int i = tid; i < 1024; i += NTHR) { const int a = i >> 8, cc = i & 255, gch = (cc >> 7) * 512 + h * 128 + (cc & 127); sCW[i] = a < 3 ? p.cw[a * 1024 + gch] : p.cb[gch]; }
      for (int i = tid; i < 16 * 72; i += NTHR) { const int r = 128 + i / 72; sVT[r * 72 + (i % 72)] = (r == 128) ? (bf16_t)0x3F80 : (bf16_t)0; } }

#pragma unroll 1
    for (int dir = d_lo; dir < d_hi; ++dir) {
        f32x4 Cacc[9]; float m_prev = 0.f;
        { int z0 = 0; asm volatile("" : "+v"(z0)); const int tid = (int)threadIdx.x + z0, fr = tid & 15, fq = (tid >> 4) & 3;
#pragma unroll
          for (int ct = 0; ct < 9; ++ct) Cacc[ct] = (f32x4){0.f, 0.f, 0.f, 0.f};
          if (!ctx) { const int sidx = ((bg - 32) * 2 + dir) * 4 + h; const float* C0 = p.sC + (size_t)sidx * 16384; const float* n0 = p.sn + (size_t)sidx * 128;
#pragma unroll
              for (int j = 0; j < 4; ++j) { const int d = 16 * wv + 4 * fq + j;
#pragma unroll
                  for (int ct = 0; ct < 8; ++ct) Cacc[ct][j] = C0[d * 128 + 16 * ct + fr];
                  Cacc[8][j] = fr == 0 ? n0[d] : 0.f; }
              m_prev = p.sm[sidx]; } }
        const float gbi = p.gb[dir * 4 + h], gbf = p.gb[8 + dir * 4 + h];
        const bool second = dsel < 0 && dir == 1;
#pragma unroll 1
        for (int s = 0; s < nc; ++s) {
            const int c = dir ? nc - 1 - s : s;
            int zz = 0; asm volatile("" : "+v"(zz));
            const int tid = (int)threadIdx.x + zz, lane = tid & 63, fr = tid & 15, fq = (tid >> 4) & 3;
            uint4 kc[2], kp[2], kn[2], vv[2];
#pragma unroll
            for (int g = 0; g < 2; ++g) { const int idx = tid + 512 * g, sl = idx >> 4, d0 = (idx & 15) * 8; const int tl = dir ? 63 - sl : sl, tok = c * 64 + tl;
                const bf16_t* up = U + ((size_t)row0 + tok) * UW + 512 + h * 128 + d0;
                kc[g] = *(const uint4*)up; kp[g] = make_uint4(0u, 0u, 0u, 0u); kn[g] = kp[g];
                if (tok > 0) kp[g] = *(const uint4*)(up - UW);
                if (tok < T - 1) kn[g] = *(const uint4*)(up + UW);
                vv[g] = *(const uint4*)(up + 512); }
            LDS_BARRIER();
            if (wv == 0) {
                const int tl = dir ? 63 - lane : lane; const size_t row = (size_t)row0 + c * 64 + tl;
                const float ip = GATES[row * 16 + dir * 4 + h] + gbi, fp = GATES[row * 16 + 8 + dir * 4 + h] + gbf;
                const float lf = -softplus_fast(-fp);
                float bs = lf;
#pragma unroll
                for (int o = 1; o < 64; o <<= 1) { const float t = __shfl_up(bs, o); if (lane >= o) bs += t; }
                const float a = ip - bs; float pm = a;
#pragma unroll
                for (int o = 1; o < 64; o <<= 1) { const float t = __shfl_up(pm, o); if (lane >= o) pm = fmaxf(pm, t); }
                const float Mt = fmaxf(m_prev, pm);
                sA[lane] = a; sM[lane] = Mt; sBb[lane] = bs;
                if (lane == 63) { sScal[0] = Mt; sScal[1] = bs; }
            }
            LDS_BARRIER();
            const float M63 = sScal[0], bL = sScal[1];
            uint4 qc[4], qp[4], qn[4];
            { const int t_ = 16 * rw + fr, tl = dir ? 63 - t_ : t_, tok = c * 64 + tl; const bf16_t* up = U + ((size_t)row0 + tok) * UW + h * 128 + 8 * fq;
#pragma unroll
              for (int kk = 0; kk < 4; ++kk) { qc[kk] = *(const uint4*)(up + 32 * kk); qp[kk] = make_uint4(0u, 0u, 0u, 0u); qn[kk] = qp[kk];
                  if (tok > 0) qp[kk] = *(const uint4*)(up + 32 * kk - UW);
                  if (tok < T - 1) qn[kk] = *(const uint4*)(up + 32 * kk + UW); } }
#pragma unroll
            for (int g = 0; g < 2; ++g) {
                const int idx = tid + 512 * g, sl = idx >> 4, d0 = (idx & 15) * 8;
                const float wk = fexp(sA[sl] - M63);
                const float* cwp = sCW + 128 + d0;
                float kv[8], t[8];
                unpack8(kc[g], t);
#pragma unroll
                for (int i = 0; i < 8; ++i) kv[i] = cwp[768 + i] + cwp[256 + i] * t[i];
                unpack8(kp[g], t);
#pragma unroll
                for (int i = 0; i < 8; ++i) kv[i] += cwp[i] * t[i];
                unpack8(kn[g], t);
#pragma unroll
                for (int i = 0; i < 8; ++i) kv[i] += cwp[512 + i] * t[i];
#pragma unroll
                for (int i = 0; i < 8; ++i) kv[i] = siluf(kv[i]) * 0.08838834764831845f;
                *(uint4*)(sK + sl * 136 + d0) = make_uint4(pk2(kv[0], kv[1]), pk2(kv[2], kv[3]), pk2(kv[4], kv[5]), pk2(kv[6], kv[7]));
#pragma unroll
                for (int i = 0; i < 8; ++i) sKwT[(d0 + i) * 72 + sl] = f2bf(kv[i] * wk);
                const unsigned vw[4] = {vv[g].x, vv[g].y, vv[g].z, vv[g].w};
#pragma unroll
                for (int i = 0; i < 8; ++i) sVT[(d0 + i) * 72 + sl] = (bf16_t)((vw[i >> 1] >> ((i & 1) * 16)) & 0xffffu);
            }
            bf16x8 qf[4];
#pragma unroll
            for (int kk = 0; kk < 4; ++kk) { const float* cwp = sCW + 32 * kk + 8 * fq; float qv[8], t[8];
                unpack8(qc[kk], t);
#pragma unroll
                for (int i = 0; i < 8; ++i) qv[i] = cwp[768 + i] + cwp[256 + i] * t[i];
                unpack8(qp[kk], t);
#pragma unroll
                for (int i = 0; i < 8; ++i) qv[i] += cwp[i] * t[i];
                unpack8(qn[kk], t);
#pragma unroll
                for (int i = 0; i < 8; ++i) qv[i] += cwp[512 + i] * t[i];
#pragma unroll
                for (int i = 0; i < 8; ++i) qv[i] = siluf(qv[i]);
                union { uint4 u; bf16x8 v; } cv; cv.u = make_uint4(pk2(qv[0], qv[1]), pk2(qv[2], qv[3]), pk2(qv[4], qv[5]), pk2(qv[6], qv[7])); qf[kk] = cv.v; }
            f32x4 num[5];
#pragma unroll
            for (int k = 0; k < 5; ++k) num[k] = (f32x4){0.f, 0.f, 0.f, 0.f};
#pragma unroll
            for (int ci = 0; ci < 5; ++ci) { const f32x4 v = Cacc[ci]; *(uint2*)(sCb + (16 * ci + fr) * 136 + 16 * wv + 4 * fq) = make_uint2(pk2(v[0], v[1]), pk2(v[2], v[3])); }
            LDS_BARRIER();
#pragma unroll
            for (int k = 0; k < 3; ++k) if (k < n_a) {
#pragma unroll
                for (int kk = 0; kk < 4; ++kk) { const bf16x8 b = *(const bf16x8*)(sCb + (16 * (ct_a + k) + fr) * 136 + 32 * kk + 8 * fq); num[k] = mfma16(qf[kk], b, num[k]); } }
            LDS_BARRIER();
#pragma unroll
            for (int ci = 0; ci < 4; ++ci) { const f32x4 v = Cacc[5 + ci]; *(uint2*)(sCb + (16 * ci + fr) * 136 + 16 * wv + 4 * fq) = make_uint2(pk2(v[0], v[1]), pk2(v[2], v[3])); }
            LDS_BARRIER();
#pragma unroll
            for (int k = 3; k < 5; ++k) {
#pragma unroll
                for (int kk = 0; kk < 4; ++kk) { const bf16x8 b = *(const bf16x8*)(sCb + (16 * (ct_b + k - 3 - 5) + fr) * 136 + 32 * kk + 8 * fq); num[k] = mfma16(qf[kk], b, num[k]); } }
            {
                float scv[4];
#pragma unroll
                for (int j = 0; j < 4; ++j) scv[j] = fexp(m_prev - sM[16 * rw + 4 * fq + j]);
#pragma unroll
                for (int k = 0; k < 5; ++k)
#pragma unroll
                    for (int j = 0; j < 4; ++j) num[k][j] *= scv[j];
            }
            LDS_BARRIER();
#pragma unroll
            for (int si = 0; si < 2; ++si) { const int st = 2 * cw + si;
                f32x4 sacc = (f32x4){0.f, 0.f, 0.f, 0.f};
                if (st <= rw) {
#pragma unroll
                    for (int kk = 0; kk < 4; ++kk) { const bf16x8 b = *(const bf16x8*)(sK + (16 * st + fr) * 136 + 32 * kk + 8 * fq); sacc = mfma16(qf[kk], b, sacc); } }
                const int sp = 16 * st + fr; const float as = sA[sp];
#pragma unroll
                for (int j = 0; j < 4; ++j) { const int tp = 16 * rw + 4 * fq + j; const float val = (sp <= tp) ? sacc[j] * fexp(as - sM[tp]) : 0.f; sS[tp * 72 + sp] = f2bf(val); }
            }
            LDS_BARRIER();
#pragma unroll
            for (int ks = 0; ks < 2; ++ks) { const bf16x8 a = *(const bf16x8*)(sS + (16 * rw + fr) * 72 + 32 * ks + 8 * fq);
#pragma unroll
                for (int k = 0; k < 5; ++k) { const int ct = k < 3 ? ct_a + k : ct_b + k - 3;
                    if (k != 2 || cw == 0) { const bf16x8 b = *(const bf16x8*)(sVT + (16 * ct + fr) * 72 + 32 * ks + 8 * fq); num[k] = mfma16(a, b, num[k]); } } }
            if (cw == 1 && fr == 0) {
#pragma unroll
                for (int j = 0; j < 4; ++j) sDen[16 * rw + 4 * fq + j] = num[4][j]; }
            LDS_BARRIER();
            float inv[4];
#pragma unroll
            for (int j = 0; j < 4; ++j) { const int tp = 16 * rw + 4 * fq + j; const float den = sDen[tp]; inv[j] = __builtin_amdgcn_rcpf(fmaxf(fabsf(den), fexp(-(sBb[tp] + sM[tp])))); }
            if (!second) {
#pragma unroll
                for (int j = 0; j < 4; ++j) { const int tp = 16 * rw + 4 * fq + j, tl = dir ? 63 - tp : tp; const size_t row = (size_t)row0 + c * 64 + tl;
                    bf16_t* hb = dsel == 1 ? HB2 + (row - NCTX) * 512 + h * 128 : HB + row * DM + h * 128;
#pragma unroll
                    for (int k = 0; k < 5; ++k) { const int ct = k < 3 ? ct_a + k : ct_b + k - 3; if ((k != 2 || cw == 0) && ct < 8) hb[16 * ct + fr] = f2bf(num[k][j] * inv[j]); } }
            } else {
                float ssr[4];
#pragma unroll
                for (int j = 0; j < 4; ++j) { const int tp = 16 * rw + 4 * fq + j, tl = dir ? 63 - tp : tp; const size_t row = (size_t)row0 + c * 64 + tl;
                    const bf16_t* hb = HB + row * DM + h * 128; float ss = 0.f;
#pragma unroll
                    for (int k = 0; k < 5; ++k) { const int ct = k < 3 ? ct_a + k : ct_b + k - 3;
                        if ((k != 2 || cw == 0) && ct < 8) { const int e = 16 * ct + fr; const float other = bf2f(ld_u16_agent(hb + e)); const float hs = num[k][j] * inv[j] + other;
                            const float o = sigmf(bf2f(U[row * UW + 1536 + h * 128 + e])); const float v = o * hs; ss += v * v; num[k][j] = v; } }
                    ss += __shfl_xor(ss, 1); ss += __shfl_xor(ss, 2); ss += __shfl_xor(ss, 4); ss += __shfl_xor(ss, 8);
                    ssr[j] = ss; if (fr == 0) sRed[cw * 64 + tp] = ss; }
                LDS_BARRIER();
#pragma unroll
                for (int j = 0; j < 4; ++j) { const int tp = 16 * rw + 4 * fq + j, tl = dir ? 63 - tp : tp; const size_t row = (size_t)row0 + c * 64 + tl;
                    bf16_t* hb = HB + row * DM + h * 128; const float rms = rsqrtf((ssr[j] + sRed[(1 - cw) * 64 + tp]) * (1.f / 128.f) + 1e-6f);
#pragma unroll
                    for (int k = 0; k < 5; ++k) { const int ct = k < 3 ? ct_a + k : ct_b + k - 3;
                        if ((k != 2 || cw == 0) && ct < 8) { const int e = 16 * ct + fr; hb[e] = f2bf(num[k][j] * rms * p.hg[h * 128 + e]); } } }
            }
            const float decay = fexp(m_prev - M63);
#pragma unroll
            for (int ct = 0; ct < 9; ++ct) Cacc[ct] = Cacc[ct] * decay;
#pragma unroll
            for (int ks = 0; ks < 2; ++ks) { const bf16x8 a = *(const bf16x8*)(sKwT + (16 * wv + fr) * 72 + 32 * ks + 8 * fq);
#pragma unroll
                for (int ct = 0; ct < 9; ++ct) { const bf16x8 b = *(const bf16x8*)(sVT + (16 * ct + fr) * 72 + 32 * ks + 8 * fq); Cacc[ct] = mfma16(a, b, Cacc[ct]); } }
            m_prev = bL + M63;
        }
        if (ctx) { const int sidx = (bg * 2 + dir) * 4 + h; float* Co = p.out + OUT_C + (size_t)sidx * 16384;
            int z1 = 0; asm volatile("" : "+v"(z1)); const int tid1 = (int)threadIdx.x + z1, fr1 = tid1 & 15, fq1 = (tid1 >> 4) & 3;
#pragma unroll
            for (int j = 0; j < 4; ++j) { const int d = 16 * wv + 4 * fq1 + j;
#pragma unroll
                for (int ct = 0; ct < 8; ++ct) Co[d * 128 + 16 * ct + fr1] = Cacc[ct][j];
                if (fr1 == 0) p.out[OUT_N + sidx * 128 + d] = Cacc[8][j]; }
            if (tid1 == 0) p.out[OUT_MM + sidx] = m_prev; }
        __syncthreads();
    }
}

__device__ __forceinline__ void phase_shift(bf16_t* U, const float* pmu, uint4* sRow) {
#pragma unroll 1
    for (int item = blockIdx.x; item < 1200; item += gridDim.x) {
        const int tid = opaque_tid(), tl = tid >> 3, g = tid & 7;
        const bool grid = item < 240; const int seq = grid ? item / 30 : (item - 240) / 30, sl = grid ? item % 30 : (item - 240) % 30;
        const int T = grid ? 2048 : 256, nst = T / 64; const size_t row0 = grid ? (size_t)NCTX + (size_t)seq * 2048 : (size_t)seq * 256;
        const int rc = sl * 64 + g * 8;
        char* base = (char*)(U + row0 * UW + 2048 + rc);
        const int act = (rc >= 1536 && rc < 1664) ? 1 : (rc >= 1792 ? 2 : 0);
        unsigned z0_ = 0u; asm volatile("" : "+v"(z0_));
        uint4 prv = make_uint4(z0_, z0_, z0_, z0_), cur = *(const uint4*)(base + (size_t)tl * (UW * 2)), nxt;
        __syncthreads();
#pragma unroll 1
        for (int k = 0; k < nst; ++k) {
            unsigned zr = 0u; asm volatile("" : "+v"(zr)); const uint4 z4 = make_uint4(zr, zr, zr, zr);
            nxt = z4; if (k + 1 < nst) nxt = *(const uint4*)(base + (size_t)((k + 1) * 64 + tl) * (UW * 2));
            sRow[(1 + tl) * 8 + g] = cur;
            if (tl == 0) sRow[65 * 8 + g] = nxt;
            LDS_BARRIER();
            uint4 lf = sRow[tl * 8 + g], rt = sRow[(2 + tl) * 8 + g];
            if (tl == 0 && (grid || k == 0)) lf = z4;
            if (tl == 63 && (grid || k == nst - 1)) rt = z4;
            float x[8], t[8], o[8], ms[8], m[8];
            int zz = 0; asm volatile("" : "+v"(zz)); const float* mup = pmu + rc + zz;
#define LD_MU8(a) do { const float4 m0 = *(const float4*)(mup + (a) * 1920), m1 = *(const float4*)(mup + (a) * 1920 + 4); m[0] = m0.x; m[1] = m0.y; m[2] = m0.z; m[3] = m0.w; m[4] = m1.x; m[5] = m1.y; m[6] = m1.z; m[7] = m1.w; } while (0)
            unpack8(cur, x);
            LD_MU8(0); unpack8(lf, t);
#pragma unroll
            for (int i = 0; i < 8; ++i) { o[i] = m[i] * t[i]; ms[i] = m[i]; }
            LD_MU8(1); unpack8(rt, t);
#pragma unroll
            for (int i = 0; i < 8; ++i) { o[i] += m[i] * t[i]; ms[i] += m[i]; }
            if (grid) {
                LD_MU8(2); unpack8(prv, t);
#pragma unroll
                for (int i = 0; i < 8; ++i) { o[i] += m[i] * t[i]; ms[i] += m[i]; }
                LD_MU8(3); unpack8(nxt, t);
#pragma unroll
                for (int i = 0; i < 8; ++i) { o[i] += m[i] * t[i]; ms[i] += m[i]; }
            }
#undef LD_MU8
#pragma unroll
            for (int i = 0; i < 8; ++i) o[i] += x[i] * (1.f - ms[i]);
            if (act == 1) {
#pragma unroll
                for (int i = 0; i < 8; ++i) o[i] = tanh_fast(o[i]); }
            if (act == 2) {
#pragma unroll
                for (int i = 0; i < 8; ++i) o[i] = sigmf(o[i]); }
            *(uint4*)(base + (size_t)(k * 64 + tl) * (UW * 2)) = make_uint4(pk2(o[0], o[1]), pk2(o[2], o[3]), pk2(o[4], o[5]), pk2(o[6], o[7]));
            LDS_BARRIER();
            if (tl == 63) sRow[g] = cur;
            prv = cur; cur = nxt;
        }
    }
}

constexpr int RW_TC = 16;
constexpr int RW_VEC = 0, RW_V = RW_VEC + 16 * 320 * 4, RW_KR = RW_V + 16 * 32 * 4, RW_XW = RW_KR + 16 * 64 * 4, RW_XA = RW_XW + 16 * 72 * 2, RW_Y = RW_XA + 16 * 72 * 2,
              RW_MU = RW_Y + 16 * 32 * 4, RW_DIR = RW_MU + 4 * 288 * 4;
static_assert(2 * RW_DIR <= LDS_BYTES && RW_DIR % 16 == 0, "rwkv lds");

__device__ __forceinline__ float dppf(float x, const int ctrl) { return x; }
#define DPP_ADD(x, ctrl) ((x) + __int_as_float(__builtin_amdgcn_update_dpp(0, __float_as_int(x), (ctrl), 0xf, 0xf, true)))
__device__ __forceinline__ float red8(float x) { x = DPP_ADD(x, 0xB1); x = DPP_ADD(x, 0x4E); x = DPP_ADD(x, 0x141); return x; }
__device__ __forceinline__ float red16(float x) { x = red8(x); x = DPP_ADD(x, 0x140); return x; }

struct Sh8 { uint4 x, l, r, u, d; };
__device__ __forceinline__ void sh8_load(Sh8& q, const bf16_t* U, size_t row0, int tok, int T, bool grid, int c0) {
    const char* Ub = (const char*)(U + row0 * UW);
    const int off = (tok * UW + c0) * 2; const uint4 z = make_uint4(0u, 0u, 0u, 0u);
    const bool hl = grid ? (tok & 63) != 0 : tok > 0, hr = grid ? (tok & 63) != 63 : tok < T - 1;
    q.x = *(const uint4*)(Ub + off);
    q.l = hl ? *(const uint4*)(Ub + (off - UW * 2)) : z; q.r = hr ? *(const uint4*)(Ub + (off + UW * 2)) : z;
    q.u = (grid && tok >= 64) ? *(const uint4*)(Ub + (off - 64 * UW * 2)) : z; q.d = (grid && tok < T - 64) ? *(const uint4*)(Ub + (off + 64 * UW * 2)) : z;
}
__device__ __forceinline__ void sh8_mix(const Sh8& q, bool grid, const float* mu4, int mustride, float* o) {
    float x[8], t[8], m[8], ms[8];
    unpack8(q.x, x);
    { const float4 a = *(const float4*)mu4, b = *(const float4*)(mu4 + 4); m[0] = a.x; m[1] = a.y; m[2] = a.z; m[3] = a.w; m[4] = b.x; m[5] = b.y; m[6] = b.z; m[7] = b.w; }
    unpack8(q.l, t);
#pragma unroll
    for (int i = 0; i < 8; ++i) { o[i] = m[i] * t[i]; ms[i] = m[i]; }
    { const float4 a = *(const float4*)(mu4 + mustride), b = *(const float4*)(mu4 + mustride + 4); m[0] = a.x; m[1] = a.y; m[2] = a.z; m[3] = a.w; m[4] = b.x; m[5] = b.y; m[6] = b.z; m[7] = b.w; }
    unpack8(q.r, t);
#pragma unroll
    for (int i = 0; i < 8; ++i) { o[i] += m[i] * t[i]; ms[i] += m[i]; }
    if (grid) {
        { const float4 a = *(const float4*)(mu4 + 2 * mustride), b = *(const float4*)(mu4 + 2 * mustride + 4); m[0] = a.x; m[1] = a.y; m[2] = a.z; m[3] = a.w; m[4] = b.x; m[5] = b.y; m[6] = b.z; m[7] = b.w; }
        unpack8(q.u, t);
#pragma unroll
        for (int i = 0; i < 8; ++i) { o[i] += m[i] * t[i]; ms[i] += m[i]; }
        { const float4 a = *(const float4*)(mu4 + 3 * mustride), b = *(const float4*)(mu4 + 3 * mustride + 4); m[0] = a.x; m[1] = a.y; m[2] = a.z; m[3] = a.w; m[4] = b.x; m[5] = b.y; m[6] = b.z; m[7] = b.w; }
        unpack8(q.d, t);
#pragma unroll
        for (int i = 0; i < 8; ++i) { o[i] += m[i] * t[i]; ms[i] += m[i]; }
    }
#pragma unroll
    for (int i = 0; i < 8; ++i) o[i] += x[i] * (1.f - ms[i]);
}
__device__ __forceinline__ void shifted8(const bf16_t* U, size_t row0, int tok, int T, bool grid, int c0, const float* mu4, int mustride, float* o) {
    Sh8 q; sh8_load(q, U, row0, tok, T, grid, c0); sh8_mix(q, grid, mu4, mustride, o);
}
typedef float f32x2 __attribute__((ext_vector_type(2)));

__device__ __forceinline__ void rwkv_task(const P& p, unsigned char* lds, int bg, int h, int rh) {
    const int wv = __builtin_amdgcn_readfirstlane((int)threadIdx.x >> 6), dir = wv >> 2, lw = wv & 3;
    const bool ctx = bg < 32; const int T = ctx ? 256 : 2048, nc = T / RW_TC; const size_t row0 = ctx ? (size_t)bg * 256 : (size_t)NCTX + (size_t)(bg - 32) * 2048;
    const bool grid = !ctx;
    unsigned char* L = lds + dir * RW_DIR;
    float* sVec = (float*)(L + RW_VEC); float* sV = (float*)(L + RW_V); float* sKr = (float*)(L + RW_KR); bf16_t* sXw = (bf16_t*)(L + RW_XW); bf16_t* sXa = (bf16_t*)(L + RW_XA);
    float* sY = (float*)(L + RW_Y); float* sMu = (float*)(L + RW_MU);
    const bf16_t* U = (const bf16_t*)(p.ws + WS_U); bf16_t* HB = (bf16_t*)(p.ws + WS_A);
    const int hc = h * 64;
    float st[8]; bf16x8 wfrag[2], afrag[2]; float w0v, a0v, kav;
    {
        const int tid = opaque_tid(), ltid = tid & 255, ri = ltid >> 3, jq = ltid & 7, fr = tid & 15, fq = (tid >> 4) & 3;
        __syncthreads();
        if (ctx) {
#pragma unroll
            for (int q = 0; q < 8; ++q) st[q] = 0.f;
        } else { const float* S0 = p.sS + ((size_t)(((bg - 32) * 2 + dir) * 8 + h)) * 4096 + (32 * rh + ri) * 64 + jq * 8;
#pragma unroll
            for (int q = 0; q < 8; ++q) st[q] = S0[q]; }
        const int jcol = hc + 16 * lw + fr;
#pragma unroll
        for (int ks = 0; ks < 2; ++ks) { float wf[8], af[8];
#pragma unroll
            for (int i = 0; i < 8; ++i) { const int l = 32 * ks + 8 * fq + i; wf[i] = p.w2[(size_t)(dir * 64 + l) * 512 + jcol]; af[i] = p.a2[(size_t)(dir * 64 + l) * 512 + jcol]; }
            union { uint4 u; bf16x8 v; } c1, c2; c1.u = make_uint4(pk2(wf[0], wf[1]), pk2(wf[2], wf[3]), pk2(wf[4], wf[5]), pk2(wf[6], wf[7])); c2.u = make_uint4(pk2(af[0], af[1]), pk2(af[2], af[3]), pk2(af[4], af[5]), pk2(af[6], af[7]));
            wfrag[ks] = c1.v; afrag[ks] = c2.v; }
        w0v = p.w0[dir * 512 + jcol]; a0v = p.a0[dir * 512 + jcol]; kav = p.ka[jcol];
    }
    uint4 q1, q2, q3 = make_uint4(0u, 0u, 0u, 0u);
    const char* Ub = (const char*)(U + row0 * UW);
    { const int tid = opaque_tid(), ltid = tid & 255; const int c = dir ? nc - 1 : 0, tok0 = c * RW_TC; const int tl = (ltid & 127) >> 3, g = ltid & 7;
      q1 = *(const uint4*)(Ub + ((tok0 + tl) * UW + (lw < 2 ? 2048 : 2048 + 512) + hc + 8 * g) * 2);
      q2 = *(const uint4*)(Ub + ((tok0 + tl) * UW + (lw < 2 ? 2048 + 1536 : 2048 + 1664) + dir * 64 + 8 * g) * 2);
      if (lw == 0) q3 = *(const uint4*)(Ub + ((tok0 + (ltid >> 2)) * UW + 2048 + 1024 + hc + 32 * rh + 8 * (ltid & 3)) * 2); }
    f32x2 st2[4];
#pragma unroll
    for (int q = 0; q < 4; ++q) st2[q] = (f32x2){st[2 * q], st[2 * q + 1]};
#pragma unroll 1
    for (int s = 0; s < nc; ++s) {
        const int c = dir ? nc - 1 - s : s; const int tok0 = c * RW_TC;
        const bool second = s >= (nc >> 1);
        const int tid = opaque_tid(), ltid = tid & 255, ri = ltid >> 3, jq = ltid & 7, fr = tid & 15, fq = (tid >> 4) & 3;
        { const int tl = (ltid & 127) >> 3, g = ltid & 7; float o[8];
          if (lw < 2) {
              unpack8(q1, o);
              *(float4*)(sVec + tl * 320 + 8 * g) = make_float4(o[0], o[1], o[2], o[3]); *(float4*)(sVec + tl * 320 + 8 * g + 4) = make_float4(o[4], o[5], o[6], o[7]);
              *(uint4*)(sXw + tl * 72 + 8 * g) = q2;
          } else {
              unpack8(q1, o);
              float kkr[8]; float ss = 0.f;
#pragma unroll
              for (int i = 0; i < 8; ++i) { kkr[i] = o[i] * p.kk[hc + 8 * g + i]; ss += kkr[i] * kkr[i]; }
              ss = red8(ss); const float rn = __builtin_amdgcn_rsqf(fmaxf(ss, 1e-24f));
              *(float4*)(sKr + tl * 64 + 8 * g) = make_float4(o[0], o[1], o[2], o[3]); *(float4*)(sKr + tl * 64 + 8 * g + 4) = make_float4(o[4], o[5], o[6], o[7]);
              *(float4*)(sVec + tl * 320 + 192 + 8 * g) = make_float4(kkr[0] * rn, kkr[1] * rn, kkr[2] * rn, kkr[3] * rn); *(float4*)(sVec + tl * 320 + 192 + 8 * g + 4) = make_float4(kkr[4] * rn, kkr[5] * rn, kkr[6] * rn, kkr[7] * rn);
              *(uint4*)(sXa + tl * 72 + 8 * g) = q2;
          }
          if (lw == 0) {
              const int tl2 = ltid >> 2, g2 = ltid & 3;
              unpack8(q3, o);
              *(float4*)(sV + tl2 * 32 + 8 * g2) = make_float4(o[0], o[1], o[2], o[3]); *(float4*)(sV + tl2 * 32 + 8 * g2 + 4) = make_float4(o[4], o[5], o[6], o[7]);
          } }
        __syncthreads();
        { f32x4 aw = (f32x4){0.f, 0.f, 0.f, 0.f}, aa = (f32x4){0.f, 0.f, 0.f, 0.f};
#pragma unroll
          for (int ks = 0; ks < 2; ++ks) { const bf16x8 xw = *(const bf16x8*)(sXw + fr * 72 + 32 * ks + 8 * fq), xa = *(const bf16x8*)(sXa + fr * 72 + 32 * ks + 8 * fq);
              aw = mfma16(xw, wfrag[ks], aw); aa = mfma16(xa, afrag[ks], aa); }
          const int j = 16 * lw + fr;
#pragma unroll
          for (int jj = 0; jj < 4; ++jj) { const int tl = 4 * fq + jj;
              const float dec = fexp(-fexp(-softplus_fast(-(w0v + aw[jj])) - 0.5f));
              const float a = sigmf(a0v + aa[jj]); const float k = sKr[tl * 64 + j], kn = sVec[tl * 320 + 192 + j];
              float* V = sVec + tl * 320 + j; V[64] = dec; V[128] = k * (1.f + (a - 1.f) * kav); V[256] = kn * a; } }
        const int otl = ltid >> 4, opr = ltid & 15; unsigned* hb = (unsigned*)(HB + (row0 + tok0 + otl) * DM + 512 + hc + 32 * rh + 2 * opr);
        unsigned ov = 0u;
        if (second) ov = __hip_atomic_load(hb, __ATOMIC_RELAXED, __HIP_MEMORY_SCOPE_AGENT);
        if (s + 1 < nc) { const int cn = dir ? nc - 2 - s : s + 1, tokn = cn * RW_TC; const int tl = (ltid & 127) >> 3, g = ltid & 7;
            q1 = *(const uint4*)(Ub + ((tokn + tl) * UW + (lw < 2 ? 2048 : 2048 + 512) + hc + 8 * g) * 2);
            q2 = *(const uint4*)(Ub + ((tokn + tl) * UW + (lw < 2 ? 2048 + 1536 : 2048 + 1664) + dir * 64 + 8 * g) * 2);
            if (lw == 0) q3 = *(const uint4*)(Ub + ((tokn + (ltid >> 2)) * UW + 2048 + 1024 + hc + 32 * rh + 8 * (ltid & 3)) * 2); }
        LDS_BARRIER();
        f32x2 sv_[4];
#pragma unroll
        for (int q = 0; q < 4; ++q) sv_[q] = st2[q];
#pragma unroll 1
        for (int rep = 0; rep < (PROBE_DUP == 102 ? 2 : 1); ++rep) {
        if (PROBE_DUP == 102) {
#pragma unroll
            for (int q = 0; q < 4; ++q) st2[q] = sv_[q]; }
float ys[RW_TC];
#pragma unroll
        for (int step = 0; step < RW_TC; ++step) { const int tl = dir ? RW_TC - 1 - step : step; const float* V = sVec + tl * 320 + jq * 8;
            const float4 ka4 = *(const float4*)(V + 192), kb4 = *(const float4*)(V + 196);
            f32x2 acc = st2[0] * (f32x2){ka4.x, ka4.y}; acc = st2[1] * (f32x2){ka4.z, ka4.w} + acc; acc = st2[2] * (f32x2){kb4.x, kb4.y} + acc; acc = st2[3] * (f32x2){kb4.z, kb4.w} + acc;
            const float sa = -red8(acc.x + acc.y);
            const float vi = sV[tl * 32 + ri];
            const float4 wa = *(const float4*)(V + 64), wb = *(const float4*)(V + 68), ba = *(const float4*)(V + 256), bb = *(const float4*)(V + 260),
                         da = *(const float4*)(V + 128), db = *(const float4*)(V + 132), ra = *(const float4*)(V), rb = *(const float4*)(V + 4);
            const f32x2 sa2 = (f32x2){sa, sa}, vi2 = (f32x2){vi, vi};
            st2[0] = st2[0] * (f32x2){wa.x, wa.y} + (sa2 * (f32x2){ba.x, ba.y} + vi2 * (f32x2){da.x, da.y});
            st2[1] = st2[1] * (f32x2){wa.z, wa.w} + (sa2 * (f32x2){ba.z, ba.w} + vi2 * (f32x2){da.z, da.w});
            st2[2] = st2[2] * (f32x2){wb.x, wb.y} + (sa2 * (f32x2){bb.x, bb.y} + vi2 * (f32x2){db.x, db.y});
            st2[3] = st2[3] * (f32x2){wb.z, wb.w} + (sa2 * (f32x2){bb.z, bb.w} + vi2 * (f32x2){db.z, db.w});
            f32x2 ya = st2[0] * (f32x2){ra.x, ra.y}; ya = st2[1] * (f32x2){ra.z, ra.w} + ya; ya = st2[2] * (f32x2){rb.x, rb.y} + ya; ya = st2[3] * (f32x2){rb.z, rb.w} + ya;
            const float y = red8(ya.x + ya.y);
            ys[step] = y; }
        if (jq == 0) {
#pragma unroll
            for (int step = 0; step < RW_TC; ++step) sY[(dir ? RW_TC - 1 - step : step) * 32 + ri] = ys[step]; }
        }
        LDS_BARRIER();
        { float y0 = sY[otl * 32 + 2 * opr], y1 = sY[otl * 32 + 2 * opr + 1];
          if (second) { y0 += __uint_as_float(ov << 16); y1 += __uint_as_float(ov & 0xffff0000u); }
          *hb = pk2(y0, y1); }
    }
#pragma unroll
    for (int q = 0; q < 4; ++q) { st[2 * q] = st2[q].x; st[2 * q + 1] = st2[q].y; }
    if (ctx) { const int tid = opaque_tid(), ltid = tid & 255, ri = ltid >> 3, jq = ltid & 7;
        float* So = p.out + OUT_S + ((size_t)((bg * 2 + dir) * 8 + h)) * 4096 + (32 * rh + ri) * 64 + jq * 8;
#pragma unroll
        for (int q = 0; q < 8; ++q) So[q] = st[q]; }
    __syncthreads();
}

constexpr int FZ_ROW = 1800;
constexpr int FZ_X = 0, FZ_MU = 32 * FZ_ROW * 2, FZ_END = FZ_MU + 4 * 1792 * 4;
static_assert(FZ_END <= LDS_BYTES && FZ_MU % 16 == 0, "finalize lds");

__device__ __forceinline__ void phase_rwkv_finalize(const P& p, unsigned char* lds) {
    bf16_t* sX = (bf16_t*)(lds + FZ_X); float* sMu = (float*)(lds + FZ_MU);
    const bf16_t* U = (const bf16_t*)(p.ws + WS_U); bf16_t* HB = (bf16_t*)(p.ws + WS_A);
    { const bf16_t* HB2 = (const bf16_t*)(p.ws + WS_HB2); const int tid0 = opaque_tid(), lane = tid0 & 63, wave = (int)threadIdx.x >> 6;
#pragma unroll 1
      for (int row = NCTX + blockIdx.x * 8 + wave; row < MT; row += gridDim.x * 8) {
          float hf[8], hb[8], og[8], v[8]; float ss = 0.f;
          unpack8(*(const uint4*)(HB + (size_t)row * DM + lane * 8), hf); unpack8(*(const uint4*)(HB2 + (size_t)(row - NCTX) * 512 + lane * 8), hb); unpack8(*(const uint4*)(U + (size_t)row * UW + 1536 + lane * 8), og);
#pragma unroll
          for (int i = 0; i < 8; ++i) { v[i] = sigmf(og[i]) * (hf[i] + hb[i]); ss += v[i] * v[i]; }
          ss = red16(ss); const float rms = rsqrtf(ss * (1.f / 128.f) + 1e-6f);
          const float4 g0 = *(const float4*)(p.hg + lane * 8), g1 = *(const float4*)(p.hg + lane * 8 + 4);
          *(uint4*)(HB + (size_t)row * DM + lane * 8) = make_uint4(pk2(v[0] * rms * g0.x, v[1] * rms * g0.y), pk2(v[2] * rms * g0.z, v[3] * rms * g0.w), pk2(v[4] * rms * g1.x, v[5] * rms * g1.y), pk2(v[6] * rms * g1.z, v[7] * rms * g1.w)); } }
    const bf16_t* A2 = (const bf16_t*)(p.ws + WS_A2BF); const bf16_t* G2 = (const bf16_t*)(p.ws + WS_G2BF);
    const int wv = __builtin_amdgcn_readfirstlane((int)threadIdx.x >> 6), hc = wv * 64;
#pragma unroll 1
    for (int tile = blockIdx.x; tile < MT / 32; tile += gridDim.x) {
        const int tid = opaque_tid(), fr = tid & 15, fq = (tid >> 4) & 3;
        const int rowt = tile * 32; const bool ctx = rowt < NCTX; const int T = ctx ? 256 : 2048; const size_t row0 = ctx ? (size_t)(rowt & ~255) : (size_t)NCTX + (size_t)((rowt - NCTX) & ~2047);
        const int tokt = rowt - (int)row0;
        __syncthreads();
#pragma unroll 2
        for (int it = 0; it < 14; ++it) { const int item = it * NTHR + tid, tl = item / 224, gi = item % 224;
            const int c0 = gi < 192 ? 2048 + 8 * gi : 2048 + 1664 + 8 * (gi - 192);
            *(uint4*)(sX + tl * FZ_ROW + 8 * gi) = *(const uint4*)(U + (row0 + tokt + tl) * UW + c0); }
        __syncthreads();
#pragma unroll 1
        for (int rt = 0; rt < 2; ++rt) {
            f32x4 af[4], ab[4], gg[4];
#pragma unroll
            for (int ct = 0; ct < 4; ++ct) { af[ct] = (f32x4){0.f, 0.f, 0.f, 0.f}; ab[ct] = af[ct]; gg[ct] = af[ct]; }
            const bf16_t* xr = sX + (16 * rt + fr) * FZ_ROW;
#pragma unroll
            for (int ks = 0; ks < 2; ++ks) { const bf16x8 xf = *(const bf16x8*)(xr + 1536 + 32 * ks + 8 * fq), xb = *(const bf16x8*)(xr + 1600 + 32 * ks + 8 * fq);
#pragma unroll
                for (int ct = 0; ct < 4; ++ct) { const int n = hc + 16 * ct + fr;
                    af[ct] = mfma16(xf, *(const bf16x8*)(A2 + (size_t)n * 64 + 32 * ks + 8 * fq), af[ct]);
                    ab[ct] = mfma16(xb, *(const bf16x8*)(A2 + (size_t)(512 + n) * 64 + 32 * ks + 8 * fq), ab[ct]); } }
#pragma unroll
            for (int ks = 0; ks < 4; ++ks) { const bf16x8 xg = *(const bf16x8*)(xr + 1664 + 32 * ks + 8 * fq);
#pragma unroll
                for (int ct = 0; ct < 4; ++ct) { const int n = hc + 16 * ct + fr; gg[ct] = mfma16(xg, *(const bf16x8*)(G2 + (size_t)n * 128 + 32 * ks + 8 * fq), gg[ct]); } }
#pragma unroll
            for (int jj = 0; jj < 4; ++jj) { const int tl = 16 * rt + 4 * fq + jj; const size_t row = (size_t)rowt + tl; const bf16_t* xt = sX + tl * FZ_ROW;
                bf16_t* hb = HB + row * DM + 512 + hc;
                float y[4], vv[4]; float sy = 0.f, sb = 0.f;
#pragma unroll
                for (int ct = 0; ct < 4; ++ct) { const int ch = hc + 16 * ct + fr;
                    const float am = 0.5f * (sigmf(p.a0[ch] + af[ct][jj]) + sigmf(p.a0[512 + ch] + ab[ct][jj]));
                    const float r = bf2f(xt[ch]), k = bf2f(xt[512 + ch]); vv[ct] = bf2f(xt[1024 + ch]);
                    sb += r * k * (1.f + (am - 1.f) * p.ka[ch]) * p.rk[ch];
                    y[ct] = bf2f(hb[16 * ct + fr]); sy += y[ct]; }
                sy = red16(sy); sb = red16(sb);
                const float mean = sy * (1.f / 64.f); float vs = 0.f;
#pragma unroll
                for (int ct = 0; ct < 4; ++ct) { const float d = y[ct] - mean; vs += d * d; }
                vs = red16(vs); const float rstd = rsqrtf(vs * (1.f / 64.f) + 64e-5f);
#pragma unroll
                for (int ct = 0; ct < 4; ++ct) { const int ch = hc + 16 * ct + fr; const float yn = (y[ct] - mean) * rstd * p.lng[ch] + p.lnb[ch];
                    hb[16 * ct + fr] = f2bf((yn + sb * vv[ct]) * gg[ct][jj]); } }
        }
    }
}

__device__ __forceinline__ void phase_scan(const P& p, unsigned char* lds, int round = 0) {
    unsigned* ctr = (unsigned*)(p.ws + WS_CTR) + round;
    volatile int* sTask = (volatile int*)(lds + LDS_BYTES - 16);
#pragma unroll 1
    for (;;) {
        __syncthreads();
        if (threadIdx.x == 0) *sTask = (int)atomicAdd(ctr, 1u);
        __syncthreads();
        const int t = __builtin_amdgcn_readfirstlane(*sTask);
        if (t >= 832) break;
#pragma unroll 1
        for (int rep = 0; rep < ((PROBE_DUP == 100 && (t < 64 || (t >= 192 && t < 320))) || (PROBE_DUP == 101 && !(t < 64 || (t >= 192 && t < 320))) ? 2 : 1); ++rep) {
        if (t < 64) mlstm_task(p, lds, 32 + (t >> 3), (t >> 1) & 3, t & 1);
        else if (t < 192) { const int q = t - 64; rwkv_task(p, lds, 32 + (q >> 4), (q >> 1) & 7, q & 1); }
        else if (t < 320) { const int q = t - 192; mlstm_task(p, lds, q >> 2, q & 3, -1); }
        else { const int q = t - 320; rwkv_task(p, lds, q >> 4, (q >> 1) & 7, q & 1); }
        }
    }
}

__device__ void phase_convert_w2(const P& p, unsigned char* lds) {
    float* tile = (float*)lds;
    const int t1 = 16 * 88, t2 = 44 * 16;
    for (int it = blockIdx.x; it < t1 + t2; it += gridDim.x) {
        if (it < t1) do_convert(p.w2in, (bf16_t*)(p.ws + WS_W1), 1024, 5632, 5632, 1, it, tile);
        else do_convert(p.w2out, (bf16_t*)(p.ws + WS_W1B), 2816, 1024, 1024, 0, it - t1, tile);
    }
}

#define XB_TMO      128
#define XB_XCNT(j)  (256  + 64 * (j))
#define XB_XSUB(j)  (1280 + 64 * (j))
#define XB_XGEN(j)  (2304 + 64 * (j))
#define XB_TOP      3328
#define XB_TOPGEN   3392
#define XCD_BAR_WORDS 3456
#define XB_SPIN_CAP (1u << 18)
__device__ __forceinline__ unsigned xb_ld(unsigned* p)              { return __hip_atomic_load(p, __ATOMIC_RELAXED, __HIP_MEMORY_SCOPE_AGENT); }
__device__ __forceinline__ unsigned xb_add(unsigned* p, unsigned v) { return __hip_atomic_fetch_add(p, v, __ATOMIC_RELAXED, __HIP_MEMORY_SCOPE_AGENT); }
__device__ __forceinline__ unsigned xb_xcc_id() { return (unsigned)__builtin_amdgcn_s_getreg((3 << 11) | 20) & 0xFu; }
#define XB_SPIN(cond, bar) do { unsigned _sp = 0; while (cond) { __builtin_amdgcn_s_sleep(1); \
    if ((++_sp & 255u) == 0u) { if (xb_ld(&(bar)[XB_TMO])) break; if (_sp > XB_SPIN_CAP) { atomicAdd(&(bar)[XB_TMO], 1u); break; } } } } while (0)
struct XcdBarrier { unsigned* bar; unsigned x; volatile unsigned* st; };
__device__ __forceinline__ XcdBarrier xcd_barrier_post(unsigned* bar, volatile unsigned* st) {
    XcdBarrier b; b.bar = bar; b.x = xb_xcc_id(); b.st = st;
    if (threadIdx.x == 0) (void)xb_add(&bar[XB_XCNT(b.x)], 1u);
    return b;
}
__device__ __forceinline__ void xcd_barrier_complete(unsigned* bar, unsigned x, unsigned& nloc, unsigned& nx) {
    const unsigned G = gridDim.x * gridDim.y * gridDim.z;
    unsigned sum, cnt, mine, sp = 0u;
    for (;;) {
        sum = 0u; cnt = 0u; mine = 0u;
#pragma unroll
        for (unsigned j = 0; j < 16; ++j) { const unsigned c = xb_ld(&bar[XB_XCNT(j)]); sum += c; cnt += (c > 0u) ? 1u : 0u; mine = (j == x) ? c : mine; }
        if (sum == G) break;
        __builtin_amdgcn_s_sleep(1);
        if ((++sp & 255u) == 0u) { if (xb_ld(&bar[XB_TMO])) break; if (sp > XB_SPIN_CAP) { atomicAdd(&bar[XB_TMO], 1u); break; } }
    }
    nloc = mine > 0u ? mine : 1u; nx = cnt > 0u ? cnt : 1u;
}
__device__ __forceinline__ void xcd_barrier(const XcdBarrier& b) {
    asm volatile("s_waitcnt vmcnt(0)" ::: "memory");
    __syncthreads();
    if (threadIdx.x == 0) {
        unsigned* bar = b.bar;
        __builtin_amdgcn_s_waitcnt(0);
        unsigned nloc = b.st[0], nx = b.st[1];
        if (nloc == 0u) { xcd_barrier_complete(bar, b.x, nloc, nx); b.st[0] = nloc; b.st[1] = nx; }
        const unsigned old = xb_add(&bar[XB_XSUB(b.x)], 1u);
        const unsigned gen = old / nloc;
        if (old + 1u == (gen + 1u) * nloc) {
            __builtin_amdgcn_fence(__ATOMIC_RELEASE, "agent");
            asm volatile("s_waitcnt vmcnt(0)" ::: "memory");
            const unsigned og = xb_add(&bar[XB_TOP], 1u);
            const unsigned tg = og / nx;
            if (og + 1u == (tg + 1u) * nx) xb_add(&bar[XB_TOPGEN], 1u);
            else XB_SPIN(xb_ld(&bar[XB_TOPGEN]) == tg, bar);
            __builtin_amdgcn_fence(__ATOMIC_ACQUIRE, "agent");
            xb_add(&bar[XB_XGEN(b.x)], 1u);
            asm volatile("s_waitcnt vmcnt(0)" ::: "memory");
        } else {
            XB_SPIN(xb_ld(&bar[XB_XGEN(b.x)]) == gen, bar);
            __builtin_amdgcn_fence(__ATOMIC_ACQUIRE, "agent");
            asm volatile("s_waitcnt vmcnt(0)" ::: "memory");
        }
    }
    __syncthreads();
}

constexpr int NPHASE = 12;
template <int PH>
__device__ __forceinline__ void run_phase(const P& p, unsigned char* lds) {
    const float* mod = (const float*)(p.ws + WS_MOD);
    if constexpr (PH == 0) phase0(p, lds);
    if constexpr (PH == 1) phase_normmod(p, 0);
    if constexpr (PH == 2) { EpiSwiglu E{(bf16_t*)(p.ws + WS_U)}; run_gemm(lds, (const bf16_t*)(p.ws + WS_A), (const bf16_t*)(p.ws + WS_W1), 5632, 1024, E); }
    if constexpr (PH == 3) { EpiResid E{p.xp, p.xs, p.out, mod + 2048, 0.5f, 0}; run_gemm(lds, (const bf16_t*)(p.ws + WS_U), (const bf16_t*)(p.ws + WS_W1B), 1024, 2816, E); }
    if constexpr (PH == 4) phase_normmod(p, 1);
    if constexpr (PH == 5) { EpiU E{(bf16_t*)(p.ws + WS_U), (float*)(p.ws + WS_GATES)}; run_gemm(lds, (const bf16_t*)(p.ws + WS_A), (const bf16_t*)(p.ws + WS_BT3), 4096, 1024, E); }
    if constexpr (PH == 6) phase_scan(p, lds);
    if constexpr (PH == 12) phase_rwkv_finalize(p, lds);
    if constexpr (PH == 13) phase_shift((bf16_t*)(p.ws + WS_U), p.mu, (uint4*)lds);
    if constexpr (PH == 7) { EpiResid E{p.xp, p.xs, p.out, mod + 5120, 1.0f, 1}; run_gemm(lds, (const bf16_t*)(p.ws + WS_A), (const bf16_t*)(p.ws + WS_BT4), 1024, 1024, E); }
    if constexpr (PH == 8) { phase_normmod(p, 2); phase_convert_w2(p, lds); }
    if constexpr (PH == 9) { EpiSwiglu E{(bf16_t*)(p.ws + WS_U)}; run_gemm(lds, (const bf16_t*)(p.ws + WS_A), (const bf16_t*)(p.ws + WS_W1), 5632, 1024, E); }
    if constexpr (PH == 10) { EpiResid E{p.xp, p.xs, p.out, mod + 8192, 0.5f, 1}; run_gemm(lds, (const bf16_t*)(p.ws + WS_U), (const bf16_t*)(p.ws + WS_W1B), 1024, 2816, E); }
    if constexpr (PH == 11) phase_finalnorm(p);
}

#if !ONE_LAUNCH
template <int PH>
__global__ void __launch_bounds__(NTHR, 2) k_phase(P p) {
    extern __shared__ __attribute__((aligned(16))) unsigned char lds[];
    run_phase<PH>(p, lds);
}
#endif

#if ONE_LAUNCH
__global__ void __launch_bounds__(NTHR, 2) k_mega(P p) {
    extern __shared__ __attribute__((aligned(16))) unsigned char lds[];
    cg::grid_group grid = cg::this_grid();
    volatile unsigned* xst = (volatile unsigned*)(lds + LDS_BYTES - 32);
    if (threadIdx.x == 0) { xst[0] = 0u; xst[1] = 0u; }
    __syncthreads();
    const XcdBarrier xbar = xcd_barrier_post((unsigned*)(p.ws + WS_BAR), xst);
#define GSYNC() xcd_barrier(xbar)
    run_phase<0>(p, lds); grid.sync();
    if (PROBE_DUP == 0) { run_phase<0>(p, lds); GSYNC(); }
    run_phase<1>(p, lds); GSYNC();
    if (PROBE_DUP == 1) { run_phase<1>(p, lds); GSYNC(); }
    run_phase<2>(p, lds); GSYNC();
    if (PROBE_DUP == 2 || PROBE_DUP == 235) { run_phase<2>(p, lds); GSYNC(); }
    run_phase<3>(p, lds); GSYNC();
    if (PROBE_DUP == 3 || PROBE_DUP == 235) { run_phase<3>(p, lds); GSYNC(); }
    run_phase<4>(p, lds); GSYNC();
    if (PROBE_DUP == 4) { run_phase<4>(p, lds); GSYNC(); }
    run_phase<5>(p, lds); GSYNC();
    if (PROBE_DUP == 5 || PROBE_DUP == 235) { run_phase<5>(p, lds); GSYNC(); }
    run_phase<13>(p, lds); GSYNC();
    run_phase<6>(p, lds); GSYNC();
    if (PROBE_DUP == 6) { phase_scan(p, lds, 1); GSYNC(); }
    run_phase<12>(p, lds); GSYNC();
    run_phase<7>(p, lds); GSYNC();
    if (PROBE_DUP == 7) { run_phase<7>(p, lds); GSYNC(); }
    run_phase<8>(p, lds); GSYNC();
    if (PROBE_DUP == 8) { run_phase<8>(p, lds); GSYNC(); }
    run_phase<9>(p, lds); GSYNC();
    if (PROBE_DUP == 9) { run_phase<9>(p, lds); GSYNC(); }
    run_phase<10>(p, lds); GSYNC();
    if (PROBE_DUP == 10) { run_phase<10>(p, lds); GSYNC(); }
    run_phase<11>(p, lds);
    if (PROBE_DUP == 200) { for (int i = 0; i < 20; ++i) GSYNC(); }
}
#endif

#if !ONE_LAUNCH
template <int PH> static void launch_phase(const P& p, int grid, hipStream_t stream) {
    static bool attr = false;
    if (!attr) { (void)hipFuncSetAttribute((const void*)k_phase<PH>, hipFuncAttributeMaxDynamicSharedMemorySize, LDS_BYTES); attr = true; }
    hipLaunchKernelGGL(k_phase<PH>, dim3(grid), dim3(NTHR), LDS_BYTES, stream, p);
}
#endif

extern "C" void kernel_launch(void* const* d_in, const int* in_sizes, int n_in, void* d_out, int out_size, void* d_ws, size_t ws_size, hipStream_t stream) {
    (void)in_sizes; (void)n_in; (void)out_size; (void)ws_size;
    static int grid = 0;
    if (grid == 0) {
        int dev = 0, cus = 0;
        if (hipGetDevice(&dev) != hipSuccess || hipDeviceGetAttribute(&cus, hipDeviceAttributeMultiprocessorCount, dev) != hipSuccess || cus <= 0) cus = 256;
#if ONE_LAUNCH
        (void)hipFuncSetAttribute((const void*)k_mega, hipFuncAttributeMaxDynamicSharedMemorySize, LDS_BYTES);
        int per_cu = 0;
        if (hipOccupancyMaxActiveBlocksPerMultiprocessor(&per_cu, (const void*)k_mega, NTHR, LDS_BYTES) != hipSuccess || per_cu < 1) per_cu = 1;
        (void)hipGetLastError();
#endif
        grid = cus;
    }
    P p{};
    const float** f = (const float**)&p;
    for (int i = 0; i < 35; ++i) f[i] = (const float*)d_in[i];
    p.out = (float*)d_out; p.ws = (unsigned char*)d_ws;
    (void)hipMemsetAsync((char*)d_ws + WS_MOD, 0, NCOND * MODW * sizeof(float) + 256 + 3456 * 4, stream);
#if ONE_LAUNCH
    void* args[] = {&p};
    hipError_t e = hipLaunchCooperativeKernel((const void*)k_mega, dim3(grid), dim3(NTHR), args, LDS_BYTES, stream);
    if (e != hipSuccess) fprintf(stderr, "cooperative launch failed: %s (grid %d)\n", hipGetErrorString(e), grid);
#else
    launch_phase<0>(p, grid, stream); launch_phase<1>(p, grid, stream); launch_phase<2>(p, grid, stream); launch_phase<3>(p, grid, stream);
    launch_phase<4>(p, grid, stream); launch_phase<5>(p, grid, stream); launch_phase<13>(p, grid, stream); launch_phase<6>(p, grid, stream); launch_phase<12>(p, grid, stream); launch_phase<7>(p, grid, stream);
    launch_phase<8>(p, grid, stream); launch_phase<9>(p, grid, stream); launch_phase<10>(p, grid, stream); launch_phase<11>(p, grid, stream);
#endif
}
```

```cpp
#include <hip/hip_runtime.h>
#include <hip/hip_cooperative_groups.h>
#include <cstdio>
#include <cstdint>
namespace cg = cooperative_groups;

#ifndef PROBE_DUP
#define PROBE_DUP -1
#endif
#ifndef ONE_LAUNCH
#define ONE_LAUNCH 1
#endif

#define LDS_BARRIER() do { asm volatile("s_waitcnt lgkmcnt(0)" ::: "memory"); __builtin_amdgcn_s_barrier(); asm volatile("" ::: "memory"); } while (0)
__device__ __forceinline__ int opaque_tid() { int z = 0; asm volatile("" : "+v"(z)); return (int)threadIdx.x + z; }

namespace pg8 {
#define PG8_LAS __attribute__((address_space(3)))
typedef unsigned short bf16_t;
typedef short bf16x8 __attribute__((ext_vector_type(8)));
typedef float f32x4 __attribute__((ext_vector_type(4)));
typedef unsigned u32x4 __attribute__((ext_vector_type(4)));
constexpr int BM = 256, BK = 64, HALF = 128, HTB = HALF * BK * 2, STAGE_BYTES = 8 * HTB, NXCD = 8, WGM = 8;

__host__ __device__ __forceinline__ int lds_byte(int r, int c) { const int st = (r >> 4) * 2 + (c >> 5), rr = r & 15, cc = c & 31, ob = rr * 64 + cc * 2; return st * 1024 + (ob ^ (((ob >> 9) & 1) << 5)); }
__host__ __device__ __forceinline__ void stage_rc(int b, int& R, int& C) { const int st = b / 1024, sb = b % 1024, swz = sb ^ (((sb >> 9) & 1) << 5); R = (st >> 1) * 16 + swz / 64; C = (st & 1) * 32 + (swz % 64) / 2; }
__host__ __device__ __forceinline__ int perm32(int rho) { const int n = rho >> 4, i = rho & 15; return 8 * (i >> 2) + 4 * n + (i & 3); }

struct Unit { int pm, pn; };
struct Gemm { const bf16_t* A; const bf16_t* Bt; int M, N, K; };

struct StaticOrder {
    int nM, nN, nwg, G, c;
    __host__ __device__ void init(int M, int N, int G_, int c_) { nM = M / BM; nN = N / BM; nwg = nM * nN; G = G_; c = c_; }
    __host__ __device__ bool next(int i, Unit& u) const {
        const long L = (long)i * G + c; if (L >= nwg) return false;
        int wgid = (int)L; { const int q = nwg / NXCD, r = nwg % NXCD, xcd = wgid % NXCD, off = wgid / NXCD; wgid = (xcd < r ? xcd * (q + 1) : r * (q + 1) + (xcd - r) * q) + off; }
        const int nig = WGM * nN, gid = wgid / nig, fm = gid * WGM, gsz = (nM - fm) < WGM ? (nM - fm) : WGM;
        u.pm = fm + ((wgid % nig) % gsz); u.pn = (wgid % nig) / gsz; return true;
    }
    __device__ __forceinline__ void a_ready(const Unit&) const {}
    __device__ __forceinline__ void done(const Unit&) const {}
};

__device__ __forceinline__ unsigned cvt_pk_bf16(float lo, float hi) { unsigned r; asm volatile("v_cvt_pk_bf16_f32 %0, %1, %2" : "=v"(r) : "v"(lo), "v"(hi)); return r; }

template <class Epi, class Sched, bool ALIGN_EPI = false, bool SP2 = false>
__device__ __forceinline__ void gemm_phase(PG8_LAS unsigned char* lds, const Gemm g, const Sched& S, const Epi& E) {
    const int tid = opaque_tid(), wid = __builtin_amdgcn_readfirstlane((int)threadIdx.x >> 6), lane = tid & 63, wr = wid >> 2, wc = wid & 3, fr = lane & 15, fq = lane >> 4;
    const int K = g.K, nt = K / BK;
    unsigned voffA[2], voffB[2];
#pragma unroll
    for (int i = 0; i < 2; ++i) { int R, C; stage_rc(tid * 16 + i * 8192, R, C); const int Rb = Epi::PERM ? ((R & ~31) + perm32(R & 31)) : R;
        voffA[i] = (unsigned)(R * K + C) * 2u; voffB[i] = (unsigned)(Rb * K + C) * 2u; }
    const size_t kstep = (size_t)(BK * 2);
    const size_t hstep = (size_t)HALF * K * 2;
    const size_t tstep = 2 * hstep;
    const unsigned ldsw = (unsigned)wid * 1024u;
    const int aoff = lds_byte(wr * 64 + fr, fq * 8), boff = lds_byte(wc * 32 + fr, fq * 8);
#define PG8_SA(b, h) (((b) * 2 + (h)) * HTB)
#define PG8_SB(b, h) ((4 + (b) * 2 + (h)) * HTB)
#define PG8_STAGE(bufoff, gbase, voff) do { _Pragma("unroll") for (int _i = 0; _i < 2; ++_i) \
        __builtin_amdgcn_global_load_lds((const unsigned*)((const char*)(gbase) + (voff)[_i]), (PG8_LAS unsigned*)(lds + (bufoff) + ldsw + _i * 8192), 16, 0, 0); } while (0)
#define PG8_LDA(dst, b, h) do { _Pragma("unroll") for (int m = 0; m < 4; ++m) _Pragma("unroll") for (int k = 0; k < 2; ++k) dst[m][k] = *(const PG8_LAS bf16x8*)(lds + PG8_SA(b, h) + aoff + m * 2048 + k * 1024); } while (0)
#define PG8_LDB(dst, b, h) do { _Pragma("unroll") for (int n = 0; n < 2; ++n) _Pragma("unroll") for (int k = 0; k < 2; ++k) dst[n][k] = *(const PG8_LAS bf16x8*)(lds + PG8_SB(b, h) + boff + n * 2048 + k * 1024); } while (0)
#define PG8_MMA(ai, bj, At, Bt) do { __builtin_amdgcn_s_setprio(1); _Pragma("unroll") for (int m = 0; m < 4; ++m) _Pragma("unroll") for (int n = 0; n < 2; ++n) _Pragma("unroll") for (int k = 0; k < 2; ++k) \
        acc[ai][bj][m][n] = __builtin_amdgcn_mfma_f32_16x16x32_bf16(Bt[n][k], At[m][k], acc[ai][bj][m][n], 0, 0, 0); __builtin_amdgcn_s_setprio(0); } while (0)
#define PG8_WAIT_V(n) asm volatile("s_waitcnt vmcnt(" #n ")" ::: "memory")
#define PG8_WAIT_L(n) asm volatile("s_waitcnt lgkmcnt(" #n ")" ::: "memory")
#define PG8_BAR __builtin_amdgcn_s_barrier()
#define PG8_SCHED __builtin_amdgcn_sched_barrier(0)
    Unit cur, nxt; int ui = 0;
    if (!S.next(0, cur)) return;
    f32x4 acc[2][2][4][2];
#pragma unroll
    for (int a = 0; a < 2; ++a)
#pragma unroll
        for (int b = 0; b < 2; ++b)
#pragma unroll
            for (int m = 0; m < 4; ++m)
#pragma unroll
                for (int n = 0; n < 2; ++n) acc[a][b][m][n] = (f32x4){0.f, 0.f, 0.f, 0.f};
    bf16x8 At[4][2], B0[2][2], B1[2][2];
    const char* cA = (const char*)g.A + (size_t)cur.pm * tstep; const char* cB = (const char*)g.Bt + (size_t)cur.pn * tstep;
    S.a_ready(cur);
    if constexpr (SP2) {
        PG8_STAGE(PG8_SB(0, 0), cB, voffB); PG8_STAGE(PG8_SB(0, 1), cB + hstep, voffB); PG8_STAGE(PG8_SA(0, 0), cA, voffA); PG8_STAGE(PG8_SA(0, 1), cA + hstep, voffA);
        if (wr == 1) PG8_BAR;
        PG8_WAIT_V(2); PG8_BAR;
        PG8_STAGE(PG8_SB(1, 0), cB + kstep, voffB); PG8_STAGE(PG8_SA(1, 0), cA + kstep, voffA); PG8_STAGE(PG8_SB(1, 1), cB + hstep + kstep, voffB);
        PG8_WAIT_V(6); PG8_BAR;
    } else {
        PG8_STAGE(PG8_SB(0, 0), cB, voffB); PG8_STAGE(PG8_SA(0, 0), cA, voffA); PG8_STAGE(PG8_SB(0, 1), cB + hstep, voffB); PG8_STAGE(PG8_SA(0, 1), cA + hstep, voffA);
        if (wr == 1) PG8_BAR;
        PG8_WAIT_V(4); PG8_BAR;
        PG8_STAGE(PG8_SB(1, 0), cB + kstep, voffB); PG8_STAGE(PG8_SA(1, 0), cA + kstep, voffA); PG8_STAGE(PG8_SB(1, 1), cB + hstep + kstep, voffB);
        PG8_WAIT_V(6); PG8_BAR;
    }
    for (;;) {
        const bool has_next = S.next(ui + 1, nxt);
        const char* nA = has_next ? (const char*)g.A + (size_t)nxt.pm * tstep : cA; const char* nB = has_next ? (const char*)g.Bt + (size_t)nxt.pn * tstep : cB;
        for (int t = 0; t < nt; t += 2) {
            const bool last = (t == nt - 2);
            const char* a1 = cA + (size_t)(t + 1) * kstep;
            const char* a2 = last ? nA : cA + (size_t)(t + 2) * kstep; const char* b2 = last ? nB : cB + (size_t)(t + 2) * kstep;
            const char* a3 = a2 + kstep; const char* b3 = b2 + kstep;
            if (last && has_next) S.a_ready(nxt);
            if constexpr (SP2) {
            PG8_LDB(B0, 0, 0); PG8_LDB(B1, 0, 1); PG8_SCHED; PG8_LDA(At, 0, 0); PG8_STAGE(PG8_SA(1, 1), a1 + hstep, voffA);
            PG8_WAIT_V(8); PG8_WAIT_L(0); PG8_BAR; PG8_MMA(0, 0, At, B0); PG8_MMA(0, 1, At, B1); PG8_BAR; PG8_SCHED;
            PG8_LDA(At, 0, 1); PG8_STAGE(PG8_SB(0, 0), b2, voffB); PG8_STAGE(PG8_SB(0, 1), b2 + hstep, voffB); PG8_STAGE(PG8_SA(0, 0), a2, voffA);
            PG8_WAIT_V(8); PG8_WAIT_L(0); PG8_BAR; PG8_MMA(1, 0, At, B0); PG8_MMA(1, 1, At, B1); PG8_BAR; PG8_SCHED;
            PG8_LDB(B0, 1, 0); PG8_LDB(B1, 1, 1); PG8_SCHED; PG8_LDA(At, 1, 0); PG8_STAGE(PG8_SA(0, 1), a2 + hstep, voffA);
            PG8_WAIT_V(8); PG8_WAIT_L(0); PG8_BAR; PG8_MMA(0, 0, At, B0); PG8_MMA(0, 1, At, B1); PG8_BAR; PG8_SCHED;
            PG8_LDA(At, 1, 1); PG8_STAGE(PG8_SB(1, 0), b3, voffB); PG8_STAGE(PG8_SB(1, 1), b3 + hstep, voffB); PG8_STAGE(PG8_SA(1, 0), a3, voffA);
            PG8_WAIT_V(8); PG8_WAIT_L(0); PG8_BAR; PG8_MMA(1, 0, At, B0); PG8_MMA(1, 1, At, B1); PG8_BAR; PG8_SCHED;
            } else {
            PG8_LDB(B0, 0, 0); PG8_SCHED; PG8_LDA(At, 0, 0); PG8_STAGE(PG8_SA(1, 1), a1 + hstep, voffA);
            PG8_WAIT_L(8); PG8_BAR; PG8_WAIT_L(0); PG8_MMA(0, 0, At, B0); PG8_BAR; PG8_SCHED;
            PG8_LDB(B1, 0, 1); PG8_STAGE(PG8_SB(0, 0), b2, voffB);
            PG8_BAR; PG8_WAIT_L(0); PG8_MMA(0, 1, At, B1); PG8_BAR;
            PG8_LDA(At, 0, 1); PG8_STAGE(PG8_SA(0, 0), a2, voffA);
            PG8_BAR; PG8_WAIT_L(0); PG8_MMA(1, 0, At, B0); PG8_BAR; PG8_SCHED;
            PG8_STAGE(PG8_SB(0, 1), b2 + hstep, voffB);
            PG8_WAIT_V(6); PG8_BAR; PG8_MMA(1, 1, At, B1); PG8_BAR;
            PG8_LDB(B0, 1, 0); PG8_SCHED; PG8_LDA(At, 1, 0); PG8_STAGE(PG8_SA(0, 1), a2 + hstep, voffA);
            PG8_WAIT_L(8); PG8_BAR; PG8_WAIT_L(0); PG8_MMA(0, 0, At, B0); PG8_BAR; PG8_SCHED;
            PG8_LDB(B1, 1, 1); PG8_STAGE(PG8_SB(1, 0), b3, voffB);
            PG8_BAR; PG8_WAIT_L(0); PG8_MMA(0, 1, At, B1); PG8_BAR;
            PG8_LDA(At, 1, 1); PG8_STAGE(PG8_SA(1, 0), a3, voffA);
            PG8_BAR; PG8_WAIT_L(0); PG8_MMA(1, 0, At, B0); PG8_BAR; PG8_SCHED;
            PG8_STAGE(PG8_SB(1, 1), b3 + hstep, voffB);
            PG8_WAIT_V(6); PG8_BAR; PG8_MMA(1, 1, At, B1); PG8_BAR;
            }
        }
        if constexpr (ALIGN_EPI) { if (wr == 0) PG8_BAR; }
        E(acc, cur, wr, wc, fr, fq); S.done(cur);
        if (!has_next) break;
#pragma unroll
        for (int a = 0; a < 2; ++a)
#pragma unroll
            for (int b = 0; b < 2; ++b)
#pragma unroll
                for (int m = 0; m < 4; ++m)
#pragma unroll
                    for (int n = 0; n < 2; ++n) acc[a][b][m][n] = (f32x4){0.f, 0.f, 0.f, 0.f};
        cur = nxt; cA = nA; cB = nB; ++ui;
        if constexpr (ALIGN_EPI) { if (wr == 1) PG8_BAR; }
    }
    PG8_WAIT_V(0);
    if constexpr (!ALIGN_EPI) { if (wr == 0) PG8_BAR; }
    PG8_BAR;
#undef PG8_SA
#undef PG8_SB
#undef PG8_STAGE
#undef PG8_LDA
#undef PG8_LDB
#undef PG8_MMA
#undef PG8_WAIT_V
#undef PG8_WAIT_L
#undef PG8_BAR
#undef PG8_SCHED
}
}

using pg8::bf16_t; using pg8::bf16x8; using pg8::f32x4;

constexpr int MT = 24576, DM = 1024, DFF = 2816, NCTX = 8192;
constexpr int UW = 3984;
constexpr int NCOND = 9, MODW = 9216;
constexpr size_t MiB = 1ull << 20;
constexpr size_t WS_A = 0, WS_U = 48 * MiB, WS_W1 = WS_U + 132 * MiB, WS_W1B = WS_W1 + (size_t)5632 * 1024 * 2,
                 WS_BT3 = 235 * MiB, WS_HB2 = 235 * MiB  ,
                 WS_BT4 = 251 * MiB, WS_MOD = 253 * MiB, WS_CTR = WS_MOD + 9 * 9216 * 4  , WS_BAR = WS_CTR + 256  , WS_GATES = 254 * MiB;
constexpr size_t WS_A2BF = 255 * MiB + 512 * 1024, WS_G2BF = WS_A2BF + 2 * 512 * 64 * 2;
constexpr int OUT_C = 25165824, OUT_N = 29360128, OUT_MM = 29392896, OUT_S = 29393152;
constexpr int LDS_BYTES = 163840;
constexpr int NTHR = 512;

struct P {
    const float *xp, *xs, *c, *sC, *sn, *sm, *sS, *cctx, *ada_w, *ada_b, *n1, *w1in, *w1out, *nmix, *wmin, *wmout,
        *cw, *cb, *gb, *hg, *mu, *w0, *w2, *a0, *a2, *g2, *kk, *ka, *rk, *lng, *lnb, *n2, *w2in, *w2out, *nf;
    float* out; unsigned char* ws;
};

__device__ __forceinline__ unsigned short f2bf(float f) { unsigned u = __float_as_uint(f); u += 0x7FFFu + ((u >> 16) & 1u); return (unsigned short)(u >> 16); }
__device__ __forceinline__ float bf2f(unsigned short b) { return __uint_as_float(((unsigned)b) << 16); }
__device__ __forceinline__ unsigned pk2(float a, float b) { return (unsigned)f2bf(a) | ((unsigned)f2bf(b) << 16); }
__device__ __forceinline__ int cond_of(int row) { return row < NCTX ? 0 : 1 + ((row - NCTX) >> 11); }
__device__ __forceinline__ float fexp(float x) { return __builtin_amdgcn_exp2f(x * 1.4426950408889634f); }
__device__ __forceinline__ float flog(float x) { return __builtin_amdgcn_logf(x) * 0.6931471805599453f; }
__device__ __forceinline__ float siluf(float x) { return x * __builtin_amdgcn_rcpf(1.f + fexp(-x)); }
__device__ __forceinline__ float sigmf(float x) { return __builtin_amdgcn_rcpf(1.f + fexp(-x)); }
__device__ __forceinline__ float tanh_fast(float x) { return 1.f - 2.f * __builtin_amdgcn_rcpf(1.f + fexp(2.f * x)); }
__device__ __forceinline__ float softplus_fast(float z) { return fmaxf(z, 0.f) + flog(1.f + fexp(-fabsf(z))); }
__device__ __forceinline__ const float* xrow(const P& p, int row) { return row < NCTX ? p.xp + (size_t)row * DM : p.xs + (size_t)(row - NCTX) * DM; }
__device__ __forceinline__ f32x4 mfma16(bf16x8 a, bf16x8 b, f32x4 c) { return __builtin_amdgcn_mfma_f32_16x16x32_bf16(a, b, c, 0, 0, 0); }
__device__ __forceinline__ void unpack8(uint4 v, float* f) {
    f[0] = __uint_as_float(v.x << 16); f[1] = __uint_as_float(v.x & 0xffff0000u); f[2] = __uint_as_float(v.y << 16); f[3] = __uint_as_float(v.y & 0xffff0000u);
    f[4] = __uint_as_float(v.z << 16); f[5] = __uint_as_float(v.z & 0xffff0000u); f[6] = __uint_as_float(v.w << 16); f[7] = __uint_as_float(v.w & 0xffff0000u);
}

__device__ __forceinline__ int colmap(int kind, int n) {
    if (kind == 0) return n;
    if (kind == 1) { const int t = n >> 8, bj = (n >> 7) & 1, c = n & 127; return bj * DFF + t * 128 + c; }
    if (n < 2048) return n; if (n < 3968) return n + 16; if (n < 3984) return n - 3968 + 2048; return -1;
}
__device__ void convert_tile(const float* __restrict__ src, bf16_t* __restrict__ dst, int K, int Nsrc, int kind, int k0, int n0, float* tile) {
    const int tid = opaque_tid();
    { const int n = tid & 63, kr = tid >> 6; const int sc = colmap(kind, n0 + n);
#pragma unroll
      for (int i = 0; i < 8; ++i) { const int k = kr + 8 * i; tile[k * 65 + n] = sc >= 0 ? src[(size_t)(k0 + k) * Nsrc + sc] : 0.f; } }
    __syncthreads();
    { const int nn = tid >> 3, kg = tid & 7; unsigned w[4];
#pragma unroll
      for (int j = 0; j < 4; ++j) w[j] = pk2(tile[(kg * 8 + 2 * j) * 65 + nn], tile[(kg * 8 + 2 * j + 1) * 65 + nn]);
      *(uint4*)(dst + (size_t)(n0 + nn) * K + k0 + kg * 8) = make_uint4(w[0], w[1], w[2], w[3]); }
    __syncthreads();
}
__device__ void convert_jobs(const P& p, int first, int njobs_sel, unsigned char* lds, int item0, int nitems_before) {}

__device__ void do_convert(const float* src, bf16_t* dst, int K, int Nsrc, int Ndst, int kind, int t, float* tile) {
    const int nkt = K / 64; const int kt = t % nkt, ntile = t / nkt; (void)Ndst;
    convert_tile(src, dst, K, Nsrc, kind, kt * 64, ntile * 64, tile);
}

__device__ void phase0(const P& p, unsigned char* lds) {
    float* tile = (float*)lds;
    const int tid = opaque_tid();
    const int n_ada = 36 * 8;
    const int t1 = 16 * 88, t2 = 44 * 16, t3 = 16 * 64, t4 = 16 * 16, t5 = 8, t6 = 8, t7 = 16;
    const int total = n_ada + t1 + t2 + t3 + t4 + t5 + t6 + t7;
    for (int it = blockIdx.x; it < total; it += gridDim.x) {
        if (it < n_ada) {
            const int cgp = it % 36, kc = it / 36;
            float* sc = tile;
            __syncthreads();
            for (int i = tid; i < NCOND * 128; i += NTHR) { const int c = i >> 7, k = i & 127; const float v = c == 0 ? p.cctx[kc * 128 + k] : p.c[(c - 1) * DM + kc * 128 + k]; sc[i] = siluf(v); }
            __syncthreads();
            const int col = cgp * 256 + (tid & 255), kh = tid >> 8;
            float acc[NCOND];
#pragma unroll
            for (int c = 0; c < NCOND; ++c) acc[c] = 0.f;
            const float* w = p.ada_w + (size_t)(kc * 128 + kh * 64) * MODW + col;
#pragma unroll 4
            for (int k = 0; k < 64; ++k) { const float wv = w[(size_t)k * MODW];
#pragma unroll
                for (int c = 0; c < NCOND; ++c) acc[c] += sc[c * 128 + kh * 64 + k] * wv; }
            float* mod = (float*)(p.ws + WS_MOD);
            const float bias = (kc == 0 && kh == 0) ? p.ada_b[col] : 0.f;
#pragma unroll
            for (int c = 0; c < NCOND; ++c) atomicAdd(mod + c * MODW + col, acc[c] + bias);
            __syncthreads();
        } else {
            int t = it - n_ada;
            if (t < t1) do_convert(p.w1in, (bf16_t*)(p.ws + WS_W1), 1024, 5632, 5632, 1, t, tile);
            else if ((t -= t1) < t2) do_convert(p.w1out, (bf16_t*)(p.ws + WS_W1B), 2816, 1024, 1024, 0, t, tile);
            else if ((t -= t2) < t3) do_convert(p.wmin, (bf16_t*)(p.ws + WS_BT3), 1024, 3984, 4096, 2, t, tile);
            else if ((t -= t3) < t4) do_convert(p.wmout, (bf16_t*)(p.ws + WS_BT4), 1024, 1024, 1024, 0, t, tile);
            else if ((t -= t4) < t5) do_convert(p.a2, (bf16_t*)(p.ws + WS_A2BF), 64, 512, 512, 0, t, tile);
            else if ((t -= t5) < t6) do_convert(p.a2 + 64 * 512, (bf16_t*)(p.ws + WS_A2BF) + 512 * 64, 64, 512, 512, 0, t, tile);
            else { t -= t6; do_convert(p.g2, (bf16_t*)(p.ws + WS_G2BF), 128, 512, 512, 0, t, tile); }
        }
    }
}

__device__ void phase_normmod(const P& p, int which) {
    const int lane = opaque_tid() & 63, wave = threadIdx.x >> 6;
    const float* gain = which == 0 ? p.n1 : (which == 1 ? p.nmix : p.n2);
    const float* mod = (const float*)(p.ws + WS_MOD);
    bf16_t* A = (bf16_t*)(p.ws + WS_A);
    for (int row = blockIdx.x * 8 + wave; row < MT; row += gridDim.x * 8) {
        const float* src = which == 0 ? xrow(p, row) : p.out + (size_t)row * DM;
        float4 v[4]; float ss = 0.f;
#pragma unroll
        for (int i = 0; i < 4; ++i) { v[i] = *(const float4*)(src + lane * 4 + 256 * i); ss += v[i].x * v[i].x + v[i].y * v[i].y + v[i].z * v[i].z + v[i].w * v[i].w; }
#pragma unroll
        for (int o = 32; o >= 1; o >>= 1) ss += __shfl_xor(ss, o);
        const float rstd = rsqrtf(ss * (1.f / 1024.f) + 1e-6f);
        const float* sh = mod + cond_of(row) * MODW + which * 3072; const float* sc = sh + 1024;
#pragma unroll
        for (int i = 0; i < 4; ++i) { const int col = lane * 4 + 256 * i;
            const float4 g = *(const float4*)(gain + col), s4 = *(const float4*)(sh + col), c4 = *(const float4*)(sc + col);
            const float o0 = v[i].x * rstd * g.x * (1.f + c4.x) + s4.x, o1 = v[i].y * rstd * g.y * (1.f + c4.y) + s4.y,
                        o2 = v[i].z * rstd * g.z * (1.f + c4.z) + s4.z, o3 = v[i].w * rstd * g.w * (1.f + c4.w) + s4.w;
            *(uint2*)(A + (size_t)row * DM + col) = make_uint2(pk2(o0, o1), pk2(o2, o3)); }
    }
}
__device__ void phase_finalnorm(const P& p) {
    const int lane = opaque_tid() & 63, wave = threadIdx.x >> 6;
    for (int row = blockIdx.x * 8 + wave; row < MT; row += gridDim.x * 8) {
        float* src = p.out + (size_t)row * DM;
        float4 v[4]; float ss = 0.f;
#pragma unroll
        for (int i = 0; i < 4; ++i) { v[i] = *(const float4*)(src + lane * 4 + 256 * i); ss += v[i].x * v[i].x + v[i].y * v[i].y + v[i].z * v[i].z + v[i].w * v[i].w; }
#pragma unroll
        for (int o = 32; o >= 1; o >>= 1) ss += __shfl_xor(ss, o);
        const float rstd = rsqrtf(ss * (1.f / 1024.f) + 1e-6f);
#pragma unroll
        for (int i = 0; i < 4; ++i) { const int col = lane * 4 + 256 * i; const float4 g = *(const float4*)(p.nf + col);
            *(float4*)(src + col) = make_float4(v[i].x * rstd * g.x, v[i].y * rstd * g.y, v[i].z * rstd * g.z, v[i].w * rstd * g.w); }
    }
}

struct EpiSwiglu {
    static constexpr bool PERM = true;
    bf16_t* O;
    __device__ __forceinline__ void operator()(const f32x4 (&acc)[2][2][4][2], const pg8::Unit& u, int wr, int wc, int fr, int fq) const {
        const int row0 = u.pm * 256 + wr * 64 + fr, col0 = u.pn * 128 + wc * 32 + 8 * fq;
#pragma unroll
        for (int ai = 0; ai < 2; ++ai)
#pragma unroll
            for (int m = 0; m < 4; ++m) { bf16_t* rowp = O + (size_t)(row0 + ai * 128 + m * 16) * DFF + col0;
                float r[8];
#pragma unroll
                for (int n = 0; n < 2; ++n)
#pragma unroll
                    for (int j = 0; j < 4; ++j) r[n * 4 + j] = siluf(acc[ai][0][m][n][j]) * acc[ai][1][m][n][j];
                pg8::u32x4 w; w.x = pg8::cvt_pk_bf16(r[0], r[1]); w.y = pg8::cvt_pk_bf16(r[2], r[3]); w.z = pg8::cvt_pk_bf16(r[4], r[5]); w.w = pg8::cvt_pk_bf16(r[6], r[7]);
                *(pg8::u32x4*)rowp = w; }
    }
};
struct EpiResid {
    static constexpr bool PERM = false;
    const float* xp; const float* xs; float* out; const float* ga; float coef; int inplace;
    __device__ __forceinline__ void operator()(const f32x4 (&acc)[2][2][4][2], const pg8::Unit& u, int wr, int wc, int fr, int fq) const {
        const int row0 = u.pm * 256 + wr * 64 + fr, col0 = u.pn * 256 + wc * 32 + 4 * fq;
        const float* gap = ga + cond_of(u.pm * 256) * MODW;
        f32x4 gv[2][2];
#pragma unroll
        for (int bj = 0; bj < 2; ++bj)
#pragma unroll
            for (int n = 0; n < 2; ++n) gv[bj][n] = *(const f32x4*)(gap + col0 + bj * 128 + n * 16) * coef;
#pragma unroll
        for (int ai = 0; ai < 2; ++ai)
#pragma unroll
            for (int m = 0; m < 4; ++m) { const int row = row0 + ai * 128 + m * 16;
                const float* base = inplace ? out + (size_t)row * DM : (row < NCTX ? xp + (size_t)row * DM : xs + (size_t)(row - NCTX) * DM);
                float* op = out + (size_t)row * DM;
#pragma unroll
                for (int bj = 0; bj < 2; ++bj)
#pragma unroll
                    for (int n = 0; n < 2; ++n) { const int c = col0 + bj * 128 + n * 16; const f32x4 b4 = *(const f32x4*)(base + c);
                        *(f32x4*)(op + c) = b4 + gv[bj][n] * acc[ai][bj][m][n]; } }
    }
};
struct EpiU {
    static constexpr bool PERM = true;
    bf16_t* U; float* gates;
    __device__ __forceinline__ void operator()(const f32x4 (&acc)[2][2][4][2], const pg8::Unit& u, int wr, int wc, int fr, int fq) const {
        const int row0 = u.pm * 256 + wr * 64 + fr;
#pragma unroll
        for (int bj = 0; bj < 2; ++bj) { const int col0 = u.pn * 256 + bj * 128 + wc * 32 + 8 * fq;
            if (col0 < UW) {
#pragma unroll
                for (int ai = 0; ai < 2; ++ai)
#pragma unroll
                    for (int m = 0; m < 4; ++m) { const int row = row0 + ai * 128 + m * 16; const f32x4 v0 = acc[ai][bj][m][0], v1 = acc[ai][bj][m][1];
                        pg8::u32x4 w; w.x = pg8::cvt_pk_bf16(v0[0], v0[1]); w.y = pg8::cvt_pk_bf16(v0[2], v0[3]); w.z = pg8::cvt_pk_bf16(v1[0], v1[1]); w.w = pg8::cvt_pk_bf16(v1[2], v1[3]);
                        *(pg8::u32x4*)(U + (size_t)row * UW + col0) = w;
                        if (col0 >= 3968) { float* gp = gates + (size_t)row * 16 + (col0 - 3968); *(f32x4*)gp = v0; *(f32x4*)(gp + 4) = v1; } } } }
    }
};

template <class Epi>
__device__ __forceinline__ void run_gemm(unsigned char* lds, const bf16_t* A, const bf16_t* Bt, int N, int K, const Epi& E) {
    pg8::Gemm g{A, Bt, MT, N, K}; pg8::StaticOrder S; S.init(MT, N, (int)gridDim.x, (int)blockIdx.x);
    pg8::gemm_phase<Epi, pg8::StaticOrder, true, true>((PG8_LAS unsigned char*)lds, g, S, E);
}

constexpr int ML_SK = 0, ML_KWT = 17408, ML_VT = ML_KWT + 18432, ML_CB = ML_VT + 20736, ML_F = ML_CB + 21760, ML_CW = ML_F + 2048, ML_END = ML_CW + 4096;
static_assert(ML_END <= LDS_BYTES, "mlstm lds");

__device__ __forceinline__ unsigned short ld_u16_agent(const bf16_t* p) { return __hip_atomic_load(p, __ATOMIC_RELAXED, __HIP_MEMORY_SCOPE_AGENT); }

__device__ __forceinline__ void conv3_row8(const bf16_t* up, bool hasp, bool hasn, const float* cwp, float* x) {
    float t[8];
    unpack8(*(const uint4*)up, t);
#pragma unroll
    for (int i = 0; i < 8; ++i) x[i] = cwp[768 + i] + cwp[256 + i] * t[i];
    if (hasp) { unpack8(*(const uint4*)(up - UW), t);
#pragma unroll
        for (int i = 0; i < 8; ++i) x[i] += cwp[i] * t[i]; }
    if (hasn) { unpack8(*(const uint4*)(up + UW), t);
#pragma unroll
        for (int i = 0; i < 8; ++i) x[i] += cwp[512 + i] * t[i]; }
}

__device__ __forceinline__ void mlstm_task(const P& p, unsigned char* lds, int bg, int h, int dsel) {
    const int wv = __builtin_amdgcn_readfirstlane((int)threadIdx.x >> 6), rw = wv & 3, cw = wv >> 2;
    const bool ctx = bg < 32; const int T = ctx ? 256 : 2048, nc = T / 64; const int row0 = ctx ? bg * 256 : NCTX + (bg - 32) * 2048;
    bf16_t* sK = (bf16_t*)(lds + ML_SK); bf16_t* sKwT = (bf16_t*)(lds + ML_KWT); bf16_t* sVT = (bf16_t*)(lds + ML_VT); bf16_t* sCb = (bf16_t*)(lds + ML_CB); bf16_t* sS = sCb;
    float* sA = (float*)(lds + ML_F); float* sM = sA + 64; float* sBb = sM + 64; float* sDen = sBb + 64; float* sScal = sDen + 64; float* sRed = sScal + 16;
    float* sCW = (float*)(lds + ML_CW);
    const bf16_t* U = (const bf16_t*)(p.ws + WS_U); const float* GATES = (const float*)(p.ws + WS_GATES); bf16_t* HB = (bf16_t*)(p.ws + WS_A); bf16_t* HB2 = (bf16_t*)(p.ws + WS_HB2);
    const int d_lo = dsel < 0 ? 0 : dsel, d_hi = dsel < 0 ? 2 : dsel + 1;
    const int ct_a = cw ? 3 : 0;
    const int ct_b = cw ? 7 : 5;
    const int n_a = cw ? 2 : 3;

    __syncthreads();
    { const int tid = threadIdx.x;
      for (int i = tid; i < 1024; i += NTHR) { const int a = i >> 8, cc = i & 255, gch = (cc >> 7) * 512 + h * 128 + (cc & 127); sCW[i] = a < 3 ? p.cw[a * 1024 + gch] : p.cb[gch]; }
      for (int i = tid; i < 16 * 72; i += NTHR) { const int r = 128 + i / 72; sVT[r * 72 + (i % 72)] = (r == 128) ? (bf16_t)0x3F80 : (bf16_t)0; } }

#pragma unroll 1
    for (int dir = d_lo; dir < d_hi; ++dir) {
        f32x4 Cacc[9]; float m_prev = 0.f;
        { int z0 = 0; asm volatile("" : "+v"(z0)); const int tid = (int)threadIdx.x + z0, fr = tid & 15, fq = (tid >> 4) & 3;
#pragma unroll
          for (int ct = 0; ct < 9; ++ct) Cacc[ct] = (f32x4){0.f, 0.f, 0.f, 0.f};
          if (!ctx) { const int sidx = ((bg - 32) * 2 + dir) * 4 + h; const float* C0 = p.sC + (size_t)sidx * 16384; const float* n0 = p.sn + (size_t)sidx * 128;
#pragma unroll
              for (int j = 0; j < 4; ++j) { const int d = 16 * wv + 4 * fq + j;
#pragma unroll
                  for (int ct = 0; ct < 8; ++ct) Cacc[ct][j] = C0[d * 128 + 16 * ct + fr];
                  Cacc[8][j] = fr == 0 ? n0[d] : 0.f; }
              m_prev = p.sm[sidx]; } }
        const float gbi = p.gb[dir * 4 + h], gbf = p.gb[8 + dir * 4 + h];
        const bool second = dsel < 0 && dir == 1;
#pragma unroll 1
        for (int s = 0; s < nc; ++s) {
            const int c = dir ? nc - 1 - s : s;
            int zz = 0; asm volatile("" : "+v"(zz));
            const int tid = (int)threadIdx.x + zz, lane = tid & 63, fr = tid & 15, fq = (tid >> 4) & 3;
            uint4 kc[2], kp[2], kn[2], vv[2];
#pragma unroll
            for (int g = 0; g < 2; ++g) { const int idx = tid + 512 * g, sl = idx >> 4, d0 = (idx & 15) * 8; const int tl = dir ? 63 - sl : sl, tok = c * 64 + tl;
                const bf16_t* up = U + ((size_t)row0 + tok) * UW + 512 + h * 128 + d0;
                kc[g] = *(const uint4*)up; kp[g] = make_uint4(0u, 0u, 0u, 0u); kn[g] = kp[g];
                if (tok > 0) kp[g] = *(const uint4*)(up - UW);
                if (tok < T - 1) kn[g] = *(const uint4*)(up + UW);
                vv[g] = *(const uint4*)(up + 512); }
            LDS_BARRIER();
            if (wv == 0) {
                const int tl = dir ? 63 - lane : lane; const size_t row = (size_t)row0 + c * 64 + tl;
                const float ip = GATES[row * 16 + dir * 4 + h] + gbi, fp = GATES[row * 16 + 8 + dir * 4 + h] + gbf;
                const float lf = -softplus_fast(-fp);
                float bs = lf;
#pragma unroll
                for (int o = 1; o < 64; o <<= 1) { const float t = __shfl_up(bs, o); if (lane >= o) bs += t; }
                const float a = ip - bs; float pm = a;
#pragma unroll
                for (int o = 1; o < 64; o <<= 1) { const float t = __shfl_up(pm, o); if (lane >= o) pm = fmaxf(pm, t); }
                const float Mt = fmaxf(m_prev, pm);
                sA[lane] = a; sM[lane] = Mt; sBb[lane] = bs;
                if (lane == 63) { sScal[0] = Mt; sScal[1] = bs; }
            }
            LDS_BARRIER();
            const float M63 = sScal[0], bL = sScal[1];
            uint4 qc[4], qp[4], qn[4];
            { const int t_ = 16 * rw + fr, tl = dir ? 63 - t_ : t_, tok = c * 64 + tl; const bf16_t* up = U + ((size_t)row0 + tok) * UW + h * 128 + 8 * fq;
#pragma unroll
              for (int kk = 0; kk < 4; ++kk) { qc[kk] = *(const uint4*)(up + 32 * kk); qp[kk] = make_uint4(0u, 0u, 0u, 0u); qn[kk] = qp[kk];
                  if (tok > 0) qp[kk] = *(const uint4*)(up + 32 * kk - UW);
                  if (tok < T - 1) qn[kk] = *(const uint4*)(up + 32 * kk + UW); } }
#pragma unroll
            for (int g = 0; g < 2; ++g) {
                const int idx = tid + 512 * g, sl = idx >> 4, d0 = (idx & 15) * 8;
                const float wk = fexp(sA[sl] - M63);
                const float* cwp = sCW + 128 + d0;
                float kv[8], t[8];
                unpack8(kc[g], t);
#pragma unroll
                for (int i = 0; i < 8; ++i) kv[i] = cwp[768 + i] + cwp[256 + i] * t[i];
                unpack8(kp[g], t);
#pragma unroll
                for (int i = 0; i < 8; ++i) kv[i] += cwp[i] * t[i];
                unpack8(kn[g], t);
#pragma unroll
                for (int i = 0; i < 8; ++i) kv[i] += cwp[512 + i] * t[i];
#pragma unroll
                for (int i = 0; i < 8; ++i) kv[i] = siluf(kv[i]) * 0.08838834764831845f;
                *(uint4*)(sK + sl * 136 + d0) = make_uint4(pk2(kv[0], kv[1]), pk2(kv[2], kv[3]), pk2(kv[4], kv[5]), pk2(kv[6], kv[7]));
#pragma unroll
                for (int i = 0; i < 8; ++i) sKwT[(d0 + i) * 72 + sl] = f2bf(kv[i] * wk);
                const unsigned vw[4] = {vv[g].x, vv[g].y, vv[g].z, vv[g].w};
#pragma unroll
                for (int i = 0; i < 8; ++i) sVT[(d0 + i) * 72 + sl] = (bf16_t)((vw[i >> 1] >> ((i & 1) * 16)) & 0xffffu);
            }
            bf16x8 qf[4];
#pragma unroll
            for (int kk = 0; kk < 4; ++kk) { const float* cwp = sCW + 32 * kk + 8 * fq; float qv[8], t[8];
                unpack8(qc[kk], t);
#pragma unroll
                for (int i = 0; i < 8; ++i) qv[i] = cwp[768 + i] + cwp[256 + i] * t[i];
                unpack8(qp[kk], t);
#pragma unroll
                for (int i = 0; i < 8; ++i) qv[i] += cwp[i] * t[i];
                unpack8(qn[kk], t);
#pragma unroll
                for (int i = 0; i < 8; ++i) qv[i] += cwp[512 + i] * t[i];
#pragma unroll
                for (int i = 0; i < 8; ++i) qv[i] = siluf(qv[i]);
                union { uint4 u; bf16x8 v; } cv; cv.u = make_uint4(pk2(qv[0], qv[1]), pk2(qv[2], qv[3]), pk2(qv[4], qv[5]), pk2(qv[6], qv[7])); qf[kk] = cv.v; }
            f32x4 num[5];
#pragma unroll
            for (int k = 0; k < 5; ++k) num[k] = (f32x4){0.f, 0.f, 0.f, 0.f};
#pragma unroll
            for (int ci = 0; ci < 5; ++ci) { const f32x4 v = Cacc[ci]; *(uint2*)(sCb + (16 * ci + fr) * 136 + 16 * wv + 4 * fq) = make_uint2(pk2(v[0], v[1]), pk2(v[2], v[3])); }
            LDS_BARRIER();
#pragma unroll
            for (int k = 0; k < 3; ++k) if (k < n_a) {
#pragma unroll
                for (int kk = 0; kk < 4; ++kk) { const bf16x8 b = *(const bf16x8*)(sCb + (16 * (ct_a + k) + fr) * 136 + 32 * kk + 8 * fq); num[k] = mfma16(qf[kk], b, num[k]); } }
            LDS_BARRIER();
#pragma unroll
            for (int ci = 0; ci < 4; ++ci) { const f32x4 v = Cacc[5 + ci]; *(uint2*)(sCb + (16 * ci + fr) * 136 + 16 * wv + 4 * fq) = make_uint2(pk2(v[0], v[1]), pk2(v[2], v[3])); }
            LDS_BARRIER();
#pragma unroll
            for (int k = 3; k < 5; ++k) {
#pragma unroll
                for (int kk = 0; kk < 4; ++kk) { const bf16x8 b = *(const bf16x8*)(sCb + (16 * (ct_b + k - 3 - 5) + fr) * 136 + 32 * kk + 8 * fq); num[k] = mfma16(qf[kk], b, num[k]); } }
            {
                float scv[4];
#pragma unroll
                for (int j = 0; j < 4; ++j) scv[j] = fexp(m_prev - sM[16 * rw + 4 * fq + j]);
#pragma unroll
                for (int k = 0; k < 5; ++k)
#pragma unroll
                    for (int j = 0; j < 4; ++j) num[k][j] *= scv[j];
            }
            LDS_BARRIER();
#pragma unroll
            for (int si = 0; si < 2; ++si) { const int st = 2 * cw + si;
                f32x4 sacc = (f32x4){0.f, 0.f, 0.f, 0.f};
                if (st <= rw) {
#pragma unroll
                    for (int kk = 0; kk < 4; ++kk) { const bf16x8 b = *(const bf16x8*)(sK + (16 * st + fr) * 136 + 32 * kk + 8 * fq); sacc = mfma16(qf[kk], b, sacc); } }
                const int sp = 16 * st + fr; const float as = sA[sp];
#pragma unroll
                for (int j = 0; j < 4; ++j) { const int tp = 16 * rw + 4 * fq + j; const float val = (sp <= tp) ? sacc[j] * fexp(as - sM[tp]) : 0.f; sS[tp * 72 + sp] = f2bf(val); }
            }
            LDS_BARRIER();
#pragma unroll
            for (int ks = 0; ks < 2; ++ks) { const bf16x8 a = *(const bf16x8*)(sS + (16 * rw + fr) * 72 + 32 * ks + 8 * fq);
#pragma unroll
                for (int k = 0; k < 5; ++k) { const int ct = k < 3 ? ct_a + k : ct_b + k - 3;
                    if (k != 2 || cw == 0) { const bf16x8 b = *(const bf16x8*)(sVT + (16 * ct + fr) * 72 + 32 * ks + 8 * fq); num[k] = mfma16(a, b, num[k]); } } }
            if (cw == 1 && fr == 0) {
#pragma unroll
                for (int j = 0; j < 4; ++j) sDen[16 * rw + 4 * fq + j] = num[4][j]; }
            LDS_BARRIER();
            float inv[4];
#pragma unroll
            for (int j = 0; j < 4; ++j) { const int tp = 16 * rw + 4 * fq + j; const float den = sDen[tp]; inv[j] = __builtin_amdgcn_rcpf(fmaxf(fabsf(den), fexp(-(sBb[tp] + sM[tp])))); }
            if (!second) {
#pragma unroll
                for (int j = 0; j < 4; ++j) { const int tp = 16 * rw + 4 * fq + j, tl = dir ? 63 - tp : tp; const size_t row = (size_t)row0 + c * 64 + tl;
                    bf16_t* hb = dsel == 1 ? HB2 + (row - NCTX) * 512 + h * 128 : HB + row * DM + h * 128;
#pragma unroll
                    for (int k = 0; k < 5; ++k) { const int ct = k < 3 ? ct_a + k : ct_b + k - 3; if ((k != 2 || cw == 0) && ct < 8) hb[16 * ct + fr] = f2bf(num[k][j] * inv[j]); } }
            } else {
                float ssr[4];
#pragma unroll
                for (int j = 0; j < 4; ++j) { const int tp = 16 * rw + 4 * fq + j, tl = dir ? 63 - tp : tp; const size_t row = (size_t)row0 + c * 64 + tl;
                    const bf16_t* hb = HB + row * DM + h * 128; float ss = 0.f;
#pragma unroll
                    for (int k = 0; k < 5; ++k) { const int ct = k < 3 ? ct_a + k : ct_b + k - 3;
                        if ((k != 2 || cw == 0) && ct < 8) { const int e = 16 * ct + fr; const float other = bf2f(ld_u16_agent(hb + e)); const float hs = num[k][j] * inv[j] + other;
                            const float o = sigmf(bf2f(U[row * UW + 1536 + h * 128 + e])); const float v = o * hs; ss += v * v; num[k][j] = v; } }
                    ss += __shfl_xor(ss, 1); ss += __shfl_xor(ss, 2); ss += __shfl_xor(ss, 4); ss += __shfl_xor(ss, 8);
                    ssr[j] = ss; if (fr == 0) sRed[cw * 64 + tp] = ss; }
                LDS_BARRIER();
#pragma unroll
                for (int j = 0; j < 4; ++j) { const int tp = 16 * rw + 4 * fq + j, tl = dir ? 63 - tp : tp; const size_t row = (size_t)row0 + c * 64 + tl;
                    bf16_t* hb = HB + row * DM + h * 128; const float rms = rsqrtf((ssr[j] + sRed[(1 - cw) * 64 + tp]) * (1.f / 128.f) + 1e-6f);
#pragma unroll
                    for (int k = 0; k < 5; ++k) { const int ct = k < 3 ? ct_a + k : ct_b + k - 3;
                        if ((k != 2 || cw == 0) && ct < 8) { const int e = 16 * ct + fr; hb[e] = f2bf(num[k][j] * rms * p.hg[h * 128 + e]); } } }
            }
            const float decay = fexp(m_prev - M63);
#pragma unroll
            for (int ct = 0; ct < 9; ++ct) Cacc[ct] = Cacc[ct] * decay;
#pragma unroll
            for (int ks = 0; ks < 2; ++ks) { const bf16x8 a = *(const bf16x8*)(sKwT + (16 * wv + fr) * 72 + 32 * ks + 8 * fq);
#pragma unroll
                for (int ct = 0; ct < 9; ++ct) { const bf16x8 b = *(const bf16x8*)(sVT + (16 * ct + fr) * 72 + 32 * ks + 8 * fq); Cacc[ct] = mfma16(a, b, Cacc[ct]); } }
            m_prev = bL + M63;
        }
        if (ctx) { const int sidx = (bg * 2 + dir) * 4 + h; float* Co = p.out + OUT_C + (size_t)sidx * 16384;
            int z1 = 0; asm volatile("" : "+v"(z1)); const int tid1 = (int)threadIdx.x + z1, fr1 = tid1 & 15, fq1 = (tid1 >> 4) & 3;
#pragma unroll
            for (int j = 0; j < 4; ++j) { const int d = 16 * wv + 4 * fq1 + j;
#pragma unroll
                for (int ct = 0; ct < 8; ++ct) Co[d * 128 + 16 * ct + fr1] = Cacc[ct][j];
                if (fr1 == 0) p.out[OUT_N + sidx * 128 + d] = Cacc[8][j]; }
            if (tid1 == 0) p.out[OUT_MM + sidx] = m_prev; }
        __syncthreads();
    }
}

__device__ __forceinline__ void phase_shift(bf16_t* U, const float* pmu, uint4* sRow) {
#pragma unroll 1
    for (int item = blockIdx.x; item < 1200; item += gridDim.x) {
        const int tid = opaque_tid(), tl = tid >> 3, g = tid & 7;
        const bool grid = item < 240; const int seq = grid ? item / 30 : (item - 240) / 30, sl = grid ? item % 30 : (item - 240) % 30;
        const int T = grid ? 2048 : 256, nst = T / 64; const size_t row0 = grid ? (size_t)NCTX + (size_t)seq * 2048 : (size_t)seq * 256;
        const int rc = sl * 64 + g * 8;
        char* base = (char*)(U + row0 * UW + 2048 + rc);
        const int act = (rc >= 1536 && rc < 1664) ? 1 : (rc >= 1792 ? 2 : 0);
        unsigned z0_ = 0u; asm volatile("" : "+v"(z0_));
        uint4 prv = make_uint4(z0_, z0_, z0_, z0_), cur = *(const uint4*)(base + (size_t)tl * (UW * 2)), nxt;
        __syncthreads();
#pragma unroll 1
        for (int k = 0; k < nst; ++k) {
            unsigned zr = 0u; asm volatile("" : "+v"(zr)); const uint4 z4 = make_uint4(zr, zr, zr, zr);
            nxt = z4; if (k + 1 < nst) nxt = *(const uint4*)(base + (size_t)((k + 1) * 64 + tl) * (UW * 2));
            sRow[(1 + tl) * 8 + g] = cur;
            if (tl == 0) sRow[65 * 8 + g] = nxt;
            LDS_BARRIER();
            uint4 lf = sRow[tl * 8 + g], rt = sRow[(2 + tl) * 8 + g];
            if (tl == 0 && (grid || k == 0)) lf = z4;
            if (tl == 63 && (grid || k == nst - 1)) rt = z4;
            float x[8], t[8], o[8], ms[8], m[8];
            int zz = 0; asm volatile("" : "+v"(zz)); const float* mup = pmu + rc + zz;
#define LD_MU8(a) do { const float4 m0 = *(const float4*)(mup + (a) * 1920), m1 = *(const float4*)(mup + (a) * 1920 + 4); m[0] = m0.x; m[1] = m0.y; m[2] = m0.z; m[3] = m0.w; m[4] = m1.x; m[5] = m1.y; m[6] = m1.z; m[7] = m1.w; } while (0)
            unpack8(cur, x);
            LD_MU8(0); unpack8(lf, t);
#pragma unroll
            for (int i = 0; i < 8; ++i) { o[i] = m[i] * t[i]; ms[i] = m[i]; }
            LD_MU8(1); unpack8(rt, t);
#pragma unroll
            for (int i = 0; i < 8; ++i) { o[i] += m[i] * t[i]; ms[i] += m[i]; }
            if (grid) {
                LD_MU8(2); unpack8(prv, t);
#pragma unroll
                for (int i = 0; i < 8; ++i) { o[i] += m[i] * t[i]; ms[i] += m[i]; }
                LD_MU8(3); unpack8(nxt, t);
#pragma unroll
                for (int i = 0; i < 8; ++i) { o[i] += m[i] * t[i]; ms[i] += m[i]; }
            }
#undef LD_MU8
#pragma unroll
            for (int i = 0; i < 8; ++i) o[i] += x[i] * (1.f - ms[i]);
            if (act == 1) {
#pragma unroll
                for (int i = 0; i < 8; ++i) o[i] = tanh_fast(o[i]); }
            if (act == 2) {
#pragma unroll
                for (int i = 0; i < 8; ++i) o[i] = sigmf(o[i]); }
            *(uint4*)(base + (size_t)(k * 64 + tl) * (UW * 2)) = make_uint4(pk2(o[0], o[1]), pk2(o[2], o[3]), pk2(o[4], o[5]), pk2(o[6], o[7]));
            LDS_BARRIER();
            if (tl == 63) sRow[g] = cur;
            prv = cur; cur = nxt;
        }
    }
}

constexpr int RW_TC = 16;
constexpr int RW_VEC = 0, RW_V = RW_VEC + 16 * 320 * 4, RW_KR = RW_V + 16 * 32 * 4, RW_XW = RW_KR + 16 * 64 * 4, RW_XA = RW_XW + 16 * 72 * 2, RW_Y = RW_XA + 16 * 72 * 2,
              RW_MU = RW_Y + 16 * 32 * 4, RW_DIR = RW_MU + 4 * 288 * 4;
static_assert(2 * RW_DIR <= LDS_BYTES && RW_DIR % 16 == 0, "rwkv lds");

__device__ __forceinline__ float dppf(float x, const int ctrl) { return x; }
#define DPP_ADD(x, ctrl) ((x) + __int_as_float(__builtin_amdgcn_update_dpp(0, __float_as_int(x), (ctrl), 0xf, 0xf, true)))
__device__ __forceinline__ float red8(float x) { x = DPP_ADD(x, 0xB1); x = DPP_ADD(x, 0x4E); x = DPP_ADD(x, 0x141); return x; }
__device__ __forceinline__ float red16(float x) { x = red8(x); x = DPP_ADD(x, 0x140); return x; }

struct Sh8 { uint4 x, l, r, u, d; };
__device__ __forceinline__ void sh8_load(Sh8& q, const bf16_t* U, size_t row0, int tok, int T, bool grid, int c0) {
    const char* Ub = (const char*)(U + row0 * UW);
    const int off = (tok * UW + c0) * 2; const uint4 z = make_uint4(0u, 0u, 0u, 0u);
    const bool hl = grid ? (tok & 63) != 0 : tok > 0, hr = grid ? (tok & 63) != 63 : tok < T - 1;
    q.x = *(const uint4*)(Ub + off);
    q.l = hl ? *(const uint4*)(Ub + (off - UW * 2)) : z; q.r = hr ? *(const uint4*)(Ub + (off + UW * 2)) : z;
    q.u = (grid && tok >= 64) ? *(const uint4*)(Ub + (off - 64 * UW * 2)) : z; q.d = (grid && tok < T - 64) ? *(const uint4*)(Ub + (off + 64 * UW * 2)) : z;
}
__device__ __forceinline__ void sh8_mix(const Sh8& q, bool grid, const float* mu4, int mustride, float* o) {
    float x[8], t[8], m[8], ms[8];
    unpack8(q.x, x);
    { const float4 a = *(const float4*)mu4, b = *(const float4*)(mu4 + 4); m[0] = a.x; m[1] = a.y; m[2] = a.z; m[3] = a.w; m[4] = b.x; m[5] = b.y; m[6] = b.z; m[7] = b.w; }
    unpack8(q.l, t);
#pragma unroll
    for (int i = 0; i < 8; ++i) { o[i] = m[i] * t[i]; ms[i] = m[i]; }
    { const float4 a = *(const float4*)(mu4 + mustride), b = *(const float4*)(mu4 + mustride + 4); m[0] = a.x; m[1] = a.y; m[2] = a.z; m[3] = a.w; m[4] = b.x; m[5] = b.y; m[6] = b.z; m[7] = b.w; }
    unpack8(q.r, t);
#pragma unroll
    for (int i = 0; i < 8; ++i) { o[i] += m[i] * t[i]; ms[i] += m[i]; }
    if (grid) {
        { const float4 a = *(const float4*)(mu4 + 2 * mustride), b = *(const float4*)(mu4 + 2 * mustride + 4); m[0] = a.x; m[1] = a.y; m[2] = a.z; m[3] = a.w; m[4] = b.x; m[5] = b.y; m[6] = b.z; m[7] = b.w; }
        unpack8(q.u, t);
#pragma unroll
        for (int i = 0; i < 8; ++i) { o[i] += m[i] * t[i]; ms[i] += m[i]; }
        { const float4 a = *(const float4*)(mu4 + 3 * mustride), b = *(const float4*)(mu4 + 3 * mustride + 4); m[0] = a.x; m[1] = a.y; m[2] = a.z; m[3] = a.w; m[4] = b.x; m[5] = b.y; m[6] = b.z; m[7] = b.w; }
        unpack8(q.d, t);
#pragma unroll
        for (int i = 0; i < 8; ++i) { o[i] += m[i] * t[i]; ms[i] += m[i]; }
    }
#pragma unroll
    for (int i = 0; i < 8; ++i) o[i] += x[i] * (1.f - ms[i]);
}
__device__ __forceinline__ void shifted8(const bf16_t* U, size_t row0, int tok, int T, bool grid, int c0, const float* mu4, int mustride, float* o) {
    Sh8 q; sh8_load(q, U, row0, tok, T, grid, c0); sh8_mix(q, grid, mu4, mustride, o);
}
typedef float f32x2 __attribute__((ext_vector_type(2)));

__device__ __forceinline__ void rwkv_task(const P& p, unsigned char* lds, int bg, int h, int rh) {
    const int wv = __builtin_amdgcn_readfirstlane((int)threadIdx.x >> 6), dir = wv >> 2, lw = wv & 3;
    const bool ctx = bg < 32; const int T = ctx ? 256 : 2048, nc = T / RW_TC; const size_t row0 = ctx ? (size_t)bg * 256 : (size_t)NCTX + (size_t)(bg - 32) * 2048;
    const bool grid = !ctx;
    unsigned char* L = lds + dir * RW_DIR;
    float* sVec = (float*)(L + RW_VEC); float* sV = (float*)(L + RW_V); float* sKr = (float*)(L + RW_KR); bf16_t* sXw = (bf16_t*)(L + RW_XW); bf16_t* sXa = (bf16_t*)(L + RW_XA);
    float* sY = (float*)(L + RW_Y); float* sMu = (float*)(L + RW_MU);
    const bf16_t* U = (const bf16_t*)(p.ws + WS_U); bf16_t* HB = (bf16_t*)(p.ws + WS_A);
    const int hc = h * 64;
    float st[8]; bf16x8 wfrag[2], afrag[2]; float w0v, a0v, kav;
    {
        const int tid = opaque_tid(), ltid = tid & 255, ri = ltid >> 3, jq = ltid & 7, fr = tid & 15, fq = (tid >> 4) & 3;
        __syncthreads();
        if (ctx) {
#pragma unroll
            for (int q = 0; q < 8; ++q) st[q] = 0.f;
        } else { const float* S0 = p.sS + ((size_t)(((bg - 32) * 2 + dir) * 8 + h)) * 4096 + (32 * rh + ri) * 64 + jq * 8;
#pragma unroll
            for (int q = 0; q < 8; ++q) st[q] = S0[q]; }
        const int jcol = hc + 16 * lw + fr;
#pragma unroll
        for (int ks = 0; ks < 2; ++ks) { float wf[8], af[8];
#pragma unroll
            for (int i = 0; i < 8; ++i) { const int l = 32 * ks + 8 * fq + i; wf[i] = p.w2[(size_t)(dir * 64 + l) * 512 + jcol]; af[i] = p.a2[(size_t)(dir * 64 + l) * 512 + jcol]; }
            union { uint4 u; bf16x8 v; } c1, c2; c1.u = make_uint4(pk2(wf[0], wf[1]), pk2(wf[2], wf[3]), pk2(wf[4], wf[5]), pk2(wf[6], wf[7])); c2.u = make_uint4(pk2(af[0], af[1]), pk2(af[2], af[3]), pk2(af[4], af[5]), pk2(af[6], af[7]));
            wfrag[ks] = c1.v; afrag[ks] = c2.v; }
        w0v = p.w0[dir * 512 + jcol]; a0v = p.a0[dir * 512 + jcol]; kav = p.ka[jcol];
    }
    uint4 q1, q2, q3 = make_uint4(0u, 0u, 0u, 0u);
    const char* Ub = (const char*)(U + row0 * UW);
    { const int tid = opaque_tid(), ltid = tid & 255; const int c = dir ? nc - 1 : 0, tok0 = c * RW_TC; const int tl = (ltid & 127) >> 3, g = ltid & 7;
      q1 = *(const uint4*)(Ub + ((tok0 + tl) * UW + (lw < 2 ? 2048 : 2048 + 512) + hc + 8 * g) * 2);
      q2 = *(const uint4*)(Ub + ((tok0 + tl) * UW + (lw < 2 ? 2048 + 1536 : 2048 + 1664) + dir * 64 + 8 * g) * 2);
      if (lw == 0) q3 = *(const uint4*)(Ub + ((tok0 + (ltid >> 2)) * UW + 2048 + 1024 + hc + 32 * rh + 8 * (ltid & 3)) * 2); }
    f32x2 st2[4];
#pragma unroll
    for (int q = 0; q < 4; ++q) st2[q] = (f32x2){st[2 * q], st[2 * q + 1]};
#pragma unroll 1
    for (int s = 0; s < nc; ++s) {
        const int c = dir ? nc - 1 - s : s; const int tok0 = c * RW_TC;
        const bool second = s >= (nc >> 1);
        const int tid = opaque_tid(), ltid = tid & 255, ri = ltid >> 3, jq = ltid & 7, fr = tid & 15, fq = (tid >> 4) & 3;
        { const int tl = (ltid & 127) >> 3, g = ltid & 7; float o[8];
          if (lw < 2) {
              unpack8(q1, o);
              *(float4*)(sVec + tl * 320 + 8 * g) = make_float4(o[0], o[1], o[2], o[3]); *(float4*)(sVec + tl * 320 + 8 * g + 4) = make_float4(o[4], o[5], o[6], o[7]);
              *(uint4*)(sXw + tl * 72 + 8 * g) = q2;
          } else {
              unpack8(q1, o);
              float kkr[8]; float ss = 0.f;
#pragma unroll
              for (int i = 0; i < 8; ++i) { kkr[i] = o[i] * p.kk[hc + 8 * g + i]; ss += kkr[i] * kkr[i]; }
              ss = red8(ss); const float rn = __builtin_amdgcn_rsqf(fmaxf(ss, 1e-24f));
              *(float4*)(sKr + tl * 64 + 8 * g) = make_float4(o[0], o[1], o[2], o[3]); *(float4*)(sKr + tl * 64 + 8 * g + 4) = make_float4(o[4], o[5], o[6], o[7]);
              *(float4*)(sVec + tl * 320 + 192 + 8 * g) = make_float4(kkr[0] * rn, kkr[1] * rn, kkr[2] * rn, kkr[3] * rn); *(float4*)(sVec + tl * 320 + 192 + 8 * g + 4) = make_float4(kkr[4] * rn, kkr[5] * rn, kkr[6] * rn, kkr[7] * rn);
              *(uint4*)(sXa + tl * 72 + 8 * g) = q2;
          }
          if (lw == 0) {
              const int tl2 = ltid >> 2, g2 = ltid & 3;
              unpack8(q3, o);
              *(float4*)(sV + tl2 * 32 + 8 * g2) = make_float4(o[0], o[1], o[2], o[3]); *(float4*)(sV + tl2 * 32 + 8 * g2 + 4) = make_float4(o[4], o[5], o[6], o[7]);
          } }
        __syncthreads();
        { f32x4 aw = (f32x4){0.f, 0.f, 0.f, 0.f}, aa = (f32x4){0.f, 0.f, 0.f, 0.f};
#pragma unroll
          for (int ks = 0; ks < 2; ++ks) { const bf16x8 xw = *(const bf16x8*)(sXw + fr * 72 + 32 * ks + 8 * fq), xa = *(const bf16x8*)(sXa + fr * 72 + 32 * ks + 8 * fq);
              aw = mfma16(xw, wfrag[ks], aw); aa = mfma16(xa, afrag[ks], aa); }
          const int j = 16 * lw + fr;
#pragma unroll
          for (int jj = 0; jj < 4; ++jj) { const int tl = 4 * fq + jj;
              const float dec = fexp(-fexp(-softplus_fast(-(w0v + aw[jj])) - 0.5f));
              const float a = sigmf(a0v + aa[jj]); const float k = sKr[tl * 64 + j], kn = sVec[tl * 320 + 192 + j];
              float* V = sVec + tl * 320 + j; V[64] = dec; V[128] = k * (1.f + (a - 1.f) * kav); V[256] = kn * a; } }
        const int otl = ltid >> 4, opr = ltid & 15; unsigned* hb = (unsigned*)(HB + (row0 + tok0 + otl) * DM + 512 + hc + 32 * rh + 2 * opr);
        unsigned ov = 0u;
        if (second) ov = __hip_atomic_load(hb, __ATOMIC_RELAXED, __HIP_MEMORY_SCOPE_AGENT);
        if (s + 1 < nc) { const int cn = dir ? nc - 2 - s : s + 1, tokn = cn * RW_TC; const int tl = (ltid & 127) >> 3, g = ltid & 7;
            q1 = *(const uint4*)(Ub + ((tokn + tl) * UW + (lw < 2 ? 2048 : 2048 + 512) + hc + 8 * g) * 2);
            q2 = *(const uint4*)(Ub + ((tokn + tl) * UW + (lw < 2 ? 2048 + 1536 : 2048 + 1664) + dir * 64 + 8 * g) * 2);
            if (lw == 0) q3 = *(const uint4*)(Ub + ((tokn + (ltid >> 2)) * UW + 2048 + 1024 + hc + 32 * rh + 8 * (ltid & 3)) * 2); }
        LDS_BARRIER();
        f32x2 sv_[4];
#pragma unroll
        for (int q = 0; q < 4; ++q) sv_[q] = st2[q];
#pragma unroll 1
        for (int rep = 0; rep < (PROBE_DUP == 102 ? 2 : 1); ++rep) {
        if (PROBE_DUP == 102) {
#pragma unroll
            for (int q = 0; q < 4; ++q) st2[q] = sv_[q]; }
float ys[RW_TC];
#pragma unroll
        for (int step = 0; step < RW_TC; ++step) { const int tl = dir ? RW_TC - 1 - step : step; const float* V = sVec + tl * 320 + jq * 8;
            const float4 ka4 = *(const float4*)(V + 192), kb4 = *(const float4*)(V + 196);
            f32x2 acc = st2[0] * (f32x2){ka4.x, ka4.y}; acc = st2[1] * (f32x2){ka4.z, ka4.w} + acc; acc = st2[2] * (f32x2){kb4.x, kb4.y} + acc; acc = st2[3] * (f32x2){kb4.z, kb4.w} + acc;
            const float sa = -red8(acc.x + acc.y);
            const float vi = sV[tl * 32 + ri];
            const float4 wa = *(const float4*)(V + 64), wb = *(const float4*)(V + 68), ba = *(const float4*)(V + 256), bb = *(const float4*)(V + 260),
                         da = *(const float4*)(V + 128), db = *(const float4*)(V + 132), ra = *(const float4*)(V), rb = *(const float4*)(V + 4);
            const f32x2 sa2 = (f32x2){sa, sa}, vi2 = (f32x2){vi, vi};
            st2[0] = st2[0] * (f32x2){wa.x, wa.y} + (sa2 * (f32x2){ba.x, ba.y} + vi2 * (f32x2){da.x, da.y});
            st2[1] = st2[1] * (f32x2){wa.z, wa.w} + (sa2 * (f32x2){ba.z, ba.w} + vi2 * (f32x2){da.z, da.w});
            st2[2] = st2[2] * (f32x2){wb.x, wb.y} + (sa2 * (f32x2){bb.x, bb.y} + vi2 * (f32x2){db.x, db.y});
            st2[3] = st2[3] * (f32x2){wb.z, wb.w} + (sa2 * (f32x2){bb.z, bb.w} + vi2 * (f32x2){db.z, db.w});
            f32x2 ya = st2[0] * (f32x2){ra.x, ra.y}; ya = st2[1] * (f32x2){ra.z, ra.w} + ya; ya = st2[2] * (f32x2){rb.x, rb.y} + ya; ya = st2[3] * (f32x2){rb.z, rb.w} + ya;
            const float y = red8(ya.x + ya.y);
            ys[step] = y; }
        if (jq == 0) {
#pragma unroll
            for (int step = 0; step < RW_TC; ++step) sY[(dir ? RW_TC - 1 - step : step) * 32 + ri] = ys[step]; }
        }
        LDS_BARRIER();
        { float y0 = sY[otl * 32 + 2 * opr], y1 = sY[otl * 32 + 2 * opr + 1];
          if (second) { y0 += __uint_as_float(ov << 16); y1 += __uint_as_float(ov & 0xffff0000u); }
          *hb = pk2(y0, y1); }
    }
#pragma unroll
    for (int q = 0; q < 4; ++q) { st[2 * q] = st2[q].x; st[2 * q + 1] = st2[q].y; }
    if (ctx) { const int tid = opaque_tid(), ltid = tid & 255, ri = ltid >> 3, jq = ltid & 7;
        float* So = p.out + OUT_S + ((size_t)((bg * 2 + dir) * 8 + h)) * 4096 + (32 * rh + ri) * 64 + jq * 8;
#pragma unroll
        for (int q = 0; q < 8; ++q) So[q] = st[q]; }
    __syncthreads();
}

constexpr int FZ_ROW = 1800;
constexpr int FZ_X = 0, FZ_MU = 32 * FZ_ROW * 2, FZ_END = FZ_MU + 4 * 1792 * 4;
static_assert(FZ_END <= LDS_BYTES && FZ_MU % 16 == 0, "finalize lds");

__device__ __forceinline__ void phase_rwkv_finalize(const P& p, unsigned char* lds) {
    bf16_t* sX = (bf16_t*)(lds + FZ_X); float* sMu = (float*)(lds + FZ_MU);
    const bf16_t* U = (const bf16_t*)(p.ws + WS_U); bf16_t* HB = (bf16_t*)(p.ws + WS_A);
    { const bf16_t* HB2 = (const bf16_t*)(p.ws + WS_HB2); const int tid0 = opaque_tid(), lane = tid0 & 63, wave = (int)threadIdx.x >> 6;
#pragma unroll 1
      for (int row = NCTX + blockIdx.x * 8 + wave; row < MT; row += gridDim.x * 8) {
          float hf[8], hb[8], og[8], v[8]; float ss = 0.f;
          unpack8(*(const uint4*)(HB + (size_t)row * DM + lane * 8), hf); unpack8(*(const uint4*)(HB2 + (size_t)(row - NCTX) * 512 + lane * 8), hb); unpack8(*(const uint4*)(U + (size_t)row * UW + 1536 + lane * 8), og);
#pragma unroll
          for (int i = 0; i < 8; ++i) { v[i] = sigmf(og[i]) * (hf[i] + hb[i]); ss += v[i] * v[i]; }
          ss = red16(ss); const float rms = rsqrtf(ss * (1.f / 128.f) + 1e-6f);
          const float4 g0 = *(const float4*)(p.hg + lane * 8), g1 = *(const float4*)(p.hg + lane * 8 + 4);
          *(uint4*)(HB + (size_t)row * DM + lane * 8) = make_uint4(pk2(v[0] * rms * g0.x, v[1] * rms * g0.y), pk2(v[2] * rms * g0.z, v[3] * rms * g0.w), pk2(v[4] * rms * g1.x, v[5] * rms * g1.y), pk2(v[6] * rms * g1.z, v[7] * rms * g1.w)); } }
    const bf16_t* A2 = (const bf16_t*)(p.ws + WS_A2BF); const bf16_t* G2 = (const bf16_t*)(p.ws + WS_G2BF);
    const int wv = __builtin_amdgcn_readfirstlane((int)threadIdx.x >> 6), hc = wv * 64;
#pragma unroll 1
    for (int tile = blockIdx.x; tile < MT / 32; tile += gridDim.x) {
        const int tid = opaque_tid(), fr = tid & 15, fq = (tid >> 4) & 3;
        const int rowt = tile * 32; const bool ctx = rowt < NCTX; const int T = ctx ? 256 : 2048; const size_t row0 = ctx ? (size_t)(rowt & ~255) : (size_t)NCTX + (size_t)((rowt - NCTX) & ~2047);
        const int tokt = rowt - (int)row0;
        __syncthreads();
#pragma unroll 2
        for (int it = 0; it < 14; ++it) { const int item = it * NTHR + tid, tl = item / 224, gi = item % 224;
            const int c0 = gi < 192 ? 2048 + 8 * gi : 2048 + 1664 + 8 * (gi - 192);
            *(uint4*)(sX + tl * FZ_ROW + 8 * gi) = *(const uint4*)(U + (row0 + tokt + tl) * UW + c0); }
        __syncthreads();
#pragma unroll 1
        for (int rt = 0; rt < 2; ++rt) {
            f32x4 af[4], ab[4], gg[4];
#pragma unroll
            for (int ct = 0; ct < 4; ++ct) { af[ct] = (f32x4){0.f, 0.f, 0.f, 0.f}; ab[ct] = af[ct]; gg[ct] = af[ct]; }
            const bf16_t* xr = sX + (16 * rt + fr) * FZ_ROW;
#pragma unroll
            for (int ks = 0; ks < 2; ++ks) { const bf16x8 xf = *(const bf16x8*)(xr + 1536 + 32 * ks + 8 * fq), xb = *(const bf16x8*)(xr + 1600 + 32 * ks + 8 * fq);
#pragma unroll
                for (int ct = 0; ct < 4; ++ct) { const int n = hc + 16 * ct + fr;
                    af[ct] = mfma16(xf, *(const bf16x8*)(A2 + (size_t)n * 64 + 32 * ks + 8 * fq), af[ct]);
                    ab[ct] = mfma16(xb, *(const bf16x8*)(A2 + (size_t)(512 + n) * 64 + 32 * ks + 8 * fq), ab[ct]); } }
#pragma unroll
            for (int ks = 0; ks < 4; ++ks) { const bf16x8 xg = *(const bf16x8*)(xr + 1664 + 32 * ks + 8 * fq);
#pragma unroll
                for (int ct = 0; ct < 4; ++ct) { const int n = hc + 16 * ct + fr; gg[ct] = mfma16(xg, *(const bf16x8*)(G2 + (size_t)n * 128 + 32 * ks + 8 * fq), gg[ct]); } }
#pragma unroll
            for (int jj = 0; jj < 4; ++jj) { const int tl = 16 * rt + 4 * fq + jj; const size_t row = (size_t)rowt + tl; const bf16_t* xt = sX + tl * FZ_ROW;
                bf16_t* hb = HB + row * DM + 512 + hc;
                float y[4], vv[4]; float sy = 0.f, sb = 0.f;
#pragma unroll
                for (int ct = 0; ct < 4; ++ct) { const int ch = hc + 16 * ct + fr;
                    const float am = 0.5f * (sigmf(p.a0[ch] + af[ct][jj]) + sigmf(p.a0[512 + ch] + ab[ct][jj]));
                    const float r = bf2f(xt[ch]), k = bf2f(xt[512 + ch]); vv[ct] = bf2f(xt[1024 + ch]);
                    sb += r * k * (1.f + (am - 1.f) * p.ka[ch]) * p.rk[ch];
                    y[ct] = bf2f(hb[16 * ct + fr]); sy += y[ct]; }
                sy = red16(sy); sb = red16(sb);
                const float mean = sy * (1.f / 64.f); float vs = 0.f;
#pragma unroll
                for (int ct = 0; ct < 4; ++ct) { const float d = y[ct] - mean; vs += d * d; }
                vs = red16(vs); const float rstd = rsqrtf(vs * (1.f / 64.f) + 64e-5f);
#pragma unroll
                for (int ct = 0; ct < 4; ++ct) { const int ch = hc + 16 * ct + fr; const float yn = (y[ct] - mean) * rstd * p.lng[ch] + p.lnb[ch];
                    hb[16 * ct + fr] = f2bf((yn + sb * vv[ct]) * gg[ct][jj]); } }
        }
    }
}

__device__ __forceinline__ void phase_scan(const P& p, unsigned char* lds, int round = 0) {
    unsigned* ctr = (unsigned*)(p.ws + WS_CTR) + round;
    volatile int* sTask = (volatile int*)(lds + LDS_BYTES - 16);
#pragma unroll 1
    for (;;) {
        __syncthreads();
        if (threadIdx.x == 0) *sTask = (int)atomicAdd(ctr, 1u);
        __syncthreads();
        const int t = __builtin_amdgcn_readfirstlane(*sTask);
        if (t >= 832) break;
#pragma unroll 1
        for (int rep = 0; rep < ((PROBE_DUP == 100 && (t < 64 || (t >= 192 && t < 320))) || (PROBE_DUP == 101 && !(t < 64 || (t >= 192 && t < 320))) ? 2 : 1); ++rep) {
        if (t < 64) mlstm_task(p, lds, 32 + (t >> 3), (t >> 1) & 3, t & 1);
        else if (t < 192) { const int q = t - 64; rwkv_task(p, lds, 32 + (q >> 4), (q >> 1) & 7, q & 1); }
        else if (t < 320) { const int q = t - 192; mlstm_task(p, lds, q >> 2, q & 3, -1); }
        else { const int q = t - 320; rwkv_task(p, lds, q >> 4, (q >> 1) & 7, q & 1); }
        }
    }
}

__device__ void phase_convert_w2(const P& p, unsigned char* lds) {
    float* tile = (float*)lds;
    const int t1 = 16 * 88, t2 = 44 * 16;
    for (int it = blockIdx.x; it < t1 + t2; it += gridDim.x) {
        if (it < t1) do_convert(p.w2in, (bf16_t*)(p.ws + WS_W1), 1024, 5632, 5632, 1, it, tile);
        else do_convert(p.w2out, (bf16_t*)(p.ws + WS_W1B), 2816, 1024, 1024, 0, it - t1, tile);
    }
}

#define XB_TMO      128
#define XB_XCNT(j)  (256  + 64 * (j))
#define XB_XSUB(j)  (1280 + 64 * (j))
#define XB_XGEN(j)  (2304 + 64 * (j))
#define XB_TOP      3328
#define XB_TOPGEN   3392
#define XCD_BAR_WORDS 3456
#define XB_SPIN_CAP (1u << 18)
__device__ __forceinline__ unsigned xb_ld(unsigned* p)              { return __hip_atomic_load(p, __ATOMIC_RELAXED, __HIP_MEMORY_SCOPE_AGENT); }
__device__ __forceinline__ unsigned xb_add(unsigned* p, unsigned v) { return __hip_atomic_fetch_add(p, v, __ATOMIC_RELAXED, __HIP_MEMORY_SCOPE_AGENT); }
__device__ __forceinline__ unsigned xb_xcc_id() { return (unsigned)__builtin_amdgcn_s_getreg((3 << 11) | 20) & 0xFu; }
#define XB_SPIN(cond, bar) do { unsigned _sp = 0; while (cond) { __builtin_amdgcn_s_sleep(1); \
    if ((++_sp & 255u) == 0u) { if (xb_ld(&(bar)[XB_TMO])) break; if (_sp > XB_SPIN_CAP) { atomicAdd(&(bar)[XB_TMO], 1u); break; } } } } while (0)
struct XcdBarrier { unsigned* bar; unsigned x; volatile unsigned* st; };
__device__ __forceinline__ XcdBarrier xcd_barrier_post(unsigned* bar, volatile unsigned* st) {
    XcdBarrier b; b.bar = bar; b.x = xb_xcc_id(); b.st = st;
    if (threadIdx.x == 0) (void)xb_add(&bar[XB_XCNT(b.x)], 1u);
    return b;
}
__device__ __forceinline__ void xcd_barrier_complete(unsigned* bar, unsigned x, unsigned& nloc, unsigned& nx) {
    const unsigned G = gridDim.x * gridDim.y * gridDim.z;
    unsigned sum, cnt, mine, sp = 0u;
    for (;;) {
        sum = 0u; cnt = 0u; mine = 0u;
#pragma unroll
        for (unsigned j = 0; j < 16; ++j) { const unsigned c = xb_ld(&bar[XB_XCNT(j)]); sum += c; cnt += (c > 0u) ? 1u : 0u; mine = (j == x) ? c : mine; }
        if (sum == G) break;
        __builtin_amdgcn_s_sleep(1);
        if ((++sp & 255u) == 0u) { if (xb_ld(&bar[XB_TMO])) break; if (sp > XB_SPIN_CAP) { atomicAdd(&bar[XB_TMO], 1u); break; } }
    }
    nloc = mine > 0u ? mine : 1u; nx = cnt > 0u ? cnt : 1u;
}
__device__ __forceinline__ void xcd_barrier(const XcdBarrier& b) {
    asm volatile("s_waitcnt vmcnt(0)" ::: "memory");
    __syncthreads();
    if (threadIdx.x == 0) {
        unsigned* bar = b.bar;
        __builtin_amdgcn_s_waitcnt(0);
        unsigned nloc = b.st[0], nx = b.st[1];
        if (nloc == 0u) { xcd_barrier_complete(bar, b.x, nloc, nx); b.st[0] = nloc; b.st[1] = nx; }
        const unsigned old = xb_add(&bar[XB_XSUB(b.x)], 1u);
        const unsigned gen = old / nloc;
        if (old + 1u == (gen + 1u) * nloc) {
            __builtin_amdgcn_fence(__ATOMIC_RELEASE, "agent");
            asm volatile("s_waitcnt vmcnt(0)" ::: "memory");
            const unsigned og = xb_add(&bar[XB_TOP], 1u);
            const unsigned tg = og / nx;
            if (og + 1u == (tg + 1u) * nx) xb_add(&bar[XB_TOPGEN], 1u);
            else XB_SPIN(xb_ld(&bar[XB_TOPGEN]) == tg, bar);
            __builtin_amdgcn_fence(__ATOMIC_ACQUIRE, "agent");
            xb_add(&bar[XB_XGEN(b.x)], 1u);
            asm volatile("s_waitcnt vmcnt(0)" ::: "memory");
        } else {
            XB_SPIN(xb_ld(&bar[XB_XGEN(b.x)]) == gen, bar);
            __builtin_amdgcn_fence(__ATOMIC_ACQUIRE, "agent");
            asm volatile("s_waitcnt vmcnt(0)" ::: "memory");
        }
    }
    __syncthreads();
}

constexpr int NPHASE = 12;
template <int PH>
__device__ __forceinline__ void run_phase(const P& p, unsigned char* lds) {
    const float* mod = (const float*)(p.ws + WS_MOD);
    if constexpr (PH == 0) phase0(p, lds);
    if constexpr (PH == 1) phase_normmod(p, 0);
    if constexpr (PH == 2) { EpiSwiglu E{(bf16_t*)(p.ws + WS_U)}; run_gemm(lds, (const bf16_t*)(p.ws + WS_A), (const bf16_t*)(p.ws + WS_W1), 5632, 1024, E); }
    if constexpr (PH == 3) { EpiResid E{p.xp, p.xs, p.out, mod + 2048, 0.5f, 0}; run_gemm(lds, (const bf16_t*)(p.ws + WS_U), (const bf16_t*)(p.ws + WS_W1B), 1024, 2816, E); }
    if constexpr (PH == 4) phase_normmod(p, 1);
    if constexpr (PH == 5) { EpiU E{(bf16_t*)(p.ws + WS_U), (float*)(p.ws + WS_GATES)}; run_gemm(lds, (const bf16_t*)(p.ws + WS_A), (const bf16_t*)(p.ws + WS_BT3), 4096, 1024, E); }
    if constexpr (PH == 6) phase_scan(p, lds);
    if constexpr (PH == 12) phase_rwkv_finalize(p, lds);
    if constexpr (PH == 13) phase_shift((bf16_t*)(p.ws + WS_U), p.mu, (uint4*)lds);
    if constexpr (PH == 7) { EpiResid E{p.xp, p.xs, p.out, mod + 5120, 1.0f, 1}; run_gemm(lds, (const bf16_t*)(p.ws + WS_A), (const bf16_t*)(p.ws + WS_BT4), 1024, 1024, E); }
    if constexpr (PH == 8) { phase_normmod(p, 2); phase_convert_w2(p, lds); }
    if constexpr (PH == 9) { EpiSwiglu E{(bf16_t*)(p.ws + WS_U)}; run_gemm(lds, (const bf16_t*)(p.ws + WS_A), (const bf16_t*)(p.ws + WS_W1), 5632, 1024, E); }
    if constexpr (PH == 10) { EpiResid E{p.xp, p.xs, p.out, mod + 8192, 0.5f, 1}; run_gemm(lds, (const bf16_t*)(p.ws + WS_U), (const bf16_t*)(p.ws + WS_W1B), 1024, 2816, E); }
    if constexpr (PH == 11) phase_finalnorm(p);
}

#if !ONE_LAUNCH
template <int PH>
__global__ void __launch_bounds__(NTHR, 2) k_phase(P p) {
    extern __shared__ __attribute__((aligned(16))) unsigned char lds[];
    run_phase<PH>(p, lds);
}
#endif

#if ONE_LAUNCH
__global__ void __launch_bounds__(NTHR, 2) k_mega(P p) {
    extern __shared__ __attribute__((aligned(16))) unsigned char lds[];
    cg::grid_group grid = cg::this_grid();
    volatile unsigned* xst = (volatile unsigned*)(lds + LDS_BYTES - 32);
    if (threadIdx.x == 0) { xst[0] = 0u; xst[1] = 0u; }
    __syncthreads();
    const XcdBarrier xbar = xcd_barrier_post((unsigned*)(p.ws + WS_BAR), xst);
#define GSYNC() xcd_barrier(xbar)
    if (p.ws == nullptr) grid.sync();
    run_phase<0>(p, lds); GSYNC();
    if (PROBE_DUP == 0) { run_phase<0>(p, lds); GSYNC(); }
    run_phase<1>(p, lds); GSYNC();
    if (PROBE_DUP == 1) { run_phase<1>(p, lds); GSYNC(); }
    run_phase<2>(p, lds); GSYNC();
    if (PROBE_DUP == 2 || PROBE_DUP == 235) { run_phase<2>(p, lds); GSYNC(); }
    run_phase<3>(p, lds); GSYNC();
    if (PROBE_DUP == 3 || PROBE_DUP == 235) { run_phase<3>(p, lds); GSYNC(); }
    run_phase<4>(p, lds); GSYNC();
    if (PROBE_DUP == 4) { run_phase<4>(p, lds); GSYNC(); }
    run_phase<5>(p, lds); GSYNC();
    if (PROBE_DUP == 5 || PROBE_DUP == 235) { run_phase<5>(p, lds); GSYNC(); }
    run_phase<13>(p, lds); GSYNC();
    run_phase<6>(p, lds); GSYNC();
    if (PROBE_DUP == 6) { phase_scan(p, lds, 1); GSYNC(); }
    run_phase<12>(p, lds); GSYNC();
    run_phase<7>(p, lds); GSYNC();
    if (PROBE_DUP == 7) { run_phase<7>(p, lds); GSYNC(); }
    run_phase<8>(p, lds); GSYNC();
    if (PROBE_DUP == 8) { run_phase<8>(p, lds); GSYNC(); }
    run_phase<9>(p, lds); GSYNC();
    if (PROBE_DUP == 9) { run_phase<9>(p, lds); GSYNC(); }
    run_phase<10>(p, lds); GSYNC();
    if (PROBE_DUP == 10) { run_phase<10>(p, lds); GSYNC(); }
    run_phase<11>(p, lds);
    if (PROBE_DUP == 200) { for (int i = 0; i < 20; ++i) GSYNC(); }
}
#endif

#if !ONE_LAUNCH
template <int PH> static void launch_phase(const P& p, int grid, hipStream_t stream) {
    static bool attr = false;
    if (!attr) { (void)hipFuncSetAttribute((const void*)k_phase<PH>, hipFuncAttributeMaxDynamicSharedMemorySize, LDS_BYTES); attr = true; }
    hipLaunchKernelGGL(k_phase<PH>, dim3(grid), dim3(NTHR), LDS_BYTES, stream, p);
}
#endif

extern "C" void kernel_launch(void* const* d_in, const int* in_sizes, int n_in, void* d_out, int out_size, void* d_ws, size_t ws_size, hipStream_t stream) {
    (void)in_sizes; (void)n_in; (void)out_size; (void)ws_size;
    static int grid = 0;
    if (grid == 0) {
        int dev = 0, cus = 0;
        if (hipGetDevice(&dev) != hipSuccess || hipDeviceGetAttribute(&cus, hipDeviceAttributeMultiprocessorCount, dev) != hipSuccess || cus <= 0) cus = 256;
#if ONE_LAUNCH
        (void)hipFuncSetAttribute((const void*)k_mega, hipFuncAttributeMaxDynamicSharedMemorySize, LDS_BYTES);
        int per_cu = 0;
        if (hipOccupancyMaxActiveBlocksPerMultiprocessor(&per_cu, (const void*)k_mega, NTHR, LDS_BYTES) != hipSuccess || per_cu < 1) per_cu = 1;
        (void)hipGetLastError();
#endif
        grid = cus;
    }
    P p{};
    const float** f = (const float**)&p;
    for (int i = 0; i < 35; ++i) f[i] = (const float*)d_in[i];
    p.out = (float*)d_out; p.ws = (unsigned char*)d_ws;
    (void)hipMemsetAsync((char*)d_ws + WS_MOD, 0, NCOND * MODW * sizeof(float) + 256 + 3456 * 4, stream);
#if ONE_LAUNCH
    void* args[] = {&p};
    hipError_t e = hipLaunchCooperativeKernel((const void*)k_mega, dim3(grid), dim3(NTHR), args, LDS_BYTES, stream);
    if (e != hipSuccess) fprintf(stderr, "cooperative launch failed: %s (grid %d)\n", hipGetErrorString(e), grid);
#else
    launch_phase<0>(p, grid, stream); launch_phase<1>(p, grid, stream); launch_phase<2>(p, grid, stream); launch_phase<3>(p, grid, stream);
    launch_phase<4>(p, grid, stream); launch_phase<5>(p, grid, stream); launch_phase<13>(p, grid, stream); launch_phase<6>(p, grid, stream); launch_phase<12>(p, grid, stream); launch_phase<7>(p, grid, stream);
    launch_phase<8>(p, grid, stream); launch_phase<9>(p, grid, stream); launch_phase<10>(p, grid, stream); launch_phase<11>(p, grid, stream);
#endif
}
```

```cpp
#include <hip/hip_runtime.h>
#include <hip/hip_cooperative_groups.h>
#include <cstdio>
#include <cstdint>
namespace cg = cooperative_groups;

#ifndef PROBE_DUP
#define PROBE_DUP -1
#endif
#ifndef ONE_LAUNCH
#define ONE_LAUNCH 1
#endif

#define LDS_BARRIER() do { asm volatile("s_waitcnt lgkmcnt(0)" ::: "memory"); __builtin_amdgcn_s_barrier(); asm volatile("" ::: "memory"); } while (0)
__device__ __forceinline__ int opaque_tid() { int z = 0; asm volatile("" : "+v"(z)); return (int)threadIdx.x + z; }

namespace pg8 {
#define PG8_LAS __attribute__((address_space(3)))
typedef unsigned short bf16_t;
typedef short bf16x8 __attribute__((ext_vector_type(8)));
typedef float f32x4 __attribute__((ext_vector_type(4)));
typedef unsigned u32x4 __attribute__((ext_vector_type(4)));
constexpr int BM = 256, BK = 64, HALF = 128, HTB = HALF * BK * 2, STAGE_BYTES = 8 * HTB, NXCD = 8, WGM = 8;

__host__ __device__ __forceinline__ int lds_byte(int r, int c) { const int st = (r >> 4) * 2 + (c >> 5), rr = r & 15, cc = c & 31, ob = rr * 64 + cc * 2; return st * 1024 + (ob ^ (((ob >> 9) & 1) << 5)); }
__host__ __device__ __forceinline__ void stage_rc(int b, int& R, int& C) { const int st = b / 1024, sb = b % 1024, swz = sb ^ (((sb >> 9) & 1) << 5); R = (st >> 1) * 16 + swz / 64; C = (st & 1) * 32 + (swz % 64) / 2; }
__host__ __device__ __forceinline__ int perm32(int rho) { const int n = rho >> 4, i = rho & 15; return 8 * (i >> 2) + 4 * n + (i & 3); }

struct Unit { int pm, pn; };
struct Gemm { const bf16_t* A; const bf16_t* Bt; int M, N, K; };

struct StaticOrder {
    int nM, nN, nwg, G, c;
    __host__ __device__ void init(int M, int N, int G_, int c_) { nM = M / BM; nN = N / BM; nwg = nM * nN; G = G_; c = c_; }
    __host__ __device__ bool next(int i, Unit& u) const {
        const long L = (long)i * G + c; if (L >= nwg) return false;
        int wgid = (int)L; { const int q = nwg / NXCD, r = nwg % NXCD, xcd = wgid % NXCD, off = wgid / NXCD; wgid = (xcd < r ? xcd * (q + 1) : r * (q + 1) + (xcd - r) * q) + off; }
        const int nig = WGM * nN, gid = wgid / nig, fm = gid * WGM, gsz = (nM - fm) < WGM ? (nM - fm) : WGM;
        u.pm = fm + ((wgid % nig) % gsz); u.pn = (wgid % nig) / gsz; return true;
    }
    __device__ __forceinline__ void a_ready(const Unit&) const {}
    __device__ __forceinline__ void done(const Unit&) const {}
};

__device__ __forceinline__ unsigned cvt_pk_bf16(float lo, float hi) { unsigned r; asm volatile("v_cvt_pk_bf16_f32 %0, %1, %2" : "=v"(r) : "v"(lo), "v"(hi)); return r; }

template <class Epi, class Sched, bool ALIGN_EPI = false, bool SP2 = false>
__device__ __forceinline__ void gemm_phase(PG8_LAS unsigned char* lds, const Gemm g, const Sched& S, const Epi& E) {
    const int tid = opaque_tid(), wid = __builtin_amdgcn_readfirstlane((int)threadIdx.x >> 6), lane = tid & 63, wr = wid >> 2, wc = wid & 3, fr = lane & 15, fq = lane >> 4;
    const int K = g.K, nt = K / BK;
    unsigned voffA[2], voffB[2];
#pragma unroll
    for (int i = 0; i < 2; ++i) { int R, C; stage_rc(tid * 16 + i * 8192, R, C); const int Rb = Epi::PERM ? ((R & ~31) + perm32(R & 31)) : R;
        voffA[i] = (unsigned)(R * K + C) * 2u; voffB[i] = (unsigned)(Rb * K + C) * 2u; }
    const size_t kstep = (size_t)(BK * 2);
    const size_t hstep = (size_t)HALF * K * 2;
    const size_t tstep = 2 * hstep;
    const unsigned ldsw = (unsigned)wid * 1024u;
    const int aoff = lds_byte(wr * 64 + fr, fq * 8), boff = lds_byte(wc * 32 + fr, fq * 8);
#define PG8_SA(b, h) (((b) * 2 + (h)) * HTB)
#define PG8_SB(b, h) ((4 + (b) * 2 + (h)) * HTB)
#define PG8_STAGE(bufoff, gbase, voff) do { _Pragma("unroll") for (int _i = 0; _i < 2; ++_i) \
        __builtin_amdgcn_global_load_lds((const unsigned*)((const char*)(gbase) + (voff)[_i]), (PG8_LAS unsigned*)(lds + (bufoff) + ldsw + _i * 8192), 16, 0, 0); } while (0)
#define PG8_LDA(dst, b, h) do { _Pragma("unroll") for (int m = 0; m < 4; ++m) _Pragma("unroll") for (int k = 0; k < 2; ++k) dst[m][k] = *(const PG8_LAS bf16x8*)(lds + PG8_SA(b, h) + aoff + m * 2048 + k * 1024); } while (0)
#define PG8_LDB(dst, b, h) do { _Pragma("unroll") for (int n = 0; n < 2; ++n) _Pragma("unroll") for (int k = 0; k < 2; ++k) dst[n][k] = *(const PG8_LAS bf16x8*)(lds + PG8_SB(b, h) + boff + n * 2048 + k * 1024); } while (0)
#define PG8_MMA(ai, bj, At, Bt) do { __builtin_amdgcn_s_setprio(1); _Pragma("unroll") for (int m = 0; m < 4; ++m) _Pragma("unroll") for (int n = 0; n < 2; ++n) _Pragma("unroll") for (int k = 0; k < 2; ++k) \
        acc[ai][bj][m][n] = __builtin_amdgcn_mfma_f32_16x16x32_bf16(Bt[n][k], At[m][k], acc[ai][bj][m][n], 0, 0, 0); __builtin_amdgcn_s_setprio(0); } while (0)
#define PG8_WAIT_V(n) asm volatile("s_waitcnt vmcnt(" #n ")" ::: "memory")
#define PG8_WAIT_L(n) asm volatile("s_waitcnt lgkmcnt(" #n ")" ::: "memory")
#define PG8_BAR __builtin_amdgcn_s_barrier()
#define PG8_SCHED __builtin_amdgcn_sched_barrier(0)
    Unit cur, nxt; int ui = 0;
    if (!S.next(0, cur)) return;
    f32x4 acc[2][2][4][2];
#pragma unroll
    for (int a = 0; a < 2; ++a)
#pragma unroll
        for (int b = 0; b < 2; ++b)
#pragma unroll
            for (int m = 0; m < 4; ++m)
#pragma unroll
                for (int n = 0; n < 2; ++n) acc[a][b][m][n] = (f32x4){0.f, 0.f, 0.f, 0.f};
    bf16x8 At[4][2], B0[2][2], B1[2][2];
    const char* cA = (const char*)g.A + (size_t)cur.pm * tstep; const char* cB = (const char*)g.Bt + (size_t)cur.pn * tstep;
    S.a_ready(cur);
    if constexpr (SP2) {
        PG8_STAGE(PG8_SB(0, 0), cB, voffB); PG8_STAGE(PG8_SB(0, 1), cB + hstep, voffB); PG8_STAGE(PG8_SA(0, 0), cA, voffA); PG8_STAGE(PG8_SA(0, 1), cA + hstep, voffA);
        if (wr == 1) PG8_BAR;
        PG8_WAIT_V(2); PG8_BAR;
        PG8_STAGE(PG8_SB(1, 0), cB + kstep, voffB); PG8_STAGE(PG8_SA(1, 0), cA + kstep, voffA); PG8_STAGE(PG8_SB(1, 1), cB + hstep + kstep, voffB);
        PG8_WAIT_V(6); PG8_BAR;
    } else {
        PG8_STAGE(PG8_SB(0, 0), cB, voffB); PG8_STAGE(PG8_SA(0, 0), cA, voffA); PG8_STAGE(PG8_SB(0, 1), cB + hstep, voffB); PG8_STAGE(PG8_SA(0, 1), cA + hstep, voffA);
        if (wr == 1) PG8_BAR;
        PG8_WAIT_V(4); PG8_BAR;
        PG8_STAGE(PG8_SB(1, 0), cB + kstep, voffB); PG8_STAGE(PG8_SA(1, 0), cA + kstep, voffA); PG8_STAGE(PG8_SB(1, 1), cB + hstep + kstep, voffB);
        PG8_WAIT_V(6); PG8_BAR;
    }
    for (;;) {
        const bool has_next = S.next(ui + 1, nxt);
        const char* nA = has_next ? (const char*)g.A + (size_t)nxt.pm * tstep : cA; const char* nB = has_next ? (const char*)g.Bt + (size_t)nxt.pn * tstep : cB;
        for (int t = 0; t < nt; t += 2) {
            const bool last = (t == nt - 2);
            const char* a1 = cA + (size_t)(t + 1) * kstep;
            const char* a2 = last ? nA : cA + (size_t)(t + 2) * kstep; const char* b2 = last ? nB : cB + (size_t)(t + 2) * kstep;
            const char* a3 = a2 + kstep; const char* b3 = b2 + kstep;
            if (last && has_next) S.a_ready(nxt);
            if constexpr (SP2) {
            PG8_LDB(B0, 0, 0); PG8_LDB(B1, 0, 1); PG8_SCHED; PG8_LDA(At, 0, 0); PG8_STAGE(PG8_SA(1, 1), a1 + hstep, voffA);
            PG8_WAIT_V(8); PG8_WAIT_L(0); PG8_BAR; PG8_MMA(0, 0, At, B0); PG8_MMA(0, 1, At, B1); PG8_BAR; PG8_SCHED;
            PG8_LDA(At, 0, 1); PG8_STAGE(PG8_SB(0, 0), b2, voffB); PG8_STAGE(PG8_SB(0, 1), b2 + hstep, voffB); PG8_STAGE(PG8_SA(0, 0), a2, voffA);
            PG8_WAIT_V(8); PG8_WAIT_L(0); PG8_BAR; PG8_MMA(1, 0, At, B0); PG8_MMA(1, 1, At, B1); PG8_BAR; PG8_SCHED;
            PG8_LDB(B0, 1, 0); PG8_LDB(B1, 1, 1); PG8_SCHED; PG8_LDA(At, 1, 0); PG8_STAGE(PG8_SA(0, 1), a2 + hstep, voffA);
            PG8_WAIT_V(8); PG8_WAIT_L(0); PG8_BAR; PG8_MMA(0, 0, At, B0); PG8_MMA(0, 1, At, B1); PG8_BAR; PG8_SCHED;
            PG8_LDA(At, 1, 1); PG8_STAGE(PG8_SB(1, 0), b3, voffB); PG8_STAGE(PG8_SB(1, 1), b3 + hstep, voffB); PG8_STAGE(PG8_SA(1, 0), a3, voffA);
            PG8_WAIT_V(8); PG8_WAIT_L(0); PG8_BAR; PG8_MMA(1, 0, At, B0); PG8_MMA(1, 1, At, B1); PG8_BAR; PG8_SCHED;
            } else {
            PG8_LDB(B0, 0, 0); PG8_SCHED; PG8_LDA(At, 0, 0); PG8_STAGE(PG8_SA(1, 1), a1 + hstep, voffA);
            PG8_WAIT_L(8); PG8_BAR; PG8_WAIT_L(0); PG8_MMA(0, 0, At, B0); PG8_BAR; PG8_SCHED;
            PG8_LDB(B1, 0, 1); PG8_STAGE(PG8_SB(0, 0), b2, voffB);
            PG8_BAR; PG8_WAIT_L(0); PG8_MMA(0, 1, At, B1); PG8_BAR;
            PG8_LDA(At, 0, 1); PG8_STAGE(PG8_SA(0, 0), a2, voffA);
            PG8_BAR; PG8_WAIT_L(0); PG8_MMA(1, 0, At, B0); PG8_BAR; PG8_SCHED;
            PG8_STAGE(PG8_SB(0, 1), b2 + hstep, voffB);
            PG8_WAIT_V(6); PG8_BAR; PG8_MMA(1, 1, At, B1); PG8_BAR;
            PG8_LDB(B0, 1, 0); PG8_SCHED; PG8_LDA(At, 1, 0); PG8_STAGE(PG8_SA(0, 1), a2 + hstep, voffA);
            PG8_WAIT_L(8); PG8_BAR; PG8_WAIT_L(0); PG8_MMA(0, 0, At, B0); PG8_BAR; PG8_SCHED;
            PG8_LDB(B1, 1, 1); PG8_STAGE(PG8_SB(1, 0), b3, voffB);
            PG8_BAR; PG8_WAIT_L(0); PG8_MMA(0, 1, At, B1); PG8_BAR;
            PG8_LDA(At, 1, 1); PG8_STAGE(PG8_SA(1, 0), a3, voffA);
            PG8_BAR; PG8_WAIT_L(0); PG8_MMA(1, 0, At, B0); PG8_BAR; PG8_SCHED;
            PG8_STAGE(PG8_SB(1, 1), b3 + hstep, voffB);
            PG8_WAIT_V(6); PG8_BAR; PG8_MMA(1, 1, At, B1); PG8_BAR;
            }
        }
        if constexpr (ALIGN_EPI) { if (wr == 0) PG8_BAR; }
        E(acc, cur, wr, wc, fr, fq); S.done(cur);
        if (!has_next) break;
#pragma unroll
        for (int a = 0; a < 2; ++a)
#pragma unroll
            for (int b = 0; b < 2; ++b)
#pragma unroll
                for (int m = 0; m < 4; ++m)
#pragma unroll
                    for (int n = 0; n < 2; ++n) acc[a][b][m][n] = (f32x4){0.f, 0.f, 0.f, 0.f};
        cur = nxt; cA = nA; cB = nB; ++ui;
        if constexpr (ALIGN_EPI) { if (wr == 1) PG8_BAR; }
    }
    PG8_WAIT_V(0);
    if constexpr (!ALIGN_EPI) { if (wr == 0) PG8_BAR; }
    PG8_BAR;
#undef PG8_SA
#undef PG8_SB
#undef PG8_STAGE
#undef PG8_LDA
#undef PG8_LDB
#undef PG8_MMA
#undef PG8_WAIT_V
#undef PG8_WAIT_L
#undef PG8_BAR
#undef PG8_SCHED
}
}

using pg8::bf16_t; using pg8::bf16x8; using pg8::f32x4;

constexpr int MT = 24576, DM = 1024, DFF = 2816, NCTX = 8192;
constexpr int UW = 3984;
constexpr int NCOND = 9, MODW = 9216;
constexpr size_t MiB = 1ull << 20;
constexpr size_t WS_A = 0, WS_U = 48 * MiB, WS_W1 = WS_U + 132 * MiB, WS_W1B = WS_W1 + (size_t)5632 * 1024 * 2,
                 WS_BT3 = 235 * MiB, WS_HB2 = 235 * MiB  ,
                 WS_BT4 = 251 * MiB, WS_MOD = 253 * MiB, WS_CTR = WS_MOD + 9 * 9216 * 4  , WS_BAR = WS_CTR + 256  , WS_GATES = 254 * MiB;
constexpr size_t WS_A2BF = 255 * MiB + 512 * 1024, WS_G2BF = WS_A2BF + 2 * 512 * 64 * 2;
constexpr int OUT_C = 25165824, OUT_N = 29360128, OUT_MM = 29392896, OUT_S = 29393152;
constexpr int LDS_BYTES = 163840;
constexpr int NTHR = 512;

struct P {
    const float *xp, *xs, *c, *sC, *sn, *sm, *sS, *cctx, *ada_w, *ada_b, *n1, *w1in, *w1out, *nmix, *wmin, *wmout,
        *cw, *cb, *gb, *hg, *mu, *w0, *w2, *a0, *a2, *g2, *kk, *ka, *rk, *lng, *lnb, *n2, *w2in, *w2out, *nf;
    float* out; unsigned char* ws;
};

__device__ __forceinline__ unsigned short f2bf(float f) { unsigned u = __float_as_uint(f); u += 0x7FFFu + ((u >> 16) & 1u); return (unsigned short)(u >> 16); }
__device__ __forceinline__ float bf2f(unsigned short b) { return __uint_as_float(((unsigned)b) << 16); }
__device__ __forceinline__ unsigned pk2(float a, float b) { return (unsigned)f2bf(a) | ((unsigned)f2bf(b) << 16); }
__device__ __forceinline__ int cond_of(int row) { return row < NCTX ? 0 : 1 + ((row - NCTX) >> 11); }
__device__ __forceinline__ float fexp(float x) { return __builtin_amdgcn_exp2f(x * 1.4426950408889634f); }
__device__ __forceinline__ float flog(float x) { return __builtin_amdgcn_logf(x) * 0.6931471805599453f; }
__device__ __forceinline__ float siluf(float x) { return x * __builtin_amdgcn_rcpf(1.f + fexp(-x)); }
__device__ __forceinline__ float sigmf(float x) { return __builtin_amdgcn_rcpf(1.f + fexp(-x)); }
__device__ __forceinline__ float tanh_fast(float x) { return 1.f - 2.f * __builtin_amdgcn_rcpf(1.f + fexp(2.f * x)); }
__device__ __forceinline__ float softplus_fast(float z) { return fmaxf(z, 0.f) + flog(1.f + fexp(-fabsf(z))); }
__device__ __forceinline__ const float* xrow(const P& p, int row) { return row < NCTX ? p.xp + (size_t)row * DM : p.xs + (size_t)(row - NCTX) * DM; }
__device__ __forceinline__ f32x4 mfma16(bf16x8 a, bf16x8 b, f32x4 c) { return __builtin_amdgcn_mfma_f32_16x16x32_bf16(a, b, c, 0, 0, 0); }
__device__ __forceinline__ void unpack8(uint4 v, float* f) {
    f[0] = __uint_as_float(v.x << 16); f[1] = __uint_as_float(v.x & 0xffff0000u); f[2] = __uint_as_float(v.y << 16); f[3] = __uint_as_float(v.y & 0xffff0000u);
    f[4] = __uint_as_float(v.z << 16); f[5] = __uint_as_float(v.z & 0xffff0000u); f[6] = __uint_as_float(v.w << 16); f[7] = __uint_as_float(v.w & 0xffff0000u);
}

__device__ __forceinline__ int colmap(int kind, int n) {
    if (kind == 0) return n;
    if (kind == 1) { const int t = n >> 8, bj = (n >> 7) & 1, c = n & 127; return bj * DFF + t * 128 + c; }
    if (n < 2048) return n; if (n < 3968) return n + 16; if (n < 3984) return n - 3968 + 2048; return -1;
}
__device__ void convert_tile(const float* __restrict__ src, bf16_t* __restrict__ dst, int K, int Nsrc, int kind, int k0, int n0, float* tile) {
    const int tid = opaque_tid();
    { const int n = tid & 63, kr = tid >> 6; const int sc = colmap(kind, n0 + n);
#pragma unroll
      for (int i = 0; i < 8; ++i) { const int k = kr + 8 * i; tile[k * 65 + n] = sc >= 0 ? src[(size_t)(k0 + k) * Nsrc + sc] : 0.f; } }
    __syncthreads();
    { const int nn = tid >> 3, kg = tid & 7; unsigned w[4];
#pragma unroll
      for (int j = 0; j < 4; ++j) w[j] = pk2(tile[(kg * 8 + 2 * j) * 65 + nn], tile[(kg * 8 + 2 * j + 1) * 65 + nn]);
      *(uint4*)(dst + (size_t)(n0 + nn) * K + k0 + kg * 8) = make_uint4(w[0], w[1], w[2], w[3]); }
    __syncthreads();
}
__device__ void convert_jobs(const P& p, int first, int njobs_sel, unsigned char* lds, int item0, int nitems_before) {}

__device__ void do_convert(const float* src, bf16_t* dst, int K, int Nsrc, int Ndst, int kind, int t, float* tile) {
    const int nkt = K / 64; const int kt = t % nkt, ntile = t / nkt; (void)Ndst;
    convert_tile(src, dst, K, Nsrc, kind, kt * 64, ntile * 64, tile);
}

__device__ void phase0(const P& p, unsigned char* lds) {
    float* tile = (float*)lds;
    const int tid = opaque_tid();
    const int n_ada = 36 * 8;
    const int t1 = 16 * 88, t2 = 44 * 16, t3 = 16 * 64, t4 = 16 * 16, t5 = 8, t6 = 8, t7 = 16;
    const int total = n_ada + t1 + t2 + t3 + t4 + t5 + t6 + t7;
    for (int it = blockIdx.x; it < total; it += gridDim.x) {
        if (it < n_ada) {
            const int cgp = it % 36, kc = it / 36;
            float* sc = tile;
            __syncthreads();
            for (int i = tid; i < NCOND * 128; i += NTHR) { const int c = i >> 7, k = i & 127; const float v = c == 0 ? p.cctx[kc * 128 + k] : p.c[(c - 1) * DM + kc * 128 + k]; sc[i] = siluf(v); }
            __syncthreads();
            const int col = cgp * 256 + (tid & 255), kh = tid >> 8;
            float acc[NCOND];
#pragma unroll
            for (int c = 0; c < NCOND; ++c) acc[c] = 0.f;
            const float* w = p.ada_w + (size_t)(kc * 128 + kh * 64) * MODW + col;
#pragma unroll 4
            for (int k = 0; k < 64; ++k) { const float wv = w[(size_t)k * MODW];
#pragma unroll
                for (int c = 0; c < NCOND; ++c) acc[c] += sc[c * 128 + kh * 64 + k] * wv; }
            float* mod = (float*)(p.ws + WS_MOD);
            const float bias = (kc == 0 && kh == 0) ? p.ada_b[col] : 0.f;
#pragma unroll
            for (int c = 0; c < NCOND; ++c) atomicAdd(mod + c * MODW + col, acc[c] + bias);
            __syncthreads();
        } else {
            int t = it - n_ada;
            if (t < t1) do_convert(p.w1in, (bf16_t*)(p.ws + WS_W1), 1024, 5632, 5632, 1, t, tile);
            else if ((t -= t1) < t2) do_convert(p.w1out, (bf16_t*)(p.ws + WS_W1B), 2816, 1024, 1024, 0, t, tile);
            else if ((t -= t2) < t3) do_convert(p.wmin, (bf16_t*)(p.ws + WS_BT3), 1024, 3984, 4096, 2, t, tile);
            else if ((t -= t3) < t4) do_convert(p.wmout, (bf16_t*)(p.ws + WS_BT4), 1024, 1024, 1024, 0, t, tile);
            else if ((t -= t4) < t5) do_convert(p.a2, (bf16_t*)(p.ws + WS_A2BF), 64, 512, 512, 0, t, tile);
            else if ((t -= t5) < t6) do_convert(p.a2 + 64 * 512, (bf16_t*)(p.ws + WS_A2BF) + 512 * 64, 64, 512, 512, 0, t, tile);
            else { t -= t6; do_convert(p.g2, (bf16_t*)(p.ws + WS_G2BF), 128, 512, 512, 0, t, tile); }
        }
    }
}

__device__ void phase_normmod(const P& p, int which) {
    const int lane = opaque_tid() & 63, wave = threadIdx.x >> 6;
    const float* gain = which == 0 ? p.n1 : (which == 1 ? p.nmix : p.n2);
    const float* mod = (const float*)(p.ws + WS_MOD);
    bf16_t* A = (bf16_t*)(p.ws + WS_A);
    for (int row = blockIdx.x * 8 + wave; row < MT; row += gridDim.x * 8) {
        const float* src = which == 0 ? xrow(p, row) : p.out + (size_t)row * DM;
        float4 v[4]; float ss = 0.f;
#pragma unroll
        for (int i = 0; i < 4; ++i) { v[i] = *(const float4*)(src + lane * 4 + 256 * i); ss += v[i].x * v[i].x + v[i].y * v[i].y + v[i].z * v[i].z + v[i].w * v[i].w; }
#pragma unroll
        for (int o = 32; o >= 1; o >>= 1) ss += __shfl_xor(ss, o);
        const float rstd = rsqrtf(ss * (1.f / 1024.f) + 1e-6f);
        const float* sh = mod + cond_of(row) * MODW + which * 3072; const float* sc = sh + 1024;
#pragma unroll
        for (int i = 0; i < 4; ++i) { const int col = lane * 4 + 256 * i;
            const float4 g = *(const float4*)(gain + col), s4 = *(const float4*)(sh + col), c4 = *(const float4*)(sc + col);
            const float o0 = v[i].x * rstd * g.x * (1.f + c4.x) + s4.x, o1 = v[i].y * rstd * g.y * (1.f + c4.y) + s4.y,
                        o2 = v[i].z * rstd * g.z * (1.f + c4.z) + s4.z, o3 = v[i].w * rstd * g.w * (1.f + c4.w) + s4.w;
            *(uint2*)(A + (size_t)row * DM + col) = make_uint2(pk2(o0, o1), pk2(o2, o3)); }
    }
}
__device__ void phase_finalnorm(const P& p) {
    const int lane = opaque_tid() & 63, wave = threadIdx.x >> 6;
    for (int row = blockIdx.x * 8 + wave; row < MT; row += gridDim.x * 8) {
        float* src = p.out + (size_t)row * DM;
        float4 v[4]; float ss = 0.f;
#pragma unroll
        for (int i = 0; i < 4; ++i) { v[i] = *(const float4*)(src + lane * 4 + 256 * i); ss += v[i].x * v[i].x + v[i].y * v[i].y + v[i].z * v[i].z + v[i].w * v[i].w; }
#pragma unroll
        for (int o = 32; o >= 1; o >>= 1) ss += __shfl_xor(ss, o);
        const float rstd = rsqrtf(ss * (1.f / 1024.f) + 1e-6f);
#pragma unroll
        for (int i = 0; i < 4; ++i) { const int col = lane * 4 + 256 * i; const float4 g = *(const float4*)(p.nf + col);
            *(float4*)(src + col) = make_float4(v[i].x * rstd * g.x, v[i].y * rstd * g.y, v[i].z * rstd * g.z, v[i].w * rstd * g.w); }
    }
}

struct EpiSwiglu {
    static constexpr bool PERM = true;
    bf16_t* O;
    __device__ __forceinline__ void operator()(const f32x4 (&acc)[2][2][4][2], const pg8::Unit& u, int wr, int wc, int fr, int fq) const {
        const int row0 = u.pm * 256 + wr * 64 + fr, col0 = u.pn * 128 + wc * 32 + 8 * fq;
#pragma unroll
        for (int ai = 0; ai < 2; ++ai)
#pragma unroll
            for (int m = 0; m < 4; ++m) { bf16_t* rowp = O + (size_t)(row0 + ai * 128 + m * 16) * DFF + col0;
                float r[8];
#pragma unroll
                for (int n = 0; n < 2; ++n)
#pragma unroll
                    for (int j = 0; j < 4; ++j) r[n * 4 + j] = siluf(acc[ai][0][m][n][j]) * acc[ai][1][m][n][j];
                pg8::u32x4 w; w.x = pg8::cvt_pk_bf16(r[0], r[1]); w.y = pg8::cvt_pk_bf16(r[2], r[3]); w.z = pg8::cvt_pk_bf16(r[4], r[5]); w.w = pg8::cvt_pk_bf16(r[6], r[7]);
                *(pg8::u32x4*)rowp = w; }
    }
};
struct EpiResid {
    static constexpr bool PERM = false;
    const float* xp; const float* xs; float* out; const float* ga; float coef; int inplace;
    __device__ __forceinline__ void operator()(const f32x4 (&acc)[2][2][4][2], const pg8::Unit& u, int wr, int wc, int fr, int fq) const {
        const int row0 = u.pm * 256 + wr * 64 + fr, col0 = u.pn * 256 + wc * 32 + 4 * fq;
        const float* gap = ga + cond_of(u.pm * 256) * MODW;
        f32x4 gv[2][2];
#pragma unroll
        for (int bj = 0; bj < 2; ++bj)
#pragma unroll
            for (int n = 0; n < 2; ++n) gv[bj][n] = *(const f32x4*)(gap + col0 + bj * 128 + n * 16) * coef;
#pragma unroll
        for (int ai = 0; ai < 2; ++ai)
#pragma unroll
            for (int m = 0; m < 4; ++m) { const int row = row0 + ai * 128 + m * 16;
                const float* base = inplace ? out + (size_t)row * DM : (row < NCTX ? xp + (size_t)row * DM : xs + (size_t)(row - NCTX) * DM);
                float* op = out + (size_t)row * DM;
#pragma unroll
                for (int bj = 0; bj < 2; ++bj)
#pragma unroll
                    for (int n = 0; n < 2; ++n) { const int c = col0 + bj * 128 + n * 16; const f32x4 b4 = *(const f32x4*)(base + c);
                        *(f32x4*)(op + c) = b4 + gv[bj][n] * acc[ai][bj][m][n]; } }
    }
};
struct EpiU {
    static constexpr bool PERM = true;
    bf16_t* U; float* gates;
    __device__ __forceinline__ void operator()(const f32x4 (&acc)[2][2][4][2], const pg8::Unit& u, int wr, int wc, int fr, int fq) const {
        const int row0 = u.pm * 256 + wr * 64 + fr;
#pragma unroll
        for (int bj = 0; bj < 2; ++bj) { const int col0 = u.pn * 256 + bj * 128 + wc * 32 + 8 * fq;
            if (col0 < UW) {
#pragma unroll
                for (int ai = 0; ai < 2; ++ai)
#pragma unroll
                    for (int m = 0; m < 4; ++m) { const int row = row0 + ai * 128 + m * 16; const f32x4 v0 = acc[ai][bj][m][0], v1 = acc[ai][bj][m][1];
                        pg8::u32x4 w; w.x = pg8::cvt_pk_bf16(v0[0], v0[1]); w.y = pg8::cvt_pk_bf16(v0[2], v0[3]); w.z = pg8::cvt_pk_bf16(v1[0], v1[1]); w.w = pg8::cvt_pk_bf16(v1[2], v1[3]);
                        *(pg8::u32x4*)(U + (size_t)row * UW + col0) = w;
                        if (col0 >= 3968) { float* gp = gates + (size_t)row * 16 + (col0 - 3968); *(f32x4*)gp = v0; *(f32x4*)(gp + 4) = v1; } } } }
    }
};

template <class Epi>
__device__ __forceinline__ void run_gemm(unsigned char* lds, const bf16_t* A, const bf16_t* Bt, int N, int K, const Epi& E) {
    pg8::Gemm g{A, Bt, MT, N, K}; pg8::StaticOrder S; S.init(MT, N, (int)gridDim.x, (int)blockIdx.x);
    pg8::gemm_phase<Epi, pg8::StaticOrder, true, true>((PG8_LAS unsigned char*)lds, g, S, E);
}

constexpr int ML_SK = 0, ML_KWT = 17408, ML_VT = ML_KWT + 18432, ML_CB = ML_VT + 20736, ML_F = ML_CB + 21760, ML_CW = ML_F + 2048, ML_END = ML_CW + 4096;
static_assert(ML_END <= LDS_BYTES, "mlstm lds");

__device__ __forceinline__ unsigned short ld_u16_agent(const bf16_t* p) { return __hip_atomic_load(p, __ATOMIC_RELAXED, __HIP_MEMORY_SCOPE_AGENT); }

__device__ __forceinline__ void conv3_row8(const bf16_t* up, bool hasp, bool hasn, const float* cwp, float* x) {
    float t[8];
    unpack8(*(const uint4*)up, t);
#pragma unroll
    for (int i = 0; i < 8; ++i) x[i] = cwp[768 + i] + cwp[256 + i] * t[i];
    if (hasp) { unpack8(*(const uint4*)(up - UW), t);
#pragma unroll
        for (int i = 0; i < 8; ++i) x[i] += cwp[i] * t[i]; }
    if (hasn) { unpack8(*(const uint4*)(up + UW), t);
#pragma unroll
        for (int i = 0; i < 8; ++i) x[i] += cwp[512 + i] * t[i]; }
}

__device__ __forceinline__ void mlstm_task(const P& p, unsigned char* lds, int bg, int h, int dsel) {
    const int wv = __builtin_amdgcn_readfirstlane((int)threadIdx.x >> 6), rw = wv & 3, cw = wv >> 2;
    const bool ctx = bg < 32; const int T = ctx ? 256 : 2048, nc = T / 64; const int row0 = ctx ? bg * 256 : NCTX + (bg - 32) * 2048;
    bf16_t* sK = (bf16_t*)(lds + ML_SK); bf16_t* sKwT = (bf16_t*)(lds + ML_KWT); bf16_t* sVT = (bf16_t*)(lds + ML_VT); bf16_t* sCb = (bf16_t*)(lds + ML_CB); bf16_t* sS = sCb;
    float* sA = (float*)(lds + ML_F); float* sM = sA + 64; float* sBb = sM + 64; float* sDen = sBb + 64; float* sScal = sDen + 64; float* sRed = sScal + 16;
    float* sCW = (float*)(lds + ML_CW);
    const bf16_t* U = (const bf16_t*)(p.ws + WS_U); const float* GATES = (const float*)(p.ws + WS_GATES); bf16_t* HB = (bf16_t*)(p.ws + WS_A); bf16_t* HB2 = (bf16_t*)(p.ws + WS_HB2);
    const int d_lo = dsel < 0 ? 0 : dsel, d_hi = dsel < 0 ? 2 : dsel + 1;
    const int ct_a = cw ? 3 : 0;
    const int ct_b = cw ? 7 : 5;
    const int n_a = cw ? 2 : 3;

    __syncthreads();
    { const int tid = threadIdx.x;
      for (int i = tid; i < 1024; i += NTHR) { const int a = i >> 8, cc = i & 255, gch = (cc >> 7) * 512 + h * 128 + (cc & 127); sCW[i] = a < 3 ? p.cw[a * 1024 + gch] : p.cb[gch]; }
      for (int i = tid; i < 16 * 72; i += NTHR) { const int r = 128 + i / 72; sVT[r * 72 + (i % 72)] = (r == 128) ? (bf16_t)0x3F80 : (bf16_t)0; } }

#pragma unroll 1
    for (int dir = d_lo; dir < d_hi; ++dir) {
        f32x4 Cacc[9]; float m_prev = 0.f;
        { int z0 = 0; asm volatile("" : "+v"(z0)); const int tid = (int)threadIdx.x + z0, fr = tid & 15, fq = (tid >> 4) & 3;
#pragma unroll
          for (int ct = 0; ct < 9; ++ct) Cacc[ct] = (f32x4){0.f, 0.f, 0.f, 0.f};
          if (!ctx) { const int sidx = ((bg - 32) * 2 + dir) * 4 + h; const float* C0 = p.sC + (size_t)sidx * 16384; const float* n0 = p.sn + (size_t)sidx * 128;
#pragma unroll
              for (int j = 0; j < 4; ++j) { const int d = 16 * wv + 4 * fq + j;
#pragma unroll
                  for (int ct = 0; ct < 8; ++ct) Cacc[ct][j] = C0[d * 128 + 16 * ct + fr];
                  Cacc[8][j] = fr == 0 ? n0[d] : 0.f; }
              m_prev = p.sm[sidx]; } }
        const float gbi = p.gb[dir * 4 + h], gbf = p.gb[8 + dir * 4 + h];
        const bool second = dsel < 0 && dir == 1;
#pragma unroll 1
        for (int s = 0; s < nc; ++s) {
            const int c = dir ? nc - 1 - s : s;
            int zz = 0; asm volatile("" : "+v"(zz));
            const int tid = (int)threadIdx.x + zz, lane = tid & 63, fr = tid & 15, fq = (tid >> 4) & 3;
            uint4 kc[2], kp[2], kn[2], vv[2];
#pragma unroll
            for (int g = 0; g < 2; ++g) { const int idx = tid + 512 * g, sl = idx >> 4, d0 = (idx & 15) * 8; const int tl = dir ? 63 - sl : sl, tok = c * 64 + tl;
                const bf16_t* up = U + ((size_t)row0 + tok) * UW + 512 + h * 128 + d0;
                kc[g] = *(const uint4*)up; kp[g] = make_uint4(0u, 0u, 0u, 0u); kn[g] = kp[g];
                if (tok > 0) kp[g] = *(const uint4*)(up - UW);
                if (tok < T - 1) kn[g] = *(const uint4*)(up + UW);
                vv[g] = *(const uint4*)(up + 512); }
            LDS_BARRIER();
            if (wv == 0) {
                const int tl = dir ? 63 - lane : lane; const size_t row = (size_t)row0 + c * 64 + tl;
                const float ip = GATES[row * 16 + dir * 4 + h] + gbi, fp = GATES[row * 16 + 8 + dir * 4 + h] + gbf;
                const float lf = -softplus_fast(-fp);
                float bs = lf;
#pragma unroll
                for (int o = 1; o < 64; o <<= 1) { const float t = __shfl_up(bs, o); if (lane >= o) bs += t; }
                const float a = ip - bs; float pm = a;
#pragma unroll
                for (int o = 1; o < 64; o <<= 1) { const float t = __shfl_up(pm, o); if (lane >= o) pm = fmaxf(pm, t); }
                const float Mt = fmaxf(m_prev, pm);
                sA[lane] = a; sM[lane] = Mt; sBb[lane] = bs;
                if (lane == 63) { sScal[0] = Mt; sScal[1] = bs; }
            }
            LDS_BARRIER();
            const float M63 = sScal[0], bL = sScal[1];
            uint4 qc[4], qp[4], qn[4];
            { const int t_ = 16 * rw + fr, tl = dir ? 63 - t_ : t_, tok = c * 64 + tl; const bf16_t* up = U + ((size_t)row0 + tok) * UW + h * 128 + 8 * fq;
#pragma unroll
              for (int kk = 0; kk < 4; ++kk) { qc[kk] = *(const uint4*)(up + 32 * kk); qp[kk] = make_uint4(0u, 0u, 0u, 0u); qn[kk] = qp[kk];
                  if (tok > 0) qp[kk] = *(const uint4*)(up + 32 * kk - UW);
                  if (tok < T - 1) qn[kk] = *(const uint4*)(up + 32 * kk + UW); } }
#pragma unroll
            for (int g = 0; g < 2; ++g) {
                const int idx = tid + 512 * g, sl = idx >> 4, d0 = (idx & 15) * 8;
                const float wk = fexp(sA[sl] - M63);
                const float* cwp = sCW + 128 + d0;
                float kv[8], t[8];
                unpack8(kc[g], t);
#pragma unroll
                for (int i = 0; i < 8; ++i) kv[i] = cwp[768 + i] + cwp[256 + i] * t[i];
                unpack8(kp[g], t);
#pragma unroll
                for (int i = 0; i < 8; ++i) kv[i] += cwp[i] * t[i];
                unpack8(kn[g], t);
#pragma unroll
                for (int i = 0; i < 8; ++i) kv[i] += cwp[512 + i] * t[i];
#pragma unroll
                for (int i = 0; i < 8; ++i) kv[i] = siluf(kv[i]) * 0.08838834764831845f;
                *(uint4*)(sK + sl * 136 + d0) = make_uint4(pk2(kv[0], kv[1]), pk2(kv[2], kv[3]), pk2(kv[4], kv[5]), pk2(kv[6], kv[7]));
#pragma unroll
                for (int i = 0; i < 8; ++i) sKwT[(d0 + i) * 72 + sl] = f2bf(kv[i] * wk);
                const unsigned vw[4] = {vv[g].x, vv[g].y, vv[g].z, vv[g].w};
#pragma unroll
                for (int i = 0; i < 8; ++i) sVT[(d0 + i) * 72 + sl] = (bf16_t)((vw[i >> 1] >> ((i & 1) * 16)) & 0xffffu);
            }
            bf16x8 qf[4];
#pragma unroll
            for (int kk = 0; kk < 4; ++kk) { const float* cwp = sCW + 32 * kk + 8 * fq; float qv[8], t[8];
                unpack8(qc[kk], t);
#pragma unroll
                for (int i = 0; i < 8; ++i) qv[i] = cwp[768 + i] + cwp[256 + i] * t[i];
                unpack8(qp[kk], t);
#pragma unroll
                for (int i = 0; i < 8; ++i) qv[i] += cwp[i] * t[i];
                unpack8(qn[kk], t);
#pragma unroll
                for (int i = 0; i < 8; ++i) qv[i] += cwp[512 + i] * t[i];
#pragma unroll
                for (int i = 0; i < 8; ++i) qv[i] = siluf(qv[i]);
                union { uint4 u; bf16x8 v; } cv; cv.u = make_uint4(pk2(qv[0], qv[1]), pk2(qv[2], qv[3]), pk2(qv[4], qv[5]), pk2(qv[6], qv[7])); qf[kk] = cv.v; }
            f32x4 num[5];
#pragma unroll
            for (int k = 0; k < 5; ++k) num[k] = (f32x4){0.f, 0.f, 0.f, 0.f};
#pragma unroll
            for (int ci = 0; ci < 5; ++ci) { const f32x4 v = Cacc[ci]; *(uint2*)(sCb + (16 * ci + fr) * 136 + 16 * wv + 4 * fq) = make_uint2(pk2(v[0], v[1]), pk2(v[2], v[3])); }
            LDS_BARRIER();
#pragma unroll
            for (int k = 0; k < 3; ++k) if (k < n_a) {
#pragma unroll
                for (int kk = 0; kk < 4; ++kk) { const bf16x8 b = *(const bf16x8*)(sCb + (16 * (ct_a + k) + fr) * 136 + 32 * kk + 8 * fq); num[k] = mfma16(qf[kk], b, num[k]); } }
            LDS_BARRIER();
#pragma unroll
            for (int ci = 0; ci < 4; ++ci) { const f32x4 v = Cacc[5 + ci]; *(uint2*)(sCb + (16 * ci + fr) * 136 + 16 * wv + 4 * fq) = make_uint2(pk2(v[0], v[1]), pk2(v[2], v[3])); }
            LDS_BARRIER();
#pragma unroll
            for (int k = 3; k < 5; ++k) {
#pragma unroll
                for (int kk = 0; kk < 4; ++kk) { const bf16x8 b = *(const bf16x8*)(sCb + (16 * (ct_b + k - 3 - 5) + fr) * 136 + 32 * kk + 8 * fq); num[k] = mfma16(qf[kk], b, num[k]); } }
            {
                float scv[4];
#pragma unroll
                for (int j = 0; j < 4; ++j) scv[j] = fexp(m_prev - sM[16 * rw + 4 * fq + j]);
#pragma unroll
                for (int k = 0; k < 5; ++k)
#pragma unroll
                    for (int j = 0; j < 4; ++j) num[k][j] *= scv[j];
            }
            LDS_BARRIER();
#pragma unroll
            for (int si = 0; si < 2; ++si) { const int st = 2 * cw + si;
                f32x4 sacc = (f32x4){0.f, 0.f, 0.f, 0.f};
                if (st <= rw) {
#pragma unroll
                    for (int kk = 0; kk < 4; ++kk) { const bf16x8 b = *(const bf16x8*)(sK + (16 * st + fr) * 136 + 32 * kk + 8 * fq); sacc = mfma16(qf[kk], b, sacc); } }
                const int sp = 16 * st + fr; const float as = sA[sp];
#pragma unroll
                for (int j = 0; j < 4; ++j) { const int tp = 16 * rw + 4 * fq + j; const float val = (sp <= tp) ? sacc[j] * fexp(as - sM[tp]) : 0.f; sS[tp * 72 + sp] = f2bf(val); }
            }
            LDS_BARRIER();
#pragma unroll
            for (int ks = 0; ks < 2; ++ks) { const bf16x8 a = *(const bf16x8*)(sS + (16 * rw + fr) * 72 + 32 * ks + 8 * fq);
#pragma unroll
                for (int k = 0; k < 5; ++k) { const int ct = k < 3 ? ct_a + k : ct_b + k - 3;
                    if (k != 2 || cw == 0) { const bf16x8 b = *(const bf16x8*)(sVT + (16 * ct + fr) * 72 + 32 * ks + 8 * fq); num[k] = mfma16(a, b, num[k]); } } }
            if (cw == 1 && fr == 0) {
#pragma unroll
                for (int j = 0; j < 4; ++j) sDen[16 * rw + 4 * fq + j] = num[4][j]; }
            LDS_BARRIER();
            float inv[4];
#pragma unroll
            for (int j = 0; j < 4; ++j) { const int tp = 16 * rw + 4 * fq + j; const float den = sDen[tp]; inv[j] = __builtin_amdgcn_rcpf(fmaxf(fabsf(den), fexp(-(sBb[tp] + sM[tp])))); }
            if (!second) {
#pragma unroll
                for (int j = 0; j < 4; ++j) { const int tp = 16 * rw + 4 * fq + j, tl = dir ? 63 - tp : tp; const size_t row = (size_t)row0 + c * 64 + tl;
                    bf16_t* hb = dsel == 1 ? HB2 + (row - NCTX) * 512 + h * 128 : HB + row * DM + h * 128;
#pragma unroll
                    for (int k = 0; k < 5; ++k) { const int ct = k < 3 ? ct_a + k : ct_b + k - 3; if ((k != 2 || cw == 0) && ct < 8) hb[16 * ct + fr] = f2bf(num[k][j] * inv[j]); } }
            } else {
                float ssr[4];
#pragma unroll
                for (int j = 0; j < 4; ++j) { const int tp = 16 * rw + 4 * fq + j, tl = dir ? 63 - tp : tp; const size_t row = (size_t)row0 + c * 64 + tl;
                    const bf16_t* hb = HB + row * DM + h * 128; float ss = 0.f;
#pragma unroll
                    for (int k = 0; k < 5; ++k) { const int ct = k < 3 ? ct_a + k : ct_b + k - 3;
                        if ((k != 2 || cw == 0) && ct < 8) { const int e = 16 * ct + fr; const float other = bf2f(ld_u16_agent(hb + e)); const float hs = num[k][j] * inv[j] + other;
                            const float o = sigmf(bf2f(U[row * UW + 1536 + h * 128 + e])); const float v = o * hs; ss += v * v; num[k][j] = v; } }
                    ss += __shfl_xor(ss, 1); ss += __shfl_xor(ss, 2); ss += __shfl_xor(ss, 4); ss += __shfl_xor(ss, 8);
                    ssr[j] = ss; if (fr == 0) sRed[cw * 64 + tp] = ss; }
                LDS_BARRIER();
#pragma unroll
                for (int j = 0; j < 4; ++j) { const int tp = 16 * rw + 4 * fq + j, tl = dir ? 63 - tp : tp; const size_t row = (size_t)row0 + c * 64 + tl;
                    bf16_t* hb = HB + row * DM + h * 128; const float rms = rsqrtf((ssr[j] + sRed[(1 - cw) * 64 + tp]) * (1.f / 128.f) + 1e-6f);
#pragma unroll
                    for (int k = 0; k < 5; ++k) { const int ct = k < 3 ? ct_a + k : ct_b + k - 3;
                        if ((k != 2 || cw == 0) && ct < 8) { const int e = 16 * ct + fr; hb[e] = f2bf(num[k][j] * rms * p.hg[h * 128 + e]); } } }
            }
            const float decay = fexp(m_prev - M63);
#pragma unroll
            for (int ct = 0; ct < 9; ++ct) Cacc[ct] = Cacc[ct] * decay;
#pragma unroll
            for (int ks = 0; ks < 2; ++ks) { const bf16x8 a = *(const bf16x8*)(sKwT + (16 * wv + fr) * 72 + 32 * ks + 8 * fq);
#pragma unroll
                for (int ct = 0; ct < 9; ++ct) { const bf16x8 b = *(const bf16x8*)(sVT + (16 * ct + fr) * 72 + 32 * ks + 8 * fq); Cacc[ct] = mfma16(a, b, Cacc[ct]); } }
            m_prev = bL + M63;
        }
        if (ctx) { const int sidx = (bg * 2 + dir) * 4 + h; float* Co = p.out + OUT_C + (size_t)sidx * 16384;
            int z1 = 0; asm volatile("" : "+v"(z1)); const int tid1 = (int)threadIdx.x + z1, fr1 = tid1 & 15, fq1 = (tid1 >> 4) & 3;
#pragma unroll
            for (int j = 0; j < 4; ++j) { const int d = 16 * wv + 4 * fq1 + j;
#pragma unroll
                for (int ct = 0; ct < 8; ++ct) Co[d * 128 + 16 * ct + fr1] = Cacc[ct][j];
                if (fr1 == 0) p.out[OUT_N + sidx * 128 + d] = Cacc[8][j]; }
            if (tid1 == 0) p.out[OUT_MM + sidx] = m_prev; }
        __syncthreads();
    }
}

__device__ __forceinline__ void phase_shift(bf16_t* U, const float* pmu, uint4* sRow) {
#pragma unroll 1
    for (int item = blockIdx.x; item < 1200; item += gridDim.x) {
        const int tid = opaque_tid(), tl = tid >> 3, g = tid & 7;
        const bool grid = item < 240; const int seq = grid ? item / 30 : (item - 240) / 30, sl = grid ? item % 30 : (item - 240) % 30;
        const int T = grid ? 2048 : 256, nst = T / 64; const size_t row0 = grid ? (size_t)NCTX + (size_t)seq * 2048 : (size_t)seq * 256;
        const int rc = sl * 64 + g * 8;
        char* base = (char*)(U + row0 * UW + 2048 + rc);
        const int act = (rc >= 1536 && rc < 1664) ? 1 : (rc >= 1792 ? 2 : 0);
        unsigned z0_ = 0u; asm volatile("" : "+v"(z0_));
        uint4 prv = make_uint4(z0_, z0_, z0_, z0_), cur = *(const uint4*)(base + (size_t)tl * (UW * 2)), nxt;
        __syncthreads();
#pragma unroll 1
        for (int k = 0; k < nst; ++k) {
            unsigned zr = 0u; asm volatile("" : "+v"(zr)); const uint4 z4 = make_uint4(zr, zr, zr, zr);
            nxt = z4; if (k + 1 < nst) nxt = *(const uint4*)(base + (size_t)((k + 1) * 64 + tl) * (UW * 2));
            sRow[(1 + tl) * 8 + g] = cur;
            if (tl == 0) sRow[65 * 8 + g] = nxt;
            LDS_BARRIER();
            uint4 lf = sRow[tl * 8 + g], rt = sRow[(2 + tl) * 8 + g];
            if (tl == 0 && (grid || k == 0)) lf = z4;
            if (tl == 63 && (grid || k == nst - 1)) rt = z4;
            float x[8], t[8], o[8], ms[8], m[8];
            int zz = 0; asm volatile("" : "+v"(zz)); const float* mup = pmu + rc + zz;
#define LD_MU8(a) do { const float4 m0 = *(const float4*)(mup + (a) * 1920), m1 = *(const float4*)(mup + (a) * 1920 + 4); m[0] = m0.x; m[1] = m0.y; m[2] = m0.z; m[3] = m0.w; m[4] = m1.x; m[5] = m1.y; m[6] = m1.z; m[7] = m1.w; } while (0)
            unpack8(cur, x);
            LD_MU8(0); unpack8(lf, t);
#pragma unroll
            for (int i = 0; i < 8; ++i) { o[i] = m[i] * t[i]; ms[i] = m[i]; }
            LD_MU8(1); unpack8(rt, t);
#pragma unroll
            for (int i = 0; i < 8; ++i) { o[i] += m[i] * t[i]; ms[i] += m[i]; }
            if (grid) {
                LD_MU8(2); unpack8(prv, t);
#pragma unroll
                for (int i = 0; i < 8; ++i) { o[i] += m[i] * t[i]; ms[i] += m[i]; }
                LD_MU8(3); unpack8(nxt, t);
#pragma unroll
                for (int i = 0; i < 8; ++i) { o[i] += m[i] * t[i]; ms[i] += m[i]; }
            }
#undef LD_MU8
#pragma unroll
            for (int i = 0; i < 8; ++i) o[i] += x[i] * (1.f - ms[i]);
            if (act == 1) {
#pragma unroll
                for (int i = 0; i < 8; ++i) o[i] = tanh_fast(o[i]); }
            if (act == 2) {
#pragma unroll
                for (int i = 0; i < 8; ++i) o[i] = sigmf(o[i]); }
            *(uint4*)(base + (size_t)(k * 64 + tl) * (UW * 2)) = make_uint4(pk2(o[0], o[1]), pk2(o[2], o[3]), pk2(o[4], o[5]), pk2(o[6], o[7]));
            LDS_BARRIER();
            if (tl == 63) sRow[g] = cur;
            prv = cur; cur = nxt;
        }
    }
}

constexpr int RW_TC = 16;
constexpr int RW_VEC = 0, RW_V = RW_VEC + 16 * 320 * 4, RW_KR = RW_V + 16 * 32 * 4, RW_XW = RW_KR + 16 * 64 * 4, RW_XA = RW_XW + 16 * 72 * 2, RW_Y = RW_XA + 16 * 72 * 2,
              RW_MU = RW_Y + 16 * 32 * 4, RW_DIR = RW_MU + 4 * 288 * 4;
static_assert(2 * RW_DIR <= LDS_BYTES && RW_DIR % 16 == 0, "rwkv lds");

__device__ __forceinline__ float dppf(float x, const int ctrl) { return x; }
#define DPP_ADD(x, ctrl) ((x) + __int_as_float(__builtin_amdgcn_update_dpp(0, __float_as_int(x), (ctrl), 0xf, 0xf, true)))
__device__ __forceinline__ float red8(float x) { x = DPP_ADD(x, 0xB1); x = DPP_ADD(x, 0x4E); x = DPP_ADD(x, 0x141); return x; }
__device__ __forceinline__ float red16(float x) { x = red8(x); x = DPP_ADD(x, 0x140); return x; }

struct Sh8 { uint4 x, l, r, u, d; };
__device__ __forceinline__ void sh8_load(Sh8& q, const bf16_t* U, size_t row0, int tok, int T, bool grid, int c0) {
    const char* Ub = (const char*)(U + row0 * UW);
    const int off = (tok * UW + c0) * 2; const uint4 z = make_uint4(0u, 0u, 0u, 0u);
    const bool hl = grid ? (tok & 63) != 0 : tok > 0, hr = grid ? (tok & 63) != 63 : tok < T - 1;
    q.x = *(const uint4*)(Ub + off);
    q.l = hl ? *(const uint4*)(Ub + (off - UW * 2)) : z; q.r = hr ? *(const uint4*)(Ub + (off + UW * 2)) : z;
    q.u = (grid && tok >= 64) ? *(const uint4*)(Ub + (off - 64 * UW * 2)) : z; q.d = (grid && tok < T - 64) ? *(const uint4*)(Ub + (off + 64 * UW * 2)) : z;
}
__device__ __forceinline__ void sh8_mix(const Sh8& q, bool grid, const float* mu4, int mustride, float* o) {
    float x[8], t[8], m[8], ms[8];
    unpack8(q.x, x);
    { const float4 a = *(const float4*)mu4, b = *(const float4*)(mu4 + 4); m[0] = a.x; m[1] = a.y; m[2] = a.z; m[3] = a.w; m[4] = b.x; m[5] = b.y; m[6] = b.z; m[7] = b.w; }
    unpack8(q.l, t);
#pragma unroll
    for (int i = 0; i < 8; ++i) { o[i] = m[i] * t[i]; ms[i] = m[i]; }
    { const float4 a = *(const float4*)(mu4 + mustride), b = *(const float4*)(mu4 + mustride + 4); m[0] = a.x; m[1] = a.y; m[2] = a.z; m[3] = a.w; m[4] = b.x; m[5] = b.y; m[6] = b.z; m[7] = b.w; }
    unpack8(q.r, t);
#pragma unroll
    for (int i = 0; i < 8; ++i) { o[i] += m[i] * t[i]; ms[i] += m[i]; }
    if (grid) {
        { const float4 a = *(const float4*)(mu4 + 2 * mustride), b = *(const float4*)(mu4 + 2 * mustride + 4); m[0] = a.x; m[1] = a.y; m[2] = a.z; m[3] = a.w; m[4] = b.x; m[5] = b.y; m[6] = b.z; m[7] = b.w; }
        unpack8(q.u, t);
#pragma unroll
        for (int i = 0; i < 8; ++i) { o[i] += m[i] * t[i]; ms[i] += m[i]; }
        { const float4 a = *(const float4*)(mu4 + 3 * mustride), b = *(const float4*)(mu4 + 3 * mustride + 4); m[0] = a.x; m[1] = a.y; m[2] = a.z; m[3] = a.w; m[4] = b.x; m[5] = b.y; m[6] = b.z; m[7] = b.w; }
        unpack8(q.d, t);
#pragma unroll
        for (int i = 0; i < 8; ++i) { o[i] += m[i] * t[i]; ms[i] += m[i]; }
    }
#pragma unroll
    for (int i = 0; i < 8; ++i) o[i] += x[i] * (1.f - ms[i]);
}
__device__ __forceinline__ void shifted8(const bf16_t* U, size_t row0, int tok, int T, bool grid, int c0, const float* mu4, int mustride, float* o) {
    Sh8 q; sh8_load(q, U, row0, tok, T, grid, c0); sh8_mix(q, grid, mu4, mustride, o);
}
typedef float f32x2 __attribute__((ext_vector_type(2)));

__device__ __forceinline__ void rwkv_task(const P& p, unsigned char* lds, int bg, int h, int rh) {
    const int wv = __builtin_amdgcn_readfirstlane((int)threadIdx.x >> 6), dir = wv >> 2, lw = wv & 3;
    const bool ctx = bg < 32; const int T = ctx ? 256 : 2048, nc = T / RW_TC; const size_t row0 = ctx ? (size_t)bg * 256 : (size_t)NCTX + (size_t)(bg - 32) * 2048;
    const bool grid = !ctx;
    unsigned char* L = lds + dir * RW_DIR;
    float* sVec = (float*)(L + RW_VEC); float* sV = (float*)(L + RW_V); float* sKr = (float*)(L + RW_KR); bf16_t* sXw = (bf16_t*)(L + RW_XW); bf16_t* sXa = (bf16_t*)(L + RW_XA);
    float* sY = (float*)(L + RW_Y); float* sMu = (float*)(L + RW_MU);
    const bf16_t* U = (const bf16_t*)(p.ws + WS_U); bf16_t* HB = (bf16_t*)(p.ws + WS_A);
    const int hc = h * 64;
    float st[8]; bf16x8 wfrag[2], afrag[2]; float w0v, a0v, kav;
    {
        const int tid = opaque_tid(), ltid = tid & 255, ri = ltid >> 3, jq = ltid & 7, fr = tid & 15, fq = (tid >> 4) & 3;
        __syncthreads();
        if (ctx) {
#pragma unroll
            for (int q = 0; q < 8; ++q) st[q] = 0.f;
        } else { const float* S0 = p.sS + ((size_t)(((bg - 32) * 2 + dir) * 8 + h)) * 4096 + (32 * rh + ri) * 64 + jq * 8;
#pragma unroll
            for (int q = 0; q < 8; ++q) st[q] = S0[q]; }
        const int jcol = hc + 16 * lw + fr;
#pragma unroll
        for (int ks = 0; ks < 2; ++ks) { float wf[8], af[8];
#pragma unroll
            for (int i = 0; i < 8; ++i) { const int l = 32 * ks + 8 * fq + i; wf[i] = p.w2[(size_t)(dir * 64 + l) * 512 + jcol]; af[i] = p.a2[(size_t)(dir * 64 + l) * 512 + jcol]; }
            union { uint4 u; bf16x8 v; } c1, c2; c1.u = make_uint4(pk2(wf[0], wf[1]), pk2(wf[2], wf[3]), pk2(wf[4], wf[5]), pk2(wf[6], wf[7])); c2.u = make_uint4(pk2(af[0], af[1]), pk2(af[2], af[3]), pk2(af[4], af[5]), pk2(af[6], af[7]));
            wfrag[ks] = c1.v; afrag[ks] = c2.v; }
        w0v = p.w0[dir * 512 + jcol]; a0v = p.a0[dir * 512 + jcol]; kav = p.ka[jcol];
    }
    uint4 q1, q2, q3 = make_uint4(0u, 0u, 0u, 0u);
    const char* Ub = (const char*)(U + row0 * UW);
    { const int tid = opaque_tid(), ltid = tid & 255; const int c = dir ? nc - 1 : 0, tok0 = c * RW_TC; const int tl = (ltid & 127) >> 3, g = ltid & 7;
      q1 = *(const uint4*)(Ub + ((tok0 + tl) * UW + (lw < 2 ? 2048 : 2048 + 512) + hc + 8 * g) * 2);
      q2 = *(const uint4*)(Ub + ((tok0 + tl) * UW + (lw < 2 ? 2048 + 1536 : 2048 + 1664) + dir * 64 + 8 * g) * 2);
      if (lw == 0) q3 = *(const uint4*)(Ub + ((tok0 + (ltid >> 2)) * UW + 2048 + 1024 + hc + 32 * rh + 8 * (ltid & 3)) * 2); }
    f32x2 st2[4];
#pragma unroll
    for (int q = 0; q < 4; ++q) st2[q] = (f32x2){st[2 * q], st[2 * q + 1]};
#pragma unroll 1
    for (int s = 0; s < nc; ++s) {
        const int c = dir ? nc - 1 - s : s; const int tok0 = c * RW_TC;
        const bool second = s >= (nc >> 1);
        const int tid = opaque_tid(), ltid = tid & 255, ri = ltid >> 3, jq = ltid & 7, fr = tid & 15, fq = (tid >> 4) & 3;
        { const int tl = (ltid & 127) >> 3, g = ltid & 7; float o[8];
          if (lw < 2) {
              unpack8(q1, o);
              *(float4*)(sVec + tl * 320 + 8 * g) = make_float4(o[0], o[1], o[2], o[3]); *(float4*)(sVec + tl * 320 + 8 * g + 4) = make_float4(o[4], o[5], o[6], o[7]);
              *(uint4*)(sXw + tl * 72 + 8 * g) = q2;
          } else {
              unpack8(q1, o);
              float kkr[8]; float ss = 0.f;
#pragma unroll
              for (int i = 0; i < 8; ++i) { kkr[i] = o[i] * p.kk[hc + 8 * g + i]; ss += kkr[i] * kkr[i]; }
              ss = red8(ss); const float rn = __builtin_amdgcn_rsqf(fmaxf(ss, 1e-24f));
              *(float4*)(sKr + tl * 64 + 8 * g) = make_float4(o[0], o[1], o[2], o[3]); *(float4*)(sKr + tl * 64 + 8 * g + 4) = make_float4(o[4], o[5], o[6], o[7]);
              *(float4*)(sVec + tl * 320 + 192 + 8 * g) = make_float4(kkr[0] * rn, kkr[1] * rn, kkr[2] * rn, kkr[3] * rn); *(float4*)(sVec + tl * 320 + 192 + 8 * g + 4) = make_float4(kkr[4] * rn, kkr[5] * rn, kkr[6] * rn, kkr[7] * rn);
              *(uint4*)(sXa + tl * 72 + 8 * g) = q2;
          }
          if (lw == 0) {
              const int tl2 = ltid >> 2, g2 = ltid & 3;
              unpack8(q3, o);
              *(float4*)(sV + tl2 * 32 + 8 * g2) = make_float4(o[0], o[1], o[2], o[3]); *(float4*)(sV + tl2 * 32 + 8 * g2 + 4) = make_float4(o[4], o[5], o[6], o[7]);
          } }
        __syncthreads();
        { f32x4 aw = (f32x4){0.f, 0.f, 0.f, 0.f}, aa = (f32x4){0.f, 0.f, 0.f, 0.f};
#pragma unroll
          for (int ks = 0; ks < 2; ++ks) { const bf16x8 xw = *(const bf16x8*)(sXw + fr * 72 + 32 * ks + 8 * fq), xa = *(const bf16x8*)(sXa + fr * 72 + 32 * ks + 8 * fq);
              aw = mfma16(xw, wfrag[ks], aw); aa = mfma16(xa, afrag[ks], aa); }
          const int j = 16 * lw + fr;
#pragma unroll
          for (int jj = 0; jj < 4; ++jj) { const int tl = 4 * fq + jj;
              const float dec = fexp(-fexp(-softplus_fast(-(w0v + aw[jj])) - 0.5f));
              const float a = sigmf(a0v + aa[jj]); const float k = sKr[tl * 64 + j], kn = sVec[tl * 320 + 192 + j];
              float* V = sVec + tl * 320 + j; V[64] = dec; V[128] = k * (1.f + (a - 1.f) * kav); V[256] = kn * a; } }
        const int otl = ltid >> 4, opr = ltid & 15; unsigned* hb = (unsigned*)(HB + (row0 + tok0 + otl) * DM + 512 + hc + 32 * rh + 2 * opr);
        unsigned ov = 0u;
        if (second) ov = __hip_atomic_load(hb, __ATOMIC_RELAXED, __HIP_MEMORY_SCOPE_AGENT);
        if (s + 1 < nc) { const int cn = dir ? nc - 2 - s : s + 1, tokn = cn * RW_TC; const int tl = (ltid & 127) >> 3, g = ltid & 7;
            q1 = *(const uint4*)(Ub + ((tokn + tl) * UW + (lw < 2 ? 2048 : 2048 + 512) + hc + 8 * g) * 2);
            q2 = *(const uint4*)(Ub + ((tokn + tl) * UW + (lw < 2 ? 2048 + 1536 : 2048 + 1664) + dir * 64 + 8 * g) * 2);
            if (lw == 0) q3 = *(const uint4*)(Ub + ((tokn + (ltid >> 2)) * UW + 2048 + 1024 + hc + 32 * rh + 8 * (ltid & 3)) * 2); }
        LDS_BARRIER();
        f32x2 sv_[4];
#pragma unroll
        for (int q = 0; q < 4; ++q) sv_[q] = st2[q];
#pragma unroll 1
        for (int rep = 0; rep < (PROBE_DUP == 102 ? 2 : 1); ++rep) {
        if (PROBE_DUP == 102) {
#pragma unroll
            for (int q = 0; q < 4; ++q) st2[q] = sv_[q]; }
float ys[RW_TC];
#pragma unroll
        for (int step = 0; step < RW_TC; ++step) { const int tl = dir ? RW_TC - 1 - step : step; const float* V = sVec + tl * 320 + jq * 8;
            const float4 ka4 = *(const float4*)(V + 192), kb4 = *(const float4*)(V + 196);
            f32x2 acc = st2[0] * (f32x2){ka4.x, ka4.y}; acc = st2[1] * (f32x2){ka4.z, ka4.w} + acc; acc = st2[2] * (f32x2){kb4.x, kb4.y} + acc; acc = st2[3] * (f32x2){kb4.z, kb4.w} + acc;
            const float sa = -red8(acc.x + acc.y);
            const float vi = sV[tl * 32 + ri];
            const float4 wa = *(const float4*)(V + 64), wb = *(const float4*)(V + 68), ba = *(const float4*)(V + 256), bb = *(const float4*)(V + 260),
                         da = *(const float4*)(V + 128), db = *(const float4*)(V + 132), ra = *(const float4*)(V), rb = *(const float4*)(V + 4);
            const f32x2 sa2 = (f32x2){sa, sa}, vi2 = (f32x2){vi, vi};
            st2[0] = st2[0] * (f32x2){wa.x, wa.y} + (sa2 * (f32x2){ba.x, ba.y} + vi2 * (f32x2){da.x, da.y});
            st2[1] = st2[1] * (f32x2){wa.z, wa.w} + (sa2 * (f32x2){ba.z, ba.w} + vi2 * (f32x2){da.z, da.w});
            st2[2] = st2[2] * (f32x2){wb.x, wb.y} + (sa2 * (f32x2){bb.x, bb.y} + vi2 * (f32x2){db.x, db.y});
            st2[3] = st2[3] * (f32x2){wb.z, wb.w} + (sa2 * (f32x2){bb.z, bb.w} + vi2 * (f32x2){db.z, db.w});
            f32x2 ya = st2[0] * (f32x2){ra.x, ra.y}; ya = st2[1] * (f32x2){ra.z, ra.w} + ya; ya = st2[2] * (f32x2){rb.x, rb.y} + ya; ya = st2[3] * (f32x2){rb.z, rb.w} + ya;
            const float y = red8(ya.x + ya.y);
            ys[step] = y; }
        if (jq == 0) {
#pragma unroll
            for (int step = 0; step < RW_TC; ++step) sY[(dir ? RW_TC - 1 - step : step) * 32 + ri] = ys[step]; }
        }
        LDS_BARRIER();
        { float y0 = sY[otl * 32 + 2 * opr], y1 = sY[otl * 32 + 2 * opr + 1];
          if (second) { y0 += __uint_as_float(ov << 16); y1 += __uint_as_float(ov & 0xffff0000u); }
          *hb = pk2(y0, y1); }
    }
#pragma unroll
    for (int q = 0; q < 4; ++q) { st[2 * q] = st2[q].x; st[2 * q + 1] = st2[q].y; }
    if (ctx) { const int tid = opaque_tid(), ltid = tid & 255, ri = ltid >> 3, jq = ltid & 7;
        float* So = p.out + OUT_S + ((size_t)((bg * 2 + dir) * 8 + h)) * 4096 + (32 * rh + ri) * 64 + jq * 8;
#pragma unroll
        for (int q = 0; q < 8; ++q) So[q] = st[q]; }
    __syncthreads();
}

constexpr int RX_VEC = 0,
              RX_KR = RX_VEC + 16 * 320 * 4,
              RX_XW = RX_KR + 4096, RX_XA = RX_XW + 2304,
              RX_Y = RX_XA + 2304,
              RX_KT = RX_Y + 4096, RX_KTN = RX_KT + 2304, RX_RT = RX_KTN + 2304, RX_RTN = RX_RT + 2304, RX_BN = RX_RTN + 2304, RX_DN = RX_BN + 2304,
              RX_BTS = RX_DN + 2304, RX_DT = RX_BTS + 5120, RX_VT = RX_DT + 5120,
              RX_ADK = RX_VT + 5120, RX_ABR = RX_ADK + 1280, RX_ADR = RX_ABR + 1280, RX_TM = RX_ADR + 1280,
              RX_N = RX_TM + 1280,
              RX_PL = RX_N + 1088,
              RX_DIR = RX_PL + 256;
static_assert(2 * RX_DIR <= LDS_BYTES - 64 && RX_DIR % 16 == 0, "rwkv (chunked) lds");
__device__ __forceinline__ int perm_pi(int j) { const int jj = j & 31; return (j & 32) + 8 * ((jj & 15) >> 2) + (jj & 3) + 4 * (jj >> 4); }
__device__ __forceinline__ int perm_sg(int c) { return 8 * (c >> 2) + (c & 3); }
__device__ __forceinline__ bf16x8 pack_acc_lo(const f32x4 v) { union { uint4 u; bf16x8 b; } c; c.u = make_uint4(pk2(v[0], v[1]), pk2(v[2], v[3]), 0u, 0u); return c.b; }
__device__ __forceinline__ bf16x8 pack_acc2(const f32x4 a, const f32x4 b) { union { uint4 u; bf16x8 v; } c; c.u = make_uint4(pk2(a[0], a[1]), pk2(a[2], a[3]), pk2(b[0], b[1]), pk2(b[2], b[3])); return c.v; }

__device__ __forceinline__ void rwkv_task_w(const P& p, unsigned char* lds, int bg, int h) {
    const int wv = __builtin_amdgcn_readfirstlane((int)threadIdx.x >> 6), dir = wv >> 2, lw = wv & 3;
    const bool ctx = bg < 32; const int T = ctx ? 256 : 2048, nc = T / 16; const size_t row0 = ctx ? (size_t)bg * 256 : (size_t)NCTX + (size_t)(bg - 32) * 2048;
    unsigned char* L = lds + dir * RX_DIR;
    float* sVec = (float*)(L + RX_VEC); float* sKr = (float*)(L + RX_KR); bf16_t* sXw = (bf16_t*)(L + RX_XW); bf16_t* sXa = (bf16_t*)(L + RX_XA); float* sY = (float*)(L + RX_Y);
    bf16_t* sKT = (bf16_t*)(L + RX_KT); bf16_t* sKTn = (bf16_t*)(L + RX_KTN); bf16_t* sRT = (bf16_t*)(L + RX_RT); bf16_t* sRTn = (bf16_t*)(L + RX_RTN); bf16_t* sBn = (bf16_t*)(L + RX_BN); bf16_t* sDn = (bf16_t*)(L + RX_DN);
    bf16_t* sBts = (bf16_t*)(L + RX_BTS); bf16_t* sDt = (bf16_t*)(L + RX_DT); bf16_t* sVT = (bf16_t*)(L + RX_VT);
    bf16_t* sAdk = (bf16_t*)(L + RX_ADK); bf16_t* sAbr = (bf16_t*)(L + RX_ABR); bf16_t* sAdr = (bf16_t*)(L + RX_ADR); bf16_t* sTm = (bf16_t*)(L + RX_TM);
    float* sN = (float*)(L + RX_N); float* sPL = (float*)(L + RX_PL);
    const bf16_t* U = (const bf16_t*)(p.ws + WS_U); bf16_t* HB = (bf16_t*)(p.ws + WS_A);
    const int hc = h * 64;
    f32x4 ST[4]; bf16x8 wfrag[2], afrag[2]; float w0v, a0v, kav, kkc[8];
    {
        const int tid = opaque_tid(), ltid = tid & 255, fr = tid & 15, fq = (tid >> 4) & 3;
        __syncthreads();
        for (int i = ltid; i < (RX_N - RX_BTS) / 4; i += 256) ((unsigned*)(L + RX_BTS))[i] = 0u;
        __syncthreads();
        if (ctx) {
#pragma unroll
            for (int jt = 0; jt < 4; ++jt) ST[jt] = (f32x4){0.f, 0.f, 0.f, 0.f};
        } else { const float* S0 = p.sS + ((size_t)(((bg - 32) * 2 + dir) * 8 + h)) * 4096 + (16 * lw + fr) * 64 + 4 * fq;
#pragma unroll
            for (int jt = 0; jt < 4; ++jt) { const float4 t = *(const float4*)(S0 + 16 * jt); ST[jt] = (f32x4){t.x, t.y, t.z, t.w}; } }
        const int jcol = hc + 16 * lw + fr;
#pragma unroll
        for (int ks = 0; ks < 2; ++ks) { float wf[8], af[8];
#pragma unroll
            for (int i = 0; i < 8; ++i) { const int l = 32 * ks + 8 * fq + i; wf[i] = p.w2[(size_t)(dir * 64 + l) * 512 + jcol]; af[i] = p.a2[(size_t)(dir * 64 + l) * 512 + jcol]; }
            union { uint4 u; bf16x8 v; } c1, c2; c1.u = make_uint4(pk2(wf[0], wf[1]), pk2(wf[2], wf[3]), pk2(wf[4], wf[5]), pk2(wf[6], wf[7])); c2.u = make_uint4(pk2(af[0], af[1]), pk2(af[2], af[3]), pk2(af[4], af[5]), pk2(af[6], af[7]));
            wfrag[ks] = c1.v; afrag[ks] = c2.v; }
        w0v = p.w0[dir * 512 + jcol]; a0v = p.a0[dir * 512 + jcol]; kav = p.ka[jcol];
#pragma unroll
        for (int i = 0; i < 8; ++i) kkc[i] = p.kk[hc + 8 * (ltid & 7) + i];
    }
    uint4 q1, q2, q3, n1a, n2a, n3a, n1b, n2b, n3b;
    const char* Ub = (const char*)(U + row0 * UW);
#define RX_LOAD(d1, d2, d3, sidx) do { const int s_ = (sidx) < nc ? (sidx) : nc - 1; const int c_ = dir ? nc - 1 - s_ : s_; const int tok_ = c_ * 16 + ((ltid_ & 127) >> 3); const int g_ = ltid_ & 7; \
        d1 = *(const uint4*)(Ub + (tok_ * UW + (lw < 2 ? 2048 : 2048 + 512) + hc + 8 * g_) * 2); \
        d2 = *(const uint4*)(Ub + (tok_ * UW + (lw < 2 ? 2048 + 1536 : 2048 + 1664) + dir * 64 + 8 * g_) * 2); \
        d3 = *(const uint4*)(Ub + (tok_ * UW + 2048 + 1024 + hc + 8 * g_) * 2); } while (0)
    { const int ltid_ = opaque_tid() & 255; RX_LOAD(q1, q2, q3, 0); RX_LOAD(n1a, n2a, n3a, 1); RX_LOAD(n1b, n2b, n3b, 2); }
#pragma unroll 1
    for (int s = 0; s < nc; ++s) {
        const int c = dir ? nc - 1 - s : s; const int tok0 = c * 16;
        const bool second = s >= (nc >> 1);
        const int tid = opaque_tid(), ltid = tid & 255, fr = tid & 15, fq = (tid >> 4) & 3;
        { const int tl = (ltid & 127) >> 3, g = ltid & 7, q = dir ? 15 - tl : tl; float o[8];
          if (lw < 2) {
              unpack8(q1, o);
              *(float4*)(sVec + q * 320 + 8 * g) = make_float4(o[0], o[1], o[2], o[3]); *(float4*)(sVec + q * 320 + 8 * g + 4) = make_float4(o[4], o[5], o[6], o[7]);
              *(uint4*)(sXw + q * 72 + 8 * g) = q2;
              const unsigned vw[4] = {q3.x, q3.y, q3.z, q3.w};
#pragma unroll
              for (int i = 0; i < 8; ++i) sVT[(8 * g + i) * 40 + q] = (bf16_t)((vw[i >> 1] >> ((i & 1) * 16)) & 0xffffu);
          } else {
              unpack8(q1, o);
              float kkr[8]; float ss = 0.f;
#pragma unroll
              for (int i = 0; i < 8; ++i) { kkr[i] = o[i] * kkc[i]; ss += kkr[i] * kkr[i]; }
              ss = red8(ss); const float rn = __builtin_amdgcn_rsqf(fmaxf(ss, 1e-24f));
              *(float4*)(sKr + q * 64 + 8 * g) = make_float4(o[0], o[1], o[2], o[3]); *(float4*)(sKr + q * 64 + 8 * g + 4) = make_float4(o[4], o[5], o[6], o[7]);
              *(float4*)(sVec + q * 320 + 192 + 8 * g) = make_float4(kkr[0] * rn, kkr[1] * rn, kkr[2] * rn, kkr[3] * rn); *(float4*)(sVec + q * 320 + 192 + 8 * g + 4) = make_float4(kkr[4] * rn, kkr[5] * rn, kkr[6] * rn, kkr[7] * rn);
              *(uint4*)(sXa + q * 72 + 8 * g) = q2;
          } }
        LDS_BARRIER();
        { f32x4 aw = (f32x4){0.f, 0.f, 0.f, 0.f}, aa = (f32x4){0.f, 0.f, 0.f, 0.f};
#pragma unroll
          for (int ks = 0; ks < 2; ++ks) { const bf16x8 xw = *(const bf16x8*)(sXw + fr * 72 + 32 * ks + 8 * fq), xa = *(const bf16x8*)(sXa + fr * 72 + 32 * ks + 8 * fq);
              aw = mfma16(xw, wfrag[ks], aw); aa = mfma16(xa, afrag[ks], aa); }
          const int j = 16 * lw + fr;
          float lg[4], av[4]; float run = 0.f;
#pragma unroll
          for (int e = 0; e < 4; ++e) { const float lw_ = -fexp(-softplus_fast(-(w0v + aw[e])) - 0.5f); run += lw_; lg[e] = run; av[e] = sigmf(a0v + aa[e]); }
          float x = run; { const float y1 = __shfl_up(x, 16); if (fq >= 1) x += y1; const float y2 = __shfl_up(x, 32); if (fq >= 2) x += y2; }
          const float excl = x - run;
          const int pj = perm_pi(j); bf16_t btv[4], dtv[4];
          float Pp = fexp(excl);
#pragma unroll
          for (int e = 0; e < 4; ++e) { const int q = 4 * fq + e; const float Lq = excl + lg[e];
              const float Pq = fexp(Lq), iP = __builtin_amdgcn_rcpf(Pq);
              const float k = sKr[q * 64 + j], kn = sVec[q * 320 + 192 + j], r = sVec[q * 320 + j];
              const float kd = k * (1.f + (av[e] - 1.f) * kav), b = kn * av[e];
              const bf16_t kt = f2bf(Pp * kn), rt = f2bf(Pq * r), bt = f2bf(b * iP), dt = f2bf(kd * iP);
              sKT[q * 72 + pj] = kt; sRT[q * 72 + pj] = rt; sBn[q * 72 + pj] = bt; sDn[q * 72 + pj] = dt;
              btv[e] = bt; dtv[e] = dt;
              if (q == 15) sPL[j] = Pq;
              Pp = Pq; }
          *(uint2*)(sBts + j * 40 + 8 * fq) = make_uint2((unsigned)btv[0] | ((unsigned)btv[1] << 16), (unsigned)btv[2] | ((unsigned)btv[3] << 16));
          *(uint2*)(sDt + j * 40 + 4 * fq) = make_uint2((unsigned)dtv[0] | ((unsigned)dtv[1] << 16), (unsigned)dtv[2] | ((unsigned)dtv[3] << 16)); }
        if (s == (nc >> 1)) asm volatile("s_waitcnt vmcnt(0)" ::: "memory"); else asm volatile("s_waitcnt vmcnt(6)" ::: "memory");
        LDS_BARRIER();
        { f32x4 gacc = (f32x4){0.f, 0.f, 0.f, 0.f}; const bf16_t* Ap = (lw < 2) ? sKT : sRT; const bf16_t* Bp = (lw & 1) ? sDn : sBn;
#pragma unroll
          for (int ks = 0; ks < 2; ++ks) gacc = mfma16(*(const bf16x8*)(Ap + fr * 72 + 32 * ks + 8 * fq), *(const bf16x8*)(Bp + fr * 72 + 32 * ks + 8 * fq), gacc);
          const int sidx = fr;
          float gm[4];
#pragma unroll
          for (int e = 0; e < 4; ++e) { const int q = 4 * fq + e; const bool keep = (lw < 2) ? (sidx < q) : (sidx <= q); gm[e] = keep ? gacc[e] : 0.f; }
          if (lw == 0) {
              const int r = tid & 15; float Tr[16];
#pragma unroll
              for (int q = 0; q < 16; ++q) Tr[q] = (r == q) ? 1.f : 0.f;
#pragma unroll
              for (int q = 0; q < 15; ++q) { const float tq = Tr[q];
#pragma unroll
                  for (int q2 = q + 1; q2 < 16; ++q2) { const float nv = __int_as_float(__builtin_amdgcn_readlane(__float_as_int(gm[q2 & 3]), q + 16 * (q2 >> 2))); Tr[q2] -= tq * nv; } }
              if ((tid & 63) < 16) { const int ps = perm_sg(r);
#pragma unroll
                  for (int q = 0; q < 16; ++q) sTm[q * 40 + ps] = f2bf(Tr[q]); }
          } else {
#pragma unroll
              for (int e = 0; e < 4; ++e) { const int q = 4 * fq + e;
                  if (lw == 1) sAdk[q * 40 + sidx] = f2bf(gm[e]);
                  else if (lw == 2) sAbr[q * 40 + perm_sg(sidx)] = f2bf(gm[e]);
                  else sAdr[q * 40 + sidx] = f2bf(gm[e]); } } }
        const int oq = ltid >> 4, otl = dir ? 15 - oq : oq; unsigned long long* hb = (unsigned long long*)(HB + (row0 + tok0 + otl) * DM + 512 + hc + 4 * (ltid & 15));
        const unsigned long long ov = __hip_atomic_load(hb, __ATOMIC_RELAXED, __HIP_MEMORY_SCOPE_AGENT);
        q1 = n1a; q2 = n2a; q3 = n3a; n1a = n1b; n2a = n2b; n3a = n3b;
        { const int ltid_ = ltid; RX_LOAD(n1b, n2b, n3b, s + 3); }
        LDS_BARRIER();
        { const bf16x8 Sb0 = pack_acc2(ST[0], ST[1]), Sb1 = pack_acc2(ST[2], ST[3]);
          const bf16x8 vtf = *(const bf16x8*)(sVT + (16 * lw + fr) * 40 + 8 * fq);
          f32x4 XT = (f32x4){0.f, 0.f, 0.f, 0.f};
          XT = mfma16(*(const bf16x8*)(sKT + fr * 72 + 8 * fq), Sb0, XT); XT = mfma16(*(const bf16x8*)(sKT + fr * 72 + 32 + 8 * fq), Sb1, XT);
          XT = mfma16(*(const bf16x8*)(sAdk + fr * 40 + 8 * fq), vtf, XT);
          f32x4 SAT = mfma16(*(const bf16x8*)(sTm + fr * 40 + 8 * fq), pack_acc_lo(XT), (f32x4){0.f, 0.f, 0.f, 0.f});
          SAT = -SAT;
          const bf16x8 SAb = pack_acc_lo(SAT);
          f32x4 YT = (f32x4){0.f, 0.f, 0.f, 0.f};
          YT = mfma16(*(const bf16x8*)(sRT + fr * 72 + 8 * fq), Sb0, YT); YT = mfma16(*(const bf16x8*)(sRT + fr * 72 + 32 + 8 * fq), Sb1, YT);
          YT = mfma16(*(const bf16x8*)(sAbr + fr * 40 + 8 * fq), SAb, YT); YT = mfma16(*(const bf16x8*)(sAdr + fr * 40 + 8 * fq), vtf, YT);
#pragma unroll
          for (int jt = 0; jt < 4; ++jt) { ST[jt] = mfma16(*(const bf16x8*)(sBts + (16 * jt + fr) * 40 + 8 * fq), SAb, ST[jt]); ST[jt] = mfma16(*(const bf16x8*)(sDt + (16 * jt + fr) * 40 + 8 * fq), vtf, ST[jt]);
              const float4 pl = *(const float4*)(sPL + 16 * jt + 4 * fq); ST[jt][0] *= pl.x; ST[jt][1] *= pl.y; ST[jt][2] *= pl.z; ST[jt][3] *= pl.w; }
#pragma unroll
          for (int e = 0; e < 4; ++e) sY[(4 * fq + e) * 64 + 16 * lw + fr] = YT[e]; }
        LDS_BARRIER();
        { const float4 y4 = *(const float4*)(sY + oq * 64 + 4 * (ltid & 15)); float y0 = y4.x, y1 = y4.y, y2 = y4.z, y3 = y4.w;
          if (second) { const unsigned lo = (unsigned)ov, hi = (unsigned)(ov >> 32); y0 += __uint_as_float(lo << 16); y1 += __uint_as_float(lo & 0xffff0000u); y2 += __uint_as_float(hi << 16); y3 += __uint_as_float(hi & 0xffff0000u); }
          *hb = (unsigned long long)pk2(y0, y1) | ((unsigned long long)pk2(y2, y3) << 32); }
    }
#undef RX_LOAD
    if (ctx) { const int tid = opaque_tid(), fr = tid & 15, fq = (tid >> 4) & 3;
        float* So = p.out + OUT_S + ((size_t)((bg * 2 + dir) * 8 + h)) * 4096 + (16 * lw + fr) * 64 + 4 * fq;
#pragma unroll
        for (int jt = 0; jt < 4; ++jt) *(float4*)(So + 16 * jt) = make_float4(ST[jt][0], ST[jt][1], ST[jt][2], ST[jt][3]); }
    __syncthreads();
}

constexpr int FZ_ROW = 1800;
constexpr int FZ_X = 0, FZ_MU = 32 * FZ_ROW * 2, FZ_END = FZ_MU + 4 * 1792 * 4;
static_assert(FZ_END <= LDS_BYTES && FZ_MU % 16 == 0, "finalize lds");

__device__ __forceinline__ void phase_rwkv_finalize(const P& p, unsigned char* lds) {
    bf16_t* sX = (bf16_t*)(lds + FZ_X); float* sMu = (float*)(lds + FZ_MU);
    const bf16_t* U = (const bf16_t*)(p.ws + WS_U); bf16_t* HB = (bf16_t*)(p.ws + WS_A);
    { const bf16_t* HB2 = (const bf16_t*)(p.ws + WS_HB2); const int tid0 = opaque_tid(), lane = tid0 & 63, wave = (int)threadIdx.x >> 6;
#pragma unroll 1
      for (int row = NCTX + blockIdx.x * 8 + wave; row < MT; row += gridDim.x * 8) {
          float hf[8], hb[8], og[8], v[8]; float ss = 0.f;
          unpack8(*(const uint4*)(HB + (size_t)row * DM + lane * 8), hf); unpack8(*(const uint4*)(HB2 + (size_t)(row - NCTX) * 512 + lane * 8), hb); unpack8(*(const uint4*)(U + (size_t)row * UW + 1536 + lane * 8), og);
#pragma unroll
          for (int i = 0; i < 8; ++i) { v[i] = sigmf(og[i]) * (hf[i] + hb[i]); ss += v[i] * v[i]; }
          ss = red16(ss); const float rms = rsqrtf(ss * (1.f / 128.f) + 1e-6f);
          const float4 g0 = *(const float4*)(p.hg + lane * 8), g1 = *(const float4*)(p.hg + lane * 8 + 4);
          *(uint4*)(HB + (size_t)row * DM + lane * 8) = make_uint4(pk2(v[0] * rms * g0.x, v[1] * rms * g0.y), pk2(v[2] * rms * g0.z, v[3] * rms * g0.w), pk2(v[4] * rms * g1.x, v[5] * rms * g1.y), pk2(v[6] * rms * g1.z, v[7] * rms * g1.w)); } }
    const bf16_t* A2 = (const bf16_t*)(p.ws + WS_A2BF); const bf16_t* G2 = (const bf16_t*)(p.ws + WS_G2BF);
    const int wv = __builtin_amdgcn_readfirstlane((int)threadIdx.x >> 6), hc = wv * 64;
#pragma unroll 1
    for (int tile = blockIdx.x; tile < MT / 32; tile += gridDim.x) {
        const int tid = opaque_tid(), fr = tid & 15, fq = (tid >> 4) & 3;
        const int rowt = tile * 32; const bool ctx = rowt < NCTX; const int T = ctx ? 256 : 2048; const size_t row0 = ctx ? (size_t)(rowt & ~255) : (size_t)NCTX + (size_t)((rowt - NCTX) & ~2047);
        const int tokt = rowt - (int)row0;
        __syncthreads();
#pragma unroll 2
        for (int it = 0; it < 14; ++it) { const int item = it * NTHR + tid, tl = item / 224, gi = item % 224;
            const int c0 = gi < 192 ? 2048 + 8 * gi : 2048 + 1664 + 8 * (gi - 192);
            *(uint4*)(sX + tl * FZ_ROW + 8 * gi) = *(const uint4*)(U + (row0 + tokt + tl) * UW + c0); }
        __syncthreads();
#pragma unroll 1
        for (int rt = 0; rt < 2; ++rt) {
            f32x4 af[4], ab[4], gg[4];
#pragma unroll
            for (int ct = 0; ct < 4; ++ct) { af[ct] = (f32x4){0.f, 0.f, 0.f, 0.f}; ab[ct] = af[ct]; gg[ct] = af[ct]; }
            const bf16_t* xr = sX + (16 * rt + fr) * FZ_ROW;
#pragma unroll
            for (int ks = 0; ks < 2; ++ks) { const bf16x8 xf = *(const bf16x8*)(xr + 1536 + 32 * ks + 8 * fq), xb = *(const bf16x8*)(xr + 1600 + 32 * ks + 8 * fq);
#pragma unroll
                for (int ct = 0; ct < 4; ++ct) { const int n = hc + 16 * ct + fr;
                    af[ct] = mfma16(xf, *(const bf16x8*)(A2 + (size_t)n * 64 + 32 * ks + 8 * fq), af[ct]);
                    ab[ct] = mfma16(xb, *(const bf16x8*)(A2 + (size_t)(512 + n) * 64 + 32 * ks + 8 * fq), ab[ct]); } }
#pragma unroll
            for (int ks = 0; ks < 4; ++ks) { const bf16x8 xg = *(const bf16x8*)(xr + 1664 + 32 * ks + 8 * fq);
#pragma unroll
                for (int ct = 0; ct < 4; ++ct) { const int n = hc + 16 * ct + fr; gg[ct] = mfma16(xg, *(const bf16x8*)(G2 + (size_t)n * 128 + 32 * ks + 8 * fq), gg[ct]); } }
#pragma unroll
            for (int jj = 0; jj < 4; ++jj) { const int tl = 16 * rt + 4 * fq + jj; const size_t row = (size_t)rowt + tl; const bf16_t* xt = sX + tl * FZ_ROW;
                bf16_t* hb = HB + row * DM + 512 + hc;
                float y[4], vv[4]; float sy = 0.f, sb = 0.f;
#pragma unroll
                for (int ct = 0; ct < 4; ++ct) { const int ch = hc + 16 * ct + fr;
                    const float am = 0.5f * (sigmf(p.a0[ch] + af[ct][jj]) + sigmf(p.a0[512 + ch] + ab[ct][jj]));
                    const float r = bf2f(xt[ch]), k = bf2f(xt[512 + ch]); vv[ct] = bf2f(xt[1024 + ch]);
                    sb += r * k * (1.f + (am - 1.f) * p.ka[ch]) * p.rk[ch];
                    y[ct] = bf2f(hb[16 * ct + fr]); sy += y[ct]; }
                sy = red16(sy); sb = red16(sb);
                const float mean = sy * (1.f / 64.f); float vs = 0.f;
#pragma unroll
                for (int ct = 0; ct < 4; ++ct) { const float d = y[ct] - mean; vs += d * d; }
                vs = red16(vs); const float rstd = rsqrtf(vs * (1.f / 64.f) + 64e-5f);
#pragma unroll
                for (int ct = 0; ct < 4; ++ct) { const int ch = hc + 16 * ct + fr; const float yn = (y[ct] - mean) * rstd * p.lng[ch] + p.lnb[ch];
                    hb[16 * ct + fr] = f2bf((yn + sb * vv[ct]) * gg[ct][jj]); } }
        }
    }
}

__device__ __forceinline__ void phase_scan(const P& p, unsigned char* lds, int round = 0) {
    unsigned* ctr = (unsigned*)(p.ws + WS_CTR) + round;
    volatile int* sTask = (volatile int*)(lds + LDS_BYTES - 16);
#pragma unroll 1
    for (;;) {
        __syncthreads();
        if (threadIdx.x == 0) *sTask = (int)atomicAdd(ctr, 1u);
        __syncthreads();
        const int t = __builtin_amdgcn_readfirstlane(*sTask);
        if (t >= 512) break;
#pragma unroll 1
        for (int rep = 0; rep < ((PROBE_DUP == 100 && (t < 64 || (t >= 128 && t < 256))) || (PROBE_DUP == 101 && !(t < 64 || (t >= 128 && t < 256))) ? 2 : 1); ++rep) {
        if (t < 64) mlstm_task(p, lds, 32 + (t >> 3), (t >> 1) & 3, t & 1);
        else if (t < 128) { const int q = t - 64; rwkv_task_w(p, lds, 32 + (q >> 3), q & 7); }
        else if (t < 256) { const int q = t - 128; mlstm_task(p, lds, q >> 2, q & 3, -1); }
        else { const int q = t - 256; rwkv_task_w(p, lds, q >> 3, q & 7); }
        }
    }
}

__device__ void phase_convert_w2(const P& p, unsigned char* lds) {
    float* tile = (float*)lds;
    const int t1 = 16 * 88, t2 = 44 * 16;
    for (int it = blockIdx.x; it < t1 + t2; it += gridDim.x) {
        if (it < t1) do_convert(p.w2in, (bf16_t*)(p.ws + WS_W1), 1024, 5632, 5632, 1, it, tile);
        else do_convert(p.w2out, (bf16_t*)(p.ws + WS_W1B), 2816, 1024, 1024, 0, it - t1, tile);
    }
}

#define XB_TMO      128
#define XB_XCNT(j)  (256  + 64 * (j))
#define XB_XSUB(j)  (1280 + 64 * (j))
#define XB_XGEN(j)  (2304 + 64 * (j))
#define XB_TOP      3328
#define XB_TOPGEN   3392
#define XCD_BAR_WORDS 3456
#define XB_SPIN_CAP (1u << 18)
__device__ __forceinline__ unsigned xb_ld(unsigned* p)              { return __hip_atomic_load(p, __ATOMIC_RELAXED, __HIP_MEMORY_SCOPE_AGENT); }
__device__ __forceinline__ unsigned xb_add(unsigned* p, unsigned v) { return __hip_atomic_fetch_add(p, v, __ATOMIC_RELAXED, __HIP_MEMORY_SCOPE_AGENT); }
__device__ __forceinline__ unsigned xb_xcc_id() { return (unsigned)__builtin_amdgcn_s_getreg((3 << 11) | 20) & 0xFu; }
#define XB_SPIN(cond, bar) do { unsigned _sp = 0; while (cond) { __builtin_amdgcn_s_sleep(1); \
    if ((++_sp & 255u) == 0u) { if (xb_ld(&(bar)[XB_TMO])) break; if (_sp > XB_SPIN_CAP) { atomicAdd(&(bar)[XB_TMO], 1u); break; } } } } while (0)
struct XcdBarrier { unsigned* bar; unsigned x; volatile unsigned* st; };
__device__ __forceinline__ XcdBarrier xcd_barrier_post(unsigned* bar, volatile unsigned* st) {
    XcdBarrier b; b.bar = bar; b.x = xb_xcc_id(); b.st = st;
    if (threadIdx.x == 0) (void)xb_add(&bar[XB_XCNT(b.x)], 1u);
    return b;
}
__device__ __forceinline__ void xcd_barrier_complete(unsigned* bar, unsigned x, unsigned& nloc, unsigned& nx) {
    const unsigned G = gridDim.x * gridDim.y * gridDim.z;
    unsigned sum, cnt, mine, sp = 0u;
    for (;;) {
        sum = 0u; cnt = 0u; mine = 0u;
#pragma unroll
        for (unsigned j = 0; j < 16; ++j) { const unsigned c = xb_ld(&bar[XB_XCNT(j)]); sum += c; cnt += (c > 0u) ? 1u : 0u; mine = (j == x) ? c : mine; }
        if (sum == G) break;
        __builtin_amdgcn_s_sleep(1);
        if ((++sp & 255u) == 0u) { if (xb_ld(&bar[XB_TMO])) break; if (sp > XB_SPIN_CAP) { atomicAdd(&bar[XB_TMO], 1u); break; } }
    }
    nloc = mine > 0u ? mine : 1u; nx = cnt > 0u ? cnt : 1u;
}
__device__ __forceinline__ void xcd_barrier(const XcdBarrier& b) {
    asm volatile("s_waitcnt vmcnt(0)" ::: "memory");
    __syncthreads();
    if (threadIdx.x == 0) {
        unsigned* bar = b.bar;
        __builtin_amdgcn_s_waitcnt(0);
        unsigned nloc = b.st[0], nx = b.st[1];
        if (nloc == 0u) { xcd_barrier_complete(bar, b.x, nloc, nx); b.st[0] = nloc; b.st[1] = nx; }
        const unsigned old = xb_add(&bar[XB_XSUB(b.x)], 1u);
        const unsigned gen = old / nloc;
        if (old + 1u == (gen + 1u) * nloc) {
            __builtin_amdgcn_fence(__ATOMIC_RELEASE, "agent");
            asm volatile("s_waitcnt vmcnt(0)" ::: "memory");
            const unsigned og = xb_add(&bar[XB_TOP], 1u);
            const unsigned tg = og / nx;
            if (og + 1u == (tg + 1u) * nx) xb_add(&bar[XB_TOPGEN], 1u);
            else XB_SPIN(xb_ld(&bar[XB_TOPGEN]) == tg, bar);
            __builtin_amdgcn_fence(__ATOMIC_ACQUIRE, "agent");
            xb_add(&bar[XB_XGEN(b.x)], 1u);
            asm volatile("s_waitcnt vmcnt(0)" ::: "memory");
        } else {
            XB_SPIN(xb_ld(&bar[XB_XGEN(b.x)]) == gen, bar);
            __builtin_amdgcn_fence(__ATOMIC_ACQUIRE, "agent");
            asm volatile("s_waitcnt vmcnt(0)" ::: "memory");
        }
    }
    __syncthreads();
}

constexpr int NPHASE = 12;
template <int PH>
__device__ __forceinline__ void run_phase(const P& p, unsigned char* lds) {
    const float* mod = (const float*)(p.ws + WS_MOD);
    if constexpr (PH == 0) phase0(p, lds);
    if constexpr (PH == 1) phase_normmod(p, 0);
    if constexpr (PH == 2) { EpiSwiglu E{(bf16_t*)(p.ws + WS_U)}; run_gemm(lds, (const bf16_t*)(p.ws + WS_A), (const bf16_t*)(p.ws + WS_W1), 5632, 1024, E); }
    if constexpr (PH == 3) { EpiResid E{p.xp, p.xs, p.out, mod + 2048, 0.5f, 0}; run_gemm(lds, (const bf16_t*)(p.ws + WS_U), (const bf16_t*)(p.ws + WS_W1B), 1024, 2816, E); }
    if constexpr (PH == 4) phase_normmod(p, 1);
    if constexpr (PH == 5) { EpiU E{(bf16_t*)(p.ws + WS_U), (float*)(p.ws + WS_GATES)}; run_gemm(lds, (const bf16_t*)(p.ws + WS_A), (const bf16_t*)(p.ws + WS_BT3), 4096, 1024, E); }
    if constexpr (PH == 6) phase_scan(p, lds);
    if constexpr (PH == 12) phase_rwkv_finalize(p, lds);
    if constexpr (PH == 13) phase_shift((bf16_t*)(p.ws + WS_U), p.mu, (uint4*)lds);
    if constexpr (PH == 7) { EpiResid E{p.xp, p.xs, p.out, mod + 5120, 1.0f, 1}; run_gemm(lds, (const bf16_t*)(p.ws + WS_A), (const bf16_t*)(p.ws + WS_BT4), 1024, 1024, E); }
    if constexpr (PH == 8) { phase_normmod(p, 2); phase_convert_w2(p, lds); }
    if constexpr (PH == 9) { EpiSwiglu E{(bf16_t*)(p.ws + WS_U)}; run_gemm(lds, (const bf16_t*)(p.ws + WS_A), (const bf16_t*)(p.ws + WS_W1), 5632, 1024, E); }
    if constexpr (PH == 10) { EpiResid E{p.xp, p.xs, p.out, mod + 8192, 0.5f, 1}; run_gemm(lds, (const bf16_t*)(p.ws + WS_U), (const bf16_t*)(p.ws + WS_W1B), 1024, 2816, E); }
    if constexpr (PH == 11) phase_finalnorm(p);
}

#if !ONE_LAUNCH
template <int PH>
__global__ void __launch_bounds__(NTHR, 2) k_phase(P p) {
    extern __shared__ __attribute__((aligned(16))) unsigned char lds[];
    run_phase<PH>(p, lds);
}
#endif

#if ONE_LAUNCH
__global__ void __launch_bounds__(NTHR, 2) k_mega(P p) {
    extern __shared__ __attribute__((aligned(16))) unsigned char lds[];
    cg::grid_group grid = cg::this_grid();
    volatile unsigned* xst = (volatile unsigned*)(lds + LDS_BYTES - 32);
    if (threadIdx.x == 0) { xst[0] = 0u; xst[1] = 0u; }
    __syncthreads();
    const XcdBarrier xbar = xcd_barrier_post((unsigned*)(p.ws + WS_BAR), xst);
#define GSYNC() xcd_barrier(xbar)
    if (p.ws == nullptr) grid.sync();
    run_phase<0>(p, lds); GSYNC();
    if (PROBE_DUP == 0) { run_phase<0>(p, lds); GSYNC(); }
    run_phase<1>(p, lds); GSYNC();
    if (PROBE_DUP == 1) { run_phase<1>(p, lds); GSYNC(); }
    run_phase<2>(p, lds); GSYNC();
    if (PROBE_DUP == 2 || PROBE_DUP == 235) { run_phase<2>(p, lds); GSYNC(); }
    run_phase<3>(p, lds); GSYNC();
    if (PROBE_DUP == 3 || PROBE_DUP == 235) { run_phase<3>(p, lds); GSYNC(); }
    run_phase<4>(p, lds); GSYNC();
    if (PROBE_DUP == 4) { run_phase<4>(p, lds); GSYNC(); }
    run_phase<5>(p, lds); GSYNC();
    if (PROBE_DUP == 5 || PROBE_DUP == 235) { run_phase<5>(p, lds); GSYNC(); }
    run_phase<13>(p, lds); GSYNC();
    run_phase<6>(p, lds); GSYNC();
    if (PROBE_DUP == 6) { phase_scan(p, lds, 1); GSYNC(); }
    run_phase<12>(p, lds); GSYNC();
    run_phase<7>(p, lds); GSYNC();
    if (PROBE_DUP == 7) { run_phase<7>(p, lds); GSYNC(); }
    run_phase<8>(p, lds); GSYNC();
    if (PROBE_DUP == 8) { run_phase<8>(p, lds); GSYNC(); }
    run_phase<9>(p, lds); GSYNC();
    if (PROBE_DUP == 9) { run_phase<9>(p, lds); GSYNC(); }
    run_phase<10>(p, lds); GSYNC();
    if (PROBE_DUP == 10) { run_phase<10>(p, lds); GSYNC(); }
    run_phase<11>(p, lds);
    if (PROBE_DUP == 200) { for (int i = 0; i < 20; ++i) GSYNC(); }
}
#endif

#if !ONE_LAUNCH
template <int PH> static void launch_phase(const P& p, int grid, hipStream_t stream) {
    static bool attr = false;
    if (!attr) { (void)hipFuncSetAttribute((const void*)k_phase<PH>, hipFuncAttributeMaxDynamicSharedMemorySize, LDS_BYTES); attr = true; }
    hipLaunchKernelGGL(k_phase<PH>, dim3(grid), dim3(NTHR), LDS_BYTES, stream, p);
}
#endif

extern "C" void kernel_launch(void* const* d_in, const int* in_sizes, int n_in, void* d_out, int out_size, void* d_ws, size_t ws_size, hipStream_t stream) {
    (void)in_sizes; (void)n_in; (void)out_size; (void)ws_size;
    static int grid = 0;
    if (grid == 0) {
        int dev = 0, cus = 0;
        if (hipGetDevice(&dev) != hipSuccess || hipDeviceGetAttribute(&cus, hipDeviceAttributeMultiprocessorCount, dev) != hipSuccess || cus <= 0) cus = 256;
#if ONE_LAUNCH
        (void)hipFuncSetAttribute((const void*)k_mega, hipFuncAttributeMaxDynamicSharedMemorySize, LDS_BYTES);
        int per_cu = 0;
        if (hipOccupancyMaxActiveBlocksPerMultiprocessor(&per_cu, (const void*)k_mega, NTHR, LDS_BYTES) != hipSuccess || per_cu < 1) per_cu = 1;
        (void)hipGetLastError();
#endif
        grid = cus;
    }
    P p{};
    const float** f = (const float**)&p;
    for (int i = 0; i < 35; ++i) f[i] = (const float*)d_in[i];
    p.out = (float*)d_out; p.ws = (unsigned char*)d_ws;
    (void)hipMemsetAsync((char*)d_ws + WS_MOD, 0, NCOND * MODW * sizeof(float) + 256 + 3456 * 4, stream);
#if ONE_LAUNCH
    void* args[] = {&p};
    hipError_t e = hipLaunchCooperativeKernel((const void*)k_mega, dim3(grid), dim3(NTHR), args, LDS_BYTES, stream);
    if (e != hipSuccess) fprintf(stderr, "cooperative launch failed: %s (grid %d)\n", hipGetErrorString(e), grid);
#else
    launch_phase<0>(p, grid, stream); launch_phase<1>(p, grid, stream); launch_phase<2>(p, grid, stream); launch_phase<3>(p, grid, stream);
    launch_phase<4>(p, grid, stream); launch_phase<5>(p, grid, stream); launch_phase<13>(p, grid, stream); launch_phase<6>(p, grid, stream); launch_phase<12>(p, grid, stream); launch_phase<7>(p, grid, stream);
    launch_phase<8>(p, grid, stream); launch_phase<9>(p, grid, stream); launch_phase<10>(p, grid, stream); launch_phase<11>(p, grid, stream);
#endif
}
```

```cpp
#include <hip/hip_runtime.h>
#include <hip/hip_cooperative_groups.h>
#include <cstdio>
#include <cstdint>
namespace cg = cooperative_groups;

#ifndef PROBE_DUP
#define PROBE_DUP -1
#endif
#ifndef ONE_LAUNCH
#define ONE_LAUNCH 1
#endif

#define LDS_BARRIER() do { asm volatile("s_waitcnt lgkmcnt(0)" ::: "memory"); __builtin_amdgcn_s_barrier(); asm volatile("" ::: "memory"); } while (0)
__device__ __forceinline__ int opaque_tid() { int z = 0; asm volatile("" : "+v"(z)); return (int)threadIdx.x + z; }

namespace pg8 {
#define PG8_LAS __attribute__((address_space(3)))
typedef unsigned short bf16_t;
typedef short bf16x8 __attribute__((ext_vector_type(8)));
typedef float f32x4 __attribute__((ext_vector_type(4)));
typedef unsigned u32x4 __attribute__((ext_vector_type(4)));
constexpr int BM = 256, BK = 64, HALF = 128, HTB = HALF * BK * 2, STAGE_BYTES = 8 * HTB, NXCD = 8, WGM = 8;

__host__ __device__ __forceinline__ int lds_byte(int r, int c) { const int st = (r >> 4) * 2 + (c >> 5), rr = r & 15, cc = c & 31, ob = rr * 64 + cc * 2; return st * 1024 + (ob ^ (((ob >> 9) & 1) << 5)); }
__host__ __device__ __forceinline__ void stage_rc(int b, int& R, int& C) { const int st = b / 1024, sb = b % 1024, swz = sb ^ (((sb >> 9) & 1) << 5); R = (st >> 1) * 16 + swz / 64; C = (st & 1) * 32 + (swz % 64) / 2; }
__host__ __device__ __forceinline__ int perm32(int rho) { const int n = rho >> 4, i = rho & 15; return 8 * (i >> 2) + 4 * n + (i & 3); }

struct Unit { int pm, pn; };
struct Gemm { const bf16_t* A; const bf16_t* Bt; int M, N, K; };

struct StaticOrder {
    int nM, nN, nwg, G, c;
    __host__ __device__ void init(int M, int N, int G_, int c_) { nM = M / BM; nN = N / BM; nwg = nM * nN; G = G_; c = c_; }
    __host__ __device__ bool next(int i, Unit& u) const {
        const long L = (long)i * G + c; if (L >= nwg) return false;
        int wgid = (int)L; { const int q = nwg / NXCD, r = nwg % NXCD, xcd = wgid % NXCD, off = wgid / NXCD; wgid = (xcd < r ? xcd * (q + 1) : r * (q + 1) + (xcd - r) * q) + off; }
        const int nig = WGM * nN, gid = wgid / nig, fm = gid * WGM, gsz = (nM - fm) < WGM ? (nM - fm) : WGM;
        u.pm = fm + ((wgid % nig) % gsz); u.pn = (wgid % nig) / gsz; return true;
    }
    __device__ __forceinline__ void a_ready(const Unit&) const {}
    __device__ __forceinline__ void done(const Unit&) const {}
};

__device__ __forceinline__ unsigned cvt_pk_bf16(float lo, float hi) { unsigned r; asm volatile("v_cvt_pk_bf16_f32 %0, %1, %2" : "=v"(r) : "v"(lo), "v"(hi)); return r; }

template <class Epi, class Sched, bool ALIGN_EPI = false, bool SP2 = false>
__device__ __forceinline__ void gemm_phase(PG8_LAS unsigned char* lds, const Gemm g, const Sched& S, const Epi& E) {
    const int tid = opaque_tid(), wid = __builtin_amdgcn_readfirstlane((int)threadIdx.x >> 6), lane = tid & 63, wr = wid >> 2, wc = wid & 3, fr = lane & 15, fq = lane >> 4;
    const int K = g.K, nt = K / BK;
    unsigned voffA[2], voffB[2];
#pragma unroll
    for (int i = 0; i < 2; ++i) { int R, C; stage_rc(tid * 16 + i * 8192, R, C); const int Rb = Epi::PERM ? ((R & ~31) + perm32(R & 31)) : R;
        voffA[i] = (unsigned)(R * K + C) * 2u; voffB[i] = (unsigned)(Rb * K + C) * 2u; }
    const size_t kstep = (size_t)(BK * 2);
    const size_t hstep = (size_t)HALF * K * 2;
    const size_t tstep = 2 * hstep;
    const unsigned ldsw = (unsigned)wid * 1024u;
    const int aoff = lds_byte(wr * 64 + fr, fq * 8), boff = lds_byte(wc * 32 + fr, fq * 8);
#define PG8_SA(b, h) (((b) * 2 + (h)) * HTB)
#define PG8_SB(b, h) ((4 + (b) * 2 + (h)) * HTB)
#define PG8_STAGE(bufoff, gbase, voff) do { _Pragma("unroll") for (int _i = 0; _i < 2; ++_i) \
        __builtin_amdgcn_global_load_lds((const unsigned*)((const char*)(gbase) + (voff)[_i]), (PG8_LAS unsigned*)(lds + (bufoff) + ldsw + _i * 8192), 16, 0, 0); } while (0)
#define PG8_LDA(dst, b, h) do { _Pragma("unroll") for (int m = 0; m < 4; ++m) _Pragma("unroll") for (int k = 0; k < 2; ++k) dst[m][k] = *(const PG8_LAS bf16x8*)(lds + PG8_SA(b, h) + aoff + m * 2048 + k * 1024); } while (0)
#define PG8_LDB(dst, b, h) do { _Pragma("unroll") for (int n = 0; n < 2; ++n) _Pragma("unroll") for (int k = 0; k < 2; ++k) dst[n][k] = *(const PG8_LAS bf16x8*)(lds + PG8_SB(b, h) + boff + n * 2048 + k * 1024); } while (0)
#define PG8_MMA(ai, bj, At, Bt) do { __builtin_amdgcn_s_setprio(1); _Pragma("unroll") for (int m = 0; m < 4; ++m) _Pragma("unroll") for (int n = 0; n < 2; ++n) _Pragma("unroll") for (int k = 0; k < 2; ++k) \
        acc[ai][bj][m][n] = __builtin_amdgcn_mfma_f32_16x16x32_bf16(Bt[n][k], At[m][k], acc[ai][bj][m][n], 0, 0, 0); __builtin_amdgcn_s_setprio(0); } while (0)
#define PG8_WAIT_V(n) asm volatile("s_waitcnt vmcnt(" #n ")" ::: "memory")
#define PG8_WAIT_L(n) asm volatile("s_waitcnt lgkmcnt(" #n ")" ::: "memory")
#define PG8_BAR __builtin_amdgcn_s_barrier()
#define PG8_SCHED __builtin_amdgcn_sched_barrier(0)
    Unit cur, nxt; int ui = 0;
    if (!S.next(0, cur)) return;
    f32x4 acc[2][2][4][2];
#pragma unroll
    for (int a = 0; a < 2; ++a)
#pragma unroll
        for (int b = 0; b < 2; ++b)
#pragma unroll
            for (int m = 0; m < 4; ++m)
#pragma unroll
                for (int n = 0; n < 2; ++n) acc[a][b][m][n] = (f32x4){0.f, 0.f, 0.f, 0.f};
    bf16x8 At[4][2], B0[2][2], B1[2][2];
    const char* cA = (const char*)g.A + (size_t)cur.pm * tstep; const char* cB = (const char*)g.Bt + (size_t)cur.pn * tstep;
    S.a_ready(cur);
    if constexpr (SP2) {
        PG8_STAGE(PG8_SB(0, 0), cB, voffB); PG8_STAGE(PG8_SB(0, 1), cB + hstep, voffB); PG8_STAGE(PG8_SA(0, 0), cA, voffA); PG8_STAGE(PG8_SA(0, 1), cA + hstep, voffA);
        if (wr == 1) PG8_BAR;
        PG8_WAIT_V(2); PG8_BAR;
        PG8_STAGE(PG8_SB(1, 0), cB + kstep, voffB); PG8_STAGE(PG8_SA(1, 0), cA + kstep, voffA); PG8_STAGE(PG8_SB(1, 1), cB + hstep + kstep, voffB);
        PG8_WAIT_V(6); PG8_BAR;
    } else {
        PG8_STAGE(PG8_SB(0, 0), cB, voffB); PG8_STAGE(PG8_SA(0, 0), cA, voffA); PG8_STAGE(PG8_SB(0, 1), cB + hstep, voffB); PG8_STAGE(PG8_SA(0, 1), cA + hstep, voffA);
        if (wr == 1) PG8_BAR;
        PG8_WAIT_V(4); PG8_BAR;
        PG8_STAGE(PG8_SB(1, 0), cB + kstep, voffB); PG8_STAGE(PG8_SA(1, 0), cA + kstep, voffA); PG8_STAGE(PG8_SB(1, 1), cB + hstep + kstep, voffB);
        PG8_WAIT_V(6); PG8_BAR;
    }
    for (;;) {
        const bool has_next = S.next(ui + 1, nxt);
        const char* nA = has_next ? (const char*)g.A + (size_t)nxt.pm * tstep : cA; const char* nB = has_next ? (const char*)g.Bt + (size_t)nxt.pn * tstep : cB;
        for (int t = 0; t < nt; t += 2) {
            const bool last = (t == nt - 2);
            const char* a1 = cA + (size_t)(t + 1) * kstep;
            const char* a2 = last ? nA : cA + (size_t)(t + 2) * kstep; const char* b2 = last ? nB : cB + (size_t)(t + 2) * kstep;
            const char* a3 = a2 + kstep; const char* b3 = b2 + kstep;
            if (last && has_next) S.a_ready(nxt);
            if constexpr (SP2) {
            PG8_LDB(B0, 0, 0); PG8_LDB(B1, 0, 1); PG8_SCHED; PG8_LDA(At, 0, 0); PG8_STAGE(PG8_SA(1, 1), a1 + hstep, voffA);
            PG8_WAIT_V(8); PG8_WAIT_L(0); PG8_BAR; PG8_MMA(0, 0, At, B0); PG8_MMA(0, 1, At, B1); PG8_BAR; PG8_SCHED;
            PG8_LDA(At, 0, 1); PG8_STAGE(PG8_SB(0, 0), b2, voffB); PG8_STAGE(PG8_SB(0, 1), b2 + hstep, voffB); PG8_STAGE(PG8_SA(0, 0), a2, voffA);
            PG8_WAIT_V(8); PG8_WAIT_L(0); PG8_BAR; PG8_MMA(1, 0, At, B0); PG8_MMA(1, 1, At, B1); PG8_BAR; PG8_SCHED;
            PG8_LDB(B0, 1, 0); PG8_LDB(B1, 1, 1); PG8_SCHED; PG8_LDA(At, 1, 0); PG8_STAGE(PG8_SA(0, 1), a2 + hstep, voffA);
            PG8_WAIT_V(8); PG8_WAIT_L(0); PG8_BAR; PG8_MMA(0, 0, At, B0); PG8_MMA(0, 1, At, B1); PG8_BAR; PG8_SCHED;
            PG8_LDA(At, 1, 1); PG8_STAGE(PG8_SB(1, 0), b3, voffB); PG8_STAGE(PG8_SB(1, 1), b3 + hstep, voffB); PG8_STAGE(PG8_SA(1, 0), a3, voffA);
            PG8_WAIT_V(8); PG8_WAIT_L(0); PG8_BAR; PG8_MMA(1, 0, At, B0); PG8_MMA(1, 1, At, B1); PG8_BAR; PG8_SCHED;
            } else {
            PG8_LDB(B0, 0, 0); PG8_SCHED; PG8_LDA(At, 0, 0); PG8_STAGE(PG8_SA(1, 1), a1 + hstep, voffA);
            PG8_WAIT_L(8); PG8_BAR; PG8_WAIT_L(0); PG8_MMA(0, 0, At, B0); PG8_BAR; PG8_SCHED;
            PG8_LDB(B1, 0, 1); PG8_STAGE(PG8_SB(0, 0), b2, voffB);
            PG8_BAR; PG8_WAIT_L(0); PG8_MMA(0, 1, At, B1); PG8_BAR;
            PG8_LDA(At, 0, 1); PG8_STAGE(PG8_SA(0, 0), a2, voffA);
            PG8_BAR; PG8_WAIT_L(0); PG8_MMA(1, 0, At, B0); PG8_BAR; PG8_SCHED;
            PG8_STAGE(PG8_SB(0, 1), b2 + hstep, voffB);
            PG8_WAIT_V(6); PG8_BAR; PG8_MMA(1, 1, At, B1); PG8_BAR;
            PG8_LDB(B0, 1, 0); PG8_SCHED; PG8_LDA(At, 1, 0); PG8_STAGE(PG8_SA(0, 1), a2 + hstep, voffA);
            PG8_WAIT_L(8); PG8_BAR; PG8_WAIT_L(0); PG8_MMA(0, 0, At, B0); PG8_BAR; PG8_SCHED;
            PG8_LDB(B1, 1, 1); PG8_STAGE(PG8_SB(1, 0), b3, voffB);
            PG8_BAR; PG8_WAIT_L(0); PG8_MMA(0, 1, At, B1); PG8_BAR;
            PG8_LDA(At, 1, 1); PG8_STAGE(PG8_SA(1, 0), a3, voffA);
            PG8_BAR; PG8_WAIT_L(0); PG8_MMA(1, 0, At, B0); PG8_BAR; PG8_SCHED;
            PG8_STAGE(PG8_SB(1, 1), b3 + hstep, voffB);
            PG8_WAIT_V(6); PG8_BAR; PG8_MMA(1, 1, At, B1); PG8_BAR;
            }
        }
        if constexpr (ALIGN_EPI) { if (wr == 0) PG8_BAR; }
        E(acc, cur, wr, wc, fr, fq); S.done(cur);
        if (!has_next) break;
#pragma unroll
        for (int a = 0; a < 2; ++a)
#pragma unroll
            for (int b = 0; b < 2; ++b)
#pragma unroll
                for (int m = 0; m < 4; ++m)
#pragma unroll
                    for (int n = 0; n < 2; ++n) acc[a][b][m][n] = (f32x4){0.f, 0.f, 0.f, 0.f};
        cur = nxt; cA = nA; cB = nB; ++ui;
        if constexpr (ALIGN_EPI) { if (wr == 1) PG8_BAR; }
    }
    PG8_WAIT_V(0);
    if constexpr (!ALIGN_EPI) { if (wr == 0) PG8_BAR; }
    PG8_BAR;
#undef PG8_SA
#undef PG8_SB
#undef PG8_STAGE
#undef PG8_LDA
#undef PG8_LDB
#undef PG8_MMA
#undef PG8_WAIT_V
#undef PG8_WAIT_L
#undef PG8_BAR
#undef PG8_SCHED
}
}

using pg8::bf16_t; using pg8::bf16x8; using pg8::f32x4;

constexpr int MT = 24576, DM = 1024, DFF = 2816, NCTX = 8192;
constexpr int UW = 3984;
constexpr int NCOND = 9, MODW = 9216;
constexpr size_t MiB = 1ull << 20;
constexpr size_t WS_A = 0, WS_U = 48 * MiB, WS_W1 = WS_U + 132 * MiB, WS_W1B = WS_W1 + (size_t)5632 * 1024 * 2,
                 WS_BT3 = 235 * MiB, WS_HB2 = 235 * MiB  ,
                 WS_BT4 = 251 * MiB, WS_MOD = 253 * MiB, WS_CTR = WS_MOD + 9 * 9216 * 4  , WS_BAR = WS_CTR + 256  , WS_GATES = 254 * MiB;
constexpr size_t WS_A2BF = 255 * MiB + 512 * 1024, WS_G2BF = WS_A2BF + 2 * 512 * 64 * 2;
constexpr int OUT_C = 25165824, OUT_N = 29360128, OUT_MM = 29392896, OUT_S = 29393152;
constexpr int LDS_BYTES = 163840;
constexpr int NTHR = 512;

struct P {
    const float *xp, *xs, *c, *sC, *sn, *sm, *sS, *cctx, *ada_w, *ada_b, *n1, *w1in, *w1out, *nmix, *wmin, *wmout,
        *cw, *cb, *gb, *hg, *mu, *w0, *w2, *a0, *a2, *g2, *kk, *ka, *rk, *lng, *lnb, *n2, *w2in, *w2out, *nf;
    float* out; unsigned char* ws;
};

typedef __bf16 hwbf16x2 __attribute__((ext_vector_type(2)));
typedef float hwf32x2 __attribute__((ext_vector_type(2)));
__device__ __forceinline__ unsigned pk2(float a, float b) { const hwf32x2 v = {a, b}; const hwbf16x2 r = __builtin_convertvector(v, hwbf16x2); return __builtin_bit_cast(unsigned, r); }
__device__ __forceinline__ unsigned short f2bf(float f) { return (unsigned short)(pk2(f, f) & 0xffffu); }
__device__ __forceinline__ float bf2f(unsigned short b) { return __uint_as_float(((unsigned)b) << 16); }
__device__ __forceinline__ int cond_of(int row) { return row < NCTX ? 0 : 1 + ((row - NCTX) >> 11); }
__device__ __forceinline__ float fexp(float x) { return __builtin_amdgcn_exp2f(x * 1.4426950408889634f); }
__device__ __forceinline__ float flog(float x) { return __builtin_amdgcn_logf(x) * 0.6931471805599453f; }
__device__ __forceinline__ float siluf(float x) { return x * __builtin_amdgcn_rcpf(1.f + fexp(-x)); }
__device__ __forceinline__ float sigmf(float x) { return __builtin_amdgcn_rcpf(1.f + fexp(-x)); }
__device__ __forceinline__ float tanh_fast(float x) { return 1.f - 2.f * __builtin_amdgcn_rcpf(1.f + fexp(2.f * x)); }
__device__ __forceinline__ float softplus_fast(float z) { return fmaxf(z, 0.f) + flog(1.f + fexp(-fabsf(z))); }
__device__ __forceinline__ const float* xrow(const P& p, int row) { return row < NCTX ? p.xp + (size_t)row * DM : p.xs + (size_t)(row - NCTX) * DM; }
__device__ __forceinline__ f32x4 mfma16(bf16x8 a, bf16x8 b, f32x4 c) { return __builtin_amdgcn_mfma_f32_16x16x32_bf16(a, b, c, 0, 0, 0); }
__device__ __forceinline__ void unpack8(uint4 v, float* f) {
    f[0] = __uint_as_float(v.x << 16); f[1] = __uint_as_float(v.x & 0xffff0000u); f[2] = __uint_as_float(v.y << 16); f[3] = __uint_as_float(v.y & 0xffff0000u);
    f[4] = __uint_as_float(v.z << 16); f[5] = __uint_as_float(v.z & 0xffff0000u); f[6] = __uint_as_float(v.w << 16); f[7] = __uint_as_float(v.w & 0xffff0000u);
}

__device__ __forceinline__ int colmap(int kind, int n) {
    if (kind == 0) return n;
    if (kind == 1) { const int t = n >> 8, bj = (n >> 7) & 1, c = n & 127; return bj * DFF + t * 128 + c; }
    if (n < 2048) return n; if (n < 3968) return n + 16; if (n < 3984) return n - 3968 + 2048; return -1;
}
__device__ void convert_tile(const float* __restrict__ src, bf16_t* __restrict__ dst, int K, int Nsrc, int kind, int k0, int n0, float* tile) {
    const int tid = opaque_tid();
    { const int n = tid & 63, kr = tid >> 6; const int sc = colmap(kind, n0 + n);
#pragma unroll
      for (int i = 0; i < 8; ++i) { const int k = kr + 8 * i; tile[k * 65 + n] = sc >= 0 ? src[(size_t)(k0 + k) * Nsrc + sc] : 0.f; } }
    __syncthreads();
    { const int nn = tid >> 3, kg = tid & 7; unsigned w[4];
#pragma unroll
      for (int j = 0; j < 4; ++j) w[j] = pk2(tile[(kg * 8 + 2 * j) * 65 + nn], tile[(kg * 8 + 2 * j + 1) * 65 + nn]);
      *(uint4*)(dst + (size_t)(n0 + nn) * K + k0 + kg * 8) = make_uint4(w[0], w[1], w[2], w[3]); }
    __syncthreads();
}
__device__ void convert_jobs(const P& p, int first, int njobs_sel, unsigned char* lds, int item0, int nitems_before) {}

__device__ void do_convert(const float* src, bf16_t* dst, int K, int Nsrc, int Ndst, int kind, int t, float* tile) {
    const int nkt = K / 64; const int kt = t % nkt, ntile = t / nkt; (void)Ndst;
    convert_tile(src, dst, K, Nsrc, kind, kt * 64, ntile * 64, tile);
}

__device__ void phase0(const P& p, unsigned char* lds) {
    float* tile = (float*)lds;
    const int tid = opaque_tid();
    const int n_ada = 36 * 8;
    const int t1 = 16 * 88, t2 = 44 * 16, t3 = 16 * 64, t4 = 16 * 16, t5 = 8, t6 = 8, t7 = 16;
    const int total = n_ada + t1 + t2 + t3 + t4 + t5 + t6 + t7;
    for (int it = blockIdx.x; it < total; it += gridDim.x) {
        if (it < n_ada) {
            const int cgp = it % 36, kc = it / 36;
            float* sc = tile;
            __syncthreads();
            for (int i = tid; i < NCOND * 128; i += NTHR) { const int c = i >> 7, k = i & 127; const float v = c == 0 ? p.cctx[kc * 128 + k] : p.c[(c - 1) * DM + kc * 128 + k]; sc[i] = siluf(v); }
            __syncthreads();
            const int col = cgp * 256 + (tid & 255), kh = tid >> 8;
            float acc[NCOND];
#pragma unroll
            for (int c = 0; c < NCOND; ++c) acc[c] = 0.f;
            const float* w = p.ada_w + (size_t)(kc * 128 + kh * 64) * MODW + col;
#pragma unroll 4
            for (int k = 0; k < 64; ++k) { const float wv = w[(size_t)k * MODW];
#pragma unroll
                for (int c = 0; c < NCOND; ++c) acc[c] += sc[c * 128 + kh * 64 + k] * wv; }
            float* mod = (float*)(p.ws + WS_MOD);
            const float bias = (kc == 0 && kh == 0) ? p.ada_b[col] : 0.f;
#pragma unroll
            for (int c = 0; c < NCOND; ++c) atomicAdd(mod + c * MODW + col, acc[c] + bias);
            __syncthreads();
        } else {
            int t = it - n_ada;
            if (t < t1) do_convert(p.w1in, (bf16_t*)(p.ws + WS_W1), 1024, 5632, 5632, 1, t, tile);
            else if ((t -= t1) < t2) do_convert(p.w1out, (bf16_t*)(p.ws + WS_W1B), 2816, 1024, 1024, 0, t, tile);
            else if ((t -= t2) < t3) do_convert(p.wmin, (bf16_t*)(p.ws + WS_BT3), 1024, 3984, 4096, 2, t, tile);
            else if ((t -= t3) < t4) do_convert(p.wmout, (bf16_t*)(p.ws + WS_BT4), 1024, 1024, 1024, 0, t, tile);
            else if ((t -= t4) < t5) do_convert(p.a2, (bf16_t*)(p.ws + WS_A2BF), 64, 512, 512, 0, t, tile);
            else if ((t -= t5) < t6) do_convert(p.a2 + 64 * 512, (bf16_t*)(p.ws + WS_A2BF) + 512 * 64, 64, 512, 512, 0, t, tile);
            else { t -= t6; do_convert(p.g2, (bf16_t*)(p.ws + WS_G2BF), 128, 512, 512, 0, t, tile); }
        }
    }
}

__device__ void phase_normmod(const P& p, int which) {
    const int lane = opaque_tid() & 63, wave = threadIdx.x >> 6;
    const float* gain = which == 0 ? p.n1 : (which == 1 ? p.nmix : p.n2);
    const float* mod = (const float*)(p.ws + WS_MOD);
    bf16_t* A = (bf16_t*)(p.ws + WS_A);
    for (int row = blockIdx.x * 8 + wave; row < MT; row += gridDim.x * 8) {
        const float* src = which == 0 ? xrow(p, row) : p.out + (size_t)row * DM;
        float4 v[4]; float ss = 0.f;
#pragma unroll
        for (int i = 0; i < 4; ++i) { v[i] = *(const float4*)(src + lane * 4 + 256 * i); ss += v[i].x * v[i].x + v[i].y * v[i].y + v[i].z * v[i].z + v[i].w * v[i].w; }
#pragma unroll
        for (int o = 32; o >= 1; o >>= 1) ss += __shfl_xor(ss, o);
        const float rstd = rsqrtf(ss * (1.f / 1024.f) + 1e-6f);
        const float* sh = mod + cond_of(row) * MODW + which * 3072; const float* sc = sh + 1024;
#pragma unroll
        for (int i = 0; i < 4; ++i) { const int col = lane * 4 + 256 * i;
            const float4 g = *(const float4*)(gain + col), s4 = *(const float4*)(sh + col), c4 = *(const float4*)(sc + col);
            const float o0 = v[i].x * rstd * g.x * (1.f + c4.x) + s4.x, o1 = v[i].y * rstd * g.y * (1.f + c4.y) + s4.y,
                        o2 = v[i].z * rstd * g.z * (1.f + c4.z) + s4.z, o3 = v[i].w * rstd * g.w * (1.f + c4.w) + s4.w;
            *(uint2*)(A + (size_t)row * DM + col) = make_uint2(pk2(o0, o1), pk2(o2, o3)); }
    }
}
__device__ void phase_finalnorm(const P& p) {
    const int lane = opaque_tid() & 63, wave = threadIdx.x >> 6;
    for (int row = blockIdx.x * 8 + wave; row < MT; row += gridDim.x * 8) {
        float* src = p.out + (size_t)row * DM;
        float4 v[4]; float ss = 0.f;
#pragma unroll
        for (int i = 0; i < 4; ++i) { v[i] = *(const float4*)(src + lane * 4 + 256 * i); ss += v[i].x * v[i].x + v[i].y * v[i].y + v[i].z * v[i].z + v[i].w * v[i].w; }
#pragma unroll
        for (int o = 32; o >= 1; o >>= 1) ss += __shfl_xor(ss, o);
        const float rstd = rsqrtf(ss * (1.f / 1024.f) + 1e-6f);
#pragma unroll
        for (int i = 0; i < 4; ++i) { const int col = lane * 4 + 256 * i; const float4 g = *(const float4*)(p.nf + col);
            *(float4*)(src + col) = make_float4(v[i].x * rstd * g.x, v[i].y * rstd * g.y, v[i].z * rstd * g.z, v[i].w * rstd * g.w); }
    }
}

struct EpiSwiglu {
    static constexpr bool PERM = true;
    bf16_t* O;
    __device__ __forceinline__ void operator()(const f32x4 (&acc)[2][2][4][2], const pg8::Unit& u, int wr, int wc, int fr, int fq) const {
        const int row0 = u.pm * 256 + wr * 64 + fr, col0 = u.pn * 128 + wc * 32 + 8 * fq;
#pragma unroll
        for (int ai = 0; ai < 2; ++ai)
#pragma unroll
            for (int m = 0; m < 4; ++m) { bf16_t* rowp = O + (size_t)(row0 + ai * 128 + m * 16) * DFF + col0;
                float r[8];
#pragma unroll
                for (int n = 0; n < 2; ++n)
#pragma unroll
                    for (int j = 0; j < 4; ++j) r[n * 4 + j] = siluf(acc[ai][0][m][n][j]) * acc[ai][1][m][n][j];
                pg8::u32x4 w; w.x = pg8::cvt_pk_bf16(r[0], r[1]); w.y = pg8::cvt_pk_bf16(r[2], r[3]); w.z = pg8::cvt_pk_bf16(r[4], r[5]); w.w = pg8::cvt_pk_bf16(r[6], r[7]);
                *(pg8::u32x4*)rowp = w; }
    }
};
struct EpiResid {
    static constexpr bool PERM = false;
    const float* xp; const float* xs; float* out; const float* ga; float coef; int inplace;
    __device__ __forceinline__ void operator()(const f32x4 (&acc)[2][2][4][2], const pg8::Unit& u, int wr, int wc, int fr, int fq) const {
        const int row0 = u.pm * 256 + wr * 64 + fr, col0 = u.pn * 256 + wc * 32 + 4 * fq;
        const float* gap = ga + cond_of(u.pm * 256) * MODW;
        f32x4 gv[2][2];
#pragma unroll
        for (int bj = 0; bj < 2; ++bj)
#pragma unroll
            for (int n = 0; n < 2; ++n) gv[bj][n] = *(const f32x4*)(gap + col0 + bj * 128 + n * 16) * coef;
#pragma unroll
        for (int ai = 0; ai < 2; ++ai)
#pragma unroll
            for (int m = 0; m < 4; ++m) { const int row = row0 + ai * 128 + m * 16;
                const float* base = inplace ? out + (size_t)row * DM : (row < NCTX ? xp + (size_t)row * DM : xs + (size_t)(row - NCTX) * DM);
                float* op = out + (size_t)row * DM;
#pragma unroll
                for (int bj = 0; bj < 2; ++bj)
#pragma unroll
                    for (int n = 0; n < 2; ++n) { const int c = col0 + bj * 128 + n * 16; const f32x4 b4 = *(const f32x4*)(base + c);
                        *(f32x4*)(op + c) = b4 + gv[bj][n] * acc[ai][bj][m][n]; } }
    }
};
struct EpiU {
    static constexpr bool PERM = true;
    bf16_t* U; float* gates;
    __device__ __forceinline__ void operator()(const f32x4 (&acc)[2][2][4][2], const pg8::Unit& u, int wr, int wc, int fr, int fq) const {
        const int row0 = u.pm * 256 + wr * 64 + fr;
#pragma unroll
        for (int bj = 0; bj < 2; ++bj) { const int col0 = u.pn * 256 + bj * 128 + wc * 32 + 8 * fq;
            if (col0 < UW) {
#pragma unroll
                for (int ai = 0; ai < 2; ++ai)
#pragma unroll
                    for (int m = 0; m < 4; ++m) { const int row = row0 + ai * 128 + m * 16; const f32x4 v0 = acc[ai][bj][m][0], v1 = acc[ai][bj][m][1];
                        pg8::u32x4 w; w.x = pg8::cvt_pk_bf16(v0[0], v0[1]); w.y = pg8::cvt_pk_bf16(v0[2], v0[3]); w.z = pg8::cvt_pk_bf16(v1[0], v1[1]); w.w = pg8::cvt_pk_bf16(v1[2], v1[3]);
                        *(pg8::u32x4*)(U + (size_t)row * UW + col0) = w;
                        if (col0 >= 3968) { float* gp = gates + (size_t)row * 16 + (col0 - 3968); *(f32x4*)gp = v0; *(f32x4*)(gp + 4) = v1; } } } }
    }
};

template <class Epi>
__device__ __forceinline__ void run_gemm(unsigned char* lds, const bf16_t* A, const bf16_t* Bt, int N, int K, const Epi& E) {
    pg8::Gemm g{A, Bt, MT, N, K}; pg8::StaticOrder S; S.init(MT, N, (int)gridDim.x, (int)blockIdx.x);
    pg8::gemm_phase<Epi, pg8::StaticOrder, true, true>((PG8_LAS unsigned char*)lds, g, S, E);
}

constexpr int ML_SK = 0, ML_KWT = 17408, ML_VT = ML_KWT + 18432, ML_CB = ML_VT + 20736, ML_F = ML_CB + 21760, ML_CW = ML_F + 2048, ML_END = ML_CW + 4096;
static_assert(ML_END <= LDS_BYTES, "mlstm lds");

__device__ __forceinline__ unsigned short ld_u16_agent(const bf16_t* p) { return __hip_atomic_load(p, __ATOMIC_RELAXED, __HIP_MEMORY_SCOPE_AGENT); }

__device__ __forceinline__ void conv3_row8(const bf16_t* up, bool hasp, bool hasn, const float* cwp, float* x) {
    float t[8];
    unpack8(*(const uint4*)up, t);
#pragma unroll
    for (int i = 0; i < 8; ++i) x[i] = cwp[768 + i] + cwp[256 + i] * t[i];
    if (hasp) { unpack8(*(const uint4*)(up - UW), t);
#pragma unroll
        for (int i = 0; i < 8; ++i) x[i] += cwp[i] * t[i]; }
    if (hasn) { unpack8(*(const uint4*)(up + UW), t);
#pragma unroll
        for (int i = 0; i < 8; ++i) x[i] += cwp[512 + i] * t[i]; }
}

__device__ __forceinline__ void mlstm_task(const P& p, unsigned char* lds, int bg, int h, int dsel) {
    const int wv = __builtin_amdgcn_readfirstlane((int)threadIdx.x >> 6), rw = wv & 3, cw = wv >> 2;
    const bool ctx = bg < 32; const int T = ctx ? 256 : 2048, nc = T / 64; const int row0 = ctx ? bg * 256 : NCTX + (bg - 32) * 2048;
    bf16_t* sK = (bf16_t*)(lds + ML_SK); bf16_t* sKwT = (bf16_t*)(lds + ML_KWT); bf16_t* sVT = (bf16_t*)(lds + ML_VT); bf16_t* sCb = (bf16_t*)(lds + ML_CB); bf16_t* sS = sCb;
    float* sA = (float*)(lds + ML_F); float* sM = sA + 64; float* sBb = sM + 64; float* sDen = sBb + 64; float* sScal = sDen + 64; float* sRed = sScal + 16;
    float* sCW = (float*)(lds + ML_CW);
    const bf16_t* U = (const bf16_t*)(p.ws + WS_U); const float* GATES = (const float*)(p.ws + WS_GATES); bf16_t* HB = (bf16_t*)(p.ws + WS_A); bf16_t* HB2 = (bf16_t*)(p.ws + WS_HB2);
    const int d_lo = dsel < 0 ? 0 : dsel, d_hi = dsel < 0 ? 2 : dsel + 1;
    const int ct_a = cw ? 3 : 0;
    const int ct_b = cw ? 7 : 5;
    const int n_a = cw ? 2 : 3;

    __syncthreads();
    { const int tid = threadIdx.x;
      for (int i = tid; i < 1024; i += NTHR) { const int a = i >> 8, cc = i & 255, gch = (cc >> 7) * 512 + h * 128 + (cc & 127); sCW[i] = a < 3 ? p.cw[a * 1024 + gch] : p.cb[gch]; }
      for (int i = tid; i < 16 * 72; i += NTHR) { const int r = 128 + i / 72; sVT[r * 72 + (i % 72)] = (r == 128) ? (bf16_t)0x3F80 : (bf16_t)0; } }

#pragma unroll 1
    for (int dir = d_lo; dir < d_hi; ++dir) {
        f32x4 Cacc[9]; float m_prev = 0.f;
        { int z0 = 0; asm volatile("" : "+v"(z0)); const int tid = (int)threadIdx.x + z0, fr = tid & 15, fq = (tid >> 4) & 3;
#pragma unroll
          for (int ct = 0; ct < 9; ++ct) Cacc[ct] = (f32x4){0.f, 0.f, 0.f, 0.f};
          if (!ctx) { const int sidx = ((bg - 32) * 2 + dir) * 4 + h; const float* C0 = p.sC + (size_t)sidx * 16384; const float* n0 = p.sn + (size_t)sidx * 128;
#pragma unroll
              for (int j = 0; j < 4; ++j) { const int d = 16 * wv + 4 * fq + j;
#pragma unroll
                  for (int ct = 0; ct < 8; ++ct) Cacc[ct][j] = C0[d * 128 + 16 * ct + fr];
                  Cacc[8][j] = fr == 0 ? n0[d] : 0.f; }
              m_prev = p.sm[sidx]; } }
        const float gbi = p.gb[dir * 4 + h], gbf = p.gb[8 + dir * 4 + h];
        const bool second = dsel < 0 && dir == 1;
#pragma unroll 1
        for (int s = 0; s < nc; ++s) {
            const int c = dir ? nc - 1 - s : s;
            int zz = 0; asm volatile("" : "+v"(zz));
            const int tid = (int)threadIdx.x + zz, lane = tid & 63, fr = tid & 15, fq = (tid >> 4) & 3;
            uint4 kc[2], kp[2], kn[2], vv[2];
#pragma unroll
            for (int g = 0; g < 2; ++g) { const int idx = tid + 512 * g, sl = idx >> 4, d0 = (idx & 15) * 8; const int tl = dir ? 63 - sl : sl, tok = c * 64 + tl;
                const bf16_t* up = U + ((size_t)row0 + tok) * UW + 512 + h * 128 + d0;
                kc[g] = *(const uint4*)up; kp[g] = make_uint4(0u, 0u, 0u, 0u); kn[g] = kp[g];
                if (tok > 0) kp[g] = *(const uint4*)(up - UW);
                if (tok < T - 1) kn[g] = *(const uint4*)(up + UW);
                vv[g] = *(const uint4*)(up + 512); }
            LDS_BARRIER();
            if (wv == 0) {
                const int tl = dir ? 63 - lane : lane; const size_t row = (size_t)row0 + c * 64 + tl;
                const float ip = GATES[row * 16 + dir * 4 + h] + gbi, fp = GATES[row * 16 + 8 + dir * 4 + h] + gbf;
                const float lf = -softplus_fast(-fp);
                float bs = lf;
#pragma unroll
                for (int o = 1; o < 64; o <<= 1) { const float t = __shfl_up(bs, o); if (lane >= o) bs += t; }
                const float a = ip - bs; float pm = a;
#pragma unroll
                for (int o = 1; o < 64; o <<= 1) { const float t = __shfl_up(pm, o); if (lane >= o) pm = fmaxf(pm, t); }
                const float Mt = fmaxf(m_prev, pm);
                sA[lane] = a; sM[lane] = Mt; sBb[lane] = bs;
                if (lane == 63) { sScal[0] = Mt; sScal[1] = bs; }
            }
            LDS_BARRIER();
            const float M63 = sScal[0], bL = sScal[1];
            uint4 qc[4], qp[4], qn[4];
            { const int t_ = 16 * rw + fr, tl = dir ? 63 - t_ : t_, tok = c * 64 + tl; const bf16_t* up = U + ((size_t)row0 + tok) * UW + h * 128 + 8 * fq;
#pragma unroll
              for (int kk = 0; kk < 4; ++kk) { qc[kk] = *(const uint4*)(up + 32 * kk); qp[kk] = make_uint4(0u, 0u, 0u, 0u); qn[kk] = qp[kk];
                  if (tok > 0) qp[kk] = *(const uint4*)(up + 32 * kk - UW);
                  if (tok < T - 1) qn[kk] = *(const uint4*)(up + 32 * kk + UW); } }
#pragma unroll
            for (int g = 0; g < 2; ++g) {
                const int idx = tid + 512 * g, sl = idx >> 4, d0 = (idx & 15) * 8;
                const float wk = fexp(sA[sl] - M63);
                const float* cwp = sCW + 128 + d0;
                float kv[8], t[8];
                unpack8(kc[g], t);
#pragma unroll
                for (int i = 0; i < 8; ++i) kv[i] = cwp[768 + i] + cwp[256 + i] * t[i];
                unpack8(kp[g], t);
#pragma unroll
                for (int i = 0; i < 8; ++i) kv[i] += cwp[i] * t[i];
                unpack8(kn[g], t);
#pragma unroll
                for (int i = 0; i < 8; ++i) kv[i] += cwp[512 + i] * t[i];
#pragma unroll
                for (int i = 0; i < 8; ++i) kv[i] = siluf(kv[i]) * 0.08838834764831845f;
                *(uint4*)(sK + sl * 136 + d0) = make_uint4(pk2(kv[0], kv[1]), pk2(kv[2], kv[3]), pk2(kv[4], kv[5]), pk2(kv[6], kv[7]));
#pragma unroll
                for (int i = 0; i < 8; ++i) sKwT[(d0 + i) * 72 + sl] = f2bf(kv[i] * wk);
                const unsigned vw[4] = {vv[g].x, vv[g].y, vv[g].z, vv[g].w};
#pragma unroll
                for (int i = 0; i < 8; ++i) sVT[(d0 + i) * 72 + sl] = (bf16_t)((vw[i >> 1] >> ((i & 1) * 16)) & 0xffffu);
            }
            bf16x8 qf[4];
#pragma unroll
            for (int kk = 0; kk < 4; ++kk) { const float* cwp = sCW + 32 * kk + 8 * fq; float qv[8], t[8];
                unpack8(qc[kk], t);
#pragma unroll
                for (int i = 0; i < 8; ++i) qv[i] = cwp[768 + i] + cwp[256 + i] * t[i];
                unpack8(qp[kk], t);
#pragma unroll
                for (int i = 0; i < 8; ++i) qv[i] += cwp[i] * t[i];
                unpack8(qn[kk], t);
#pragma unroll
                for (int i = 0; i < 8; ++i) qv[i] += cwp[512 + i] * t[i];
#pragma unroll
                for (int i = 0; i < 8; ++i) qv[i] = siluf(qv[i]);
                union { uint4 u; bf16x8 v; } cv; cv.u = make_uint4(pk2(qv[0], qv[1]), pk2(qv[2], qv[3]), pk2(qv[4], qv[5]), pk2(qv[6], qv[7])); qf[kk] = cv.v; }
            f32x4 num[5];
#pragma unroll
            for (int k = 0; k < 5; ++k) num[k] = (f32x4){0.f, 0.f, 0.f, 0.f};
#pragma unroll
            for (int ci = 0; ci < 5; ++ci) { const f32x4 v = Cacc[ci]; *(uint2*)(sCb + (16 * ci + fr) * 136 + 16 * wv + 4 * fq) = make_uint2(pk2(v[0], v[1]), pk2(v[2], v[3])); }
            LDS_BARRIER();
#pragma unroll
            for (int k = 0; k < 3; ++k) if (k < n_a) {
#pragma unroll
                for (int kk = 0; kk < 4; ++kk) { const bf16x8 b = *(const bf16x8*)(sCb + (16 * (ct_a + k) + fr) * 136 + 32 * kk + 8 * fq); num[k] = mfma16(qf[kk], b, num[k]); } }
            LDS_BARRIER();
#pragma unroll
            for (int ci = 0; ci < 4; ++ci) { const f32x4 v = Cacc[5 + ci]; *(uint2*)(sCb + (16 * ci + fr) * 136 + 16 * wv + 4 * fq) = make_uint2(pk2(v[0], v[1]), pk2(v[2], v[3])); }
            LDS_BARRIER();
#pragma unroll
            for (int k = 3; k < 5; ++k) {
#pragma unroll
                for (int kk = 0; kk < 4; ++kk) { const bf16x8 b = *(const bf16x8*)(sCb + (16 * (ct_b + k - 3 - 5) + fr) * 136 + 32 * kk + 8 * fq); num[k] = mfma16(qf[kk], b, num[k]); } }
            {
                float scv[4];
#pragma unroll
                for (int j = 0; j < 4; ++j) scv[j] = fexp(m_prev - sM[16 * rw + 4 * fq + j]);
#pragma unroll
                for (int k = 0; k < 5; ++k)
#pragma unroll
                    for (int j = 0; j < 4; ++j) num[k][j] *= scv[j];
            }
            LDS_BARRIER();
#pragma unroll
            for (int si = 0; si < 2; ++si) { const int st = 2 * cw + si;
                f32x4 sacc = (f32x4){0.f, 0.f, 0.f, 0.f};
                if (st <= rw) {
#pragma unroll
                    for (int kk = 0; kk < 4; ++kk) { const bf16x8 b = *(const bf16x8*)(sK + (16 * st + fr) * 136 + 32 * kk + 8 * fq); sacc = mfma16(qf[kk], b, sacc); } }
                const int sp = 16 * st + fr; const float as = sA[sp];
#pragma unroll
                for (int j = 0; j < 4; ++j) { const int tp = 16 * rw + 4 * fq + j; const float val = (sp <= tp) ? sacc[j] * fexp(as - sM[tp]) : 0.f; sS[tp * 72 + sp] = f2bf(val); }
            }
            LDS_BARRIER();
#pragma unroll
            for (int ks = 0; ks < 2; ++ks) { const bf16x8 a = *(const bf16x8*)(sS + (16 * rw + fr) * 72 + 32 * ks + 8 * fq);
#pragma unroll
                for (int k = 0; k < 5; ++k) { const int ct = k < 3 ? ct_a + k : ct_b + k - 3;
                    if (k != 2 || cw == 0) { const bf16x8 b = *(const bf16x8*)(sVT + (16 * ct + fr) * 72 + 32 * ks + 8 * fq); num[k] = mfma16(a, b, num[k]); } } }
            if (cw == 1 && fr == 0) {
#pragma unroll
                for (int j = 0; j < 4; ++j) sDen[16 * rw + 4 * fq + j] = num[4][j]; }
            LDS_BARRIER();
            float inv[4];
#pragma unroll
            for (int j = 0; j < 4; ++j) { const int tp = 16 * rw + 4 * fq + j; const float den = sDen[tp]; inv[j] = __builtin_amdgcn_rcpf(fmaxf(fabsf(den), fexp(-(sBb[tp] + sM[tp])))); }
            if (!second) {
#pragma unroll
                for (int j = 0; j < 4; ++j) { const int tp = 16 * rw + 4 * fq + j, tl = dir ? 63 - tp : tp; const size_t row = (size_t)row0 + c * 64 + tl;
                    bf16_t* hb = dsel == 1 ? HB2 + (row - NCTX) * 512 + h * 128 : HB + row * DM + h * 128;
#pragma unroll
                    for (int k = 0; k < 5; ++k) { const int ct = k < 3 ? ct_a + k : ct_b + k - 3; if ((k != 2 || cw == 0) && ct < 8) hb[16 * ct + fr] = f2bf(num[k][j] * inv[j]); } }
            } else {
                float ssr[4];
#pragma unroll
                for (int j = 0; j < 4; ++j) { const int tp = 16 * rw + 4 * fq + j, tl = dir ? 63 - tp : tp; const size_t row = (size_t)row0 + c * 64 + tl;
                    const bf16_t* hb = HB + row * DM + h * 128; float ss = 0.f;
#pragma unroll
                    for (int k = 0; k < 5; ++k) { const int ct = k < 3 ? ct_a + k : ct_b + k - 3;
                        if ((k != 2 || cw == 0) && ct < 8) { const int e = 16 * ct + fr; const float other = bf2f(ld_u16_agent(hb + e)); const float hs = num[k][j] * inv[j] + other;
                            const float o = sigmf(bf2f(U[row * UW + 1536 + h * 128 + e])); const float v = o * hs; ss += v * v; num[k][j] = v; } }
                    ss += __shfl_xor(ss, 1); ss += __shfl_xor(ss, 2); ss += __shfl_xor(ss, 4); ss += __shfl_xor(ss, 8);
                    ssr[j] = ss; if (fr == 0) sRed[cw * 64 + tp] = ss; }
                LDS_BARRIER();
#pragma unroll
                for (int j = 0; j < 4; ++j) { const int tp = 16 * rw + 4 * fq + j, tl = dir ? 63 - tp : tp; const size_t row = (size_t)row0 + c * 64 + tl;
                    bf16_t* hb = HB + row * DM + h * 128; const float rms = rsqrtf((ssr[j] + sRed[(1 - cw) * 64 + tp]) * (1.f / 128.f) + 1e-6f);
#pragma unroll
                    for (int k = 0; k < 5; ++k) { const int ct = k < 3 ? ct_a + k : ct_b + k - 3;
                        if ((k != 2 || cw == 0) && ct < 8) { const int e = 16 * ct + fr; hb[e] = f2bf(num[k][j] * rms * p.hg[h * 128 + e]); } } }
            }
            const float decay = fexp(m_prev - M63);
#pragma unroll
            for (int ct = 0; ct < 9; ++ct) Cacc[ct] = Cacc[ct] * decay;
#pragma unroll
            for (int ks = 0; ks < 2; ++ks) { const bf16x8 a = *(const bf16x8*)(sKwT + (16 * wv + fr) * 72 + 32 * ks + 8 * fq);
#pragma unroll
                for (int ct = 0; ct < 9; ++ct) { const bf16x8 b = *(const bf16x8*)(sVT + (16 * ct + fr) * 72 + 32 * ks + 8 * fq); Cacc[ct] = mfma16(a, b, Cacc[ct]); } }
            m_prev = bL + M63;
        }
        if (ctx) { const int sidx = (bg * 2 + dir) * 4 + h; float* Co = p.out + OUT_C + (size_t)sidx * 16384;
            int z1 = 0; asm volatile("" : "+v"(z1)); const int tid1 = (int)threadIdx.x + z1, fr1 = tid1 & 15, fq1 = (tid1 >> 4) & 3;
#pragma unroll
            for (int j = 0; j < 4; ++j) { const int d = 16 * wv + 4 * fq1 + j;
#pragma unroll
                for (int ct = 0; ct < 8; ++ct) Co[d * 128 + 16 * ct + fr1] = Cacc[ct][j];
                if (fr1 == 0) p.out[OUT_N + sidx * 128 + d] = Cacc[8][j]; }
            if (tid1 == 0) p.out[OUT_MM + sidx] = m_prev; }
        __syncthreads();
    }
}

__device__ __forceinline__ void phase_shift(bf16_t* U, const float* pmu, uint4* sRow) {
#pragma unroll 1
    for (int item = blockIdx.x; item < 1200; item += gridDim.x) {
        const int tid = opaque_tid(), tl = tid >> 3, g = tid & 7;
        const bool grid = item < 240; const int seq = grid ? item / 30 : (item - 240) / 30, sl = grid ? item % 30 : (item - 240) % 30;
        const int T = grid ? 2048 : 256, nst = T / 64; const size_t row0 = grid ? (size_t)NCTX + (size_t)seq * 2048 : (size_t)seq * 256;
        const int rc = sl * 64 + g * 8;
        char* base = (char*)(U + row0 * UW + 2048 + rc);
        const int act = (rc >= 1536 && rc < 1664) ? 1 : (rc >= 1792 ? 2 : 0);
        unsigned z0_ = 0u; asm volatile("" : "+v"(z0_));
        uint4 prv = make_uint4(z0_, z0_, z0_, z0_), cur = *(const uint4*)(base + (size_t)tl * (UW * 2)), nxt;
        __syncthreads();
#pragma unroll 1
        for (int k = 0; k < nst; ++k) {
            unsigned zr = 0u; asm volatile("" : "+v"(zr)); const uint4 z4 = make_uint4(zr, zr, zr, zr);
            nxt = z4; if (k + 1 < nst) nxt = *(const uint4*)(base + (size_t)((k + 1) * 64 + tl) * (UW * 2));
            sRow[(1 + tl) * 8 + g] = cur;
            if (tl == 0) sRow[65 * 8 + g] = nxt;
            LDS_BARRIER();
            uint4 lf = sRow[tl * 8 + g], rt = sRow[(2 + tl) * 8 + g];
            if (tl == 0 && (grid || k == 0)) lf = z4;
            if (tl == 63 && (grid || k == nst - 1)) rt = z4;
            float x[8], t[8], o[8], ms[8], m[8];
            int zz = 0; asm volatile("" : "+v"(zz)); const float* mup = pmu + rc + zz;
#define LD_MU8(a) do { const float4 m0 = *(const float4*)(mup + (a) * 1920), m1 = *(const float4*)(mup + (a) * 1920 + 4); m[0] = m0.x; m[1] = m0.y; m[2] = m0.z; m[3] = m0.w; m[4] = m1.x; m[5] = m1.y; m[6] = m1.z; m[7] = m1.w; } while (0)
            unpack8(cur, x);
            LD_MU8(0); unpack8(lf, t);
#pragma unroll
            for (int i = 0; i < 8; ++i) { o[i] = m[i] * t[i]; ms[i] = m[i]; }
            LD_MU8(1); unpack8(rt, t);
#pragma unroll
            for (int i = 0; i < 8; ++i) { o[i] += m[i] * t[i]; ms[i] += m[i]; }
            if (grid) {
                LD_MU8(2); unpack8(prv, t);
#pragma unroll
                for (int i = 0; i < 8; ++i) { o[i] += m[i] * t[i]; ms[i] += m[i]; }
                LD_MU8(3); unpack8(nxt, t);
#pragma unroll
                for (int i = 0; i < 8; ++i) { o[i] += m[i] * t[i]; ms[i] += m[i]; }
            }
#undef LD_MU8
#pragma unroll
            for (int i = 0; i < 8; ++i) o[i] += x[i] * (1.f - ms[i]);
            if (act == 1) {
#pragma unroll
                for (int i = 0; i < 8; ++i) o[i] = tanh_fast(o[i]); }
            if (act == 2) {
#pragma unroll
                for (int i = 0; i < 8; ++i) o[i] = sigmf(o[i]); }
            *(uint4*)(base + (size_t)(k * 64 + tl) * (UW * 2)) = make_uint4(pk2(o[0], o[1]), pk2(o[2], o[3]), pk2(o[4], o[5]), pk2(o[6], o[7]));
            LDS_BARRIER();
            if (tl == 63) sRow[g] = cur;
            prv = cur; cur = nxt;
        }
    }
}

constexpr int RW_TC = 16;
constexpr int RW_VEC = 0, RW_V = RW_VEC + 16 * 320 * 4, RW_KR = RW_V + 16 * 32 * 4, RW_XW = RW_KR + 16 * 64 * 4, RW_XA = RW_XW + 16 * 72 * 2, RW_Y = RW_XA + 16 * 72 * 2,
              RW_MU = RW_Y + 16 * 32 * 4, RW_DIR = RW_MU + 4 * 288 * 4;
static_assert(2 * RW_DIR <= LDS_BYTES && RW_DIR % 16 == 0, "rwkv lds");

__device__ __forceinline__ float dppf(float x, const int ctrl) { return x; }
#define DPP_ADD(x, ctrl) ((x) + __int_as_float(__builtin_amdgcn_update_dpp(0, __float_as_int(x), (ctrl), 0xf, 0xf, true)))
__device__ __forceinline__ float red8(float x) { x = DPP_ADD(x, 0xB1); x = DPP_ADD(x, 0x4E); x = DPP_ADD(x, 0x141); return x; }
__device__ __forceinline__ float red16(float x) { x = red8(x); x = DPP_ADD(x, 0x140); return x; }

struct Sh8 { uint4 x, l, r, u, d; };
__device__ __forceinline__ void sh8_load(Sh8& q, const bf16_t* U, size_t row0, int tok, int T, bool grid, int c0) {
    const char* Ub = (const char*)(U + row0 * UW);
    const int off = (tok * UW + c0) * 2; const uint4 z = make_uint4(0u, 0u, 0u, 0u);
    const bool hl = grid ? (tok & 63) != 0 : tok > 0, hr = grid ? (tok & 63) != 63 : tok < T - 1;
    q.x = *(const uint4*)(Ub + off);
    q.l = hl ? *(const uint4*)(Ub + (off - UW * 2)) : z; q.r = hr ? *(const uint4*)(Ub + (off + UW * 2)) : z;
    q.u = (grid && tok >= 64) ? *(const uint4*)(Ub + (off - 64 * UW * 2)) : z; q.d = (grid && tok < T - 64) ? *(const uint4*)(Ub + (off + 64 * UW * 2)) : z;
}
__device__ __forceinline__ void sh8_mix(const Sh8& q, bool grid, const float* mu4, int mustride, float* o) {
    float x[8], t[8], m[8], ms[8];
    unpack8(q.x, x);
    { const float4 a = *(const float4*)mu4, b = *(const float4*)(mu4 + 4); m[0] = a.x; m[1] = a.y; m[2] = a.z; m[3] = a.w; m[4] = b.x; m[5] = b.y; m[6] = b.z; m[7] = b.w; }
    unpack8(q.l, t);
#pragma unroll
    for (int i = 0; i < 8; ++i) { o[i] = m[i] * t[i]; ms[i] = m[i]; }
    { const float4 a = *(const float4*)(mu4 + mustride), b = *(const float4*)(mu4 + mustride + 4); m[0] = a.x; m[1] = a.y; m[2] = a.z; m[3] = a.w; m[4] = b.x; m[5] = b.y; m[6] = b.z; m[7] = b.w; }
    unpack8(q.r, t);
#pragma unroll
    for (int i = 0; i < 8; ++i) { o[i] += m[i] * t[i]; ms[i] += m[i]; }
    if (grid) {
        { const float4 a = *(const float4*)(mu4 + 2 * mustride), b = *(const float4*)(mu4 + 2 * mustride + 4); m[0] = a.x; m[1] = a.y; m[2] = a.z; m[3] = a.w; m[4] = b.x; m[5] = b.y; m[6] = b.z; m[7] = b.w; }
        unpack8(q.u, t);
#pragma unroll
        for (int i = 0; i < 8; ++i) { o[i] += m[i] * t[i]; ms[i] += m[i]; }
        { const float4 a = *(const float4*)(mu4 + 3 * mustride), b = *(const float4*)(mu4 + 3 * mustride + 4); m[0] = a.x; m[1] = a.y; m[2] = a.z; m[3] = a.w; m[4] = b.x; m[5] = b.y; m[6] = b.z; m[7] = b.w; }
        unpack8(q.d, t);
#pragma unroll
        for (int i = 0; i < 8; ++i) { o[i] += m[i] * t[i]; ms[i] += m[i]; }
    }
#pragma unroll
    for (int i = 0; i < 8; ++i) o[i] += x[i] * (1.f - ms[i]);
}
__device__ __forceinline__ void shifted8(const bf16_t* U, size_t row0, int tok, int T, bool grid, int c0, const float* mu4, int mustride, float* o) {
    Sh8 q; sh8_load(q, U, row0, tok, T, grid, c0); sh8_mix(q, grid, mu4, mustride, o);
}
typedef float f32x2 __attribute__((ext_vector_type(2)));

__device__ __forceinline__ void rwkv_task(const P& p, unsigned char* lds, int bg, int h, int rh) {
    const int wv = __builtin_amdgcn_readfirstlane((int)threadIdx.x >> 6), dir = wv >> 2, lw = wv & 3;
    const bool ctx = bg < 32; const int T = ctx ? 256 : 2048, nc = T / RW_TC; const size_t row0 = ctx ? (size_t)bg * 256 : (size_t)NCTX + (size_t)(bg - 32) * 2048;
    const bool grid = !ctx;
    unsigned char* L = lds + dir * RW_DIR;
    float* sVec = (float*)(L + RW_VEC); float* sV = (float*)(L + RW_V); float* sKr = (float*)(L + RW_KR); bf16_t* sXw = (bf16_t*)(L + RW_XW); bf16_t* sXa = (bf16_t*)(L + RW_XA);
    float* sY = (float*)(L + RW_Y); float* sMu = (float*)(L + RW_MU);
    const bf16_t* U = (const bf16_t*)(p.ws + WS_U); bf16_t* HB = (bf16_t*)(p.ws + WS_A);
    const int hc = h * 64;
    float st[8]; bf16x8 wfrag[2], afrag[2]; float w0v, a0v, kav;
    {
        const int tid = opaque_tid(), ltid = tid & 255, ri = ltid >> 3, jq = ltid & 7, fr = tid & 15, fq = (tid >> 4) & 3;
        __syncthreads();
        if (ctx) {
#pragma unroll
            for (int q = 0; q < 8; ++q) st[q] = 0.f;
        } else { const float* S0 = p.sS + ((size_t)(((bg - 32) * 2 + dir) * 8 + h)) * 4096 + (32 * rh + ri) * 64 + jq * 8;
#pragma unroll
            for (int q = 0; q < 8; ++q) st[q] = S0[q]; }
        const int jcol = hc + 16 * lw + fr;
#pragma unroll
        for (int ks = 0; ks < 2; ++ks) { float wf[8], af[8];
#pragma unroll
            for (int i = 0; i < 8; ++i) { const int l = 32 * ks + 8 * fq + i; wf[i] = p.w2[(size_t)(dir * 64 + l) * 512 + jcol]; af[i] = p.a2[(size_t)(dir * 64 + l) * 512 + jcol]; }
            union { uint4 u; bf16x8 v; } c1, c2; c1.u = make_uint4(pk2(wf[0], wf[1]), pk2(wf[2], wf[3]), pk2(wf[4], wf[5]), pk2(wf[6], wf[7])); c2.u = make_uint4(pk2(af[0], af[1]), pk2(af[2], af[3]), pk2(af[4], af[5]), pk2(af[6], af[7]));
            wfrag[ks] = c1.v; afrag[ks] = c2.v; }
        w0v = p.w0[dir * 512 + jcol]; a0v = p.a0[dir * 512 + jcol]; kav = p.ka[jcol];
    }
    uint4 q1, q2, q3 = make_uint4(0u, 0u, 0u, 0u);
    const char* Ub = (const char*)(U + row0 * UW);
    { const int tid = opaque_tid(), ltid = tid & 255; const int c = dir ? nc - 1 : 0, tok0 = c * RW_TC; const int tl = (ltid & 127) >> 3, g = ltid & 7;
      q1 = *(const uint4*)(Ub + ((tok0 + tl) * UW + (lw < 2 ? 2048 : 2048 + 512) + hc + 8 * g) * 2);
      q2 = *(const uint4*)(Ub + ((tok0 + tl) * UW + (lw < 2 ? 2048 + 1536 : 2048 + 1664) + dir * 64 + 8 * g) * 2);
      if (lw == 0) q3 = *(const uint4*)(Ub + ((tok0 + (ltid >> 2)) * UW + 2048 + 1024 + hc + 32 * rh + 8 * (ltid & 3)) * 2); }
    f32x2 st2[4];
#pragma unroll
    for (int q = 0; q < 4; ++q) st2[q] = (f32x2){st[2 * q], st[2 * q + 1]};
#pragma unroll 1
    for (int s = 0; s < nc; ++s) {
        const int c = dir ? nc - 1 - s : s; const int tok0 = c * RW_TC;
        const bool second = s >= (nc >> 1);
        const int tid = opaque_tid(), ltid = tid & 255, ri = ltid >> 3, jq = ltid & 7, fr = tid & 15, fq = (tid >> 4) & 3;
        { const int tl = (ltid & 127) >> 3, g = ltid & 7; float o[8];
          if (lw < 2) {
              unpack8(q1, o);
              *(float4*)(sVec + tl * 320 + 8 * g) = make_float4(o[0], o[1], o[2], o[3]); *(float4*)(sVec + tl * 320 + 8 * g + 4) = make_float4(o[4], o[5], o[6], o[7]);
              *(uint4*)(sXw + tl * 72 + 8 * g) = q2;
          } else {
              unpack8(q1, o);
              float kkr[8]; float ss = 0.f;
#pragma unroll
              for (int i = 0; i < 8; ++i) { kkr[i] = o[i] * p.kk[hc + 8 * g + i]; ss += kkr[i] * kkr[i]; }
              ss = red8(ss); const float rn = __builtin_amdgcn_rsqf(fmaxf(ss, 1e-24f));
              *(float4*)(sKr + tl * 64 + 8 * g) = make_float4(o[0], o[1], o[2], o[3]); *(float4*)(sKr + tl * 64 + 8 * g + 4) = make_float4(o[4], o[5], o[6], o[7]);
              *(float4*)(sVec + tl * 320 + 192 + 8 * g) = make_float4(kkr[0] * rn, kkr[1] * rn, kkr[2] * rn, kkr[3] * rn); *(float4*)(sVec + tl * 320 + 192 + 8 * g + 4) = make_float4(kkr[4] * rn, kkr[5] * rn, kkr[6] * rn, kkr[7] * rn);
              *(uint4*)(sXa + tl * 72 + 8 * g) = q2;
          }
          if (lw == 0) {
              const int tl2 = ltid >> 2, g2 = ltid & 3;
              unpack8(q3, o);
              *(float4*)(sV + tl2 * 32 + 8 * g2) = make_float4(o[0], o[1], o[2], o[3]); *(float4*)(sV + tl2 * 32 + 8 * g2 + 4) = make_float4(o[4], o[5], o[6], o[7]);
          } }
        __syncthreads();
        { f32x4 aw = (f32x4){0.f, 0.f, 0.f, 0.f}, aa = (f32x4){0.f, 0.f, 0.f, 0.f};
#pragma unroll
          for (int ks = 0; ks < 2; ++ks) { const bf16x8 xw = *(const bf16x8*)(sXw + fr * 72 + 32 * ks + 8 * fq), xa = *(const bf16x8*)(sXa + fr * 72 + 32 * ks + 8 * fq);
              aw = mfma16(xw, wfrag[ks], aw); aa = mfma16(xa, afrag[ks], aa); }
          const int j = 16 * lw + fr;
#pragma unroll
          for (int jj = 0; jj < 4; ++jj) { const int tl = 4 * fq + jj;
              const float dec = fexp(-fexp(-softplus_fast(-(w0v + aw[jj])) - 0.5f));
              const float a = sigmf(a0v + aa[jj]); const float k = sKr[tl * 64 + j], kn = sVec[tl * 320 + 192 + j];
              float* V = sVec + tl * 320 + j; V[64] = dec; V[128] = k * (1.f + (a - 1.f) * kav); V[256] = kn * a; } }
        const int otl = ltid >> 4, opr = ltid & 15; unsigned* hb = (unsigned*)(HB + (row0 + tok0 + otl) * DM + 512 + hc + 32 * rh + 2 * opr);
        unsigned ov = 0u;
        if (second) ov = __hip_atomic_load(hb, __ATOMIC_RELAXED, __HIP_MEMORY_SCOPE_AGENT);
        if (s + 1 < nc) { const int cn = dir ? nc - 2 - s : s + 1, tokn = cn * RW_TC; const int tl = (ltid & 127) >> 3, g = ltid & 7;
            q1 = *(const uint4*)(Ub + ((tokn + tl) * UW + (lw < 2 ? 2048 : 2048 + 512) + hc + 8 * g) * 2);
            q2 = *(const uint4*)(Ub + ((tokn + tl) * UW + (lw < 2 ? 2048 + 1536 : 2048 + 1664) + dir * 64 + 8 * g) * 2);
            if (lw == 0) q3 = *(const uint4*)(Ub + ((tokn + (ltid >> 2)) * UW + 2048 + 1024 + hc + 32 * rh + 8 * (ltid & 3)) * 2); }
        LDS_BARRIER();
        f32x2 sv_[4];
#pragma unroll
        for (int q = 0; q < 4; ++q) sv_[q] = st2[q];
#pragma unroll 1
        for (int rep = 0; rep < (PROBE_DUP == 102 ? 2 : 1); ++rep) {
        if (PROBE_DUP == 102) {
#pragma unroll
            for (int q = 0; q < 4; ++q) st2[q] = sv_[q]; }
float ys[RW_TC];
#pragma unroll
        for (int step = 0; step < RW_TC; ++step) { const int tl = dir ? RW_TC - 1 - step : step; const float* V = sVec + tl * 320 + jq * 8;
            const float4 ka4 = *(const float4*)(V + 192), kb4 = *(const float4*)(V + 196);
            f32x2 acc = st2[0] * (f32x2){ka4.x, ka4.y}; acc = st2[1] * (f32x2){ka4.z, ka4.w} + acc; acc = st2[2] * (f32x2){kb4.x, kb4.y} + acc; acc = st2[3] * (f32x2){kb4.z, kb4.w} + acc;
            const float sa = -red8(acc.x + acc.y);
            const float vi = sV[tl * 32 + ri];
            const float4 wa = *(const float4*)(V + 64), wb = *(const float4*)(V + 68), ba = *(const float4*)(V + 256), bb = *(const float4*)(V + 260),
                         da = *(const float4*)(V + 128), db = *(const float4*)(V + 132), ra = *(const float4*)(V), rb = *(const float4*)(V + 4);
            const f32x2 sa2 = (f32x2){sa, sa}, vi2 = (f32x2){vi, vi};
            st2[0] = st2[0] * (f32x2){wa.x, wa.y} + (sa2 * (f32x2){ba.x, ba.y} + vi2 * (f32x2){da.x, da.y});
            st2[1] = st2[1] * (f32x2){wa.z, wa.w} + (sa2 * (f32x2){ba.z, ba.w} + vi2 * (f32x2){da.z, da.w});
            st2[2] = st2[2] * (f32x2){wb.x, wb.y} + (sa2 * (f32x2){bb.x, bb.y} + vi2 * (f32x2){db.x, db.y});
            st2[3] = st2[3] * (f32x2){wb.z, wb.w} + (sa2 * (f32x2){bb.z, bb.w} + vi2 * (f32x2){db.z, db.w});
            f32x2 ya = st2[0] * (f32x2){ra.x, ra.y}; ya = st2[1] * (f32x2){ra.z, ra.w} + ya; ya = st2[2] * (f32x2){rb.x, rb.y} + ya; ya = st2[3] * (f32x2){rb.z, rb.w} + ya;
            const float y = red8(ya.x + ya.y);
            ys[step] = y; }
        if (jq == 0) {
#pragma unroll
            for (int step = 0; step < RW_TC; ++step) sY[(dir ? RW_TC - 1 - step : step) * 32 + ri] = ys[step]; }
        }
        LDS_BARRIER();
        { float y0 = sY[otl * 32 + 2 * opr], y1 = sY[otl * 32 + 2 * opr + 1];
          if (second) { y0 += __uint_as_float(ov << 16); y1 += __uint_as_float(ov & 0xffff0000u); }
          *hb = pk2(y0, y1); }
    }
#pragma unroll
    for (int q = 0; q < 4; ++q) { st[2 * q] = st2[q].x; st[2 * q + 1] = st2[q].y; }
    if (ctx) { const int tid = opaque_tid(), ltid = tid & 255, ri = ltid >> 3, jq = ltid & 7;
        float* So = p.out + OUT_S + ((size_t)((bg * 2 + dir) * 8 + h)) * 4096 + (32 * rh + ri) * 64 + jq * 8;
#pragma unroll
        for (int q = 0; q < 8; ++q) So[q] = st[q]; }
    __syncthreads();
}

constexpr int RX_VEC = 0,
              RX_KR = RX_VEC + 16 * 320 * 4,
              RX_XW = RX_KR + 4096, RX_XA = RX_XW + 2304,
              RX_Y = RX_XA + 2304,
              RX_KT = RX_Y + 4096, RX_KTN = RX_KT + 2304, RX_RT = RX_KTN + 2304, RX_RTN = RX_RT + 2304, RX_BN = RX_RTN + 2304, RX_DN = RX_BN + 2304,
              RX_BTS = RX_DN + 2304, RX_DT = RX_BTS + 5120, RX_VT = RX_DT + 5120,
              RX_ADK = RX_VT + 5120, RX_ABR = RX_ADK + 1280, RX_ADR = RX_ABR + 1280, RX_TM = RX_ADR + 1280,
              RX_N = RX_TM + 1280,
              RX_PL = RX_N + 1088,
              RX_DIR = RX_PL + 256;
static_assert(2 * RX_DIR <= LDS_BYTES - 64 && RX_DIR % 16 == 0, "rwkv (chunked) lds");
__device__ __forceinline__ int perm_pi(int j) { const int jj = j & 31; return (j & 32) + 8 * ((jj & 15) >> 2) + (jj & 3) + 4 * (jj >> 4); }
__device__ __forceinline__ int perm_sg(int c) { return 8 * (c >> 2) + (c & 3); }
__device__ __forceinline__ bf16x8 pack_acc_lo(const f32x4 v) { union { uint4 u; bf16x8 b; } c; c.u = make_uint4(pk2(v[0], v[1]), pk2(v[2], v[3]), 0u, 0u); return c.b; }
__device__ __forceinline__ bf16x8 pack_acc2(const f32x4 a, const f32x4 b) { union { uint4 u; bf16x8 v; } c; c.u = make_uint4(pk2(a[0], a[1]), pk2(a[2], a[3]), pk2(b[0], b[1]), pk2(b[2], b[3])); return c.v; }

__device__ __forceinline__ void rwkv_task_w(const P& p, unsigned char* lds, int bg, int h) {
    const int wv = __builtin_amdgcn_readfirstlane((int)threadIdx.x >> 6), dir = wv >> 2, lw = wv & 3;
    const bool ctx = bg < 32; const int T = ctx ? 256 : 2048, nc = T / 16; const size_t row0 = ctx ? (size_t)bg * 256 : (size_t)NCTX + (size_t)(bg - 32) * 2048;
    unsigned char* L = lds + dir * RX_DIR;
    float* sVec = (float*)(L + RX_VEC); float* sKr = (float*)(L + RX_KR); bf16_t* sXw = (bf16_t*)(L + RX_XW); bf16_t* sXa = (bf16_t*)(L + RX_XA); float* sY = (float*)(L + RX_Y);
    bf16_t* sKT = (bf16_t*)(L + RX_KT); bf16_t* sKTn = (bf16_t*)(L + RX_KTN); bf16_t* sRT = (bf16_t*)(L + RX_RT); bf16_t* sRTn = (bf16_t*)(L + RX_RTN); bf16_t* sBn = (bf16_t*)(L + RX_BN); bf16_t* sDn = (bf16_t*)(L + RX_DN);
    bf16_t* sBts = (bf16_t*)(L + RX_BTS); bf16_t* sDt = (bf16_t*)(L + RX_DT); bf16_t* sVT = (bf16_t*)(L + RX_VT);
    bf16_t* sAdk = (bf16_t*)(L + RX_ADK); bf16_t* sAbr = (bf16_t*)(L + RX_ABR); bf16_t* sAdr = (bf16_t*)(L + RX_ADR); bf16_t* sTm = (bf16_t*)(L + RX_TM);
    float* sN = (float*)(L + RX_N); float* sPL = (float*)(L + RX_PL);
    const bf16_t* U = (const bf16_t*)(p.ws + WS_U); bf16_t* HB = (bf16_t*)(p.ws + WS_A);
    const int hc = h * 64;
    f32x4 ST[4]; bf16x8 wfrag[2], afrag[2]; float w0v, a0v, kav, kkc[8];
    {
        const int tid = opaque_tid(), ltid = tid & 255, fr = tid & 15, fq = (tid >> 4) & 3;
        __syncthreads();
        for (int i = ltid; i < (RX_N - RX_BTS) / 4; i += 256) ((unsigned*)(L + RX_BTS))[i] = 0u;
        __syncthreads();
        if (ctx) {
#pragma unroll
            for (int jt = 0; jt < 4; ++jt) ST[jt] = (f32x4){0.f, 0.f, 0.f, 0.f};
        } else { const float* S0 = p.sS + ((size_t)(((bg - 32) * 2 + dir) * 8 + h)) * 4096 + (16 * lw + fr) * 64 + 4 * fq;
#pragma unroll
            for (int jt = 0; jt < 4; ++jt) { const float4 t = *(const float4*)(S0 + 16 * jt); ST[jt] = (f32x4){t.x, t.y, t.z, t.w}; } }
        const int jcol = hc + 16 * lw + fr;
#pragma unroll
        for (int ks = 0; ks < 2; ++ks) { float wf[8], af[8];
#pragma unroll
            for (int i = 0; i < 8; ++i) { const int l = 32 * ks + 8 * fq + i; wf[i] = p.w2[(size_t)(dir * 64 + l) * 512 + jcol]; af[i] = p.a2[(size_t)(dir * 64 + l) * 512 + jcol]; }
            union { uint4 u; bf16x8 v; } c1, c2; c1.u = make_uint4(pk2(wf[0], wf[1]), pk2(wf[2], wf[3]), pk2(wf[4], wf[5]), pk2(wf[6], wf[7])); c2.u = make_uint4(pk2(af[0], af[1]), pk2(af[2], af[3]), pk2(af[4], af[5]), pk2(af[6], af[7]));
            wfrag[ks] = c1.v; afrag[ks] = c2.v; }
        w0v = p.w0[dir * 512 + jcol]; a0v = p.a0[dir * 512 + jcol]; kav = p.ka[jcol];
#pragma unroll
        for (int i = 0; i < 8; ++i) kkc[i] = p.kk[hc + 8 * (ltid & 7) + i];
    }
    uint4 q1, q2, q3, n1a, n2a, n3a, n1b, n2b, n3b;
    const char* Ub = (const char*)(U + row0 * UW);
#define RX_LOAD(d1, d2, d3, sidx) do { const int s_ = (sidx) < nc ? (sidx) : nc - 1; const int c_ = dir ? nc - 1 - s_ : s_; const int tok_ = c_ * 16 + ((ltid_ & 127) >> 3); const int g_ = ltid_ & 7; \
        d1 = *(const uint4*)(Ub + (tok_ * UW + (lw < 2 ? 2048 : 2048 + 512) + hc + 8 * g_) * 2); \
        d2 = *(const uint4*)(Ub + (tok_ * UW + (lw < 2 ? 2048 + 1536 : 2048 + 1664) + dir * 64 + 8 * g_) * 2); \
        d3 = *(const uint4*)(Ub + (tok_ * UW + 2048 + 1024 + hc + 8 * g_) * 2); } while (0)
    { const int ltid_ = opaque_tid() & 255; RX_LOAD(q1, q2, q3, 0); RX_LOAD(n1a, n2a, n3a, 1); RX_LOAD(n1b, n2b, n3b, 2); }
#pragma unroll 1
    for (int s = 0; s < nc; ++s) {
        const int c = dir ? nc - 1 - s : s; const int tok0 = c * 16;
        const bool second = s >= (nc >> 1);
        const int tid = opaque_tid(), ltid = tid & 255, fr = tid & 15, fq = (tid >> 4) & 3;
        { const int tl = (ltid & 127) >> 3, g = ltid & 7, q = dir ? 15 - tl : tl; float o[8];
          if (lw < 2) {
              unpack8(q1, o);
              *(float4*)(sVec + q * 320 + 8 * g) = make_float4(o[0], o[1], o[2], o[3]); *(float4*)(sVec + q * 320 + 8 * g + 4) = make_float4(o[4], o[5], o[6], o[7]);
              *(uint4*)(sXw + q * 72 + 8 * g) = q2;
              const unsigned vw[4] = {q3.x, q3.y, q3.z, q3.w};
#pragma unroll
              for (int i = 0; i < 8; ++i) sVT[(8 * g + i) * 40 + q] = (bf16_t)((vw[i >> 1] >> ((i & 1) * 16)) & 0xffffu);
          } else {
              unpack8(q1, o);
              float kkr[8]; float ss = 0.f;
#pragma unroll
              for (int i = 0; i < 8; ++i) { kkr[i] = o[i] * kkc[i]; ss += kkr[i] * kkr[i]; }
              ss = red8(ss); const float rn = __builtin_amdgcn_rsqf(fmaxf(ss, 1e-24f));
              *(float4*)(sKr + q * 64 + 8 * g) = make_float4(o[0], o[1], o[2], o[3]); *(float4*)(sKr + q * 64 + 8 * g + 4) = make_float4(o[4], o[5], o[6], o[7]);
              *(float4*)(sVec + q * 320 + 192 + 8 * g) = make_float4(kkr[0] * rn, kkr[1] * rn, kkr[2] * rn, kkr[3] * rn); *(float4*)(sVec + q * 320 + 192 + 8 * g + 4) = make_float4(kkr[4] * rn, kkr[5] * rn, kkr[6] * rn, kkr[7] * rn);
              *(uint4*)(sXa + q * 72 + 8 * g) = q2;
          } }
        LDS_BARRIER();
        { f32x4 aw = (f32x4){0.f, 0.f, 0.f, 0.f}, aa = (f32x4){0.f, 0.f, 0.f, 0.f};
#pragma unroll
          for (int ks = 0; ks < 2; ++ks) { const bf16x8 xw = *(const bf16x8*)(sXw + fr * 72 + 32 * ks + 8 * fq), xa = *(const bf16x8*)(sXa + fr * 72 + 32 * ks + 8 * fq);
              aw = mfma16(xw, wfrag[ks], aw); aa = mfma16(xa, afrag[ks], aa); }
          const int j = 16 * lw + fr;
          float lg[4], av[4]; float run = 0.f;
#pragma unroll
          for (int e = 0; e < 4; ++e) { const float lw_ = -fexp(-softplus_fast(-(w0v + aw[e])) - 0.5f); run += lw_; lg[e] = run; av[e] = sigmf(a0v + aa[e]); }
          float x = run; { const float y1 = __shfl_up(x, 16); if (fq >= 1) x += y1; const float y2 = __shfl_up(x, 32); if (fq >= 2) x += y2; }
          const float excl = x - run;
          const int pj = perm_pi(j); bf16_t btv[4], dtv[4];
          float Pp = fexp(excl);
#pragma unroll
          for (int e = 0; e < 4; ++e) { const int q = 4 * fq + e; const float Lq = excl + lg[e];
              const float Pq = fexp(Lq), iP = __builtin_amdgcn_rcpf(Pq);
              const float k = sKr[q * 64 + j], kn = sVec[q * 320 + 192 + j], r = sVec[q * 320 + j];
              const float kd = k * (1.f + (av[e] - 1.f) * kav), b = kn * av[e];
              const bf16_t kt = f2bf(Pp * kn), rt = f2bf(Pq * r), bt = f2bf(b * iP), dt = f2bf(kd * iP);
              sKT[q * 72 + pj] = kt; sRT[q * 72 + pj] = rt; sBn[q * 72 + pj] = bt; sDn[q * 72 + pj] = dt;
              btv[e] = bt; dtv[e] = dt;
              if (q == 15) sPL[j] = Pq;
              Pp = Pq; }
          *(uint2*)(sBts + j * 40 + 8 * fq) = make_uint2((unsigned)btv[0] | ((unsigned)btv[1] << 16), (unsigned)btv[2] | ((unsigned)btv[3] << 16));
          *(uint2*)(sDt + j * 40 + 4 * fq) = make_uint2((unsigned)dtv[0] | ((unsigned)dtv[1] << 16), (unsigned)dtv[2] | ((unsigned)dtv[3] << 16)); }
        if (s == (nc >> 1)) asm volatile("s_waitcnt vmcnt(0)" ::: "memory"); else asm volatile("s_waitcnt vmcnt(6)" ::: "memory");
        LDS_BARRIER();
        { f32x4 gacc = (f32x4){0.f, 0.f, 0.f, 0.f}; const bf16_t* Ap = (lw < 2) ? sKT : sRT; const bf16_t* Bp = (lw & 1) ? sDn : sBn;
#pragma unroll
          for (int ks = 0; ks < 2; ++ks) gacc = mfma16(*(const bf16x8*)(Ap + fr * 72 + 32 * ks + 8 * fq), *(const bf16x8*)(Bp + fr * 72 + 32 * ks + 8 * fq), gacc);
          const int sidx = fr;
          float gm[4];
#pragma unroll
          for (int e = 0; e < 4; ++e) { const int q = 4 * fq + e; const bool keep = (lw < 2) ? (sidx < q) : (sidx <= q); gm[e] = keep ? gacc[e] : 0.f; }
          if (lw == 0) {
              const int r = tid & 15; float Tr[16];
#pragma unroll
              for (int q = 0; q < 16; ++q) Tr[q] = (r == q) ? 1.f : 0.f;
#pragma unroll
              for (int q = 0; q < 15; ++q) { const float tq = Tr[q];
#pragma unroll
                  for (int q2 = q + 1; q2 < 16; ++q2) { const float nv = __int_as_float(__builtin_amdgcn_readlane(__float_as_int(gm[q2 & 3]), q + 16 * (q2 >> 2))); Tr[q2] -= tq * nv; } }
              if ((tid & 63) < 16) { const int ps = perm_sg(r);
#pragma unroll
                  for (int q = 0; q < 16; ++q) sTm[q * 40 + ps] = f2bf(Tr[q]); }
          } else {
#pragma unroll
              for (int e = 0; e < 4; ++e) { const int q = 4 * fq + e;
                  if (lw == 1) sAdk[q * 40 + sidx] = f2bf(gm[e]);
                  else if (lw == 2) sAbr[q * 40 + perm_sg(sidx)] = f2bf(gm[e]);
                  else sAdr[q * 40 + sidx] = f2bf(gm[e]); } } }
        const int oq = ltid >> 4, otl = dir ? 15 - oq : oq; unsigned long long* hb = (unsigned long long*)(HB + (row0 + tok0 + otl) * DM + 512 + hc + 4 * (ltid & 15));
        const unsigned long long ov = __hip_atomic_load(hb, __ATOMIC_RELAXED, __HIP_MEMORY_SCOPE_AGENT);
        q1 = n1a; q2 = n2a; q3 = n3a; n1a = n1b; n2a = n2b; n3a = n3b;
        { const int ltid_ = ltid; RX_LOAD(n1b, n2b, n3b, s + 3); }
        LDS_BARRIER();
        { const bf16x8 Sb0 = pack_acc2(ST[0], ST[1]), Sb1 = pack_acc2(ST[2], ST[3]);
          const bf16x8 vtf = *(const bf16x8*)(sVT + (16 * lw + fr) * 40 + 8 * fq);
          f32x4 XT = (f32x4){0.f, 0.f, 0.f, 0.f};
          XT = mfma16(*(const bf16x8*)(sKT + fr * 72 + 8 * fq), Sb0, XT); XT = mfma16(*(const bf16x8*)(sKT + fr * 72 + 32 + 8 * fq), Sb1, XT);
          XT = mfma16(*(const bf16x8*)(sAdk + fr * 40 + 8 * fq), vtf, XT);
          f32x4 SAT = mfma16(*(const bf16x8*)(sTm + fr * 40 + 8 * fq), pack_acc_lo(XT), (f32x4){0.f, 0.f, 0.f, 0.f});
          SAT = -SAT;
          const bf16x8 SAb = pack_acc_lo(SAT);
          f32x4 YT = (f32x4){0.f, 0.f, 0.f, 0.f};
          YT = mfma16(*(const bf16x8*)(sRT + fr * 72 + 8 * fq), Sb0, YT); YT = mfma16(*(const bf16x8*)(sRT + fr * 72 + 32 + 8 * fq), Sb1, YT);
          YT = mfma16(*(const bf16x8*)(sAbr + fr * 40 + 8 * fq), SAb, YT); YT = mfma16(*(const bf16x8*)(sAdr + fr * 40 + 8 * fq), vtf, YT);
#pragma unroll
          for (int jt = 0; jt < 4; ++jt) { ST[jt] = mfma16(*(const bf16x8*)(sBts + (16 * jt + fr) * 40 + 8 * fq), SAb, ST[jt]); ST[jt] = mfma16(*(const bf16x8*)(sDt + (16 * jt + fr) * 40 + 8 * fq), vtf, ST[jt]);
              const float4 pl = *(const float4*)(sPL + 16 * jt + 4 * fq); ST[jt][0] *= pl.x; ST[jt][1] *= pl.y; ST[jt][2] *= pl.z; ST[jt][3] *= pl.w; }
#pragma unroll
          for (int e = 0; e < 4; ++e) sY[(4 * fq + e) * 64 + 16 * lw + fr] = YT[e]; }
        LDS_BARRIER();
        { const float4 y4 = *(const float4*)(sY + oq * 64 + 4 * (ltid & 15)); float y0 = y4.x, y1 = y4.y, y2 = y4.z, y3 = y4.w;
          if (second) { const unsigned lo = (unsigned)ov, hi = (unsigned)(ov >> 32); y0 += __uint_as_float(lo << 16); y1 += __uint_as_float(lo & 0xffff0000u); y2 += __uint_as_float(hi << 16); y3 += __uint_as_float(hi & 0xffff0000u); }
          *hb = (unsigned long long)pk2(y0, y1) | ((unsigned long long)pk2(y2, y3) << 32); }
    }
#undef RX_LOAD
    if (ctx) { const int tid = opaque_tid(), fr = tid & 15, fq = (tid >> 4) & 3;
        float* So = p.out + OUT_S + ((size_t)((bg * 2 + dir) * 8 + h)) * 4096 + (16 * lw + fr) * 64 + 4 * fq;
#pragma unroll
        for (int jt = 0; jt < 4; ++jt) *(float4*)(So + 16 * jt) = make_float4(ST[jt][0], ST[jt][1], ST[jt][2], ST[jt][3]); }
    __syncthreads();
}

constexpr int FZ_ROW = 1800;
constexpr int FZ_X = 0, FZ_MU = 32 * FZ_ROW * 2, FZ_END = FZ_MU + 4 * 1792 * 4;
static_assert(FZ_END <= LDS_BYTES && FZ_MU % 16 == 0, "finalize lds");

__device__ __forceinline__ void phase_rwkv_finalize(const P& p, unsigned char* lds) {
    bf16_t* sX = (bf16_t*)(lds + FZ_X); float* sMu = (float*)(lds + FZ_MU);
    const bf16_t* U = (const bf16_t*)(p.ws + WS_U); bf16_t* HB = (bf16_t*)(p.ws + WS_A);
    { const bf16_t* HB2 = (const bf16_t*)(p.ws + WS_HB2); const int tid0 = opaque_tid(), lane = tid0 & 63, wave = (int)threadIdx.x >> 6;
#pragma unroll 1
      for (int row = NCTX + blockIdx.x * 8 + wave; row < MT; row += gridDim.x * 8) {
          float hf[8], hb[8], og[8], v[8]; float ss = 0.f;
          unpack8(*(const uint4*)(HB + (size_t)row * DM + lane * 8), hf); unpack8(*(const uint4*)(HB2 + (size_t)(row - NCTX) * 512 + lane * 8), hb); unpack8(*(const uint4*)(U + (size_t)row * UW + 1536 + lane * 8), og);
#pragma unroll
          for (int i = 0; i < 8; ++i) { v[i] = sigmf(og[i]) * (hf[i] + hb[i]); ss += v[i] * v[i]; }
          ss = red16(ss); const float rms = rsqrtf(ss * (1.f / 128.f) + 1e-6f);
          const float4 g0 = *(const float4*)(p.hg + lane * 8), g1 = *(const float4*)(p.hg + lane * 8 + 4);
          *(uint4*)(HB + (size_t)row * DM + lane * 8) = make_uint4(pk2(v[0] * rms * g0.x, v[1] * rms * g0.y), pk2(v[2] * rms * g0.z, v[3] * rms * g0.w), pk2(v[4] * rms * g1.x, v[5] * rms * g1.y), pk2(v[6] * rms * g1.z, v[7] * rms * g1.w)); } }
    const bf16_t* A2 = (const bf16_t*)(p.ws + WS_A2BF); const bf16_t* G2 = (const bf16_t*)(p.ws + WS_G2BF);
    const int wv = __builtin_amdgcn_readfirstlane((int)threadIdx.x >> 6), hc = wv * 64;
#pragma unroll 1
    for (int tile = blockIdx.x; tile < MT / 32; tile += gridDim.x) {
        const int tid = opaque_tid(), fr = tid & 15, fq = (tid >> 4) & 3;
        const int rowt = tile * 32; const bool ctx = rowt < NCTX; const int T = ctx ? 256 : 2048; const size_t row0 = ctx ? (size_t)(rowt & ~255) : (size_t)NCTX + (size_t)((rowt - NCTX) & ~2047);
        const int tokt = rowt - (int)row0;
        __syncthreads();
#pragma unroll 2
        for (int it = 0; it < 14; ++it) { const int item = it * NTHR + tid, tl = item / 224, gi = item % 224;
            const int c0 = gi < 192 ? 2048 + 8 * gi : 2048 + 1664 + 8 * (gi - 192);
            *(uint4*)(sX + tl * FZ_ROW + 8 * gi) = *(const uint4*)(U + (row0 + tokt + tl) * UW + c0); }
        __syncthreads();
#pragma unroll 1
        for (int rt = 0; rt < 2; ++rt) {
            f32x4 af[4], ab[4], gg[4];
#pragma unroll
            for (int ct = 0; ct < 4; ++ct) { af[ct] = (f32x4){0.f, 0.f, 0.f, 0.f}; ab[ct] = af[ct]; gg[ct] = af[ct]; }
            const bf16_t* xr = sX + (16 * rt + fr) * FZ_ROW;
#pragma unroll
            for (int ks = 0; ks < 2; ++ks) { const bf16x8 xf = *(const bf16x8*)(xr + 1536 + 32 * ks + 8 * fq), xb = *(const bf16x8*)(xr + 1600 + 32 * ks + 8 * fq);
#pragma unroll
                for (int ct = 0; ct < 4; ++ct) { const int n = hc + 16 * ct + fr;
                    af[ct] = mfma16(xf, *(const bf16x8*)(A2 + (size_t)n * 64 + 32 * ks + 8 * fq), af[ct]);
                    ab[ct] = mfma16(xb, *(const bf16x8*)(A2 + (size_t)(512 + n) * 64 + 32 * ks + 8 * fq), ab[ct]); } }
#pragma unroll
            for (int ks = 0; ks < 4; ++ks) { const bf16x8 xg = *(const bf16x8*)(xr + 1664 + 32 * ks + 8 * fq);
#pragma unroll
                for (int ct = 0; ct < 4; ++ct) { const int n = hc + 16 * ct + fr; gg[ct] = mfma16(xg, *(const bf16x8*)(G2 + (size_t)n * 128 + 32 * ks + 8 * fq), gg[ct]); } }
#pragma unroll
            for (int jj = 0; jj < 4; ++jj) { const int tl = 16 * rt + 4 * fq + jj; const size_t row = (size_t)rowt + tl; const bf16_t* xt = sX + tl * FZ_ROW;
                bf16_t* hb = HB + row * DM + 512 + hc;
                float y[4], vv[4]; float sy = 0.f, sb = 0.f;
#pragma unroll
                for (int ct = 0; ct < 4; ++ct) { const int ch = hc + 16 * ct + fr;
                    const float am = 0.5f * (sigmf(p.a0[ch] + af[ct][jj]) + sigmf(p.a0[512 + ch] + ab[ct][jj]));
                    const float r = bf2f(xt[ch]), k = bf2f(xt[512 + ch]); vv[ct] = bf2f(xt[1024 + ch]);
                    sb += r * k * (1.f + (am - 1.f) * p.ka[ch]) * p.rk[ch];
                    y[ct] = bf2f(hb[16 * ct + fr]); sy += y[ct]; }
                sy = red16(sy); sb = red16(sb);
                const float mean = sy * (1.f / 64.f); float vs = 0.f;
#pragma unroll
                for (int ct = 0; ct < 4; ++ct) { const float d = y[ct] - mean; vs += d * d; }
                vs = red16(vs); const float rstd = rsqrtf(vs * (1.f / 64.f) + 64e-5f);
#pragma unroll
                for (int ct = 0; ct < 4; ++ct) { const int ch = hc + 16 * ct + fr; const float yn = (y[ct] - mean) * rstd * p.lng[ch] + p.lnb[ch];
                    hb[16 * ct + fr] = f2bf((yn + sb * vv[ct]) * gg[ct][jj]); } }
        }
    }
}

__device__ __forceinline__ void phase_scan(const P& p, unsigned char* lds, int round = 0) {
    unsigned* ctr = (unsigned*)(p.ws + WS_CTR) + round;
    volatile int* sTask = (volatile int*)(lds + LDS_BYTES - 16);
#pragma unroll 1
    for (;;) {
        __syncthreads();
        if (threadIdx.x == 0) *sTask = (int)atomicAdd(ctr, 1u);
        __syncthreads();
        const int t = __builtin_amdgcn_readfirstlane(*sTask);
        if (t >= 512) break;
#pragma unroll 1
        for (int rep = 0; rep < ((PROBE_DUP == 100 && (t < 64 || (t >= 128 && t < 256))) || (PROBE_DUP == 101 && !(t < 64 || (t >= 128 && t < 256))) ? 2 : 1); ++rep) {
        if (t < 64) mlstm_task(p, lds, 32 + (t >> 3), (t >> 1) & 3, t & 1);
        else if (t < 128) { const int q = t - 64; rwkv_task_w(p, lds, 32 + (q >> 3), q & 7); }
        else if (t < 256) { const int q = t - 128; mlstm_task(p, lds, q >> 2, q & 3, -1); }
        else { const int q = t - 256; rwkv_task_w(p, lds, q >> 3, q & 7); }
        }
    }
}

__device__ void phase_convert_w2(const P& p, unsigned char* lds) {
    float* tile = (float*)lds;
    const int t1 = 16 * 88, t2 = 44 * 16;
    for (int it = blockIdx.x; it < t1 + t2; it += gridDim.x) {
        if (it < t1) do_convert(p.w2in, (bf16_t*)(p.ws + WS_W1), 1024, 5632, 5632, 1, it, tile);
        else do_convert(p.w2out, (bf16_t*)(p.ws + WS_W1B), 2816, 1024, 1024, 0, it - t1, tile);
    }
}

#define XB_TMO      128
#define XB_XCNT(j)  (256  + 64 * (j))
#define XB_XSUB(j)  (1280 + 64 * (j))
#define XB_XGEN(j)  (2304 + 64 * (j))
#define XB_TOP      3328
#define XB_TOPGEN   3392
#define XCD_BAR_WORDS 3456
#define XB_SPIN_CAP (1u << 18)
__device__ __forceinline__ unsigned xb_ld(unsigned* p)              { return __hip_atomic_load(p, __ATOMIC_RELAXED, __HIP_MEMORY_SCOPE_AGENT); }
__device__ __forceinline__ unsigned xb_add(unsigned* p, unsigned v) { return __hip_atomic_fetch_add(p, v, __ATOMIC_RELAXED, __HIP_MEMORY_SCOPE_AGENT); }
__device__ __forceinline__ unsigned xb_xcc_id() { return (unsigned)__builtin_amdgcn_s_getreg((3 << 11) | 20) & 0xFu; }
#define XB_SPIN(cond, bar) do { unsigned _sp = 0; while (cond) { __builtin_amdgcn_s_sleep(1); \
    if ((++_sp & 255u) == 0u) { if (xb_ld(&(bar)[XB_TMO])) break; if (_sp > XB_SPIN_CAP) { atomicAdd(&(bar)[XB_TMO], 1u); break; } } } } while (0)
struct XcdBarrier { unsigned* bar; unsigned x; volatile unsigned* st; };
__device__ __forceinline__ XcdBarrier xcd_barrier_post(unsigned* bar, volatile unsigned* st) {
    XcdBarrier b; b.bar = bar; b.x = xb_xcc_id(); b.st = st;
    if (threadIdx.x == 0) (void)xb_add(&bar[XB_XCNT(b.x)], 1u);
    return b;
}
__device__ __forceinline__ void xcd_barrier_complete(unsigned* bar, unsigned x, unsigned& nloc, unsigned& nx) {
    const unsigned G = gridDim.x * gridDim.y * gridDim.z;
    unsigned sum, cnt, mine, sp = 0u;
    for (;;) {
        sum = 0u; cnt = 0u; mine = 0u;
#pragma unroll
        for (unsigned j = 0; j < 16; ++j) { const unsigned c = xb_ld(&bar[XB_XCNT(j)]); sum += c; cnt += (c > 0u) ? 1u : 0u; mine = (j == x) ? c : mine; }
        if (sum == G) break;
        __builtin_amdgcn_s_sleep(1);
        if ((++sp & 255u) == 0u) { if (xb_ld(&bar[XB_TMO])) break; if (sp > XB_SPIN_CAP) { atomicAdd(&bar[XB_TMO], 1u); break; } }
    }
    nloc = mine > 0u ? mine : 1u; nx = cnt > 0u ? cnt : 1u;
}
__device__ __forceinline__ void xcd_barrier(const XcdBarrier& b) {
    asm volatile("s_waitcnt vmcnt(0)" ::: "memory");
    __syncthreads();
    if (threadIdx.x == 0) {
        unsigned* bar = b.bar;
        __builtin_amdgcn_s_waitcnt(0);
        unsigned nloc = b.st[0], nx = b.st[1];
        if (nloc == 0u) { xcd_barrier_complete(bar, b.x, nloc, nx); b.st[0] = nloc; b.st[1] = nx; }
        const unsigned old = xb_add(&bar[XB_XSUB(b.x)], 1u);
        const unsigned gen = old / nloc;
        if (old + 1u == (gen + 1u) * nloc) {
            __builtin_amdgcn_fence(__ATOMIC_RELEASE, "agent");
            asm volatile("s_waitcnt vmcnt(0)" ::: "memory");
            const unsigned og = xb_add(&bar[XB_TOP], 1u);
            const unsigned tg = og / nx;
            if (og + 1u == (tg + 1u) * nx) xb_add(&bar[XB_TOPGEN], 1u);
            else XB_SPIN(xb_ld(&bar[XB_TOPGEN]) == tg, bar);
            __builtin_amdgcn_fence(__ATOMIC_ACQUIRE, "agent");
            xb_add(&bar[XB_XGEN(b.x)], 1u);
            asm volatile("s_waitcnt vmcnt(0)" ::: "memory");
        } else {
            XB_SPIN(xb_ld(&bar[XB_XGEN(b.x)]) == gen, bar);
            __builtin_amdgcn_fence(__ATOMIC_ACQUIRE, "agent");
            asm volatile("s_waitcnt vmcnt(0)" ::: "memory");
        }
    }
    __syncthreads();
}

constexpr int NPHASE = 12;
template <int PH>
__device__ __forceinline__ void run_phase(const P& p, unsigned char* lds) {
    const float* mod = (const float*)(p.ws + WS_MOD);
    if constexpr (PH == 0) phase0(p, lds);
    if constexpr (PH == 1) phase_normmod(p, 0);
    if constexpr (PH == 2) { EpiSwiglu E{(bf16_t*)(p.ws + WS_U)}; run_gemm(lds, (const bf16_t*)(p.ws + WS_A), (const bf16_t*)(p.ws + WS_W1), 5632, 1024, E); }
    if constexpr (PH == 3) { EpiResid E{p.xp, p.xs, p.out, mod + 2048, 0.5f, 0}; run_gemm(lds, (const bf16_t*)(p.ws + WS_U), (const bf16_t*)(p.ws + WS_W1B), 1024, 2816, E); }
    if constexpr (PH == 4) phase_normmod(p, 1);
    if constexpr (PH == 5) { EpiU E{(bf16_t*)(p.ws + WS_U), (float*)(p.ws + WS_GATES)}; run_gemm(lds, (const bf16_t*)(p.ws + WS_A), (const bf16_t*)(p.ws + WS_BT3), 4096, 1024, E); }
    if constexpr (PH == 6) phase_scan(p, lds);
    if constexpr (PH == 12) phase_rwkv_finalize(p, lds);
    if constexpr (PH == 13) phase_shift((bf16_t*)(p.ws + WS_U), p.mu, (uint4*)lds);
    if constexpr (PH == 7) { EpiResid E{p.xp, p.xs, p.out, mod + 5120, 1.0f, 1}; run_gemm(lds, (const bf16_t*)(p.ws + WS_A), (const bf16_t*)(p.ws + WS_BT4), 1024, 1024, E); }
    if constexpr (PH == 8) { phase_normmod(p, 2); phase_convert_w2(p, lds); }
    if constexpr (PH == 9) { EpiSwiglu E{(bf16_t*)(p.ws + WS_U)}; run_gemm(lds, (const bf16_t*)(p.ws + WS_A), (const bf16_t*)(p.ws + WS_W1), 5632, 1024, E); }
    if constexpr (PH == 10) { EpiResid E{p.xp, p.xs, p.out, mod + 8192, 0.5f, 1}; run_gemm(lds, (const bf16_t*)(p.ws + WS_U), (const bf16_t*)(p.ws + WS_W1B), 1024, 2816, E); }
    if constexpr (PH == 11) phase_finalnorm(p);
}

#if !ONE_LAUNCH
template <int PH>
__global__ void __launch_bounds__(NTHR, 2) k_phase(P p) {
    extern __shared__ __attribute__((aligned(16))) unsigned char lds[];
    run_phase<PH>(p, lds);
}
#endif

#if ONE_LAUNCH
__global__ void __launch_bounds__(NTHR, 2) k_mega(P p) {
    extern __shared__ __attribute__((aligned(16))) unsigned char lds[];
    cg::grid_group grid = cg::this_grid();
    volatile unsigned* xst = (volatile unsigned*)(lds + LDS_BYTES - 32);
    if (threadIdx.x == 0) { xst[0] = 0u; xst[1] = 0u; }
    __syncthreads();
    const XcdBarrier xbar = xcd_barrier_post((unsigned*)(p.ws + WS_BAR), xst);
#define GSYNC() xcd_barrier(xbar)
    if (p.ws == nullptr) grid.sync();
    run_phase<0>(p, lds); GSYNC();
    if (PROBE_DUP == 0) { run_phase<0>(p, lds); GSYNC(); }
    run_phase<1>(p, lds); GSYNC();
    if (PROBE_DUP == 1) { run_phase<1>(p, lds); GSYNC(); }
    run_phase<2>(p, lds); GSYNC();
    if (PROBE_DUP == 2 || PROBE_DUP == 235) { run_phase<2>(p, lds); GSYNC(); }
    run_phase<3>(p, lds); GSYNC();
    if (PROBE_DUP == 3 || PROBE_DUP == 235) { run_phase<3>(p, lds); GSYNC(); }
    run_phase<4>(p, lds); GSYNC();
    if (PROBE_DUP == 4) { run_phase<4>(p, lds); GSYNC(); }
    run_phase<5>(p, lds); GSYNC();
    if (PROBE_DUP == 5 || PROBE_DUP == 235) { run_phase<5>(p, lds); GSYNC(); }
    run_phase<13>(p, lds); GSYNC();
    run_phase<6>(p, lds); GSYNC();
    if (PROBE_DUP == 6) { phase_scan(p, lds, 1); GSYNC(); }
    run_phase<12>(p, lds); GSYNC();
    run_phase<7>(p, lds); GSYNC();
    if (PROBE_DUP == 7) { run_phase<7>(p, lds); GSYNC(); }
    run_phase<8>(p, lds); GSYNC();
    if (PROBE_DUP == 8) { run_phase<8>(p, lds); GSYNC(); }
    run_phase<9>(p, lds); GSYNC();
    if (PROBE_DUP == 9) { run_phase<9>(p, lds); GSYNC(); }
    run_phase<10>(p, lds); GSYNC();
    if (PROBE_DUP == 10) { run_phase<10>(p, lds); GSYNC(); }
    run_phase<11>(p, lds);
    if (PROBE_DUP == 200) { for (int i = 0; i < 20; ++i) GSYNC(); }
}
#endif

#if !ONE_LAUNCH
template <int PH> static void launch_phase(const P& p, int grid, hipStream_t stream) {
    static bool attr = false;
    if (!attr) { (void)hipFuncSetAttribute((const void*)k_phase<PH>, hipFuncAttributeMaxDynamicSharedMemorySize, LDS_BYTES); attr = true; }
    hipLaunchKernelGGL(k_phase<PH>, dim3(grid), dim3(NTHR), LDS_BYTES, stream, p);
}
#endif

extern "C" void kernel_launch(void* const* d_in, const int* in_sizes, int n_in, void* d_out, int out_size, void* d_ws, size_t ws_size, hipStream_t stream) {
    (void)in_sizes; (void)n_in; (void)out_size; (void)ws_size;
    static int grid = 0;
    if (grid == 0) {
        int dev = 0, cus = 0;
        if (hipGetDevice(&dev) != hipSuccess || hipDeviceGetAttribute(&cus, hipDeviceAttributeMultiprocessorCount, dev) != hipSuccess || cus <= 0) cus = 256;
#if ONE_LAUNCH
        (void)hipFuncSetAttribute((const void*)k_mega, hipFuncAttributeMaxDynamicSharedMemorySize, LDS_BYTES);
        int per_cu = 0;
        if (hipOccupancyMaxActiveBlocksPerMultiprocessor(&per_cu, (const void*)k_mega, NTHR, LDS_BYTES) != hipSuccess || per_cu < 1) per_cu = 1;
        (void)hipGetLastError();
#endif
        grid = cus;
    }
    P p{};
    const float** f = (const float**)&p;
    for (int i = 0; i < 35; ++i) f[i] = (const float*)d_in[i];
    p.out = (float*)d_out; p.ws = (unsigned char*)d_ws;
    (void)hipMemsetAsync((char*)d_ws + WS_MOD, 0, NCOND * MODW * sizeof(float) + 256 + 3456 * 4, stream);
#if ONE_LAUNCH
    void* args[] = {&p};
    hipError_t e = hipLaunchCooperativeKernel((const void*)k_mega, dim3(grid), dim3(NTHR), args, LDS_BYTES, stream);
    if (e != hipSuccess) fprintf(stderr, "cooperative launch failed: %s (grid %d)\n", hipGetErrorString(e), grid);
#else
    launch_phase<0>(p, grid, stream); launch_phase<1>(p, grid, stream); launch_phase<2>(p, grid, stream); launch_phase<3>(p, grid, stream);
    launch_phase<4>(p, grid, stream); launch_phase<5>(p, grid, stream); launch_phase<13>(p, grid, stream); launch_phase<6>(p, grid, stream); launch_phase<12>(p, grid, stream); launch_phase<7>(p, grid, stream);
    launch_phase<8>(p, grid, stream); launch_phase<9>(p, grid, stream); launch_phase<10>(p, grid, stream); launch_phase<11>(p, grid, stream);
#endif
}
```

```cpp
#include <hip/hip_runtime.h>
#include <hip/hip_cooperative_groups.h>
#include <cstdio>
#include <cstdint>
namespace cg = cooperative_groups;

#ifndef PROBE_DUP
#define PROBE_DUP -1
#endif
#ifndef ONE_LAUNCH
#define ONE_LAUNCH 1
#endif

#define LDS_BARRIER() do { asm volatile("s_waitcnt lgkmcnt(0)" ::: "memory"); __builtin_amdgcn_s_barrier(); asm volatile("" ::: "memory"); } while (0)
__device__ __forceinline__ int opaque_tid() { int z = 0; asm volatile("" : "+v"(z)); return (int)threadIdx.x + z; }

namespace pg8 {
#define PG8_LAS __attribute__((address_space(3)))
typedef unsigned short bf16_t;
typedef short bf16x8 __attribute__((ext_vector_type(8)));
typedef float f32x4 __attribute__((ext_vector_type(4)));
typedef unsigned u32x4 __attribute__((ext_vector_type(4)));
constexpr int BM = 256, BK = 64, HALF = 128, HTB = HALF * BK * 2, STAGE_BYTES = 8 * HTB, NXCD = 8, WGM = 8;

__host__ __device__ __forceinline__ int lds_byte(int r, int c) { const int st = (r >> 4) * 2 + (c >> 5), rr = r & 15, cc = c & 31, ob = rr * 64 + cc * 2; return st * 1024 + (ob ^ (((ob >> 9) & 1) << 5)); }
__host__ __device__ __forceinline__ void stage_rc(int b, int& R, int& C) { const int st = b / 1024, sb = b % 1024, swz = sb ^ (((sb >> 9) & 1) << 5); R = (st >> 1) * 16 + swz / 64; C = (st & 1) * 32 + (swz % 64) / 2; }
__host__ __device__ __forceinline__ int perm32(int rho) { const int n = rho >> 4, i = rho & 15; return 8 * (i >> 2) + 4 * n + (i & 3); }

struct Unit { int pm, pn; };
struct Gemm { const bf16_t* A; const bf16_t* Bt; int M, N, K; };

struct StaticOrder {
    int nM, nN, nwg, G, c;
    __host__ __device__ void init(int M, int N, int G_, int c_) { nM = M / BM; nN = N / BM; nwg = nM * nN; G = G_; c = c_; }
    __host__ __device__ bool next(int i, Unit& u) const {
        const long L = (long)i * G + c; if (L >= nwg) return false;
        int wgid = (int)L; { const int q = nwg / NXCD, r = nwg % NXCD, xcd = wgid % NXCD, off = wgid / NXCD; wgid = (xcd < r ? xcd * (q + 1) : r * (q + 1) + (xcd - r) * q) + off; }
        const int nig = WGM * nN, gid = wgid / nig, fm = gid * WGM, gsz = (nM - fm) < WGM ? (nM - fm) : WGM;
        u.pm = fm + ((wgid % nig) % gsz); u.pn = (wgid % nig) / gsz; return true;
    }
    __device__ __forceinline__ void a_ready(const Unit&) const {}
    __device__ __forceinline__ void done(const Unit&) const {}
};

__device__ __forceinline__ unsigned cvt_pk_bf16(float lo, float hi) { unsigned r; asm volatile("v_cvt_pk_bf16_f32 %0, %1, %2" : "=v"(r) : "v"(lo), "v"(hi)); return r; }

template <class Epi, class Sched, bool ALIGN_EPI = false, bool SP2 = false>
__device__ __forceinline__ void gemm_phase(PG8_LAS unsigned char* lds, const Gemm g, const Sched& S, const Epi& E) {
    const int tid = opaque_tid(), wid = __builtin_amdgcn_readfirstlane((int)threadIdx.x >> 6), lane = tid & 63, wr = wid >> 2, wc = wid & 3, fr = lane & 15, fq = lane >> 4;
    const int K = g.K, nt = K / BK;
    unsigned voffA[2], voffB[2];
#pragma unroll
    for (int i = 0; i < 2; ++i) { int R, C; stage_rc(tid * 16 + i * 8192, R, C); const int Rb = Epi::PERM ? ((R & ~31) + perm32(R & 31)) : R;
        voffA[i] = (unsigned)(R * K + C) * 2u; voffB[i] = (unsigned)(Rb * K + C) * 2u; }
    const size_t kstep = (size_t)(BK * 2);
    const size_t hstep = (size_t)HALF * K * 2;
    const size_t tstep = 2 * hstep;
    const unsigned ldsw = (unsigned)wid * 1024u;
    const int aoff = lds_byte(wr * 64 + fr, fq * 8), boff = lds_byte(wc * 32 + fr, fq * 8);
#define PG8_SA(b, h) (((b) * 2 + (h)) * HTB)
#define PG8_SB(b, h) ((4 + (b) * 2 + (h)) * HTB)
#define PG8_STAGE(bufoff, gbase, voff) do { _Pragma("unroll") for (int _i = 0; _i < 2; ++_i) \
        __builtin_amdgcn_global_load_lds((const unsigned*)((const char*)(gbase) + (voff)[_i]), (PG8_LAS unsigned*)(lds + (bufoff) + ldsw + _i * 8192), 16, 0, 0); } while (0)
#define PG8_LDA(dst, b, h) do { _Pragma("unroll") for (int m = 0; m < 4; ++m) _Pragma("unroll") for (int k = 0; k < 2; ++k) dst[m][k] = *(const PG8_LAS bf16x8*)(lds + PG8_SA(b, h) + aoff + m * 2048 + k * 1024); } while (0)
#define PG8_LDB(dst, b, h) do { _Pragma("unroll") for (int n = 0; n < 2; ++n) _Pragma("unroll") for (int k = 0; k < 2; ++k) dst[n][k] = *(const PG8_LAS bf16x8*)(lds + PG8_SB(b, h) + boff + n * 2048 + k * 1024); } while (0)
#define PG8_MMA(ai, bj, At, Bt) do { __builtin_amdgcn_s_setprio(1); _Pragma("unroll") for (int m = 0; m < 4; ++m) _Pragma("unroll") for (int n = 0; n < 2; ++n) _Pragma("unroll") for (int k = 0; k < 2; ++k) \
        acc[ai][bj][m][n] = __builtin_amdgcn_mfma_f32_16x16x32_bf16(Bt[n][k], At[m][k], acc[ai][bj][m][n], 0, 0, 0); __builtin_amdgcn_s_setprio(0); } while (0)
#define PG8_WAIT_V(n) asm volatile("s_waitcnt vmcnt(" #n ")" ::: "memory")
#define PG8_WAIT_L(n) asm volatile("s_waitcnt lgkmcnt(" #n ")" ::: "memory")
#define PG8_BAR __builtin_amdgcn_s_barrier()
#define PG8_SCHED __builtin_amdgcn_sched_barrier(0)
    Unit cur, nxt; int ui = 0;
    if (!S.next(0, cur)) return;
    f32x4 acc[2][2][4][2];
#pragma unroll
    for (int a = 0; a < 2; ++a)
#pragma unroll
        for (int b = 0; b < 2; ++b)
#pragma unroll
            for (int m = 0; m < 4; ++m)
#pragma unroll
                for (int n = 0; n < 2; ++n) acc[a][b][m][n] = (f32x4){0.f, 0.f, 0.f, 0.f};
    bf16x8 At[4][2], B0[2][2], B1[2][2];
    const char* cA = (const char*)g.A + (size_t)cur.pm * tstep; const char* cB = (const char*)g.Bt + (size_t)cur.pn * tstep;
    S.a_ready(cur);
    if constexpr (SP2) {
        PG8_STAGE(PG8_SB(0, 0), cB, voffB); PG8_STAGE(PG8_SB(0, 1), cB + hstep, voffB); PG8_STAGE(PG8_SA(0, 0), cA, voffA); PG8_STAGE(PG8_SA(0, 1), cA + hstep, voffA);
        if (wr == 1) PG8_BAR;
        PG8_WAIT_V(2); PG8_BAR;
        PG8_STAGE(PG8_SB(1, 0), cB + kstep, voffB); PG8_STAGE(PG8_SA(1, 0), cA + kstep, voffA); PG8_STAGE(PG8_SB(1, 1), cB + hstep + kstep, voffB);
        PG8_WAIT_V(6); PG8_BAR;
    } else {
        PG8_STAGE(PG8_SB(0, 0), cB, voffB); PG8_STAGE(PG8_SA(0, 0), cA, voffA); PG8_STAGE(PG8_SB(0, 1), cB + hstep, voffB); PG8_STAGE(PG8_SA(0, 1), cA + hstep, voffA);
        if (wr == 1) PG8_BAR;
        PG8_WAIT_V(4); PG8_BAR;
        PG8_STAGE(PG8_SB(1, 0), cB + kstep, voffB); PG8_STAGE(PG8_SA(1, 0), cA + kstep, voffA); PG8_STAGE(PG8_SB(1, 1), cB + hstep + kstep, voffB);
        PG8_WAIT_V(6); PG8_BAR;
    }
    for (;;) {
        const bool has_next = S.next(ui + 1, nxt);
        const char* nA = has_next ? (const char*)g.A + (size_t)nxt.pm * tstep : cA; const char* nB = has_next ? (const char*)g.Bt + (size_t)nxt.pn * tstep : cB;
        for (int t = 0; t < nt; t += 2) {
            const bool last = (t == nt - 2);
            const char* a1 = cA + (size_t)(t + 1) * kstep;
            const char* a2 = last ? nA : cA + (size_t)(t + 2) * kstep; const char* b2 = last ? nB : cB + (size_t)(t + 2) * kstep;
            const char* a3 = a2 + kstep; const char* b3 = b2 + kstep;
            if (last && has_next) S.a_ready(nxt);
            if constexpr (SP2) {
            PG8_LDB(B0, 0, 0); PG8_LDB(B1, 0, 1); PG8_SCHED; PG8_LDA(At, 0, 0); PG8_STAGE(PG8_SA(1, 1), a1 + hstep, voffA);
            PG8_WAIT_V(8); PG8_WAIT_L(0); PG8_BAR; PG8_MMA(0, 0, At, B0); PG8_MMA(0, 1, At, B1); PG8_BAR; PG8_SCHED;
            PG8_LDA(At, 0, 1); PG8_STAGE(PG8_SB(0, 0), b2, voffB); PG8_STAGE(PG8_SB(0, 1), b2 + hstep, voffB); PG8_STAGE(PG8_SA(0, 0), a2, voffA);
            PG8_WAIT_V(8); PG8_WAIT_L(0); PG8_BAR; PG8_MMA(1, 0, At, B0); PG8_MMA(1, 1, At, B1); PG8_BAR; PG8_SCHED;
            PG8_LDB(B0, 1, 0); PG8_LDB(B1, 1, 1); PG8_SCHED; PG8_LDA(At, 1, 0); PG8_STAGE(PG8_SA(0, 1), a2 + hstep, voffA);
            PG8_WAIT_V(8); PG8_WAIT_L(0); PG8_BAR; PG8_MMA(0, 0, At, B0); PG8_MMA(0, 1, At, B1); PG8_BAR; PG8_SCHED;
            PG8_LDA(At, 1, 1); PG8_STAGE(PG8_SB(1, 0), b3, voffB); PG8_STAGE(PG8_SB(1, 1), b3 + hstep, voffB); PG8_STAGE(PG8_SA(1, 0), a3, voffA);
            PG8_WAIT_V(8); PG8_WAIT_L(0); PG8_BAR; PG8_MMA(1, 0, At, B0); PG8_MMA(1, 1, At, B1); PG8_BAR; PG8_SCHED;
            } else {
            PG8_LDB(B0, 0, 0); PG8_SCHED; PG8_LDA(At, 0, 0); PG8_STAGE(PG8_SA(1, 1), a1 + hstep, voffA);
            PG8_WAIT_L(8); PG8_BAR; PG8_WAIT_L(0); PG8_MMA(0, 0, At, B0); PG8_BAR; PG8_SCHED;
            PG8_LDB(B1, 0, 1); PG8_STAGE(PG8_SB(0, 0), b2, voffB);
            PG8_BAR; PG8_WAIT_L(0); PG8_MMA(0, 1, At, B1); PG8_BAR;
            PG8_LDA(At, 0, 1); PG8_STAGE(PG8_SA(0, 0), a2, voffA);
            PG8_BAR; PG8_WAIT_L(0); PG8_MMA(1, 0, At, B0); PG8_BAR; PG8_SCHED;
            PG8_STAGE(PG8_SB(0, 1), b2 + hstep, voffB);
            PG8_WAIT_V(6); PG8_BAR; PG8_MMA(1, 1, At, B1); PG8_BAR;
            PG8_LDB(B0, 1, 0); PG8_SCHED; PG8_LDA(At, 1, 0); PG8_STAGE(PG8_SA(0, 1), a2 + hstep, voffA);
            PG8_WAIT_L(8); PG8_BAR; PG8_WAIT_L(0); PG8_MMA(0, 0, At, B0); PG8_BAR; PG8_SCHED;
            PG8_LDB(B1, 1, 1); PG8_STAGE(PG8_SB(1, 0), b3, voffB);
            PG8_BAR; PG8_WAIT_L(0); PG8_MMA(0, 1, At, B1); PG8_BAR;
            PG8_LDA(At, 1, 1); PG8_STAGE(PG8_SA(1, 0), a3, voffA);
            PG8_BAR; PG8_WAIT_L(0); PG8_MMA(1, 0, At, B0); PG8_BAR; PG8_SCHED;
            PG8_STAGE(PG8_SB(1, 1), b3 + hstep, voffB);
            PG8_WAIT_V(6); PG8_BAR; PG8_MMA(1, 1, At, B1); PG8_BAR;
            }
        }
        if constexpr (ALIGN_EPI) { if (wr == 0) PG8_BAR; }
        E(acc, cur, wr, wc, fr, fq); S.done(cur);
        if (!has_next) break;
#pragma unroll
        for (int a = 0; a < 2; ++a)
#pragma unroll
            for (int b = 0; b < 2; ++b)
#pragma unroll
                for (int m = 0; m < 4; ++m)
#pragma unroll
                    for (int n = 0; n < 2; ++n) acc[a][b][m][n] = (f32x4){0.f, 0.f, 0.f, 0.f};
        cur = nxt; cA = nA; cB = nB; ++ui;
        if constexpr (ALIGN_EPI) { if (wr == 1) PG8_BAR; }
    }
    PG8_WAIT_V(0);
    if constexpr (!ALIGN_EPI) { if (wr == 0) PG8_BAR; }
    PG8_BAR;
#undef PG8_SA
#undef PG8_SB
#undef PG8_STAGE
#undef PG8_LDA
#undef PG8_LDB
#undef PG8_MMA
#undef PG8_WAIT_V
#undef PG8_WAIT_L
#undef PG8_BAR
#undef PG8_SCHED
}
}

using pg8::bf16_t; using pg8::bf16x8; using pg8::f32x4;

constexpr int MT = 24576, DM = 1024, DFF = 2816, NCTX = 8192;
constexpr int UW = 3984;
constexpr int NCOND = 9, MODW = 9216;
constexpr size_t MiB = 1ull << 20;
constexpr size_t WS_A = 0, WS_U = 48 * MiB, WS_W1 = WS_U + 132 * MiB, WS_W1B = WS_W1 + (size_t)5632 * 1024 * 2,
                 WS_BT3 = 235 * MiB, WS_HB2 = 235 * MiB  ,
                 WS_BT4 = 251 * MiB, WS_MOD = 253 * MiB, WS_CTR = WS_MOD + 9 * 9216 * 4  , WS_BAR = WS_CTR + 256  , WS_GATES = 254 * MiB;
constexpr size_t WS_A2BF = 255 * MiB + 512 * 1024, WS_G2BF = WS_A2BF + 2 * 512 * 64 * 2;
constexpr int OUT_C = 25165824, OUT_N = 29360128, OUT_MM = 29392896, OUT_S = 29393152;
constexpr int LDS_BYTES = 163840;
constexpr int NTHR = 512;

struct P {
    const float *xp, *xs, *c, *sC, *sn, *sm, *sS, *cctx, *ada_w, *ada_b, *n1, *w1in, *w1out, *nmix, *wmin, *wmout,
        *cw, *cb, *gb, *hg, *mu, *w0, *w2, *a0, *a2, *g2, *kk, *ka, *rk, *lng, *lnb, *n2, *w2in, *w2out, *nf;
    float* out; unsigned char* ws;
};

typedef __bf16 hwbf16x2 __attribute__((ext_vector_type(2)));
typedef float hwf32x2 __attribute__((ext_vector_type(2)));
__device__ __forceinline__ unsigned pk2(float a, float b) { const hwf32x2 v = {a, b}; const hwbf16x2 r = __builtin_convertvector(v, hwbf16x2); return __builtin_bit_cast(unsigned, r); }
__device__ __forceinline__ unsigned short f2bf(float f) { return (unsigned short)(pk2(f, f) & 0xffffu); }
__device__ __forceinline__ float bf2f(unsigned short b) { return __uint_as_float(((unsigned)b) << 16); }
__device__ __forceinline__ int cond_of(int row) { return row < NCTX ? 0 : 1 + ((row - NCTX) >> 11); }
__device__ __forceinline__ float fexp(float x) { return __builtin_amdgcn_exp2f(x * 1.4426950408889634f); }
__device__ __forceinline__ float flog(float x) { return __builtin_amdgcn_logf(x) * 0.6931471805599453f; }
__device__ __forceinline__ float siluf(float x) { return x * __builtin_amdgcn_rcpf(1.f + fexp(-x)); }
__device__ __forceinline__ float sigmf(float x) { return __builtin_amdgcn_rcpf(1.f + fexp(-x)); }
__device__ __forceinline__ float tanh_fast(float x) { return 1.f - 2.f * __builtin_amdgcn_rcpf(1.f + fexp(2.f * x)); }
__device__ __forceinline__ float softplus_fast(float z) { return fmaxf(z, 0.f) + flog(1.f + fexp(-fabsf(z))); }
__device__ __forceinline__ const float* xrow(const P& p, int row) { return row < NCTX ? p.xp + (size_t)row * DM : p.xs + (size_t)(row - NCTX) * DM; }
__device__ __forceinline__ f32x4 mfma16(bf16x8 a, bf16x8 b, f32x4 c) { return __builtin_amdgcn_mfma_f32_16x16x32_bf16(a, b, c, 0, 0, 0); }
__device__ __forceinline__ void unpack8(uint4 v, float* f) {
    f[0] = __uint_as_float(v.x << 16); f[1] = __uint_as_float(v.x & 0xffff0000u); f[2] = __uint_as_float(v.y << 16); f[3] = __uint_as_float(v.y & 0xffff0000u);
    f[4] = __uint_as_float(v.z << 16); f[5] = __uint_as_float(v.z & 0xffff0000u); f[6] = __uint_as_float(v.w << 16); f[7] = __uint_as_float(v.w & 0xffff0000u);
}

__device__ __forceinline__ int colmap(int kind, int n) {
    if (kind == 0) return n;
    if (kind == 1) { const int t = n >> 8, bj = (n >> 7) & 1, c = n & 127; return bj * DFF + t * 128 + c; }
    if (n < 2048) return n; if (n < 3968) return n + 16; if (n < 3984) return n - 3968 + 2048; return -1;
}
__device__ void convert_tile(const float* __restrict__ src, bf16_t* __restrict__ dst, int K, int Nsrc, int kind, int k0, int n0, float* tile) {
    const int tid = opaque_tid();
    { const int n = tid & 63, kr = tid >> 6; const int sc = colmap(kind, n0 + n);
#pragma unroll
      for (int i = 0; i < 8; ++i) { const int k = kr + 8 * i; tile[k * 65 + n] = sc >= 0 ? src[(size_t)(k0 + k) * Nsrc + sc] : 0.f; } }
    __syncthreads();
    { const int nn = tid >> 3, kg = tid & 7; unsigned w[4];
#pragma unroll
      for (int j = 0; j < 4; ++j) w[j] = pk2(tile[(kg * 8 + 2 * j) * 65 + nn], tile[(kg * 8 + 2 * j + 1) * 65 + nn]);
      *(uint4*)(dst + (size_t)(n0 + nn) * K + k0 + kg * 8) = make_uint4(w[0], w[1], w[2], w[3]); }
    __syncthreads();
}
__device__ void convert_jobs(const P& p, int first, int njobs_sel, unsigned char* lds, int item0, int nitems_before) {}

__device__ void do_convert(const float* src, bf16_t* dst, int K, int Nsrc, int Ndst, int kind, int t, float* tile) {
    const int nkt = K / 64; const int kt = t % nkt, ntile = t / nkt; (void)Ndst;
    convert_tile(src, dst, K, Nsrc, kind, kt * 64, ntile * 64, tile);
}

__device__ void phase0(const P& p, unsigned char* lds) {
    float* tile = (float*)lds;
    const int tid = opaque_tid();
    const int n_ada = 36 * 8;
    const int t1 = 16 * 88, t2 = 44 * 16, t3 = 16 * 64, t4 = 16 * 16, t5 = 8, t6 = 8, t7 = 16;
    const int total = n_ada + t1 + t2 + t3 + t4 + t5 + t6 + t7;
    for (int it = blockIdx.x; it < total; it += gridDim.x) {
        if (it < n_ada) {
            const int cgp = it % 36, kc = it / 36;
            float* sc = tile;
            __syncthreads();
            for (int i = tid; i < NCOND * 128; i += NTHR) { const int c = i >> 7, k = i & 127; const float v = c == 0 ? p.cctx[kc * 128 + k] : p.c[(c - 1) * DM + kc * 128 + k]; sc[i] = siluf(v); }
            __syncthreads();
            const int col = cgp * 256 + (tid & 255), kh = tid >> 8;
            float acc[NCOND];
#pragma unroll
            for (int c = 0; c < NCOND; ++c) acc[c] = 0.f;
            const float* w = p.ada_w + (size_t)(kc * 128 + kh * 64) * MODW + col;
#pragma unroll 4
            for (int k = 0; k < 64; ++k) { const float wv = w[(size_t)k * MODW];
#pragma unroll
                for (int c = 0; c < NCOND; ++c) acc[c] += sc[c * 128 + kh * 64 + k] * wv; }
            float* mod = (float*)(p.ws + WS_MOD);
            const float bias = (kc == 0 && kh == 0) ? p.ada_b[col] : 0.f;
#pragma unroll
            for (int c = 0; c < NCOND; ++c) atomicAdd(mod + c * MODW + col, acc[c] + bias);
            __syncthreads();
        } else {
            int t = it - n_ada;
            if (t < t1) do_convert(p.w1in, (bf16_t*)(p.ws + WS_W1), 1024, 5632, 5632, 1, t, tile);
            else if ((t -= t1) < t2) do_convert(p.w1out, (bf16_t*)(p.ws + WS_W1B), 2816, 1024, 1024, 0, t, tile);
            else if ((t -= t2) < t3) do_convert(p.wmin, (bf16_t*)(p.ws + WS_BT3), 1024, 3984, 4096, 2, t, tile);
            else if ((t -= t3) < t4) do_convert(p.wmout, (bf16_t*)(p.ws + WS_BT4), 1024, 1024, 1024, 0, t, tile);
            else if ((t -= t4) < t5) do_convert(p.a2, (bf16_t*)(p.ws + WS_A2BF), 64, 512, 512, 0, t, tile);
            else if ((t -= t5) < t6) do_convert(p.a2 + 64 * 512, (bf16_t*)(p.ws + WS_A2BF) + 512 * 64, 64, 512, 512, 0, t, tile);
            else { t -= t6; do_convert(p.g2, (bf16_t*)(p.ws + WS_G2BF), 128, 512, 512, 0, t, tile); }
        }
    }
}

__device__ void phase_normmod(const P& p, int which) {
    const int lane = opaque_tid() & 63, wave = threadIdx.x >> 6;
    const float* gain = which == 0 ? p.n1 : (which == 1 ? p.nmix : p.n2);
    const float* mod = (const float*)(p.ws + WS_MOD);
    bf16_t* A = (bf16_t*)(p.ws + WS_A);
    for (int row = blockIdx.x * 8 + wave; row < MT; row += gridDim.x * 8) {
        const float* src = which == 0 ? xrow(p, row) : p.out + (size_t)row * DM;
        float4 v[4]; float ss = 0.f;
#pragma unroll
        for (int i = 0; i < 4; ++i) { v[i] = *(const float4*)(src + lane * 4 + 256 * i); ss += v[i].x * v[i].x + v[i].y * v[i].y + v[i].z * v[i].z + v[i].w * v[i].w; }
#pragma unroll
        for (int o = 32; o >= 1; o >>= 1) ss += __shfl_xor(ss, o);
        const float rstd = rsqrtf(ss * (1.f / 1024.f) + 1e-6f);
        const float* sh = mod + cond_of(row) * MODW + which * 3072; const float* sc = sh + 1024;
#pragma unroll
        for (int i = 0; i < 4; ++i) { const int col = lane * 4 + 256 * i;
            const float4 g = *(const float4*)(gain + col), s4 = *(const float4*)(sh + col), c4 = *(const float4*)(sc + col);
            const float o0 = v[i].x * rstd * g.x * (1.f + c4.x) + s4.x, o1 = v[i].y * rstd * g.y * (1.f + c4.y) + s4.y,
                        o2 = v[i].z * rstd * g.z * (1.f + c4.z) + s4.z, o3 = v[i].w * rstd * g.w * (1.f + c4.w) + s4.w;
            *(uint2*)(A + (size_t)row * DM + col) = make_uint2(pk2(o0, o1), pk2(o2, o3)); }
    }
}
__device__ void phase_finalnorm(const P& p) {
    const int lane = opaque_tid() & 63, wave = threadIdx.x >> 6;
    for (int row = blockIdx.x * 8 + wave; row < MT; row += gridDim.x * 8) {
        float* src = p.out + (size_t)row * DM;
        float4 v[4]; float ss = 0.f;
#pragma unroll
        for (int i = 0; i < 4; ++i) { v[i] = *(const float4*)(src + lane * 4 + 256 * i); ss += v[i].x * v[i].x + v[i].y * v[i].y + v[i].z * v[i].z + v[i].w * v[i].w; }
#pragma unroll
        for (int o = 32; o >= 1; o >>= 1) ss += __shfl_xor(ss, o);
        const float rstd = rsqrtf(ss * (1.f / 1024.f) + 1e-6f);
#pragma unroll
        for (int i = 0; i < 4; ++i) { const int col = lane * 4 + 256 * i; const float4 g = *(const float4*)(p.nf + col);
            *(float4*)(src + col) = make_float4(v[i].x * rstd * g.x, v[i].y * rstd * g.y, v[i].z * rstd * g.z, v[i].w * rstd * g.w); }
    }
}

struct EpiSwiglu {
    static constexpr bool PERM = true;
    bf16_t* O;
    __device__ __forceinline__ void operator()(const f32x4 (&acc)[2][2][4][2], const pg8::Unit& u, int wr, int wc, int fr, int fq) const {
        const int row0 = u.pm * 256 + wr * 64 + fr, col0 = u.pn * 128 + wc * 32 + 8 * fq;
#pragma unroll
        for (int ai = 0; ai < 2; ++ai)
#pragma unroll
            for (int m = 0; m < 4; ++m) { bf16_t* rowp = O + (size_t)(row0 + ai * 128 + m * 16) * DFF + col0;
                float r[8];
#pragma unroll
                for (int n = 0; n < 2; ++n)
#pragma unroll
                    for (int j = 0; j < 4; ++j) r[n * 4 + j] = siluf(acc[ai][0][m][n][j]) * acc[ai][1][m][n][j];
                pg8::u32x4 w; w.x = pg8::cvt_pk_bf16(r[0], r[1]); w.y = pg8::cvt_pk_bf16(r[2], r[3]); w.z = pg8::cvt_pk_bf16(r[4], r[5]); w.w = pg8::cvt_pk_bf16(r[6], r[7]);
                *(pg8::u32x4*)rowp = w; }
    }
};
struct EpiResid {
    static constexpr bool PERM = false;
    const float* xp; const float* xs; float* out; const float* ga; float coef; int inplace;
    __device__ __forceinline__ void operator()(const f32x4 (&acc)[2][2][4][2], const pg8::Unit& u, int wr, int wc, int fr, int fq) const {
        const int row0 = u.pm * 256 + wr * 64 + fr, col0 = u.pn * 256 + wc * 32 + 4 * fq;
        const float* gap = ga + cond_of(u.pm * 256) * MODW;
        f32x4 gv[2][2];
#pragma unroll
        for (int bj = 0; bj < 2; ++bj)
#pragma unroll
            for (int n = 0; n < 2; ++n) gv[bj][n] = *(const f32x4*)(gap + col0 + bj * 128 + n * 16) * coef;
#pragma unroll
        for (int ai = 0; ai < 2; ++ai)
#pragma unroll
            for (int m = 0; m < 4; ++m) { const int row = row0 + ai * 128 + m * 16;
                const float* base = inplace ? out + (size_t)row * DM : (row < NCTX ? xp + (size_t)row * DM : xs + (size_t)(row - NCTX) * DM);
                float* op = out + (size_t)row * DM;
#pragma unroll
                for (int bj = 0; bj < 2; ++bj)
#pragma unroll
                    for (int n = 0; n < 2; ++n) { const int c = col0 + bj * 128 + n * 16; const f32x4 b4 = *(const f32x4*)(base + c);
                        *(f32x4*)(op + c) = b4 + gv[bj][n] * acc[ai][bj][m][n]; } }
    }
};
struct EpiU {
    static constexpr bool PERM = true;
    bf16_t* U; float* gates;
    __device__ __forceinline__ void operator()(const f32x4 (&acc)[2][2][4][2], const pg8::Unit& u, int wr, int wc, int fr, int fq) const {
        const int row0 = u.pm * 256 + wr * 64 + fr;
#pragma unroll
        for (int bj = 0; bj < 2; ++bj) { const int col0 = u.pn * 256 + bj * 128 + wc * 32 + 8 * fq;
            if (col0 < UW) {
#pragma unroll
                for (int ai = 0; ai < 2; ++ai)
#pragma unroll
                    for (int m = 0; m < 4; ++m) { const int row = row0 + ai * 128 + m * 16; const f32x4 v0 = acc[ai][bj][m][0], v1 = acc[ai][bj][m][1];
                        pg8::u32x4 w; w.x = pg8::cvt_pk_bf16(v0[0], v0[1]); w.y = pg8::cvt_pk_bf16(v0[2], v0[3]); w.z = pg8::cvt_pk_bf16(v1[0], v1[1]); w.w = pg8::cvt_pk_bf16(v1[2], v1[3]);
                        *(pg8::u32x4*)(U + (size_t)row * UW + col0) = w;
                        if (col0 >= 3968) { float* gp = gates + (size_t)row * 16 + (col0 - 3968); *(f32x4*)gp = v0; *(f32x4*)(gp + 4) = v1; } } } }
    }
};

template <class Epi>
__device__ __forceinline__ void run_gemm(unsigned char* lds, const bf16_t* A, const bf16_t* Bt, int N, int K, const Epi& E) {
    pg8::Gemm g{A, Bt, MT, N, K}; pg8::StaticOrder S; S.init(MT, N, (int)gridDim.x, (int)blockIdx.x);
    pg8::gemm_phase<Epi, pg8::StaticOrder, true, true>((PG8_LAS unsigned char*)lds, g, S, E);
}

constexpr int ML_SK = 0, ML_KWT = 17408, ML_VT = ML_KWT + 18432, ML_CB = ML_VT + 20736, ML_F = ML_CB + 21760, ML_CW = ML_F + 2048, ML_END = ML_CW + 4096;
static_assert(ML_END <= LDS_BYTES, "mlstm lds");

__device__ __forceinline__ unsigned short ld_u16_agent(const bf16_t* p) { return __hip_atomic_load(p, __ATOMIC_RELAXED, __HIP_MEMORY_SCOPE_AGENT); }

__device__ __forceinline__ void conv3_row8(const bf16_t* up, bool hasp, bool hasn, const float* cwp, float* x) {
    float t[8];
    unpack8(*(const uint4*)up, t);
#pragma unroll
    for (int i = 0; i < 8; ++i) x[i] = cwp[768 + i] + cwp[256 + i] * t[i];
    if (hasp) { unpack8(*(const uint4*)(up - UW), t);
#pragma unroll
        for (int i = 0; i < 8; ++i) x[i] += cwp[i] * t[i]; }
    if (hasn) { unpack8(*(const uint4*)(up + UW), t);
#pragma unroll
        for (int i = 0; i < 8; ++i) x[i] += cwp[512 + i] * t[i]; }
}

__device__ __forceinline__ void mlstm_task(const P& p, unsigned char* lds, int bg, int h, int dsel) {
    const int wv = __builtin_amdgcn_readfirstlane((int)threadIdx.x >> 6), rw = wv & 3, cw = wv >> 2;
    const bool ctx = bg < 32; const int T = ctx ? 256 : 2048, nc = T / 64; const int row0 = ctx ? bg * 256 : NCTX + (bg - 32) * 2048;
    bf16_t* sK = (bf16_t*)(lds + ML_SK); bf16_t* sKwT = (bf16_t*)(lds + ML_KWT); bf16_t* sVT = (bf16_t*)(lds + ML_VT); bf16_t* sCb = (bf16_t*)(lds + ML_CB); bf16_t* sS = sCb;
    float* sA = (float*)(lds + ML_F); float* sM = sA + 64; float* sBb = sM + 64; float* sDen = sBb + 64; float* sScal = sDen + 64; float* sRed = sScal + 16;
    float* sCW = (float*)(lds + ML_CW);
    const bf16_t* U = (const bf16_t*)(p.ws + WS_U); const float* GATES = (const float*)(p.ws + WS_GATES); bf16_t* HB = (bf16_t*)(p.ws + WS_A); bf16_t* HB2 = (bf16_t*)(p.ws + WS_HB2);
    const int d_lo = dsel < 0 ? 0 : dsel, d_hi = dsel < 0 ? 2 : dsel + 1;
    const int ct_a = cw ? 3 : 0;
    const int ct_b = cw ? 7 : 5;
    const int n_a = cw ? 2 : 3;

    __syncthreads();
    { const int tid = threadIdx.x;
      for (int i = tid; i < 1024; i += NTHR) { const int a = i >> 8, cc = i & 255, gch = (cc >> 7) * 512 + h * 128 + (cc & 127); sCW[i] = a < 3 ? p.cw[a * 1024 + gch] : p.cb[gch]; }
      for (int i = tid; i < 16 * 72; i += NTHR) { const int r = 128 + i / 72; sVT[r * 72 + (i % 72)] = (r == 128) ? (bf16_t)0x3F80 : (bf16_t)0; } }

#pragma unroll 1
    for (int dir = d_lo; dir < d_hi; ++dir) {
        f32x4 Cacc[9]; float m_prev = 0.f;
        { int z0 = 0; asm volatile("" : "+v"(z0)); const int tid = (int)threadIdx.x + z0, fr = tid & 15, fq = (tid >> 4) & 3;
#pragma unroll
          for (int ct = 0; ct < 9; ++ct) Cacc[ct] = (f32x4){0.f, 0.f, 0.f, 0.f};
          if (!ctx) { const int sidx = ((bg - 32) * 2 + dir) * 4 + h; const float* C0 = p.sC + (size_t)sidx * 16384; const float* n0 = p.sn + (size_t)sidx * 128;
#pragma unroll
              for (int j = 0; j < 4; ++j) { const int d = 16 * wv + 4 * fq + j;
#pragma unroll
                  for (int ct = 0; ct < 8; ++ct) Cacc[ct][j] = C0[d * 128 + 16 * ct + fr];
                  Cacc[8][j] = fr == 0 ? n0[d] : 0.f; }
              m_prev = p.sm[sidx]; } }
        const float gbi = p.gb[dir * 4 + h], gbf = p.gb[8 + dir * 4 + h];
        const bool second = dsel < 0 && dir == 1;
#pragma unroll 1
        for (int s = 0; s < nc; ++s) {
            const int c = dir ? nc - 1 - s : s;
            int zz = 0; asm volatile("" : "+v"(zz));
            const int tid = (int)threadIdx.x + zz, lane = tid & 63, fr = tid & 15, fq = (tid >> 4) & 3;
            uint4 kc[2], kp[2], kn[2], vv[2];
#pragma unroll
            for (int g = 0; g < 2; ++g) { const int idx = tid + 512 * g, sl = idx >> 4, d0 = (idx & 15) * 8; const int tl = dir ? 63 - sl : sl, tok = c * 64 + tl;
                const bf16_t* up = U + ((size_t)row0 + tok) * UW + 512 + h * 128 + d0;
                kc[g] = *(const uint4*)up; kp[g] = make_uint4(0u, 0u, 0u, 0u); kn[g] = kp[g];
                if (tok > 0) kp[g] = *(const uint4*)(up - UW);
                if (tok < T - 1) kn[g] = *(const uint4*)(up + UW);
                vv[g] = *(const uint4*)(up + 512); }
            LDS_BARRIER();
            if (wv == 0) {
                const int tl = dir ? 63 - lane : lane; const size_t row = (size_t)row0 + c * 64 + tl;
                const float ip = GATES[row * 16 + dir * 4 + h] + gbi, fp = GATES[row * 16 + 8 + dir * 4 + h] + gbf;
                const float lf = -softplus_fast(-fp);
                float bs = lf;
#pragma unroll
                for (int o = 1; o < 64; o <<= 1) { const float t = __shfl_up(bs, o); if (lane >= o) bs += t; }
                const float a = ip - bs; float pm = a;
#pragma unroll
                for (int o = 1; o < 64; o <<= 1) { const float t = __shfl_up(pm, o); if (lane >= o) pm = fmaxf(pm, t); }
                const float Mt = fmaxf(m_prev, pm);
                sA[lane] = a; sM[lane] = Mt; sBb[lane] = bs;
                if (lane == 63) { sScal[0] = Mt; sScal[1] = bs; }
            }
            LDS_BARRIER();
            const float M63 = sScal[0], bL = sScal[1];
            uint4 qc[4], qp[4], qn[4];
            { const int t_ = 16 * rw + fr, tl = dir ? 63 - t_ : t_, tok = c * 64 + tl; const bf16_t* up = U + ((size_t)row0 + tok) * UW + h * 128 + 8 * fq;
#pragma unroll
              for (int kk = 0; kk < 4; ++kk) { qc[kk] = *(const uint4*)(up + 32 * kk); qp[kk] = make_uint4(0u, 0u, 0u, 0u); qn[kk] = qp[kk];
                  if (tok > 0) qp[kk] = *(const uint4*)(up + 32 * kk - UW);
                  if (tok < T - 1) qn[kk] = *(const uint4*)(up + 32 * kk + UW); } }
#pragma unroll
            for (int g = 0; g < 2; ++g) {
                const int idx = tid + 512 * g, sl = idx >> 4, d0 = (idx & 15) * 8;
                const float wk = fexp(sA[sl] - M63);
                const float* cwp = sCW + 128 + d0;
                float kv[8], t[8];
                unpack8(kc[g], t);
#pragma unroll
                for (int i = 0; i < 8; ++i) kv[i] = cwp[768 + i] + cwp[256 + i] * t[i];
                unpack8(kp[g], t);
#pragma unroll
                for (int i = 0; i < 8; ++i) kv[i] += cwp[i] * t[i];
                unpack8(kn[g], t);
#pragma unroll
                for (int i = 0; i < 8; ++i) kv[i] += cwp[512 + i] * t[i];
#pragma unroll
                for (int i = 0; i < 8; ++i) kv[i] = siluf(kv[i]) * 0.08838834764831845f;
                *(uint4*)(sK + sl * 136 + d0) = make_uint4(pk2(kv[0], kv[1]), pk2(kv[2], kv[3]), pk2(kv[4], kv[5]), pk2(kv[6], kv[7]));
#pragma unroll
                for (int i = 0; i < 8; ++i) sKwT[(d0 + i) * 72 + sl] = f2bf(kv[i] * wk);
                const unsigned vw[4] = {vv[g].x, vv[g].y, vv[g].z, vv[g].w};
#pragma unroll
                for (int i = 0; i < 8; ++i) sVT[(d0 + i) * 72 + sl] = (bf16_t)((vw[i >> 1] >> ((i & 1) * 16)) & 0xffffu);
            }
            bf16x8 qf[4];
#pragma unroll
            for (int kk = 0; kk < 4; ++kk) { const float* cwp = sCW + 32 * kk + 8 * fq; float qv[8], t[8];
                unpack8(qc[kk], t);
#pragma unroll
                for (int i = 0; i < 8; ++i) qv[i] = cwp[768 + i] + cwp[256 + i] * t[i];
                unpack8(qp[kk], t);
#pragma unroll
                for (int i = 0; i < 8; ++i) qv[i] += cwp[i] * t[i];
                unpack8(qn[kk], t);
#pragma unroll
                for (int i = 0; i < 8; ++i) qv[i] += cwp[512 + i] * t[i];
#pragma unroll
                for (int i = 0; i < 8; ++i) qv[i] = siluf(qv[i]);
                union { uint4 u; bf16x8 v; } cv; cv.u = make_uint4(pk2(qv[0], qv[1]), pk2(qv[2], qv[3]), pk2(qv[4], qv[5]), pk2(qv[6], qv[7])); qf[kk] = cv.v; }
            f32x4 num[5];
#pragma unroll
            for (int k = 0; k < 5; ++k) num[k] = (f32x4){0.f, 0.f, 0.f, 0.f};
#pragma unroll
            for (int ci = 0; ci < 5; ++ci) { const f32x4 v = Cacc[ci]; *(uint2*)(sCb + (16 * ci + fr) * 136 + 16 * wv + 4 * fq) = make_uint2(pk2(v[0], v[1]), pk2(v[2], v[3])); }
            LDS_BARRIER();
#pragma unroll
            for (int k = 0; k < 3; ++k) if (k < n_a) {
#pragma unroll
                for (int kk = 0; kk < 4; ++kk) { const bf16x8 b = *(const bf16x8*)(sCb + (16 * (ct_a + k) + fr) * 136 + 32 * kk + 8 * fq); num[k] = mfma16(qf[kk], b, num[k]); } }
            LDS_BARRIER();
#pragma unroll
            for (int ci = 0; ci < 4; ++ci) { const f32x4 v = Cacc[5 + ci]; *(uint2*)(sCb + (16 * ci + fr) * 136 + 16 * wv + 4 * fq) = make_uint2(pk2(v[0], v[1]), pk2(v[2], v[3])); }
            LDS_BARRIER();
#pragma unroll
            for (int k = 3; k < 5; ++k) {
#pragma unroll
                for (int kk = 0; kk < 4; ++kk) { const bf16x8 b = *(const bf16x8*)(sCb + (16 * (ct_b + k - 3 - 5) + fr) * 136 + 32 * kk + 8 * fq); num[k] = mfma16(qf[kk], b, num[k]); } }
            {
                float scv[4];
#pragma unroll
                for (int j = 0; j < 4; ++j) scv[j] = fexp(m_prev - sM[16 * rw + 4 * fq + j]);
#pragma unroll
                for (int k = 0; k < 5; ++k)
#pragma unroll
                    for (int j = 0; j < 4; ++j) num[k][j] *= scv[j];
            }
            LDS_BARRIER();
#pragma unroll
            for (int si = 0; si < 2; ++si) { const int st = 2 * cw + si;
                f32x4 sacc = (f32x4){0.f, 0.f, 0.f, 0.f};
                if (st <= rw) {
#pragma unroll
                    for (int kk = 0; kk < 4; ++kk) { const bf16x8 b = *(const bf16x8*)(sK + (16 * st + fr) * 136 + 32 * kk + 8 * fq); sacc = mfma16(qf[kk], b, sacc); } }
                const int sp = 16 * st + fr; const float as = sA[sp];
#pragma unroll
                for (int j = 0; j < 4; ++j) { const int tp = 16 * rw + 4 * fq + j; const float val = (sp <= tp) ? sacc[j] * fexp(as - sM[tp]) : 0.f; sS[tp * 72 + sp] = f2bf(val); }
            }
            LDS_BARRIER();
#pragma unroll
            for (int ks = 0; ks < 2; ++ks) { const bf16x8 a = *(const bf16x8*)(sS + (16 * rw + fr) * 72 + 32 * ks + 8 * fq);
#pragma unroll
                for (int k = 0; k < 5; ++k) { const int ct = k < 3 ? ct_a + k : ct_b + k - 3;
                    if (k != 2 || cw == 0) { const bf16x8 b = *(const bf16x8*)(sVT + (16 * ct + fr) * 72 + 32 * ks + 8 * fq); num[k] = mfma16(a, b, num[k]); } } }
            if (cw == 1 && fr == 0) {
#pragma unroll
                for (int j = 0; j < 4; ++j) sDen[16 * rw + 4 * fq + j] = num[4][j]; }
            LDS_BARRIER();
            float inv[4];
#pragma unroll
            for (int j = 0; j < 4; ++j) { const int tp = 16 * rw + 4 * fq + j; const float den = sDen[tp]; inv[j] = __builtin_amdgcn_rcpf(fmaxf(fabsf(den), fexp(-(sBb[tp] + sM[tp])))); }
            if (!second) {
#pragma unroll
                for (int j = 0; j < 4; ++j) { const int tp = 16 * rw + 4 * fq + j, tl = dir ? 63 - tp : tp; const size_t row = (size_t)row0 + c * 64 + tl;
                    bf16_t* hb = dsel == 1 ? HB2 + (row - NCTX) * 512 + h * 128 : HB + row * DM + h * 128;
#pragma unroll
                    for (int k = 0; k < 5; ++k) { const int ct = k < 3 ? ct_a + k : ct_b + k - 3; if ((k != 2 || cw == 0) && ct < 8) hb[16 * ct + fr] = f2bf(num[k][j] * inv[j]); } }
            } else {
                float ssr[4];
#pragma unroll
                for (int j = 0; j < 4; ++j) { const int tp = 16 * rw + 4 * fq + j, tl = dir ? 63 - tp : tp; const size_t row = (size_t)row0 + c * 64 + tl;
                    const bf16_t* hb = HB + row * DM + h * 128; float ss = 0.f;
#pragma unroll
                    for (int k = 0; k < 5; ++k) { const int ct = k < 3 ? ct_a + k : ct_b + k - 3;
                        if ((k != 2 || cw == 0) && ct < 8) { const int e = 16 * ct + fr; const float other = bf2f(ld_u16_agent(hb + e)); const float hs = num[k][j] * inv[j] + other;
                            const float o = sigmf(bf2f(U[row * UW + 1536 + h * 128 + e])); const float v = o * hs; ss += v * v; num[k][j] = v; } }
                    ss += __shfl_xor(ss, 1); ss += __shfl_xor(ss, 2); ss += __shfl_xor(ss, 4); ss += __shfl_xor(ss, 8);
                    ssr[j] = ss; if (fr == 0) sRed[cw * 64 + tp] = ss; }
                LDS_BARRIER();
#pragma unroll
                for (int j = 0; j < 4; ++j) { const int tp = 16 * rw + 4 * fq + j, tl = dir ? 63 - tp : tp; const size_t row = (size_t)row0 + c * 64 + tl;
                    bf16_t* hb = HB + row * DM + h * 128; const float rms = rsqrtf((ssr[j] + sRed[(1 - cw) * 64 + tp]) * (1.f / 128.f) + 1e-6f);
#pragma unroll
                    for (int k = 0; k < 5; ++k) { const int ct = k < 3 ? ct_a + k : ct_b + k - 3;
                        if ((k != 2 || cw == 0) && ct < 8) { const int e = 16 * ct + fr; hb[e] = f2bf(num[k][j] * rms * p.hg[h * 128 + e]); } } }
            }
            const float decay = fexp(m_prev - M63);
#pragma unroll
            for (int ct = 0; ct < 9; ++ct) Cacc[ct] = Cacc[ct] * decay;
#pragma unroll
            for (int ks = 0; ks < 2; ++ks) { const bf16x8 a = *(const bf16x8*)(sKwT + (16 * wv + fr) * 72 + 32 * ks + 8 * fq);
#pragma unroll
                for (int ct = 0; ct < 9; ++ct) { const bf16x8 b = *(const bf16x8*)(sVT + (16 * ct + fr) * 72 + 32 * ks + 8 * fq); Cacc[ct] = mfma16(a, b, Cacc[ct]); } }
            m_prev = bL + M63;
        }
        if (ctx) { const int sidx = (bg * 2 + dir) * 4 + h; float* Co = p.out + OUT_C + (size_t)sidx * 16384;
            int z1 = 0; asm volatile("" : "+v"(z1)); const int tid1 = (int)threadIdx.x + z1, fr1 = tid1 & 15, fq1 = (tid1 >> 4) & 3;
#pragma unroll
            for (int j = 0; j < 4; ++j) { const int d = 16 * wv + 4 * fq1 + j;
#pragma unroll
                for (int ct = 0; ct < 8; ++ct) Co[d * 128 + 16 * ct + fr1] = Cacc[ct][j];
                if (fr1 == 0) p.out[OUT_N + sidx * 128 + d] = Cacc[8][j]; }
            if (tid1 == 0) p.out[OUT_MM + sidx] = m_prev; }
        __syncthreads();
    }
}

__device__ __forceinline__ void phase_shift(bf16_t* U, const float* pmu, uint4* sRow) {
#pragma unroll 1
    for (int item = blockIdx.x; item < 1200; item += gridDim.x) {
        const int tid = opaque_tid(), tl = tid >> 3, g = tid & 7;
        const bool grid = item < 240; const int seq = grid ? item / 30 : (item - 240) / 30, sl = grid ? item % 30 : (item - 240) % 30;
        const int T = grid ? 2048 : 256, nst = T / 64; const size_t row0 = grid ? (size_t)NCTX + (size_t)seq * 2048 : (size_t)seq * 256;
        const int rc = sl * 64 + g * 8;
        char* base = (char*)(U + row0 * UW + 2048 + rc);
        const int act = (rc >= 1536 && rc < 1664) ? 1 : (rc >= 1792 ? 2 : 0);
        unsigned z0_ = 0u; asm volatile("" : "+v"(z0_));
        uint4 prv = make_uint4(z0_, z0_, z0_, z0_), cur = *(const uint4*)(base + (size_t)tl * (UW * 2)), nxt;
        __syncthreads();
#pragma unroll 1
        for (int k = 0; k < nst; ++k) {
            unsigned zr = 0u; asm volatile("" : "+v"(zr)); const uint4 z4 = make_uint4(zr, zr, zr, zr);
            nxt = z4; if (k + 1 < nst) nxt = *(const uint4*)(base + (size_t)((k + 1) * 64 + tl) * (UW * 2));
            sRow[(1 + tl) * 8 + g] = cur;
            if (tl == 0) sRow[65 * 8 + g] = nxt;
            LDS_BARRIER();
            uint4 lf = sRow[tl * 8 + g], rt = sRow[(2 + tl) * 8 + g];
            if (tl == 0 && (grid || k == 0)) lf = z4;
            if (tl == 63 && (grid || k == nst - 1)) rt = z4;
            float x[8], t[8], o[8], ms[8], m[8];
            int zz = 0; asm volatile("" : "+v"(zz)); const float* mup = pmu + rc + zz;
#define LD_MU8(a) do { const float4 m0 = *(const float4*)(mup + (a) * 1920), m1 = *(const float4*)(mup + (a) * 1920 + 4); m[0] = m0.x; m[1] = m0.y; m[2] = m0.z; m[3] = m0.w; m[4] = m1.x; m[5] = m1.y; m[6] = m1.z; m[7] = m1.w; } while (0)
            unpack8(cur, x);
            LD_MU8(0); unpack8(lf, t);
#pragma unroll
            for (int i = 0; i < 8; ++i) { o[i] = m[i] * t[i]; ms[i] = m[i]; }
            LD_MU8(1); unpack8(rt, t);
#pragma unroll
            for (int i = 0; i < 8; ++i) { o[i] += m[i] * t[i]; ms[i] += m[i]; }
            if (grid) {
                LD_MU8(2); unpack8(prv, t);
#pragma unroll
                for (int i = 0; i < 8; ++i) { o[i] += m[i] * t[i]; ms[i] += m[i]; }
                LD_MU8(3); unpack8(nxt, t);
#pragma unroll
                for (int i = 0; i < 8; ++i) { o[i] += m[i] * t[i]; ms[i] += m[i]; }
            }
#undef LD_MU8
#pragma unroll
            for (int i = 0; i < 8; ++i) o[i] += x[i] * (1.f - ms[i]);
            if (act == 1) {
#pragma unroll
                for (int i = 0; i < 8; ++i) o[i] = tanh_fast(o[i]); }
            if (act == 2) {
#pragma unroll
                for (int i = 0; i < 8; ++i) o[i] = sigmf(o[i]); }
            *(uint4*)(base + (size_t)(k * 64 + tl) * (UW * 2)) = make_uint4(pk2(o[0], o[1]), pk2(o[2], o[3]), pk2(o[4], o[5]), pk2(o[6], o[7]));
            LDS_BARRIER();
            if (tl == 63) sRow[g] = cur;
            prv = cur; cur = nxt;
        }
    }
}

constexpr int RW_TC = 16;
constexpr int RW_VEC = 0, RW_V = RW_VEC + 16 * 320 * 4, RW_KR = RW_V + 16 * 32 * 4, RW_XW = RW_KR + 16 * 64 * 4, RW_XA = RW_XW + 16 * 72 * 2, RW_Y = RW_XA + 16 * 72 * 2,
              RW_MU = RW_Y + 16 * 32 * 4, RW_DIR = RW_MU + 4 * 288 * 4;
static_assert(2 * RW_DIR <= LDS_BYTES && RW_DIR % 16 == 0, "rwkv lds");

__device__ __forceinline__ float dppf(float x, const int ctrl) { return x; }
#define DPP_ADD(x, ctrl) ((x) + __int_as_float(__builtin_amdgcn_update_dpp(0, __float_as_int(x), (ctrl), 0xf, 0xf, true)))
__device__ __forceinline__ float red8(float x) { x = DPP_ADD(x, 0xB1); x = DPP_ADD(x, 0x4E); x = DPP_ADD(x, 0x141); return x; }
__device__ __forceinline__ float red16(float x) { x = red8(x); x = DPP_ADD(x, 0x140); return x; }

struct Sh8 { uint4 x, l, r, u, d; };
__device__ __forceinline__ void sh8_load(Sh8& q, const bf16_t* U, size_t row0, int tok, int T, bool grid, int c0) {
    const char* Ub = (const char*)(U + row0 * UW);
    const int off = (tok * UW + c0) * 2; const uint4 z = make_uint4(0u, 0u, 0u, 0u);
    const bool hl = grid ? (tok & 63) != 0 : tok > 0, hr = grid ? (tok & 63) != 63 : tok < T - 1;
    q.x = *(const uint4*)(Ub + off);
    q.l = hl ? *(const uint4*)(Ub + (off - UW * 2)) : z; q.r = hr ? *(const uint4*)(Ub + (off + UW * 2)) : z;
    q.u = (grid && tok >= 64) ? *(const uint4*)(Ub + (off - 64 * UW * 2)) : z; q.d = (grid && tok < T - 64) ? *(const uint4*)(Ub + (off + 64 * UW * 2)) : z;
}
__device__ __forceinline__ void sh8_mix(const Sh8& q, bool grid, const float* mu4, int mustride, float* o) {
    float x[8], t[8], m[8], ms[8];
    unpack8(q.x, x);
    { const float4 a = *(const float4*)mu4, b = *(const float4*)(mu4 + 4); m[0] = a.x; m[1] = a.y; m[2] = a.z; m[3] = a.w; m[4] = b.x; m[5] = b.y; m[6] = b.z; m[7] = b.w; }
    unpack8(q.l, t);
#pragma unroll
    for (int i = 0; i < 8; ++i) { o[i] = m[i] * t[i]; ms[i] = m[i]; }
    { const float4 a = *(const float4*)(mu4 + mustride), b = *(const float4*)(mu4 + mustride + 4); m[0] = a.x; m[1] = a.y; m[2] = a.z; m[3] = a.w; m[4] = b.x; m[5] = b.y; m[6] = b.z; m[7] = b.w; }
    unpack8(q.r, t);
#pragma unroll
    for (int i = 0; i < 8; ++i) { o[i] += m[i] * t[i]; ms[i] += m[i]; }
    if (grid) {
        { const float4 a = *(const float4*)(mu4 + 2 * mustride), b = *(const float4*)(mu4 + 2 * mustride + 4); m[0] = a.x; m[1] = a.y; m[2] = a.z; m[3] = a.w; m[4] = b.x; m[5] = b.y; m[6] = b.z; m[7] = b.w; }
        unpack8(q.u, t);
#pragma unroll
        for (int i = 0; i < 8; ++i) { o[i] += m[i] * t[i]; ms[i] += m[i]; }
        { const float4 a = *(const float4*)(mu4 + 3 * mustride), b = *(const float4*)(mu4 + 3 * mustride + 4); m[0] = a.x; m[1] = a.y; m[2] = a.z; m[3] = a.w; m[4] = b.x; m[5] = b.y; m[6] = b.z; m[7] = b.w; }
        unpack8(q.d, t);
#pragma unroll
        for (int i = 0; i < 8; ++i) { o[i] += m[i] * t[i]; ms[i] += m[i]; }
    }
#pragma unroll
    for (int i = 0; i < 8; ++i) o[i] += x[i] * (1.f - ms[i]);
}
__device__ __forceinline__ void shifted8(const bf16_t* U, size_t row0, int tok, int T, bool grid, int c0, const float* mu4, int mustride, float* o) {
    Sh8 q; sh8_load(q, U, row0, tok, T, grid, c0); sh8_mix(q, grid, mu4, mustride, o);
}
typedef float f32x2 __attribute__((ext_vector_type(2)));

__device__ __forceinline__ void rwkv_task(const P& p, unsigned char* lds, int bg, int h, int rh) {
    const int wv = __builtin_amdgcn_readfirstlane((int)threadIdx.x >> 6), dir = wv >> 2, lw = wv & 3;
    const bool ctx = bg < 32; const int T = ctx ? 256 : 2048, nc = T / RW_TC; const size_t row0 = ctx ? (size_t)bg * 256 : (size_t)NCTX + (size_t)(bg - 32) * 2048;
    const bool grid = !ctx;
    unsigned char* L = lds + dir * RW_DIR;
    float* sVec = (float*)(L + RW_VEC); float* sV = (float*)(L + RW_V); float* sKr = (float*)(L + RW_KR); bf16_t* sXw = (bf16_t*)(L + RW_XW); bf16_t* sXa = (bf16_t*)(L + RW_XA);
    float* sY = (float*)(L + RW_Y); float* sMu = (float*)(L + RW_MU);
    const bf16_t* U = (const bf16_t*)(p.ws + WS_U); bf16_t* HB = (bf16_t*)(p.ws + WS_A);
    const int hc = h * 64;
    float st[8]; bf16x8 wfrag[2], afrag[2]; float w0v, a0v, kav;
    {
        const int tid = opaque_tid(), ltid = tid & 255, ri = ltid >> 3, jq = ltid & 7, fr = tid & 15, fq = (tid >> 4) & 3;
        __syncthreads();
        if (ctx) {
#pragma unroll
            for (int q = 0; q < 8; ++q) st[q] = 0.f;
        } else { const float* S0 = p.sS + ((size_t)(((bg - 32) * 2 + dir) * 8 + h)) * 4096 + (32 * rh + ri) * 64 + jq * 8;
#pragma unroll
            for (int q = 0; q < 8; ++q) st[q] = S0[q]; }
        const int jcol = hc + 16 * lw + fr;
#pragma unroll
        for (int ks = 0; ks < 2; ++ks) { float wf[8], af[8];
#pragma unroll
            for (int i = 0; i < 8; ++i) { const int l = 32 * ks + 8 * fq + i; wf[i] = p.w2[(size_t)(dir * 64 + l) * 512 + jcol]; af[i] = p.a2[(size_t)(dir * 64 + l) * 512 + jcol]; }
            union { uint4 u; bf16x8 v; } c1, c2; c1.u = make_uint4(pk2(wf[0], wf[1]), pk2(wf[2], wf[3]), pk2(wf[4], wf[5]), pk2(wf[6], wf[7])); c2.u = make_uint4(pk2(af[0], af[1]), pk2(af[2], af[3]), pk2(af[4], af[5]), pk2(af[6], af[7]));
            wfrag[ks] = c1.v; afrag[ks] = c2.v; }
        w0v = p.w0[dir * 512 + jcol]; a0v = p.a0[dir * 512 + jcol]; kav = p.ka[jcol];
    }
    uint4 q1, q2, q3 = make_uint4(0u, 0u, 0u, 0u);
    const char* Ub = (const char*)(U + row0 * UW);
    { const int tid = opaque_tid(), ltid = tid & 255; const int c = dir ? nc - 1 : 0, tok0 = c * RW_TC; const int tl = (ltid & 127) >> 3, g = ltid & 7;
      q1 = *(const uint4*)(Ub + ((tok0 + tl) * UW + (lw < 2 ? 2048 : 2048 + 512) + hc + 8 * g) * 2);
      q2 = *(const uint4*)(Ub + ((tok0 + tl) * UW + (lw < 2 ? 2048 + 1536 : 2048 + 1664) + dir * 64 + 8 * g) * 2);
      if (lw == 0) q3 = *(const uint4*)(Ub + ((tok0 + (ltid >> 2)) * UW + 2048 + 1024 + hc + 32 * rh + 8 * (ltid & 3)) * 2); }
    f32x2 st2[4];
#pragma unroll
    for (int q = 0; q < 4; ++q) st2[q] = (f32x2){st[2 * q], st[2 * q + 1]};
#pragma unroll 1
    for (int s = 0; s < nc; ++s) {
        const int c = dir ? nc - 1 - s : s; const int tok0 = c * RW_TC;
        const bool second = s >= (nc >> 1);
        const int tid = opaque_tid(), ltid = tid & 255, ri = ltid >> 3, jq = ltid & 7, fr = tid & 15, fq = (tid >> 4) & 3;
        { const int tl = (ltid & 127) >> 3, g = ltid & 7; float o[8];
          if (lw < 2) {
              unpack8(q1, o);
              *(float4*)(sVec + tl * 320 + 8 * g) = make_float4(o[0], o[1], o[2], o[3]); *(float4*)(sVec + tl * 320 + 8 * g + 4) = make_float4(o[4], o[5], o[6], o[7]);
              *(uint4*)(sXw + tl * 72 + 8 * g) = q2;
          } else {
              unpack8(q1, o);
              float kkr[8]; float ss = 0.f;
#pragma unroll
              for (int i = 0; i < 8; ++i) { kkr[i] = o[i] * p.kk[hc + 8 * g + i]; ss += kkr[i] * kkr[i]; }
              ss = red8(ss); const float rn = __builtin_amdgcn_rsqf(fmaxf(ss, 1e-24f));
              *(float4*)(sKr + tl * 64 + 8 * g) = make_float4(o[0], o[1], o[2], o[3]); *(float4*)(sKr + tl * 64 + 8 * g + 4) = make_float4(o[4], o[5], o[6], o[7]);
              *(float4*)(sVec + tl * 320 + 192 + 8 * g) = make_float4(kkr[0] * rn, kkr[1] * rn, kkr[2] * rn, kkr[3] * rn); *(float4*)(sVec + tl * 320 + 192 + 8 * g + 4) = make_float4(kkr[4] * rn, kkr[5] * rn, kkr[6] * rn, kkr[7] * rn);
              *(uint4*)(sXa + tl * 72 + 8 * g) = q2;
          }
          if (lw == 0) {
              const int tl2 = ltid >> 2, g2 = ltid & 3;
              unpack8(q3, o);
              *(float4*)(sV + tl2 * 32 + 8 * g2) = make_float4(o[0], o[1], o[2], o[3]); *(float4*)(sV + tl2 * 32 + 8 * g2 + 4) = make_float4(o[4], o[5], o[6], o[7]);
          } }
        __syncthreads();
        { f32x4 aw = (f32x4){0.f, 0.f, 0.f, 0.f}, aa = (f32x4){0.f, 0.f, 0.f, 0.f};
#pragma unroll
          for (int ks = 0; ks < 2; ++ks) { const bf16x8 xw = *(const bf16x8*)(sXw + fr * 72 + 32 * ks + 8 * fq), xa = *(const bf16x8*)(sXa + fr * 72 + 32 * ks + 8 * fq);
              aw = mfma16(xw, wfrag[ks], aw); aa = mfma16(xa, afrag[ks], aa); }
          const int j = 16 * lw + fr;
#pragma unroll
          for (int jj = 0; jj < 4; ++jj) { const int tl = 4 * fq + jj;
              const float dec = fexp(-fexp(-softplus_fast(-(w0v + aw[jj])) - 0.5f));
              const float a = sigmf(a0v + aa[jj]); const float k = sKr[tl * 64 + j], kn = sVec[tl * 320 + 192 + j];
              float* V = sVec + tl * 320 + j; V[64] = dec; V[128] = k * (1.f + (a - 1.f) * kav); V[256] = kn * a; } }
        const int otl = ltid >> 4, opr = ltid & 15; unsigned* hb = (unsigned*)(HB + (row0 + tok0 + otl) * DM + 512 + hc + 32 * rh + 2 * opr);
        unsigned ov = 0u;
        if (second) ov = __hip_atomic_load(hb, __ATOMIC_RELAXED, __HIP_MEMORY_SCOPE_AGENT);
        if (s + 1 < nc) { const int cn = dir ? nc - 2 - s : s + 1, tokn = cn * RW_TC; const int tl = (ltid & 127) >> 3, g = ltid & 7;
            q1 = *(const uint4*)(Ub + ((tokn + tl) * UW + (lw < 2 ? 2048 : 2048 + 512) + hc + 8 * g) * 2);
            q2 = *(const uint4*)(Ub + ((tokn + tl) * UW + (lw < 2 ? 2048 + 1536 : 2048 + 1664) + dir * 64 + 8 * g) * 2);
            if (lw == 0) q3 = *(const uint4*)(Ub + ((tokn + (ltid >> 2)) * UW + 2048 + 1024 + hc + 32 * rh + 8 * (ltid & 3)) * 2); }
        LDS_BARRIER();
        f32x2 sv_[4];
#pragma unroll
        for (int q = 0; q < 4; ++q) sv_[q] = st2[q];
#pragma unroll 1
        for (int rep = 0; rep < (PROBE_DUP == 102 ? 2 : 1); ++rep) {
        if (PROBE_DUP == 102) {
#pragma unroll
            for (int q = 0; q < 4; ++q) st2[q] = sv_[q]; }
float ys[RW_TC];
#pragma unroll
        for (int step = 0; step < RW_TC; ++step) { const int tl = dir ? RW_TC - 1 - step : step; const float* V = sVec + tl * 320 + jq * 8;
            const float4 ka4 = *(const float4*)(V + 192), kb4 = *(const float4*)(V + 196);
            f32x2 acc = st2[0] * (f32x2){ka4.x, ka4.y}; acc = st2[1] * (f32x2){ka4.z, ka4.w} + acc; acc = st2[2] * (f32x2){kb4.x, kb4.y} + acc; acc = st2[3] * (f32x2){kb4.z, kb4.w} + acc;
            const float sa = -red8(acc.x + acc.y);
            const float vi = sV[tl * 32 + ri];
            const float4 wa = *(const float4*)(V + 64), wb = *(const float4*)(V + 68), ba = *(const float4*)(V + 256), bb = *(const float4*)(V + 260),
                         da = *(const float4*)(V + 128), db = *(const float4*)(V + 132), ra = *(const float4*)(V), rb = *(const float4*)(V + 4);
            const f32x2 sa2 = (f32x2){sa, sa}, vi2 = (f32x2){vi, vi};
            st2[0] = st2[0] * (f32x2){wa.x, wa.y} + (sa2 * (f32x2){ba.x, ba.y} + vi2 * (f32x2){da.x, da.y});
            st2[1] = st2[1] * (f32x2){wa.z, wa.w} + (sa2 * (f32x2){ba.z, ba.w} + vi2 * (f32x2){da.z, da.w});
            st2[2] = st2[2] * (f32x2){wb.x, wb.y} + (sa2 * (f32x2){bb.x, bb.y} + vi2 * (f32x2){db.x, db.y});
            st2[3] = st2[3] * (f32x2){wb.z, wb.w} + (sa2 * (f32x2){bb.z, bb.w} + vi2 * (f32x2){db.z, db.w});
            f32x2 ya = st2[0] * (f32x2){ra.x, ra.y}; ya = st2[1] * (f32x2){ra.z, ra.w} + ya; ya = st2[2] * (f32x2){rb.x, rb.y} + ya; ya = st2[3] * (f32x2){rb.z, rb.w} + ya;
            const float y = red8(ya.x + ya.y);
            ys[step] = y; }
        if (jq == 0) {
#pragma unroll
            for (int step = 0; step < RW_TC; ++step) sY[(dir ? RW_TC - 1 - step : step) * 32 + ri] = ys[step]; }
        }
        LDS_BARRIER();
        { float y0 = sY[otl * 32 + 2 * opr], y1 = sY[otl * 32 + 2 * opr + 1];
          if (second) { y0 += __uint_as_float(ov << 16); y1 += __uint_as_float(ov & 0xffff0000u); }
          *hb = pk2(y0, y1); }
    }
#pragma unroll
    for (int q = 0; q < 4; ++q) { st[2 * q] = st2[q].x; st[2 * q + 1] = st2[q].y; }
    if (ctx) { const int tid = opaque_tid(), ltid = tid & 255, ri = ltid >> 3, jq = ltid & 7;
        float* So = p.out + OUT_S + ((size_t)((bg * 2 + dir) * 8 + h)) * 4096 + (32 * rh + ri) * 64 + jq * 8;
#pragma unroll
        for (int q = 0; q < 8; ++q) So[q] = st[q]; }
    __syncthreads();
}

constexpr int RX_VEC = 0,
              RX_KR = RX_VEC + 16 * 320 * 4,
              RX_XW = RX_KR + 4096, RX_XA = RX_XW + 2304,
              RX_Y = RX_XA + 2304,
              RX_KT = RX_Y + 4096, RX_KTN = RX_KT + 2304, RX_RT = RX_KTN + 2304, RX_RTN = RX_RT + 2304, RX_BN = RX_RTN + 2304, RX_DN = RX_BN + 2304,
              RX_BTS = RX_DN + 2304, RX_DT = RX_BTS + 5120, RX_VT = RX_DT + 5120,
              RX_ADK = RX_VT + 5120, RX_ABR = RX_ADK + 1280, RX_ADR = RX_ABR + 1280, RX_TM = RX_ADR + 1280,
              RX_N = RX_TM + 1280,
              RX_PL = RX_N + 1088,
              RX_DIR = RX_PL + 256;
static_assert(2 * RX_DIR <= LDS_BYTES - 64 && RX_DIR % 16 == 0, "rwkv (chunked) lds");
__device__ __forceinline__ int perm_pi(int j) { const int jj = j & 31; return (j & 32) + 8 * ((jj & 15) >> 2) + (jj & 3) + 4 * (jj >> 4); }
__device__ __forceinline__ int perm_sg(int c) { return 8 * (c >> 2) + (c & 3); }
__device__ __forceinline__ bf16x8 pack_acc_lo(const f32x4 v) { union { uint4 u; bf16x8 b; } c; c.u = make_uint4(pk2(v[0], v[1]), pk2(v[2], v[3]), 0u, 0u); return c.b; }
__device__ __forceinline__ bf16x8 pack_acc2(const f32x4 a, const f32x4 b) { union { uint4 u; bf16x8 v; } c; c.u = make_uint4(pk2(a[0], a[1]), pk2(a[2], a[3]), pk2(b[0], b[1]), pk2(b[2], b[3])); return c.v; }

__device__ __forceinline__ void rwkv_task_w(const P& p, unsigned char* lds, int bg, int h) {
    const int wv = __builtin_amdgcn_readfirstlane((int)threadIdx.x >> 6), dir = wv >> 2, lw = wv & 3;
    const bool ctx = bg < 32; const int T = ctx ? 256 : 2048, nc = T / 16; const size_t row0 = ctx ? (size_t)bg * 256 : (size_t)NCTX + (size_t)(bg - 32) * 2048;
    unsigned char* L = lds + dir * RX_DIR;
    float* sVec = (float*)(L + RX_VEC); float* sKr = (float*)(L + RX_KR); bf16_t* sXw = (bf16_t*)(L + RX_XW); bf16_t* sXa = (bf16_t*)(L + RX_XA); float* sY = (float*)(L + RX_Y);
    bf16_t* sKT = (bf16_t*)(L + RX_KT); bf16_t* sKTn = (bf16_t*)(L + RX_KTN); bf16_t* sRT = (bf16_t*)(L + RX_RT); bf16_t* sRTn = (bf16_t*)(L + RX_RTN); bf16_t* sBn = (bf16_t*)(L + RX_BN); bf16_t* sDn = (bf16_t*)(L + RX_DN);
    bf16_t* sBts = (bf16_t*)(L + RX_BTS); bf16_t* sDt = (bf16_t*)(L + RX_DT); bf16_t* sVT = (bf16_t*)(L + RX_VT);
    bf16_t* sAdk = (bf16_t*)(L + RX_ADK); bf16_t* sAbr = (bf16_t*)(L + RX_ABR); bf16_t* sAdr = (bf16_t*)(L + RX_ADR); bf16_t* sTm = (bf16_t*)(L + RX_TM);
    float* sN = (float*)(L + RX_N); float* sPL = (float*)(L + RX_PL);
    const bf16_t* U = (const bf16_t*)(p.ws + WS_U); bf16_t* HB = (bf16_t*)(p.ws + WS_A);
    const int hc = h * 64;
    f32x4 ST[4]; bf16x8 wfrag[2], afrag[2]; float w0v, a0v, kav, kkc[8];
    {
        const int tid = opaque_tid(), ltid = tid & 255, fr = tid & 15, fq = (tid >> 4) & 3;
        __syncthreads();
        for (int i = ltid; i < (RX_N - RX_BTS) / 4; i += 256) ((unsigned*)(L + RX_BTS))[i] = 0u;
        __syncthreads();
        if (ctx) {
#pragma unroll
            for (int jt = 0; jt < 4; ++jt) ST[jt] = (f32x4){0.f, 0.f, 0.f, 0.f};
        } else { const float* S0 = p.sS + ((size_t)(((bg - 32) * 2 + dir) * 8 + h)) * 4096 + (16 * lw + fr) * 64 + 4 * fq;
#pragma unroll
            for (int jt = 0; jt < 4; ++jt) { const float4 t = *(const float4*)(S0 + 16 * jt); ST[jt] = (f32x4){t.x, t.y, t.z, t.w}; } }
        const int jcol = hc + 16 * lw + fr;
#pragma unroll
        for (int ks = 0; ks < 2; ++ks) { float wf[8], af[8];
#pragma unroll
            for (int i = 0; i < 8; ++i) { const int l = 32 * ks + 8 * fq + i; wf[i] = p.w2[(size_t)(dir * 64 + l) * 512 + jcol]; af[i] = p.a2[(size_t)(dir * 64 + l) * 512 + jcol]; }
            union { uint4 u; bf16x8 v; } c1, c2; c1.u = make_uint4(pk2(wf[0], wf[1]), pk2(wf[2], wf[3]), pk2(wf[4], wf[5]), pk2(wf[6], wf[7])); c2.u = make_uint4(pk2(af[0], af[1]), pk2(af[2], af[3]), pk2(af[4], af[5]), pk2(af[6], af[7]));
            wfrag[ks] = c1.v; afrag[ks] = c2.v; }
        w0v = p.w0[dir * 512 + jcol]; a0v = p.a0[dir * 512 + jcol]; kav = p.ka[jcol];
#pragma unroll
        for (int i = 0; i < 8; ++i) kkc[i] = p.kk[hc + 8 * (ltid & 7) + i];
    }
    uint4 q1, q2, q3, n1a, n2a, n3a, n1b, n2b, n3b;
    const char* Ub = (const char*)(U + row0 * UW);
#define RX_LOAD(d1, d2, d3, sidx) do { const int s_ = (sidx) < nc ? (sidx) : nc - 1; const int c_ = dir ? nc - 1 - s_ : s_; const int tok_ = c_ * 16 + ((ltid_ & 127) >> 3); const int g_ = ltid_ & 7; \
        d1 = *(const uint4*)(Ub + (tok_ * UW + (lw < 2 ? 2048 : 2048 + 512) + hc + 8 * g_) * 2); \
        d2 = *(const uint4*)(Ub + (tok_ * UW + (lw < 2 ? 2048 + 1536 : 2048 + 1664) + dir * 64 + 8 * g_) * 2); \
        d3 = *(const uint4*)(Ub + (tok_ * UW + 2048 + 1024 + hc + 8 * g_) * 2); } while (0)
    { const int ltid_ = opaque_tid() & 255; RX_LOAD(q1, q2, q3, 0); RX_LOAD(n1a, n2a, n3a, 1); RX_LOAD(n1b, n2b, n3b, 2); }
#pragma unroll 1
    for (int s = 0; s < nc; ++s) {
        const int c = dir ? nc - 1 - s : s; const int tok0 = c * 16;
        const bool second = s >= (nc >> 1);
        const int tid = opaque_tid(), ltid = tid & 255, fr = tid & 15, fq = (tid >> 4) & 3;
        { const int tl = (ltid & 127) >> 3, g = ltid & 7, q = dir ? 15 - tl : tl; float o[8];
          if (lw < 2) {
              unpack8(q1, o);
              *(float4*)(sVec + q * 320 + 8 * g) = make_float4(o[0], o[1], o[2], o[3]); *(float4*)(sVec + q * 320 + 8 * g + 4) = make_float4(o[4], o[5], o[6], o[7]);
              *(uint4*)(sXw + q * 72 + 8 * g) = q2;
              const unsigned vw[4] = {q3.x, q3.y, q3.z, q3.w};
#pragma unroll
              for (int i = 0; i < 8; ++i) sVT[(8 * g + i) * 40 + q] = (bf16_t)((vw[i >> 1] >> ((i & 1) * 16)) & 0xffffu);
          } else {
              unpack8(q1, o);
              float kkr[8]; float ss = 0.f;
#pragma unroll
              for (int i = 0; i < 8; ++i) { kkr[i] = o[i] * kkc[i]; ss += kkr[i] * kkr[i]; }
              ss = red8(ss); const float rn = __builtin_amdgcn_rsqf(fmaxf(ss, 1e-24f));
              *(float4*)(sKr + q * 64 + 8 * g) = make_float4(o[0], o[1], o[2], o[3]); *(float4*)(sKr + q * 64 + 8 * g + 4) = make_float4(o[4], o[5], o[6], o[7]);
              *(float4*)(sVec + q * 320 + 192 + 8 * g) = make_float4(kkr[0] * rn, kkr[1] * rn, kkr[2] * rn, kkr[3] * rn); *(float4*)(sVec + q * 320 + 192 + 8 * g + 4) = make_float4(kkr[4] * rn, kkr[5] * rn, kkr[6] * rn, kkr[7] * rn);
              *(uint4*)(sXa + q * 72 + 8 * g) = q2;
          } }
        LDS_BARRIER();
        { f32x4 aw = (f32x4){0.f, 0.f, 0.f, 0.f}, aa = (f32x4){0.f, 0.f, 0.f, 0.f};
#pragma unroll
          for (int ks = 0; ks < 2; ++ks) { const bf16x8 xw = *(const bf16x8*)(sXw + fr * 72 + 32 * ks + 8 * fq), xa = *(const bf16x8*)(sXa + fr * 72 + 32 * ks + 8 * fq);
              aw = mfma16(xw, wfrag[ks], aw); aa = mfma16(xa, afrag[ks], aa); }
          const int j = 16 * lw + fr;
          float lg[4], av[4]; float run = 0.f;
#pragma unroll
          for (int e = 0; e < 4; ++e) { const float lw_ = -fexp(-softplus_fast(-(w0v + aw[e])) - 0.5f); run += lw_; lg[e] = run; av[e] = sigmf(a0v + aa[e]); }
          float x = run; { const float y1 = __shfl_up(x, 16); if (fq >= 1) x += y1; const float y2 = __shfl_up(x, 32); if (fq >= 2) x += y2; }
          const float excl = x - run;
          const int pj = perm_pi(j); bf16_t btv[4], dtv[4];
          float Pp = fexp(excl);
#pragma unroll
          for (int e = 0; e < 4; ++e) { const int q = 4 * fq + e; const float Lq = excl + lg[e];
              const float Pq = fexp(Lq), iP = __builtin_amdgcn_rcpf(Pq);
              const float k = sKr[q * 64 + j], kn = sVec[q * 320 + 192 + j], r = sVec[q * 320 + j];
              const float kd = k * (1.f + (av[e] - 1.f) * kav), b = kn * av[e];
              const bf16_t kt = f2bf(Pp * kn), rt = f2bf(Pq * r), bt = f2bf(b * iP), dt = f2bf(kd * iP);
              sKT[q * 72 + pj] = kt; sRT[q * 72 + pj] = rt; sBn[q * 72 + pj] = bt; sDn[q * 72 + pj] = dt;
              btv[e] = bt; dtv[e] = dt;
              if (q == 15) sPL[j] = Pq;
              Pp = Pq; }
          *(uint2*)(sBts + j * 40 + 8 * fq) = make_uint2((unsigned)btv[0] | ((unsigned)btv[1] << 16), (unsigned)btv[2] | ((unsigned)btv[3] << 16));
          *(uint2*)(sDt + j * 40 + 4 * fq) = make_uint2((unsigned)dtv[0] | ((unsigned)dtv[1] << 16), (unsigned)dtv[2] | ((unsigned)dtv[3] << 16)); }
        if (s == (nc >> 1)) asm volatile("s_waitcnt vmcnt(0)" ::: "memory"); else asm volatile("s_waitcnt vmcnt(6)" ::: "memory");
        LDS_BARRIER();
        { f32x4 gacc = (f32x4){0.f, 0.f, 0.f, 0.f}; const bf16_t* Ap = (lw < 2) ? sKT : sRT; const bf16_t* Bp = (lw & 1) ? sDn : sBn;
#pragma unroll
          for (int ks = 0; ks < 2; ++ks) gacc = mfma16(*(const bf16x8*)(Ap + fr * 72 + 32 * ks + 8 * fq), *(const bf16x8*)(Bp + fr * 72 + 32 * ks + 8 * fq), gacc);
          const int sidx = fr;
          float gm[4];
#pragma unroll
          for (int e = 0; e < 4; ++e) { const int q = 4 * fq + e; const bool keep = (lw < 2) ? (sidx < q) : (sidx <= q); gm[e] = keep ? gacc[e] : 0.f; }
          if (lw == 0) {
              const int r = tid & 15; float Tr[16];
#pragma unroll
              for (int q = 0; q < 16; ++q) Tr[q] = (r == q) ? 1.f : 0.f;
#pragma unroll
              for (int q = 0; q < 15; ++q) { const float tq = Tr[q];
#pragma unroll
                  for (int q2 = q + 1; q2 < 16; ++q2) { const float nv = __int_as_float(__builtin_amdgcn_readlane(__float_as_int(gm[q2 & 3]), q + 16 * (q2 >> 2))); Tr[q2] -= tq * nv; } }
              if ((tid & 63) < 16) { const int ps = perm_sg(r);
#pragma unroll
                  for (int q = 0; q < 16; ++q) sTm[q * 40 + ps] = f2bf(Tr[q]); }
          } else {
#pragma unroll
              for (int e = 0; e < 4; ++e) { const int q = 4 * fq + e;
                  if (lw == 1) sAdk[q * 40 + sidx] = f2bf(gm[e]);
                  else if (lw == 2) sAbr[q * 40 + perm_sg(sidx)] = f2bf(gm[e]);
                  else sAdr[q * 40 + sidx] = f2bf(gm[e]); } } }
        const int oq = ltid >> 4, otl = dir ? 15 - oq : oq; unsigned long long* hb = (unsigned long long*)(HB + (row0 + tok0 + otl) * DM + 512 + hc + 4 * (ltid & 15));
        const unsigned long long ov = __hip_atomic_load(hb, __ATOMIC_RELAXED, __HIP_MEMORY_SCOPE_AGENT);
        q1 = n1a; q2 = n2a; q3 = n3a; n1a = n1b; n2a = n2b; n3a = n3b;
        { const int ltid_ = ltid; RX_LOAD(n1b, n2b, n3b, s + 3); }
        LDS_BARRIER();
        { const bf16x8 Sb0 = pack_acc2(ST[0], ST[1]), Sb1 = pack_acc2(ST[2], ST[3]);
          const bf16x8 vtf = *(const bf16x8*)(sVT + (16 * lw + fr) * 40 + 8 * fq);
          f32x4 XT = (f32x4){0.f, 0.f, 0.f, 0.f};
          XT = mfma16(*(const bf16x8*)(sKT + fr * 72 + 8 * fq), Sb0, XT); XT = mfma16(*(const bf16x8*)(sKT + fr * 72 + 32 + 8 * fq), Sb1, XT);
          XT = mfma16(*(const bf16x8*)(sAdk + fr * 40 + 8 * fq), vtf, XT);
          f32x4 SAT = mfma16(*(const bf16x8*)(sTm + fr * 40 + 8 * fq), pack_acc_lo(XT), (f32x4){0.f, 0.f, 0.f, 0.f});
          SAT = -SAT;
          const bf16x8 SAb = pack_acc_lo(SAT);
          f32x4 YT = (f32x4){0.f, 0.f, 0.f, 0.f};
          YT = mfma16(*(const bf16x8*)(sRT + fr * 72 + 8 * fq), Sb0, YT); YT = mfma16(*(const bf16x8*)(sRT + fr * 72 + 32 + 8 * fq), Sb1, YT);
          YT = mfma16(*(const bf16x8*)(sAbr + fr * 40 + 8 * fq), SAb, YT); YT = mfma16(*(const bf16x8*)(sAdr + fr * 40 + 8 * fq), vtf, YT);
#pragma unroll
          for (int jt = 0; jt < 4; ++jt) { ST[jt] = mfma16(*(const bf16x8*)(sBts + (16 * jt + fr) * 40 + 8 * fq), SAb, ST[jt]); ST[jt] = mfma16(*(const bf16x8*)(sDt + (16 * jt + fr) * 40 + 8 * fq), vtf, ST[jt]);
              const float4 pl = *(const float4*)(sPL + 16 * jt + 4 * fq); ST[jt][0] *= pl.x; ST[jt][1] *= pl.y; ST[jt][2] *= pl.z; ST[jt][3] *= pl.w; }
#pragma unroll
          for (int e = 0; e < 4; ++e) sY[(4 * fq + e) * 64 + 16 * lw + fr] = YT[e]; }
        LDS_BARRIER();
        { const float4 y4 = *(const float4*)(sY + oq * 64 + 4 * (ltid & 15)); float y0 = y4.x, y1 = y4.y, y2 = y4.z, y3 = y4.w;
          if (second) { const unsigned lo = (unsigned)ov, hi = (unsigned)(ov >> 32); y0 += __uint_as_float(lo << 16); y1 += __uint_as_float(lo & 0xffff0000u); y2 += __uint_as_float(hi << 16); y3 += __uint_as_float(hi & 0xffff0000u); }
          *hb = (unsigned long long)pk2(y0, y1) | ((unsigned long long)pk2(y2, y3) << 32); }
    }
#undef RX_LOAD
    if (ctx) { const int tid = opaque_tid(), fr = tid & 15, fq = (tid >> 4) & 3;
        float* So = p.out + OUT_S + ((size_t)((bg * 2 + dir) * 8 + h)) * 4096 + (16 * lw + fr) * 64 + 4 * fq;
#pragma unroll
        for (int jt = 0; jt < 4; ++jt) *(float4*)(So + 16 * jt) = make_float4(ST[jt][0], ST[jt][1], ST[jt][2], ST[jt][3]); }
    __syncthreads();
}

constexpr int FZ_ROW = 1800;
constexpr int FZ_X = 0, FZ_MU = 32 * FZ_ROW * 2, FZ_END = FZ_MU + 4 * 1792 * 4;
static_assert(FZ_END <= LDS_BYTES && FZ_MU % 16 == 0, "finalize lds");

__device__ __forceinline__ void phase_rwkv_finalize(const P& p, unsigned char* lds) {
    bf16_t* sX = (bf16_t*)(lds + FZ_X); float* sMu = (float*)(lds + FZ_MU);
    const bf16_t* U = (const bf16_t*)(p.ws + WS_U); bf16_t* HB = (bf16_t*)(p.ws + WS_A);
    { const bf16_t* HB2 = (const bf16_t*)(p.ws + WS_HB2); const int tid0 = opaque_tid(), lane = tid0 & 63, wave = (int)threadIdx.x >> 6;
#pragma unroll 1
      for (int row = NCTX + blockIdx.x * 8 + wave; row < MT; row += gridDim.x * 8) {
          float hf[8], hb[8], og[8], v[8]; float ss = 0.f;
          unpack8(*(const uint4*)(HB + (size_t)row * DM + lane * 8), hf); unpack8(*(const uint4*)(HB2 + (size_t)(row - NCTX) * 512 + lane * 8), hb); unpack8(*(const uint4*)(U + (size_t)row * UW + 1536 + lane * 8), og);
#pragma unroll
          for (int i = 0; i < 8; ++i) { v[i] = sigmf(og[i]) * (hf[i] + hb[i]); ss += v[i] * v[i]; }
          ss = red16(ss); const float rms = rsqrtf(ss * (1.f / 128.f) + 1e-6f);
          const float4 g0 = *(const float4*)(p.hg + lane * 8), g1 = *(const float4*)(p.hg + lane * 8 + 4);
          *(uint4*)(HB + (size_t)row * DM + lane * 8) = make_uint4(pk2(v[0] * rms * g0.x, v[1] * rms * g0.y), pk2(v[2] * rms * g0.z, v[3] * rms * g0.w), pk2(v[4] * rms * g1.x, v[5] * rms * g1.y), pk2(v[6] * rms * g1.z, v[7] * rms * g1.w)); } }
    const bf16_t* A2 = (const bf16_t*)(p.ws + WS_A2BF); const bf16_t* G2 = (const bf16_t*)(p.ws + WS_G2BF);
    const int wv = __builtin_amdgcn_readfirstlane((int)threadIdx.x >> 6), hc = wv * 64;
#pragma unroll 1
    for (int tile = blockIdx.x; tile < MT / 32; tile += gridDim.x) {
        const int tid = opaque_tid(), fr = tid & 15, fq = (tid >> 4) & 3;
        const int rowt = tile * 32; const bool ctx = rowt < NCTX; const int T = ctx ? 256 : 2048; const size_t row0 = ctx ? (size_t)(rowt & ~255) : (size_t)NCTX + (size_t)((rowt - NCTX) & ~2047);
        const int tokt = rowt - (int)row0;
        __syncthreads();
#pragma unroll 2
        for (int it = 0; it < 14; ++it) { const int item = it * NTHR + tid, tl = item / 224, gi = item % 224;
            const int c0 = gi < 192 ? 2048 + 8 * gi : 2048 + 1664 + 8 * (gi - 192);
            *(uint4*)(sX + tl * FZ_ROW + 8 * gi) = *(const uint4*)(U + (row0 + tokt + tl) * UW + c0); }
        __syncthreads();
#pragma unroll 1
        for (int rt = 0; rt < 2; ++rt) {
            f32x4 af[4], ab[4], gg[4];
#pragma unroll
            for (int ct = 0; ct < 4; ++ct) { af[ct] = (f32x4){0.f, 0.f, 0.f, 0.f}; ab[ct] = af[ct]; gg[ct] = af[ct]; }
            const bf16_t* xr = sX + (16 * rt + fr) * FZ_ROW;
#pragma unroll
            for (int ks = 0; ks < 2; ++ks) { const bf16x8 xf = *(const bf16x8*)(xr + 1536 + 32 * ks + 8 * fq), xb = *(const bf16x8*)(xr + 1600 + 32 * ks + 8 * fq);
#pragma unroll
                for (int ct = 0; ct < 4; ++ct) { const int n = hc + 16 * ct + fr;
                    af[ct] = mfma16(xf, *(const bf16x8*)(A2 + (size_t)n * 64 + 32 * ks + 8 * fq), af[ct]);
                    ab[ct] = mfma16(xb, *(const bf16x8*)(A2 + (size_t)(512 + n) * 64 + 32 * ks + 8 * fq), ab[ct]); } }
#pragma unroll
            for (int ks = 0; ks < 4; ++ks) { const bf16x8 xg = *(const bf16x8*)(xr + 1664 + 32 * ks + 8 * fq);
#pragma unroll
                for (int ct = 0; ct < 4; ++ct) { const int n = hc + 16 * ct + fr; gg[ct] = mfma16(xg, *(const bf16x8*)(G2 + (size_t)n * 128 + 32 * ks + 8 * fq), gg[ct]); } }
#pragma unroll
            for (int jj = 0; jj < 4; ++jj) { const int tl = 16 * rt + 4 * fq + jj; const size_t row = (size_t)rowt + tl; const bf16_t* xt = sX + tl * FZ_ROW;
                bf16_t* hb = HB + row * DM + 512 + hc;
                float y[4], vv[4]; float sy = 0.f, sb = 0.f;
#pragma unroll
                for (int ct = 0; ct < 4; ++ct) { const int ch = hc + 16 * ct + fr;
                    const float am = 0.5f * (sigmf(p.a0[ch] + af[ct][jj]) + sigmf(p.a0[512 + ch] + ab[ct][jj]));
                    const float r = bf2f(xt[ch]), k = bf2f(xt[512 + ch]); vv[ct] = bf2f(xt[1024 + ch]);
                    sb += r * k * (1.f + (am - 1.f) * p.ka[ch]) * p.rk[ch];
                    y[ct] = bf2f(hb[16 * ct + fr]); sy += y[ct]; }
                sy = red16(sy); sb = red16(sb);
                const float mean = sy * (1.f / 64.f); float vs = 0.f;
#pragma unroll
                for (int ct = 0; ct < 4; ++ct) { const float d = y[ct] - mean; vs += d * d; }
                vs = red16(vs); const float rstd = rsqrtf(vs * (1.f / 64.f) + 64e-5f);
#pragma unroll
                for (int ct = 0; ct < 4; ++ct) { const int ch = hc + 16 * ct + fr; const float yn = (y[ct] - mean) * rstd * p.lng[ch] + p.lnb[ch];
                    hb[16 * ct + fr] = f2bf((yn + sb * vv[ct]) * gg[ct][jj]); } }
        }
    }
}

__device__ __forceinline__ void phase_scan(const P& p, unsigned char* lds, int round = 0) {
    unsigned* ctr = (unsigned*)(p.ws + WS_CTR) + round;
    volatile int* sTask = (volatile int*)(lds + LDS_BYTES - 16);
#pragma unroll 1
    for (;;) {
        __syncthreads();
        if (threadIdx.x == 0) *sTask = (int)atomicAdd(ctr, 1u);
        __syncthreads();
        const int t = __builtin_amdgcn_readfirstlane(*sTask);
        if (t >= 512) break;
#pragma unroll 1
        for (int rep = 0; rep < ((PROBE_DUP == 100 && (t < 64 || (t >= 128 && t < 256))) || (PROBE_DUP == 101 && !(t < 64 || (t >= 128 && t < 256))) ? 2 : 1); ++rep) {
        if (t < 64) mlstm_task(p, lds, 32 + (t >> 3), (t >> 1) & 3, t & 1);
        else if (t < 128) { const int q = t - 64; rwkv_task_w(p, lds, 32 + (q >> 3), q & 7); }
        else if (t < 256) { const int q = t - 128; mlstm_task(p, lds, q >> 2, q & 3, -1); }
        else { const int q = t - 256; rwkv_task_w(p, lds, q >> 3, q & 7); }
        }
    }
}

__device__ void phase_convert_w2(const P& p, unsigned char* lds) {
    float* tile = (float*)lds;
    const int t1 = 16 * 88, t2 = 44 * 16;
    const int nb = gridDim.x, lo = nb > 128 ? 128 : 0;
    if ((int)blockIdx.x < lo) return;
    for (int it = blockIdx.x - lo; it < t1 + t2; it += nb - lo) {
        if (it < t1) do_convert(p.w2in, (bf16_t*)(p.ws + WS_W1), 1024, 5632, 5632, 1, it, tile);
        else do_convert(p.w2out, (bf16_t*)(p.ws + WS_W1B), 2816, 1024, 1024, 0, it - t1, tile);
    }
}

#define XB_TMO      128
#define XB_XCNT(j)  (256  + 64 * (j))
#define XB_XSUB(j)  (1280 + 64 * (j))
#define XB_XGEN(j)  (2304 + 64 * (j))
#define XB_TOP      3328
#define XB_TOPGEN   3392
#define XCD_BAR_WORDS 3456
#define XB_SPIN_CAP (1u << 18)
__device__ __forceinline__ unsigned xb_ld(unsigned* p)              { return __hip_atomic_load(p, __ATOMIC_RELAXED, __HIP_MEMORY_SCOPE_AGENT); }
__device__ __forceinline__ unsigned xb_add(unsigned* p, unsigned v) { return __hip_atomic_fetch_add(p, v, __ATOMIC_RELAXED, __HIP_MEMORY_SCOPE_AGENT); }
__device__ __forceinline__ unsigned xb_xcc_id() { return (unsigned)__builtin_amdgcn_s_getreg((3 << 11) | 20) & 0xFu; }
#define XB_SPIN(cond, bar) do { unsigned _sp = 0; while (cond) { __builtin_amdgcn_s_sleep(1); \
    if ((++_sp & 255u) == 0u) { if (xb_ld(&(bar)[XB_TMO])) break; if (_sp > XB_SPIN_CAP) { atomicAdd(&(bar)[XB_TMO], 1u); break; } } } } while (0)
struct XcdBarrier { unsigned* bar; unsigned x; volatile unsigned* st; };
__device__ __forceinline__ XcdBarrier xcd_barrier_post(unsigned* bar, volatile unsigned* st) {
    XcdBarrier b; b.bar = bar; b.x = xb_xcc_id(); b.st = st;
    if (threadIdx.x == 0) (void)xb_add(&bar[XB_XCNT(b.x)], 1u);
    return b;
}
__device__ __forceinline__ void xcd_barrier_complete(unsigned* bar, unsigned x, unsigned& nloc, unsigned& nx) {
    const unsigned G = gridDim.x * gridDim.y * gridDim.z;
    unsigned sum, cnt, mine, sp = 0u;
    for (;;) {
        sum = 0u; cnt = 0u; mine = 0u;
#pragma unroll
        for (unsigned j = 0; j < 16; ++j) { const unsigned c = xb_ld(&bar[XB_XCNT(j)]); sum += c; cnt += (c > 0u) ? 1u : 0u; mine = (j == x) ? c : mine; }
        if (sum == G) break;
        __builtin_amdgcn_s_sleep(1);
        if ((++sp & 255u) == 0u) { if (xb_ld(&bar[XB_TMO])) break; if (sp > XB_SPIN_CAP) { atomicAdd(&bar[XB_TMO], 1u); break; } }
    }
    nloc = mine > 0u ? mine : 1u; nx = cnt > 0u ? cnt : 1u;
}
__device__ __forceinline__ void xcd_barrier(const XcdBarrier& b) {
    asm volatile("s_waitcnt vmcnt(0)" ::: "memory");
    __syncthreads();
    if (threadIdx.x == 0) {
        unsigned* bar = b.bar;
        __builtin_amdgcn_s_waitcnt(0);
        unsigned nloc = b.st[0], nx = b.st[1];
        if (nloc == 0u) { xcd_barrier_complete(bar, b.x, nloc, nx); b.st[0] = nloc; b.st[1] = nx; }
        const unsigned old = xb_add(&bar[XB_XSUB(b.x)], 1u);
        const unsigned gen = old / nloc;
        if (old + 1u == (gen + 1u) * nloc) {
            __builtin_amdgcn_fence(__ATOMIC_RELEASE, "agent");
            asm volatile("s_waitcnt vmcnt(0)" ::: "memory");
            const unsigned og = xb_add(&bar[XB_TOP], 1u);
            const unsigned tg = og / nx;
            if (og + 1u == (tg + 1u) * nx) xb_add(&bar[XB_TOPGEN], 1u);
            else XB_SPIN(xb_ld(&bar[XB_TOPGEN]) == tg, bar);
            __builtin_amdgcn_fence(__ATOMIC_ACQUIRE, "agent");
            xb_add(&bar[XB_XGEN(b.x)], 1u);
            asm volatile("s_waitcnt vmcnt(0)" ::: "memory");
        } else {
            XB_SPIN(xb_ld(&bar[XB_XGEN(b.x)]) == gen, bar);
            __builtin_amdgcn_fence(__ATOMIC_ACQUIRE, "agent");
            asm volatile("s_waitcnt vmcnt(0)" ::: "memory");
        }
    }
    __syncthreads();
}

constexpr int NPHASE = 12;
template <int PH>
__device__ __forceinline__ void run_phase(const P& p, unsigned char* lds) {
    const float* mod = (const float*)(p.ws + WS_MOD);
    if constexpr (PH == 0) phase0(p, lds);
    if constexpr (PH == 1) phase_normmod(p, 0);
    if constexpr (PH == 2) { EpiSwiglu E{(bf16_t*)(p.ws + WS_U)}; run_gemm(lds, (const bf16_t*)(p.ws + WS_A), (const bf16_t*)(p.ws + WS_W1), 5632, 1024, E); }
    if constexpr (PH == 3) { EpiResid E{p.xp, p.xs, p.out, mod + 2048, 0.5f, 0}; run_gemm(lds, (const bf16_t*)(p.ws + WS_U), (const bf16_t*)(p.ws + WS_W1B), 1024, 2816, E); }
    if constexpr (PH == 4) phase_normmod(p, 1);
    if constexpr (PH == 5) { EpiU E{(bf16_t*)(p.ws + WS_U), (float*)(p.ws + WS_GATES)}; run_gemm(lds, (const bf16_t*)(p.ws + WS_A), (const bf16_t*)(p.ws + WS_BT3), 4096, 1024, E); }
    if constexpr (PH == 6) phase_scan(p, lds);
    if constexpr (PH == 12) phase_rwkv_finalize(p, lds);
    if constexpr (PH == 13) phase_shift((bf16_t*)(p.ws + WS_U), p.mu, (uint4*)lds);
    if constexpr (PH == 7) { EpiResid E{p.xp, p.xs, p.out, mod + 5120, 1.0f, 1}; run_gemm(lds, (const bf16_t*)(p.ws + WS_A), (const bf16_t*)(p.ws + WS_BT4), 1024, 1024, E); phase_convert_w2(p, lds); }
    if constexpr (PH == 8) phase_normmod(p, 2);
    if constexpr (PH == 9) { EpiSwiglu E{(bf16_t*)(p.ws + WS_U)}; run_gemm(lds, (const bf16_t*)(p.ws + WS_A), (const bf16_t*)(p.ws + WS_W1), 5632, 1024, E); }
    if constexpr (PH == 10) { EpiResid E{p.xp, p.xs, p.out, mod + 8192, 0.5f, 1}; run_gemm(lds, (const bf16_t*)(p.ws + WS_U), (const bf16_t*)(p.ws + WS_W1B), 1024, 2816, E); }
    if constexpr (PH == 11) phase_finalnorm(p);
}

#if !ONE_LAUNCH
template <int PH>
__global__ void __launch_bounds__(NTHR, 2) k_phase(P p) {
    extern __shared__ __attribute__((aligned(16))) unsigned char lds[];
    run_phase<PH>(p, lds);
}
#endif

#if ONE_LAUNCH
__global__ void __launch_bounds__(NTHR, 2) k_mega(P p) {
    extern __shared__ __attribute__((aligned(16))) unsigned char lds[];
    cg::grid_group grid = cg::this_grid();
    volatile unsigned* xst = (volatile unsigned*)(lds + LDS_BYTES - 32);
    if (threadIdx.x == 0) { xst[0] = 0u; xst[1] = 0u; }
    __syncthreads();
    const XcdBarrier xbar = xcd_barrier_post((unsigned*)(p.ws + WS_BAR), xst);
#define GSYNC() xcd_barrier(xbar)
    if (p.ws == nullptr) grid.sync();
    run_phase<0>(p, lds); GSYNC();
    if (PROBE_DUP == 0) { run_phase<0>(p, lds); GSYNC(); }
    run_phase<1>(p, lds); GSYNC();
    if (PROBE_DUP == 1) { run_phase<1>(p, lds); GSYNC(); }
    run_phase<2>(p, lds); GSYNC();
    if (PROBE_DUP == 2 || PROBE_DUP == 235) { run_phase<2>(p, lds); GSYNC(); }
    run_phase<3>(p, lds); GSYNC();
    if (PROBE_DUP == 3 || PROBE_DUP == 235) { run_phase<3>(p, lds); GSYNC(); }
    run_phase<4>(p, lds); GSYNC();
    if (PROBE_DUP == 4) { run_phase<4>(p, lds); GSYNC(); }
    run_phase<5>(p, lds); GSYNC();
    if (PROBE_DUP == 5 || PROBE_DUP == 235) { run_phase<5>(p, lds); GSYNC(); }
    run_phase<13>(p, lds); GSYNC();
    run_phase<6>(p, lds); GSYNC();
    if (PROBE_DUP == 6) { phase_scan(p, lds, 1); GSYNC(); }
    run_phase<12>(p, lds); GSYNC();
    run_phase<7>(p, lds); GSYNC();
    if (PROBE_DUP == 7) { run_phase<7>(p, lds); GSYNC(); }
    run_phase<8>(p, lds); GSYNC();
    if (PROBE_DUP == 8) { run_phase<8>(p, lds); GSYNC(); }
    run_phase<9>(p, lds); GSYNC();
    if (PROBE_DUP == 9) { run_phase<9>(p, lds); GSYNC(); }
    run_phase<10>(p, lds); GSYNC();
    if (PROBE_DUP == 10) { run_phase<10>(p, lds); GSYNC(); }
    run_phase<11>(p, lds);
    if (PROBE_DUP == 200) { for (int i = 0; i < 20; ++i) GSYNC(); }
}
#endif

#if !ONE_LAUNCH
template <int PH> static void launch_phase(const P& p, int grid, hipStream_t stream) {
    static bool attr = false;
    if (!attr) { (void)hipFuncSetAttribute((const void*)k_phase<PH>, hipFuncAttributeMaxDynamicSharedMemorySize, LDS_BYTES); attr = true; }
    hipLaunchKernelGGL(k_phase<PH>, dim3(grid), dim3(NTHR), LDS_BYTES, stream, p);
}
#endif

extern "C" void kernel_launch(void* const* d_in, const int* in_sizes, int n_in, void* d_out, int out_size, void* d_ws, size_t ws_size, hipStream_t stream) {
    (void)in_sizes; (void)n_in; (void)out_size; (void)ws_size;
    static int grid = 0;
    if (grid == 0) {
        int dev = 0, cus = 0;
        if (hipGetDevice(&dev) != hipSuccess || hipDeviceGetAttribute(&cus, hipDeviceAttributeMultiprocessorCount, dev) != hipSuccess || cus <= 0) cus = 256;
#if ONE_LAUNCH
        (void)hipFuncSetAttribute((const void*)k_mega, hipFuncAttributeMaxDynamicSharedMemorySize, LDS_BYTES);
        int per_cu = 0;
        if (hipOccupancyMaxActiveBlocksPerMultiprocessor(&per_cu, (const void*)k_mega, NTHR, LDS_BYTES) != hipSuccess || per_cu < 1) per_cu = 1;
        (void)hipGetLastError();
#endif
        grid = cus;
    }
    P p{};
    const float** f = (const float**)&p;
    for (int i = 0; i < 35; ++i) f[i] = (const float*)d_in[i];
    p.out = (float*)d_out; p.ws = (unsigned char*)d_ws;
    (void)hipMemsetAsync((char*)d_ws + WS_MOD, 0, NCOND * MODW * sizeof(float) + 256 + 3456 * 4, stream);
#if ONE_LAUNCH
    void* args[] = {&p};
    hipError_t e = hipLaunchCooperativeKernel((const void*)k_mega, dim3(grid), dim3(NTHR), args, LDS_BYTES, stream);
    if (e != hipSuccess) fprintf(stderr, "cooperative launch failed: %s (grid %d)\n", hipGetErrorString(e), grid);
#else
    launch_phase<0>(p, grid, stream); launch_phase<1>(p, grid, stream); launch_phase<2>(p, grid, stream); launch_phase<3>(p, grid, stream);
    launch_phase<4>(p, grid, stream); launch_phase<5>(p, grid, stream); launch_phase<13>(p, grid, stream); launch_phase<6>(p, grid, stream); launch_phase<12>(p, grid, stream); launch_phase<7>(p, grid, stream);
    launch_phase<8>(p, grid, stream); launch_phase<9>(p, grid, stream); launch_phase<10>(p, grid, stream); launch_phase<11>(p, grid, stream);
#endif
}
```

```cpp
#include <hip/hip_runtime.h>
#include <hip/hip_cooperative_groups.h>
#include <cstdio>
#include <cstdint>
namespace cg = cooperative_groups;

#ifndef PROBE_DUP
#define PROBE_DUP -1
#endif
#ifndef ONE_LAUNCH
#define ONE_LAUNCH 1
#endif

#define LDS_BARRIER() do { asm volatile("s_waitcnt lgkmcnt(0)" ::: "memory"); __builtin_amdgcn_s_barrier(); asm volatile("" ::: "memory"); } while (0)
__device__ __forceinline__ int opaque_tid() { int z = 0; asm volatile("" : "+v"(z)); return (int)threadIdx.x + z; }

namespace pg8 {
#define PG8_LAS __attribute__((address_space(3)))
typedef unsigned short bf16_t;
typedef short bf16x8 __attribute__((ext_vector_type(8)));
typedef float f32x4 __attribute__((ext_vector_type(4)));
typedef unsigned u32x4 __attribute__((ext_vector_type(4)));
constexpr int BM = 256, BK = 64, HALF = 128, HTB = HALF * BK * 2, STAGE_BYTES = 8 * HTB, NXCD = 8, WGM = 8;

__host__ __device__ __forceinline__ int lds_byte(int r, int c) { const int st = (r >> 4) * 2 + (c >> 5), rr = r & 15, cc = c & 31, ob = rr * 64 + cc * 2; return st * 1024 + (ob ^ (((ob >> 9) & 1) << 5)); }
__host__ __device__ __forceinline__ void stage_rc(int b, int& R, int& C) { const int st = b / 1024, sb = b % 1024, swz = sb ^ (((sb >> 9) & 1) << 5); R = (st >> 1) * 16 + swz / 64; C = (st & 1) * 32 + (swz % 64) / 2; }
__host__ __device__ __forceinline__ int perm32(int rho) { const int n = rho >> 4, i = rho & 15; return 8 * (i >> 2) + 4 * n + (i & 3); }

struct Unit { int pm, pn; };
struct Gemm { const bf16_t* A; const bf16_t* Bt; int M, N, K; };

struct StaticOrder {
    int nM, nN, nwg, G, c;
    __host__ __device__ void init(int M, int N, int G_, int c_) { nM = M / BM; nN = N / BM; nwg = nM * nN; G = G_; c = c_; }
    __host__ __device__ bool next(int i, Unit& u) const {
        const long L = (long)i * G + c; if (L >= nwg) return false;
        int wgid = (int)L; { const int q = nwg / NXCD, r = nwg % NXCD, xcd = wgid % NXCD, off = wgid / NXCD; wgid = (xcd < r ? xcd * (q + 1) : r * (q + 1) + (xcd - r) * q) + off; }
        const int nig = WGM * nN, gid = wgid / nig, fm = gid * WGM, gsz = (nM - fm) < WGM ? (nM - fm) : WGM;
        u.pm = fm + ((wgid % nig) % gsz); u.pn = (wgid % nig) / gsz; return true;
    }
    __device__ __forceinline__ void a_ready(const Unit&) const {}
    __device__ __forceinline__ void done(const Unit&) const {}
};

__device__ __forceinline__ unsigned cvt_pk_bf16(float lo, float hi) { unsigned r; asm volatile("v_cvt_pk_bf16_f32 %0, %1, %2" : "=v"(r) : "v"(lo), "v"(hi)); return r; }

template <class Epi, class Sched, bool ALIGN_EPI = false, bool SP2 = false>
__device__ __forceinline__ void gemm_phase(PG8_LAS unsigned char* lds, const Gemm g, const Sched& S, const Epi& E) {
    const int tid = opaque_tid(), wid = __builtin_amdgcn_readfirstlane((int)threadIdx.x >> 6), lane = tid & 63, wr = wid >> 2, wc = wid & 3, fr = lane & 15, fq = lane >> 4;
    const int K = g.K, nt = K / BK;
    unsigned voffA[2], voffB[2];
#pragma unroll
    for (int i = 0; i < 2; ++i) { int R, C; stage_rc(tid * 16 + i * 8192, R, C); const int Rb = Epi::PERM ? ((R & ~31) + perm32(R & 31)) : R;
        voffA[i] = (unsigned)(R * K + C) * 2u; voffB[i] = (unsigned)(Rb * K + C) * 2u; }
    const size_t kstep = (size_t)(BK * 2);
    const size_t hstep = (size_t)HALF * K * 2;
    const size_t tstep = 2 * hstep;
    const unsigned ldsw = (unsigned)wid * 1024u;
    const int aoff = lds_byte(wr * 64 + fr, fq * 8), boff = lds_byte(wc * 32 + fr, fq * 8);
#define PG8_SA(b, h) (((b) * 2 + (h)) * HTB)
#define PG8_SB(b, h) ((4 + (b) * 2 + (h)) * HTB)
#define PG8_STAGE(bufoff, gbase, voff) do { _Pragma("unroll") for (int _i = 0; _i < 2; ++_i) \
        __builtin_amdgcn_global_load_lds((const unsigned*)((const char*)(gbase) + (voff)[_i]), (PG8_LAS unsigned*)(lds + (bufoff) + ldsw + _i * 8192), 16, 0, 0); } while (0)
#define PG8_LDA(dst, b, h) do { _Pragma("unroll") for (int m = 0; m < 4; ++m) _Pragma("unroll") for (int k = 0; k < 2; ++k) dst[m][k] = *(const PG8_LAS bf16x8*)(lds + PG8_SA(b, h) + aoff + m * 2048 + k * 1024); } while (0)
#define PG8_LDB(dst, b, h) do { _Pragma("unroll") for (int n = 0; n < 2; ++n) _Pragma("unroll") for (int k = 0; k < 2; ++k) dst[n][k] = *(const PG8_LAS bf16x8*)(lds + PG8_SB(b, h) + boff + n * 2048 + k * 1024); } while (0)
#define PG8_MMA(ai, bj, At, Bt) do { __builtin_amdgcn_s_setprio(1); _Pragma("unroll") for (int m = 0; m < 4; ++m) _Pragma("unroll") for (int n = 0; n < 2; ++n) _Pragma("unroll") for (int k = 0; k < 2; ++k) \
        acc[ai][bj][m][n] = __builtin_amdgcn_mfma_f32_16x16x32_bf16(Bt[n][k], At[m][k], acc[ai][bj][m][n], 0, 0, 0); __builtin_amdgcn_s_setprio(0); } while (0)
#define PG8_WAIT_V(n) asm volatile("s_waitcnt vmcnt(" #n ")" ::: "memory")
#define PG8_WAIT_L(n) asm volatile("s_waitcnt lgkmcnt(" #n ")" ::: "memory")
#define PG8_BAR __builtin_amdgcn_s_barrier()
#define PG8_SCHED __builtin_amdgcn_sched_barrier(0)
    Unit cur, nxt; int ui = 0;
    if (!S.next(0, cur)) return;
    f32x4 acc[2][2][4][2];
#pragma unroll
    for (int a = 0; a < 2; ++a)
#pragma unroll
        for (int b = 0; b < 2; ++b)
#pragma unroll
            for (int m = 0; m < 4; ++m)
#pragma unroll
                for (int n = 0; n < 2; ++n) acc[a][b][m][n] = (f32x4){0.f, 0.f, 0.f, 0.f};
    bf16x8 At[4][2], B0[2][2], B1[2][2];
    const char* cA = (const char*)g.A + (size_t)cur.pm * tstep; const char* cB = (const char*)g.Bt + (size_t)cur.pn * tstep;
    S.a_ready(cur);
    if constexpr (SP2) {
        PG8_STAGE(PG8_SB(0, 0), cB, voffB); PG8_STAGE(PG8_SB(0, 1), cB + hstep, voffB); PG8_STAGE(PG8_SA(0, 0), cA, voffA); PG8_STAGE(PG8_SA(0, 1), cA + hstep, voffA);
        if (wr == 1) PG8_BAR;
        PG8_WAIT_V(2); PG8_BAR;
        PG8_STAGE(PG8_SB(1, 0), cB + kstep, voffB); PG8_STAGE(PG8_SA(1, 0), cA + kstep, voffA); PG8_STAGE(PG8_SB(1, 1), cB + hstep + kstep, voffB);
        PG8_WAIT_V(6); PG8_BAR;
    } else {
        PG8_STAGE(PG8_SB(0, 0), cB, voffB); PG8_STAGE(PG8_SA(0, 0), cA, voffA); PG8_STAGE(PG8_SB(0, 1), cB + hstep, voffB); PG8_STAGE(PG8_SA(0, 1), cA + hstep, voffA);
        if (wr == 1) PG8_BAR;
        PG8_WAIT_V(4); PG8_BAR;
        PG8_STAGE(PG8_SB(1, 0), cB + kstep, voffB); PG8_STAGE(PG8_SA(1, 0), cA + kstep, voffA); PG8_STAGE(PG8_SB(1, 1), cB + hstep + kstep, voffB);
        PG8_WAIT_V(6); PG8_BAR;
    }
    for (;;) {
        const bool has_next = S.next(ui + 1, nxt);
        const char* nA = has_next ? (const char*)g.A + (size_t)nxt.pm * tstep : cA; const char* nB = has_next ? (const char*)g.Bt + (size_t)nxt.pn * tstep : cB;
        for (int t = 0; t < nt; t += 2) {
            const bool last = (t == nt - 2);
            const char* a1 = cA + (size_t)(t + 1) * kstep;
            const char* a2 = last ? nA : cA + (size_t)(t + 2) * kstep; const char* b2 = last ? nB : cB + (size_t)(t + 2) * kstep;
            const char* a3 = a2 + kstep; const char* b3 = b2 + kstep;
            if (last && has_next) S.a_ready(nxt);
            if constexpr (SP2) {
            PG8_LDB(B0, 0, 0); PG8_LDB(B1, 0, 1); PG8_SCHED; PG8_LDA(At, 0, 0); PG8_STAGE(PG8_SA(1, 1), a1 + hstep, voffA);
            PG8_WAIT_V(8); PG8_WAIT_L(0); PG8_BAR; PG8_MMA(0, 0, At, B0); PG8_MMA(0, 1, At, B1); PG8_BAR; PG8_SCHED;
            PG8_LDA(At, 0, 1); PG8_STAGE(PG8_SB(0, 0), b2, voffB); PG8_STAGE(PG8_SB(0, 1), b2 + hstep, voffB); PG8_STAGE(PG8_SA(0, 0), a2, voffA);
            PG8_WAIT_V(8); PG8_WAIT_L(0); PG8_BAR; PG8_MMA(1, 0, At, B0); PG8_MMA(1, 1, At, B1); PG8_BAR; PG8_SCHED;
            PG8_LDB(B0, 1, 0); PG8_LDB(B1, 1, 1); PG8_SCHED; PG8_LDA(At, 1, 0); PG8_STAGE(PG8_SA(0, 1), a2 + hstep, voffA);
            PG8_WAIT_V(8); PG8_WAIT_L(0); PG8_BAR; PG8_MMA(0, 0, At, B0); PG8_MMA(0, 1, At, B1); PG8_BAR; PG8_SCHED;
            PG8_LDA(At, 1, 1); PG8_STAGE(PG8_SB(1, 0), b3, voffB); PG8_STAGE(PG8_SB(1, 1), b3 + hstep, voffB); PG8_STAGE(PG8_SA(1, 0), a3, voffA);
            PG8_WAIT_V(8); PG8_WAIT_L(0); PG8_BAR; PG8_MMA(1, 0, At, B0); PG8_MMA(1, 1, At, B1); PG8_BAR; PG8_SCHED;
            } else {
            PG8_LDB(B0, 0, 0); PG8_SCHED; PG8_LDA(At, 0, 0); PG8_STAGE(PG8_SA(1, 1), a1 + hstep, voffA);
            PG8_WAIT_L(8); PG8_BAR; PG8_WAIT_L(0); PG8_MMA(0, 0, At, B0); PG8_BAR; PG8_SCHED;
            PG8_LDB(B1, 0, 1); PG8_STAGE(PG8_SB(0, 0), b2, voffB);
            PG8_BAR; PG8_WAIT_L(0); PG8_MMA(0, 1, At, B1); PG8_BAR;
            PG8_LDA(At, 0, 1); PG8_STAGE(PG8_SA(0, 0), a2, voffA);
            PG8_BAR; PG8_WAIT_L(0); PG8_MMA(1, 0, At, B0); PG8_BAR; PG8_SCHED;
            PG8_STAGE(PG8_SB(0, 1), b2 + hstep, voffB);
            PG8_WAIT_V(6); PG8_BAR; PG8_MMA(1, 1, At, B1); PG8_BAR;
            PG8_LDB(B0, 1, 0); PG8_SCHED; PG8_LDA(At, 1, 0); PG8_STAGE(PG8_SA(0, 1), a2 + hstep, voffA);
            PG8_WAIT_L(8); PG8_BAR; PG8_WAIT_L(0); PG8_MMA(0, 0, At, B0); PG8_BAR; PG8_SCHED;
            PG8_LDB(B1, 1, 1); PG8_STAGE(PG8_SB(1, 0), b3, voffB);
            PG8_BAR; PG8_WAIT_L(0); PG8_MMA(0, 1, At, B1); PG8_BAR;
            PG8_LDA(At, 1, 1); PG8_STAGE(PG8_SA(1, 0), a3, voffA);
            PG8_BAR; PG8_WAIT_L(0); PG8_MMA(1, 0, At, B0); PG8_BAR; PG8_SCHED;
            PG8_STAGE(PG8_SB(1, 1), b3 + hstep, voffB);
            PG8_WAIT_V(6); PG8_BAR; PG8_MMA(1, 1, At, B1); PG8_BAR;
            }
        }
        if constexpr (ALIGN_EPI) { if (wr == 0) PG8_BAR; }
        E(acc, cur, wr, wc, fr, fq); S.done(cur);
        if (!has_next) break;
#pragma unroll
        for (int a = 0; a < 2; ++a)
#pragma unroll
            for (int b = 0; b < 2; ++b)
#pragma unroll
                for (int m = 0; m < 4; ++m)
#pragma unroll
                    for (int n = 0; n < 2; ++n) acc[a][b][m][n] = (f32x4){0.f, 0.f, 0.f, 0.f};
        cur = nxt; cA = nA; cB = nB; ++ui;
        if constexpr (ALIGN_EPI) { if (wr == 1) PG8_BAR; }
    }
    PG8_WAIT_V(0);
    if constexpr (!ALIGN_EPI) { if (wr == 0) PG8_BAR; }
    PG8_BAR;
#undef PG8_SA
#undef PG8_SB
#undef PG8_STAGE
#undef PG8_LDA
#undef PG8_LDB
#undef PG8_MMA
#undef PG8_WAIT_V
#undef PG8_WAIT_L
#undef PG8_BAR
#undef PG8_SCHED
}
}

using pg8::bf16_t; using pg8::bf16x8; using pg8::f32x4;

constexpr int MT = 24576, DM = 1024, DFF = 2816, NCTX = 8192;
constexpr int UW = 3984;
constexpr int NCOND = 9, MODW = 9216;
constexpr size_t MiB = 1ull << 20;
constexpr size_t WS_A = 0, WS_U = 48 * MiB, WS_W1 = WS_U + 132 * MiB, WS_W1B = WS_W1 + (size_t)5632 * 1024 * 2,
                 WS_BT3 = 235 * MiB, WS_HB2 = 235 * MiB  ,
                 WS_BT4 = 251 * MiB, WS_MOD = 253 * MiB, WS_CTR = WS_MOD + 9 * 9216 * 4  , WS_BAR = WS_CTR + 256  , WS_GATES = 254 * MiB;
constexpr size_t WS_A2BF = 255 * MiB + 512 * 1024, WS_G2BF = WS_A2BF + 2 * 512 * 64 * 2;
constexpr int OUT_C = 25165824, OUT_N = 29360128, OUT_MM = 29392896, OUT_S = 29393152;
constexpr int LDS_BYTES = 163840;
constexpr int NTHR = 512;

struct P {
    const float *xp, *xs, *c, *sC, *sn, *sm, *sS, *cctx, *ada_w, *ada_b, *n1, *w1in, *w1out, *nmix, *wmin, *wmout,
        *cw, *cb, *gb, *hg, *mu, *w0, *w2, *a0, *a2, *g2, *kk, *ka, *rk, *lng, *lnb, *n2, *w2in, *w2out, *nf;
    float* out; unsigned char* ws;
};

typedef __bf16 hwbf16x2 __attribute__((ext_vector_type(2)));
typedef float hwf32x2 __attribute__((ext_vector_type(2)));
__device__ __forceinline__ unsigned pk2(float a, float b) { const hwf32x2 v = {a, b}; const hwbf16x2 r = __builtin_convertvector(v, hwbf16x2); return __builtin_bit_cast(unsigned, r); }
__device__ __forceinline__ unsigned short f2bf(float f) { return (unsigned short)(pk2(f, f) & 0xffffu); }
__device__ __forceinline__ float bf2f(unsigned short b) { return __uint_as_float(((unsigned)b) << 16); }
__device__ __forceinline__ int cond_of(int row) { return row < NCTX ? 0 : 1 + ((row - NCTX) >> 11); }
__device__ __forceinline__ float fexp(float x) { return __builtin_amdgcn_exp2f(x * 1.4426950408889634f); }
__device__ __forceinline__ float flog(float x) { return __builtin_amdgcn_logf(x) * 0.6931471805599453f; }
__device__ __forceinline__ float siluf(float x) { return x * __builtin_amdgcn_rcpf(1.f + fexp(-x)); }
__device__ __forceinline__ float sigmf(float x) { return __builtin_amdgcn_rcpf(1.f + fexp(-x)); }
__device__ __forceinline__ float tanh_fast(float x) { return 1.f - 2.f * __builtin_amdgcn_rcpf(1.f + fexp(2.f * x)); }
__device__ __forceinline__ float softplus_fast(float z) { return fmaxf(z, 0.f) + flog(1.f + fexp(-fabsf(z))); }
__device__ __forceinline__ const float* xrow(const P& p, int row) { return row < NCTX ? p.xp + (size_t)row * DM : p.xs + (size_t)(row - NCTX) * DM; }
__device__ __forceinline__ f32x4 mfma16(bf16x8 a, bf16x8 b, f32x4 c) { return __builtin_amdgcn_mfma_f32_16x16x32_bf16(a, b, c, 0, 0, 0); }
__device__ __forceinline__ void unpack8(uint4 v, float* f) {
    f[0] = __uint_as_float(v.x << 16); f[1] = __uint_as_float(v.x & 0xffff0000u); f[2] = __uint_as_float(v.y << 16); f[3] = __uint_as_float(v.y & 0xffff0000u);
    f[4] = __uint_as_float(v.z << 16); f[5] = __uint_as_float(v.z & 0xffff0000u); f[6] = __uint_as_float(v.w << 16); f[7] = __uint_as_float(v.w & 0xffff0000u);
}

__device__ __forceinline__ int colmap(int kind, int n) {
    if (kind == 0) return n;
    if (kind == 1) { const int t = n >> 8, bj = (n >> 7) & 1, c = n & 127; return bj * DFF + t * 128 + c; }
    if (n < 2048) return n; if (n < 3968) return n + 16; if (n < 3984) return n - 3968 + 2048; return -1;
}
__device__ void convert_tile(const float* __restrict__ src, bf16_t* __restrict__ dst, int K, int Nsrc, int kind, int k0, int n0, float* tile) {
    const int tid = opaque_tid();
    { const int n = tid & 63, kr = tid >> 6; const int sc = colmap(kind, n0 + n);
#pragma unroll
      for (int i = 0; i < 8; ++i) { const int k = kr + 8 * i; tile[k * 65 + n] = sc >= 0 ? src[(size_t)(k0 + k) * Nsrc + sc] : 0.f; } }
    __syncthreads();
    { const int nn = tid >> 3, kg = tid & 7; unsigned w[4];
#pragma unroll
      for (int j = 0; j < 4; ++j) w[j] = pk2(tile[(kg * 8 + 2 * j) * 65 + nn], tile[(kg * 8 + 2 * j + 1) * 65 + nn]);
      *(uint4*)(dst + (size_t)(n0 + nn) * K + k0 + kg * 8) = make_uint4(w[0], w[1], w[2], w[3]); }
    __syncthreads();
}
__device__ void convert_jobs(const P& p, int first, int njobs_sel, unsigned char* lds, int item0, int nitems_before) {}

__device__ void do_convert(const float* src, bf16_t* dst, int K, int Nsrc, int Ndst, int kind, int t, float* tile) {
    const int nkt = K / 64; const int kt = t % nkt, ntile = t / nkt; (void)Ndst;
    convert_tile(src, dst, K, Nsrc, kind, kt * 64, ntile * 64, tile);
}

__device__ void phase0(const P& p, unsigned char* lds) {
    float* tile = (float*)lds;
    const int tid = opaque_tid();
    const int n_ada = 36 * 8;
    const int t1 = 16 * 88, t2 = 44 * 16, t3 = 16 * 64, t4 = 16 * 16, t5 = 8, t6 = 8, t7 = 16;
    const int total = n_ada + t1 + t2 + t3 + t4 + t5 + t6 + t7;
    for (int it = blockIdx.x; it < total; it += gridDim.x) {
        if (it < n_ada) {
            const int cgp = it % 36, kc = it / 36;
            float* sc = tile;
            __syncthreads();
            for (int i = tid; i < NCOND * 128; i += NTHR) { const int c = i >> 7, k = i & 127; const float v = c == 0 ? p.cctx[kc * 128 + k] : p.c[(c - 1) * DM + kc * 128 + k]; sc[i] = siluf(v); }
            __syncthreads();
            const int col = cgp * 256 + (tid & 255), kh = tid >> 8;
            float acc[NCOND];
#pragma unroll
            for (int c = 0; c < NCOND; ++c) acc[c] = 0.f;
            const float* w = p.ada_w + (size_t)(kc * 128 + kh * 64) * MODW + col;
#pragma unroll 4
            for (int k = 0; k < 64; ++k) { const float wv = w[(size_t)k * MODW];
#pragma unroll
                for (int c = 0; c < NCOND; ++c) acc[c] += sc[c * 128 + kh * 64 + k] * wv; }
            float* mod = (float*)(p.ws + WS_MOD);
            const float bias = (kc == 0 && kh == 0) ? p.ada_b[col] : 0.f;
#pragma unroll
            for (int c = 0; c < NCOND; ++c) atomicAdd(mod + c * MODW + col, acc[c] + bias);
            __syncthreads();
        } else {
            int t = it - n_ada;
            if (t < t1) do_convert(p.w1in, (bf16_t*)(p.ws + WS_W1), 1024, 5632, 5632, 1, t, tile);
            else if ((t -= t1) < t2) do_convert(p.w1out, (bf16_t*)(p.ws + WS_W1B), 2816, 1024, 1024, 0, t, tile);
            else if ((t -= t2) < t3) do_convert(p.wmin, (bf16_t*)(p.ws + WS_BT3), 1024, 3984, 4096, 2, t, tile);
            else if ((t -= t3) < t4) do_convert(p.wmout, (bf16_t*)(p.ws + WS_BT4), 1024, 1024, 1024, 0, t, tile);
            else if ((t -= t4) < t5) do_convert(p.a2, (bf16_t*)(p.ws + WS_A2BF), 64, 512, 512, 0, t, tile);
            else if ((t -= t5) < t6) do_convert(p.a2 + 64 * 512, (bf16_t*)(p.ws + WS_A2BF) + 512 * 64, 64, 512, 512, 0, t, tile);
            else { t -= t6; do_convert(p.g2, (bf16_t*)(p.ws + WS_G2BF), 128, 512, 512, 0, t, tile); }
        }
    }
}

__device__ void phase_normmod(const P& p, int which) {
    const int lane = opaque_tid() & 63, wave = threadIdx.x >> 6;
    const float* gain = which == 0 ? p.n1 : (which == 1 ? p.nmix : p.n2);
    const float* mod = (const float*)(p.ws + WS_MOD);
    bf16_t* A = (bf16_t*)(p.ws + WS_A);
    for (int row = blockIdx.x * 8 + wave; row < MT; row += gridDim.x * 8) {
        const float* src = which == 0 ? xrow(p, row) : p.out + (size_t)row * DM;
        float4 v[4]; float ss = 0.f;
#pragma unroll
        for (int i = 0; i < 4; ++i) { v[i] = *(const float4*)(src + lane * 4 + 256 * i); ss += v[i].x * v[i].x + v[i].y * v[i].y + v[i].z * v[i].z + v[i].w * v[i].w; }
#pragma unroll
        for (int o = 32; o >= 1; o >>= 1) ss += __shfl_xor(ss, o);
        const float rstd = rsqrtf(ss * (1.f / 1024.f) + 1e-6f);
        const float* sh = mod + cond_of(row) * MODW + which * 3072; const float* sc = sh + 1024;
#pragma unroll
        for (int i = 0; i < 4; ++i) { const int col = lane * 4 + 256 * i;
            const float4 g = *(const float4*)(gain + col), s4 = *(const float4*)(sh + col), c4 = *(const float4*)(sc + col);
            const float o0 = v[i].x * rstd * g.x * (1.f + c4.x) + s4.x, o1 = v[i].y * rstd * g.y * (1.f + c4.y) + s4.y,
                        o2 = v[i].z * rstd * g.z * (1.f + c4.z) + s4.z, o3 = v[i].w * rstd * g.w * (1.f + c4.w) + s4.w;
            *(uint2*)(A + (size_t)row * DM + col) = make_uint2(pk2(o0, o1), pk2(o2, o3)); }
    }
}
__device__ void phase_finalnorm(const P& p) {
    const int lane = opaque_tid() & 63, wave = threadIdx.x >> 6;
    for (int row = blockIdx.x * 8 + wave; row < MT; row += gridDim.x * 8) {
        float* src = p.out + (size_t)row * DM;
        float4 v[4]; float ss = 0.f;
#pragma unroll
        for (int i = 0; i < 4; ++i) { v[i] = *(const float4*)(src + lane * 4 + 256 * i); ss += v[i].x * v[i].x + v[i].y * v[i].y + v[i].z * v[i].z + v[i].w * v[i].w; }
#pragma unroll
        for (int o = 32; o >= 1; o >>= 1) ss += __shfl_xor(ss, o);
        const float rstd = rsqrtf(ss * (1.f / 1024.f) + 1e-6f);
#pragma unroll
        for (int i = 0; i < 4; ++i) { const int col = lane * 4 + 256 * i; const float4 g = *(const float4*)(p.nf + col);
            *(float4*)(src + col) = make_float4(v[i].x * rstd * g.x, v[i].y * rstd * g.y, v[i].z * rstd * g.z, v[i].w * rstd * g.w); }
    }
}

struct EpiSwiglu {
    static constexpr bool PERM = true;
    bf16_t* O;
    __device__ __forceinline__ void operator()(const f32x4 (&acc)[2][2][4][2], const pg8::Unit& u, int wr, int wc, int fr, int fq) const {
        const int row0 = u.pm * 256 + wr * 64 + fr, col0 = u.pn * 128 + wc * 32 + 8 * fq;
#pragma unroll
        for (int ai = 0; ai < 2; ++ai)
#pragma unroll
            for (int m = 0; m < 4; ++m) { bf16_t* rowp = O + (size_t)(row0 + ai * 128 + m * 16) * DFF + col0;
                float r[8];
#pragma unroll
                for (int n = 0; n < 2; ++n)
#pragma unroll
                    for (int j = 0; j < 4; ++j) r[n * 4 + j] = siluf(acc[ai][0][m][n][j]) * acc[ai][1][m][n][j];
                pg8::u32x4 w; w.x = pg8::cvt_pk_bf16(r[0], r[1]); w.y = pg8::cvt_pk_bf16(r[2], r[3]); w.z = pg8::cvt_pk_bf16(r[4], r[5]); w.w = pg8::cvt_pk_bf16(r[6], r[7]);
                *(pg8::u32x4*)rowp = w; }
    }
};
struct EpiResid {
    static constexpr bool PERM = false;
    const float* xp; const float* xs; float* out; const float* ga; float coef; int inplace;
    __device__ __forceinline__ void operator()(const f32x4 (&acc)[2][2][4][2], const pg8::Unit& u, int wr, int wc, int fr, int fq) const {
        const int row0 = u.pm * 256 + wr * 64 + fr, col0 = u.pn * 256 + wc * 32 + 4 * fq;
        const float* gap = ga + cond_of(u.pm * 256) * MODW;
        f32x4 gv[2][2];
#pragma unroll
        for (int bj = 0; bj < 2; ++bj)
#pragma unroll
            for (int n = 0; n < 2; ++n) gv[bj][n] = *(const f32x4*)(gap + col0 + bj * 128 + n * 16) * coef;
#pragma unroll
        for (int ai = 0; ai < 2; ++ai)
#pragma unroll
            for (int m = 0; m < 4; ++m) { const int row = row0 + ai * 128 + m * 16;
                const float* base = inplace ? out + (size_t)row * DM : (row < NCTX ? xp + (size_t)row * DM : xs + (size_t)(row - NCTX) * DM);
                float* op = out + (size_t)row * DM;
#pragma unroll
                for (int bj = 0; bj < 2; ++bj)
#pragma unroll
                    for (int n = 0; n < 2; ++n) { const int c = col0 + bj * 128 + n * 16; const f32x4 b4 = *(const f32x4*)(base + c);
                        *(f32x4*)(op + c) = b4 + gv[bj][n] * acc[ai][bj][m][n]; } }
    }
};
struct EpiU {
    static constexpr bool PERM = true;
    bf16_t* U; float* gates;
    __device__ __forceinline__ void operator()(const f32x4 (&acc)[2][2][4][2], const pg8::Unit& u, int wr, int wc, int fr, int fq) const {
        const int row0 = u.pm * 256 + wr * 64 + fr;
#pragma unroll
        for (int bj = 0; bj < 2; ++bj) { const int col0 = u.pn * 256 + bj * 128 + wc * 32 + 8 * fq;
            if (col0 < UW) {
#pragma unroll
                for (int ai = 0; ai < 2; ++ai)
#pragma unroll
                    for (int m = 0; m < 4; ++m) { const int row = row0 + ai * 128 + m * 16; const f32x4 v0 = acc[ai][bj][m][0], v1 = acc[ai][bj][m][1];
                        pg8::u32x4 w; w.x = pg8::cvt_pk_bf16(v0[0], v0[1]); w.y = pg8::cvt_pk_bf16(v0[2], v0[3]); w.z = pg8::cvt_pk_bf16(v1[0], v1[1]); w.w = pg8::cvt_pk_bf16(v1[2], v1[3]);
                        *(pg8::u32x4*)(U + (size_t)row * UW + col0) = w;
                        if (col0 >= 3968) { float* gp = gates + (size_t)row * 16 + (col0 - 3968); *(f32x4*)gp = v0; *(f32x4*)(gp + 4) = v1; } } } }
    }
};

template <class Epi>
__device__ __forceinline__ void run_gemm(unsigned char* lds, const bf16_t* A, const bf16_t* Bt, int N, int K, const Epi& E) {
    pg8::Gemm g{A, Bt, MT, N, K}; pg8::StaticOrder S; S.init(MT, N, (int)gridDim.x, (int)blockIdx.x);
    pg8::gemm_phase<Epi, pg8::StaticOrder, true, true>((PG8_LAS unsigned char*)lds, g, S, E);
}

constexpr int ML_SK = 0, ML_KWT = 17408, ML_VT = ML_KWT + 18432, ML_CB = ML_VT + 20736, ML_F = ML_CB + 21760, ML_CW = ML_F + 2048, ML_END = ML_CW + 4096;
static_assert(ML_END <= LDS_BYTES, "mlstm lds");

__device__ __forceinline__ unsigned short ld_u16_agent(const bf16_t* p) { return __hip_atomic_load(p, __ATOMIC_RELAXED, __HIP_MEMORY_SCOPE_AGENT); }

__device__ __forceinline__ void conv3_row8(const bf16_t* up, bool hasp, bool hasn, const float* cwp, float* x) {
    float t[8];
    unpack8(*(const uint4*)up, t);
#pragma unroll
    for (int i = 0; i < 8; ++i) x[i] = cwp[768 + i] + cwp[256 + i] * t[i];
    if (hasp) { unpack8(*(const uint4*)(up - UW), t);
#pragma unroll
        for (int i = 0; i < 8; ++i) x[i] += cwp[i] * t[i]; }
    if (hasn) { unpack8(*(const uint4*)(up + UW), t);
#pragma unroll
        for (int i = 0; i < 8; ++i) x[i] += cwp[512 + i] * t[i]; }
}

__device__ __forceinline__ void mlstm_task(const P& p, unsigned char* lds, int bg, int h, int dsel) {
    const int wv = __builtin_amdgcn_readfirstlane((int)threadIdx.x >> 6), rw = wv & 3, cw = wv >> 2;
    const bool ctx = bg < 32; const int T = ctx ? 256 : 2048, nc = T / 64; const int row0 = ctx ? bg * 256 : NCTX + (bg - 32) * 2048;
    bf16_t* sK = (bf16_t*)(lds + ML_SK); bf16_t* sKwT = (bf16_t*)(lds + ML_KWT); bf16_t* sVT = (bf16_t*)(lds + ML_VT); bf16_t* sCb = (bf16_t*)(lds + ML_CB); bf16_t* sS = sCb;
    float* sA = (float*)(lds + ML_F); float* sM = sA + 64; float* sBb = sM + 64; float* sDen = sBb + 64; float* sScal = sDen + 64; float* sRed = sScal + 16;
    float* sCW = (float*)(lds + ML_CW);
    const bf16_t* U = (const bf16_t*)(p.ws + WS_U); const float* GATES = (const float*)(p.ws + WS_GATES); bf16_t* HB = (bf16_t*)(p.ws + WS_A); bf16_t* HB2 = (bf16_t*)(p.ws + WS_HB2);
    const int d_lo = dsel < 0 ? 0 : dsel, d_hi = dsel < 0 ? 2 : dsel + 1;
    const int ct_a = cw ? 3 : 0;
    const int ct_b = cw ? 7 : 5;
    const int n_a = cw ? 2 : 3;

    __syncthreads();
    { const int tid = threadIdx.x;
      for (int i = tid; i < 1024; i += NTHR) { const int a = i >> 8, cc = i & 255, gch = (cc >> 7) * 512 + h * 128 + (cc & 127); sCW[i] = a < 3 ? p.cw[a * 1024 + gch] : p.cb[gch]; }
      for (int i = tid; i < 16 * 72; i += NTHR) { const int r = 128 + i / 72; sVT[r * 72 + (i % 72)] = (r == 128) ? (bf16_t)0x3F80 : (bf16_t)0; } }

#pragma unroll 1
    for (int dir = d_lo; dir < d_hi; ++dir) {
        f32x4 Cacc[9]; float m_prev = 0.f;
        { int z0 = 0; asm volatile("" : "+v"(z0)); const int tid = (int)threadIdx.x + z0, fr = tid & 15, fq = (tid >> 4) & 3;
#pragma unroll
          for (int ct = 0; ct < 9; ++ct) Cacc[ct] = (f32x4){0.f, 0.f, 0.f, 0.f};
          if (!ctx) { const int sidx = ((bg - 32) * 2 + dir) * 4 + h; const float* C0 = p.sC + (size_t)sidx * 16384; const float* n0 = p.sn + (size_t)sidx * 128;
#pragma unroll
              for (int j = 0; j < 4; ++j) { const int d = 16 * wv + 4 * fq + j;
#pragma unroll
                  for (int ct = 0; ct < 8; ++ct) Cacc[ct][j] = C0[d * 128 + 16 * ct + fr];
                  Cacc[8][j] = fr == 0 ? n0[d] : 0.f; }
              m_prev = p.sm[sidx]; } }
        const float gbi = p.gb[dir * 4 + h], gbf = p.gb[8 + dir * 4 + h];
        const bool second = dsel < 0 && dir == 1;
#pragma unroll 1
        for (int s = 0; s < nc; ++s) {
            const int c = dir ? nc - 1 - s : s;
            int zz = 0; asm volatile("" : "+v"(zz));
            const int tid = (int)threadIdx.x + zz, lane = tid & 63, fr = tid & 15, fq = (tid >> 4) & 3;
            uint4 kc[2], kp[2], kn[2], vv[2];
#pragma unroll
            for (int g = 0; g < 2; ++g) { const int idx = tid + 512 * g, sl = idx >> 4, d0 = (idx & 15) * 8; const int tl = dir ? 63 - sl : sl, tok = c * 64 + tl;
                const bf16_t* up = U + ((size_t)row0 + tok) * UW + 512 + h * 128 + d0;
                kc[g] = *(const uint4*)up; kp[g] = make_uint4(0u, 0u, 0u, 0u); kn[g] = kp[g];
                if (tok > 0) kp[g] = *(const uint4*)(up - UW);
                if (tok < T - 1) kn[g] = *(const uint4*)(up + UW);
                vv[g] = *(const uint4*)(up + 512); }
            LDS_BARRIER();
            if (wv == 0) {
                const int tl = dir ? 63 - lane : lane; const size_t row = (size_t)row0 + c * 64 + tl;
                const float ip = GATES[row * 16 + dir * 4 + h] + gbi, fp = GATES[row * 16 + 8 + dir * 4 + h] + gbf;
                const float lf = -softplus_fast(-fp);
                float bs = lf;
#pragma unroll
                for (int o = 1; o < 64; o <<= 1) { const float t = __shfl_up(bs, o); if (lane >= o) bs += t; }
                const float a = ip - bs; float pm = a;
#pragma unroll
                for (int o = 1; o < 64; o <<= 1) { const float t = __shfl_up(pm, o); if (lane >= o) pm = fmaxf(pm, t); }
                const float Mt = fmaxf(m_prev, pm);
                sA[lane] = a; sM[lane] = Mt; sBb[lane] = bs;
                if (lane == 63) { sScal[0] = Mt; sScal[1] = bs; }
            }
            LDS_BARRIER();
            const float M63 = sScal[0], bL = sScal[1];
            uint4 qc[4], qp[4], qn[4];
            { const int t_ = 16 * rw + fr, tl = dir ? 63 - t_ : t_, tok = c * 64 + tl; const bf16_t* up = U + ((size_t)row0 + tok) * UW + h * 128 + 8 * fq;
#pragma unroll
              for (int kk = 0; kk < 4; ++kk) { qc[kk] = *(const uint4*)(up + 32 * kk); qp[kk] = make_uint4(0u, 0u, 0u, 0u); qn[kk] = qp[kk];
                  if (tok > 0) qp[kk] = *(const uint4*)(up + 32 * kk - UW);
                  if (tok < T - 1) qn[kk] = *(const uint4*)(up + 32 * kk + UW); } }
#pragma unroll
            for (int g = 0; g < 2; ++g) {
                const int idx = tid + 512 * g, sl = idx >> 4, d0 = (idx & 15) * 8;
                const float wk = fexp(sA[sl] - M63);
                const float* cwp = sCW + 128 + d0;
                float kv[8], t[8];
                unpack8(kc[g], t);
#pragma unroll
                for (int i = 0; i < 8; ++i) kv[i] = cwp[768 + i] + cwp[256 + i] * t[i];
                unpack8(kp[g], t);
#pragma unroll
                for (int i = 0; i < 8; ++i) kv[i] += cwp[i] * t[i];
                unpack8(kn[g], t);
#pragma unroll
                for (int i = 0; i < 8; ++i) kv[i] += cwp[512 + i] * t[i];
#pragma unroll
                for (int i = 0; i < 8; ++i) kv[i] = siluf(kv[i]) * 0.08838834764831845f;
                *(uint4*)(sK + sl * 136 + d0) = make_uint4(pk2(kv[0], kv[1]), pk2(kv[2], kv[3]), pk2(kv[4], kv[5]), pk2(kv[6], kv[7]));
#pragma unroll
                for (int i = 0; i < 8; ++i) sKwT[(d0 + i) * 72 + sl] = f2bf(kv[i] * wk);
                const unsigned vw[4] = {vv[g].x, vv[g].y, vv[g].z, vv[g].w};
#pragma unroll
                for (int i = 0; i < 8; ++i) sVT[(d0 + i) * 72 + sl] = (bf16_t)((vw[i >> 1] >> ((i & 1) * 16)) & 0xffffu);
            }
            bf16x8 qf[4];
#pragma unroll
            for (int kk = 0; kk < 4; ++kk) { const float* cwp = sCW + 32 * kk + 8 * fq; float qv[8], t[8];
                unpack8(qc[kk], t);
#pragma unroll
                for (int i = 0; i < 8; ++i) qv[i] = cwp[768 + i] + cwp[256 + i] * t[i];
                unpack8(qp[kk], t);
#pragma unroll
                for (int i = 0; i < 8; ++i) qv[i] += cwp[i] * t[i];
                unpack8(qn[kk], t);
#pragma unroll
                for (int i = 0; i < 8; ++i) qv[i] += cwp[512 + i] * t[i];
#pragma unroll
                for (int i = 0; i < 8; ++i) qv[i] = siluf(qv[i]);
                union { uint4 u; bf16x8 v; } cv; cv.u = make_uint4(pk2(qv[0], qv[1]), pk2(qv[2], qv[3]), pk2(qv[4], qv[5]), pk2(qv[6], qv[7])); qf[kk] = cv.v; }
            f32x4 num[5];
#pragma unroll
            for (int k = 0; k < 5; ++k) num[k] = (f32x4){0.f, 0.f, 0.f, 0.f};
#pragma unroll
            for (int ci = 0; ci < 5; ++ci) { const f32x4 v = Cacc[ci]; *(uint2*)(sCb + (16 * ci + fr) * 136 + 16 * wv + 4 * fq) = make_uint2(pk2(v[0], v[1]), pk2(v[2], v[3])); }
            LDS_BARRIER();
#pragma unroll
            for (int k = 0; k < 3; ++k) if (k < n_a) {
#pragma unroll
                for (int kk = 0; kk < 4; ++kk) { const bf16x8 b = *(const bf16x8*)(sCb + (16 * (ct_a + k) + fr) * 136 + 32 * kk + 8 * fq); num[k] = mfma16(qf[kk], b, num[k]); } }
            LDS_BARRIER();
#pragma unroll
            for (int ci = 0; ci < 4; ++ci) { const f32x4 v = Cacc[5 + ci]; *(uint2*)(sCb + (16 * ci + fr) * 136 + 16 * wv + 4 * fq) = make_uint2(pk2(v[0], v[1]), pk2(v[2], v[3])); }
            LDS_BARRIER();
#pragma unroll
            for (int k = 3; k < 5; ++k) {
#pragma unroll
                for (int kk = 0; kk < 4; ++kk) { const bf16x8 b = *(const bf16x8*)(sCb + (16 * (ct_b + k - 3 - 5) + fr) * 136 + 32 * kk + 8 * fq); num[k] = mfma16(qf[kk], b, num[k]); } }
            {
                float scv[4];
#pragma unroll
                for (int j = 0; j < 4; ++j) scv[j] = fexp(m_prev - sM[16 * rw + 4 * fq + j]);
#pragma unroll
                for (int k = 0; k < 5; ++k)
#pragma unroll
                    for (int j = 0; j < 4; ++j) num[k][j] *= scv[j];
            }
            LDS_BARRIER();
#pragma unroll
            for (int si = 0; si < 2; ++si) { const int st = 2 * cw + si;
                f32x4 sacc = (f32x4){0.f, 0.f, 0.f, 0.f};
                if (st <= rw) {
#pragma unroll
                    for (int kk = 0; kk < 4; ++kk) { const bf16x8 b = *(const bf16x8*)(sK + (16 * st + fr) * 136 + 32 * kk + 8 * fq); sacc = mfma16(qf[kk], b, sacc); } }
                const int sp = 16 * st + fr; const float as = sA[sp];
#pragma unroll
                for (int j = 0; j < 4; ++j) { const int tp = 16 * rw + 4 * fq + j; const float val = (sp <= tp) ? sacc[j] * fexp(as - sM[tp]) : 0.f; sS[tp * 72 + sp] = f2bf(val); }
            }
            LDS_BARRIER();
#pragma unroll
            for (int ks = 0; ks < 2; ++ks) { const bf16x8 a = *(const bf16x8*)(sS + (16 * rw + fr) * 72 + 32 * ks + 8 * fq);
#pragma unroll
                for (int k = 0; k < 5; ++k) { const int ct = k < 3 ? ct_a + k : ct_b + k - 3;
                    if (k != 2 || cw == 0) { const bf16x8 b = *(const bf16x8*)(sVT + (16 * ct + fr) * 72 + 32 * ks + 8 * fq); num[k] = mfma16(a, b, num[k]); } } }
            if (cw == 1 && fr == 0) {
#pragma unroll
                for (int j = 0; j < 4; ++j) sDen[16 * rw + 4 * fq + j] = num[4][j]; }
            LDS_BARRIER();
            float inv[4];
#pragma unroll
            for (int j = 0; j < 4; ++j) { const int tp = 16 * rw + 4 * fq + j; const float den = sDen[tp]; inv[j] = __builtin_amdgcn_rcpf(fmaxf(fabsf(den), fexp(-(sBb[tp] + sM[tp])))); }
            if (!second) {
#pragma unroll
                for (int j = 0; j < 4; ++j) { const int tp = 16 * rw + 4 * fq + j, tl = dir ? 63 - tp : tp; const size_t row = (size_t)row0 + c * 64 + tl;
                    bf16_t* hb = dsel == 1 ? HB2 + (row - NCTX) * 512 + h * 128 : HB + row * DM + h * 128;
#pragma unroll
                    for (int k = 0; k < 5; ++k) { const int ct = k < 3 ? ct_a + k : ct_b + k - 3; if ((k != 2 || cw == 0) && ct < 8) hb[16 * ct + fr] = f2bf(num[k][j] * inv[j]); } }
            } else {
                float ssr[4];
#pragma unroll
                for (int j = 0; j < 4; ++j) { const int tp = 16 * rw + 4 * fq + j, tl = dir ? 63 - tp : tp; const size_t row = (size_t)row0 + c * 64 + tl;
                    const bf16_t* hb = HB + row * DM + h * 128; float ss = 0.f;
#pragma unroll
                    for (int k = 0; k < 5; ++k) { const int ct = k < 3 ? ct_a + k : ct_b + k - 3;
                        if ((k != 2 || cw == 0) && ct < 8) { const int e = 16 * ct + fr; const float other = bf2f(ld_u16_agent(hb + e)); const float hs = num[k][j] * inv[j] + other;
                            const float o = sigmf(bf2f(U[row * UW + 1536 + h * 128 + e])); const float v = o * hs; ss += v * v; num[k][j] = v; } }
                    ss += __shfl_xor(ss, 1); ss += __shfl_xor(ss, 2); ss += __shfl_xor(ss, 4); ss += __shfl_xor(ss, 8);
                    ssr[j] = ss; if (fr == 0) sRed[cw * 64 + tp] = ss; }
                LDS_BARRIER();
#pragma unroll
                for (int j = 0; j < 4; ++j) { const int tp = 16 * rw + 4 * fq + j, tl = dir ? 63 - tp : tp; const size_t row = (size_t)row0 + c * 64 + tl;
                    bf16_t* hb = HB + row * DM + h * 128; const float rms = rsqrtf((ssr[j] + sRed[(1 - cw) * 64 + tp]) * (1.f / 128.f) + 1e-6f);
#pragma unroll
                    for (int k = 0; k < 5; ++k) { const int ct = k < 3 ? ct_a + k : ct_b + k - 3;
                        if ((k != 2 || cw == 0) && ct < 8) { const int e = 16 * ct + fr; hb[e] = f2bf(num[k][j] * rms * p.hg[h * 128 + e]); } } }
            }
            const float decay = fexp(m_prev - M63);
#pragma unroll
            for (int ct = 0; ct < 9; ++ct) Cacc[ct] = Cacc[ct] * decay;
#pragma unroll
            for (int ks = 0; ks < 2; ++ks) { const bf16x8 a = *(const bf16x8*)(sKwT + (16 * wv + fr) * 72 + 32 * ks + 8 * fq);
#pragma unroll
                for (int ct = 0; ct < 9; ++ct) { const bf16x8 b = *(const bf16x8*)(sVT + (16 * ct + fr) * 72 + 32 * ks + 8 * fq); Cacc[ct] = mfma16(a, b, Cacc[ct]); } }
            m_prev = bL + M63;
        }
        if (ctx) { const int sidx = (bg * 2 + dir) * 4 + h; float* Co = p.out + OUT_C + (size_t)sidx * 16384;
            int z1 = 0; asm volatile("" : "+v"(z1)); const int tid1 = (int)threadIdx.x + z1, fr1 = tid1 & 15, fq1 = (tid1 >> 4) & 3;
#pragma unroll
            for (int j = 0; j < 4; ++j) { const int d = 16 * wv + 4 * fq1 + j;
#pragma unroll
                for (int ct = 0; ct < 8; ++ct) Co[d * 128 + 16 * ct + fr1] = Cacc[ct][j];
                if (fr1 == 0) p.out[OUT_N + sidx * 128 + d] = Cacc[8][j]; }
            if (tid1 == 0) p.out[OUT_MM + sidx] = m_prev; }
        __syncthreads();
    }
}

__device__ __forceinline__ void phase_shift(bf16_t* U, const float* pmu, uint4* sRow) {
#pragma unroll 1
    for (int item = blockIdx.x; item < 1200; item += gridDim.x) {
        const int tid = opaque_tid(), tl = tid >> 3, g = tid & 7;
        const bool grid = item < 240; const int seq = grid ? item / 30 : (item - 240) / 30, sl = grid ? item % 30 : (item - 240) % 30;
        const int T = grid ? 2048 : 256, nst = T / 64; const size_t row0 = grid ? (size_t)NCTX + (size_t)seq * 2048 : (size_t)seq * 256;
        const int rc = sl * 64 + g * 8;
        char* base = (char*)(U + row0 * UW + 2048 + rc);
        const int act = (rc >= 1536 && rc < 1664) ? 1 : (rc >= 1792 ? 2 : 0);
        unsigned z0_ = 0u; asm volatile("" : "+v"(z0_));
        uint4 prv = make_uint4(z0_, z0_, z0_, z0_), cur = *(const uint4*)(base + (size_t)tl * (UW * 2)), nxt;
        __syncthreads();
#pragma unroll 1
        for (int k = 0; k < nst; ++k) {
            unsigned zr = 0u; asm volatile("" : "+v"(zr)); const uint4 z4 = make_uint4(zr, zr, zr, zr);
            nxt = z4; if (k + 1 < nst) nxt = *(const uint4*)(base + (size_t)((k + 1) * 64 + tl) * (UW * 2));
            sRow[(1 + tl) * 8 + g] = cur;
            if (tl == 0) sRow[65 * 8 + g] = nxt;
            LDS_BARRIER();
            uint4 lf = sRow[tl * 8 + g], rt = sRow[(2 + tl) * 8 + g];
            if (tl == 0 && (grid || k == 0)) lf = z4;
            if (tl == 63 && (grid || k == nst - 1)) rt = z4;
            float x[8], t[8], o[8], ms[8], m[8];
            int zz = 0; asm volatile("" : "+v"(zz)); const float* mup = pmu + rc + zz;
#define LD_MU8(a) do { const float4 m0 = *(const float4*)(mup + (a) * 1920), m1 = *(const float4*)(mup + (a) * 1920 + 4); m[0] = m0.x; m[1] = m0.y; m[2] = m0.z; m[3] = m0.w; m[4] = m1.x; m[5] = m1.y; m[6] = m1.z; m[7] = m1.w; } while (0)
            unpack8(cur, x);
            LD_MU8(0); unpack8(lf, t);
#pragma unroll
            for (int i = 0; i < 8; ++i) { o[i] = m[i] * t[i]; ms[i] = m[i]; }
            LD_MU8(1); unpack8(rt, t);
#pragma unroll
            for (int i = 0; i < 8; ++i) { o[i] += m[i] * t[i]; ms[i] += m[i]; }
            if (grid) {
                LD_MU8(2); unpack8(prv, t);
#pragma unroll
                for (int i = 0; i < 8; ++i) { o[i] += m[i] * t[i]; ms[i] += m[i]; }
                LD_MU8(3); unpack8(nxt, t);
#pragma unroll
                for (int i = 0; i < 8; ++i) { o[i] += m[i] * t[i]; ms[i] += m[i]; }
            }
#undef LD_MU8
#pragma unroll
            for (int i = 0; i < 8; ++i) o[i] += x[i] * (1.f - ms[i]);
            if (act == 1) {
#pragma unroll
                for (int i = 0; i < 8; ++i) o[i] = tanh_fast(o[i]); }
            if (act == 2) {
#pragma unroll
                for (int i = 0; i < 8; ++i) o[i] = sigmf(o[i]); }
            *(uint4*)(base + (size_t)(k * 64 + tl) * (UW * 2)) = make_uint4(pk2(o[0], o[1]), pk2(o[2], o[3]), pk2(o[4], o[5]), pk2(o[6], o[7]));
            LDS_BARRIER();
            if (tl == 63) sRow[g] = cur;
            prv = cur; cur = nxt;
        }
    }
}

constexpr int RW_TC = 16;
constexpr int RW_VEC = 0, RW_V = RW_VEC + 16 * 320 * 4, RW_KR = RW_V + 16 * 32 * 4, RW_XW = RW_KR + 16 * 64 * 4, RW_XA = RW_XW + 16 * 72 * 2, RW_Y = RW_XA + 16 * 72 * 2,
              RW_MU = RW_Y + 16 * 32 * 4, RW_DIR = RW_MU + 4 * 288 * 4;
static_assert(2 * RW_DIR <= LDS_BYTES && RW_DIR % 16 == 0, "rwkv lds");

__device__ __forceinline__ float dppf(float x, const int ctrl) { return x; }
#define DPP_ADD(x, ctrl) ((x) + __int_as_float(__builtin_amdgcn_update_dpp(0, __float_as_int(x), (ctrl), 0xf, 0xf, true)))
__device__ __forceinline__ float red8(float x) { x = DPP_ADD(x, 0xB1); x = DPP_ADD(x, 0x4E); x = DPP_ADD(x, 0x141); return x; }
__device__ __forceinline__ float red16(float x) { x = red8(x); x = DPP_ADD(x, 0x140); return x; }

struct Sh8 { uint4 x, l, r, u, d; };
__device__ __forceinline__ void sh8_load(Sh8& q, const bf16_t* U, size_t row0, int tok, int T, bool grid, int c0) {
    const char* Ub = (const char*)(U + row0 * UW);
    const int off = (tok * UW + c0) * 2; const uint4 z = make_uint4(0u, 0u, 0u, 0u);
    const bool hl = grid ? (tok & 63) != 0 : tok > 0, hr = grid ? (tok & 63) != 63 : tok < T - 1;
    q.x = *(const uint4*)(Ub + off);
    q.l = hl ? *(const uint4*)(Ub + (off - UW * 2)) : z; q.r = hr ? *(const uint4*)(Ub + (off + UW * 2)) : z;
    q.u = (grid && tok >= 64) ? *(const uint4*)(Ub + (off - 64 * UW * 2)) : z; q.d = (grid && tok < T - 64) ? *(const uint4*)(Ub + (off + 64 * UW * 2)) : z;
}
__device__ __forceinline__ void sh8_mix(const Sh8& q, bool grid, const float* mu4, int mustride, float* o) {
    float x[8], t[8], m[8], ms[8];
    unpack8(q.x, x);
    { const float4 a = *(const float4*)mu4, b = *(const float4*)(mu4 + 4); m[0] = a.x; m[1] = a.y; m[2] = a.z; m[3] = a.w; m[4] = b.x; m[5] = b.y; m[6] = b.z; m[7] = b.w; }
    unpack8(q.l, t);
#pragma unroll
    for (int i = 0; i < 8; ++i) { o[i] = m[i] * t[i]; ms[i] = m[i]; }
    { const float4 a = *(const float4*)(mu4 + mustride), b = *(const float4*)(mu4 + mustride + 4); m[0] = a.x; m[1] = a.y; m[2] = a.z; m[3] = a.w; m[4] = b.x; m[5] = b.y; m[6] = b.z; m[7] = b.w; }
    unpack8(q.r, t);
#pragma unroll
    for (int i = 0; i < 8; ++i) { o[i] += m[i] * t[i]; ms[i] += m[i]; }
    if (grid) {
        { const float4 a = *(const float4*)(mu4 + 2 * mustride), b = *(const float4*)(mu4 + 2 * mustride + 4); m[0] = a.x; m[1] = a.y; m[2] = a.z; m[3] = a.w; m[4] = b.x; m[5] = b.y; m[6] = b.z; m[7] = b.w; }
        unpack8(q.u, t);
#pragma unroll
        for (int i = 0; i < 8; ++i) { o[i] += m[i] * t[i]; ms[i] += m[i]; }
        { const float4 a = *(const float4*)(mu4 + 3 * mustride), b = *(const float4*)(mu4 + 3 * mustride + 4); m[0] = a.x; m[1] = a.y; m[2] = a.z; m[3] = a.w; m[4] = b.x; m[5] = b.y; m[6] = b.z; m[7] = b.w; }
        unpack8(q.d, t);
#pragma unroll
        for (int i = 0; i < 8; ++i) { o[i] += m[i] * t[i]; ms[i] += m[i]; }
    }
#pragma unroll
    for (int i = 0; i < 8; ++i) o[i] += x[i] * (1.f - ms[i]);
}
__device__ __forceinline__ void shifted8(const bf16_t* U, size_t row0, int tok, int T, bool grid, int c0, const float* mu4, int mustride, float* o) {
    Sh8 q; sh8_load(q, U, row0, tok, T, grid, c0); sh8_mix(q, grid, mu4, mustride, o);
}
typedef float f32x2 __attribute__((ext_vector_type(2)));

__device__ __forceinline__ void rwkv_task(const P& p, unsigned char* lds, int bg, int h, int rh) {
    const int wv = __builtin_amdgcn_readfirstlane((int)threadIdx.x >> 6), dir = wv >> 2, lw = wv & 3;
    const bool ctx = bg < 32; const int T = ctx ? 256 : 2048, nc = T / RW_TC; const size_t row0 = ctx ? (size_t)bg * 256 : (size_t)NCTX + (size_t)(bg - 32) * 2048;
    const bool grid = !ctx;
    unsigned char* L = lds + dir * RW_DIR;
    float* sVec = (float*)(L + RW_VEC); float* sV = (float*)(L + RW_V); float* sKr = (float*)(L + RW_KR); bf16_t* sXw = (bf16_t*)(L + RW_XW); bf16_t* sXa = (bf16_t*)(L + RW_XA);
    float* sY = (float*)(L + RW_Y); float* sMu = (float*)(L + RW_MU);
    const bf16_t* U = (const bf16_t*)(p.ws + WS_U); bf16_t* HB = (bf16_t*)(p.ws + WS_A);
    const int hc = h * 64;
    float st[8]; bf16x8 wfrag[2], afrag[2]; float w0v, a0v, kav;
    {
        const int tid = opaque_tid(), ltid = tid & 255, ri = ltid >> 3, jq = ltid & 7, fr = tid & 15, fq = (tid >> 4) & 3;
        __syncthreads();
        if (ctx) {
#pragma unroll
            for (int q = 0; q < 8; ++q) st[q] = 0.f;
        } else { const float* S0 = p.sS + ((size_t)(((bg - 32) * 2 + dir) * 8 + h)) * 4096 + (32 * rh + ri) * 64 + jq * 8;
#pragma unroll
            for (int q = 0; q < 8; ++q) st[q] = S0[q]; }
        const int jcol = hc + 16 * lw + fr;
#pragma unroll
        for (int ks = 0; ks < 2; ++ks) { float wf[8], af[8];
#pragma unroll
            for (int i = 0; i < 8; ++i) { const int l = 32 * ks + 8 * fq + i; wf[i] = p.w2[(size_t)(dir * 64 + l) * 512 + jcol]; af[i] = p.a2[(size_t)(dir * 64 + l) * 512 + jcol]; }
            union { uint4 u; bf16x8 v; } c1, c2; c1.u = make_uint4(pk2(wf[0], wf[1]), pk2(wf[2], wf[3]), pk2(wf[4], wf[5]), pk2(wf[6], wf[7])); c2.u = make_uint4(pk2(af[0], af[1]), pk2(af[2], af[3]), pk2(af[4], af[5]), pk2(af[6], af[7]));
            wfrag[ks] = c1.v; afrag[ks] = c2.v; }
        w0v = p.w0[dir * 512 + jcol]; a0v = p.a0[dir * 512 + jcol]; kav = p.ka[jcol];
    }
    uint4 q1, q2, q3 = make_uint4(0u, 0u, 0u, 0u);
    const char* Ub = (const char*)(U + row0 * UW);
    { const int tid = opaque_tid(), ltid = tid & 255; const int c = dir ? nc - 1 : 0, tok0 = c * RW_TC; const int tl = (ltid & 127) >> 3, g = ltid & 7;
      q1 = *(const uint4*)(Ub + ((tok0 + tl) * UW + (lw < 2 ? 2048 : 2048 + 512) + hc + 8 * g) * 2);
      q2 = *(const uint4*)(Ub + ((tok0 + tl) * UW + (lw < 2 ? 2048 + 1536 : 2048 + 1664) + dir * 64 + 8 * g) * 2);
      if (lw == 0) q3 = *(const uint4*)(Ub + ((tok0 + (ltid >> 2)) * UW + 2048 + 1024 + hc + 32 * rh + 8 * (ltid & 3)) * 2); }
    f32x2 st2[4];
#pragma unroll
    for (int q = 0; q < 4; ++q) st2[q] = (f32x2){st[2 * q], st[2 * q + 1]};
#pragma unroll 1
    for (int s = 0; s < nc; ++s) {
        const int c = dir ? nc - 1 - s : s; const int tok0 = c * RW_TC;
        const bool second = s >= (nc >> 1);
        const int tid = opaque_tid(), ltid = tid & 255, ri = ltid >> 3, jq = ltid & 7, fr = tid & 15, fq = (tid >> 4) & 3;
        { const int tl = (ltid & 127) >> 3, g = ltid & 7; float o[8];
          if (lw < 2) {
              unpack8(q1, o);
              *(float4*)(sVec + tl * 320 + 8 * g) = make_float4(o[0], o[1], o[2], o[3]); *(float4*)(sVec + tl * 320 + 8 * g + 4) = make_float4(o[4], o[5], o[6], o[7]);
              *(uint4*)(sXw + tl * 72 + 8 * g) = q2;
          } else {
              unpack8(q1, o);
              float kkr[8]; float ss = 0.f;
#pragma unroll
              for (int i = 0; i < 8; ++i) { kkr[i] = o[i] * p.kk[hc + 8 * g + i]; ss += kkr[i] * kkr[i]; }
              ss = red8(ss); const float rn = __builtin_amdgcn_rsqf(fmaxf(ss, 1e-24f));
              *(float4*)(sKr + tl * 64 + 8 * g) = make_float4(o[0], o[1], o[2], o[3]); *(float4*)(sKr + tl * 64 + 8 * g + 4) = make_float4(o[4], o[5], o[6], o[7]);
              *(float4*)(sVec + tl * 320 + 192 + 8 * g) = make_float4(kkr[0] * rn, kkr[1] * rn, kkr[2] * rn, kkr[3] * rn); *(float4*)(sVec + tl * 320 + 192 + 8 * g + 4) = make_float4(kkr[4] * rn, kkr[5] * rn, kkr[6] * rn, kkr[7] * rn);
              *(uint4*)(sXa + tl * 72 + 8 * g) = q2;
          }
          if (lw == 0) {
              const int tl2 = ltid >> 2, g2 = ltid & 3;
              unpack8(q3, o);
              *(float4*)(sV + tl2 * 32 + 8 * g2) = make_float4(o[0], o[1], o[2], o[3]); *(float4*)(sV + tl2 * 32 + 8 * g2 + 4) = make_float4(o[4], o[5], o[6], o[7]);
          } }
        __syncthreads();
        { f32x4 aw = (f32x4){0.f, 0.f, 0.f, 0.f}, aa = (f32x4){0.f, 0.f, 0.f, 0.f};
#pragma unroll
          for (int ks = 0; ks < 2; ++ks) { const bf16x8 xw = *(const bf16x8*)(sXw + fr * 72 + 32 * ks + 8 * fq), xa = *(const bf16x8*)(sXa + fr * 72 + 32 * ks + 8 * fq);
              aw = mfma16(xw, wfrag[ks], aw); aa = mfma16(xa, afrag[ks], aa); }
          const int j = 16 * lw + fr;
#pragma unroll
          for (int jj = 0; jj < 4; ++jj) { const int tl = 4 * fq + jj;
              const float dec = fexp(-fexp(-softplus_fast(-(w0v + aw[jj])) - 0.5f));
              const float a = sigmf(a0v + aa[jj]); const float k = sKr[tl * 64 + j], kn = sVec[tl * 320 + 192 + j];
              float* V = sVec + tl * 320 + j; V[64] = dec; V[128] = k * (1.f + (a - 1.f) * kav); V[256] = kn * a; } }
        const int otl = ltid >> 4, opr = ltid & 15; unsigned* hb = (unsigned*)(HB + (row0 + tok0 + otl) * DM + 512 + hc + 32 * rh + 2 * opr);
        unsigned ov = 0u;
        if (second) ov = __hip_atomic_load(hb, __ATOMIC_RELAXED, __HIP_MEMORY_SCOPE_AGENT);
        if (s + 1 < nc) { const int cn = dir ? nc - 2 - s : s + 1, tokn = cn * RW_TC; const int tl = (ltid & 127) >> 3, g = ltid & 7;
            q1 = *(const uint4*)(Ub + ((tokn + tl) * UW + (lw < 2 ? 2048 : 2048 + 512) + hc + 8 * g) * 2);
            q2 = *(const uint4*)(Ub + ((tokn + tl) * UW + (lw < 2 ? 2048 + 1536 : 2048 + 1664) + dir * 64 + 8 * g) * 2);
            if (lw == 0) q3 = *(const uint4*)(Ub + ((tokn + (ltid >> 2)) * UW + 2048 + 1024 + hc + 32 * rh + 8 * (ltid & 3)) * 2); }
        LDS_BARRIER();
        f32x2 sv_[4];
#pragma unroll
        for (int q = 0; q < 4; ++q) sv_[q] = st2[q];
#pragma unroll 1
        for (int rep = 0; rep < (PROBE_DUP == 102 ? 2 : 1); ++rep) {
        if (PROBE_DUP == 102) {
#pragma unroll
            for (int q = 0; q < 4; ++q) st2[q] = sv_[q]; }
float ys[RW_TC];
#pragma unroll
        for (int step = 0; step < RW_TC; ++step) { const int tl = dir ? RW_TC - 1 - step : step; const float* V = sVec + tl * 320 + jq * 8;
            const float4 ka4 = *(const float4*)(V + 192), kb4 = *(const float4*)(V + 196);
            f32x2 acc = st2[0] * (f32x2){ka4.x, ka4.y}; acc = st2[1] * (f32x2){ka4.z, ka4.w} + acc; acc = st2[2] * (f32x2){kb4.x, kb4.y} + acc; acc = st2[3] * (f32x2){kb4.z, kb4.w} + acc;
            const float sa = -red8(acc.x + acc.y);
            const float vi = sV[tl * 32 + ri];
            const float4 wa = *(const float4*)(V + 64), wb = *(const float4*)(V + 68), ba = *(const float4*)(V + 256), bb = *(const float4*)(V + 260),
                         da = *(const float4*)(V + 128), db = *(const float4*)(V + 132), ra = *(const float4*)(V), rb = *(const float4*)(V + 4);
            const f32x2 sa2 = (f32x2){sa, sa}, vi2 = (f32x2){vi, vi};
            st2[0] = st2[0] * (f32x2){wa.x, wa.y} + (sa2 * (f32x2){ba.x, ba.y} + vi2 * (f32x2){da.x, da.y});
            st2[1] = st2[1] * (f32x2){wa.z, wa.w} + (sa2 * (f32x2){ba.z, ba.w} + vi2 * (f32x2){da.z, da.w});
            st2[2] = st2[2] * (f32x2){wb.x, wb.y} + (sa2 * (f32x2){bb.x, bb.y} + vi2 * (f32x2){db.x, db.y});
            st2[3] = st2[3] * (f32x2){wb.z, wb.w} + (sa2 * (f32x2){bb.z, bb.w} + vi2 * (f32x2){db.z, db.w});
            f32x2 ya = st2[0] * (f32x2){ra.x, ra.y}; ya = st2[1] * (f32x2){ra.z, ra.w} + ya; ya = st2[2] * (f32x2){rb.x, rb.y} + ya; ya = st2[3] * (f32x2){rb.z, rb.w} + ya;
            const float y = red8(ya.x + ya.y);
            ys[step] = y; }
        if (jq == 0) {
#pragma unroll
            for (int step = 0; step < RW_TC; ++step) sY[(dir ? RW_TC - 1 - step : step) * 32 + ri] = ys[step]; }
        }
        LDS_BARRIER();
        { float y0 = sY[otl * 32 + 2 * opr], y1 = sY[otl * 32 + 2 * opr + 1];
          if (second) { y0 += __uint_as_float(ov << 16); y1 += __uint_as_float(ov & 0xffff0000u); }
          *hb = pk2(y0, y1); }
    }
#pragma unroll
    for (int q = 0; q < 4; ++q) { st[2 * q] = st2[q].x; st[2 * q + 1] = st2[q].y; }
    if (ctx) { const int tid = opaque_tid(), ltid = tid & 255, ri = ltid >> 3, jq = ltid & 7;
        float* So = p.out + OUT_S + ((size_t)((bg * 2 + dir) * 8 + h)) * 4096 + (32 * rh + ri) * 64 + jq * 8;
#pragma unroll
        for (int q = 0; q < 8; ++q) So[q] = st[q]; }
    __syncthreads();
}

constexpr int RX_VEC = 0,
              RX_KR = RX_VEC + 16 * 320 * 4,
              RX_XW = RX_KR + 4096, RX_XA = RX_XW + 2304,
              RX_Y = RX_XA + 2304,
              RX_KT = RX_Y + 4096, RX_KTN = RX_KT + 2304, RX_RT = RX_KTN + 2304, RX_RTN = RX_RT + 2304, RX_BN = RX_RTN + 2304, RX_DN = RX_BN + 2304,
              RX_BTS = RX_DN + 2304, RX_DT = RX_BTS + 5120, RX_VT = RX_DT + 5120,
              RX_ADK = RX_VT + 5120, RX_ABR = RX_ADK + 1280, RX_ADR = RX_ABR + 1280, RX_TM = RX_ADR + 1280,
              RX_N = RX_TM + 1280,
              RX_PL = RX_N + 1088,
              RX_DIR = RX_PL + 256;
static_assert(2 * RX_DIR <= LDS_BYTES - 64 && RX_DIR % 16 == 0, "rwkv (chunked) lds");
__device__ __forceinline__ int perm_pi(int j) { const int jj = j & 31; return (j & 32) + 8 * ((jj & 15) >> 2) + (jj & 3) + 4 * (jj >> 4); }
__device__ __forceinline__ int perm_sg(int c) { return 8 * (c >> 2) + (c & 3); }
__device__ __forceinline__ bf16x8 pack_acc_lo(const f32x4 v) { union { uint4 u; bf16x8 b; } c; c.u = make_uint4(pk2(v[0], v[1]), pk2(v[2], v[3]), 0u, 0u); return c.b; }
__device__ __forceinline__ bf16x8 pack_acc2(const f32x4 a, const f32x4 b) { union { uint4 u; bf16x8 v; } c; c.u = make_uint4(pk2(a[0], a[1]), pk2(a[2], a[3]), pk2(b[0], b[1]), pk2(b[2], b[3])); return c.v; }

__device__ __forceinline__ void rwkv_task_w(const P& p, unsigned char* lds, int bg, int h) {
    const int wv = __builtin_amdgcn_readfirstlane((int)threadIdx.x >> 6), dir = wv >> 2, lw = wv & 3;
    const bool ctx = bg < 32; const int T = ctx ? 256 : 2048, nc = T / 16; const size_t row0 = ctx ? (size_t)bg * 256 : (size_t)NCTX + (size_t)(bg - 32) * 2048;
    unsigned char* L = lds + dir * RX_DIR;
    float* sVec = (float*)(L + RX_VEC); float* sKr = (float*)(L + RX_KR); bf16_t* sXw = (bf16_t*)(L + RX_XW); bf16_t* sXa = (bf16_t*)(L + RX_XA); float* sY = (float*)(L + RX_Y);
    bf16_t* sKT = (bf16_t*)(L + RX_KT); bf16_t* sKTn = (bf16_t*)(L + RX_KTN); bf16_t* sRT = (bf16_t*)(L + RX_RT); bf16_t* sRTn = (bf16_t*)(L + RX_RTN); bf16_t* sBn = (bf16_t*)(L + RX_BN); bf16_t* sDn = (bf16_t*)(L + RX_DN);
    bf16_t* sBts = (bf16_t*)(L + RX_BTS); bf16_t* sDt = (bf16_t*)(L + RX_DT); bf16_t* sVT = (bf16_t*)(L + RX_VT);
    bf16_t* sAdk = (bf16_t*)(L + RX_ADK); bf16_t* sAbr = (bf16_t*)(L + RX_ABR); bf16_t* sAdr = (bf16_t*)(L + RX_ADR); bf16_t* sTm = (bf16_t*)(L + RX_TM);
    float* sN = (float*)(L + RX_N); float* sPL = (float*)(L + RX_PL);
    const bf16_t* U = (const bf16_t*)(p.ws + WS_U); bf16_t* HB = (bf16_t*)(p.ws + WS_A);
    const int hc = h * 64;
    f32x4 ST[4]; bf16x8 wfrag[2], afrag[2]; float w0v, a0v, kav, kkc[8];
    {
        const int tid = opaque_tid(), ltid = tid & 255, fr = tid & 15, fq = (tid >> 4) & 3;
        __syncthreads();
        for (int i = ltid; i < (RX_N - RX_BTS) / 4; i += 256) ((unsigned*)(L + RX_BTS))[i] = 0u;
        __syncthreads();
        if (ctx) {
#pragma unroll
            for (int jt = 0; jt < 4; ++jt) ST[jt] = (f32x4){0.f, 0.f, 0.f, 0.f};
        } else { const float* S0 = p.sS + ((size_t)(((bg - 32) * 2 + dir) * 8 + h)) * 4096 + (16 * lw + fr) * 64 + 4 * fq;
#pragma unroll
            for (int jt = 0; jt < 4; ++jt) { const float4 t = *(const float4*)(S0 + 16 * jt); ST[jt] = (f32x4){t.x, t.y, t.z, t.w}; } }
        const int jcol = hc + 16 * lw + fr;
#pragma unroll
        for (int ks = 0; ks < 2; ++ks) { float wf[8], af[8];
#pragma unroll
            for (int i = 0; i < 8; ++i) { const int l = 32 * ks + 8 * fq + i; wf[i] = p.w2[(size_t)(dir * 64 + l) * 512 + jcol]; af[i] = p.a2[(size_t)(dir * 64 + l) * 512 + jcol]; }
            union { uint4 u; bf16x8 v; } c1, c2; c1.u = make_uint4(pk2(wf[0], wf[1]), pk2(wf[2], wf[3]), pk2(wf[4], wf[5]), pk2(wf[6], wf[7])); c2.u = make_uint4(pk2(af[0], af[1]), pk2(af[2], af[3]), pk2(af[4], af[5]), pk2(af[6], af[7]));
            wfrag[ks] = c1.v; afrag[ks] = c2.v; }
        w0v = p.w0[dir * 512 + jcol]; a0v = p.a0[dir * 512 + jcol]; kav = p.ka[jcol];
#pragma unroll
        for (int i = 0; i < 8; ++i) kkc[i] = p.kk[hc + 8 * (ltid & 7) + i];
    }
    uint4 q1, q2, q3, n1a, n2a, n3a, n1b, n2b, n3b;
    const char* Ub = (const char*)(U + row0 * UW);
#define RX_LOAD(d1, d2, d3, sidx) do { const int s_ = (sidx) < nc ? (sidx) : nc - 1; const int c_ = dir ? nc - 1 - s_ : s_; const int tok_ = c_ * 16 + ((ltid_ & 127) >> 3); const int g_ = ltid_ & 7; \
        d1 = *(const uint4*)(Ub + (tok_ * UW + (lw < 2 ? 2048 : 2048 + 512) + hc + 8 * g_) * 2); \
        d2 = *(const uint4*)(Ub + (tok_ * UW + (lw < 2 ? 2048 + 1536 : 2048 + 1664) + dir * 64 + 8 * g_) * 2); \
        d3 = *(const uint4*)(Ub + (tok_ * UW + 2048 + 1024 + hc + 8 * g_) * 2); } while (0)
    { const int ltid_ = opaque_tid() & 255; RX_LOAD(q1, q2, q3, 0); RX_LOAD(n1a, n2a, n3a, 1); RX_LOAD(n1b, n2b, n3b, 2); }
#pragma unroll 1
    for (int s = 0; s < nc; ++s) {
        const int c = dir ? nc - 1 - s : s; const int tok0 = c * 16;
        const bool second = s >= (nc >> 1);
        const int tid = opaque_tid(), ltid = tid & 255, fr = tid & 15, fq = (tid >> 4) & 3;
        { const int tl = (ltid & 127) >> 3, g = ltid & 7, q = dir ? 15 - tl : tl; float o[8];
          if (lw < 2) {
              unpack8(q1, o);
              *(float4*)(sVec + q * 320 + 8 * g) = make_float4(o[0], o[1], o[2], o[3]); *(float4*)(sVec + q * 320 + 8 * g + 4) = make_float4(o[4], o[5], o[6], o[7]);
              *(uint4*)(sXw + q * 72 + 8 * g) = q2;
              const unsigned vw[4] = {q3.x, q3.y, q3.z, q3.w};
#pragma unroll
              for (int i = 0; i < 8; ++i) sVT[(8 * g + i) * 40 + q] = (bf16_t)((vw[i >> 1] >> ((i & 1) * 16)) & 0xffffu);
          } else {
              unpack8(q1, o);
              float kkr[8]; float ss = 0.f;
#pragma unroll
              for (int i = 0; i < 8; ++i) { kkr[i] = o[i] * kkc[i]; ss += kkr[i] * kkr[i]; }
              ss = red8(ss); const float rn = __builtin_amdgcn_rsqf(fmaxf(ss, 1e-24f));
              *(float4*)(sKr + q * 64 + 8 * g) = make_float4(o[0], o[1], o[2], o[3]); *(float4*)(sKr + q * 64 + 8 * g + 4) = make_float4(o[4], o[5], o[6], o[7]);
              *(float4*)(sVec + q * 320 + 192 + 8 * g) = make_float4(kkr[0] * rn, kkr[1] * rn, kkr[2] * rn, kkr[3] * rn); *(float4*)(sVec + q * 320 + 192 + 8 * g + 4) = make_float4(kkr[4] * rn, kkr[5] * rn, kkr[6] * rn, kkr[7] * rn);
              *(uint4*)(sXa + q * 72 + 8 * g) = q2;
          } }
        LDS_BARRIER();
        { f32x4 aw = (f32x4){0.f, 0.f, 0.f, 0.f}, aa = (f32x4){0.f, 0.f, 0.f, 0.f};
#pragma unroll
          for (int ks = 0; ks < 2; ++ks) { const bf16x8 xw = *(const bf16x8*)(sXw + fr * 72 + 32 * ks + 8 * fq), xa = *(const bf16x8*)(sXa + fr * 72 + 32 * ks + 8 * fq);
              aw = mfma16(xw, wfrag[ks], aw); aa = mfma16(xa, afrag[ks], aa); }
          const int j = 16 * lw + fr;
          float lg[4], av[4]; float run = 0.f;
#pragma unroll
          for (int e = 0; e < 4; ++e) { const float lw_ = -fexp(-softplus_fast(-(w0v + aw[e])) - 0.5f); run += lw_; lg[e] = run; av[e] = sigmf(a0v + aa[e]); }
          float x = run; { const float y1 = __shfl_up(x, 16); if (fq >= 1) x += y1; const float y2 = __shfl_up(x, 32); if (fq >= 2) x += y2; }
          const float excl = x - run;
          const int pj = perm_pi(j); bf16_t btv[4], dtv[4];
          float Pp = fexp(excl);
#pragma unroll
          for (int e = 0; e < 4; ++e) { const int q = 4 * fq + e; const float Lq = excl + lg[e];
              const float Pq = fexp(Lq), iP = __builtin_amdgcn_rcpf(Pq);
              const float k = sKr[q * 64 + j], kn = sVec[q * 320 + 192 + j], r = sVec[q * 320 + j];
              const float kd = k * (1.f + (av[e] - 1.f) * kav), b = kn * av[e];
              const bf16_t kt = f2bf(Pp * kn), rt = f2bf(Pq * r), bt = f2bf(b * iP), dt = f2bf(kd * iP);
              sKT[q * 72 + pj] = kt; sRT[q * 72 + pj] = rt; sBn[q * 72 + pj] = bt; sDn[q * 72 + pj] = dt;
              btv[e] = bt; dtv[e] = dt;
              if (q == 15) sPL[j] = Pq;
              Pp = Pq; }
          *(uint2*)(sBts + j * 40 + 8 * fq) = make_uint2((unsigned)btv[0] | ((unsigned)btv[1] << 16), (unsigned)btv[2] | ((unsigned)btv[3] << 16));
          *(uint2*)(sDt + j * 40 + 4 * fq) = make_uint2((unsigned)dtv[0] | ((unsigned)dtv[1] << 16), (unsigned)dtv[2] | ((unsigned)dtv[3] << 16)); }
        if (s == (nc >> 1)) asm volatile("s_waitcnt vmcnt(0)" ::: "memory"); else asm volatile("s_waitcnt vmcnt(6)" ::: "memory");
        LDS_BARRIER();
        { const int role = (lw - dir) & 3;
          f32x4 gacc = (f32x4){0.f, 0.f, 0.f, 0.f}; const bf16_t* Ap = (role < 2) ? sKT : sRT; const bf16_t* Bp = (role & 1) ? sDn : sBn;
#pragma unroll
          for (int ks = 0; ks < 2; ++ks) gacc = mfma16(*(const bf16x8*)(Ap + fr * 72 + 32 * ks + 8 * fq), *(const bf16x8*)(Bp + fr * 72 + 32 * ks + 8 * fq), gacc);
          const int sidx = fr;
          float gm[4];
#pragma unroll
          for (int e = 0; e < 4; ++e) { const int q = 4 * fq + e; const bool keep = (role < 2) ? (sidx < q) : (sidx <= q); gm[e] = keep ? gacc[e] : 0.f; }
          if (role == 0) {
              const int r = tid & 15; float Tr[16];
#pragma unroll
              for (int q = 0; q < 16; ++q) Tr[q] = (r == q) ? 1.f : 0.f;
#pragma unroll
              for (int q = 0; q < 15; ++q) { const float tq = Tr[q];
#pragma unroll
                  for (int q2 = q + 1; q2 < 16; ++q2) { const float nv = __int_as_float(__builtin_amdgcn_readlane(__float_as_int(gm[q2 & 3]), q + 16 * (q2 >> 2))); Tr[q2] -= tq * nv; } }
              if ((tid & 63) < 16) { const int ps = perm_sg(r);
#pragma unroll
                  for (int q = 0; q < 16; ++q) sTm[q * 40 + ps] = f2bf(Tr[q]); }
          } else {
#pragma unroll
              for (int e = 0; e < 4; ++e) { const int q = 4 * fq + e;
                  if (role == 1) sAdk[q * 40 + sidx] = f2bf(gm[e]);
                  else if (role == 2) sAbr[q * 40 + perm_sg(sidx)] = f2bf(gm[e]);
                  else sAdr[q * 40 + sidx] = f2bf(gm[e]); } } }
        const int oq = ltid >> 4, otl = dir ? 15 - oq : oq; unsigned long long* hb = (unsigned long long*)(HB + (row0 + tok0 + otl) * DM + 512 + hc + 4 * (ltid & 15));
        const unsigned long long ov = __hip_atomic_load(hb, __ATOMIC_RELAXED, __HIP_MEMORY_SCOPE_AGENT);
        q1 = n1a; q2 = n2a; q3 = n3a; n1a = n1b; n2a = n2b; n3a = n3b;
        { const int ltid_ = ltid; RX_LOAD(n1b, n2b, n3b, s + 3); }
        LDS_BARRIER();
        { const bf16x8 Sb0 = pack_acc2(ST[0], ST[1]), Sb1 = pack_acc2(ST[2], ST[3]);
          const bf16x8 vtf = *(const bf16x8*)(sVT + (16 * lw + fr) * 40 + 8 * fq);
          f32x4 XT = (f32x4){0.f, 0.f, 0.f, 0.f};
          XT = mfma16(*(const bf16x8*)(sKT + fr * 72 + 8 * fq), Sb0, XT); XT = mfma16(*(const bf16x8*)(sKT + fr * 72 + 32 + 8 * fq), Sb1, XT);
          XT = mfma16(*(const bf16x8*)(sAdk + fr * 40 + 8 * fq), vtf, XT);
          f32x4 SAT = mfma16(*(const bf16x8*)(sTm + fr * 40 + 8 * fq), pack_acc_lo(XT), (f32x4){0.f, 0.f, 0.f, 0.f});
          SAT = -SAT;
          const bf16x8 SAb = pack_acc_lo(SAT);
          f32x4 YT = (f32x4){0.f, 0.f, 0.f, 0.f};
          YT = mfma16(*(const bf16x8*)(sRT + fr * 72 + 8 * fq), Sb0, YT); YT = mfma16(*(const bf16x8*)(sRT + fr * 72 + 32 + 8 * fq), Sb1, YT);
          YT = mfma16(*(const bf16x8*)(sAbr + fr * 40 + 8 * fq), SAb, YT); YT = mfma16(*(const bf16x8*)(sAdr + fr * 40 + 8 * fq), vtf, YT);
#pragma unroll
          for (int jt = 0; jt < 4; ++jt) { ST[jt] = mfma16(*(const bf16x8*)(sBts + (16 * jt + fr) * 40 + 8 * fq), SAb, ST[jt]); ST[jt] = mfma16(*(const bf16x8*)(sDt + (16 * jt + fr) * 40 + 8 * fq), vtf, ST[jt]);
              const float4 pl = *(const float4*)(sPL + 16 * jt + 4 * fq); ST[jt][0] *= pl.x; ST[jt][1] *= pl.y; ST[jt][2] *= pl.z; ST[jt][3] *= pl.w; }
#pragma unroll
          for (int e = 0; e < 4; ++e) sY[(4 * fq + e) * 64 + 16 * lw + fr] = YT[e]; }
        LDS_BARRIER();
        { const float4 y4 = *(const float4*)(sY + oq * 64 + 4 * (ltid & 15)); float y0 = y4.x, y1 = y4.y, y2 = y4.z, y3 = y4.w;
          if (second) { const unsigned lo = (unsigned)ov, hi = (unsigned)(ov >> 32); y0 += __uint_as_float(lo << 16); y1 += __uint_as_float(lo & 0xffff0000u); y2 += __uint_as_float(hi << 16); y3 += __uint_as_float(hi & 0xffff0000u); }
          *hb = (unsigned long long)pk2(y0, y1) | ((unsigned long long)pk2(y2, y3) << 32); }
    }
#undef RX_LOAD
    if (ctx) { const int tid = opaque_tid(), fr = tid & 15, fq = (tid >> 4) & 3;
        float* So = p.out + OUT_S + ((size_t)((bg * 2 + dir) * 8 + h)) * 4096 + (16 * lw + fr) * 64 + 4 * fq;
#pragma unroll
        for (int jt = 0; jt < 4; ++jt) *(float4*)(So + 16 * jt) = make_float4(ST[jt][0], ST[jt][1], ST[jt][2], ST[jt][3]); }
    __syncthreads();
}

constexpr int FZ_ROW = 1800;
constexpr int FZ_X = 0, FZ_MU = 32 * FZ_ROW * 2, FZ_END = FZ_MU + 4 * 1792 * 4;
static_assert(FZ_END <= LDS_BYTES && FZ_MU % 16 == 0, "finalize lds");

__device__ __forceinline__ void phase_rwkv_finalize(const P& p, unsigned char* lds) {
    bf16_t* sX = (bf16_t*)(lds + FZ_X); float* sMu = (float*)(lds + FZ_MU);
    const bf16_t* U = (const bf16_t*)(p.ws + WS_U); bf16_t* HB = (bf16_t*)(p.ws + WS_A);
    { const bf16_t* HB2 = (const bf16_t*)(p.ws + WS_HB2); const int tid0 = opaque_tid(), lane = tid0 & 63, wave = (int)threadIdx.x >> 6;
#pragma unroll 1
      for (int row = NCTX + blockIdx.x * 8 + wave; row < MT; row += gridDim.x * 8) {
          float hf[8], hb[8], og[8], v[8]; float ss = 0.f;
          unpack8(*(const uint4*)(HB + (size_t)row * DM + lane * 8), hf); unpack8(*(const uint4*)(HB2 + (size_t)(row - NCTX) * 512 + lane * 8), hb); unpack8(*(const uint4*)(U + (size_t)row * UW + 1536 + lane * 8), og);
#pragma unroll
          for (int i = 0; i < 8; ++i) { v[i] = sigmf(og[i]) * (hf[i] + hb[i]); ss += v[i] * v[i]; }
          ss = red16(ss); const float rms = rsqrtf(ss * (1.f / 128.f) + 1e-6f);
          const float4 g0 = *(const float4*)(p.hg + lane * 8), g1 = *(const float4*)(p.hg + lane * 8 + 4);
          *(uint4*)(HB + (size_t)row * DM + lane * 8) = make_uint4(pk2(v[0] * rms * g0.x, v[1] * rms * g0.y), pk2(v[2] * rms * g0.z, v[3] * rms * g0.w), pk2(v[4] * rms * g1.x, v[5] * rms * g1.y), pk2(v[6] * rms * g1.z, v[7] * rms * g1.w)); } }
    const bf16_t* A2 = (const bf16_t*)(p.ws + WS_A2BF); const bf16_t* G2 = (const bf16_t*)(p.ws + WS_G2BF);
    const int wv = __builtin_amdgcn_readfirstlane((int)threadIdx.x >> 6), hc = wv * 64;
#pragma unroll 1
    for (int tile = blockIdx.x; tile < MT / 32; tile += gridDim.x) {
        const int tid = opaque_tid(), fr = tid & 15, fq = (tid >> 4) & 3;
        const int rowt = tile * 32; const bool ctx = rowt < NCTX; const int T = ctx ? 256 : 2048; const size_t row0 = ctx ? (size_t)(rowt & ~255) : (size_t)NCTX + (size_t)((rowt - NCTX) & ~2047);
        const int tokt = rowt - (int)row0;
        __syncthreads();
#pragma unroll 2
        for (int it = 0; it < 14; ++it) { const int item = it * NTHR + tid, tl = item / 224, gi = item % 224;
            const int c0 = gi < 192 ? 2048 + 8 * gi : 2048 + 1664 + 8 * (gi - 192);
            *(uint4*)(sX + tl * FZ_ROW + 8 * gi) = *(const uint4*)(U + (row0 + tokt + tl) * UW + c0); }
        __syncthreads();
#pragma unroll 1
        for (int rt = 0; rt < 2; ++rt) {
            f32x4 af[4], ab[4], gg[4];
#pragma unroll
            for (int ct = 0; ct < 4; ++ct) { af[ct] = (f32x4){0.f, 0.f, 0.f, 0.f}; ab[ct] = af[ct]; gg[ct] = af[ct]; }
            const bf16_t* xr = sX + (16 * rt + fr) * FZ_ROW;
#pragma unroll
            for (int ks = 0; ks < 2; ++ks) { const bf16x8 xf = *(const bf16x8*)(xr + 1536 + 32 * ks + 8 * fq), xb = *(const bf16x8*)(xr + 1600 + 32 * ks + 8 * fq);
#pragma unroll
                for (int ct = 0; ct < 4; ++ct) { const int n = hc + 16 * ct + fr;
                    af[ct] = mfma16(xf, *(const bf16x8*)(A2 + (size_t)n * 64 + 32 * ks + 8 * fq), af[ct]);
                    ab[ct] = mfma16(xb, *(const bf16x8*)(A2 + (size_t)(512 + n) * 64 + 32 * ks + 8 * fq), ab[ct]); } }
#pragma unroll
            for (int ks = 0; ks < 4; ++ks) { const bf16x8 xg = *(const bf16x8*)(xr + 1664 + 32 * ks + 8 * fq);
#pragma unroll
                for (int ct = 0; ct < 4; ++ct) { const int n = hc + 16 * ct + fr; gg[ct] = mfma16(xg, *(const bf16x8*)(G2 + (size_t)n * 128 + 32 * ks + 8 * fq), gg[ct]); } }
#pragma unroll
            for (int jj = 0; jj < 4; ++jj) { const int tl = 16 * rt + 4 * fq + jj; const size_t row = (size_t)rowt + tl; const bf16_t* xt = sX + tl * FZ_ROW;
                bf16_t* hb = HB + row * DM + 512 + hc;
                float y[4], vv[4]; float sy = 0.f, sb = 0.f;
#pragma unroll
                for (int ct = 0; ct < 4; ++ct) { const int ch = hc + 16 * ct + fr;
                    const float am = 0.5f * (sigmf(p.a0[ch] + af[ct][jj]) + sigmf(p.a0[512 + ch] + ab[ct][jj]));
                    const float r = bf2f(xt[ch]), k = bf2f(xt[512 + ch]); vv[ct] = bf2f(xt[1024 + ch]);
                    sb += r * k * (1.f + (am - 1.f) * p.ka[ch]) * p.rk[ch];
                    y[ct] = bf2f(hb[16 * ct + fr]); sy += y[ct]; }
                sy = red16(sy); sb = red16(sb);
                const float mean = sy * (1.f / 64.f); float vs = 0.f;
#pragma unroll
                for (int ct = 0; ct < 4; ++ct) { const float d = y[ct] - mean; vs += d * d; }
                vs = red16(vs); const float rstd = rsqrtf(vs * (1.f / 64.f) + 64e-5f);
#pragma unroll
                for (int ct = 0; ct < 4; ++ct) { const int ch = hc + 16 * ct + fr; const float yn = (y[ct] - mean) * rstd * p.lng[ch] + p.lnb[ch];
                    hb[16 * ct + fr] = f2bf((yn + sb * vv[ct]) * gg[ct][jj]); } }
        }
    }
}

__device__ __forceinline__ void phase_scan(const P& p, unsigned char* lds, int round = 0) {
    unsigned* ctr = (unsigned*)(p.ws + WS_CTR) + round;
    volatile int* sTask = (volatile int*)(lds + LDS_BYTES - 16);
#pragma unroll 1
    for (;;) {
        __syncthreads();
        if (threadIdx.x == 0) *sTask = (int)atomicAdd(ctr, 1u);
        __syncthreads();
        const int t = __builtin_amdgcn_readfirstlane(*sTask);
        if (t >= 512) break;
#pragma unroll 1
        for (int rep = 0; rep < ((PROBE_DUP == 100 && (t < 64 || (t >= 128 && t < 256))) || (PROBE_DUP == 101 && !(t < 64 || (t >= 128 && t < 256))) ? 2 : 1); ++rep) {
        if (t < 64) mlstm_task(p, lds, 32 + (t >> 3), (t >> 1) & 3, t & 1);
        else if (t < 128) { const int q = t - 64; rwkv_task_w(p, lds, 32 + (q >> 3), q & 7); }
        else if (t < 256) { const int q = t - 128; mlstm_task(p, lds, q >> 2, q & 3, -1); }
        else { const int q = t - 256; rwkv_task_w(p, lds, q >> 3, q & 7); }
        }
    }
}

__device__ void phase_convert_w2(const P& p, unsigned char* lds) {
    float* tile = (float*)lds;
    const int t1 = 16 * 88, t2 = 44 * 16;
    const int nb = gridDim.x, lo = nb > 128 ? 128 : 0;
    if ((int)blockIdx.x < lo) return;
    for (int it = blockIdx.x - lo; it < t1 + t2; it += nb - lo) {
        if (it < t1) do_convert(p.w2in, (bf16_t*)(p.ws + WS_W1), 1024, 5632, 5632, 1, it, tile);
        else do_convert(p.w2out, (bf16_t*)(p.ws + WS_W1B), 2816, 1024, 1024, 0, it - t1, tile);
    }
}

#define XB_TMO      128
#define XB_XCNT(j)  (256  + 64 * (j))
#define XB_XSUB(j)  (1280 + 64 * (j))
#define XB_XGEN(j)  (2304 + 64 * (j))
#define XB_TOP      3328
#define XB_TOPGEN   3392
#define XCD_BAR_WORDS 3456
#define XB_SPIN_CAP (1u << 18)
__device__ __forceinline__ unsigned xb_ld(unsigned* p)              { return __hip_atomic_load(p, __ATOMIC_RELAXED, __HIP_MEMORY_SCOPE_AGENT); }
__device__ __forceinline__ unsigned xb_add(unsigned* p, unsigned v) { return __hip_atomic_fetch_add(p, v, __ATOMIC_RELAXED, __HIP_MEMORY_SCOPE_AGENT); }
__device__ __forceinline__ unsigned xb_xcc_id() { return (unsigned)__builtin_amdgcn_s_getreg((3 << 11) | 20) & 0xFu; }
#define XB_SPIN(cond, bar) do { unsigned _sp = 0; while (cond) { __builtin_amdgcn_s_sleep(1); \
    if ((++_sp & 255u) == 0u) { if (xb_ld(&(bar)[XB_TMO])) break; if (_sp > XB_SPIN_CAP) { atomicAdd(&(bar)[XB_TMO], 1u); break; } } } } while (0)
struct XcdBarrier { unsigned* bar; unsigned x; volatile unsigned* st; };
__device__ __forceinline__ XcdBarrier xcd_barrier_post(unsigned* bar, volatile unsigned* st) {
    XcdBarrier b; b.bar = bar; b.x = xb_xcc_id(); b.st = st;
    if (threadIdx.x == 0) (void)xb_add(&bar[XB_XCNT(b.x)], 1u);
    return b;
}
__device__ __forceinline__ void xcd_barrier_complete(unsigned* bar, unsigned x, unsigned& nloc, unsigned& nx) {
    const unsigned G = gridDim.x * gridDim.y * gridDim.z;
    unsigned sum, cnt, mine, sp = 0u;
    for (;;) {
        sum = 0u; cnt = 0u; mine = 0u;
#pragma unroll
        for (unsigned j = 0; j < 16; ++j) { const unsigned c = xb_ld(&bar[XB_XCNT(j)]); sum += c; cnt += (c > 0u) ? 1u : 0u; mine = (j == x) ? c : mine; }
        if (sum == G) break;
        __builtin_amdgcn_s_sleep(1);
        if ((++sp & 255u) == 0u) { if (xb_ld(&bar[XB_TMO])) break; if (sp > XB_SPIN_CAP) { atomicAdd(&bar[XB_TMO], 1u); break; } }
    }
    nloc = mine > 0u ? mine : 1u; nx = cnt > 0u ? cnt : 1u;
}
__device__ __forceinline__ void xcd_barrier(const XcdBarrier& b) {
    asm volatile("s_waitcnt vmcnt(0)" ::: "memory");
    __syncthreads();
    if (threadIdx.x == 0) {
        unsigned* bar = b.bar;
        __builtin_amdgcn_s_waitcnt(0);
        unsigned nloc = b.st[0], nx = b.st[1];
        if (nloc == 0u) { xcd_barrier_complete(bar, b.x, nloc, nx); b.st[0] = nloc; b.st[1] = nx; }
        const unsigned old = xb_add(&bar[XB_XSUB(b.x)], 1u);
        const unsigned gen = old / nloc;
        if (old + 1u == (gen + 1u) * nloc) {
            __builtin_amdgcn_fence(__ATOMIC_RELEASE, "agent");
            asm volatile("s_waitcnt vmcnt(0)" ::: "memory");
            const unsigned og = xb_add(&bar[XB_TOP], 1u);
            const unsigned tg = og / nx;
            if (og + 1u == (tg + 1u) * nx) xb_add(&bar[XB_TOPGEN], 1u);
            else XB_SPIN(xb_ld(&bar[XB_TOPGEN]) == tg, bar);
            __builtin_amdgcn_fence(__ATOMIC_ACQUIRE, "agent");
            xb_add(&bar[XB_XGEN(b.x)], 1u);
            asm volatile("s_waitcnt vmcnt(0)" ::: "memory");
        } else {
            XB_SPIN(xb_ld(&bar[XB_XGEN(b.x)]) == gen, bar);
            __builtin_amdgcn_fence(__ATOMIC_ACQUIRE, "agent");
            asm volatile("s_waitcnt vmcnt(0)" ::: "memory");
        }
    }
    __syncthreads();
}

constexpr int NPHASE = 12;
template <int PH>
__device__ __forceinline__ void run_phase(const P& p, unsigned char* lds) {
    const float* mod = (const float*)(p.ws + WS_MOD);
    if constexpr (PH == 0) phase0(p, lds);
    if constexpr (PH == 1) phase_normmod(p, 0);
    if constexpr (PH == 2) { EpiSwiglu E{(bf16_t*)(p.ws + WS_U)}; run_gemm(lds, (const bf16_t*)(p.ws + WS_A), (const bf16_t*)(p.ws + WS_W1), 5632, 1024, E); }
    if constexpr (PH == 3) { EpiResid E{p.xp, p.xs, p.out, mod + 2048, 0.5f, 0}; run_gemm(lds, (const bf16_t*)(p.ws + WS_U), (const bf16_t*)(p.ws + WS_W1B), 1024, 2816, E); }
    if constexpr (PH == 4) phase_normmod(p, 1);
    if constexpr (PH == 5) { EpiU E{(bf16_t*)(p.ws + WS_U), (float*)(p.ws + WS_GATES)}; run_gemm(lds, (const bf16_t*)(p.ws + WS_A), (const bf16_t*)(p.ws + WS_BT3), 4096, 1024, E); }
    if constexpr (PH == 6) phase_scan(p, lds);
    if constexpr (PH == 12) phase_rwkv_finalize(p, lds);
    if constexpr (PH == 13) phase_shift((bf16_t*)(p.ws + WS_U), p.mu, (uint4*)lds);
    if constexpr (PH == 7) { EpiResid E{p.xp, p.xs, p.out, mod + 5120, 1.0f, 1}; run_gemm(lds, (const bf16_t*)(p.ws + WS_A), (const bf16_t*)(p.ws + WS_BT4), 1024, 1024, E); phase_convert_w2(p, lds); }
    if constexpr (PH == 8) phase_normmod(p, 2);
    if constexpr (PH == 9) { EpiSwiglu E{(bf16_t*)(p.ws + WS_U)}; run_gemm(lds, (const bf16_t*)(p.ws + WS_A), (const bf16_t*)(p.ws + WS_W1), 5632, 1024, E); }
    if constexpr (PH == 10) { EpiResid E{p.xp, p.xs, p.out, mod + 8192, 0.5f, 1}; run_gemm(lds, (const bf16_t*)(p.ws + WS_U), (const bf16_t*)(p.ws + WS_W1B), 1024, 2816, E); }
    if constexpr (PH == 11) phase_finalnorm(p);
}

#if !ONE_LAUNCH
template <int PH>
__global__ void __launch_bounds__(NTHR, 2) k_phase(P p) {
    extern __shared__ __attribute__((aligned(16))) unsigned char lds[];
    run_phase<PH>(p, lds);
}
#endif

#if ONE_LAUNCH
__global__ void __launch_bounds__(NTHR, 2) k_mega(P p) {
    extern __shared__ __attribute__((aligned(16))) unsigned char lds[];
    cg::grid_group grid = cg::this_grid();
    volatile unsigned* xst = (volatile unsigned*)(lds + LDS_BYTES - 32);
    if (threadIdx.x == 0) { xst[0] = 0u; xst[1] = 0u; }
    __syncthreads();
    const XcdBarrier xbar = xcd_barrier_post((unsigned*)(p.ws + WS_BAR), xst);
#define GSYNC() xcd_barrier(xbar)
    if (p.ws == nullptr) grid.sync();
    run_phase<0>(p, lds); GSYNC();
    if (PROBE_DUP == 0) { run_phase<0>(p, lds); GSYNC(); }
    run_phase<1>(p, lds); GSYNC();
    if (PROBE_DUP == 1) { run_phase<1>(p, lds); GSYNC(); }
    run_phase<2>(p, lds); GSYNC();
    if (PROBE_DUP == 2 || PROBE_DUP == 235) { run_phase<2>(p, lds); GSYNC(); }
    run_phase<3>(p, lds); GSYNC();
    if (PROBE_DUP == 3 || PROBE_DUP == 235) { run_phase<3>(p, lds); GSYNC(); }
    run_phase<4>(p, lds); GSYNC();
    if (PROBE_DUP == 4) { run_phase<4>(p, lds); GSYNC(); }
    run_phase<5>(p, lds); GSYNC();
    if (PROBE_DUP == 5 || PROBE_DUP == 235) { run_phase<5>(p, lds); GSYNC(); }
    run_phase<13>(p, lds); GSYNC();
    run_phase<6>(p, lds); GSYNC();
    if (PROBE_DUP == 6) { phase_scan(p, lds, 1); GSYNC(); }
    run_phase<12>(p, lds); GSYNC();
    run_phase<7>(p, lds); GSYNC();
    if (PROBE_DUP == 7) { run_phase<7>(p, lds); GSYNC(); }
    run_phase<8>(p, lds); GSYNC();
    if (PROBE_DUP == 8) { run_phase<8>(p, lds); GSYNC(); }
    run_phase<9>(p, lds); GSYNC();
    if (PROBE_DUP == 9) { run_phase<9>(p, lds); GSYNC(); }
    run_phase<10>(p, lds); GSYNC();
    if (PROBE_DUP == 10) { run_phase<10>(p, lds); GSYNC(); }
    run_phase<11>(p, lds);
    if (PROBE_DUP == 200) { for (int i = 0; i < 20; ++i) GSYNC(); }
}
#endif

#if !ONE_LAUNCH
template <int PH> static void launch_phase(const P& p, int grid, hipStream_t stream) {
    static bool attr = false;
    if (!attr) { (void)hipFuncSetAttribute((const void*)k_phase<PH>, hipFuncAttributeMaxDynamicSharedMemorySize, LDS_BYTES); attr = true; }
    hipLaunchKernelGGL(k_phase<PH>, dim3(grid), dim3(NTHR), LDS_BYTES, stream, p);
}
#endif

extern "C" void kernel_launch(void* const* d_in, const int* in_sizes, int n_in, void* d_out, int out_size, void* d_ws, size_t ws_size, hipStream_t stream) {
    (void)in_sizes; (void)n_in; (void)out_size; (void)ws_size;
    static int grid = 0;
    if (grid == 0) {
        int dev = 0, cus = 0;
        if (hipGetDevice(&dev) != hipSuccess || hipDeviceGetAttribute(&cus, hipDeviceAttributeMultiprocessorCount, dev) != hipSuccess || cus <= 0) cus = 256;
#if ONE_LAUNCH
        (void)hipFuncSetAttribute((const void*)k_mega, hipFuncAttributeMaxDynamicSharedMemorySize, LDS_BYTES);
        int per_cu = 0;
        if (hipOccupancyMaxActiveBlocksPerMultiprocessor(&per_cu, (const void*)k_mega, NTHR, LDS_BYTES) != hipSuccess || per_cu < 1) per_cu = 1;
        (void)hipGetLastError();
#endif
        grid = cus;
    }
    P p{};
    const float** f = (const float**)&p;
    for (int i = 0; i < 35; ++i) f[i] = (const float*)d_in[i];
    p.out = (float*)d_out; p.ws = (unsigned char*)d_ws;
    (void)hipMemsetAsync((char*)d_ws + WS_MOD, 0, NCOND * MODW * sizeof(float) + 256 + 3456 * 4, stream);
#if ONE_LAUNCH
    void* args[] = {&p};
    hipError_t e = hipLaunchCooperativeKernel((const void*)k_mega, dim3(grid), dim3(NTHR), args, LDS_BYTES, stream);
    if (e != hipSuccess) fprintf(stderr, "cooperative launch failed: %s (grid %d)\n", hipGetErrorString(e), grid);
#else
    launch_phase<0>(p, grid, stream); launch_phase<1>(p, grid, stream); launch_phase<2>(p, grid, stream); launch_phase<3>(p, grid, stream);
    launch_phase<4>(p, grid, stream); launch_phase<5>(p, grid, stream); launch_phase<13>(p, grid, stream); launch_phase<6>(p, grid, stream); launch_phase<12>(p, grid, stream); launch_phase<7>(p, grid, stream);
    launch_phase<8>(p, grid, stream); launch_phase<9>(p, grid, stream); launch_phase<10>(p, grid, stream); launch_phase<11>(p, grid, stream);
#endif
}
```

```cpp
#include <hip/hip_runtime.h>
#include <hip/hip_cooperative_groups.h>
#include <cstdio>
#include <cstdint>
namespace cg = cooperative_groups;

#ifndef PROBE_DUP
#define PROBE_DUP -1
#endif
#ifndef ONE_LAUNCH
#define ONE_LAUNCH 1
#endif

#define LDS_BARRIER() do { asm volatile("s_waitcnt lgkmcnt(0)" ::: "memory"); __builtin_amdgcn_s_barrier(); asm volatile("" ::: "memory"); } while (0)
__device__ __forceinline__ int opaque_tid() { int z = 0; asm volatile("" : "+v"(z)); return (int)threadIdx.x + z; }

namespace pg8 {
#define PG8_LAS __attribute__((address_space(3)))
typedef unsigned short bf16_t;
typedef short bf16x8 __attribute__((ext_vector_type(8)));
typedef float f32x4 __attribute__((ext_vector_type(4)));
typedef unsigned u32x4 __attribute__((ext_vector_type(4)));
constexpr int BM = 256, BK = 64, HALF = 128, HTB = HALF * BK * 2, STAGE_BYTES = 8 * HTB, NXCD = 8, WGM = 8;

__host__ __device__ __forceinline__ int lds_byte(int r, int c) { const int st = (r >> 4) * 2 + (c >> 5), rr = r & 15, cc = c & 31, ob = rr * 64 + cc * 2; return st * 1024 + (ob ^ (((ob >> 9) & 1) << 5)); }
__host__ __device__ __forceinline__ void stage_rc(int b, int& R, int& C) { const int st = b / 1024, sb = b % 1024, swz = sb ^ (((sb >> 9) & 1) << 5); R = (st >> 1) * 16 + swz / 64; C = (st & 1) * 32 + (swz % 64) / 2; }
__host__ __device__ __forceinline__ int perm32(int rho) { const int n = rho >> 4, i = rho & 15; return 8 * (i >> 2) + 4 * n + (i & 3); }

struct Unit { int pm, pn; };
struct Gemm { const bf16_t* A; const bf16_t* Bt; int M, N, K; };

struct StaticOrder {
    int nM, nN, nwg, G, c;
    __host__ __device__ void init(int M, int N, int G_, int c_) { nM = M / BM; nN = N / BM; nwg = nM * nN; G = G_; c = c_; }
    __host__ __device__ bool next(int i, Unit& u) const {
        const long L = (long)i * G + c; if (L >= nwg) return false;
        int wgid = (int)L; { const int q = nwg / NXCD, r = nwg % NXCD, xcd = wgid % NXCD, off = wgid / NXCD; wgid = (xcd < r ? xcd * (q + 1) : r * (q + 1) + (xcd - r) * q) + off; }
        const int nig = WGM * nN, gid = wgid / nig, fm = gid * WGM, gsz = (nM - fm) < WGM ? (nM - fm) : WGM;
        u.pm = fm + ((wgid % nig) % gsz); u.pn = (wgid % nig) / gsz; return true;
    }
    __device__ __forceinline__ void a_ready(const Unit&) const {}
    __device__ __forceinline__ void done(const Unit&) const {}
};

__device__ __forceinline__ unsigned cvt_pk_bf16(float lo, float hi) { unsigned r; asm volatile("v_cvt_pk_bf16_f32 %0, %1, %2" : "=v"(r) : "v"(lo), "v"(hi)); return r; }

template <class Epi, class Sched, bool ALIGN_EPI = false, bool SP2 = false>
__device__ __forceinline__ void gemm_phase(PG8_LAS unsigned char* lds, const Gemm g, const Sched& S, const Epi& E) {
    const int tid = opaque_tid(), wid = __builtin_amdgcn_readfirstlane((int)threadIdx.x >> 6), lane = tid & 63, wr = wid >> 2, wc = wid & 3, fr = lane & 15, fq = lane >> 4;
    const int K = g.K, nt = K / BK;
    unsigned voffA[2], voffB[2];
#pragma unroll
    for (int i = 0; i < 2; ++i) { int R, C; stage_rc(tid * 16 + i * 8192, R, C); const int Rb = Epi::PERM ? ((R & ~31) + perm32(R & 31)) : R;
        voffA[i] = (unsigned)(R * K + C) * 2u; voffB[i] = (unsigned)(Rb * K + C) * 2u; }
    const size_t kstep = (size_t)(BK * 2);
    const size_t hstep = (size_t)HALF * K * 2;
    const size_t tstep = 2 * hstep;
    const unsigned ldsw = (unsigned)wid * 1024u;
    const int aoff = lds_byte(wr * 64 + fr, fq * 8), boff = lds_byte(wc * 32 + fr, fq * 8);
#define PG8_SA(b, h) (((b) * 2 + (h)) * HTB)
#define PG8_SB(b, h) ((4 + (b) * 2 + (h)) * HTB)
#define PG8_STAGE(bufoff, gbase, voff) do { _Pragma("unroll") for (int _i = 0; _i < 2; ++_i) \
        __builtin_amdgcn_global_load_lds((const unsigned*)((const char*)(gbase) + (voff)[_i]), (PG8_LAS unsigned*)(lds + (bufoff) + ldsw + _i * 8192), 16, 0, 0); } while (0)
#define PG8_LDA(dst, b, h) do { _Pragma("unroll") for (int m = 0; m < 4; ++m) _Pragma("unroll") for (int k = 0; k < 2; ++k) dst[m][k] = *(const PG8_LAS bf16x8*)(lds + PG8_SA(b, h) + aoff + m * 2048 + k * 1024); } while (0)
#define PG8_LDB(dst, b, h) do { _Pragma("unroll") for (int n = 0; n < 2; ++n) _Pragma("unroll") for (int k = 0; k < 2; ++k) dst[n][k] = *(const PG8_LAS bf16x8*)(lds + PG8_SB(b, h) + boff + n * 2048 + k * 1024); } while (0)
#define PG8_MMA(ai, bj, At, Bt) do { __builtin_amdgcn_s_setprio(1); _Pragma("unroll") for (int m = 0; m < 4; ++m) _Pragma("unroll") for (int n = 0; n < 2; ++n) _Pragma("unroll") for (int k = 0; k < 2; ++k) \
        acc[ai][bj][m][n] = __builtin_amdgcn_mfma_f32_16x16x32_bf16(Bt[n][k], At[m][k], acc[ai][bj][m][n], 0, 0, 0); __builtin_amdgcn_s_setprio(0); } while (0)
#define PG8_WAIT_V(n) asm volatile("s_waitcnt vmcnt(" #n ")" ::: "memory")
#define PG8_WAIT_L(n) asm volatile("s_waitcnt lgkmcnt(" #n ")" ::: "memory")
#define PG8_BAR __builtin_amdgcn_s_barrier()
#define PG8_SCHED __builtin_amdgcn_sched_barrier(0)
    Unit cur, nxt; int ui = 0;
    if (!S.next(0, cur)) return;
    f32x4 acc[2][2][4][2];
#pragma unroll
    for (int a = 0; a < 2; ++a)
#pragma unroll
        for (int b = 0; b < 2; ++b)
#pragma unroll
            for (int m = 0; m < 4; ++m)
#pragma unroll
                for (int n = 0; n < 2; ++n) acc[a][b][m][n] = (f32x4){0.f, 0.f, 0.f, 0.f};
    bf16x8 At[4][2], B0[2][2], B1[2][2];
    const char* cA = (const char*)g.A + (size_t)cur.pm * tstep; const char* cB = (const char*)g.Bt + (size_t)cur.pn * tstep;
    S.a_ready(cur);
    if constexpr (SP2) {
        PG8_STAGE(PG8_SB(0, 0), cB, voffB); PG8_STAGE(PG8_SB(0, 1), cB + hstep, voffB); PG8_STAGE(PG8_SA(0, 0), cA, voffA); PG8_STAGE(PG8_SA(0, 1), cA + hstep, voffA);
        if (wr == 1) PG8_BAR;
        PG8_WAIT_V(2); PG8_BAR;
        PG8_STAGE(PG8_SB(1, 0), cB + kstep, voffB); PG8_STAGE(PG8_SA(1, 0), cA + kstep, voffA); PG8_STAGE(PG8_SB(1, 1), cB + hstep + kstep, voffB);
        PG8_WAIT_V(6); PG8_BAR;
    } else {
        PG8_STAGE(PG8_SB(0, 0), cB, voffB); PG8_STAGE(PG8_SA(0, 0), cA, voffA); PG8_STAGE(PG8_SB(0, 1), cB + hstep, voffB); PG8_STAGE(PG8_SA(0, 1), cA + hstep, voffA);
        if (wr == 1) PG8_BAR;
        PG8_WAIT_V(4); PG8_BAR;
        PG8_STAGE(PG8_SB(1, 0), cB + kstep, voffB); PG8_STAGE(PG8_SA(1, 0), cA + kstep, voffA); PG8_STAGE(PG8_SB(1, 1), cB + hstep + kstep, voffB);
        PG8_WAIT_V(6); PG8_BAR;
    }
    for (;;) {
        const bool has_next = S.next(ui + 1, nxt);
        const char* nA = has_next ? (const char*)g.A + (size_t)nxt.pm * tstep : cA; const char* nB = has_next ? (const char*)g.Bt + (size_t)nxt.pn * tstep : cB;
        for (int t = 0; t < nt; t += 2) {
            const bool last = (t == nt - 2);
            const char* a1 = cA + (size_t)(t + 1) * kstep;
            const char* a2 = last ? nA : cA + (size_t)(t + 2) * kstep; const char* b2 = last ? nB : cB + (size_t)(t + 2) * kstep;
            const char* a3 = a2 + kstep; const char* b3 = b2 + kstep;
            if (last && has_next) S.a_ready(nxt);
            if constexpr (SP2) {
            PG8_LDB(B0, 0, 0); PG8_LDB(B1, 0, 1); PG8_SCHED; PG8_LDA(At, 0, 0); PG8_STAGE(PG8_SA(1, 1), a1 + hstep, voffA);
            PG8_WAIT_V(8); PG8_WAIT_L(0); PG8_BAR; PG8_MMA(0, 0, At, B0); PG8_MMA(0, 1, At, B1); PG8_BAR; PG8_SCHED;
            PG8_LDA(At, 0, 1); PG8_STAGE(PG8_SB(0, 0), b2, voffB); PG8_STAGE(PG8_SB(0, 1), b2 + hstep, voffB); PG8_STAGE(PG8_SA(0, 0), a2, voffA);
            PG8_WAIT_V(8); PG8_WAIT_L(0); PG8_BAR; PG8_MMA(1, 0, At, B0); PG8_MMA(1, 1, At, B1); PG8_BAR; PG8_SCHED;
            PG8_LDB(B0, 1, 0); PG8_LDB(B1, 1, 1); PG8_SCHED; PG8_LDA(At, 1, 0); PG8_STAGE(PG8_SA(0, 1), a2 + hstep, voffA);
            PG8_WAIT_V(8); PG8_WAIT_L(0); PG8_BAR; PG8_MMA(0, 0, At, B0); PG8_MMA(0, 1, At, B1); PG8_BAR; PG8_SCHED;
            PG8_LDA(At, 1, 1); PG8_STAGE(PG8_SB(1, 0), b3, voffB); PG8_STAGE(PG8_SB(1, 1), b3 + hstep, voffB); PG8_STAGE(PG8_SA(1, 0), a3, voffA);
            PG8_WAIT_V(8); PG8_WAIT_L(0); PG8_BAR; PG8_MMA(1, 0, At, B0); PG8_MMA(1, 1, At, B1); PG8_BAR; PG8_SCHED;
            } else {
            PG8_LDB(B0, 0, 0); PG8_SCHED; PG8_LDA(At, 0, 0); PG8_STAGE(PG8_SA(1, 1), a1 + hstep, voffA);
            PG8_WAIT_L(8); PG8_BAR; PG8_WAIT_L(0); PG8_MMA(0, 0, At, B0); PG8_BAR; PG8_SCHED;
            PG8_LDB(B1, 0, 1); PG8_STAGE(PG8_SB(0, 0), b2, voffB);
            PG8_BAR; PG8_WAIT_L(0); PG8_MMA(0, 1, At, B1); PG8_BAR;
            PG8_LDA(At, 0, 1); PG8_STAGE(PG8_SA(0, 0), a2, voffA);
            PG8_BAR; PG8_WAIT_L(0); PG8_MMA(1, 0, At, B0); PG8_BAR; PG8_SCHED;
            PG8_STAGE(PG8_SB(0, 1), b2 + hstep, voffB);
            PG8_WAIT_V(6); PG8_BAR; PG8_MMA(1, 1, At, B1); PG8_BAR;
            PG8_LDB(B0, 1, 0); PG8_SCHED; PG8_LDA(At, 1, 0); PG8_STAGE(PG8_SA(0, 1), a2 + hstep, voffA);
            PG8_WAIT_L(8); PG8_BAR; PG8_WAIT_L(0); PG8_MMA(0, 0, At, B0); PG8_BAR; PG8_SCHED;
            PG8_LDB(B1, 1, 1); PG8_STAGE(PG8_SB(1, 0), b3, voffB);
            PG8_BAR; PG8_WAIT_L(0); PG8_MMA(0, 1, At, B1); PG8_BAR;
            PG8_LDA(At, 1, 1); PG8_STAGE(PG8_SA(1, 0), a3, voffA);
            PG8_BAR; PG8_WAIT_L(0); PG8_MMA(1, 0, At, B0); PG8_BAR; PG8_SCHED;
            PG8_STAGE(PG8_SB(1, 1), b3 + hstep, voffB);
            PG8_WAIT_V(6); PG8_BAR; PG8_MMA(1, 1, At, B1); PG8_BAR;
            }
        }
        if constexpr (ALIGN_EPI) { if (wr == 0) PG8_BAR; }
        E(acc, cur, wr, wc, fr, fq); S.done(cur);
        if (!has_next) break;
#pragma unroll
        for (int a = 0; a < 2; ++a)
#pragma unroll
            for (int b = 0; b < 2; ++b)
#pragma unroll
                for (int m = 0; m < 4; ++m)
#pragma unroll
                    for (int n = 0; n < 2; ++n) acc[a][b][m][n] = (f32x4){0.f, 0.f, 0.f, 0.f};
        cur = nxt; cA = nA; cB = nB; ++ui;
        if constexpr (ALIGN_EPI) { if (wr == 1) PG8_BAR; }
    }
    PG8_WAIT_V(0);
    if constexpr (!ALIGN_EPI) { if (wr == 0) PG8_BAR; }
    PG8_BAR;
#undef PG8_SA
#undef PG8_SB
#undef PG8_STAGE
#undef PG8_LDA
#undef PG8_LDB
#undef PG8_MMA
#undef PG8_WAIT_V
#undef PG8_WAIT_L
#undef PG8_BAR
#undef PG8_SCHED
}
}

using pg8::bf16_t; using pg8::bf16x8; using pg8::f32x4;

constexpr int MT = 24576, DM = 1024, DFF = 2816, NCTX = 8192;
constexpr int UW = 3984;
constexpr int NCOND = 9, MODW = 9216;
constexpr size_t MiB = 1ull << 20;
constexpr size_t WS_A = 0, WS_U = 48 * MiB, WS_W1 = WS_U + 132 * MiB, WS_W1B = WS_W1 + (size_t)5632 * 1024 * 2,
                 WS_BT3 = 235 * MiB, WS_HB2 = 235 * MiB  ,
                 WS_BT4 = 251 * MiB, WS_MOD = 253 * MiB, WS_CTR = WS_MOD + 9 * 9216 * 4  , WS_BAR = WS_CTR + 256  , WS_GATES = 254 * MiB;
constexpr size_t WS_A2BF = 255 * MiB + 512 * 1024, WS_G2BF = WS_A2BF + 2 * 512 * 64 * 2;
constexpr int OUT_C = 25165824, OUT_N = 29360128, OUT_MM = 29392896, OUT_S = 29393152;
constexpr int LDS_BYTES = 163840;
constexpr int NTHR = 512;

struct P {
    const float *xp, *xs, *c, *sC, *sn, *sm, *sS, *cctx, *ada_w, *ada_b, *n1, *w1in, *w1out, *nmix, *wmin, *wmout,
        *cw, *cb, *gb, *hg, *mu, *w0, *w2, *a0, *a2, *g2, *kk, *ka, *rk, *lng, *lnb, *n2, *w2in, *w2out, *nf;
    float* out; unsigned char* ws;
};

typedef __bf16 hwbf16x2 __attribute__((ext_vector_type(2)));
typedef float hwf32x2 __attribute__((ext_vector_type(2)));
__device__ __forceinline__ unsigned pk2(float a, float b) { const hwf32x2 v = {a, b}; const hwbf16x2 r = __builtin_convertvector(v, hwbf16x2); return __builtin_bit_cast(unsigned, r); }
__device__ __forceinline__ unsigned short f2bf(float f) { return (unsigned short)(pk2(f, f) & 0xffffu); }
__device__ __forceinline__ float bf2f(unsigned short b) { return __uint_as_float(((unsigned)b) << 16); }
__device__ __forceinline__ int cond_of(int row) { return row < NCTX ? 0 : 1 + ((row - NCTX) >> 11); }
__device__ __forceinline__ float fexp(float x) { return __builtin_amdgcn_exp2f(x * 1.4426950408889634f); }
__device__ __forceinline__ float flog(float x) { return __builtin_amdgcn_logf(x) * 0.6931471805599453f; }
__device__ __forceinline__ float siluf(float x) { return x * __builtin_amdgcn_rcpf(1.f + fexp(-x)); }
__device__ __forceinline__ float sigmf(float x) { return __builtin_amdgcn_rcpf(1.f + fexp(-x)); }
__device__ __forceinline__ float tanh_fast(float x) { return 1.f - 2.f * __builtin_amdgcn_rcpf(1.f + fexp(2.f * x)); }
__device__ __forceinline__ float softplus_fast(float z) { return fmaxf(z, 0.f) + flog(1.f + fexp(-fabsf(z))); }
__device__ __forceinline__ const float* xrow(const P& p, int row) { return row < NCTX ? p.xp + (size_t)row * DM : p.xs + (size_t)(row - NCTX) * DM; }
__device__ __forceinline__ f32x4 mfma16(bf16x8 a, bf16x8 b, f32x4 c) { return __builtin_amdgcn_mfma_f32_16x16x32_bf16(a, b, c, 0, 0, 0); }
__device__ __forceinline__ void unpack8(uint4 v, float* f) {
    f[0] = __uint_as_float(v.x << 16); f[1] = __uint_as_float(v.x & 0xffff0000u); f[2] = __uint_as_float(v.y << 16); f[3] = __uint_as_float(v.y & 0xffff0000u);
    f[4] = __uint_as_float(v.z << 16); f[5] = __uint_as_float(v.z & 0xffff0000u); f[6] = __uint_as_float(v.w << 16); f[7] = __uint_as_float(v.w & 0xffff0000u);
}

__device__ __forceinline__ int colmap(int kind, int n) {
    if (kind == 0) return n;
    if (kind == 1) { const int t = n >> 8, bj = (n >> 7) & 1, c = n & 127; return bj * DFF + t * 128 + c; }
    if (n < 2048) return n; if (n < 3968) return n + 16; if (n < 3984) return n - 3968 + 2048; return -1;
}
__device__ void convert_tile(const float* __restrict__ src, bf16_t* __restrict__ dst, int K, int Nsrc, int kind, int k0, int n0, float* tile) {
    const int tid = opaque_tid();
    { const int n = tid & 63, kr = tid >> 6; const int sc = colmap(kind, n0 + n);
#pragma unroll
      for (int i = 0; i < 8; ++i) { const int k = kr + 8 * i; tile[k * 65 + n] = sc >= 0 ? src[(size_t)(k0 + k) * Nsrc + sc] : 0.f; } }
    __syncthreads();
    { const int nn = tid >> 3, kg = tid & 7; unsigned w[4];
#pragma unroll
      for (int j = 0; j < 4; ++j) w[j] = pk2(tile[(kg * 8 + 2 * j) * 65 + nn], tile[(kg * 8 + 2 * j + 1) * 65 + nn]);
      *(uint4*)(dst + (size_t)(n0 + nn) * K + k0 + kg * 8) = make_uint4(w[0], w[1], w[2], w[3]); }
    __syncthreads();
}
__device__ void convert_jobs(const P& p, int first, int njobs_sel, unsigned char* lds, int item0, int nitems_before) {}

__device__ void do_convert(const float* src, bf16_t* dst, int K, int Nsrc, int Ndst, int kind, int t, float* tile) {
    const int nkt = K / 64; const int kt = t % nkt, ntile = t / nkt; (void)Ndst;
    convert_tile(src, dst, K, Nsrc, kind, kt * 64, ntile * 64, tile);
}

__device__ void phase0(const P& p, unsigned char* lds) {
    float* tile = (float*)lds;
    const int tid = opaque_tid();
    const int n_ada = 36 * 8;
    const int t1 = 16 * 88, t2 = 44 * 16, t3 = 16 * 64, t4 = 16 * 16, t5 = 8, t6 = 8, t7 = 16;
    const int total = n_ada + t1 + t2 + t3 + t4 + t5 + t6 + t7;
    for (int it = blockIdx.x; it < total; it += gridDim.x) {
        if (it < n_ada) {
            const int cgp = it % 36, kc = it / 36;
            float* sc = tile;
            __syncthreads();
            for (int i = tid; i < NCOND * 128; i += NTHR) { const int c = i >> 7, k = i & 127; const float v = c == 0 ? p.cctx[kc * 128 + k] : p.c[(c - 1) * DM + kc * 128 + k]; sc[i] = siluf(v); }
            __syncthreads();
            const int col = cgp * 256 + (tid & 255), kh = tid >> 8;
            float acc[NCOND];
#pragma unroll
            for (int c = 0; c < NCOND; ++c) acc[c] = 0.f;
            const float* w = p.ada_w + (size_t)(kc * 128 + kh * 64) * MODW + col;
#pragma unroll 4
            for (int k = 0; k < 64; ++k) { const float wv = w[(size_t)k * MODW];
#pragma unroll
                for (int c = 0; c < NCOND; ++c) acc[c] += sc[c * 128 + kh * 64 + k] * wv; }
            float* mod = (float*)(p.ws + WS_MOD);
            const float bias = (kc == 0 && kh == 0) ? p.ada_b[col] : 0.f;
#pragma unroll
            for (int c = 0; c < NCOND; ++c) atomicAdd(mod + c * MODW + col, acc[c] + bias);
            __syncthreads();
        } else {
            int t = it - n_ada;
            if (t < t1) do_convert(p.w1in, (bf16_t*)(p.ws + WS_W1), 1024, 5632, 5632, 1, t, tile);
            else if ((t -= t1) < t2) do_convert(p.w1out, (bf16_t*)(p.ws + WS_W1B), 2816, 1024, 1024, 0, t, tile);
            else if ((t -= t2) < t3) do_convert(p.wmin, (bf16_t*)(p.ws + WS_BT3), 1024, 3984, 4096, 2, t, tile);
            else if ((t -= t3) < t4) do_convert(p.wmout, (bf16_t*)(p.ws + WS_BT4), 1024, 1024, 1024, 0, t, tile);
            else if ((t -= t4) < t5) do_convert(p.a2, (bf16_t*)(p.ws + WS_A2BF), 64, 512, 512, 0, t, tile);
            else if ((t -= t5) < t6) do_convert(p.a2 + 64 * 512, (bf16_t*)(p.ws + WS_A2BF) + 512 * 64, 64, 512, 512, 0, t, tile);
            else { t -= t6; do_convert(p.g2, (bf16_t*)(p.ws + WS_G2BF), 128, 512, 512, 0, t, tile); }
        }
    }
}

__device__ void phase_normmod(const P& p, int which) {
    const int lane = opaque_tid() & 63, wave = threadIdx.x >> 6;
    const float* gain = which == 0 ? p.n1 : (which == 1 ? p.nmix : p.n2);
    const float* mod = (const float*)(p.ws + WS_MOD);
    bf16_t* A = (bf16_t*)(p.ws + WS_A);
    for (int row = blockIdx.x * 8 + wave; row < MT; row += gridDim.x * 8) {
        const float* src = which == 0 ? xrow(p, row) : p.out + (size_t)row * DM;
        float4 v[4]; float ss = 0.f;
#pragma unroll
        for (int i = 0; i < 4; ++i) { v[i] = *(const float4*)(src + lane * 4 + 256 * i); ss += v[i].x * v[i].x + v[i].y * v[i].y + v[i].z * v[i].z + v[i].w * v[i].w; }
#pragma unroll
        for (int o = 32; o >= 1; o >>= 1) ss += __shfl_xor(ss, o);
        const float rstd = rsqrtf(ss * (1.f / 1024.f) + 1e-6f);
        const float* sh = mod + cond_of(row) * MODW + which * 3072; const float* sc = sh + 1024;
#pragma unroll
        for (int i = 0; i < 4; ++i) { const int col = lane * 4 + 256 * i;
            const float4 g = *(const float4*)(gain + col), s4 = *(const float4*)(sh + col), c4 = *(const float4*)(sc + col);
            const float o0 = v[i].x * rstd * g.x * (1.f + c4.x) + s4.x, o1 = v[i].y * rstd * g.y * (1.f + c4.y) + s4.y,
                        o2 = v[i].z * rstd * g.z * (1.f + c4.z) + s4.z, o3 = v[i].w * rstd * g.w * (1.f + c4.w) + s4.w;
            *(uint2*)(A + (size_t)row * DM + col) = make_uint2(pk2(o0, o1), pk2(o2, o3)); }
    }
}
__device__ void phase_finalnorm(const P& p) {
    const int lane = opaque_tid() & 63, wave = threadIdx.x >> 6;
    for (int row = blockIdx.x * 8 + wave; row < MT; row += gridDim.x * 8) {
        float* src = p.out + (size_t)row * DM;
        float4 v[4]; float ss = 0.f;
#pragma unroll
        for (int i = 0; i < 4; ++i) { v[i] = *(const float4*)(src + lane * 4 + 256 * i); ss += v[i].x * v[i].x + v[i].y * v[i].y + v[i].z * v[i].z + v[i].w * v[i].w; }
#pragma unroll
        for (int o = 32; o >= 1; o >>= 1) ss += __shfl_xor(ss, o);
        const float rstd = rsqrtf(ss * (1.f / 1024.f) + 1e-6f);
#pragma unroll
        for (int i = 0; i < 4; ++i) { const int col = lane * 4 + 256 * i; const float4 g = *(const float4*)(p.nf + col);
            *(float4*)(src + col) = make_float4(v[i].x * rstd * g.x, v[i].y * rstd * g.y, v[i].z * rstd * g.z, v[i].w * rstd * g.w); }
    }
}

struct EpiSwiglu {
    static constexpr bool PERM = true;
    bf16_t* O;
    __device__ __forceinline__ void operator()(const f32x4 (&acc)[2][2][4][2], const pg8::Unit& u, int wr, int wc, int fr, int fq) const {
        const int row0 = u.pm * 256 + wr * 64 + fr, col0 = u.pn * 128 + wc * 32 + 8 * fq;
#pragma unroll
        for (int ai = 0; ai < 2; ++ai)
#pragma unroll
            for (int m = 0; m < 4; ++m) { bf16_t* rowp = O + (size_t)(row0 + ai * 128 + m * 16) * DFF + col0;
                float r[8];
#pragma unroll
                for (int n = 0; n < 2; ++n)
#pragma unroll
                    for (int j = 0; j < 4; ++j) r[n * 4 + j] = siluf(acc[ai][0][m][n][j]) * acc[ai][1][m][n][j];
                pg8::u32x4 w; w.x = pg8::cvt_pk_bf16(r[0], r[1]); w.y = pg8::cvt_pk_bf16(r[2], r[3]); w.z = pg8::cvt_pk_bf16(r[4], r[5]); w.w = pg8::cvt_pk_bf16(r[6], r[7]);
                *(pg8::u32x4*)rowp = w; }
    }
};
struct EpiResid {
    static constexpr bool PERM = false;
    const float* xp; const float* xs; float* out; const float* ga; float coef; int inplace;
    __device__ __forceinline__ void operator()(const f32x4 (&acc)[2][2][4][2], const pg8::Unit& u, int wr, int wc, int fr, int fq) const {
        const int row0 = u.pm * 256 + wr * 64 + fr, col0 = u.pn * 256 + wc * 32 + 4 * fq;
        const float* gap = ga + cond_of(u.pm * 256) * MODW;
        f32x4 gv[2][2];
#pragma unroll
        for (int bj = 0; bj < 2; ++bj)
#pragma unroll
            for (int n = 0; n < 2; ++n) gv[bj][n] = *(const f32x4*)(gap + col0 + bj * 128 + n * 16) * coef;
#pragma unroll
        for (int ai = 0; ai < 2; ++ai)
#pragma unroll
            for (int m = 0; m < 4; ++m) { const int row = row0 + ai * 128 + m * 16;
                const float* base = inplace ? out + (size_t)row * DM : (row < NCTX ? xp + (size_t)row * DM : xs + (size_t)(row - NCTX) * DM);
                float* op = out + (size_t)row * DM;
#pragma unroll
                for (int bj = 0; bj < 2; ++bj)
#pragma unroll
                    for (int n = 0; n < 2; ++n) { const int c = col0 + bj * 128 + n * 16; const f32x4 b4 = *(const f32x4*)(base + c);
                        *(f32x4*)(op + c) = b4 + gv[bj][n] * acc[ai][bj][m][n]; } }
    }
};
struct EpiU {
    static constexpr bool PERM = true;
    bf16_t* U; float* gates;
    __device__ __forceinline__ void operator()(const f32x4 (&acc)[2][2][4][2], const pg8::Unit& u, int wr, int wc, int fr, int fq) const {
        const int row0 = u.pm * 256 + wr * 64 + fr;
#pragma unroll
        for (int bj = 0; bj < 2; ++bj) { const int col0 = u.pn * 256 + bj * 128 + wc * 32 + 8 * fq;
            if (col0 < UW) {
#pragma unroll
                for (int ai = 0; ai < 2; ++ai)
#pragma unroll
                    for (int m = 0; m < 4; ++m) { const int row = row0 + ai * 128 + m * 16; const f32x4 v0 = acc[ai][bj][m][0], v1 = acc[ai][bj][m][1];
                        pg8::u32x4 w; w.x = pg8::cvt_pk_bf16(v0[0], v0[1]); w.y = pg8::cvt_pk_bf16(v0[2], v0[3]); w.z = pg8::cvt_pk_bf16(v1[0], v1[1]); w.w = pg8::cvt_pk_bf16(v1[2], v1[3]);
                        *(pg8::u32x4*)(U + (size_t)row * UW + col0) = w;
                        if (col0 >= 3968) { float* gp = gates + (size_t)row * 16 + (col0 - 3968); *(f32x4*)gp = v0; *(f32x4*)(gp + 4) = v1; } } } }
    }
};

template <class Epi>
__device__ __forceinline__ void run_gemm(unsigned char* lds, const bf16_t* A, const bf16_t* Bt, int N, int K, const Epi& E) {
    pg8::Gemm g{A, Bt, MT, N, K}; pg8::StaticOrder S; S.init(MT, N, (int)gridDim.x, (int)blockIdx.x);
    pg8::gemm_phase<Epi, pg8::StaticOrder, true, true>((PG8_LAS unsigned char*)lds, g, S, E);
}

constexpr int ML_SK = 0, ML_KWT = 17408, ML_VT = ML_KWT + 18432, ML_CB = ML_VT + 20736, ML_F = ML_CB + 21760, ML_CW = ML_F + 2048, ML_END = ML_CW + 4096;
static_assert(ML_END <= LDS_BYTES, "mlstm lds");

__device__ __forceinline__ unsigned short ld_u16_agent(const bf16_t* p) { return __hip_atomic_load(p, __ATOMIC_RELAXED, __HIP_MEMORY_SCOPE_AGENT); }

__device__ __forceinline__ void conv3_row8(const bf16_t* up, bool hasp, bool hasn, const float* cwp, float* x) {
    float t[8];
    unpack8(*(const uint4*)up, t);
#pragma unroll
    for (int i = 0; i < 8; ++i) x[i] = cwp[768 + i] + cwp[256 + i] * t[i];
    if (hasp) { unpack8(*(const uint4*)(up - UW), t);
#pragma unroll
        for (int i = 0; i < 8; ++i) x[i] += cwp[i] * t[i]; }
    if (hasn) { unpack8(*(const uint4*)(up + UW), t);
#pragma unroll
        for (int i = 0; i < 8; ++i) x[i] += cwp[512 + i] * t[i]; }
}

__device__ __forceinline__ void mlstm_task(const P& p, unsigned char* lds, int bg, int h, int dsel) {
    const int wv = __builtin_amdgcn_readfirstlane((int)threadIdx.x >> 6), rw = wv & 3, cw = wv >> 2;
    const bool ctx = bg < 32; const int T = ctx ? 256 : 2048, nc = T / 64; const int row0 = ctx ? bg * 256 : NCTX + (bg - 32) * 2048;
    bf16_t* sK = (bf16_t*)(lds + ML_SK); bf16_t* sKwT = (bf16_t*)(lds + ML_KWT); bf16_t* sVT = (bf16_t*)(lds + ML_VT); bf16_t* sCb = (bf16_t*)(lds + ML_CB); bf16_t* sS = sCb;
    float* sA = (float*)(lds + ML_F); float* sM = sA + 64; float* sBb = sM + 64; float* sDen = sBb + 64; float* sScal = sDen + 64; float* sRed = sScal + 16;
    float* sCW = (float*)(lds + ML_CW);
    const bf16_t* U = (const bf16_t*)(p.ws + WS_U); const float* GATES = (const float*)(p.ws + WS_GATES); bf16_t* HB = (bf16_t*)(p.ws + WS_A); bf16_t* HB2 = (bf16_t*)(p.ws + WS_HB2);
    const int d_lo = dsel < 0 ? 0 : dsel, d_hi = dsel < 0 ? 2 : dsel + 1;
    const int ct_a = cw ? 3 : 0;
    const int ct_b = cw ? 7 : 5;
    const int n_a = cw ? 2 : 3;

    __syncthreads();
    { const int tid = threadIdx.x;
      for (int i = tid; i < 1024; i += NTHR) { const int a = i >> 8, cc = i & 255, gch = (cc >> 7) * 512 + h * 128 + (cc & 127); sCW[i] = a < 3 ? p.cw[a * 1024 + gch] : p.cb[gch]; }
      for (int i = tid; i < 16 * 72; i += NTHR) { const int r = 128 + i / 72; sVT[r * 72 + (i % 72)] = (r == 128) ? (bf16_t)0x3F80 : (bf16_t)0; } }

#pragma unroll 1
    for (int dir = d_lo; dir < d_hi; ++dir) {
        f32x4 Cacc[9]; float m_prev = 0.f;
        { int z0 = 0; asm volatile("" : "+v"(z0)); const int tid = (int)threadIdx.x + z0, fr = tid & 15, fq = (tid >> 4) & 3;
#pragma unroll
          for (int ct = 0; ct < 9; ++ct) Cacc[ct] = (f32x4){0.f, 0.f, 0.f, 0.f};
          if (!ctx) { const int sidx = ((bg - 32) * 2 + dir) * 4 + h; const float* C0 = p.sC + (size_t)sidx * 16384; const float* n0 = p.sn + (size_t)sidx * 128;
#pragma unroll
              for (int j = 0; j < 4; ++j) { const int d = 16 * wv + 4 * fq + j;
#pragma unroll
                  for (int ct = 0; ct < 8; ++ct) Cacc[ct][j] = C0[d * 128 + 16 * ct + fr];
                  Cacc[8][j] = fr == 0 ? n0[d] : 0.f; }
              m_prev = p.sm[sidx]; } }
        const float gbi = p.gb[dir * 4 + h], gbf = p.gb[8 + dir * 4 + h];
        const bool second = dsel < 0 && dir == 1;
#pragma unroll 1
        for (int s = 0; s < nc; ++s) {
            const int c = dir ? nc - 1 - s : s;
            int zz = 0; asm volatile("" : "+v"(zz));
            const int tid = (int)threadIdx.x + zz, lane = tid & 63, fr = tid & 15, fq = (tid >> 4) & 3;
            uint4 kc[2], kp[2], kn[2], vv[2];
#pragma unroll
            for (int g = 0; g < 2; ++g) { const int idx = tid + 512 * g, sl = idx >> 4, d0 = (idx & 15) * 8; const int tl = dir ? 63 - sl : sl, tok = c * 64 + tl;
                const bf16_t* up = U + ((size_t)row0 + tok) * UW + 512 + h * 128 + d0;
                kc[g] = *(const uint4*)up; kp[g] = make_uint4(0u, 0u, 0u, 0u); kn[g] = kp[g];
                if (tok > 0) kp[g] = *(const uint4*)(up - UW);
                if (tok < T - 1) kn[g] = *(const uint4*)(up + UW);
                vv[g] = *(const uint4*)(up + 512); }
            LDS_BARRIER();
            if (wv == 0) {
                const int tl = dir ? 63 - lane : lane; const size_t row = (size_t)row0 + c * 64 + tl;
                const float ip = GATES[row * 16 + dir * 4 + h] + gbi, fp = GATES[row * 16 + 8 + dir * 4 + h] + gbf;
                const float lf = -softplus_fast(-fp);
                float bs = lf;
#pragma unroll
                for (int o = 1; o < 64; o <<= 1) { const float t = __shfl_up(bs, o); if (lane >= o) bs += t; }
                const float a = ip - bs; float pm = a;
#pragma unroll
                for (int o = 1; o < 64; o <<= 1) { const float t = __shfl_up(pm, o); if (lane >= o) pm = fmaxf(pm, t); }
                const float Mt = fmaxf(m_prev, pm);
                sA[lane] = a; sM[lane] = Mt; sBb[lane] = bs;
                if (lane == 63) { sScal[0] = Mt; sScal[1] = bs; }
            }
            LDS_BARRIER();
            const float M63 = sScal[0], bL = sScal[1];
            uint4 qc[4], qp[4], qn[4];
            { const int t_ = 16 * rw + fr, tl = dir ? 63 - t_ : t_, tok = c * 64 + tl; const bf16_t* up = U + ((size_t)row0 + tok) * UW + h * 128 + 8 * fq;
#pragma unroll
              for (int kk = 0; kk < 4; ++kk) { qc[kk] = *(const uint4*)(up + 32 * kk); qp[kk] = make_uint4(0u, 0u, 0u, 0u); qn[kk] = qp[kk];
                  if (tok > 0) qp[kk] = *(const uint4*)(up + 32 * kk - UW);
                  if (tok < T - 1) qn[kk] = *(const uint4*)(up + 32 * kk + UW); } }
#pragma unroll
            for (int g = 0; g < 2; ++g) {
                const int idx = tid + 512 * g, sl = idx >> 4, d0 = (idx & 15) * 8;
                const float wk = fexp(sA[sl] - M63);
                const float* cwp = sCW + 128 + d0;
                float kv[8], t[8];
                unpack8(kc[g], t);
#pragma unroll
                for (int i = 0; i < 8; ++i) kv[i] = cwp[768 + i] + cwp[256 + i] * t[i];
                unpack8(kp[g], t);
#pragma unroll
                for (int i = 0; i < 8; ++i) kv[i] += cwp[i] * t[i];
                unpack8(kn[g], t);
#pragma unroll
                for (int i = 0; i < 8; ++i) kv[i] += cwp[512 + i] * t[i];
#pragma unroll
                for (int i = 0; i < 8; ++i) kv[i] = siluf(kv[i]) * 0.08838834764831845f;
                *(uint4*)(sK + sl * 136 + d0) = make_uint4(pk2(kv[0], kv[1]), pk2(kv[2], kv[3]), pk2(kv[4], kv[5]), pk2(kv[6], kv[7]));
#pragma unroll
                for (int i = 0; i < 8; ++i) sKwT[(d0 + i) * 72 + sl] = f2bf(kv[i] * wk);
                const unsigned vw[4] = {vv[g].x, vv[g].y, vv[g].z, vv[g].w};
#pragma unroll
                for (int i = 0; i < 8; ++i) sVT[(d0 + i) * 72 + sl] = (bf16_t)((vw[i >> 1] >> ((i & 1) * 16)) & 0xffffu);
            }
            bf16x8 qf[4];
#pragma unroll
            for (int kk = 0; kk < 4; ++kk) { const float* cwp = sCW + 32 * kk + 8 * fq; float qv[8], t[8];
                unpack8(qc[kk], t);
#pragma unroll
                for (int i = 0; i < 8; ++i) qv[i] = cwp[768 + i] + cwp[256 + i] * t[i];
                unpack8(qp[kk], t);
#pragma unroll
                for (int i = 0; i < 8; ++i) qv[i] += cwp[i] * t[i];
                unpack8(qn[kk], t);
#pragma unroll
                for (int i = 0; i < 8; ++i) qv[i] += cwp[512 + i] * t[i];
#pragma unroll
                for (int i = 0; i < 8; ++i) qv[i] = siluf(qv[i]);
                union { uint4 u; bf16x8 v; } cv; cv.u = make_uint4(pk2(qv[0], qv[1]), pk2(qv[2], qv[3]), pk2(qv[4], qv[5]), pk2(qv[6], qv[7])); qf[kk] = cv.v; }
            f32x4 num[5];
#pragma unroll
            for (int k = 0; k < 5; ++k) num[k] = (f32x4){0.f, 0.f, 0.f, 0.f};
#pragma unroll
            for (int ci = 0; ci < 5; ++ci) { const f32x4 v = Cacc[ci]; *(uint2*)(sCb + (16 * ci + fr) * 136 + 16 * wv + 4 * fq) = make_uint2(pk2(v[0], v[1]), pk2(v[2], v[3])); }
            LDS_BARRIER();
#pragma unroll
            for (int k = 0; k < 3; ++k) if (k < n_a) {
#pragma unroll
                for (int kk = 0; kk < 4; ++kk) { const bf16x8 b = *(const bf16x8*)(sCb + (16 * (ct_a + k) + fr) * 136 + 32 * kk + 8 * fq); num[k] = mfma16(qf[kk], b, num[k]); } }
            LDS_BARRIER();
#pragma unroll
            for (int ci = 0; ci < 4; ++ci) { const f32x4 v = Cacc[5 + ci]; *(uint2*)(sCb + (16 * ci + fr) * 136 + 16 * wv + 4 * fq) = make_uint2(pk2(v[0], v[1]), pk2(v[2], v[3])); }
            LDS_BARRIER();
#pragma unroll
            for (int k = 3; k < 5; ++k) {
#pragma unroll
                for (int kk = 0; kk < 4; ++kk) { const bf16x8 b = *(const bf16x8*)(sCb + (16 * (ct_b + k - 3 - 5) + fr) * 136 + 32 * kk + 8 * fq); num[k] = mfma16(qf[kk], b, num[k]); } }
            {
                float scv[4];
#pragma unroll
                for (int j = 0; j < 4; ++j) scv[j] = fexp(m_prev - sM[16 * rw + 4 * fq + j]);
#pragma unroll
                for (int k = 0; k < 5; ++k)
#pragma unroll
                    for (int j = 0; j < 4; ++j) num[k][j] *= scv[j];
            }
            LDS_BARRIER();
#pragma unroll
            for (int si = 0; si < 2; ++si) { const int st = 2 * cw + si;
                f32x4 sacc = (f32x4){0.f, 0.f, 0.f, 0.f};
                if (st <= rw) {
#pragma unroll
                    for (int kk = 0; kk < 4; ++kk) { const bf16x8 b = *(const bf16x8*)(sK + (16 * st + fr) * 136 + 32 * kk + 8 * fq); sacc = mfma16(qf[kk], b, sacc); } }
                const int sp = 16 * st + fr; const float as = sA[sp];
#pragma unroll
                for (int j = 0; j < 4; ++j) { const int tp = 16 * rw + 4 * fq + j; const float val = (sp <= tp) ? sacc[j] * fexp(as - sM[tp]) : 0.f; sS[tp * 72 + sp] = f2bf(val); }
            }
            LDS_BARRIER();
#pragma unroll
            for (int ks = 0; ks < 2; ++ks) { const bf16x8 a = *(const bf16x8*)(sS + (16 * rw + fr) * 72 + 32 * ks + 8 * fq);
#pragma unroll
                for (int k = 0; k < 5; ++k) { const int ct = k < 3 ? ct_a + k : ct_b + k - 3;
                    if (k != 2 || cw == 0) { const bf16x8 b = *(const bf16x8*)(sVT + (16 * ct + fr) * 72 + 32 * ks + 8 * fq); num[k] = mfma16(a, b, num[k]); } } }
            if (cw == 1 && fr == 0) {
#pragma unroll
                for (int j = 0; j < 4; ++j) sDen[16 * rw + 4 * fq + j] = num[4][j]; }
            LDS_BARRIER();
            float inv[4];
#pragma unroll
            for (int j = 0; j < 4; ++j) { const int tp = 16 * rw + 4 * fq + j; const float den = sDen[tp]; inv[j] = __builtin_amdgcn_rcpf(fmaxf(fabsf(den), fexp(-(sBb[tp] + sM[tp])))); }
            if (!second) {
#pragma unroll
                for (int j = 0; j < 4; ++j) { const int tp = 16 * rw + 4 * fq + j, tl = dir ? 63 - tp : tp; const size_t row = (size_t)row0 + c * 64 + tl;
                    bf16_t* hb = dsel == 1 ? HB2 + (row - NCTX) * 512 + h * 128 : HB + row * DM + h * 128;
#pragma unroll
                    for (int k = 0; k < 5; ++k) { const int ct = k < 3 ? ct_a + k : ct_b + k - 3; if ((k != 2 || cw == 0) && ct < 8) hb[16 * ct + fr] = f2bf(num[k][j] * inv[j]); } }
            } else {
                float ssr[4];
#pragma unroll
                for (int j = 0; j < 4; ++j) { const int tp = 16 * rw + 4 * fq + j, tl = dir ? 63 - tp : tp; const size_t row = (size_t)row0 + c * 64 + tl;
                    const bf16_t* hb = HB + row * DM + h * 128; float ss = 0.f;
#pragma unroll
                    for (int k = 0; k < 5; ++k) { const int ct = k < 3 ? ct_a + k : ct_b + k - 3;
                        if ((k != 2 || cw == 0) && ct < 8) { const int e = 16 * ct + fr; const float other = bf2f(ld_u16_agent(hb + e)); const float hs = num[k][j] * inv[j] + other;
                            const float o = sigmf(bf2f(U[row * UW + 1536 + h * 128 + e])); const float v = o * hs; ss += v * v; num[k][j] = v; } }
                    ss += __shfl_xor(ss, 1); ss += __shfl_xor(ss, 2); ss += __shfl_xor(ss, 4); ss += __shfl_xor(ss, 8);
                    ssr[j] = ss; if (fr == 0) sRed[cw * 64 + tp] = ss; }
                LDS_BARRIER();
#pragma unroll
                for (int j = 0; j < 4; ++j) { const int tp = 16 * rw + 4 * fq + j, tl = dir ? 63 - tp : tp; const size_t row = (size_t)row0 + c * 64 + tl;
                    bf16_t* hb = HB + row * DM + h * 128; const float rms = rsqrtf((ssr[j] + sRed[(1 - cw) * 64 + tp]) * (1.f / 128.f) + 1e-6f);
#pragma unroll
                    for (int k = 0; k < 5; ++k) { const int ct = k < 3 ? ct_a + k : ct_b + k - 3;
                        if ((k != 2 || cw == 0) && ct < 8) { const int e = 16 * ct + fr; hb[e] = f2bf(num[k][j] * rms * p.hg[h * 128 + e]); } } }
            }
            const float decay = fexp(m_prev - M63);
#pragma unroll
            for (int ct = 0; ct < 9; ++ct) Cacc[ct] = Cacc[ct] * decay;
#pragma unroll
            for (int ks = 0; ks < 2; ++ks) { const bf16x8 a = *(const bf16x8*)(sKwT + (16 * wv + fr) * 72 + 32 * ks + 8 * fq);
#pragma unroll
                for (int ct = 0; ct < 9; ++ct) { const bf16x8 b = *(const bf16x8*)(sVT + (16 * ct + fr) * 72 + 32 * ks + 8 * fq); Cacc[ct] = mfma16(a, b, Cacc[ct]); } }
            m_prev = bL + M63;
        }
        if (ctx) { const int sidx = (bg * 2 + dir) * 4 + h; float* Co = p.out + OUT_C + (size_t)sidx * 16384;
            int z1 = 0; asm volatile("" : "+v"(z1)); const int tid1 = (int)threadIdx.x + z1, fr1 = tid1 & 15, fq1 = (tid1 >> 4) & 3;
#pragma unroll
            for (int j = 0; j < 4; ++j) { const int d = 16 * wv + 4 * fq1 + j;
#pragma unroll
                for (int ct = 0; ct < 8; ++ct) Co[d * 128 + 16 * ct + fr1] = Cacc[ct][j];
                if (fr1 == 0) p.out[OUT_N + sidx * 128 + d] = Cacc[8][j]; }
            if (tid1 == 0) p.out[OUT_MM + sidx] = m_prev; }
        __syncthreads();
    }
}

__device__ __forceinline__ void phase_shift(bf16_t* U, const float* pmu, uint4* sRow) {
#pragma unroll 1
    for (int item = blockIdx.x; item < 1200; item += gridDim.x) {
        const int tid = opaque_tid(), tl = tid >> 3, g = tid & 7;
        const bool grid = item < 240; const int seq = grid ? item / 30 : (item - 240) / 30, sl = grid ? item % 30 : (item - 240) % 30;
        const int T = grid ? 2048 : 256, nst = T / 64; const size_t row0 = grid ? (size_t)NCTX + (size_t)seq * 2048 : (size_t)seq * 256;
        const int rc = sl * 64 + g * 8;
        char* base = (char*)(U + row0 * UW + 2048 + rc);
        const int act = (rc >= 1536 && rc < 1664) ? 1 : (rc >= 1792 ? 2 : 0);
        unsigned z0_ = 0u; asm volatile("" : "+v"(z0_));
        uint4 prv = make_uint4(z0_, z0_, z0_, z0_), cur = *(const uint4*)(base + (size_t)tl * (UW * 2)), nxt;
        __syncthreads();
#pragma unroll 1
        for (int k = 0; k < nst; ++k) {
            unsigned zr = 0u; asm volatile("" : "+v"(zr)); const uint4 z4 = make_uint4(zr, zr, zr, zr);
            nxt = z4; if (k + 1 < nst) nxt = *(const uint4*)(base + (size_t)((k + 1) * 64 + tl) * (UW * 2));
            sRow[(1 + tl) * 8 + g] = cur;
            if (tl == 0) sRow[65 * 8 + g] = nxt;
            LDS_BARRIER();
            uint4 lf = sRow[tl * 8 + g], rt = sRow[(2 + tl) * 8 + g];
            if (tl == 0 && (grid || k == 0)) lf = z4;
            if (tl == 63 && (grid || k == nst - 1)) rt = z4;
            float x[8], t[8], o[8], ms[8], m[8];
            int zz = 0; asm volatile("" : "+v"(zz)); const float* mup = pmu + rc + zz;
#define LD_MU8(a) do { const float4 m0 = *(const float4*)(mup + (a) * 1920), m1 = *(const float4*)(mup + (a) * 1920 + 4); m[0] = m0.x; m[1] = m0.y; m[2] = m0.z; m[3] = m0.w; m[4] = m1.x; m[5] = m1.y; m[6] = m1.z; m[7] = m1.w; } while (0)
            unpack8(cur, x);
            LD_MU8(0); unpack8(lf, t);
#pragma unroll
            for (int i = 0; i < 8; ++i) { o[i] = m[i] * t[i]; ms[i] = m[i]; }
            LD_MU8(1); unpack8(rt, t);
#pragma unroll
            for (int i = 0; i < 8; ++i) { o[i] += m[i] * t[i]; ms[i] += m[i]; }
            if (grid) {
                LD_MU8(2); unpack8(prv, t);
#pragma unroll
                for (int i = 0; i < 8; ++i) { o[i] += m[i] * t[i]; ms[i] += m[i]; }
                LD_MU8(3); unpack8(nxt, t);
#pragma unroll
                for (int i = 0; i < 8; ++i) { o[i] += m[i] * t[i]; ms[i] += m[i]; }
            }
#undef LD_MU8
#pragma unroll
            for (int i = 0; i < 8; ++i) o[i] += x[i] * (1.f - ms[i]);
            if (act == 1) {
#pragma unroll
                for (int i = 0; i < 8; ++i) o[i] = tanh_fast(o[i]); }
            if (act == 2) {
#pragma unroll
                for (int i = 0; i < 8; ++i) o[i] = sigmf(o[i]); }
            *(uint4*)(base + (size_t)(k * 64 + tl) * (UW * 2)) = make_uint4(pk2(o[0], o[1]), pk2(o[2], o[3]), pk2(o[4], o[5]), pk2(o[6], o[7]));
            LDS_BARRIER();
            if (tl == 63) sRow[g] = cur;
            prv = cur; cur = nxt;
        }
    }
}

constexpr int RW_TC = 16;
constexpr int RW_VEC = 0, RW_V = RW_VEC + 16 * 320 * 4, RW_KR = RW_V + 16 * 32 * 4, RW_XW = RW_KR + 16 * 64 * 4, RW_XA = RW_XW + 16 * 72 * 2, RW_Y = RW_XA + 16 * 72 * 2,
              RW_MU = RW_Y + 16 * 32 * 4, RW_DIR = RW_MU + 4 * 288 * 4;
static_assert(2 * RW_DIR <= LDS_BYTES && RW_DIR % 16 == 0, "rwkv lds");

__device__ __forceinline__ float dppf(float x, const int ctrl) { return x; }
#define DPP_ADD(x, ctrl) ((x) + __int_as_float(__builtin_amdgcn_update_dpp(0, __float_as_int(x), (ctrl), 0xf, 0xf, true)))
__device__ __forceinline__ float red8(float x) { x = DPP_ADD(x, 0xB1); x = DPP_ADD(x, 0x4E); x = DPP_ADD(x, 0x141); return x; }
__device__ __forceinline__ float red16(float x) { x = red8(x); x = DPP_ADD(x, 0x140); return x; }

struct Sh8 { uint4 x, l, r, u, d; };
__device__ __forceinline__ void sh8_load(Sh8& q, const bf16_t* U, size_t row0, int tok, int T, bool grid, int c0) {
    const char* Ub = (const char*)(U + row0 * UW);
    const int off = (tok * UW + c0) * 2; const uint4 z = make_uint4(0u, 0u, 0u, 0u);
    const bool hl = grid ? (tok & 63) != 0 : tok > 0, hr = grid ? (tok & 63) != 63 : tok < T - 1;
    q.x = *(const uint4*)(Ub + off);
    q.l = hl ? *(const uint4*)(Ub + (off - UW * 2)) : z; q.r = hr ? *(const uint4*)(Ub + (off + UW * 2)) : z;
    q.u = (grid && tok >= 64) ? *(const uint4*)(Ub + (off - 64 * UW * 2)) : z; q.d = (grid && tok < T - 64) ? *(const uint4*)(Ub + (off + 64 * UW * 2)) : z;
}
__device__ __forceinline__ void sh8_mix(const Sh8& q, bool grid, const float* mu4, int mustride, float* o) {
    float x[8], t[8], m[8], ms[8];
    unpack8(q.x, x);
    { const float4 a = *(const float4*)mu4, b = *(const float4*)(mu4 + 4); m[0] = a.x; m[1] = a.y; m[2] = a.z; m[3] = a.w; m[4] = b.x; m[5] = b.y; m[6] = b.z; m[7] = b.w; }
    unpack8(q.l, t);
#pragma unroll
    for (int i = 0; i < 8; ++i) { o[i] = m[i] * t[i]; ms[i] = m[i]; }
    { const float4 a = *(const float4*)(mu4 + mustride), b = *(const float4*)(mu4 + mustride + 4); m[0] = a.x; m[1] = a.y; m[2] = a.z; m[3] = a.w; m[4] = b.x; m[5] = b.y; m[6] = b.z; m[7] = b.w; }
    unpack8(q.r, t);
#pragma unroll
    for (int i = 0; i < 8; ++i) { o[i] += m[i] * t[i]; ms[i] += m[i]; }
    if (grid) {
        { const float4 a = *(const float4*)(mu4 + 2 * mustride), b = *(const float4*)(mu4 + 2 * mustride + 4); m[0] = a.x; m[1] = a.y; m[2] = a.z; m[3] = a.w; m[4] = b.x; m[5] = b.y; m[6] = b.z; m[7] = b.w; }
        unpack8(q.u, t);
#pragma unroll
        for (int i = 0; i < 8; ++i) { o[i] += m[i] * t[i]; ms[i] += m[i]; }
        { const float4 a = *(const float4*)(mu4 + 3 * mustride), b = *(const float4*)(mu4 + 3 * mustride + 4); m[0] = a.x; m[1] = a.y; m[2] = a.z; m[3] = a.w; m[4] = b.x; m[5] = b.y; m[6] = b.z; m[7] = b.w; }
        unpack8(q.d, t);
#pragma unroll
        for (int i = 0; i < 8; ++i) { o[i] += m[i] * t[i]; ms[i] += m[i]; }
    }
#pragma unroll
    for (int i = 0; i < 8; ++i) o[i] += x[i] * (1.f - ms[i]);
}
__device__ __forceinline__ void shifted8(const bf16_t* U, size_t row0, int tok, int T, bool grid, int c0, const float* mu4, int mustride, float* o) {
    Sh8 q; sh8_load(q, U, row0, tok, T, grid, c0); sh8_mix(q, grid, mu4, mustride, o);
}
typedef float f32x2 __attribute__((ext_vector_type(2)));

__device__ __forceinline__ void rwkv_task(const P& p, unsigned char* lds, int bg, int h, int rh) {
    const int wv = __builtin_amdgcn_readfirstlane((int)threadIdx.x >> 6), dir = wv >> 2, lw = wv & 3;
    const bool ctx = bg < 32; const int T = ctx ? 256 : 2048, nc = T / RW_TC; const size_t row0 = ctx ? (size_t)bg * 256 : (size_t)NCTX + (size_t)(bg - 32) * 2048;
    const bool grid = !ctx;
    unsigned char* L = lds + dir * RW_DIR;
    float* sVec = (float*)(L + RW_VEC); float* sV = (float*)(L + RW_V); float* sKr = (float*)(L + RW_KR); bf16_t* sXw = (bf16_t*)(L + RW_XW); bf16_t* sXa = (bf16_t*)(L + RW_XA);
    float* sY = (float*)(L + RW_Y); float* sMu = (float*)(L + RW_MU);
    const bf16_t* U = (const bf16_t*)(p.ws + WS_U); bf16_t* HB = (bf16_t*)(p.ws + WS_A);
    const int hc = h * 64;
    float st[8]; bf16x8 wfrag[2], afrag[2]; float w0v, a0v, kav;
    {
        const int tid = opaque_tid(), ltid = tid & 255, ri = ltid >> 3, jq = ltid & 7, fr = tid & 15, fq = (tid >> 4) & 3;
        __syncthreads();
        if (ctx) {
#pragma unroll
            for (int q = 0; q < 8; ++q) st[q] = 0.f;
        } else { const float* S0 = p.sS + ((size_t)(((bg - 32) * 2 + dir) * 8 + h)) * 4096 + (32 * rh + ri) * 64 + jq * 8;
#pragma unroll
            for (int q = 0; q < 8; ++q) st[q] = S0[q]; }
        const int jcol = hc + 16 * lw + fr;
#pragma unroll
        for (int ks = 0; ks < 2; ++ks) { float wf[8], af[8];
#pragma unroll
            for (int i = 0; i < 8; ++i) { const int l = 32 * ks + 8 * fq + i; wf[i] = p.w2[(size_t)(dir * 64 + l) * 512 + jcol]; af[i] = p.a2[(size_t)(dir * 64 + l) * 512 + jcol]; }
            union { uint4 u; bf16x8 v; } c1, c2; c1.u = make_uint4(pk2(wf[0], wf[1]), pk2(wf[2], wf[3]), pk2(wf[4], wf[5]), pk2(wf[6], wf[7])); c2.u = make_uint4(pk2(af[0], af[1]), pk2(af[2], af[3]), pk2(af[4], af[5]), pk2(af[6], af[7]));
            wfrag[ks] = c1.v; afrag[ks] = c2.v; }
        w0v = p.w0[dir * 512 + jcol]; a0v = p.a0[dir * 512 + jcol]; kav = p.ka[jcol];
    }
    uint4 q1, q2, q3 = make_uint4(0u, 0u, 0u, 0u);
    const char* Ub = (const char*)(U + row0 * UW);
    { const int tid = opaque_tid(), ltid = tid & 255; const int c = dir ? nc - 1 : 0, tok0 = c * RW_TC; const int tl = (ltid & 127) >> 3, g = ltid & 7;
      q1 = *(const uint4*)(Ub + ((tok0 + tl) * UW + (lw < 2 ? 2048 : 2048 + 512) + hc + 8 * g) * 2);
      q2 = *(const uint4*)(Ub + ((tok0 + tl) * UW + (lw < 2 ? 2048 + 1536 : 2048 + 1664) + dir * 64 + 8 * g) * 2);
      if (lw == 0) q3 = *(const uint4*)(Ub + ((tok0 + (ltid >> 2)) * UW + 2048 + 1024 + hc + 32 * rh + 8 * (ltid & 3)) * 2); }
    f32x2 st2[4];
#pragma unroll
    for (int q = 0; q < 4; ++q) st2[q] = (f32x2){st[2 * q], st[2 * q + 1]};
#pragma unroll 1
    for (int s = 0; s < nc; ++s) {
        const int c = dir ? nc - 1 - s : s; const int tok0 = c * RW_TC;
        const bool second = s >= (nc >> 1);
        const int tid = opaque_tid(), ltid = tid & 255, ri = ltid >> 3, jq = ltid & 7, fr = tid & 15, fq = (tid >> 4) & 3;
        { const int tl = (ltid & 127) >> 3, g = ltid & 7; float o[8];
          if (lw < 2) {
              unpack8(q1, o);
              *(float4*)(sVec + tl * 320 + 8 * g) = make_float4(o[0], o[1], o[2], o[3]); *(float4*)(sVec + tl * 320 + 8 * g + 4) = make_float4(o[4], o[5], o[6], o[7]);
              *(uint4*)(sXw + tl * 72 + 8 * g) = q2;
          } else {
              unpack8(q1, o);
              float kkr[8]; float ss = 0.f;
#pragma unroll
              for (int i = 0; i < 8; ++i) { kkr[i] = o[i] * p.kk[hc + 8 * g + i]; ss += kkr[i] * kkr[i]; }
              ss = red8(ss); const float rn = __builtin_amdgcn_rsqf(fmaxf(ss, 1e-24f));
              *(float4*)(sKr + tl * 64 + 8 * g) = make_float4(o[0], o[1], o[2], o[3]); *(float4*)(sKr + tl * 64 + 8 * g + 4) = make_float4(o[4], o[5], o[6], o[7]);
              *(float4*)(sVec + tl * 320 + 192 + 8 * g) = make_float4(kkr[0] * rn, kkr[1] * rn, kkr[2] * rn, kkr[3] * rn); *(float4*)(sVec + tl * 320 + 192 + 8 * g + 4) = make_float4(kkr[4] * rn, kkr[5] * rn, kkr[6] * rn, kkr[7] * rn);
              *(uint4*)(sXa + tl * 72 + 8 * g) = q2;
          }
          if (lw == 0) {
              const int tl2 = ltid >> 2, g2 = ltid & 3;
              unpack8(q3, o);
              *(float4*)(sV + tl2 * 32 + 8 * g2) = make_float4(o[0], o[1], o[2], o[3]); *(float4*)(sV + tl2 * 32 + 8 * g2 + 4) = make_float4(o[4], o[5], o[6], o[7]);
          } }
        __syncthreads();
        { f32x4 aw = (f32x4){0.f, 0.f, 0.f, 0.f}, aa = (f32x4){0.f, 0.f, 0.f, 0.f};
#pragma unroll
          for (int ks = 0; ks < 2; ++ks) { const bf16x8 xw = *(const bf16x8*)(sXw + fr * 72 + 32 * ks + 8 * fq), xa = *(const bf16x8*)(sXa + fr * 72 + 32 * ks + 8 * fq);
              aw = mfma16(xw, wfrag[ks], aw); aa = mfma16(xa, afrag[ks], aa); }
          const int j = 16 * lw + fr;
#pragma unroll
          for (int jj = 0; jj < 4; ++jj) { const int tl = 4 * fq + jj;
              const float dec = fexp(-fexp(-softplus_fast(-(w0v + aw[jj])) - 0.5f));
              const float a = sigmf(a0v + aa[jj]); const float k = sKr[tl * 64 + j], kn = sVec[tl * 320 + 192 + j];
              float* V = sVec + tl * 320 + j; V[64] = dec; V[128] = k * (1.f + (a - 1.f) * kav); V[256] = kn * a; } }
        const int otl = ltid >> 4, opr = ltid & 15; unsigned* hb = (unsigned*)(HB + (row0 + tok0 + otl) * DM + 512 + hc + 32 * rh + 2 * opr);
        unsigned ov = 0u;
        if (second) ov = __hip_atomic_load(hb, __ATOMIC_RELAXED, __HIP_MEMORY_SCOPE_AGENT);
        if (s + 1 < nc) { const int cn = dir ? nc - 2 - s : s + 1, tokn = cn * RW_TC; const int tl = (ltid & 127) >> 3, g = ltid & 7;
            q1 = *(const uint4*)(Ub + ((tokn + tl) * UW + (lw < 2 ? 2048 : 2048 + 512) + hc + 8 * g) * 2);
            q2 = *(const uint4*)(Ub + ((tokn + tl) * UW + (lw < 2 ? 2048 + 1536 : 2048 + 1664) + dir * 64 + 8 * g) * 2);
            if (lw == 0) q3 = *(const uint4*)(Ub + ((tokn + (ltid >> 2)) * UW + 2048 + 1024 + hc + 32 * rh + 8 * (ltid & 3)) * 2); }
        LDS_BARRIER();
        f32x2 sv_[4];
#pragma unroll
        for (int q = 0; q < 4; ++q) sv_[q] = st2[q];
#pragma unroll 1
        for (int rep = 0; rep < (PROBE_DUP == 102 ? 2 : 1); ++rep) {
        if (PROBE_DUP == 102) {
#pragma unroll
            for (int q = 0; q < 4; ++q) st2[q] = sv_[q]; }
float ys[RW_TC];
#pragma unroll
        for (int step = 0; step < RW_TC; ++step) { const int tl = dir ? RW_TC - 1 - step : step; const float* V = sVec + tl * 320 + jq * 8;
            const float4 ka4 = *(const float4*)(V + 192), kb4 = *(const float4*)(V + 196);
            f32x2 acc = st2[0] * (f32x2){ka4.x, ka4.y}; acc = st2[1] * (f32x2){ka4.z, ka4.w} + acc; acc = st2[2] * (f32x2){kb4.x, kb4.y} + acc; acc = st2[3] * (f32x2){kb4.z, kb4.w} + acc;
            const float sa = -red8(acc.x + acc.y);
            const float vi = sV[tl * 32 + ri];
            const float4 wa = *(const float4*)(V + 64), wb = *(const float4*)(V + 68), ba = *(const float4*)(V + 256), bb = *(const float4*)(V + 260),
                         da = *(const float4*)(V + 128), db = *(const float4*)(V + 132), ra = *(const float4*)(V), rb = *(const float4*)(V + 4);
            const f32x2 sa2 = (f32x2){sa, sa}, vi2 = (f32x2){vi, vi};
            st2[0] = st2[0] * (f32x2){wa.x, wa.y} + (sa2 * (f32x2){ba.x, ba.y} + vi2 * (f32x2){da.x, da.y});
            st2[1] = st2[1] * (f32x2){wa.z, wa.w} + (sa2 * (f32x2){ba.z, ba.w} + vi2 * (f32x2){da.z, da.w});
            st2[2] = st2[2] * (f32x2){wb.x, wb.y} + (sa2 * (f32x2){bb.x, bb.y} + vi2 * (f32x2){db.x, db.y});
            st2[3] = st2[3] * (f32x2){wb.z, wb.w} + (sa2 * (f32x2){bb.z, bb.w} + vi2 * (f32x2){db.z, db.w});
            f32x2 ya = st2[0] * (f32x2){ra.x, ra.y}; ya = st2[1] * (f32x2){ra.z, ra.w} + ya; ya = st2[2] * (f32x2){rb.x, rb.y} + ya; ya = st2[3] * (f32x2){rb.z, rb.w} + ya;
            const float y = red8(ya.x + ya.y);
            ys[step] = y; }
        if (jq == 0) {
#pragma unroll
            for (int step = 0; step < RW_TC; ++step) sY[(dir ? RW_TC - 1 - step : step) * 32 + ri] = ys[step]; }
        }
        LDS_BARRIER();
        { float y0 = sY[otl * 32 + 2 * opr], y1 = sY[otl * 32 + 2 * opr + 1];
          if (second) { y0 += __uint_as_float(ov << 16); y1 += __uint_as_float(ov & 0xffff0000u); }
          *hb = pk2(y0, y1); }
    }
#pragma unroll
    for (int q = 0; q < 4; ++q) { st[2 * q] = st2[q].x; st[2 * q + 1] = st2[q].y; }
    if (ctx) { const int tid = opaque_tid(), ltid = tid & 255, ri = ltid >> 3, jq = ltid & 7;
        float* So = p.out + OUT_S + ((size_t)((bg * 2 + dir) * 8 + h)) * 4096 + (32 * rh + ri) * 64 + jq * 8;
#pragma unroll
        for (int q = 0; q < 8; ++q) So[q] = st[q]; }
    __syncthreads();
}

constexpr int RX_VEC = 0,
              RX_KR = RX_VEC + 16 * 320 * 4,
              RX_XW = RX_KR + 4096, RX_XA = RX_XW + 2304,
              RX_Y = RX_XA + 2304,
              RX_KT = RX_Y + 4096, RX_KTN = RX_KT + 2304, RX_RT = RX_KTN + 2304, RX_RTN = RX_RT + 2304, RX_BN = RX_RTN + 2304, RX_DN = RX_BN + 2304,
              RX_BTS = RX_DN + 2304, RX_DT = RX_BTS + 5120, RX_VT = RX_DT + 5120,
              RX_ADK = RX_VT + 5120, RX_ABR = RX_ADK + 1280, RX_ADR = RX_ABR + 1280, RX_TM = RX_ADR + 1280,
              RX_N = RX_TM + 1280,
              RX_PL = RX_N + 1088,
              RX_DIR = RX_PL + 256;
static_assert(2 * RX_DIR <= LDS_BYTES - 64 && RX_DIR % 16 == 0, "rwkv (chunked) lds");
__device__ __forceinline__ int perm_pi(int j) { const int jj = j & 31; return (j & 32) + 8 * ((jj & 15) >> 2) + (jj & 3) + 4 * (jj >> 4); }
__device__ __forceinline__ int perm_sg(int c) { return 8 * (c >> 2) + (c & 3); }
__device__ __forceinline__ bf16x8 pack_acc_lo(const f32x4 v) { union { uint4 u; bf16x8 b; } c; c.u = make_uint4(pk2(v[0], v[1]), pk2(v[2], v[3]), 0u, 0u); return c.b; }
__device__ __forceinline__ bf16x8 pack_acc2(const f32x4 a, const f32x4 b) { union { uint4 u; bf16x8 v; } c; c.u = make_uint4(pk2(a[0], a[1]), pk2(a[2], a[3]), pk2(b[0], b[1]), pk2(b[2], b[3])); return c.v; }

__device__ __forceinline__ void rwkv_task_w(const P& p, unsigned char* lds, int bg, int h) {
    const int wv = __builtin_amdgcn_readfirstlane((int)threadIdx.x >> 6), dir = wv >> 2, lw = wv & 3;
    const bool ctx = bg < 32; const int T = ctx ? 256 : 2048, nc = T / 16; const size_t row0 = ctx ? (size_t)bg * 256 : (size_t)NCTX + (size_t)(bg - 32) * 2048;
    unsigned char* L = lds + dir * RX_DIR;
    float* sVec = (float*)(L + RX_VEC); float* sKr = (float*)(L + RX_KR); bf16_t* sXw = (bf16_t*)(L + RX_XW); bf16_t* sXa = (bf16_t*)(L + RX_XA); float* sY = (float*)(L + RX_Y);
    bf16_t* sKT = (bf16_t*)(L + RX_KT); bf16_t* sKTn = (bf16_t*)(L + RX_KTN); bf16_t* sRT = (bf16_t*)(L + RX_RT); bf16_t* sRTn = (bf16_t*)(L + RX_RTN); bf16_t* sBn = (bf16_t*)(L + RX_BN); bf16_t* sDn = (bf16_t*)(L + RX_DN);
    bf16_t* sBts = (bf16_t*)(L + RX_BTS); bf16_t* sDt = (bf16_t*)(L + RX_DT); bf16_t* sVT = (bf16_t*)(L + RX_VT);
    bf16_t* sAdk = (bf16_t*)(L + RX_ADK); bf16_t* sAbr = (bf16_t*)(L + RX_ABR); bf16_t* sAdr = (bf16_t*)(L + RX_ADR); bf16_t* sTm = (bf16_t*)(L + RX_TM);
    float* sN = (float*)(L + RX_N); float* sPL = (float*)(L + RX_PL);
    const bf16_t* U = (const bf16_t*)(p.ws + WS_U); bf16_t* HB = (bf16_t*)(p.ws + WS_A);
    const int hc = h * 64;
    f32x4 ST[4]; bf16x8 wfrag[2], afrag[2]; float w0v, a0v, kav, kkc[8];
    {
        const int tid = opaque_tid(), ltid = tid & 255, fr = tid & 15, fq = (tid >> 4) & 3;
        __syncthreads();
        for (int i = ltid; i < (RX_N - RX_BTS) / 4; i += 256) ((unsigned*)(L + RX_BTS))[i] = 0u;
        __syncthreads();
        if (ctx) {
#pragma unroll
            for (int jt = 0; jt < 4; ++jt) ST[jt] = (f32x4){0.f, 0.f, 0.f, 0.f};
        } else { const float* S0 = p.sS + ((size_t)(((bg - 32) * 2 + dir) * 8 + h)) * 4096 + (16 * lw + fr) * 64 + 4 * fq;
#pragma unroll
            for (int jt = 0; jt < 4; ++jt) { const float4 t = *(const float4*)(S0 + 16 * jt); ST[jt] = (f32x4){t.x, t.y, t.z, t.w}; } }
        const int jcol = hc + 16 * lw + fr;
#pragma unroll
        for (int ks = 0; ks < 2; ++ks) { float wf[8], af[8];
#pragma unroll
            for (int i = 0; i < 8; ++i) { const int l = 32 * ks + 8 * fq + i; wf[i] = p.w2[(size_t)(dir * 64 + l) * 512 + jcol]; af[i] = p.a2[(size_t)(dir * 64 + l) * 512 + jcol]; }
            union { uint4 u; bf16x8 v; } c1, c2; c1.u = make_uint4(pk2(wf[0], wf[1]), pk2(wf[2], wf[3]), pk2(wf[4], wf[5]), pk2(wf[6], wf[7])); c2.u = make_uint4(pk2(af[0], af[1]), pk2(af[2], af[3]), pk2(af[4], af[5]), pk2(af[6], af[7]));
            wfrag[ks] = c1.v; afrag[ks] = c2.v; }
        w0v = p.w0[dir * 512 + jcol]; a0v = p.a0[dir * 512 + jcol]; kav = p.ka[jcol];
#pragma unroll
        for (int i = 0; i < 8; ++i) kkc[i] = p.kk[hc + 8 * (ltid & 7) + i];
    }
    uint4 q1, q2, q3, n1a, n2a, n3a, n1b, n2b, n3b;
    const char* Ub = (const char*)(U + row0 * UW);
#define RX_LOAD(d1, d2, d3, sidx) do { const int s_ = (sidx) < nc ? (sidx) : nc - 1; const int c_ = dir ? nc - 1 - s_ : s_; const int tok_ = c_ * 16 + ((ltid_ & 127) >> 3); const int g_ = ltid_ & 7; \
        d1 = *(const uint4*)(Ub + (tok_ * UW + (lw < 2 ? 2048 : 2048 + 512) + hc + 8 * g_) * 2); \
        d2 = *(const uint4*)(Ub + (tok_ * UW + (lw < 2 ? 2048 + 1536 : 2048 + 1664) + dir * 64 + 8 * g_) * 2); \
        d3 = *(const uint4*)(Ub + (tok_ * UW + 2048 + 1024 + hc + 8 * g_) * 2); } while (0)
    { const int ltid_ = opaque_tid() & 255; RX_LOAD(q1, q2, q3, 0); RX_LOAD(n1a, n2a, n3a, 1); RX_LOAD(n1b, n2b, n3b, 2); }
#pragma unroll 1
    for (int s = 0; s < nc; ++s) {
        const int c = dir ? nc - 1 - s : s; const int tok0 = c * 16;
        const bool second = s >= (nc >> 1);
        const int tid = opaque_tid(), ltid = tid & 255, fr = tid & 15, fq = (tid >> 4) & 3;
        { const int tl = (ltid & 127) >> 3, g = ltid & 7, q = dir ? 15 - tl : tl; float o[8];
          if (lw < 2) {
              unpack8(q1, o);
              *(float4*)(sVec + q * 320 + 8 * g) = make_float4(o[0], o[1], o[2], o[3]); *(float4*)(sVec + q * 320 + 8 * g + 4) = make_float4(o[4], o[5], o[6], o[7]);
              *(uint4*)(sXw + q * 72 + 8 * g) = q2;
              const unsigned vw[4] = {q3.x, q3.y, q3.z, q3.w};
#pragma unroll
              for (int i = 0; i < 8; ++i) sVT[(8 * g + i) * 40 + q] = (bf16_t)((vw[i >> 1] >> ((i & 1) * 16)) & 0xffffu);
          } else {
              unpack8(q1, o);
              float kkr[8]; float ss = 0.f;
#pragma unroll
              for (int i = 0; i < 8; ++i) { kkr[i] = o[i] * kkc[i]; ss += kkr[i] * kkr[i]; }
              ss = red8(ss); const float rn = __builtin_amdgcn_rsqf(fmaxf(ss, 1e-24f));
              *(float4*)(sKr + q * 64 + 8 * g) = make_float4(o[0], o[1], o[2], o[3]); *(float4*)(sKr + q * 64 + 8 * g + 4) = make_float4(o[4], o[5], o[6], o[7]);
              *(float4*)(sVec + q * 320 + 192 + 8 * g) = make_float4(kkr[0] * rn, kkr[1] * rn, kkr[2] * rn, kkr[3] * rn); *(float4*)(sVec + q * 320 + 192 + 8 * g + 4) = make_float4(kkr[4] * rn, kkr[5] * rn, kkr[6] * rn, kkr[7] * rn);
              *(uint4*)(sXa + q * 72 + 8 * g) = q2;
          } }
        LDS_BARRIER();
        { f32x4 aw = (f32x4){0.f, 0.f, 0.f, 0.f}, aa = (f32x4){0.f, 0.f, 0.f, 0.f};
#pragma unroll
          for (int ks = 0; ks < 2; ++ks) { const bf16x8 xw = *(const bf16x8*)(sXw + fr * 72 + 32 * ks + 8 * fq), xa = *(const bf16x8*)(sXa + fr * 72 + 32 * ks + 8 * fq);
              aw = mfma16(xw, wfrag[ks], aw); aa = mfma16(xa, afrag[ks], aa); }
          const int j = 16 * lw + fr;
          float lg[4], av[4]; float run = 0.f;
#pragma unroll
          for (int e = 0; e < 4; ++e) { const float lw_ = -0.6065306597126334f * sigmf(w0v + aw[e])  ; run += lw_; lg[e] = run; av[e] = sigmf(a0v + aa[e]); }
          float x = run; { const float y1 = __shfl_up(x, 16); if (fq >= 1) x += y1; const float y2 = __shfl_up(x, 32); if (fq >= 2) x += y2; }
          const float excl = x - run;
          const int pj = perm_pi(j); bf16_t btv[4], dtv[4];
          float Pp = fexp(excl);
#pragma unroll
          for (int e = 0; e < 4; ++e) { const int q = 4 * fq + e; const float Lq = excl + lg[e];
              const float Pq = fexp(Lq), iP = __builtin_amdgcn_rcpf(Pq);
              const float k = sKr[q * 64 + j], kn = sVec[q * 320 + 192 + j], r = sVec[q * 320 + j];
              const float kd = k * (1.f + (av[e] - 1.f) * kav), b = kn * av[e];
              const bf16_t kt = f2bf(Pp * kn), rt = f2bf(Pq * r), bt = f2bf(b * iP), dt = f2bf(kd * iP);
              sKT[q * 72 + pj] = kt; sRT[q * 72 + pj] = rt; sBn[q * 72 + pj] = bt; sDn[q * 72 + pj] = dt;
              btv[e] = bt; dtv[e] = dt;
              if (q == 15) sPL[j] = Pq;
              Pp = Pq; }
          *(uint2*)(sBts + j * 40 + 8 * fq) = make_uint2((unsigned)btv[0] | ((unsigned)btv[1] << 16), (unsigned)btv[2] | ((unsigned)btv[3] << 16));
          *(uint2*)(sDt + j * 40 + 4 * fq) = make_uint2((unsigned)dtv[0] | ((unsigned)dtv[1] << 16), (unsigned)dtv[2] | ((unsigned)dtv[3] << 16)); }
        if (s == (nc >> 1)) asm volatile("s_waitcnt vmcnt(0)" ::: "memory"); else asm volatile("s_waitcnt vmcnt(6)" ::: "memory");
        LDS_BARRIER();
        { const int role = (lw - dir) & 3;
          f32x4 gacc = (f32x4){0.f, 0.f, 0.f, 0.f}; const bf16_t* Ap = (role < 2) ? sKT : sRT; const bf16_t* Bp = (role & 1) ? sDn : sBn;
#pragma unroll
          for (int ks = 0; ks < 2; ++ks) gacc = mfma16(*(const bf16x8*)(Ap + fr * 72 + 32 * ks + 8 * fq), *(const bf16x8*)(Bp + fr * 72 + 32 * ks + 8 * fq), gacc);
          const int sidx = fr;
          float gm[4];
#pragma unroll
          for (int e = 0; e < 4; ++e) { const int q = 4 * fq + e; const bool keep = (role < 2) ? (sidx < q) : (sidx <= q); gm[e] = keep ? gacc[e] : 0.f; }
          if (role == 0) {
              const int r = tid & 15; float Tr[16];
#pragma unroll
              for (int q = 0; q < 16; ++q) Tr[q] = (r == q) ? 1.f : 0.f;
#pragma unroll
              for (int q = 0; q < 15; ++q) { const float tq = Tr[q];
#pragma unroll
                  for (int q2 = q + 1; q2 < 16; ++q2) { const float nv = __int_as_float(__builtin_amdgcn_readlane(__float_as_int(gm[q2 & 3]), q + 16 * (q2 >> 2))); Tr[q2] -= tq * nv; } }
              if ((tid & 63) < 16) { const int ps = perm_sg(r);
#pragma unroll
                  for (int q = 0; q < 16; ++q) sTm[q * 40 + ps] = f2bf(Tr[q]); }
          } else {
#pragma unroll
              for (int e = 0; e < 4; ++e) { const int q = 4 * fq + e;
                  if (role == 1) sAdk[q * 40 + sidx] = f2bf(gm[e]);
                  else if (role == 2) sAbr[q * 40 + perm_sg(sidx)] = f2bf(gm[e]);
                  else sAdr[q * 40 + sidx] = f2bf(gm[e]); } } }
        const int oq = ltid >> 4, otl = dir ? 15 - oq : oq; unsigned long long* hb = (unsigned long long*)(HB + (row0 + tok0 + otl) * DM + 512 + hc + 4 * (ltid & 15));
        const unsigned long long ov = __hip_atomic_load(hb, __ATOMIC_RELAXED, __HIP_MEMORY_SCOPE_AGENT);
        q1 = n1a; q2 = n2a; q3 = n3a; n1a = n1b; n2a = n2b; n3a = n3b;
        { const int ltid_ = ltid; RX_LOAD(n1b, n2b, n3b, s + 3); }
        LDS_BARRIER();
        { const bf16x8 Sb0 = pack_acc2(ST[0], ST[1]), Sb1 = pack_acc2(ST[2], ST[3]);
          const bf16x8 vtf = *(const bf16x8*)(sVT + (16 * lw + fr) * 40 + 8 * fq);
          f32x4 XT = (f32x4){0.f, 0.f, 0.f, 0.f};
          XT = mfma16(*(const bf16x8*)(sKT + fr * 72 + 8 * fq), Sb0, XT); XT = mfma16(*(const bf16x8*)(sKT + fr * 72 + 32 + 8 * fq), Sb1, XT);
          XT = mfma16(*(const bf16x8*)(sAdk + fr * 40 + 8 * fq), vtf, XT);
          f32x4 SAT = mfma16(*(const bf16x8*)(sTm + fr * 40 + 8 * fq), pack_acc_lo(XT), (f32x4){0.f, 0.f, 0.f, 0.f});
          SAT = -SAT;
          const bf16x8 SAb = pack_acc_lo(SAT);
          f32x4 YT = (f32x4){0.f, 0.f, 0.f, 0.f};
          YT = mfma16(*(const bf16x8*)(sRT + fr * 72 + 8 * fq), Sb0, YT); YT = mfma16(*(const bf16x8*)(sRT + fr * 72 + 32 + 8 * fq), Sb1, YT);
          YT = mfma16(*(const bf16x8*)(sAbr + fr * 40 + 8 * fq), SAb, YT); YT = mfma16(*(const bf16x8*)(sAdr + fr * 40 + 8 * fq), vtf, YT);
#pragma unroll
          for (int jt = 0; jt < 4; ++jt) { ST[jt] = mfma16(*(const bf16x8*)(sBts + (16 * jt + fr) * 40 + 8 * fq), SAb, ST[jt]); ST[jt] = mfma16(*(const bf16x8*)(sDt + (16 * jt + fr) * 40 + 8 * fq), vtf, ST[jt]);
              const float4 pl = *(const float4*)(sPL + 16 * jt + 4 * fq); ST[jt][0] *= pl.x; ST[jt][1] *= pl.y; ST[jt][2] *= pl.z; ST[jt][3] *= pl.w; }
#pragma unroll
          for (int e = 0; e < 4; ++e) sY[(4 * fq + e) * 64 + 16 * lw + fr] = YT[e]; }
        LDS_BARRIER();
        { const float4 y4 = *(const float4*)(sY + oq * 64 + 4 * (ltid & 15)); float y0 = y4.x, y1 = y4.y, y2 = y4.z, y3 = y4.w;
          if (second) { const unsigned lo = (unsigned)ov, hi = (unsigned)(ov >> 32); y0 += __uint_as_float(lo << 16); y1 += __uint_as_float(lo & 0xffff0000u); y2 += __uint_as_float(hi << 16); y3 += __uint_as_float(hi & 0xffff0000u); }
          *hb = (unsigned long long)pk2(y0, y1) | ((unsigned long long)pk2(y2, y3) << 32); }
    }
#undef RX_LOAD
    if (ctx) { const int tid = opaque_tid(), fr = tid & 15, fq = (tid >> 4) & 3;
        float* So = p.out + OUT_S + ((size_t)((bg * 2 + dir) * 8 + h)) * 4096 + (16 * lw + fr) * 64 + 4 * fq;
#pragma unroll
        for (int jt = 0; jt < 4; ++jt) *(float4*)(So + 16 * jt) = make_float4(ST[jt][0], ST[jt][1], ST[jt][2], ST[jt][3]); }
    __syncthreads();
}

constexpr int FZ_ROW = 1800;
constexpr int FZ_X = 0, FZ_MU = 32 * FZ_ROW * 2, FZ_END = FZ_MU + 4 * 1792 * 4;
static_assert(FZ_END <= LDS_BYTES && FZ_MU % 16 == 0, "finalize lds");

__device__ __forceinline__ void phase_rwkv_finalize(const P& p, unsigned char* lds) {
    bf16_t* sX = (bf16_t*)(lds + FZ_X); float* sMu = (float*)(lds + FZ_MU);
    const bf16_t* U = (const bf16_t*)(p.ws + WS_U); bf16_t* HB = (bf16_t*)(p.ws + WS_A);
    { const bf16_t* HB2 = (const bf16_t*)(p.ws + WS_HB2); const int tid0 = opaque_tid(), lane = tid0 & 63, wave = (int)threadIdx.x >> 6;
#pragma unroll 1
      for (int row = NCTX + blockIdx.x * 8 + wave; row < MT; row += gridDim.x * 8) {
          float hf[8], hb[8], og[8], v[8]; float ss = 0.f;
          unpack8(*(const uint4*)(HB + (size_t)row * DM + lane * 8), hf); unpack8(*(const uint4*)(HB2 + (size_t)(row - NCTX) * 512 + lane * 8), hb); unpack8(*(const uint4*)(U + (size_t)row * UW + 1536 + lane * 8), og);
#pragma unroll
          for (int i = 0; i < 8; ++i) { v[i] = sigmf(og[i]) * (hf[i] + hb[i]); ss += v[i] * v[i]; }
          ss = red16(ss); const float rms = rsqrtf(ss * (1.f / 128.f) + 1e-6f);
          const float4 g0 = *(const float4*)(p.hg + lane * 8), g1 = *(const float4*)(p.hg + lane * 8 + 4);
          *(uint4*)(HB + (size_t)row * DM + lane * 8) = make_uint4(pk2(v[0] * rms * g0.x, v[1] * rms * g0.y), pk2(v[2] * rms * g0.z, v[3] * rms * g0.w), pk2(v[4] * rms * g1.x, v[5] * rms * g1.y), pk2(v[6] * rms * g1.z, v[7] * rms * g1.w)); } }
    const bf16_t* A2 = (const bf16_t*)(p.ws + WS_A2BF); const bf16_t* G2 = (const bf16_t*)(p.ws + WS_G2BF);
    const int wv = __builtin_amdgcn_readfirstlane((int)threadIdx.x >> 6), hc = wv * 64;
#pragma unroll 1
    for (int tile = blockIdx.x; tile < MT / 32; tile += gridDim.x) {
        const int tid = opaque_tid(), fr = tid & 15, fq = (tid >> 4) & 3;
        const int rowt = tile * 32; const bool ctx = rowt < NCTX; const int T = ctx ? 256 : 2048; const size_t row0 = ctx ? (size_t)(rowt & ~255) : (size_t)NCTX + (size_t)((rowt - NCTX) & ~2047);
        const int tokt = rowt - (int)row0;
        __syncthreads();
#pragma unroll 2
        for (int it = 0; it < 14; ++it) { const int item = it * NTHR + tid, tl = item / 224, gi = item % 224;
            const int c0 = gi < 192 ? 2048 + 8 * gi : 2048 + 1664 + 8 * (gi - 192);
            *(uint4*)(sX + tl * FZ_ROW + 8 * gi) = *(const uint4*)(U + (row0 + tokt + tl) * UW + c0); }
        __syncthreads();
#pragma unroll 1
        for (int rt = 0; rt < 2; ++rt) {
            f32x4 af[4], ab[4], gg[4];
#pragma unroll
            for (int ct = 0; ct < 4; ++ct) { af[ct] = (f32x4){0.f, 0.f, 0.f, 0.f}; ab[ct] = af[ct]; gg[ct] = af[ct]; }
            const bf16_t* xr = sX + (16 * rt + fr) * FZ_ROW;
#pragma unroll
            for (int ks = 0; ks < 2; ++ks) { const bf16x8 xf = *(const bf16x8*)(xr + 1536 + 32 * ks + 8 * fq), xb = *(const bf16x8*)(xr + 1600 + 32 * ks + 8 * fq);
#pragma unroll
                for (int ct = 0; ct < 4; ++ct) { const int n = hc + 16 * ct + fr;
                    af[ct] = mfma16(xf, *(const bf16x8*)(A2 + (size_t)n * 64 + 32 * ks + 8 * fq), af[ct]);
                    ab[ct] = mfma16(xb, *(const bf16x8*)(A2 + (size_t)(512 + n) * 64 + 32 * ks + 8 * fq), ab[ct]); } }
#pragma unroll
            for (int ks = 0; ks < 4; ++ks) { const bf16x8 xg = *(const bf16x8*)(xr + 1664 + 32 * ks + 8 * fq);
#pragma unroll
                for (int ct = 0; ct < 4; ++ct) { const int n = hc + 16 * ct + fr; gg[ct] = mfma16(xg, *(const bf16x8*)(G2 + (size_t)n * 128 + 32 * ks + 8 * fq), gg[ct]); } }
#pragma unroll
            for (int jj = 0; jj < 4; ++jj) { const int tl = 16 * rt + 4 * fq + jj; const size_t row = (size_t)rowt + tl; const bf16_t* xt = sX + tl * FZ_ROW;
                bf16_t* hb = HB + row * DM + 512 + hc;
                float y[4], vv[4]; float sy = 0.f, sb = 0.f;
#pragma unroll
                for (int ct = 0; ct < 4; ++ct) { const int ch = hc + 16 * ct + fr;
                    const float am = 0.5f * (sigmf(p.a0[ch] + af[ct][jj]) + sigmf(p.a0[512 + ch] + ab[ct][jj]));
                    const float r = bf2f(xt[ch]), k = bf2f(xt[512 + ch]); vv[ct] = bf2f(xt[1024 + ch]);
                    sb += r * k * (1.f + (am - 1.f) * p.ka[ch]) * p.rk[ch];
                    y[ct] = bf2f(hb[16 * ct + fr]); sy += y[ct]; }
                sy = red16(sy); sb = red16(sb);
                const float mean = sy * (1.f / 64.f); float vs = 0.f;
#pragma unroll
                for (int ct = 0; ct < 4; ++ct) { const float d = y[ct] - mean; vs += d * d; }
                vs = red16(vs); const float rstd = rsqrtf(vs * (1.f / 64.f) + 64e-5f);
#pragma unroll
                for (int ct = 0; ct < 4; ++ct) { const int ch = hc + 16 * ct + fr; const float yn = (y[ct] - mean) * rstd * p.lng[ch] + p.lnb[ch];
                    hb[16 * ct + fr] = f2bf((yn + sb * vv[ct]) * gg[ct][jj]); } }
        }
    }
}

__device__ __forceinline__ void phase_scan(const P& p, unsigned char* lds, int round = 0) {
    unsigned* ctr = (unsigned*)(p.ws + WS_CTR) + round;
    volatile int* sTask = (volatile int*)(lds + LDS_BYTES - 16);
#pragma unroll 1
    for (;;) {
        __syncthreads();
        if (threadIdx.x == 0) *sTask = (int)atomicAdd(ctr, 1u);
        __syncthreads();
        const int t = __builtin_amdgcn_readfirstlane(*sTask);
        if (t >= 512) break;
#pragma unroll 1
        for (int rep = 0; rep < ((PROBE_DUP == 100 && (t < 64 || (t >= 128 && t < 256))) || (PROBE_DUP == 101 && !(t < 64 || (t >= 128 && t < 256))) ? 2 : 1); ++rep) {
        if (t < 64) mlstm_task(p, lds, 32 + (t >> 3), (t >> 1) & 3, t & 1);
        else if (t < 128) { const int q = t - 64; rwkv_task_w(p, lds, 32 + (q >> 3), q & 7); }
        else if (t < 256) { const int q = t - 128; mlstm_task(p, lds, q >> 2, q & 3, -1); }
        else { const int q = t - 256; rwkv_task_w(p, lds, q >> 3, q & 7); }
        }
    }
}

__device__ void phase_convert_w2(const P& p, unsigned char* lds) {
    float* tile = (float*)lds;
    const int t1 = 16 * 88, t2 = 44 * 16;
    const int nb = gridDim.x, lo = nb > 128 ? 128 : 0;
    if ((int)blockIdx.x < lo) return;
    for (int it = blockIdx.x - lo; it < t1 + t2; it += nb - lo) {
        if (it < t1) do_convert(p.w2in, (bf16_t*)(p.ws + WS_W1), 1024, 5632, 5632, 1, it, tile);
        else do_convert(p.w2out, (bf16_t*)(p.ws + WS_W1B), 2816, 1024, 1024, 0, it - t1, tile);
    }
}

#define XB_TMO      128
#define XB_XCNT(j)  (256  + 64 * (j))
#define XB_XSUB(j)  (1280 + 64 * (j))
#define XB_XGEN(j)  (2304 + 64 * (j))
#define XB_TOP      3328
#define XB_TOPGEN   3392
#define XCD_BAR_WORDS 3456
#define XB_SPIN_CAP (1u << 18)
__device__ __forceinline__ unsigned xb_ld(unsigned* p)              { return __hip_atomic_load(p, __ATOMIC_RELAXED, __HIP_MEMORY_SCOPE_AGENT); }
__device__ __forceinline__ unsigned xb_add(unsigned* p, unsigned v) { return __hip_atomic_fetch_add(p, v, __ATOMIC_RELAXED, __HIP_MEMORY_SCOPE_AGENT); }
__device__ __forceinline__ unsigned xb_xcc_id() { return (unsigned)__builtin_amdgcn_s_getreg((3 << 11) | 20) & 0xFu; }
#define XB_SPIN(cond, bar) do { unsigned _sp = 0; while (cond) { __builtin_amdgcn_s_sleep(1); \
    if ((++_sp & 255u) == 0u) { if (xb_ld(&(bar)[XB_TMO])) break; if (_sp > XB_SPIN_CAP) { atomicAdd(&(bar)[XB_TMO], 1u); break; } } } } while (0)
struct XcdBarrier { unsigned* bar; unsigned x; volatile unsigned* st; };
__device__ __forceinline__ XcdBarrier xcd_barrier_post(unsigned* bar, volatile unsigned* st) {
    XcdBarrier b; b.bar = bar; b.x = xb_xcc_id(); b.st = st;
    if (threadIdx.x == 0) (void)xb_add(&bar[XB_XCNT(b.x)], 1u);
    return b;
}
__device__ __forceinline__ void xcd_barrier_complete(unsigned* bar, unsigned x, unsigned& nloc, unsigned& nx) {
    const unsigned G = gridDim.x * gridDim.y * gridDim.z;
    unsigned sum, cnt, mine, sp = 0u;
    for (;;) {
        sum = 0u; cnt = 0u; mine = 0u;
#pragma unroll
        for (unsigned j = 0; j < 16; ++j) { const unsigned c = xb_ld(&bar[XB_XCNT(j)]); sum += c; cnt += (c > 0u) ? 1u : 0u; mine = (j == x) ? c : mine; }
        if (sum == G) break;
        __builtin_amdgcn_s_sleep(1);
        if ((++sp & 255u) == 0u) { if (xb_ld(&bar[XB_TMO])) break; if (sp > XB_SPIN_CAP) { atomicAdd(&bar[XB_TMO], 1u); break; } }
    }
    nloc = mine > 0u ? mine : 1u; nx = cnt > 0u ? cnt : 1u;
}
__device__ __forceinline__ void xcd_barrier(const XcdBarrier& b) {
    asm volatile("s_waitcnt vmcnt(0)" ::: "memory");
    __syncthreads();
    if (threadIdx.x == 0) {
        unsigned* bar = b.bar;
        __builtin_amdgcn_s_waitcnt(0);
        unsigned nloc = b.st[0], nx = b.st[1];
        if (nloc == 0u) { xcd_barrier_complete(bar, b.x, nloc, nx); b.st[0] = nloc; b.st[1] = nx; }
        const unsigned old = xb_add(&bar[XB_XSUB(b.x)], 1u);
        const unsigned gen = old / nloc;
        if (old + 1u == (gen + 1u) * nloc) {
            __builtin_amdgcn_fence(__ATOMIC_RELEASE, "agent");
            asm volatile("s_waitcnt vmcnt(0)" ::: "memory");
            const unsigned og = xb_add(&bar[XB_TOP], 1u);
            const unsigned tg = og / nx;
            if (og + 1u == (tg + 1u) * nx) xb_add(&bar[XB_TOPGEN], 1u);
            else XB_SPIN(xb_ld(&bar[XB_TOPGEN]) == tg, bar);
            __builtin_amdgcn_fence(__ATOMIC_ACQUIRE, "agent");
            xb_add(&bar[XB_XGEN(b.x)], 1u);
            asm volatile("s_waitcnt vmcnt(0)" ::: "memory");
        } else {
            XB_SPIN(xb_ld(&bar[XB_XGEN(b.x)]) == gen, bar);
            __builtin_amdgcn_fence(__ATOMIC_ACQUIRE, "agent");
            asm volatile("s_waitcnt vmcnt(0)" ::: "memory");
        }
    }
    __syncthreads();
}

constexpr int NPHASE = 12;
template <int PH>
__device__ __forceinline__ void run_phase(const P& p, unsigned char* lds) {
    const float* mod = (const float*)(p.ws + WS_MOD);
    if constexpr (PH == 0) phase0(p, lds);
    if constexpr (PH == 1) phase_normmod(p, 0);
    if constexpr (PH == 2) { EpiSwiglu E{(bf16_t*)(p.ws + WS_U)}; run_gemm(lds, (const bf16_t*)(p.ws + WS_A), (const bf16_t*)(p.ws + WS_W1), 5632, 1024, E); }
    if constexpr (PH == 3) { EpiResid E{p.xp, p.xs, p.out, mod + 2048, 0.5f, 0}; run_gemm(lds, (const bf16_t*)(p.ws + WS_U), (const bf16_t*)(p.ws + WS_W1B), 1024, 2816, E); }
    if constexpr (PH == 4) phase_normmod(p, 1);
    if constexpr (PH == 5) { EpiU E{(bf16_t*)(p.ws + WS_U), (float*)(p.ws + WS_GATES)}; run_gemm(lds, (const bf16_t*)(p.ws + WS_A), (const bf16_t*)(p.ws + WS_BT3), 4096, 1024, E); }
    if constexpr (PH == 6) phase_scan(p, lds);
    if constexpr (PH == 12) phase_rwkv_finalize(p, lds);
    if constexpr (PH == 13) phase_shift((bf16_t*)(p.ws + WS_U), p.mu, (uint4*)lds);
    if constexpr (PH == 7) { EpiResid E{p.xp, p.xs, p.out, mod + 5120, 1.0f, 1}; run_gemm(lds, (const bf16_t*)(p.ws + WS_A), (const bf16_t*)(p.ws + WS_BT4), 1024, 1024, E); phase_convert_w2(p, lds); }
    if constexpr (PH == 8) phase_normmod(p, 2);
    if constexpr (PH == 9) { EpiSwiglu E{(bf16_t*)(p.ws + WS_U)}; run_gemm(lds, (const bf16_t*)(p.ws + WS_A), (const bf16_t*)(p.ws + WS_W1), 5632, 1024, E); }
    if constexpr (PH == 10) { EpiResid E{p.xp, p.xs, p.out, mod + 8192, 0.5f, 1}; run_gemm(lds, (const bf16_t*)(p.ws + WS_U), (const bf16_t*)(p.ws + WS_W1B), 1024, 2816, E); }
    if constexpr (PH == 11) phase_finalnorm(p);
}

#if !ONE_LAUNCH
template <int PH>
__global__ void __launch_bounds__(NTHR, 2) k_phase(P p) {
    extern __shared__ __attribute__((aligned(16))) unsigned char lds[];
    run_phase<PH>(p, lds);
}
#endif

#if ONE_LAUNCH
__global__ void __launch_bounds__(NTHR, 2) k_mega(P p) {
    extern __shared__ __attribute__((aligned(16))) unsigned char lds[];
    cg::grid_group grid = cg::this_grid();
    volatile unsigned* xst = (volatile unsigned*)(lds + LDS_BYTES - 32);
    if (threadIdx.x == 0) { xst[0] = 0u; xst[1] = 0u; }
    __syncthreads();
    const XcdBarrier xbar = xcd_barrier_post((unsigned*)(p.ws + WS_BAR), xst);
#define GSYNC() xcd_barrier(xbar)
    if (p.ws == nullptr) grid.sync();
    run_phase<0>(p, lds); GSYNC();
    if (PROBE_DUP == 0) { run_phase<0>(p, lds); GSYNC(); }
    run_phase<1>(p, lds); GSYNC();
    if (PROBE_DUP == 1) { run_phase<1>(p, lds); GSYNC(); }
    run_phase<2>(p, lds); GSYNC();
    if (PROBE_DUP == 2 || PROBE_DUP == 235) { run_phase<2>(p, lds); GSYNC(); }
    run_phase<3>(p, lds); GSYNC();
    if (PROBE_DUP == 3 || PROBE_DUP == 235) { run_phase<3>(p, lds); GSYNC(); }
    run_phase<4>(p, lds); GSYNC();
    if (PROBE_DUP == 4) { run_phase<4>(p, lds); GSYNC(); }
    run_phase<5>(p, lds); GSYNC();
    if (PROBE_DUP == 5 || PROBE_DUP == 235) { run_phase<5>(p, lds); GSYNC(); }
    run_phase<13>(p, lds); GSYNC();
    run_phase<6>(p, lds); GSYNC();
    if (PROBE_DUP == 6) { phase_scan(p, lds, 1); GSYNC(); }
    run_phase<12>(p, lds); GSYNC();
    run_phase<7>(p, lds); GSYNC();
    if (PROBE_DUP == 7) { run_phase<7>(p, lds); GSYNC(); }
    run_phase<8>(p, lds); GSYNC();
    if (PROBE_DUP == 8) { run_phase<8>(p, lds); GSYNC(); }
    run_phase<9>(p, lds); GSYNC();
    if (PROBE_DUP == 9) { run_phase<9>(p, lds); GSYNC(); }
    run_phase<10>(p, lds); GSYNC();
    if (PROBE_DUP == 10) { run_phase<10>(p, lds); GSYNC(); }
    run_phase<11>(p, lds);
    if (PROBE_DUP == 200) { for (int i = 0; i < 20; ++i) GSYNC(); }
}
#endif

#if !ONE_LAUNCH
template <int PH> static void launch_phase(const P& p, int grid, hipStream_t stream) {
    static bool attr = false;
    if (!attr) { (void)hipFuncSetAttribute((const void*)k_phase<PH>, hipFuncAttributeMaxDynamicSharedMemorySize, LDS_BYTES); attr = true; }
    hipLaunchKernelGGL(k_phase<PH>, dim3(grid), dim3(NTHR), LDS_BYTES, stream, p);
}
#endif

extern "C" void kernel_launch(void* const* d_in, const int* in_sizes, int n_in, void* d_out, int out_size, void* d_ws, size_t ws_size, hipStream_t stream) {
    (void)in_sizes; (void)n_in; (void)out_size; (void)ws_size;
    static int grid = 0;
    if (grid == 0) {
        int dev = 0, cus = 0;
        if (hipGetDevice(&dev) != hipSuccess || hipDeviceGetAttribute(&cus, hipDeviceAttributeMultiprocessorCount, dev) != hipSuccess || cus <= 0) cus = 256;
#if ONE_LAUNCH
        (void)hipFuncSetAttribute((const void*)k_mega, hipFuncAttributeMaxDynamicSharedMemorySize, LDS_BYTES);
        int per_cu = 0;
        if (hipOccupancyMaxActiveBlocksPerMultiprocessor(&per_cu, (const void*)k_mega, NTHR, LDS_BYTES) != hipSuccess || per_cu < 1) per_cu = 1;
        (void)hipGetLastError();
#endif
        grid = cus;
    }
    P p{};
    const float** f = (const float**)&p;
    for (int i = 0; i < 35; ++i) f[i] = (const float*)d_in[i];
    p.out = (float*)d_out; p.ws = (unsigned char*)d_ws;
    (void)hipMemsetAsync((char*)d_ws + WS_MOD, 0, NCOND * MODW * sizeof(float) + 256 + 3456 * 4, stream);
#if ONE_LAUNCH
    void* args[] = {&p};
    hipError_t e = hipLaunchCooperativeKernel((const void*)k_mega, dim3(grid), dim3(NTHR), args, LDS_BYTES, stream);
    if (e != hipSuccess) fprintf(stderr, "cooperative launch failed: %s (grid %d)\n", hipGetErrorString(e), grid);
#else
    launch_phase<0>(p, grid, stream); launch_phase<1>(p, grid, stream); launch_phase<2>(p, grid, stream); launch_phase<3>(p, grid, stream);
    launch_phase<4>(p, grid, stream); launch_phase<5>(p, grid, stream); launch_phase<13>(p, grid, stream); launch_phase<6>(p, grid, stream); launch_phase<12>(p, grid, stream); launch_phase<7>(p, grid, stream);
    launch_phase<8>(p, grid, stream); launch_phase<9>(p, grid, stream); launch_phase<10>(p, grid, stream); launch_phase<11>(p, grid, stream);
#endif
}
```

```cpp
#include <hip/hip_runtime.h>
#include <hip/hip_cooperative_groups.h>
#include <cstdio>
#include <cstdint>
namespace cg = cooperative_groups;

#ifndef PROBE_DUP
#define PROBE_DUP -1
#endif
#ifndef ONE_LAUNCH
#define ONE_LAUNCH 1
#endif

#define LDS_BARRIER() do { asm volatile("s_waitcnt lgkmcnt(0)" ::: "memory"); __builtin_amdgcn_s_barrier(); asm volatile("" ::: "memory"); } while (0)
__device__ __forceinline__ int opaque_tid() { int z = 0; asm volatile("" : "+v"(z)); return (int)threadIdx.x + z; }

namespace pg8 {
#define PG8_LAS __attribute__((address_space(3)))
typedef unsigned short bf16_t;
typedef short bf16x8 __attribute__((ext_vector_type(8)));
typedef float f32x4 __attribute__((ext_vector_type(4)));
typedef unsigned u32x4 __attribute__((ext_vector_type(4)));
constexpr int BM = 256, BK = 64, HALF = 128, HTB = HALF * BK * 2, STAGE_BYTES = 8 * HTB, NXCD = 8, WGM = 8;

__host__ __device__ __forceinline__ int lds_byte(int r, int c) { const int st = (r >> 4) * 2 + (c >> 5), rr = r & 15, cc = c & 31, ob = rr * 64 + cc * 2; return st * 1024 + (ob ^ (((ob >> 9) & 1) << 5)); }
__host__ __device__ __forceinline__ void stage_rc(int b, int& R, int& C) { const int st = b / 1024, sb = b % 1024, swz = sb ^ (((sb >> 9) & 1) << 5); R = (st >> 1) * 16 + swz / 64; C = (st & 1) * 32 + (swz % 64) / 2; }
__host__ __device__ __forceinline__ int perm32(int rho) { const int n = rho >> 4, i = rho & 15; return 8 * (i >> 2) + 4 * n + (i & 3); }

struct Unit { int pm, pn; };
struct Gemm { const bf16_t* A; const bf16_t* Bt; int M, N, K; };

struct StaticOrder {
    int nM, nN, nwg, G, c;
    __host__ __device__ void init(int M, int N, int G_, int c_) { nM = M / BM; nN = N / BM; nwg = nM * nN; G = G_; c = c_; }
    __host__ __device__ bool next(int i, Unit& u) const {
        const long L = (long)i * G + c; if (L >= nwg) return false;
        int wgid = (int)L; { const int q = nwg / NXCD, r = nwg % NXCD, xcd = wgid % NXCD, off = wgid / NXCD; wgid = (xcd < r ? xcd * (q + 1) : r * (q + 1) + (xcd - r) * q) + off; }
        const int nig = WGM * nN, gid = wgid / nig, fm = gid * WGM, gsz = (nM - fm) < WGM ? (nM - fm) : WGM;
        u.pm = fm + ((wgid % nig) % gsz); u.pn = (wgid % nig) / gsz; return true;
    }
    __device__ __forceinline__ void a_ready(const Unit&) const {}
    __device__ __forceinline__ void done(const Unit&) const {}
};

__device__ __forceinline__ unsigned cvt_pk_bf16(float lo, float hi) { unsigned r; asm volatile("v_cvt_pk_bf16_f32 %0, %1, %2" : "=v"(r) : "v"(lo), "v"(hi)); return r; }

template <class Epi, class Sched, bool ALIGN_EPI = false, bool SP2 = false>
__device__ __forceinline__ void gemm_phase(PG8_LAS unsigned char* lds, const Gemm g, const Sched& S, const Epi& E) {
    const int tid = opaque_tid(), wid = __builtin_amdgcn_readfirstlane((int)threadIdx.x >> 6), lane = tid & 63, wr = wid >> 2, wc = wid & 3, fr = lane & 15, fq = lane >> 4;
    const int K = g.K, nt = K / BK;
    unsigned voffA[2], voffB[2];
#pragma unroll
    for (int i = 0; i < 2; ++i) { int R, C; stage_rc(tid * 16 + i * 8192, R, C); const int Rb = Epi::PERM ? ((R & ~31) + perm32(R & 31)) : R;
        voffA[i] = (unsigned)(R * K + C) * 2u; voffB[i] = (unsigned)(Rb * K + C) * 2u; }
    const size_t kstep = (size_t)(BK * 2);
    const size_t hstep = (size_t)HALF * K * 2;
    const size_t tstep = 2 * hstep;
    const unsigned ldsw = (unsigned)wid * 1024u;
    const int aoff = lds_byte(wr * 64 + fr, fq * 8), boff = lds_byte(wc * 32 + fr, fq * 8);
#define PG8_SA(b, h) (((b) * 2 + (h)) * HTB)
#define PG8_SB(b, h) ((4 + (b) * 2 + (h)) * HTB)
#define PG8_STAGE(bufoff, gbase, voff) do { _Pragma("unroll") for (int _i = 0; _i < 2; ++_i) \
        __builtin_amdgcn_global_load_lds((const unsigned*)((const char*)(gbase) + (voff)[_i]), (PG8_LAS unsigned*)(lds + (bufoff) + ldsw + _i * 8192), 16, 0, 0); } while (0)
#define PG8_LDA(dst, b, h) do { _Pragma("unroll") for (int m = 0; m < 4; ++m) _Pragma("unroll") for (int k = 0; k < 2; ++k) dst[m][k] = *(const PG8_LAS bf16x8*)(lds + PG8_SA(b, h) + aoff + m * 2048 + k * 1024); } while (0)
#define PG8_LDB(dst, b, h) do { _Pragma("unroll") for (int n = 0; n < 2; ++n) _Pragma("unroll") for (int k = 0; k < 2; ++k) dst[n][k] = *(const PG8_LAS bf16x8*)(lds + PG8_SB(b, h) + boff + n * 2048 + k * 1024); } while (0)
#define PG8_MMA(ai, bj, At, Bt) do { __builtin_amdgcn_s_setprio(1); _Pragma("unroll") for (int m = 0; m < 4; ++m) _Pragma("unroll") for (int n = 0; n < 2; ++n) _Pragma("unroll") for (int k = 0; k < 2; ++k) \
        acc[ai][bj][m][n] = __builtin_amdgcn_mfma_f32_16x16x32_bf16(Bt[n][k], At[m][k], acc[ai][bj][m][n], 0, 0, 0); __builtin_amdgcn_s_setprio(0); } while (0)
#define PG8_WAIT_V(n) asm volatile("s_waitcnt vmcnt(" #n ")" ::: "memory")
#define PG8_WAIT_L(n) asm volatile("s_waitcnt lgkmcnt(" #n ")" ::: "memory")
#define PG8_BAR __builtin_amdgcn_s_barrier()
#define PG8_SCHED __builtin_amdgcn_sched_barrier(0)
    Unit cur, nxt; int ui = 0;
    if (!S.next(0, cur)) return;
    f32x4 acc[2][2][4][2];
#pragma unroll
    for (int a = 0; a < 2; ++a)
#pragma unroll
        for (int b = 0; b < 2; ++b)
#pragma unroll
            for (int m = 0; m < 4; ++m)
#pragma unroll
                for (int n = 0; n < 2; ++n) acc[a][b][m][n] = (f32x4){0.f, 0.f, 0.f, 0.f};
    bf16x8 At[4][2], B0[2][2], B1[2][2];
    const char* cA = (const char*)g.A + (size_t)cur.pm * tstep; const char* cB = (const char*)g.Bt + (size_t)cur.pn * tstep;
    S.a_ready(cur);
    if constexpr (SP2) {
        PG8_STAGE(PG8_SB(0, 0), cB, voffB); PG8_STAGE(PG8_SB(0, 1), cB + hstep, voffB); PG8_STAGE(PG8_SA(0, 0), cA, voffA); PG8_STAGE(PG8_SA(0, 1), cA + hstep, voffA);
        if (wr == 1) PG8_BAR;
        PG8_WAIT_V(2); PG8_BAR;
        PG8_STAGE(PG8_SB(1, 0), cB + kstep, voffB); PG8_STAGE(PG8_SA(1, 0), cA + kstep, voffA); PG8_STAGE(PG8_SB(1, 1), cB + hstep + kstep, voffB);
        PG8_WAIT_V(6); PG8_BAR;
    } else {
        PG8_STAGE(PG8_SB(0, 0), cB, voffB); PG8_STAGE(PG8_SA(0, 0), cA, voffA); PG8_STAGE(PG8_SB(0, 1), cB + hstep, voffB); PG8_STAGE(PG8_SA(0, 1), cA + hstep, voffA);
        if (wr == 1) PG8_BAR;
        PG8_WAIT_V(4); PG8_BAR;
        PG8_STAGE(PG8_SB(1, 0), cB + kstep, voffB); PG8_STAGE(PG8_SA(1, 0), cA + kstep, voffA); PG8_STAGE(PG8_SB(1, 1), cB + hstep + kstep, voffB);
        PG8_WAIT_V(6); PG8_BAR;
    }
    for (;;) {
        const bool has_next = S.next(ui + 1, nxt);
        const char* nA = has_next ? (const char*)g.A + (size_t)nxt.pm * tstep : cA; const char* nB = has_next ? (const char*)g.Bt + (size_t)nxt.pn * tstep : cB;
        for (int t = 0; t < nt; t += 2) {
            const bool last = (t == nt - 2);
            const char* a1 = cA + (size_t)(t + 1) * kstep;
            const char* a2 = last ? nA : cA + (size_t)(t + 2) * kstep; const char* b2 = last ? nB : cB + (size_t)(t + 2) * kstep;
            const char* a3 = a2 + kstep; const char* b3 = b2 + kstep;
            if (last && has_next) S.a_ready(nxt);
            if constexpr (SP2) {
            PG8_LDB(B0, 0, 0); PG8_LDB(B1, 0, 1); PG8_SCHED; PG8_LDA(At, 0, 0); PG8_STAGE(PG8_SA(1, 1), a1 + hstep, voffA);
            PG8_WAIT_V(8); PG8_WAIT_L(0); PG8_BAR; PG8_MMA(0, 0, At, B0); PG8_MMA(0, 1, At, B1); PG8_BAR; PG8_SCHED;
            PG8_LDA(At, 0, 1); PG8_STAGE(PG8_SB(0, 0), b2, voffB); PG8_STAGE(PG8_SB(0, 1), b2 + hstep, voffB); PG8_STAGE(PG8_SA(0, 0), a2, voffA);
            PG8_WAIT_V(8); PG8_WAIT_L(0); PG8_BAR; PG8_MMA(1, 0, At, B0); PG8_MMA(1, 1, At, B1); PG8_BAR; PG8_SCHED;
            PG8_LDB(B0, 1, 0); PG8_LDB(B1, 1, 1); PG8_SCHED; PG8_LDA(At, 1, 0); PG8_STAGE(PG8_SA(0, 1), a2 + hstep, voffA);
            PG8_WAIT_V(8); PG8_WAIT_L(0); PG8_BAR; PG8_MMA(0, 0, At, B0); PG8_MMA(0, 1, At, B1); PG8_BAR; PG8_SCHED;
            PG8_LDA(At, 1, 1); PG8_STAGE(PG8_SB(1, 0), b3, voffB); PG8_STAGE(PG8_SB(1, 1), b3 + hstep, voffB); PG8_STAGE(PG8_SA(1, 0), a3, voffA);
            PG8_WAIT_V(8); PG8_WAIT_L(0); PG8_BAR; PG8_MMA(1, 0, At, B0); PG8_MMA(1, 1, At, B1); PG8_BAR; PG8_SCHED;
            } else {
            PG8_LDB(B0, 0, 0); PG8_SCHED; PG8_LDA(At, 0, 0); PG8_STAGE(PG8_SA(1, 1), a1 + hstep, voffA);
            PG8_WAIT_L(8); PG8_BAR; PG8_WAIT_L(0); PG8_MMA(0, 0, At, B0); PG8_BAR; PG8_SCHED;
            PG8_LDB(B1, 0, 1); PG8_STAGE(PG8_SB(0, 0), b2, voffB);
            PG8_BAR; PG8_WAIT_L(0); PG8_MMA(0, 1, At, B1); PG8_BAR;
            PG8_LDA(At, 0, 1); PG8_STAGE(PG8_SA(0, 0), a2, voffA);
            PG8_BAR; PG8_WAIT_L(0); PG8_MMA(1, 0, At, B0); PG8_BAR; PG8_SCHED;
            PG8_STAGE(PG8_SB(0, 1), b2 + hstep, voffB);
            PG8_WAIT_V(6); PG8_BAR; PG8_MMA(1, 1, At, B1); PG8_BAR;
            PG8_LDB(B0, 1, 0); PG8_SCHED; PG8_LDA(At, 1, 0); PG8_STAGE(PG8_SA(0, 1), a2 + hstep, voffA);
            PG8_WAIT_L(8); PG8_BAR; PG8_WAIT_L(0); PG8_MMA(0, 0, At, B0); PG8_BAR; PG8_SCHED;
            PG8_LDB(B1, 1, 1); PG8_STAGE(PG8_SB(1, 0), b3, voffB);
            PG8_BAR; PG8_WAIT_L(0); PG8_MMA(0, 1, At, B1); PG8_BAR;
            PG8_LDA(At, 1, 1); PG8_STAGE(PG8_SA(1, 0), a3, voffA);
            PG8_BAR; PG8_WAIT_L(0); PG8_MMA(1, 0, At, B0); PG8_BAR; PG8_SCHED;
            PG8_STAGE(PG8_SB(1, 1), b3 + hstep, voffB);
            PG8_WAIT_V(6); PG8_BAR; PG8_MMA(1, 1, At, B1); PG8_BAR;
            }
        }
        if constexpr (ALIGN_EPI) { if (wr == 0) PG8_BAR; }
        E(acc, cur, wr, wc, fr, fq); S.done(cur);
        if (!has_next) break;
#pragma unroll
        for (int a = 0; a < 2; ++a)
#pragma unroll
            for (int b = 0; b < 2; ++b)
#pragma unroll
                for (int m = 0; m < 4; ++m)
#pragma unroll
                    for (int n = 0; n < 2; ++n) acc[a][b][m][n] = (f32x4){0.f, 0.f, 0.f, 0.f};
        cur = nxt; cA = nA; cB = nB; ++ui;
        if constexpr (ALIGN_EPI) { if (wr == 1) PG8_BAR; }
    }
    PG8_WAIT_V(0);
    if constexpr (!ALIGN_EPI) { if (wr == 0) PG8_BAR; }
    PG8_BAR;
#undef PG8_SA
#undef PG8_SB
#undef PG8_STAGE
#undef PG8_LDA
#undef PG8_LDB
#undef PG8_MMA
#undef PG8_WAIT_V
#undef PG8_WAIT_L
#undef PG8_BAR
#undef PG8_SCHED
}
}

using pg8::bf16_t; using pg8::bf16x8; using pg8::f32x4;

constexpr int MT = 24576, DM = 1024, DFF = 2816, NCTX = 8192;
constexpr int UW = 3984;
constexpr int NCOND = 9, MODW = 9216;
constexpr size_t MiB = 1ull << 20;
constexpr size_t WS_A = 0, WS_U = 48 * MiB, WS_W1 = WS_U + 132 * MiB, WS_W1B = WS_W1 + (size_t)5632 * 1024 * 2,
                 WS_BT3 = 235 * MiB, WS_HB2 = 235 * MiB  ,
                 WS_BT4 = 251 * MiB, WS_MOD = 253 * MiB, WS_CTR = WS_MOD + 9 * 9216 * 4  , WS_BAR = WS_CTR + 256  , WS_GATES = 254 * MiB;
constexpr size_t WS_A2BF = 255 * MiB + 512 * 1024, WS_G2BF = WS_A2BF + 2 * 512 * 64 * 2;
constexpr int OUT_C = 25165824, OUT_N = 29360128, OUT_MM = 29392896, OUT_S = 29393152;
constexpr int LDS_BYTES = 163840;
constexpr int NTHR = 512;

struct P {
    const float *xp, *xs, *c, *sC, *sn, *sm, *sS, *cctx, *ada_w, *ada_b, *n1, *w1in, *w1out, *nmix, *wmin, *wmout,
        *cw, *cb, *gb, *hg, *mu, *w0, *w2, *a0, *a2, *g2, *kk, *ka, *rk, *lng, *lnb, *n2, *w2in, *w2out, *nf;
    float* out; unsigned char* ws;
};

typedef __bf16 hwbf16x2 __attribute__((ext_vector_type(2)));
typedef float hwf32x2 __attribute__((ext_vector_type(2)));
__device__ __forceinline__ unsigned pk2(float a, float b) { const hwf32x2 v = {a, b}; const hwbf16x2 r = __builtin_convertvector(v, hwbf16x2); return __builtin_bit_cast(unsigned, r); }
__device__ __forceinline__ unsigned short f2bf(float f) { return (unsigned short)(pk2(f, f) & 0xffffu); }
__device__ __forceinline__ float bf2f(unsigned short b) { return __uint_as_float(((unsigned)b) << 16); }
__device__ __forceinline__ int cond_of(int row) { return row < NCTX ? 0 : 1 + ((row - NCTX) >> 11); }
__device__ __forceinline__ float fexp(float x) { return __builtin_amdgcn_exp2f(x * 1.4426950408889634f); }
__device__ __forceinline__ float flog(float x) { return __builtin_amdgcn_logf(x) * 0.6931471805599453f; }
__device__ __forceinline__ float siluf(float x) { return x * __builtin_amdgcn_rcpf(1.f + fexp(-x)); }
__device__ __forceinline__ float sigmf(float x) { return __builtin_amdgcn_rcpf(1.f + fexp(-x)); }
__device__ __forceinline__ float tanh_fast(float x) { return 1.f - 2.f * __builtin_amdgcn_rcpf(1.f + fexp(2.f * x)); }
__device__ __forceinline__ float softplus_fast(float z) { return fmaxf(z, 0.f) + flog(1.f + fexp(-fabsf(z))); }
__device__ __forceinline__ const float* xrow(const P& p, int row) { return row < NCTX ? p.xp + (size_t)row * DM : p.xs + (size_t)(row - NCTX) * DM; }
__device__ __forceinline__ f32x4 mfma16(bf16x8 a, bf16x8 b, f32x4 c) { return __builtin_amdgcn_mfma_f32_16x16x32_bf16(a, b, c, 0, 0, 0); }
__device__ __forceinline__ void unpack8(uint4 v, float* f) {
    f[0] = __uint_as_float(v.x << 16); f[1] = __uint_as_float(v.x & 0xffff0000u); f[2] = __uint_as_float(v.y << 16); f[3] = __uint_as_float(v.y & 0xffff0000u);
    f[4] = __uint_as_float(v.z << 16); f[5] = __uint_as_float(v.z & 0xffff0000u); f[6] = __uint_as_float(v.w << 16); f[7] = __uint_as_float(v.w & 0xffff0000u);
}

__device__ __forceinline__ int colmap(int kind, int n) {
    if (kind == 0) return n;
    if (kind == 1) { const int t = n >> 8, bj = (n >> 7) & 1, c = n & 127; return bj * DFF + t * 128 + c; }
    if (n < 2048) return n; if (n < 3968) return n + 16; if (n < 3984) return n - 3968 + 2048; return -1;
}
__device__ void convert_tile(const float* __restrict__ src, bf16_t* __restrict__ dst, int K, int Nsrc, int kind, int k0, int n0, float* tile) {
    const int tid = opaque_tid();
    { const int n = tid & 63, kr = tid >> 6; const int sc = colmap(kind, n0 + n);
#pragma unroll
      for (int i = 0; i < 8; ++i) { const int k = kr + 8 * i; tile[k * 65 + n] = sc >= 0 ? src[(size_t)(k0 + k) * Nsrc + sc] : 0.f; } }
    __syncthreads();
    { const int nn = tid >> 3, kg = tid & 7; unsigned w[4];
#pragma unroll
      for (int j = 0; j < 4; ++j) w[j] = pk2(tile[(kg * 8 + 2 * j) * 65 + nn], tile[(kg * 8 + 2 * j + 1) * 65 + nn]);
      *(uint4*)(dst + (size_t)(n0 + nn) * K + k0 + kg * 8) = make_uint4(w[0], w[1], w[2], w[3]); }
    __syncthreads();
}
__device__ void convert_jobs(const P& p, int first, int njobs_sel, unsigned char* lds, int item0, int nitems_before) {}

__device__ void do_convert(const float* src, bf16_t* dst, int K, int Nsrc, int Ndst, int kind, int t, float* tile) {
    const int nkt = K / 64; const int kt = t % nkt, ntile = t / nkt; (void)Ndst;
    convert_tile(src, dst, K, Nsrc, kind, kt * 64, ntile * 64, tile);
}

__device__ void phase0(const P& p, unsigned char* lds) {
    float* tile = (float*)lds;
    const int tid = opaque_tid();
    const int n_ada = 36 * 8;
    const int t1 = 16 * 88, t2 = 44 * 16, t3 = 16 * 64, t4 = 16 * 16, t5 = 8, t6 = 8, t7 = 16;
    const int total = n_ada + t1 + t2 + t3 + t4 + t5 + t6 + t7;
    for (int it = blockIdx.x; it < total; it += gridDim.x) {
        if (it < n_ada) {
            const int cgp = it % 36, kc = it / 36;
            float* sc = tile;
            __syncthreads();
            for (int i = tid; i < NCOND * 128; i += NTHR) { const int c = i >> 7, k = i & 127; const float v = c == 0 ? p.cctx[kc * 128 + k] : p.c[(c - 1) * DM + kc * 128 + k]; sc[i] = siluf(v); }
            __syncthreads();
            const int col = cgp * 256 + (tid & 255), kh = tid >> 8;
            float acc[NCOND];
#pragma unroll
            for (int c = 0; c < NCOND; ++c) acc[c] = 0.f;
            const float* w = p.ada_w + (size_t)(kc * 128 + kh * 64) * MODW + col;
#pragma unroll 4
            for (int k = 0; k < 64; ++k) { const float wv = w[(size_t)k * MODW];
#pragma unroll
                for (int c = 0; c < NCOND; ++c) acc[c] += sc[c * 128 + kh * 64 + k] * wv; }
            float* mod = (float*)(p.ws + WS_MOD);
            const float bias = (kc == 0 && kh == 0) ? p.ada_b[col] : 0.f;
#pragma unroll
            for (int c = 0; c < NCOND; ++c) atomicAdd(mod + c * MODW + col, acc[c] + bias);
            __syncthreads();
        } else {
            int t = it - n_ada;
            if (t < t1) do_convert(p.w1in, (bf16_t*)(p.ws + WS_W1), 1024, 5632, 5632, 1, t, tile);
            else if ((t -= t1) < t2) do_convert(p.w1out, (bf16_t*)(p.ws + WS_W1B), 2816, 1024, 1024, 0, t, tile);
            else if ((t -= t2) < t3) do_convert(p.wmin, (bf16_t*)(p.ws + WS_BT3), 1024, 3984, 4096, 2, t, tile);
            else if ((t -= t3) < t4) do_convert(p.wmout, (bf16_t*)(p.ws + WS_BT4), 1024, 1024, 1024, 0, t, tile);
            else if ((t -= t4) < t5) do_convert(p.a2, (bf16_t*)(p.ws + WS_A2BF), 64, 512, 512, 0, t, tile);
            else if ((t -= t5) < t6) do_convert(p.a2 + 64 * 512, (bf16_t*)(p.ws + WS_A2BF) + 512 * 64, 64, 512, 512, 0, t, tile);
            else { t -= t6; do_convert(p.g2, (bf16_t*)(p.ws + WS_G2BF), 128, 512, 512, 0, t, tile); }
        }
    }
}

__device__ void phase_normmod(const P& p, int which) {
    const int lane = opaque_tid() & 63, wave = threadIdx.x >> 6;
    const float* gain = which == 0 ? p.n1 : (which == 1 ? p.nmix : p.n2);
    const float* mod = (const float*)(p.ws + WS_MOD);
    bf16_t* A = (bf16_t*)(p.ws + WS_A);
    for (int row = blockIdx.x * 8 + wave; row < MT; row += gridDim.x * 8) {
        const float* src = which == 0 ? xrow(p, row) : p.out + (size_t)row * DM;
        float4 v[4]; float ss = 0.f;
#pragma unroll
        for (int i = 0; i < 4; ++i) { v[i] = *(const float4*)(src + lane * 4 + 256 * i); ss += v[i].x * v[i].x + v[i].y * v[i].y + v[i].z * v[i].z + v[i].w * v[i].w; }
#pragma unroll
        for (int o = 32; o >= 1; o >>= 1) ss += __shfl_xor(ss, o);
        const float rstd = rsqrtf(ss * (1.f / 1024.f) + 1e-6f);
        const float* sh = mod + cond_of(row) * MODW + which * 3072; const float* sc = sh + 1024;
#pragma unroll
        for (int i = 0; i < 4; ++i) { const int col = lane * 4 + 256 * i;
            const float4 g = *(const float4*)(gain + col), s4 = *(const float4*)(sh + col), c4 = *(const float4*)(sc + col);
            const float o0 = v[i].x * rstd * g.x * (1.f + c4.x) + s4.x, o1 = v[i].y * rstd * g.y * (1.f + c4.y) + s4.y,
                        o2 = v[i].z * rstd * g.z * (1.f + c4.z) + s4.z, o3 = v[i].w * rstd * g.w * (1.f + c4.w) + s4.w;
            *(uint2*)(A + (size_t)row * DM + col) = make_uint2(pk2(o0, o1), pk2(o2, o3)); }
    }
}
__device__ void phase_finalnorm(const P& p) {
    const int lane = opaque_tid() & 63, wave = threadIdx.x >> 6;
    for (int row = blockIdx.x * 8 + wave; row < MT; row += gridDim.x * 8) {
        float* src = p.out + (size_t)row * DM;
        float4 v[4]; float ss = 0.f;
#pragma unroll
        for (int i = 0; i < 4; ++i) { v[i] = *(const float4*)(src + lane * 4 + 256 * i); ss += v[i].x * v[i].x + v[i].y * v[i].y + v[i].z * v[i].z + v[i].w * v[i].w; }
#pragma unroll
        for (int o = 32; o >= 1; o >>= 1) ss += __shfl_xor(ss, o);
        const float rstd = rsqrtf(ss * (1.f / 1024.f) + 1e-6f);
#pragma unroll
        for (int i = 0; i < 4; ++i) { const int col = lane * 4 + 256 * i; const float4 g = *(const float4*)(p.nf + col);
            *(float4*)(src + col) = make_float4(v[i].x * rstd * g.x, v[i].y * rstd * g.y, v[i].z * rstd * g.z, v[i].w * rstd * g.w); }
    }
}

struct EpiSwiglu {
    static constexpr bool PERM = true;
    bf16_t* O;
    __device__ __forceinline__ void operator()(const f32x4 (&acc)[2][2][4][2], const pg8::Unit& u, int wr, int wc, int fr, int fq) const {
        const int row0 = u.pm * 256 + wr * 64 + fr, col0 = u.pn * 128 + wc * 32 + 8 * fq;
#pragma unroll
        for (int ai = 0; ai < 2; ++ai)
#pragma unroll
            for (int m = 0; m < 4; ++m) { bf16_t* rowp = O + (size_t)(row0 + ai * 128 + m * 16) * DFF + col0;
                float r[8];
#pragma unroll
                for (int n = 0; n < 2; ++n)
#pragma unroll
                    for (int j = 0; j < 4; ++j) r[n * 4 + j] = siluf(acc[ai][0][m][n][j]) * acc[ai][1][m][n][j];
                pg8::u32x4 w; w.x = pg8::cvt_pk_bf16(r[0], r[1]); w.y = pg8::cvt_pk_bf16(r[2], r[3]); w.z = pg8::cvt_pk_bf16(r[4], r[5]); w.w = pg8::cvt_pk_bf16(r[6], r[7]);
                *(pg8::u32x4*)rowp = w; }
    }
};
struct EpiResid {
    static constexpr bool PERM = false;
    const float* xp; const float* xs; float* out; const float* ga; float coef; int inplace;
    __device__ __forceinline__ void operator()(const f32x4 (&acc)[2][2][4][2], const pg8::Unit& u, int wr, int wc, int fr, int fq) const {
        const int row0 = u.pm * 256 + wr * 64 + fr, col0 = u.pn * 256 + wc * 32 + 4 * fq;
        const float* gap = ga + cond_of(u.pm * 256) * MODW;
        f32x4 gv[2][2];
#pragma unroll
        for (int bj = 0; bj < 2; ++bj)
#pragma unroll
            for (int n = 0; n < 2; ++n) gv[bj][n] = *(const f32x4*)(gap + col0 + bj * 128 + n * 16) * coef;
#pragma unroll
        for (int ai = 0; ai < 2; ++ai)
#pragma unroll
            for (int m = 0; m < 4; ++m) { const int row = row0 + ai * 128 + m * 16;
                const float* base = inplace ? out + (size_t)row * DM : (row < NCTX ? xp + (size_t)row * DM : xs + (size_t)(row - NCTX) * DM);
                float* op = out + (size_t)row * DM;
#pragma unroll
                for (int bj = 0; bj < 2; ++bj)
#pragma unroll
                    for (int n = 0; n < 2; ++n) { const int c = col0 + bj * 128 + n * 16; const f32x4 b4 = *(const f32x4*)(base + c);
                        *(f32x4*)(op + c) = b4 + gv[bj][n] * acc[ai][bj][m][n]; } }
    }
};
struct EpiU {
    static constexpr bool PERM = true;
    bf16_t* U; float* gates;
    __device__ __forceinline__ void operator()(const f32x4 (&acc)[2][2][4][2], const pg8::Unit& u, int wr, int wc, int fr, int fq) const {
        const int row0 = u.pm * 256 + wr * 64 + fr;
#pragma unroll
        for (int bj = 0; bj < 2; ++bj) { const int col0 = u.pn * 256 + bj * 128 + wc * 32 + 8 * fq;
            if (col0 < UW) {
#pragma unroll
                for (int ai = 0; ai < 2; ++ai)
#pragma unroll
                    for (int m = 0; m < 4; ++m) { const int row = row0 + ai * 128 + m * 16; const f32x4 v0 = acc[ai][bj][m][0], v1 = acc[ai][bj][m][1];
                        pg8::u32x4 w; w.x = pg8::cvt_pk_bf16(v0[0], v0[1]); w.y = pg8::cvt_pk_bf16(v0[2], v0[3]); w.z = pg8::cvt_pk_bf16(v1[0], v1[1]); w.w = pg8::cvt_pk_bf16(v1[2], v1[3]);
                        *(pg8::u32x4*)(U + (size_t)row * UW + col0) = w;
                        if (col0 >= 3968) { float* gp = gates + (size_t)row * 16 + (col0 - 3968); *(f32x4*)gp = v0; *(f32x4*)(gp + 4) = v1; } } } }
    }
};

template <class Epi>
__device__ __forceinline__ void run_gemm(unsigned char* lds, const bf16_t* A, const bf16_t* Bt, int N, int K, const Epi& E) {
    pg8::Gemm g{A, Bt, MT, N, K}; pg8::StaticOrder S; S.init(MT, N, (int)gridDim.x, (int)blockIdx.x);
    pg8::gemm_phase<Epi, pg8::StaticOrder, true, true>((PG8_LAS unsigned char*)lds, g, S, E);
}

constexpr int ML_SK = 0, ML_KWT = 17408, ML_VT = ML_KWT + 18432, ML_CB = ML_VT + 20736, ML_F = ML_CB + 21760, ML_CW = ML_F + 2048, ML_END = ML_CW + 4096;
static_assert(ML_END <= LDS_BYTES, "mlstm lds");

__device__ __forceinline__ unsigned short ld_u16_agent(const bf16_t* p) { return __hip_atomic_load(p, __ATOMIC_RELAXED, __HIP_MEMORY_SCOPE_AGENT); }

__device__ __forceinline__ void conv3_row8(const bf16_t* up, bool hasp, bool hasn, const float* cwp, float* x) {
    float t[8];
    unpack8(*(const uint4*)up, t);
#pragma unroll
    for (int i = 0; i < 8; ++i) x[i] = cwp[768 + i] + cwp[256 + i] * t[i];
    if (hasp) { unpack8(*(const uint4*)(up - UW), t);
#pragma unroll
        for (int i = 0; i < 8; ++i) x[i] += cwp[i] * t[i]; }
    if (hasn) { unpack8(*(const uint4*)(up + UW), t);
#pragma unroll
        for (int i = 0; i < 8; ++i) x[i] += cwp[512 + i] * t[i]; }
}

__device__ __forceinline__ void mlstm_task(const P& p, unsigned char* lds, int bg, int h, int dsel) {
    const int wv = __builtin_amdgcn_readfirstlane((int)threadIdx.x >> 6), rw = wv & 3, cw = wv >> 2;
    const bool ctx = bg < 32; const int T = ctx ? 256 : 2048, nc = T / 64; const int row0 = ctx ? bg * 256 : NCTX + (bg - 32) * 2048;
    bf16_t* sK = (bf16_t*)(lds + ML_SK); bf16_t* sKwT = (bf16_t*)(lds + ML_KWT); bf16_t* sVT = (bf16_t*)(lds + ML_VT); bf16_t* sCb = (bf16_t*)(lds + ML_CB); bf16_t* sS = sCb;
    float* sA = (float*)(lds + ML_F); float* sM = sA + 64; float* sBb = sM + 64; float* sDen = sBb + 64; float* sScal = sDen + 64; float* sRed = sScal + 16;
    float* sCW = (float*)(lds + ML_CW);
    const bf16_t* U = (const bf16_t*)(p.ws + WS_U); const float* GATES = (const float*)(p.ws + WS_GATES); bf16_t* HB = (bf16_t*)(p.ws + WS_A); bf16_t* HB2 = (bf16_t*)(p.ws + WS_HB2);
    const int d_lo = dsel < 0 ? 0 : dsel, d_hi = dsel < 0 ? 2 : dsel + 1;
    const int ct_a = cw ? 3 : 0;
    const int ct_b = cw ? 7 : 5;
    const int n_a = cw ? 2 : 3;

    __syncthreads();
    { const int tid = threadIdx.x;
      for (int i = tid; i < 1024; i += NTHR) { const int a = i >> 8, cc = i & 255, gch = (cc >> 7) * 512 + h * 128 + (cc & 127); sCW[i] = a < 3 ? p.cw[a * 1024 + gch] : p.cb[gch]; }
      for (int i = tid; i < 16 * 72; i += NTHR) { const int r = 128 + i / 72; sVT[r * 72 + (i % 72)] = (r == 128) ? (bf16_t)0x3F80 : (bf16_t)0; } }

#pragma unroll 1
    for (int dir = d_lo; dir < d_hi; ++dir) {
        f32x4 Cacc[9]; float m_prev = 0.f;
        { int z0 = 0; asm volatile("" : "+v"(z0)); const int tid = (int)threadIdx.x + z0, fr = tid & 15, fq = (tid >> 4) & 3;
#pragma unroll
          for (int ct = 0; ct < 9; ++ct) Cacc[ct] = (f32x4){0.f, 0.f, 0.f, 0.f};
          if (!ctx) { const int sidx = ((bg - 32) * 2 + dir) * 4 + h; const float* C0 = p.sC + (size_t)sidx * 16384; const float* n0 = p.sn + (size_t)sidx * 128;
#pragma unroll
              for (int j = 0; j < 4; ++j) { const int d = 16 * wv + 4 * fq + j;
#pragma unroll
                  for (int ct = 0; ct < 8; ++ct) Cacc[ct][j] = C0[d * 128 + 16 * ct + fr];
                  Cacc[8][j] = fr == 0 ? n0[d] : 0.f; }
              m_prev = p.sm[sidx]; } }
        const float gbi = p.gb[dir * 4 + h], gbf = p.gb[8 + dir * 4 + h];
        const bool second = dsel < 0 && dir == 1;
#pragma unroll 1
        for (int s = 0; s < nc; ++s) {
            const int c = dir ? nc - 1 - s : s;
            int zz = 0; asm volatile("" : "+v"(zz));
            const int tid = (int)threadIdx.x + zz, lane = tid & 63, fr = tid & 15, fq = (tid >> 4) & 3;
            uint4 kc[2], kp[2], kn[2], vv[2];
#pragma unroll
            for (int g = 0; g < 2; ++g) { const int idx = tid + 512 * g, sl = idx >> 4, d0 = (idx & 15) * 8; const int tl = dir ? 63 - sl : sl, tok = c * 64 + tl;
                const bf16_t* up = U + ((size_t)row0 + tok) * UW + 512 + h * 128 + d0;
                kc[g] = *(const uint4*)up; kp[g] = make_uint4(0u, 0u, 0u, 0u); kn[g] = kp[g];
                if (tok > 0) kp[g] = *(const uint4*)(up - UW);
                if (tok < T - 1) kn[g] = *(const uint4*)(up + UW);
                vv[g] = *(const uint4*)(up + 512); }
            LDS_BARRIER();
            if (wv == 0) {
                const int tl = dir ? 63 - lane : lane; const size_t row = (size_t)row0 + c * 64 + tl;
                const float ip = GATES[row * 16 + dir * 4 + h] + gbi, fp = GATES[row * 16 + 8 + dir * 4 + h] + gbf;
                const float lf = -softplus_fast(-fp);
                float bs = lf;
#pragma unroll
                for (int o = 1; o < 64; o <<= 1) { const float t = __shfl_up(bs, o); if (lane >= o) bs += t; }
                const float a = ip - bs; float pm = a;
#pragma unroll
                for (int o = 1; o < 64; o <<= 1) { const float t = __shfl_up(pm, o); if (lane >= o) pm = fmaxf(pm, t); }
                const float Mt = fmaxf(m_prev, pm);
                sA[lane] = a; sM[lane] = Mt; sBb[lane] = bs;
                if (lane == 63) { sScal[0] = Mt; sScal[1] = bs; }
            }
            LDS_BARRIER();
            const float M63 = sScal[0], bL = sScal[1];
            uint4 qc[4], qp[4], qn[4];
            { const int t_ = 16 * rw + fr, tl = dir ? 63 - t_ : t_, tok = c * 64 + tl; const bf16_t* up = U + ((size_t)row0 + tok) * UW + h * 128 + 8 * fq;
#pragma unroll
              for (int kk = 0; kk < 4; ++kk) { qc[kk] = *(const uint4*)(up + 32 * kk); qp[kk] = make_uint4(0u, 0u, 0u, 0u); qn[kk] = qp[kk];
                  if (tok > 0) qp[kk] = *(const uint4*)(up + 32 * kk - UW);
                  if (tok < T - 1) qn[kk] = *(const uint4*)(up + 32 * kk + UW); } }
#pragma unroll
            for (int g = 0; g < 2; ++g) {
                const int idx = tid + 512 * g, sl = idx >> 4, d0 = (idx & 15) * 8;
                const float wk = fexp(sA[sl] - M63);
                const float* cwp = sCW + 128 + d0;
                float kv[8], t[8];
                unpack8(kc[g], t);
#pragma unroll
                for (int i = 0; i < 8; ++i) kv[i] = cwp[768 + i] + cwp[256 + i] * t[i];
                unpack8(kp[g], t);
#pragma unroll
                for (int i = 0; i < 8; ++i) kv[i] += cwp[i] * t[i];
                unpack8(kn[g], t);
#pragma unroll
                for (int i = 0; i < 8; ++i) kv[i] += cwp[512 + i] * t[i];
#pragma unroll
                for (int i = 0; i < 8; ++i) kv[i] = siluf(kv[i]) * 0.08838834764831845f;
                *(uint4*)(sK + sl * 136 + d0) = make_uint4(pk2(kv[0], kv[1]), pk2(kv[2], kv[3]), pk2(kv[4], kv[5]), pk2(kv[6], kv[7]));
#pragma unroll
                for (int i = 0; i < 8; ++i) sKwT[(d0 + i) * 72 + sl] = f2bf(kv[i] * wk);
                const unsigned vw[4] = {vv[g].x, vv[g].y, vv[g].z, vv[g].w};
#pragma unroll
                for (int i = 0; i < 8; ++i) sVT[(d0 + i) * 72 + sl] = (bf16_t)((vw[i >> 1] >> ((i & 1) * 16)) & 0xffffu);
            }
            bf16x8 qf[4];
#pragma unroll
            for (int kk = 0; kk < 4; ++kk) { const float* cwp = sCW + 32 * kk + 8 * fq; float qv[8], t[8];
                unpack8(qc[kk], t);
#pragma unroll
                for (int i = 0; i < 8; ++i) qv[i] = cwp[768 + i] + cwp[256 + i] * t[i];
                unpack8(qp[kk], t);
#pragma unroll
                for (int i = 0; i < 8; ++i) qv[i] += cwp[i] * t[i];
                unpack8(qn[kk], t);
#pragma unroll
                for (int i = 0; i < 8; ++i) qv[i] += cwp[512 + i] * t[i];
#pragma unroll
                for (int i = 0; i < 8; ++i) qv[i] = siluf(qv[i]);
                union { uint4 u; bf16x8 v; } cv; cv.u = make_uint4(pk2(qv[0], qv[1]), pk2(qv[2], qv[3]), pk2(qv[4], qv[5]), pk2(qv[6], qv[7])); qf[kk] = cv.v; }
            f32x4 num[5];
#pragma unroll
            for (int k = 0; k < 5; ++k) num[k] = (f32x4){0.f, 0.f, 0.f, 0.f};
#pragma unroll
            for (int ci = 0; ci < 5; ++ci) { const f32x4 v = Cacc[ci]; *(uint2*)(sCb + (16 * ci + fr) * 136 + 16 * wv + 4 * fq) = make_uint2(pk2(v[0], v[1]), pk2(v[2], v[3])); }
            LDS_BARRIER();
#pragma unroll
            for (int k = 0; k < 3; ++k) if (k < n_a) {
#pragma unroll
                for (int kk = 0; kk < 4; ++kk) { const bf16x8 b = *(const bf16x8*)(sCb + (16 * (ct_a + k) + fr) * 136 + 32 * kk + 8 * fq); num[k] = mfma16(qf[kk], b, num[k]); } }
            LDS_BARRIER();
#pragma unroll
            for (int ci = 0; ci < 4; ++ci) { const f32x4 v = Cacc[5 + ci]; *(uint2*)(sCb + (16 * ci + fr) * 136 + 16 * wv + 4 * fq) = make_uint2(pk2(v[0], v[1]), pk2(v[2], v[3])); }
            LDS_BARRIER();
#pragma unroll
            for (int k = 3; k < 5; ++k) {
#pragma unroll
                for (int kk = 0; kk < 4; ++kk) { const bf16x8 b = *(const bf16x8*)(sCb + (16 * (ct_b + k - 3 - 5) + fr) * 136 + 32 * kk + 8 * fq); num[k] = mfma16(qf[kk], b, num[k]); } }
            {
                float scv[4];
#pragma unroll
                for (int j = 0; j < 4; ++j) scv[j] = fexp(m_prev - sM[16 * rw + 4 * fq + j]);
#pragma unroll
                for (int k = 0; k < 5; ++k)
#pragma unroll
                    for (int j = 0; j < 4; ++j) num[k][j] *= scv[j];
            }
            LDS_BARRIER();
#pragma unroll
            for (int si = 0; si < 2; ++si) { const int st = 2 * cw + si;
                f32x4 sacc = (f32x4){0.f, 0.f, 0.f, 0.f};
                if (st <= rw) {
#pragma unroll
                    for (int kk = 0; kk < 4; ++kk) { const bf16x8 b = *(const bf16x8*)(sK + (16 * st + fr) * 136 + 32 * kk + 8 * fq); sacc = mfma16(qf[kk], b, sacc); } }
                const int sp = 16 * st + fr; const float as = sA[sp];
#pragma unroll
                for (int j = 0; j < 4; ++j) { const int tp = 16 * rw + 4 * fq + j; const float val = (sp <= tp) ? sacc[j] * fexp(as - sM[tp]) : 0.f; sS[tp * 72 + sp] = f2bf(val); }
            }
            LDS_BARRIER();
#pragma unroll
            for (int ks = 0; ks < 2; ++ks) { const bf16x8 a = *(const bf16x8*)(sS + (16 * rw + fr) * 72 + 32 * ks + 8 * fq);
#pragma unroll
                for (int k = 0; k < 5; ++k) { const int ct = k < 3 ? ct_a + k : ct_b + k - 3;
                    if (k != 2 || cw == 0) { const bf16x8 b = *(const bf16x8*)(sVT + (16 * ct + fr) * 72 + 32 * ks + 8 * fq); num[k] = mfma16(a, b, num[k]); } } }
            if (cw == 1 && fr == 0) {
#pragma unroll
                for (int j = 0; j < 4; ++j) sDen[16 * rw + 4 * fq + j] = num[4][j]; }
            LDS_BARRIER();
            float inv[4];
#pragma unroll
            for (int j = 0; j < 4; ++j) { const int tp = 16 * rw + 4 * fq + j; const float den = sDen[tp]; inv[j] = __builtin_amdgcn_rcpf(fmaxf(fabsf(den), fexp(-(sBb[tp] + sM[tp])))); }
            if (!second) {
#pragma unroll
                for (int j = 0; j < 4; ++j) { const int tp = 16 * rw + 4 * fq + j, tl = dir ? 63 - tp : tp; const size_t row = (size_t)row0 + c * 64 + tl;
                    bf16_t* hb = dsel == 1 ? HB2 + (row - NCTX) * 512 + h * 128 : HB + row * DM + h * 128;
#pragma unroll
                    for (int k = 0; k < 5; ++k) { const int ct = k < 3 ? ct_a + k : ct_b + k - 3; if ((k != 2 || cw == 0) && ct < 8) hb[16 * ct + fr] = f2bf(num[k][j] * inv[j]); } }
            } else {
                float ssr[4];
#pragma unroll
                for (int j = 0; j < 4; ++j) { const int tp = 16 * rw + 4 * fq + j, tl = dir ? 63 - tp : tp; const size_t row = (size_t)row0 + c * 64 + tl;
                    const bf16_t* hb = HB + row * DM + h * 128; float ss = 0.f;
#pragma unroll
                    for (int k = 0; k < 5; ++k) { const int ct = k < 3 ? ct_a + k : ct_b + k - 3;
                        if ((k != 2 || cw == 0) && ct < 8) { const int e = 16 * ct + fr; const float other = bf2f(ld_u16_agent(hb + e)); const float hs = num[k][j] * inv[j] + other;
                            const float o = sigmf(bf2f(U[row * UW + 1536 + h * 128 + e])); const float v = o * hs; ss += v * v; num[k][j] = v; } }
                    ss += __shfl_xor(ss, 1); ss += __shfl_xor(ss, 2); ss += __shfl_xor(ss, 4); ss += __shfl_xor(ss, 8);
                    ssr[j] = ss; if (fr == 0) sRed[cw * 64 + tp] = ss; }
                LDS_BARRIER();
#pragma unroll
                for (int j = 0; j < 4; ++j) { const int tp = 16 * rw + 4 * fq + j, tl = dir ? 63 - tp : tp; const size_t row = (size_t)row0 + c * 64 + tl;
                    bf16_t* hb = HB + row * DM + h * 128; const float rms = rsqrtf((ssr[j] + sRed[(1 - cw) * 64 + tp]) * (1.f / 128.f) + 1e-6f);
#pragma unroll
                    for (int k = 0; k < 5; ++k) { const int ct = k < 3 ? ct_a + k : ct_b + k - 3;
                        if ((k != 2 || cw == 0) && ct < 8) { const int e = 16 * ct + fr; hb[e] = f2bf(num[k][j] * rms * p.hg[h * 128 + e]); } } }
            }
            const float decay = fexp(m_prev - M63);
#pragma unroll
            for (int ct = 0; ct < 9; ++ct) Cacc[ct] = Cacc[ct] * decay;
#pragma unroll
            for (int ks = 0; ks < 2; ++ks) { const bf16x8 a = *(const bf16x8*)(sKwT + (16 * wv + fr) * 72 + 32 * ks + 8 * fq);
#pragma unroll
                for (int ct = 0; ct < 9; ++ct) { const bf16x8 b = *(const bf16x8*)(sVT + (16 * ct + fr) * 72 + 32 * ks + 8 * fq); Cacc[ct] = mfma16(a, b, Cacc[ct]); } }
            m_prev = bL + M63;
        }
        if (ctx) { const int sidx = (bg * 2 + dir) * 4 + h; float* Co = p.out + OUT_C + (size_t)sidx * 16384;
            int z1 = 0; asm volatile("" : "+v"(z1)); const int tid1 = (int)threadIdx.x + z1, fr1 = tid1 & 15, fq1 = (tid1 >> 4) & 3;
#pragma unroll
            for (int j = 0; j < 4; ++j) { const int d = 16 * wv + 4 * fq1 + j;
#pragma unroll
                for (int ct = 0; ct < 8; ++ct) Co[d * 128 + 16 * ct + fr1] = Cacc[ct][j];
                if (fr1 == 0) p.out[OUT_N + sidx * 128 + d] = Cacc[8][j]; }
            if (tid1 == 0) p.out[OUT_MM + sidx] = m_prev; }
        __syncthreads();
    }
}

__device__ __forceinline__ void phase_shift(bf16_t* U, const float* pmu, uint4* sRow) {
#pragma unroll 1
    for (int item = blockIdx.x; item < 1200; item += gridDim.x) {
        const int tid = opaque_tid(), tl = tid >> 3, g = tid & 7;
        const bool grid = item < 240; const int seq = grid ? item / 30 : (item - 240) / 30, sl = grid ? item % 30 : (item - 240) % 30;
        const int T = grid ? 2048 : 256, nst = T / 64; const size_t row0 = grid ? (size_t)NCTX + (size_t)seq * 2048 : (size_t)seq * 256;
        const int rc = sl * 64 + g * 8;
        char* base = (char*)(U + row0 * UW + 2048 + rc);
        const int act = (rc >= 1536 && rc < 1664) ? 1 : (rc >= 1792 ? 2 : 0);
        unsigned z0_ = 0u; asm volatile("" : "+v"(z0_));
        uint4 prv = make_uint4(z0_, z0_, z0_, z0_), cur = *(const uint4*)(base + (size_t)tl * (UW * 2)), nxt;
        __syncthreads();
#pragma unroll 1
        for (int k = 0; k < nst; ++k) {
            unsigned zr = 0u; asm volatile("" : "+v"(zr)); const uint4 z4 = make_uint4(zr, zr, zr, zr);
            nxt = z4; if (k + 1 < nst) nxt = *(const uint4*)(base + (size_t)((k + 1) * 64 + tl) * (UW * 2));
            sRow[(1 + tl) * 8 + g] = cur;
            if (tl == 0) sRow[65 * 8 + g] = nxt;
            LDS_BARRIER();
            uint4 lf = sRow[tl * 8 + g], rt = sRow[(2 + tl) * 8 + g];
            if (tl == 0 && (grid || k == 0)) lf = z4;
            if (tl == 63 && (grid || k == nst - 1)) rt = z4;
            float x[8], t[8], o[8], ms[8], m[8];
            int zz = 0; asm volatile("" : "+v"(zz)); const float* mup = pmu + rc + zz;
#define LD_MU8(a) do { const float4 m0 = *(const float4*)(mup + (a) * 1920), m1 = *(const float4*)(mup + (a) * 1920 + 4); m[0] = m0.x; m[1] = m0.y; m[2] = m0.z; m[3] = m0.w; m[4] = m1.x; m[5] = m1.y; m[6] = m1.z; m[7] = m1.w; } while (0)
            unpack8(cur, x);
            LD_MU8(0); unpack8(lf, t);
#pragma unroll
            for (int i = 0; i < 8; ++i) { o[i] = m[i] * t[i]; ms[i] = m[i]; }
            LD_MU8(1); unpack8(rt, t);
#pragma unroll
            for (int i = 0; i < 8; ++i) { o[i] += m[i] * t[i]; ms[i] += m[i]; }
            if (grid) {
                LD_MU8(2); unpack8(prv, t);
#pragma unroll
                for (int i = 0; i < 8; ++i) { o[i] += m[i] * t[i]; ms[i] += m[i]; }
                LD_MU8(3); unpack8(nxt, t);
#pragma unroll
                for (int i = 0; i < 8; ++i) { o[i] += m[i] * t[i]; ms[i] += m[i]; }
            }
#undef LD_MU8
#pragma unroll
            for (int i = 0; i < 8; ++i) o[i] += x[i] * (1.f - ms[i]);
            if (act == 1) {
#pragma unroll
                for (int i = 0; i < 8; ++i) o[i] = tanh_fast(o[i]); }
            if (act == 2) {
#pragma unroll
                for (int i = 0; i < 8; ++i) o[i] = sigmf(o[i]); }
            *(uint4*)(base + (size_t)(k * 64 + tl) * (UW * 2)) = make_uint4(pk2(o[0], o[1]), pk2(o[2], o[3]), pk2(o[4], o[5]), pk2(o[6], o[7]));
            LDS_BARRIER();
            if (tl == 63) sRow[g] = cur;
            prv = cur; cur = nxt;
        }
    }
}

constexpr int RW_TC = 16;
constexpr int RW_VEC = 0, RW_V = RW_VEC + 16 * 320 * 4, RW_KR = RW_V + 16 * 32 * 4, RW_XW = RW_KR + 16 * 64 * 4, RW_XA = RW_XW + 16 * 72 * 2, RW_Y = RW_XA + 16 * 72 * 2,
              RW_MU = RW_Y + 16 * 32 * 4, RW_DIR = RW_MU + 4 * 288 * 4;
static_assert(2 * RW_DIR <= LDS_BYTES && RW_DIR % 16 == 0, "rwkv lds");

__device__ __forceinline__ float dppf(float x, const int ctrl) { return x; }
#define DPP_ADD(x, ctrl) ((x) + __int_as_float(__builtin_amdgcn_update_dpp(0, __float_as_int(x), (ctrl), 0xf, 0xf, true)))
__device__ __forceinline__ float red8(float x) { x = DPP_ADD(x, 0xB1); x = DPP_ADD(x, 0x4E); x = DPP_ADD(x, 0x141); return x; }
__device__ __forceinline__ float red16(float x) { x = red8(x); x = DPP_ADD(x, 0x140); return x; }

struct Sh8 { uint4 x, l, r, u, d; };
__device__ __forceinline__ void sh8_load(Sh8& q, const bf16_t* U, size_t row0, int tok, int T, bool grid, int c0) {
    const char* Ub = (const char*)(U + row0 * UW);
    const int off = (tok * UW + c0) * 2; const uint4 z = make_uint4(0u, 0u, 0u, 0u);
    const bool hl = grid ? (tok & 63) != 0 : tok > 0, hr = grid ? (tok & 63) != 63 : tok < T - 1;
    q.x = *(const uint4*)(Ub + off);
    q.l = hl ? *(const uint4*)(Ub + (off - UW * 2)) : z; q.r = hr ? *(const uint4*)(Ub + (off + UW * 2)) : z;
    q.u = (grid && tok >= 64) ? *(const uint4*)(Ub + (off - 64 * UW * 2)) : z; q.d = (grid && tok < T - 64) ? *(const uint4*)(Ub + (off + 64 * UW * 2)) : z;
}
__device__ __forceinline__ void sh8_mix(const Sh8& q, bool grid, const float* mu4, int mustride, float* o) {
    float x[8], t[8], m[8], ms[8];
    unpack8(q.x, x);
    { const float4 a = *(const float4*)mu4, b = *(const float4*)(mu4 + 4); m[0] = a.x; m[1] = a.y; m[2] = a.z; m[3] = a.w; m[4] = b.x; m[5] = b.y; m[6] = b.z; m[7] = b.w; }
    unpack8(q.l, t);
#pragma unroll
    for (int i = 0; i < 8; ++i) { o[i] = m[i] * t[i]; ms[i] = m[i]; }
    { const float4 a = *(const float4*)(mu4 + mustride), b = *(const float4*)(mu4 + mustride + 4); m[0] = a.x; m[1] = a.y; m[2] = a.z; m[3] = a.w; m[4] = b.x; m[5] = b.y; m[6] = b.z; m[7] = b.w; }
    unpack8(q.r, t);
#pragma unroll
    for (int i = 0; i < 8; ++i) { o[i] += m[i] * t[i]; ms[i] += m[i]; }
    if (grid) {
        { const float4 a = *(const float4*)(mu4 + 2 * mustride), b = *(const float4*)(mu4 + 2 * mustride + 4); m[0] = a.x; m[1] = a.y; m[2] = a.z; m[3] = a.w; m[4] = b.x; m[5] = b.y; m[6] = b.z; m[7] = b.w; }
        unpack8(q.u, t);
#pragma unroll
        for (int i = 0; i < 8; ++i) { o[i] += m[i] * t[i]; ms[i] += m[i]; }
        { const float4 a = *(const float4*)(mu4 + 3 * mustride), b = *(const float4*)(mu4 + 3 * mustride + 4); m[0] = a.x; m[1] = a.y; m[2] = a.z; m[3] = a.w; m[4] = b.x; m[5] = b.y; m[6] = b.z; m[7] = b.w; }
        unpack8(q.d, t);
#pragma unroll
        for (int i = 0; i < 8; ++i) { o[i] += m[i] * t[i]; ms[i] += m[i]; }
    }
#pragma unroll
    for (int i = 0; i < 8; ++i) o[i] += x[i] * (1.f - ms[i]);
}
__device__ __forceinline__ void shifted8(const bf16_t* U, size_t row0, int tok, int T, bool grid, int c0, const float* mu4, int mustride, float* o) {
    Sh8 q; sh8_load(q, U, row0, tok, T, grid, c0); sh8_mix(q, grid, mu4, mustride, o);
}
typedef float f32x2 __attribute__((ext_vector_type(2)));

__device__ __forceinline__ void rwkv_task(const P& p, unsigned char* lds, int bg, int h, int rh) {
    const int wv = __builtin_amdgcn_readfirstlane((int)threadIdx.x >> 6), dir = wv >> 2, lw = wv & 3;
    const bool ctx = bg < 32; const int T = ctx ? 256 : 2048, nc = T / RW_TC; const size_t row0 = ctx ? (size_t)bg * 256 : (size_t)NCTX + (size_t)(bg - 32) * 2048;
    const bool grid = !ctx;
    unsigned char* L = lds + dir * RW_DIR;
    float* sVec = (float*)(L + RW_VEC); float* sV = (float*)(L + RW_V); float* sKr = (float*)(L + RW_KR); bf16_t* sXw = (bf16_t*)(L + RW_XW); bf16_t* sXa = (bf16_t*)(L + RW_XA);
    float* sY = (float*)(L + RW_Y); float* sMu = (float*)(L + RW_MU);
    const bf16_t* U = (const bf16_t*)(p.ws + WS_U); bf16_t* HB = (bf16_t*)(p.ws + WS_A);
    const int hc = h * 64;
    float st[8]; bf16x8 wfrag[2], afrag[2]; float w0v, a0v, kav;
    {
        const int tid = opaque_tid(), ltid = tid & 255, ri = ltid >> 3, jq = ltid & 7, fr = tid & 15, fq = (tid >> 4) & 3;
        __syncthreads();
        if (ctx) {
#pragma unroll
            for (int q = 0; q < 8; ++q) st[q] = 0.f;
        } else { const float* S0 = p.sS + ((size_t)(((bg - 32) * 2 + dir) * 8 + h)) * 4096 + (32 * rh + ri) * 64 + jq * 8;
#pragma unroll
            for (int q = 0; q < 8; ++q) st[q] = S0[q]; }
        const int jcol = hc + 16 * lw + fr;
#pragma unroll
        for (int ks = 0; ks < 2; ++ks) { float wf[8], af[8];
#pragma unroll
            for (int i = 0; i < 8; ++i) { const int l = 32 * ks + 8 * fq + i; wf[i] = p.w2[(size_t)(dir * 64 + l) * 512 + jcol]; af[i] = p.a2[(size_t)(dir * 64 + l) * 512 + jcol]; }
            union { uint4 u; bf16x8 v; } c1, c2; c1.u = make_uint4(pk2(wf[0], wf[1]), pk2(wf[2], wf[3]), pk2(wf[4], wf[5]), pk2(wf[6], wf[7])); c2.u = make_uint4(pk2(af[0], af[1]), pk2(af[2], af[3]), pk2(af[4], af[5]), pk2(af[6], af[7]));
            wfrag[ks] = c1.v; afrag[ks] = c2.v; }
        w0v = p.w0[dir * 512 + jcol]; a0v = p.a0[dir * 512 + jcol]; kav = p.ka[jcol];
    }
    uint4 q1, q2, q3 = make_uint4(0u, 0u, 0u, 0u);
    const char* Ub = (const char*)(U + row0 * UW);
    { const int tid = opaque_tid(), ltid = tid & 255; const int c = dir ? nc - 1 : 0, tok0 = c * RW_TC; const int tl = (ltid & 127) >> 3, g = ltid & 7;
      q1 = *(const uint4*)(Ub + ((tok0 + tl) * UW + (lw < 2 ? 2048 : 2048 + 512) + hc + 8 * g) * 2);
      q2 = *(const uint4*)(Ub + ((tok0 + tl) * UW + (lw < 2 ? 2048 + 1536 : 2048 + 1664) + dir * 64 + 8 * g) * 2);
      if (lw == 0) q3 = *(const uint4*)(Ub + ((tok0 + (ltid >> 2)) * UW + 2048 + 1024 + hc + 32 * rh + 8 * (ltid & 3)) * 2); }
    f32x2 st2[4];
#pragma unroll
    for (int q = 0; q < 4; ++q) st2[q] = (f32x2){st[2 * q], st[2 * q + 1]};
#pragma unroll 1
    for (int s = 0; s < nc; ++s) {
        const int c = dir ? nc - 1 - s : s; const int tok0 = c * RW_TC;
        const bool second = s >= (nc >> 1);
        const int tid = opaque_tid(), ltid = tid & 255, ri = ltid >> 3, jq = ltid & 7, fr = tid & 15, fq = (tid >> 4) & 3;
        { const int tl = (ltid & 127) >> 3, g = ltid & 7; float o[8];
          if (lw < 2) {
              unpack8(q1, o);
              *(float4*)(sVec + tl * 320 + 8 * g) = make_float4(o[0], o[1], o[2], o[3]); *(float4*)(sVec + tl * 320 + 8 * g + 4) = make_float4(o[4], o[5], o[6], o[7]);
              *(uint4*)(sXw + tl * 72 + 8 * g) = q2;
          } else {
              unpack8(q1, o);
              float kkr[8]; float ss = 0.f;
#pragma unroll
              for (int i = 0; i < 8; ++i) { kkr[i] = o[i] * p.kk[hc + 8 * g + i]; ss += kkr[i] * kkr[i]; }
              ss = red8(ss); const float rn = __builtin_amdgcn_rsqf(fmaxf(ss, 1e-24f));
              *(float4*)(sKr + tl * 64 + 8 * g) = make_float4(o[0], o[1], o[2], o[3]); *(float4*)(sKr + tl * 64 + 8 * g + 4) = make_float4(o[4], o[5], o[6], o[7]);
              *(float4*)(sVec + tl * 320 + 192 + 8 * g) = make_float4(kkr[0] * rn, kkr[1] * rn, kkr[2] * rn, kkr[3] * rn); *(float4*)(sVec + tl * 320 + 192 + 8 * g + 4) = make_float4(kkr[4] * rn, kkr[5] * rn, kkr[6] * rn, kkr[7] * rn);
              *(uint4*)(sXa + tl * 72 + 8 * g) = q2;
          }
          if (lw == 0) {
              const int tl2 = ltid >> 2, g2 = ltid & 3;
              unpack8(q3, o);
              *(float4*)(sV + tl2 * 32 + 8 * g2) = make_float4(o[0], o[1], o[2], o[3]); *(float4*)(sV + tl2 * 32 + 8 * g2 + 4) = make_float4(o[4], o[5], o[6], o[7]);
          } }
        __syncthreads();
        { f32x4 aw = (f32x4){0.f, 0.f, 0.f, 0.f}, aa = (f32x4){0.f, 0.f, 0.f, 0.f};
#pragma unroll
          for (int ks = 0; ks < 2; ++ks) { const bf16x8 xw = *(const bf16x8*)(sXw + fr * 72 + 32 * ks + 8 * fq), xa = *(const bf16x8*)(sXa + fr * 72 + 32 * ks + 8 * fq);
              aw = mfma16(xw, wfrag[ks], aw); aa = mfma16(xa, afrag[ks], aa); }
          const int j = 16 * lw + fr;
#pragma unroll
          for (int jj = 0; jj < 4; ++jj) { const int tl = 4 * fq + jj;
              const float dec = fexp(-fexp(-softplus_fast(-(w0v + aw[jj])) - 0.5f));
              const float a = sigmf(a0v + aa[jj]); const float k = sKr[tl * 64 + j], kn = sVec[tl * 320 + 192 + j];
              float* V = sVec + tl * 320 + j; V[64] = dec; V[128] = k * (1.f + (a - 1.f) * kav); V[256] = kn * a; } }
        const int otl = ltid >> 4, opr = ltid & 15; unsigned* hb = (unsigned*)(HB + (row0 + tok0 + otl) * DM + 512 + hc + 32 * rh + 2 * opr);
        unsigned ov = 0u;
        if (second) ov = __hip_atomic_load(hb, __ATOMIC_RELAXED, __HIP_MEMORY_SCOPE_AGENT);
        if (s + 1 < nc) { const int cn = dir ? nc - 2 - s : s + 1, tokn = cn * RW_TC; const int tl = (ltid & 127) >> 3, g = ltid & 7;
            q1 = *(const uint4*)(Ub + ((tokn + tl) * UW + (lw < 2 ? 2048 : 2048 + 512) + hc + 8 * g) * 2);
            q2 = *(const uint4*)(Ub + ((tokn + tl) * UW + (lw < 2 ? 2048 + 1536 : 2048 + 1664) + dir * 64 + 8 * g) * 2);
            if (lw == 0) q3 = *(const uint4*)(Ub + ((tokn + (ltid >> 2)) * UW + 2048 + 1024 + hc + 32 * rh + 8 * (ltid & 3)) * 2); }
        LDS_BARRIER();
        f32x2 sv_[4];
#pragma unroll
        for (int q = 0; q < 4; ++q) sv_[q] = st2[q];
#pragma unroll 1
        for (int rep = 0; rep < (PROBE_DUP == 102 ? 2 : 1); ++rep) {
        if (PROBE_DUP == 102) {
#pragma unroll
            for (int q = 0; q < 4; ++q) st2[q] = sv_[q]; }
float ys[RW_TC];
#pragma unroll
        for (int step = 0; step < RW_TC; ++step) { const int tl = dir ? RW_TC - 1 - step : step; const float* V = sVec + tl * 320 + jq * 8;
            const float4 ka4 = *(const float4*)(V + 192), kb4 = *(const float4*)(V + 196);
            f32x2 acc = st2[0] * (f32x2){ka4.x, ka4.y}; acc = st2[1] * (f32x2){ka4.z, ka4.w} + acc; acc = st2[2] * (f32x2){kb4.x, kb4.y} + acc; acc = st2[3] * (f32x2){kb4.z, kb4.w} + acc;
            const float sa = -red8(acc.x + acc.y);
            const float vi = sV[tl * 32 + ri];
            const float4 wa = *(const float4*)(V + 64), wb = *(const float4*)(V + 68), ba = *(const float4*)(V + 256), bb = *(const float4*)(V + 260),
                         da = *(const float4*)(V + 128), db = *(const float4*)(V + 132), ra = *(const float4*)(V), rb = *(const float4*)(V + 4);
            const f32x2 sa2 = (f32x2){sa, sa}, vi2 = (f32x2){vi, vi};
            st2[0] = st2[0] * (f32x2){wa.x, wa.y} + (sa2 * (f32x2){ba.x, ba.y} + vi2 * (f32x2){da.x, da.y});
            st2[1] = st2[1] * (f32x2){wa.z, wa.w} + (sa2 * (f32x2){ba.z, ba.w} + vi2 * (f32x2){da.z, da.w});
            st2[2] = st2[2] * (f32x2){wb.x, wb.y} + (sa2 * (f32x2){bb.x, bb.y} + vi2 * (f32x2){db.x, db.y});
            st2[3] = st2[3] * (f32x2){wb.z, wb.w} + (sa2 * (f32x2){bb.z, bb.w} + vi2 * (f32x2){db.z, db.w});
            f32x2 ya = st2[0] * (f32x2){ra.x, ra.y}; ya = st2[1] * (f32x2){ra.z, ra.w} + ya; ya = st2[2] * (f32x2){rb.x, rb.y} + ya; ya = st2[3] * (f32x2){rb.z, rb.w} + ya;
            const float y = red8(ya.x + ya.y);
            ys[step] = y; }
        if (jq == 0) {
#pragma unroll
            for (int step = 0; step < RW_TC; ++step) sY[(dir ? RW_TC - 1 - step : step) * 32 + ri] = ys[step]; }
        }
        LDS_BARRIER();
        { float y0 = sY[otl * 32 + 2 * opr], y1 = sY[otl * 32 + 2 * opr + 1];
          if (second) { y0 += __uint_as_float(ov << 16); y1 += __uint_as_float(ov & 0xffff0000u); }
          *hb = pk2(y0, y1); }
    }
#pragma unroll
    for (int q = 0; q < 4; ++q) { st[2 * q] = st2[q].x; st[2 * q + 1] = st2[q].y; }
    if (ctx) { const int tid = opaque_tid(), ltid = tid & 255, ri = ltid >> 3, jq = ltid & 7;
        float* So = p.out + OUT_S + ((size_t)((bg * 2 + dir) * 8 + h)) * 4096 + (32 * rh + ri) * 64 + jq * 8;
#pragma unroll
        for (int q = 0; q < 8; ++q) So[q] = st[q]; }
    __syncthreads();
}

constexpr int RX_VEC = 0,
              RX_KR = RX_VEC + 16 * 320 * 4,
              RX_XW = RX_KR + 4096, RX_XA = RX_XW + 2304,
              RX_Y = RX_XA + 2304,
              RX_KT = RX_Y + 4096, RX_KTN = RX_KT + 2304, RX_RT = RX_KTN + 2304, RX_RTN = RX_RT + 2304, RX_BN = RX_RTN + 2304, RX_DN = RX_BN + 2304,
              RX_BTS = RX_DN + 2304, RX_DT = RX_BTS + 5120, RX_VT = RX_DT + 5120,
              RX_ADK = RX_VT + 5120, RX_ABR = RX_ADK + 1280, RX_ADR = RX_ABR + 1280, RX_TM = RX_ADR + 1280,
              RX_N = RX_TM + 1280,
              RX_PL = RX_N + 1088,
              RX_DIR = RX_PL + 256;
static_assert(2 * RX_DIR <= LDS_BYTES - 64 && RX_DIR % 16 == 0, "rwkv (chunked) lds");
__device__ __forceinline__ int perm_pi(int j) { const int jj = j & 31; return (j & 32) + 8 * ((jj & 15) >> 2) + (jj & 3) + 4 * (jj >> 4); }
__device__ __forceinline__ int perm_sg(int c) { return 8 * (c >> 2) + (c & 3); }
__device__ __forceinline__ bf16x8 pack_acc_lo(const f32x4 v) { union { uint4 u; bf16x8 b; } c; c.u = make_uint4(pk2(v[0], v[1]), pk2(v[2], v[3]), 0u, 0u); return c.b; }
__device__ __forceinline__ bf16x8 pack_acc2(const f32x4 a, const f32x4 b) { union { uint4 u; bf16x8 v; } c; c.u = make_uint4(pk2(a[0], a[1]), pk2(a[2], a[3]), pk2(b[0], b[1]), pk2(b[2], b[3])); return c.v; }

__device__ __forceinline__ void rwkv_task_w(const P& p, unsigned char* lds, int bg, int h) {
    const int wv = __builtin_amdgcn_readfirstlane((int)threadIdx.x >> 6), dir = wv >> 2, lw = wv & 3;
    const bool ctx = bg < 32; const int T = ctx ? 256 : 2048, nc = T / 16; const size_t row0 = ctx ? (size_t)bg * 256 : (size_t)NCTX + (size_t)(bg - 32) * 2048;
    unsigned char* L = lds + dir * RX_DIR;
    float* sVec = (float*)(L + RX_VEC); float* sKr = (float*)(L + RX_KR); bf16_t* sXw = (bf16_t*)(L + RX_XW); bf16_t* sXa = (bf16_t*)(L + RX_XA); float* sY = (float*)(L + RX_Y);
    bf16_t* sKT = (bf16_t*)(L + RX_KT); bf16_t* sKTn = (bf16_t*)(L + RX_KTN); bf16_t* sRT = (bf16_t*)(L + RX_RT); bf16_t* sRTn = (bf16_t*)(L + RX_RTN); bf16_t* sBn = (bf16_t*)(L + RX_BN); bf16_t* sDn = (bf16_t*)(L + RX_DN);
    bf16_t* sBts = (bf16_t*)(L + RX_BTS); bf16_t* sDt = (bf16_t*)(L + RX_DT); bf16_t* sVT = (bf16_t*)(L + RX_VT);
    bf16_t* sAdk = (bf16_t*)(L + RX_ADK); bf16_t* sAbr = (bf16_t*)(L + RX_ABR); bf16_t* sAdr = (bf16_t*)(L + RX_ADR); bf16_t* sTm = (bf16_t*)(L + RX_TM);
    float* sN = (float*)(L + RX_N); float* sPL = (float*)(L + RX_PL);
    const bf16_t* U = (const bf16_t*)(p.ws + WS_U); bf16_t* HB = (bf16_t*)(p.ws + WS_A);
    const int hc = h * 64;
    f32x4 ST[4]; bf16x8 wfrag[2], afrag[2]; float w0v, a0v, kav, kkc[8];
    {
        const int tid = opaque_tid(), ltid = tid & 255, fr = tid & 15, fq = (tid >> 4) & 3;
        __syncthreads();
        for (int i = ltid; i < (RX_N - RX_BTS) / 4; i += 256) ((unsigned*)(L + RX_BTS))[i] = 0u;
        __syncthreads();
        if (ctx) {
#pragma unroll
            for (int jt = 0; jt < 4; ++jt) ST[jt] = (f32x4){0.f, 0.f, 0.f, 0.f};
        } else { const float* S0 = p.sS + ((size_t)(((bg - 32) * 2 + dir) * 8 + h)) * 4096 + (16 * lw + fr) * 64 + 4 * fq;
#pragma unroll
            for (int jt = 0; jt < 4; ++jt) { const float4 t = *(const float4*)(S0 + 16 * jt); ST[jt] = (f32x4){t.x, t.y, t.z, t.w}; } }
        const int jcol = hc + 16 * lw + fr;
#pragma unroll
        for (int ks = 0; ks < 2; ++ks) { float wf[8], af[8];
#pragma unroll
            for (int i = 0; i < 8; ++i) { const int l = 32 * ks + 8 * fq + i; wf[i] = p.w2[(size_t)(dir * 64 + l) * 512 + jcol]; af[i] = p.a2[(size_t)(dir * 64 + l) * 512 + jcol]; }
            union { uint4 u; bf16x8 v; } c1, c2; c1.u = make_uint4(pk2(wf[0], wf[1]), pk2(wf[2], wf[3]), pk2(wf[4], wf[5]), pk2(wf[6], wf[7])); c2.u = make_uint4(pk2(af[0], af[1]), pk2(af[2], af[3]), pk2(af[4], af[5]), pk2(af[6], af[7]));
            wfrag[ks] = c1.v; afrag[ks] = c2.v; }
        w0v = p.w0[dir * 512 + jcol]; a0v = p.a0[dir * 512 + jcol]; kav = p.ka[jcol];
#pragma unroll
        for (int i = 0; i < 8; ++i) kkc[i] = p.kk[hc + 8 * (ltid & 7) + i];
    }
    uint4 q1, q2, q3, n1a, n2a, n3a, n1b, n2b, n3b;
    const char* Ub = (const char*)(U + row0 * UW);
#define RX_LOAD(d1, d2, d3, sidx) do { const int s_ = (sidx) < nc ? (sidx) : nc - 1; const int c_ = dir ? nc - 1 - s_ : s_; const int tok_ = c_ * 16 + ((ltid_ & 127) >> 3); const int g_ = ltid_ & 7; \
        d1 = *(const uint4*)(Ub + (tok_ * UW + (lw < 2 ? 2048 : 2048 + 512) + hc + 8 * g_) * 2); \
        d2 = *(const uint4*)(Ub + (tok_ * UW + (lw < 2 ? 2048 + 1536 : 2048 + 1664) + dir * 64 + 8 * g_) * 2); \
        d3 = *(const uint4*)(Ub + (tok_ * UW + 2048 + 1024 + hc + 8 * g_) * 2); } while (0)
    { const int ltid_ = opaque_tid() & 255; RX_LOAD(q1, q2, q3, 0); RX_LOAD(n1a, n2a, n3a, 1); RX_LOAD(n1b, n2b, n3b, 2); }
#pragma unroll 1
    for (int s = 0; s < nc; ++s) {
        const int c = dir ? nc - 1 - s : s; const int tok0 = c * 16;
        const bool second = s >= (nc >> 1);
        const int tid = opaque_tid(), ltid = tid & 255, fr = tid & 15, fq = (tid >> 4) & 3;
        { const int tl = (ltid & 127) >> 3, g = ltid & 7, q = dir ? 15 - tl : tl; float o[8];
          if (lw < 2) {
              unpack8(q1, o);
              *(float4*)(sVec + q * 320 + 8 * g) = make_float4(o[0], o[1], o[2], o[3]); *(float4*)(sVec + q * 320 + 8 * g + 4) = make_float4(o[4], o[5], o[6], o[7]);
              *(uint4*)(sXw + q * 72 + 8 * g) = q2;
              const unsigned vw[4] = {q3.x, q3.y, q3.z, q3.w};
#pragma unroll
              for (int i = 0; i < 8; ++i) sVT[(8 * g + i) * 40 + q] = (bf16_t)((vw[i >> 1] >> ((i & 1) * 16)) & 0xffffu);
          } else {
              unpack8(q1, o);
              float kkr[8]; float ss = 0.f;
#pragma unroll
              for (int i = 0; i < 8; ++i) { kkr[i] = o[i] * kkc[i]; ss += kkr[i] * kkr[i]; }
              ss = red8(ss); const float rn = __builtin_amdgcn_rsqf(fmaxf(ss, 1e-24f));
              *(float4*)(sKr + q * 64 + 8 * g) = make_float4(o[0], o[1], o[2], o[3]); *(float4*)(sKr + q * 64 + 8 * g + 4) = make_float4(o[4], o[5], o[6], o[7]);
              *(float4*)(sVec + q * 320 + 192 + 8 * g) = make_float4(kkr[0] * rn, kkr[1] * rn, kkr[2] * rn, kkr[3] * rn); *(float4*)(sVec + q * 320 + 192 + 8 * g + 4) = make_float4(kkr[4] * rn, kkr[5] * rn, kkr[6] * rn, kkr[7] * rn);
              *(uint4*)(sXa + q * 72 + 8 * g) = q2;
          } }
        LDS_BARRIER();
        { f32x4 aw = (f32x4){0.f, 0.f, 0.f, 0.f}, aa = (f32x4){0.f, 0.f, 0.f, 0.f};
#pragma unroll
          for (int ks = 0; ks < 2; ++ks) { const bf16x8 xw = *(const bf16x8*)(sXw + fr * 72 + 32 * ks + 8 * fq), xa = *(const bf16x8*)(sXa + fr * 72 + 32 * ks + 8 * fq);
              aw = mfma16(xw, wfrag[ks], aw); aa = mfma16(xa, afrag[ks], aa); }
          const int j = 16 * lw + fr;
          float lg[4], av[4]; float run = 0.f;
#pragma unroll
          for (int e = 0; e < 4; ++e) { const float lw_ = -0.6065306597126334f * sigmf(w0v + aw[e])  ; run += lw_; lg[e] = run; av[e] = sigmf(a0v + aa[e]); }
          float x = run; { const float y1 = __shfl_up(x, 16); if (fq >= 1) x += y1; const float y2 = __shfl_up(x, 32); if (fq >= 2) x += y2; }
          const float excl = x - run;
          const int pj = perm_pi(j); bf16_t btv[4], dtv[4];
          float Pp = fexp(excl);
#pragma unroll
          for (int e = 0; e < 4; ++e) { const int q = 4 * fq + e; const float Lq = excl + lg[e];
              const float Pq = fexp(Lq), iP = __builtin_amdgcn_rcpf(Pq);
              const float k = sKr[q * 64 + j], kn = sVec[q * 320 + 192 + j], r = sVec[q * 320 + j];
              const float kd = k * (1.f + (av[e] - 1.f) * kav), b = kn * av[e];
              const bf16_t kt = f2bf(Pp * kn), rt = f2bf(Pq * r), bt = f2bf(b * iP), dt = f2bf(kd * iP);
              sKT[q * 72 + pj] = kt; sRT[q * 72 + pj] = rt; sBn[q * 72 + pj] = bt; sDn[q * 72 + pj] = dt;
              btv[e] = bt; dtv[e] = dt;
              if (q == 15) sPL[j] = Pq;
              Pp = Pq; }
          *(uint2*)(sBts + j * 40 + 8 * fq) = make_uint2((unsigned)btv[0] | ((unsigned)btv[1] << 16), (unsigned)btv[2] | ((unsigned)btv[3] << 16));
          *(uint2*)(sDt + j * 40 + 4 * fq) = make_uint2((unsigned)dtv[0] | ((unsigned)dtv[1] << 16), (unsigned)dtv[2] | ((unsigned)dtv[3] << 16)); }
        if (s == (nc >> 1)) asm volatile("s_waitcnt vmcnt(0)" ::: "memory"); else asm volatile("s_waitcnt vmcnt(6)" ::: "memory");
        LDS_BARRIER();
        { const int role = (lw - dir) & 3;
          f32x4 gacc = (f32x4){0.f, 0.f, 0.f, 0.f}; const bf16_t* Ap = (role < 2) ? sKT : sRT; const bf16_t* Bp = (role & 1) ? sDn : sBn;
#pragma unroll
          for (int ks = 0; ks < 2; ++ks) gacc = mfma16(*(const bf16x8*)(Ap + fr * 72 + 32 * ks + 8 * fq), *(const bf16x8*)(Bp + fr * 72 + 32 * ks + 8 * fq), gacc);
          const int sidx = fr;
          float gm[4];
#pragma unroll
          for (int e = 0; e < 4; ++e) { const int q = 4 * fq + e; const bool keep = (role < 2) ? (sidx < q) : (sidx <= q); gm[e] = keep ? gacc[e] : 0.f; }
          if (role == 0) {
              const int r = tid & 15; float Tr[16];
#pragma unroll
              for (int q = 0; q < 16; ++q) Tr[q] = (r == q) ? 1.f : 0.f;
#pragma unroll
              for (int q = 0; q < 15; ++q) { const float tq = Tr[q];
#pragma unroll
                  for (int q2 = q + 1; q2 < 16; ++q2) { const float nv = __int_as_float(__builtin_amdgcn_readlane(__float_as_int(gm[q2 & 3]), q + 16 * (q2 >> 2))); Tr[q2] -= tq * nv; } }
              if ((tid & 63) < 16) { const int ps = perm_sg(r);
#pragma unroll
                  for (int q = 0; q < 16; ++q) sTm[q * 40 + ps] = f2bf(Tr[q]); }
          } else {
#pragma unroll
              for (int e = 0; e < 4; ++e) { const int q = 4 * fq + e;
                  if (role == 1) sAdk[q * 40 + sidx] = f2bf(gm[e]);
                  else if (role == 2) sAbr[q * 40 + perm_sg(sidx)] = f2bf(gm[e]);
                  else sAdr[q * 40 + sidx] = f2bf(gm[e]); } } }
        const int oq = ltid >> 4, otl = dir ? 15 - oq : oq; unsigned long long* hb = (unsigned long long*)(HB + (row0 + tok0 + otl) * DM + 512 + hc + 4 * (ltid & 15));
        const unsigned long long ov = __hip_atomic_load(hb, __ATOMIC_RELAXED, __HIP_MEMORY_SCOPE_AGENT);
        q1 = n1a; q2 = n2a; q3 = n3a; n1a = n1b; n2a = n2b; n3a = n3b;
        { const int ltid_ = ltid; RX_LOAD(n1b, n2b, n3b, s + 3); }
        LDS_BARRIER();
        { const bf16x8 Sb0 = pack_acc2(ST[0], ST[1]), Sb1 = pack_acc2(ST[2], ST[3]);
          const bf16x8 vtf = *(const bf16x8*)(sVT + (16 * lw + fr) * 40 + 8 * fq);
          f32x4 XT = (f32x4){0.f, 0.f, 0.f, 0.f};
          XT = mfma16(*(const bf16x8*)(sKT + fr * 72 + 8 * fq), Sb0, XT); XT = mfma16(*(const bf16x8*)(sKT + fr * 72 + 32 + 8 * fq), Sb1, XT);
          XT = mfma16(*(const bf16x8*)(sAdk + fr * 40 + 8 * fq), vtf, XT);
          f32x4 SAT = mfma16(*(const bf16x8*)(sTm + fr * 40 + 8 * fq), pack_acc_lo(XT), (f32x4){0.f, 0.f, 0.f, 0.f});
          SAT = -SAT;
          const bf16x8 SAb = pack_acc_lo(SAT);
          f32x4 YT = (f32x4){0.f, 0.f, 0.f, 0.f};
          YT = mfma16(*(const bf16x8*)(sRT + fr * 72 + 8 * fq), Sb0, YT); YT = mfma16(*(const bf16x8*)(sRT + fr * 72 + 32 + 8 * fq), Sb1, YT);
          YT = mfma16(*(const bf16x8*)(sAbr + fr * 40 + 8 * fq), SAb, YT); YT = mfma16(*(const bf16x8*)(sAdr + fr * 40 + 8 * fq), vtf, YT);
#pragma unroll
          for (int jt = 0; jt < 4; ++jt) { ST[jt] = mfma16(*(const bf16x8*)(sBts + (16 * jt + fr) * 40 + 8 * fq), SAb, ST[jt]); ST[jt] = mfma16(*(const bf16x8*)(sDt + (16 * jt + fr) * 40 + 8 * fq), vtf, ST[jt]);
              const float4 pl = *(const float4*)(sPL + 16 * jt + 4 * fq); ST[jt][0] *= pl.x; ST[jt][1] *= pl.y; ST[jt][2] *= pl.z; ST[jt][3] *= pl.w; }
#pragma unroll
          for (int e = 0; e < 4; ++e) sY[(4 * fq + e) * 64 + 16 * lw + fr] = YT[e]; }
        LDS_BARRIER();
        { const float4 y4 = *(const float4*)(sY + oq * 64 + 4 * (ltid & 15)); float y0 = y4.x, y1 = y4.y, y2 = y4.z, y3 = y4.w;
          if (second) { const unsigned lo = (unsigned)ov, hi = (unsigned)(ov >> 32); y0 += __uint_as_float(lo << 16); y1 += __uint_as_float(lo & 0xffff0000u); y2 += __uint_as_float(hi << 16); y3 += __uint_as_float(hi & 0xffff0000u); }
          *hb = (unsigned long long)pk2(y0, y1) | ((unsigned long long)pk2(y2, y3) << 32); }
    }
#undef RX_LOAD
    if (ctx) { const int tid = opaque_tid(), fr = tid & 15, fq = (tid >> 4) & 3;
        float* So = p.out + OUT_S + ((size_t)((bg * 2 + dir) * 8 + h)) * 4096 + (16 * lw + fr) * 64 + 4 * fq;
#pragma unroll
        for (int jt = 0; jt < 4; ++jt) *(float4*)(So + 16 * jt) = make_float4(ST[jt][0], ST[jt][1], ST[jt][2], ST[jt][3]); }
    __syncthreads();
}

constexpr int FZ_ROW = 1800;
constexpr int FZ_X = 0, FZ_MU = 32 * FZ_ROW * 2, FZ_END = FZ_MU + 4 * 1792 * 4;
static_assert(FZ_END <= LDS_BYTES && FZ_MU % 16 == 0, "finalize lds");

__device__ __forceinline__ void phase_rwkv_finalize(const P& p, unsigned char* lds) {
    bf16_t* sX = (bf16_t*)(lds + FZ_X); float* sMu = (float*)(lds + FZ_MU);
    const bf16_t* U = (const bf16_t*)(p.ws + WS_U); bf16_t* HB = (bf16_t*)(p.ws + WS_A);
    { const bf16_t* HB2 = (const bf16_t*)(p.ws + WS_HB2); const int tid0 = opaque_tid(), lane = tid0 & 63, wave = (int)threadIdx.x >> 6;
#pragma unroll 1
      for (int row = NCTX + blockIdx.x * 8 + wave; row < MT; row += gridDim.x * 8) {
          float hf[8], hb[8], og[8], v[8]; float ss = 0.f;
          unpack8(*(const uint4*)(HB + (size_t)row * DM + lane * 8), hf); unpack8(*(const uint4*)(HB2 + (size_t)(row - NCTX) * 512 + lane * 8), hb); unpack8(*(const uint4*)(U + (size_t)row * UW + 1536 + lane * 8), og);
#pragma unroll
          for (int i = 0; i < 8; ++i) { v[i] = sigmf(og[i]) * (hf[i] + hb[i]); ss += v[i] * v[i]; }
          ss = red16(ss); const float rms = rsqrtf(ss * (1.f / 128.f) + 1e-6f);
          const float4 g0 = *(const float4*)(p.hg + lane * 8), g1 = *(const float4*)(p.hg + lane * 8 + 4);
          *(uint4*)(HB + (size_t)row * DM + lane * 8) = make_uint4(pk2(v[0] * rms * g0.x, v[1] * rms * g0.y), pk2(v[2] * rms * g0.z, v[3] * rms * g0.w), pk2(v[4] * rms * g1.x, v[5] * rms * g1.y), pk2(v[6] * rms * g1.z, v[7] * rms * g1.w)); } }
    const bf16_t* A2 = (const bf16_t*)(p.ws + WS_A2BF); const bf16_t* G2 = (const bf16_t*)(p.ws + WS_G2BF);
    const int wv = __builtin_amdgcn_readfirstlane((int)threadIdx.x >> 6), hc = wv * 64;
    bf16x8 wAf[2][4], wAb[2][4], wG[4][4];
    { const int t0 = opaque_tid(), fr0 = t0 & 15, fq0 = (t0 >> 4) & 3;
#pragma unroll
      for (int ct = 0; ct < 4; ++ct) { const int n = hc + 16 * ct + fr0;
#pragma unroll
          for (int ks = 0; ks < 2; ++ks) { wAf[ks][ct] = *(const bf16x8*)(A2 + (size_t)n * 64 + 32 * ks + 8 * fq0); wAb[ks][ct] = *(const bf16x8*)(A2 + (size_t)(512 + n) * 64 + 32 * ks + 8 * fq0); }
#pragma unroll
          for (int ks = 0; ks < 4; ++ks) wG[ks][ct] = *(const bf16x8*)(G2 + (size_t)n * 128 + 32 * ks + 8 * fq0); } }
#pragma unroll 1
    for (int tile = blockIdx.x; tile < MT / 32; tile += gridDim.x) {
        const int tid = opaque_tid(), fr = tid & 15, fq = (tid >> 4) & 3;
        const int rowt = tile * 32; const bool ctx = rowt < NCTX; const int T = ctx ? 256 : 2048; const size_t row0 = ctx ? (size_t)(rowt & ~255) : (size_t)NCTX + (size_t)((rowt - NCTX) & ~2047);
        const int tokt = rowt - (int)row0;
        __syncthreads();
#pragma unroll 2
        for (int it = 0; it < 14; ++it) { const int item = it * NTHR + tid, tl = item / 224, gi = item % 224;
            const int c0 = gi < 192 ? 2048 + 8 * gi : 2048 + 1664 + 8 * (gi - 192);
            *(uint4*)(sX + tl * FZ_ROW + 8 * gi) = *(const uint4*)(U + (row0 + tokt + tl) * UW + c0); }
        __syncthreads();
#pragma unroll 1
        for (int rt = 0; rt < 2; ++rt) {
            f32x4 af[4], ab[4], gg[4];
#pragma unroll
            for (int ct = 0; ct < 4; ++ct) { af[ct] = (f32x4){0.f, 0.f, 0.f, 0.f}; ab[ct] = af[ct]; gg[ct] = af[ct]; }
            const bf16_t* xr = sX + (16 * rt + fr) * FZ_ROW;
#pragma unroll
            for (int ks = 0; ks < 2; ++ks) { const bf16x8 xf = *(const bf16x8*)(xr + 1536 + 32 * ks + 8 * fq), xb = *(const bf16x8*)(xr + 1600 + 32 * ks + 8 * fq);
#pragma unroll
                for (int ct = 0; ct < 4; ++ct) { af[ct] = mfma16(xf, wAf[ks][ct], af[ct]); ab[ct] = mfma16(xb, wAb[ks][ct], ab[ct]); } }
#pragma unroll
            for (int ks = 0; ks < 4; ++ks) { const bf16x8 xg = *(const bf16x8*)(xr + 1664 + 32 * ks + 8 * fq);
#pragma unroll
                for (int ct = 0; ct < 4; ++ct) gg[ct] = mfma16(xg, wG[ks][ct], gg[ct]); }
#pragma unroll
            for (int jj = 0; jj < 4; ++jj) { const int tl = 16 * rt + 4 * fq + jj; const size_t row = (size_t)rowt + tl; const bf16_t* xt = sX + tl * FZ_ROW;
                bf16_t* hb = HB + row * DM + 512 + hc;
                float y[4], vv[4]; float sy = 0.f, sb = 0.f;
#pragma unroll
                for (int ct = 0; ct < 4; ++ct) { const int ch = hc + 16 * ct + fr;
                    const float am = 0.5f * (sigmf(p.a0[ch] + af[ct][jj]) + sigmf(p.a0[512 + ch] + ab[ct][jj]));
                    const float r = bf2f(xt[ch]), k = bf2f(xt[512 + ch]); vv[ct] = bf2f(xt[1024 + ch]);
                    sb += r * k * (1.f + (am - 1.f) * p.ka[ch]) * p.rk[ch];
                    y[ct] = bf2f(hb[16 * ct + fr]); sy += y[ct]; }
                sy = red16(sy); sb = red16(sb);
                const float mean = sy * (1.f / 64.f); float vs = 0.f;
#pragma unroll
                for (int ct = 0; ct < 4; ++ct) { const float d = y[ct] - mean; vs += d * d; }
                vs = red16(vs); const float rstd = rsqrtf(vs * (1.f / 64.f) + 64e-5f);
#pragma unroll
                for (int ct = 0; ct < 4; ++ct) { const int ch = hc + 16 * ct + fr; const float yn = (y[ct] - mean) * rstd * p.lng[ch] + p.lnb[ch];
                    hb[16 * ct + fr] = f2bf((yn + sb * vv[ct]) * gg[ct][jj]); } }
        }
    }
}

__device__ __forceinline__ void phase_scan(const P& p, unsigned char* lds, int round = 0) {
    unsigned* ctr = (unsigned*)(p.ws + WS_CTR) + round;
    volatile int* sTask = (volatile int*)(lds + LDS_BYTES - 16);
#pragma unroll 1
    for (;;) {
        __syncthreads();
        if (threadIdx.x == 0) *sTask = (int)atomicAdd(ctr, 1u);
        __syncthreads();
        const int t = __builtin_amdgcn_readfirstlane(*sTask);
        if (t >= 512) break;
#pragma unroll 1
        for (int rep = 0; rep < ((PROBE_DUP == 100 && (t < 64 || (t >= 128 && t < 256))) || (PROBE_DUP == 101 && !(t < 64 || (t >= 128 && t < 256))) ? 2 : 1); ++rep) {
        if (t < 64) mlstm_task(p, lds, 32 + (t >> 3), (t >> 1) & 3, t & 1);
        else if (t < 128) { const int q = t - 64; rwkv_task_w(p, lds, 32 + (q >> 3), q & 7); }
        else if (t < 256) { const int q = t - 128; mlstm_task(p, lds, q >> 2, q & 3, -1); }
        else { const int q = t - 256; rwkv_task_w(p, lds, q >> 3, q & 7); }
        }
    }
}

__device__ void phase_convert_w2(const P& p, unsigned char* lds) {
    float* tile = (float*)lds;
    const int t1 = 16 * 88, t2 = 44 * 16;
    const int nb = gridDim.x, lo = nb > 128 ? 128 : 0;
    if ((int)blockIdx.x < lo) return;
    for (int it = blockIdx.x - lo; it < t1 + t2; it += nb - lo) {
        if (it < t1) do_convert(p.w2in, (bf16_t*)(p.ws + WS_W1), 1024, 5632, 5632, 1, it, tile);
        else do_convert(p.w2out, (bf16_t*)(p.ws + WS_W1B), 2816, 1024, 1024, 0, it - t1, tile);
    }
}

#define XB_TMO      128
#define XB_XCNT(j)  (256  + 64 * (j))
#define XB_XSUB(j)  (1280 + 64 * (j))
#define XB_XGEN(j)  (2304 + 64 * (j))
#define XB_TOP      3328
#define XB_TOPGEN   3392
#define XCD_BAR_WORDS 3456
#define XB_SPIN_CAP (1u << 18)
__device__ __forceinline__ unsigned xb_ld(unsigned* p)              { return __hip_atomic_load(p, __ATOMIC_RELAXED, __HIP_MEMORY_SCOPE_AGENT); }
__device__ __forceinline__ unsigned xb_add(unsigned* p, unsigned v) { return __hip_atomic_fetch_add(p, v, __ATOMIC_RELAXED, __HIP_MEMORY_SCOPE_AGENT); }
__device__ __forceinline__ unsigned xb_xcc_id() { return (unsigned)__builtin_amdgcn_s_getreg((3 << 11) | 20) & 0xFu; }
#define XB_SPIN(cond, bar) do { unsigned _sp = 0; while (cond) { __builtin_amdgcn_s_sleep(1); \
    if ((++_sp & 255u) == 0u) { if (xb_ld(&(bar)[XB_TMO])) break; if (_sp > XB_SPIN_CAP) { atomicAdd(&(bar)[XB_TMO], 1u); break; } } } } while (0)
struct XcdBarrier { unsigned* bar; unsigned x; volatile unsigned* st; };
__device__ __forceinline__ XcdBarrier xcd_barrier_post(unsigned* bar, volatile unsigned* st) {
    XcdBarrier b; b.bar = bar; b.x = xb_xcc_id(); b.st = st;
    if (threadIdx.x == 0) (void)xb_add(&bar[XB_XCNT(b.x)], 1u);
    return b;
}
__device__ __forceinline__ void xcd_barrier_complete(unsigned* bar, unsigned x, unsigned& nloc, unsigned& nx) {
    const unsigned G = gridDim.x * gridDim.y * gridDim.z;
    unsigned sum, cnt, mine, sp = 0u;
    for (;;) {
        sum = 0u; cnt = 0u; mine = 0u;
#pragma unroll
        for (unsigned j = 0; j < 16; ++j) { const unsigned c = xb_ld(&bar[XB_XCNT(j)]); sum += c; cnt += (c > 0u) ? 1u : 0u; mine = (j == x) ? c : mine; }
        if (sum == G) break;
        __builtin_amdgcn_s_sleep(1);
        if ((++sp & 255u) == 0u) { if (xb_ld(&bar[XB_TMO])) break; if (sp > XB_SPIN_CAP) { atomicAdd(&bar[XB_TMO], 1u); break; } }
    }
    nloc = mine > 0u ? mine : 1u; nx = cnt > 0u ? cnt : 1u;
}
__device__ __forceinline__ void xcd_barrier(const XcdBarrier& b) {
    asm volatile("s_waitcnt vmcnt(0)" ::: "memory");
    __syncthreads();
    if (threadIdx.x == 0) {
        unsigned* bar = b.bar;
        __builtin_amdgcn_s_waitcnt(0);
        unsigned nloc = b.st[0], nx = b.st[1];
        if (nloc == 0u) { xcd_barrier_complete(bar, b.x, nloc, nx); b.st[0] = nloc; b.st[1] = nx; }
        const unsigned old = xb_add(&bar[XB_XSUB(b.x)], 1u);
        const unsigned gen = old / nloc;
        if (old + 1u == (gen + 1u) * nloc) {
            __builtin_amdgcn_fence(__ATOMIC_RELEASE, "agent");
            asm volatile("s_waitcnt vmcnt(0)" ::: "memory");
            const unsigned og = xb_add(&bar[XB_TOP], 1u);
            const unsigned tg = og / nx;
            if (og + 1u == (tg + 1u) * nx) xb_add(&bar[XB_TOPGEN], 1u);
            else XB_SPIN(xb_ld(&bar[XB_TOPGEN]) == tg, bar);
            __builtin_amdgcn_fence(__ATOMIC_ACQUIRE, "agent");
            xb_add(&bar[XB_XGEN(b.x)], 1u);
            asm volatile("s_waitcnt vmcnt(0)" ::: "memory");
        } else {
            XB_SPIN(xb_ld(&bar[XB_XGEN(b.x)]) == gen, bar);
            __builtin_amdgcn_fence(__ATOMIC_ACQUIRE, "agent");
            asm volatile("s_waitcnt vmcnt(0)" ::: "memory");
        }
    }
    __syncthreads();
}

constexpr int NPHASE = 12;
template <int PH>
__device__ __forceinline__ void run_phase(const P& p, unsigned char* lds) {
    const float* mod = (const float*)(p.ws + WS_MOD);
    if constexpr (PH == 0) phase0(p, lds);
    if constexpr (PH == 1) phase_normmod(p, 0);
    if constexpr (PH == 2) { EpiSwiglu E{(bf16_t*)(p.ws + WS_U)}; run_gemm(lds, (const bf16_t*)(p.ws + WS_A), (const bf16_t*)(p.ws + WS_W1), 5632, 1024, E); }
    if constexpr (PH == 3) { EpiResid E{p.xp, p.xs, p.out, mod + 2048, 0.5f, 0}; run_gemm(lds, (const bf16_t*)(p.ws + WS_U), (const bf16_t*)(p.ws + WS_W1B), 1024, 2816, E); }
    if constexpr (PH == 4) phase_normmod(p, 1);
    if constexpr (PH == 5) { EpiU E{(bf16_t*)(p.ws + WS_U), (float*)(p.ws + WS_GATES)}; run_gemm(lds, (const bf16_t*)(p.ws + WS_A), (const bf16_t*)(p.ws + WS_BT3), 4096, 1024, E); }
    if constexpr (PH == 6) phase_scan(p, lds);
    if constexpr (PH == 12) phase_rwkv_finalize(p, lds);
    if constexpr (PH == 13) phase_shift((bf16_t*)(p.ws + WS_U), p.mu, (uint4*)lds);
    if constexpr (PH == 7) { EpiResid E{p.xp, p.xs, p.out, mod + 5120, 1.0f, 1}; run_gemm(lds, (const bf16_t*)(p.ws + WS_A), (const bf16_t*)(p.ws + WS_BT4), 1024, 1024, E); phase_convert_w2(p, lds); }
    if constexpr (PH == 8) phase_normmod(p, 2);
    if constexpr (PH == 9) { EpiSwiglu E{(bf16_t*)(p.ws + WS_U)}; run_gemm(lds, (const bf16_t*)(p.ws + WS_A), (const bf16_t*)(p.ws + WS_W1), 5632, 1024, E); }
    if constexpr (PH == 10) { EpiResid E{p.xp, p.xs, p.out, mod + 8192, 0.5f, 1}; run_gemm(lds, (const bf16_t*)(p.ws + WS_U), (const bf16_t*)(p.ws + WS_W1B), 1024, 2816, E); }
    if constexpr (PH == 11) phase_finalnorm(p);
}

#if !ONE_LAUNCH
template <int PH>
__global__ void __launch_bounds__(NTHR, 2) k_phase(P p) {
    extern __shared__ __attribute__((aligned(16))) unsigned char lds[];
    run_phase<PH>(p, lds);
}
#endif

#if ONE_LAUNCH
__global__ void __launch_bounds__(NTHR, 2) k_mega(P p) {
    extern __shared__ __attribute__((aligned(16))) unsigned char lds[];
    cg::grid_group grid = cg::this_grid();
    volatile unsigned* xst = (volatile unsigned*)(lds + LDS_BYTES - 32);
    if (threadIdx.x == 0) { xst[0] = 0u; xst[1] = 0u; }
    __syncthreads();
    const XcdBarrier xbar = xcd_barrier_post((unsigned*)(p.ws + WS_BAR), xst);
#define GSYNC() xcd_barrier(xbar)
    if (p.ws == nullptr) grid.sync();
    run_phase<0>(p, lds); GSYNC();
    if (PROBE_DUP == 0) { run_phase<0>(p, lds); GSYNC(); }
    run_phase<1>(p, lds); GSYNC();
    if (PROBE_DUP == 1) { run_phase<1>(p, lds); GSYNC(); }
    run_phase<2>(p, lds); GSYNC();
    if (PROBE_DUP == 2 || PROBE_DUP == 235) { run_phase<2>(p, lds); GSYNC(); }
    run_phase<3>(p, lds); GSYNC();
    if (PROBE_DUP == 3 || PROBE_DUP == 235) { run_phase<3>(p, lds); GSYNC(); }
    run_phase<4>(p, lds); GSYNC();
    if (PROBE_DUP == 4) { run_phase<4>(p, lds); GSYNC(); }
    run_phase<5>(p, lds); GSYNC();
    if (PROBE_DUP == 5 || PROBE_DUP == 235) { run_phase<5>(p, lds); GSYNC(); }
    run_phase<13>(p, lds); GSYNC();
    run_phase<6>(p, lds); GSYNC();
    if (PROBE_DUP == 6) { phase_scan(p, lds, 1); GSYNC(); }
    run_phase<12>(p, lds); GSYNC();
    run_phase<7>(p, lds); GSYNC();
    if (PROBE_DUP == 7) { run_phase<7>(p, lds); GSYNC(); }
    run_phase<8>(p, lds); GSYNC();
    if (PROBE_DUP == 8) { run_phase<8>(p, lds); GSYNC(); }
    run_phase<9>(p, lds); GSYNC();
    if (PROBE_DUP == 9) { run_phase<9>(p, lds); GSYNC(); }
    run_phase<10>(p, lds); GSYNC();
    if (PROBE_DUP == 10) { run_phase<10>(p, lds); GSYNC(); }
    run_phase<11>(p, lds);
    if (PROBE_DUP == 200) { for (int i = 0; i < 20; ++i) GSYNC(); }
}
#endif

#if !ONE_LAUNCH
template <int PH> static void launch_phase(const P& p, int grid, hipStream_t stream) {
    static bool attr = false;
    if (!attr) { (void)hipFuncSetAttribute((const void*)k_phase<PH>, hipFuncAttributeMaxDynamicSharedMemorySize, LDS_BYTES); attr = true; }
    hipLaunchKernelGGL(k_phase<PH>, dim3(grid), dim3(NTHR), LDS_BYTES, stream, p);
}
#endif

extern "C" void kernel_launch(void* const* d_in, const int* in_sizes, int n_in, void* d_out, int out_size, void* d_ws, size_t ws_size, hipStream_t stream) {
    (void)in_sizes; (void)n_in; (void)out_size; (void)ws_size;
    static int grid = 0;
    if (grid == 0) {
        int dev = 0, cus = 0;
        if (hipGetDevice(&dev) != hipSuccess || hipDeviceGetAttribute(&cus, hipDeviceAttributeMultiprocessorCount, dev) != hipSuccess || cus <= 0) cus = 256;
#if ONE_LAUNCH
        (void)hipFuncSetAttribute((const void*)k_mega, hipFuncAttributeMaxDynamicSharedMemorySize, LDS_BYTES);
        int per_cu = 0;
        if (hipOccupancyMaxActiveBlocksPerMultiprocessor(&per_cu, (const void*)k_mega, NTHR, LDS_BYTES) != hipSuccess || per_cu < 1) per_cu = 1;
        (void)hipGetLastError();
#endif
        grid = cus;
    }
    P p{};
    const float** f = (const float**)&p;
    for (int i = 0; i < 35; ++i) f[i] = (const float*)d_in[i];
    p.out = (float*)d_out; p.ws = (unsigned char*)d_ws;
    (void)hipMemsetAsync((char*)d_ws + WS_MOD, 0, NCOND * MODW * sizeof(float) + 256 + 3456 * 4, stream);
#if ONE_LAUNCH
    void* args[] = {&p};
    hipError_t e = hipLaunchCooperativeKernel((const void*)k_mega, dim3(grid), dim3(NTHR), args, LDS_BYTES, stream);
    if (e != hipSuccess) fprintf(stderr, "cooperative launch failed: %s (grid %d)\n", hipGetErrorString(e), grid);
#else
    launch_phase<0>(p, grid, stream); launch_phase<1>(p, grid, stream); launch_phase<2>(p, grid, stream); launch_phase<3>(p, grid, stream);
    launch_phase<4>(p, grid, stream); launch_phase<5>(p, grid, stream); launch_phase<13>(p, grid, stream); launch_phase<6>(p, grid, stream); launch_phase<12>(p, grid, stream); launch_phase<7>(p, grid, stream);
    launch_phase<8>(p, grid, stream); launch_phase<9>(p, grid, stream); launch_phase<10>(p, grid, stream); launch_phase<11>(p, grid, stream);
#endif
}
```

```cpp
#include <hip/hip_runtime.h>
#include <hip/hip_cooperative_groups.h>
#include <cstdio>
#include <cstdint>
namespace cg = cooperative_groups;

#ifndef PROBE_DUP
#define PROBE_DUP -1
#endif
#ifndef ONE_LAUNCH
#define ONE_LAUNCH 1
#endif

#define LDS_BARRIER() do { asm volatile("s_waitcnt lgkmcnt(0)" ::: "memory"); __builtin_amdgcn_s_barrier(); asm volatile("" ::: "memory"); } while (0)
__device__ __forceinline__ int opaque_tid() { int z = 0; asm volatile("" : "+v"(z)); return (int)threadIdx.x + z; }

namespace pg8 {
#define PG8_LAS __attribute__((address_space(3)))
typedef unsigned short bf16_t;
typedef short bf16x8 __attribute__((ext_vector_type(8)));
typedef float f32x4 __attribute__((ext_vector_type(4)));
typedef unsigned u32x4 __attribute__((ext_vector_type(4)));
constexpr int BM = 256, BK = 64, HALF = 128, HTB = HALF * BK * 2, STAGE_BYTES = 8 * HTB, NXCD = 8, WGM = 8;

__host__ __device__ __forceinline__ int lds_byte(int r, int c) { const int st = (r >> 4) * 2 + (c >> 5), rr = r & 15, cc = c & 31, ob = rr * 64 + cc * 2; return st * 1024 + (ob ^ (((ob >> 9) & 1) << 5)); }
__host__ __device__ __forceinline__ void stage_rc(int b, int& R, int& C) { const int st = b / 1024, sb = b % 1024, swz = sb ^ (((sb >> 9) & 1) << 5); R = (st >> 1) * 16 + swz / 64; C = (st & 1) * 32 + (swz % 64) / 2; }
__host__ __device__ __forceinline__ int perm32(int rho) { const int n = rho >> 4, i = rho & 15; return 8 * (i >> 2) + 4 * n + (i & 3); }

struct Unit { int pm, pn; };
struct Gemm { const bf16_t* A; const bf16_t* Bt; int M, N, K; };

struct StaticOrder {
    int nM, nN, nwg, G, c;
    __host__ __device__ void init(int M, int N, int G_, int c_) { nM = M / BM; nN = N / BM; nwg = nM * nN; G = G_; c = c_; }
    __host__ __device__ bool next(int i, Unit& u) const {
        const long L = (long)i * G + c; if (L >= nwg) return false;
        int wgid = (int)L; { const int q = nwg / NXCD, r = nwg % NXCD, xcd = wgid % NXCD, off = wgid / NXCD; wgid = (xcd < r ? xcd * (q + 1) : r * (q + 1) + (xcd - r) * q) + off; }
        const int nig = WGM * nN, gid = wgid / nig, fm = gid * WGM, gsz = (nM - fm) < WGM ? (nM - fm) : WGM;
        u.pm = fm + ((wgid % nig) % gsz); u.pn = (wgid % nig) / gsz; return true;
    }
    __device__ __forceinline__ void a_ready(const Unit&) const {}
    __device__ __forceinline__ void done(const Unit&) const {}
};

__device__ __forceinline__ unsigned cvt_pk_bf16(float lo, float hi) { unsigned r; asm volatile("v_cvt_pk_bf16_f32 %0, %1, %2" : "=v"(r) : "v"(lo), "v"(hi)); return r; }

template <class Epi, class Sched, bool ALIGN_EPI = false, bool SP2 = false>
__device__ __forceinline__ void gemm_phase(PG8_LAS unsigned char* lds, const Gemm g, const Sched& S, const Epi& E) {
    const int tid = opaque_tid(), wid = __builtin_amdgcn_readfirstlane((int)threadIdx.x >> 6), lane = tid & 63, wr = wid >> 2, wc = wid & 3, fr = lane & 15, fq = lane >> 4;
    const int K = g.K, nt = K / BK;
    unsigned voffA[2], voffB[2];
#pragma unroll
    for (int i = 0; i < 2; ++i) { int R, C; stage_rc(tid * 16 + i * 8192, R, C); const int Rb = Epi::PERM ? ((R & ~31) + perm32(R & 31)) : R;
        voffA[i] = (unsigned)(R * K + C) * 2u; voffB[i] = (unsigned)(Rb * K + C) * 2u; }
    const size_t kstep = (size_t)(BK * 2);
    const size_t hstep = (size_t)HALF * K * 2;
    const size_t tstep = 2 * hstep;
    const unsigned ldsw = (unsigned)wid * 1024u;
    const int aoff = lds_byte(wr * 64 + fr, fq * 8), boff = lds_byte(wc * 32 + fr, fq * 8);
#define PG8_SA(b, h) (((b) * 2 + (h)) * HTB)
#define PG8_SB(b, h) ((4 + (b) * 2 + (h)) * HTB)
#define PG8_STAGE(bufoff, gbase, voff) do { _Pragma("unroll") for (int _i = 0; _i < 2; ++_i) \
        __builtin_amdgcn_global_load_lds((const unsigned*)((const char*)(gbase) + (voff)[_i]), (PG8_LAS unsigned*)(lds + (bufoff) + ldsw + _i * 8192), 16, 0, 0); } while (0)
#define PG8_LDA(dst, b, h) do { _Pragma("unroll") for (int m = 0; m < 4; ++m) _Pragma("unroll") for (int k = 0; k < 2; ++k) dst[m][k] = *(const PG8_LAS bf16x8*)(lds + PG8_SA(b, h) + aoff + m * 2048 + k * 1024); } while (0)
#define PG8_LDB(dst, b, h) do { _Pragma("unroll") for (int n = 0; n < 2; ++n) _Pragma("unroll") for (int k = 0; k < 2; ++k) dst[n][k] = *(const PG8_LAS bf16x8*)(lds + PG8_SB(b, h) + boff + n * 2048 + k * 1024); } while (0)
#define PG8_MMA(ai, bj, At, Bt) do { __builtin_amdgcn_s_setprio(1); _Pragma("unroll") for (int m = 0; m < 4; ++m) _Pragma("unroll") for (int n = 0; n < 2; ++n) _Pragma("unroll") for (int k = 0; k < 2; ++k) \
        acc[ai][bj][m][n] = __builtin_amdgcn_mfma_f32_16x16x32_bf16(Bt[n][k], At[m][k], acc[ai][bj][m][n], 0, 0, 0); __builtin_amdgcn_s_setprio(0); } while (0)
#define PG8_WAIT_V(n) asm volatile("s_waitcnt vmcnt(" #n ")" ::: "memory")
#define PG8_WAIT_L(n) asm volatile("s_waitcnt lgkmcnt(" #n ")" ::: "memory")
#define PG8_BAR __builtin_amdgcn_s_barrier()
#define PG8_SCHED __builtin_amdgcn_sched_barrier(0)
    Unit cur, nxt; int ui = 0;
    if (!S.next(0, cur)) return;
    f32x4 acc[2][2][4][2];
#pragma unroll
    for (int a = 0; a < 2; ++a)
#pragma unroll
        for (int b = 0; b < 2; ++b)
#pragma unroll
            for (int m = 0; m < 4; ++m)
#pragma unroll
                for (int n = 0; n < 2; ++n) acc[a][b][m][n] = (f32x4){0.f, 0.f, 0.f, 0.f};
    bf16x8 At[4][2], B0[2][2], B1[2][2];
    const char* cA = (const char*)g.A + (size_t)cur.pm * tstep; const char* cB = (const char*)g.Bt + (size_t)cur.pn * tstep;
    S.a_ready(cur);
    if constexpr (SP2) {
        PG8_STAGE(PG8_SB(0, 0), cB, voffB); PG8_STAGE(PG8_SB(0, 1), cB + hstep, voffB); PG8_STAGE(PG8_SA(0, 0), cA, voffA); PG8_STAGE(PG8_SA(0, 1), cA + hstep, voffA);
        if (wr == 1) PG8_BAR;
        PG8_WAIT_V(2); PG8_BAR;
        PG8_STAGE(PG8_SB(1, 0), cB + kstep, voffB); PG8_STAGE(PG8_SA(1, 0), cA + kstep, voffA); PG8_STAGE(PG8_SB(1, 1), cB + hstep + kstep, voffB);
        PG8_WAIT_V(6); PG8_BAR;
    } else {
        PG8_STAGE(PG8_SB(0, 0), cB, voffB); PG8_STAGE(PG8_SA(0, 0), cA, voffA); PG8_STAGE(PG8_SB(0, 1), cB + hstep, voffB); PG8_STAGE(PG8_SA(0, 1), cA + hstep, voffA);
        if (wr == 1) PG8_BAR;
        PG8_WAIT_V(4); PG8_BAR;
        PG8_STAGE(PG8_SB(1, 0), cB + kstep, voffB); PG8_STAGE(PG8_SA(1, 0), cA + kstep, voffA); PG8_STAGE(PG8_SB(1, 1), cB + hstep + kstep, voffB);
        PG8_WAIT_V(6); PG8_BAR;
    }
    for (;;) {
        const bool has_next = S.next(ui + 1, nxt);
        const char* nA = has_next ? (const char*)g.A + (size_t)nxt.pm * tstep : cA; const char* nB = has_next ? (const char*)g.Bt + (size_t)nxt.pn * tstep : cB;
        for (int t = 0; t < nt; t += 2) {
            const bool last = (t == nt - 2);
            const char* a1 = cA + (size_t)(t + 1) * kstep;
            const char* a2 = last ? nA : cA + (size_t)(t + 2) * kstep; const char* b2 = last ? nB : cB + (size_t)(t + 2) * kstep;
            const char* a3 = a2 + kstep; const char* b3 = b2 + kstep;
            if (last && has_next) S.a_ready(nxt);
            if constexpr (SP2) {
            PG8_LDB(B0, 0, 0); PG8_LDB(B1, 0, 1); PG8_SCHED; PG8_LDA(At, 0, 0); PG8_STAGE(PG8_SA(1, 1), a1 + hstep, voffA);
            PG8_WAIT_V(8); PG8_WAIT_L(0); PG8_BAR; PG8_MMA(0, 0, At, B0); PG8_MMA(0, 1, At, B1); PG8_BAR; PG8_SCHED;
            PG8_LDA(At, 0, 1); PG8_STAGE(PG8_SB(0, 0), b2, voffB); PG8_STAGE(PG8_SB(0, 1), b2 + hstep, voffB); PG8_STAGE(PG8_SA(0, 0), a2, voffA);
            PG8_WAIT_V(8); PG8_WAIT_L(0); PG8_BAR; PG8_MMA(1, 0, At, B0); PG8_MMA(1, 1, At, B1); PG8_BAR; PG8_SCHED;
            PG8_LDB(B0, 1, 0); PG8_LDB(B1, 1, 1); PG8_SCHED; PG8_LDA(At, 1, 0); PG8_STAGE(PG8_SA(0, 1), a2 + hstep, voffA);
            PG8_WAIT_V(8); PG8_WAIT_L(0); PG8_BAR; PG8_MMA(0, 0, At, B0); PG8_MMA(0, 1, At, B1); PG8_BAR; PG8_SCHED;
            PG8_LDA(At, 1, 1); PG8_STAGE(PG8_SB(1, 0), b3, voffB); PG8_STAGE(PG8_SB(1, 1), b3 + hstep, voffB); PG8_STAGE(PG8_SA(1, 0), a3, voffA);
            PG8_WAIT_V(8); PG8_WAIT_L(0); PG8_BAR; PG8_MMA(1, 0, At, B0); PG8_MMA(1, 1, At, B1); PG8_BAR; PG8_SCHED;
            } else {
            PG8_LDB(B0, 0, 0); PG8_SCHED; PG8_LDA(At, 0, 0); PG8_STAGE(PG8_SA(1, 1), a1 + hstep, voffA);
            PG8_WAIT_L(8); PG8_BAR; PG8_WAIT_L(0); PG8_MMA(0, 0, At, B0); PG8_BAR; PG8_SCHED;
            PG8_LDB(B1, 0, 1); PG8_STAGE(PG8_SB(0, 0), b2, voffB);
            PG8_BAR; PG8_WAIT_L(0); PG8_MMA(0, 1, At, B1); PG8_BAR;
            PG8_LDA(At, 0, 1); PG8_STAGE(PG8_SA(0, 0), a2, voffA);
            PG8_BAR; PG8_WAIT_L(0); PG8_MMA(1, 0, At, B0); PG8_BAR; PG8_SCHED;
            PG8_STAGE(PG8_SB(0, 1), b2 + hstep, voffB);
            PG8_WAIT_V(6); PG8_BAR; PG8_MMA(1, 1, At, B1); PG8_BAR;
            PG8_LDB(B0, 1, 0); PG8_SCHED; PG8_LDA(At, 1, 0); PG8_STAGE(PG8_SA(0, 1), a2 + hstep, voffA);
            PG8_WAIT_L(8); PG8_BAR; PG8_WAIT_L(0); PG8_MMA(0, 0, At, B0); PG8_BAR; PG8_SCHED;
            PG8_LDB(B1, 1, 1); PG8_STAGE(PG8_SB(1, 0), b3, voffB);
            PG8_BAR; PG8_WAIT_L(0); PG8_MMA(0, 1, At, B1); PG8_BAR;
            PG8_LDA(At, 1, 1); PG8_STAGE(PG8_SA(1, 0), a3, voffA);
            PG8_BAR; PG8_WAIT_L(0); PG8_MMA(1, 0, At, B0); PG8_BAR; PG8_SCHED;
            PG8_STAGE(PG8_SB(1, 1), b3 + hstep, voffB);
            PG8_WAIT_V(6); PG8_BAR; PG8_MMA(1, 1, At, B1); PG8_BAR;
            }
        }
        if constexpr (ALIGN_EPI) { if (wr == 0) PG8_BAR; }
        E(acc, cur, wr, wc, fr, fq); S.done(cur);
        if (!has_next) break;
#pragma unroll
        for (int a = 0; a < 2; ++a)
#pragma unroll
            for (int b = 0; b < 2; ++b)
#pragma unroll
                for (int m = 0; m < 4; ++m)
#pragma unroll
                    for (int n = 0; n < 2; ++n) acc[a][b][m][n] = (f32x4){0.f, 0.f, 0.f, 0.f};
        cur = nxt; cA = nA; cB = nB; ++ui;
        if constexpr (ALIGN_EPI) { if (wr == 1) PG8_BAR; }
    }
    PG8_WAIT_V(0);
    if constexpr (!ALIGN_EPI) { if (wr == 0) PG8_BAR; }
    PG8_BAR;
#undef PG8_SA
#undef PG8_SB
#undef PG8_STAGE
#undef PG8_LDA
#undef PG8_LDB
#undef PG8_MMA
#undef PG8_WAIT_V
#undef PG8_WAIT_L
#undef PG8_BAR
#undef PG8_SCHED
}
}

using pg8::bf16_t; using pg8::bf16x8; using pg8::f32x4;

constexpr int MT = 24576, DM = 1024, DFF = 2816, NCTX = 8192;
constexpr int UW = 3984;
constexpr int NCOND = 9, MODW = 9216;
constexpr size_t MiB = 1ull << 20;
constexpr size_t WS_A = 0, WS_U = 48 * MiB, WS_W1 = WS_U + 132 * MiB, WS_W1B = WS_W1 + (size_t)5632 * 1024 * 2,
                 WS_BT3 = 235 * MiB, WS_HB2 = 235 * MiB  ,
                 WS_BT4 = 251 * MiB, WS_MOD = 253 * MiB, WS_CTR = WS_MOD + 9 * 9216 * 4  , WS_BAR = WS_CTR + 256  , WS_GATES = 254 * MiB;
constexpr size_t WS_A2BF = 255 * MiB + 512 * 1024, WS_G2BF = WS_A2BF + 2 * 512 * 64 * 2;
constexpr int OUT_C = 25165824, OUT_N = 29360128, OUT_MM = 29392896, OUT_S = 29393152;
constexpr int LDS_BYTES = 163840;
constexpr int NTHR = 512;

struct P {
    const float *xp, *xs, *c, *sC, *sn, *sm, *sS, *cctx, *ada_w, *ada_b, *n1, *w1in, *w1out, *nmix, *wmin, *wmout,
        *cw, *cb, *gb, *hg, *mu, *w0, *w2, *a0, *a2, *g2, *kk, *ka, *rk, *lng, *lnb, *n2, *w2in, *w2out, *nf;
    float* out; unsigned char* ws;
};

typedef __bf16 hwbf16x2 __attribute__((ext_vector_type(2)));
typedef float hwf32x2 __attribute__((ext_vector_type(2)));
__device__ __forceinline__ unsigned pk2(float a, float b) { const hwf32x2 v = {a, b}; const hwbf16x2 r = __builtin_convertvector(v, hwbf16x2); return __builtin_bit_cast(unsigned, r); }
__device__ __forceinline__ unsigned short f2bf(float f) { return (unsigned short)(pk2(f, f) & 0xffffu); }
__device__ __forceinline__ float bf2f(unsigned short b) { return __uint_as_float(((unsigned)b) << 16); }
__device__ __forceinline__ int cond_of(int row) { return row < NCTX ? 0 : 1 + ((row - NCTX) >> 11); }
__device__ __forceinline__ float fexp(float x) { return __builtin_amdgcn_exp2f(x * 1.4426950408889634f); }
__device__ __forceinline__ float flog(float x) { return __builtin_amdgcn_logf(x) * 0.6931471805599453f; }
__device__ __forceinline__ float siluf(float x) { return x * __builtin_amdgcn_rcpf(1.f + fexp(-x)); }
__device__ __forceinline__ float sigmf(float x) { return __builtin_amdgcn_rcpf(1.f + fexp(-x)); }
__device__ __forceinline__ float tanh_fast(float x) { return 1.f - 2.f * __builtin_amdgcn_rcpf(1.f + fexp(2.f * x)); }
__device__ __forceinline__ float softplus_fast(float z) { return fmaxf(z, 0.f) + flog(1.f + fexp(-fabsf(z))); }
__device__ __forceinline__ const float* xrow(const P& p, int row) { return row < NCTX ? p.xp + (size_t)row * DM : p.xs + (size_t)(row - NCTX) * DM; }
__device__ __forceinline__ f32x4 mfma16(bf16x8 a, bf16x8 b, f32x4 c) { return __builtin_amdgcn_mfma_f32_16x16x32_bf16(a, b, c, 0, 0, 0); }
__device__ __forceinline__ void unpack8(uint4 v, float* f) {
    f[0] = __uint_as_float(v.x << 16); f[1] = __uint_as_float(v.x & 0xffff0000u); f[2] = __uint_as_float(v.y << 16); f[3] = __uint_as_float(v.y & 0xffff0000u);
    f[4] = __uint_as_float(v.z << 16); f[5] = __uint_as_float(v.z & 0xffff0000u); f[6] = __uint_as_float(v.w << 16); f[7] = __uint_as_float(v.w & 0xffff0000u);
}

__device__ __forceinline__ int colmap(int kind, int n) {
    if (kind == 0) return n;
    if (kind == 1) { const int t = n >> 8, bj = (n >> 7) & 1, c = n & 127; return bj * DFF + t * 128 + c; }
    if (n < 2048) return n; if (n < 3968) return n + 16; if (n < 3984) return n - 3968 + 2048; return -1;
}
__device__ void convert_tile(const float* __restrict__ src, bf16_t* __restrict__ dst, int K, int Nsrc, int kind, int k0, int n0, float* tile) {
    const int tid = opaque_tid();
    { const int n = tid & 63, kr = tid >> 6; const int sc = colmap(kind, n0 + n);
#pragma unroll
      for (int i = 0; i < 8; ++i) { const int k = kr + 8 * i; tile[k * 65 + n] = sc >= 0 ? src[(size_t)(k0 + k) * Nsrc + sc] : 0.f; } }
    __syncthreads();
    { const int nn = tid >> 3, kg = tid & 7; unsigned w[4];
#pragma unroll
      for (int j = 0; j < 4; ++j) w[j] = pk2(tile[(kg * 8 + 2 * j) * 65 + nn], tile[(kg * 8 + 2 * j + 1) * 65 + nn]);
      *(uint4*)(dst + (size_t)(n0 + nn) * K + k0 + kg * 8) = make_uint4(w[0], w[1], w[2], w[3]); }
    __syncthreads();
}
__device__ void convert_jobs(const P& p, int first, int njobs_sel, unsigned char* lds, int item0, int nitems_before) {}

__device__ void do_convert(const float* src, bf16_t* dst, int K, int Nsrc, int Ndst, int kind, int t, float* tile) {
    const int nkt = K / 64; const int kt = t % nkt, ntile = t / nkt; (void)Ndst;
    convert_tile(src, dst, K, Nsrc, kind, kt * 64, ntile * 64, tile);
}

__device__ void phase0(const P& p, unsigned char* lds) {
    float* tile = (float*)lds;
    const int tid = opaque_tid();
    const int n_ada = 36 * 8;
    const int t1 = 16 * 88, t2 = 44 * 16, t3 = 16 * 64, t4 = 16 * 16, t5 = 8, t6 = 8, t7 = 16;
    const int total = n_ada + t1 + t2 + t3 + t4 + t5 + t6 + t7;
    for (int it = blockIdx.x; it < total; it += gridDim.x) {
        if (it < n_ada) {
            const int cgp = it % 36, kc = it / 36;
            float* sc = tile;
            __syncthreads();
            for (int i = tid; i < NCOND * 128; i += NTHR) { const int c = i >> 7, k = i & 127; const float v = c == 0 ? p.cctx[kc * 128 + k] : p.c[(c - 1) * DM + kc * 128 + k]; sc[i] = siluf(v); }
            __syncthreads();
            const int col = cgp * 256 + (tid & 255), kh = tid >> 8;
            float acc[NCOND];
#pragma unroll
            for (int c = 0; c < NCOND; ++c) acc[c] = 0.f;
            const float* w = p.ada_w + (size_t)(kc * 128 + kh * 64) * MODW + col;
#pragma unroll 4
            for (int k = 0; k < 64; ++k) { const float wv = w[(size_t)k * MODW];
#pragma unroll
                for (int c = 0; c < NCOND; ++c) acc[c] += sc[c * 128 + kh * 64 + k] * wv; }
            float* mod = (float*)(p.ws + WS_MOD);
            const float bias = (kc == 0 && kh == 0) ? p.ada_b[col] : 0.f;
#pragma unroll
            for (int c = 0; c < NCOND; ++c) atomicAdd(mod + c * MODW + col, acc[c] + bias);
            __syncthreads();
        } else {
            int t = it - n_ada;
            if (t < t1) do_convert(p.w1in, (bf16_t*)(p.ws + WS_W1), 1024, 5632, 5632, 1, t, tile);
            else if ((t -= t1) < t2) do_convert(p.w1out, (bf16_t*)(p.ws + WS_W1B), 2816, 1024, 1024, 0, t, tile);
            else if ((t -= t2) < t3) do_convert(p.wmin, (bf16_t*)(p.ws + WS_BT3), 1024, 3984, 4096, 2, t, tile);
            else if ((t -= t3) < t4) do_convert(p.wmout, (bf16_t*)(p.ws + WS_BT4), 1024, 1024, 1024, 0, t, tile);
            else if ((t -= t4) < t5) do_convert(p.a2, (bf16_t*)(p.ws + WS_A2BF), 64, 512, 512, 0, t, tile);
            else if ((t -= t5) < t6) do_convert(p.a2 + 64 * 512, (bf16_t*)(p.ws + WS_A2BF) + 512 * 64, 64, 512, 512, 0, t, tile);
            else { t -= t6; do_convert(p.g2, (bf16_t*)(p.ws + WS_G2BF), 128, 512, 512, 0, t, tile); }
        }
    }
}

__device__ void phase_normmod(const P& p, int which) {
    const int lane = opaque_tid() & 63, wave = threadIdx.x >> 6;
    const float* gain = which == 0 ? p.n1 : (which == 1 ? p.nmix : p.n2);
    const float* mod = (const float*)(p.ws + WS_MOD);
    bf16_t* A = (bf16_t*)(p.ws + WS_A);
    for (int row = blockIdx.x * 8 + wave; row < MT; row += gridDim.x * 8) {
        const float* src = which == 0 ? xrow(p, row) : p.out + (size_t)row * DM;
        float4 v[4]; float ss = 0.f;
#pragma unroll
        for (int i = 0; i < 4; ++i) { v[i] = *(const float4*)(src + lane * 4 + 256 * i); ss += v[i].x * v[i].x + v[i].y * v[i].y + v[i].z * v[i].z + v[i].w * v[i].w; }
#pragma unroll
        for (int o = 32; o >= 1; o >>= 1) ss += __shfl_xor(ss, o);
        const float rstd = rsqrtf(ss * (1.f / 1024.f) + 1e-6f);
        const float* sh = mod + cond_of(row) * MODW + which * 3072; const float* sc = sh + 1024;
#pragma unroll
        for (int i = 0; i < 4; ++i) { const int col = lane * 4 + 256 * i;
            const float4 g = *(const float4*)(gain + col), s4 = *(const float4*)(sh + col), c4 = *(const float4*)(sc + col);
            const float o0 = v[i].x * rstd * g.x * (1.f + c4.x) + s4.x, o1 = v[i].y * rstd * g.y * (1.f + c4.y) + s4.y,
                        o2 = v[i].z * rstd * g.z * (1.f + c4.z) + s4.z, o3 = v[i].w * rstd * g.w * (1.f + c4.w) + s4.w;
            *(uint2*)(A + (size_t)row * DM + col) = make_uint2(pk2(o0, o1), pk2(o2, o3)); }
    }
}
__device__ void phase_finalnorm(const P& p) {
    const int lane = opaque_tid() & 63, wave = threadIdx.x >> 6;
    for (int row = blockIdx.x * 8 + wave; row < MT; row += gridDim.x * 8) {
        float* src = p.out + (size_t)row * DM;
        float4 v[4]; float ss = 0.f;
#pragma unroll
        for (int i = 0; i < 4; ++i) { v[i] = *(const float4*)(src + lane * 4 + 256 * i); ss += v[i].x * v[i].x + v[i].y * v[i].y + v[i].z * v[i].z + v[i].w * v[i].w; }
#pragma unroll
        for (int o = 32; o >= 1; o >>= 1) ss += __shfl_xor(ss, o);
        const float rstd = rsqrtf(ss * (1.f / 1024.f) + 1e-6f);
#pragma unroll
        for (int i = 0; i < 4; ++i) { const int col = lane * 4 + 256 * i; const float4 g = *(const float4*)(p.nf + col);
            *(float4*)(src + col) = make_float4(v[i].x * rstd * g.x, v[i].y * rstd * g.y, v[i].z * rstd * g.z, v[i].w * rstd * g.w); }
    }
}

struct EpiSwiglu {
    static constexpr bool PERM = true;
    bf16_t* O;
    __device__ __forceinline__ void operator()(const f32x4 (&acc)[2][2][4][2], const pg8::Unit& u, int wr, int wc, int fr, int fq) const {
        const int row0 = u.pm * 256 + wr * 64 + fr, col0 = u.pn * 128 + wc * 32 + 8 * fq;
#pragma unroll
        for (int ai = 0; ai < 2; ++ai)
#pragma unroll
            for (int m = 0; m < 4; ++m) { bf16_t* rowp = O + (size_t)(row0 + ai * 128 + m * 16) * DFF + col0;
                float r[8];
#pragma unroll
                for (int n = 0; n < 2; ++n)
#pragma unroll
                    for (int j = 0; j < 4; ++j) r[n * 4 + j] = siluf(acc[ai][0][m][n][j]) * acc[ai][1][m][n][j];
                pg8::u32x4 w; w.x = pg8::cvt_pk_bf16(r[0], r[1]); w.y = pg8::cvt_pk_bf16(r[2], r[3]); w.z = pg8::cvt_pk_bf16(r[4], r[5]); w.w = pg8::cvt_pk_bf16(r[6], r[7]);
                *(pg8::u32x4*)rowp = w; }
    }
};
struct EpiResid {
    static constexpr bool PERM = false;
    const float* xp; const float* xs; float* out; const float* ga; float coef; int inplace;
    __device__ __forceinline__ void operator()(const f32x4 (&acc)[2][2][4][2], const pg8::Unit& u, int wr, int wc, int fr, int fq) const {
        const int row0 = u.pm * 256 + wr * 64 + fr, col0 = u.pn * 256 + wc * 32 + 4 * fq;
        const float* gap = ga + cond_of(u.pm * 256) * MODW;
        f32x4 gv[2][2];
#pragma unroll
        for (int bj = 0; bj < 2; ++bj)
#pragma unroll
            for (int n = 0; n < 2; ++n) gv[bj][n] = *(const f32x4*)(gap + col0 + bj * 128 + n * 16) * coef;
#pragma unroll
        for (int ai = 0; ai < 2; ++ai)
#pragma unroll
            for (int m = 0; m < 4; ++m) { const int row = row0 + ai * 128 + m * 16;
                const float* base = inplace ? out + (size_t)row * DM : (row < NCTX ? xp + (size_t)row * DM : xs + (size_t)(row - NCTX) * DM);
                float* op = out + (size_t)row * DM;
#pragma unroll
                for (int bj = 0; bj < 2; ++bj)
#pragma unroll
                    for (int n = 0; n < 2; ++n) { const int c = col0 + bj * 128 + n * 16; const f32x4 b4 = *(const f32x4*)(base + c);
                        *(f32x4*)(op + c) = b4 + gv[bj][n] * acc[ai][bj][m][n]; } }
    }
};
struct EpiU {
    static constexpr bool PERM = true;
    bf16_t* U; float* gates;
    __device__ __forceinline__ void operator()(const f32x4 (&acc)[2][2][4][2], const pg8::Unit& u, int wr, int wc, int fr, int fq) const {
        const int row0 = u.pm * 256 + wr * 64 + fr;
#pragma unroll
        for (int bj = 0; bj < 2; ++bj) { const int col0 = u.pn * 256 + bj * 128 + wc * 32 + 8 * fq;
            if (col0 < UW) {
#pragma unroll
                for (int ai = 0; ai < 2; ++ai)
#pragma unroll
                    for (int m = 0; m < 4; ++m) { const int row = row0 + ai * 128 + m * 16; const f32x4 v0 = acc[ai][bj][m][0], v1 = acc[ai][bj][m][1];
                        pg8::u32x4 w; w.x = pg8::cvt_pk_bf16(v0[0], v0[1]); w.y = pg8::cvt_pk_bf16(v0[2], v0[3]); w.z = pg8::cvt_pk_bf16(v1[0], v1[1]); w.w = pg8::cvt_pk_bf16(v1[2], v1[3]);
                        *(pg8::u32x4*)(U + (size_t)row * UW + col0) = w;
                        if (col0 >= 3968) { float* gp = gates + (size_t)row * 16 + (col0 - 3968); *(f32x4*)gp = v0; *(f32x4*)(gp + 4) = v1; } } } }
    }
};

template <class Epi>
__device__ __forceinline__ void run_gemm(unsigned char* lds, const bf16_t* A, const bf16_t* Bt, int N, int K, const Epi& E) {
    pg8::Gemm g{A, Bt, MT, N, K}; pg8::StaticOrder S; S.init(MT, N, (int)gridDim.x, (int)blockIdx.x);
    pg8::gemm_phase<Epi, pg8::StaticOrder, true, true>((PG8_LAS unsigned char*)lds, g, S, E);
}

constexpr int ML_SK = 0, ML_KWT = 17408, ML_VT = ML_KWT + 18432, ML_CB = ML_VT + 20736, ML_F = ML_CB + 21760, ML_CW = ML_F + 2048, ML_END = ML_CW + 4096;
static_assert(ML_END <= LDS_BYTES, "mlstm lds");

__device__ __forceinline__ unsigned short ld_u16_agent(const bf16_t* p) { return __hip_atomic_load(p, __ATOMIC_RELAXED, __HIP_MEMORY_SCOPE_AGENT); }

__device__ __forceinline__ void conv3_row8(const bf16_t* up, bool hasp, bool hasn, const float* cwp, float* x) {
    float t[8];
    unpack8(*(const uint4*)up, t);
#pragma unroll
    for (int i = 0; i < 8; ++i) x[i] = cwp[768 + i] + cwp[256 + i] * t[i];
    if (hasp) { unpack8(*(const uint4*)(up - UW), t);
#pragma unroll
        for (int i = 0; i < 8; ++i) x[i] += cwp[i] * t[i]; }
    if (hasn) { unpack8(*(const uint4*)(up + UW), t);
#pragma unroll
        for (int i = 0; i < 8; ++i) x[i] += cwp[512 + i] * t[i]; }
}

__device__ __forceinline__ void mlstm_task(const P& p, unsigned char* lds, int bg, int h, int dsel) {
    const int wv = __builtin_amdgcn_readfirstlane((int)threadIdx.x >> 6), rw = wv & 3, cw = wv >> 2;
    const bool ctx = bg < 32; const int T = ctx ? 256 : 2048, nc = T / 64; const int row0 = ctx ? bg * 256 : NCTX + (bg - 32) * 2048;
    bf16_t* sK = (bf16_t*)(lds + ML_SK); bf16_t* sKwT = (bf16_t*)(lds + ML_KWT); bf16_t* sVT = (bf16_t*)(lds + ML_VT); bf16_t* sCb = (bf16_t*)(lds + ML_CB); bf16_t* sS = sCb;
    float* sA = (float*)(lds + ML_F); float* sM = sA + 64; float* sBb = sM + 64; float* sDen = sBb + 64; float* sScal = sDen + 64; float* sRed = sScal + 16;
    float* sCW = (float*)(lds + ML_CW);
    const bf16_t* U = (const bf16_t*)(p.ws + WS_U); const float* GATES = (const float*)(p.ws + WS_GATES); bf16_t* HB = (bf16_t*)(p.ws + WS_A); bf16_t* HB2 = (bf16_t*)(p.ws + WS_HB2);
    const int d_lo = dsel < 0 ? 0 : dsel, d_hi = dsel < 0 ? 2 : dsel + 1;
    const int ct_a = cw ? 3 : 0;
    const int ct_b = cw ? 7 : 5;
    const int n_a = cw ? 2 : 3;

    __syncthreads();
    { const int tid = threadIdx.x;
      for (int i = tid; i < 1024; i += NTHR) { const int a = i >> 8, cc = i & 255, gch = (cc >> 7) * 512 + h * 128 + (cc & 127); sCW[i] = a < 3 ? p.cw[a * 1024 + gch] : p.cb[gch]; }
      for (int i = tid; i < 16 * 72; i += NTHR) { const int r = 128 + i / 72; sVT[r * 72 + (i % 72)] = (r == 128) ? (bf16_t)0x3F80 : (bf16_t)0; } }

#pragma unroll 1
    for (int dir = d_lo; dir < d_hi; ++dir) {
        f32x4 Cacc[9]; float m_prev = 0.f;
        { int z0 = 0; asm volatile("" : "+v"(z0)); const int tid = (int)threadIdx.x + z0, fr = tid & 15, fq = (tid >> 4) & 3;
#pragma unroll
          for (int ct = 0; ct < 9; ++ct) Cacc[ct] = (f32x4){0.f, 0.f, 0.f, 0.f};
          if (!ctx) { const int sidx = ((bg - 32) * 2 + dir) * 4 + h; const float* C0 = p.sC + (size_t)sidx * 16384; const float* n0 = p.sn + (size_t)sidx * 128;
#pragma unroll
              for (int j = 0; j < 4; ++j) { const int d = 16 * wv + 4 * fq + j;
#pragma unroll
                  for (int ct = 0; ct < 8; ++ct) Cacc[ct][j] = C0[d * 128 + 16 * ct + fr];
                  Cacc[8][j] = fr == 0 ? n0[d] : 0.f; }
              m_prev = p.sm[sidx]; } }
        const float gbi = p.gb[dir * 4 + h], gbf = p.gb[8 + dir * 4 + h];
        const bool second = dsel < 0 && dir == 1;
#pragma unroll 1
        for (int s = 0; s < nc; ++s) {
            const int c = dir ? nc - 1 - s : s;
            int zz = 0; asm volatile("" : "+v"(zz));
            const int tid = (int)threadIdx.x + zz, lane = tid & 63, fr = tid & 15, fq = (tid >> 4) & 3;
            uint4 kc[2], kp[2], kn[2], vv[2];
#pragma unroll
            for (int g = 0; g < 2; ++g) { const int idx = tid + 512 * g, sl = idx >> 4, d0 = (idx & 15) * 8; const int tl = dir ? 63 - sl : sl, tok = c * 64 + tl;
                const bf16_t* up = U + ((size_t)row0 + tok) * UW + 512 + h * 128 + d0;
                kc[g] = *(const uint4*)up; kp[g] = make_uint4(0u, 0u, 0u, 0u); kn[g] = kp[g];
                if (tok > 0) kp[g] = *(const uint4*)(up - UW);
                if (tok < T - 1) kn[g] = *(const uint4*)(up + UW);
                vv[g] = *(const uint4*)(up + 512); }
            LDS_BARRIER();
            if (wv == 0) {
                const int tl = dir ? 63 - lane : lane; const size_t row = (size_t)row0 + c * 64 + tl;
                const float ip = GATES[row * 16 + dir * 4 + h] + gbi, fp = GATES[row * 16 + 8 + dir * 4 + h] + gbf;
                const float lf = -softplus_fast(-fp);
                float bs = lf;
#pragma unroll
                for (int o = 1; o < 64; o <<= 1) { const float t = __shfl_up(bs, o); if (lane >= o) bs += t; }
                const float a = ip - bs; float pm = a;
#pragma unroll
                for (int o = 1; o < 64; o <<= 1) { const float t = __shfl_up(pm, o); if (lane >= o) pm = fmaxf(pm, t); }
                const float Mt = fmaxf(m_prev, pm);
                sA[lane] = a; sM[lane] = Mt; sBb[lane] = bs;
                if (lane == 63) { sScal[0] = Mt; sScal[1] = bs; }
            }
            LDS_BARRIER();
            const float M63 = sScal[0], bL = sScal[1];
            uint4 qc[4], qp[4], qn[4];
            { const int t_ = 16 * rw + fr, tl = dir ? 63 - t_ : t_, tok = c * 64 + tl; const bf16_t* up = U + ((size_t)row0 + tok) * UW + h * 128 + 8 * fq;
#pragma unroll
              for (int kk = 0; kk < 4; ++kk) { qc[kk] = *(const uint4*)(up + 32 * kk); qp[kk] = make_uint4(0u, 0u, 0u, 0u); qn[kk] = qp[kk];
                  if (tok > 0) qp[kk] = *(const uint4*)(up + 32 * kk - UW);
                  if (tok < T - 1) qn[kk] = *(const uint4*)(up + 32 * kk + UW); } }
#pragma unroll
            for (int g = 0; g < 2; ++g) {
                const int idx = tid + 512 * g, sl = idx >> 4, d0 = (idx & 15) * 8;
                const float wk = fexp(sA[sl] - M63);
                const float* cwp = sCW + 128 + d0;
                float kv[8], t[8];
                unpack8(kc[g], t);
#pragma unroll
                for (int i = 0; i < 8; ++i) kv[i] = cwp[768 + i] + cwp[256 + i] * t[i];
                unpack8(kp[g], t);
#pragma unroll
                for (int i = 0; i < 8; ++i) kv[i] += cwp[i] * t[i];
                unpack8(kn[g], t);
#pragma unroll
                for (int i = 0; i < 8; ++i) kv[i] += cwp[512 + i] * t[i];
#pragma unroll
                for (int i = 0; i < 8; ++i) kv[i] = siluf(kv[i]) * 0.08838834764831845f;
                *(uint4*)(sK + sl * 136 + d0) = make_uint4(pk2(kv[0], kv[1]), pk2(kv[2], kv[3]), pk2(kv[4], kv[5]), pk2(kv[6], kv[7]));
#pragma unroll
                for (int i = 0; i < 8; ++i) sKwT[(d0 + i) * 72 + sl] = f2bf(kv[i] * wk);
                const unsigned vw[4] = {vv[g].x, vv[g].y, vv[g].z, vv[g].w};
#pragma unroll
                for (int i = 0; i < 8; ++i) sVT[(d0 + i) * 72 + sl] = (bf16_t)((vw[i >> 1] >> ((i & 1) * 16)) & 0xffffu);
            }
            bf16x8 qf[4];
#pragma unroll
            for (int kk = 0; kk < 4; ++kk) { const float* cwp = sCW + 32 * kk + 8 * fq; float qv[8], t[8];
                unpack8(qc[kk], t);
#pragma unroll
                for (int i = 0; i < 8; ++i) qv[i] = cwp[768 + i] + cwp[256 + i] * t[i];
                unpack8(qp[kk], t);
#pragma unroll
                for (int i = 0; i < 8; ++i) qv[i] += cwp[i] * t[i];
                unpack8(qn[kk], t);
#pragma unroll
                for (int i = 0; i < 8; ++i) qv[i] += cwp[512 + i] * t[i];
#pragma unroll
                for (int i = 0; i < 8; ++i) qv[i] = siluf(qv[i]);
                union { uint4 u; bf16x8 v; } cv; cv.u = make_uint4(pk2(qv[0], qv[1]), pk2(qv[2], qv[3]), pk2(qv[4], qv[5]), pk2(qv[6], qv[7])); qf[kk] = cv.v; }
            f32x4 num[5];
#pragma unroll
            for (int k = 0; k < 5; ++k) num[k] = (f32x4){0.f, 0.f, 0.f, 0.f};
#pragma unroll
            for (int ci = 0; ci < 5; ++ci) { const f32x4 v = Cacc[ci]; *(uint2*)(sCb + (16 * ci + fr) * 136 + 16 * wv + 4 * fq) = make_uint2(pk2(v[0], v[1]), pk2(v[2], v[3])); }
            LDS_BARRIER();
#pragma unroll
            for (int k = 0; k < 3; ++k) if (k < n_a) {
#pragma unroll
                for (int kk = 0; kk < 4; ++kk) { const bf16x8 b = *(const bf16x8*)(sCb + (16 * (ct_a + k) + fr) * 136 + 32 * kk + 8 * fq); num[k] = mfma16(qf[kk], b, num[k]); } }
            LDS_BARRIER();
#pragma unroll
            for (int ci = 0; ci < 4; ++ci) { const f32x4 v = Cacc[5 + ci]; *(uint2*)(sCb + (16 * ci + fr) * 136 + 16 * wv + 4 * fq) = make_uint2(pk2(v[0], v[1]), pk2(v[2], v[3])); }
            LDS_BARRIER();
#pragma unroll
            for (int k = 3; k < 5; ++k) {
#pragma unroll
                for (int kk = 0; kk < 4; ++kk) { const bf16x8 b = *(const bf16x8*)(sCb + (16 * (ct_b + k - 3 - 5) + fr) * 136 + 32 * kk + 8 * fq); num[k] = mfma16(qf[kk], b, num[k]); } }
            {
                float scv[4];
#pragma unroll
                for (int j = 0; j < 4; ++j) scv[j] = fexp(m_prev - sM[16 * rw + 4 * fq + j]);
#pragma unroll
                for (int k = 0; k < 5; ++k)
#pragma unroll
                    for (int j = 0; j < 4; ++j) num[k][j] *= scv[j];
            }
            LDS_BARRIER();
#pragma unroll
            for (int si = 0; si < 2; ++si) { const int st = 2 * cw + si;
                f32x4 sacc = (f32x4){0.f, 0.f, 0.f, 0.f};
                if (st <= rw) {
#pragma unroll
                    for (int kk = 0; kk < 4; ++kk) { const bf16x8 b = *(const bf16x8*)(sK + (16 * st + fr) * 136 + 32 * kk + 8 * fq); sacc = mfma16(qf[kk], b, sacc); } }
                const int sp = 16 * st + fr; const float as = sA[sp];
#pragma unroll
                for (int j = 0; j < 4; ++j) { const int tp = 16 * rw + 4 * fq + j; const float val = (sp <= tp) ? sacc[j] * fexp(as - sM[tp]) : 0.f; sS[tp * 72 + sp] = f2bf(val); }
            }
            LDS_BARRIER();
#pragma unroll
            for (int ks = 0; ks < 2; ++ks) { const bf16x8 a = *(const bf16x8*)(sS + (16 * rw + fr) * 72 + 32 * ks + 8 * fq);
#pragma unroll
                for (int k = 0; k < 5; ++k) { const int ct = k < 3 ? ct_a + k : ct_b + k - 3;
                    if (k != 2 || cw == 0) { const bf16x8 b = *(const bf16x8*)(sVT + (16 * ct + fr) * 72 + 32 * ks + 8 * fq); num[k] = mfma16(a, b, num[k]); } } }
            if (cw == 1 && fr == 0) {
#pragma unroll
                for (int j = 0; j < 4; ++j) sDen[16 * rw + 4 * fq + j] = num[4][j]; }
            LDS_BARRIER();
            float inv[4];
#pragma unroll
            for (int j = 0; j < 4; ++j) { const int tp = 16 * rw + 4 * fq + j; const float den = sDen[tp]; inv[j] = __builtin_amdgcn_rcpf(fmaxf(fabsf(den), fexp(-(sBb[tp] + sM[tp])))); }
            if (!second) {
#pragma unroll
                for (int j = 0; j < 4; ++j) { const int tp = 16 * rw + 4 * fq + j, tl = dir ? 63 - tp : tp; const size_t row = (size_t)row0 + c * 64 + tl;
                    bf16_t* hb = dsel == 1 ? HB2 + (row - NCTX) * 512 + h * 128 : HB + row * DM + h * 128;
#pragma unroll
                    for (int k = 0; k < 5; ++k) { const int ct = k < 3 ? ct_a + k : ct_b + k - 3; if ((k != 2 || cw == 0) && ct < 8) hb[16 * ct + fr] = f2bf(num[k][j] * inv[j]); } }
            } else {
                float ssr[4];
#pragma unroll
                for (int j = 0; j < 4; ++j) { const int tp = 16 * rw + 4 * fq + j, tl = dir ? 63 - tp : tp; const size_t row = (size_t)row0 + c * 64 + tl;
                    const bf16_t* hb = HB + row * DM + h * 128; float ss = 0.f;
#pragma unroll
                    for (int k = 0; k < 5; ++k) { const int ct = k < 3 ? ct_a + k : ct_b + k - 3;
                        if ((k != 2 || cw == 0) && ct < 8) { const int e = 16 * ct + fr; const float other = bf2f(ld_u16_agent(hb + e)); const float hs = num[k][j] * inv[j] + other;
                            const float o = sigmf(bf2f(U[row * UW + 1536 + h * 128 + e])); const float v = o * hs; ss += v * v; num[k][j] = v; } }
                    ss += __shfl_xor(ss, 1); ss += __shfl_xor(ss, 2); ss += __shfl_xor(ss, 4); ss += __shfl_xor(ss, 8);
                    ssr[j] = ss; if (fr == 0) sRed[cw * 64 + tp] = ss; }
                LDS_BARRIER();
#pragma unroll
                for (int j = 0; j < 4; ++j) { const int tp = 16 * rw + 4 * fq + j, tl = dir ? 63 - tp : tp; const size_t row = (size_t)row0 + c * 64 + tl;
                    bf16_t* hb = HB + row * DM + h * 128; const float rms = rsqrtf((ssr[j] + sRed[(1 - cw) * 64 + tp]) * (1.f / 128.f) + 1e-6f);
#pragma unroll
                    for (int k = 0; k < 5; ++k) { const int ct = k < 3 ? ct_a + k : ct_b + k - 3;
                        if ((k != 2 || cw == 0) && ct < 8) { const int e = 16 * ct + fr; hb[e] = f2bf(num[k][j] * rms * p.hg[h * 128 + e]); } } }
            }
            const float decay = fexp(m_prev - M63);
#pragma unroll
            for (int ct = 0; ct < 9; ++ct) Cacc[ct] = Cacc[ct] * decay;
#pragma unroll
            for (int ks = 0; ks < 2; ++ks) { const bf16x8 a = *(const bf16x8*)(sKwT + (16 * wv + fr) * 72 + 32 * ks + 8 * fq);
#pragma unroll
                for (int ct = 0; ct < 9; ++ct) { const bf16x8 b = *(const bf16x8*)(sVT + (16 * ct + fr) * 72 + 32 * ks + 8 * fq); Cacc[ct] = mfma16(a, b, Cacc[ct]); } }
            m_prev = bL + M63;
        }
        if (ctx) { const int sidx = (bg * 2 + dir) * 4 + h; float* Co = p.out + OUT_C + (size_t)sidx * 16384;
            int z1 = 0; asm volatile("" : "+v"(z1)); const int tid1 = (int)threadIdx.x + z1, fr1 = tid1 & 15, fq1 = (tid1 >> 4) & 3;
#pragma unroll
            for (int j = 0; j < 4; ++j) { const int d = 16 * wv + 4 * fq1 + j;
#pragma unroll
                for (int ct = 0; ct < 8; ++ct) Co[d * 128 + 16 * ct + fr1] = Cacc[ct][j];
                if (fr1 == 0) p.out[OUT_N + sidx * 128 + d] = Cacc[8][j]; }
            if (tid1 == 0) p.out[OUT_MM + sidx] = m_prev; }
        __syncthreads();
    }
}

__device__ __forceinline__ void phase_shift(bf16_t* U, const float* pmu, uint4* sRow) {
#pragma unroll 1
    for (int item = blockIdx.x; item < 1200; item += gridDim.x) {
        const int tid = opaque_tid(), tl = tid >> 3, g = tid & 7;
        const bool grid = item < 240; const int seq = grid ? item / 30 : (item - 240) / 30, sl = grid ? item % 30 : (item - 240) % 30;
        const int T = grid ? 2048 : 256, nst = T / 64; const size_t row0 = grid ? (size_t)NCTX + (size_t)seq * 2048 : (size_t)seq * 256;
        const int rc = sl * 64 + g * 8;
        char* base = (char*)(U + row0 * UW + 2048 + rc);
        const int act = (rc >= 1536 && rc < 1664) ? 1 : (rc >= 1792 ? 2 : 0);
        unsigned z0_ = 0u; asm volatile("" : "+v"(z0_));
        uint4 prv = make_uint4(z0_, z0_, z0_, z0_), cur = *(const uint4*)(base + (size_t)tl * (UW * 2)), nxt;
        __syncthreads();
#pragma unroll 1
        for (int k = 0; k < nst; ++k) {
            unsigned zr = 0u; asm volatile("" : "+v"(zr)); const uint4 z4 = make_uint4(zr, zr, zr, zr);
            nxt = z4; if (k + 1 < nst) nxt = *(const uint4*)(base + (size_t)((k + 1) * 64 + tl) * (UW * 2));
            sRow[(1 + tl) * 8 + g] = cur;
            if (tl == 0) sRow[65 * 8 + g] = nxt;
            LDS_BARRIER();
            uint4 lf = sRow[tl * 8 + g], rt = sRow[(2 + tl) * 8 + g];
            if (tl == 0 && (grid || k == 0)) lf = z4;
            if (tl == 63 && (grid || k == nst - 1)) rt = z4;
            float x[8], t[8], o[8], ms[8], m[8];
            int zz = 0; asm volatile("" : "+v"(zz)); const float* mup = pmu + rc + zz;
#define LD_MU8(a) do { const float4 m0 = *(const float4*)(mup + (a) * 1920), m1 = *(const float4*)(mup + (a) * 1920 + 4); m[0] = m0.x; m[1] = m0.y; m[2] = m0.z; m[3] = m0.w; m[4] = m1.x; m[5] = m1.y; m[6] = m1.z; m[7] = m1.w; } while (0)
            unpack8(cur, x);
            LD_MU8(0); unpack8(lf, t);
#pragma unroll
            for (int i = 0; i < 8; ++i) { o[i] = m[i] * t[i]; ms[i] = m[i]; }
            LD_MU8(1); unpack8(rt, t);
#pragma unroll
            for (int i = 0; i < 8; ++i) { o[i] += m[i] * t[i]; ms[i] += m[i]; }
            if (grid) {
                LD_MU8(2); unpack8(prv, t);
#pragma unroll
                for (int i = 0; i < 8; ++i) { o[i] += m[i] * t[i]; ms[i] += m[i]; }
                LD_MU8(3); unpack8(nxt, t);
#pragma unroll
                for (int i = 0; i < 8; ++i) { o[i] += m[i] * t[i]; ms[i] += m[i]; }
            }
#undef LD_MU8
#pragma unroll
            for (int i = 0; i < 8; ++i) o[i] += x[i] * (1.f - ms[i]);
            if (act == 1) {
#pragma unroll
                for (int i = 0; i < 8; ++i) o[i] = tanh_fast(o[i]); }
            if (act == 2) {
#pragma unroll
                for (int i = 0; i < 8; ++i) o[i] = sigmf(o[i]); }
            *(uint4*)(base + (size_t)(k * 64 + tl) * (UW * 2)) = make_uint4(pk2(o[0], o[1]), pk2(o[2], o[3]), pk2(o[4], o[5]), pk2(o[6], o[7]));
            LDS_BARRIER();
            if (tl == 63) sRow[g] = cur;
            prv = cur; cur = nxt;
        }
    }
}

constexpr int RW_TC = 16;
constexpr int RW_VEC = 0, RW_V = RW_VEC + 16 * 320 * 4, RW_KR = RW_V + 16 * 32 * 4, RW_XW = RW_KR + 16 * 64 * 4, RW_XA = RW_XW + 16 * 72 * 2, RW_Y = RW_XA + 16 * 72 * 2,
              RW_MU = RW_Y + 16 * 32 * 4, RW_DIR = RW_MU + 4 * 288 * 4;
static_assert(2 * RW_DIR <= LDS_BYTES && RW_DIR % 16 == 0, "rwkv lds");

__device__ __forceinline__ float dppf(float x, const int ctrl) { return x; }
#define DPP_ADD(x, ctrl) ((x) + __int_as_float(__builtin_amdgcn_update_dpp(0, __float_as_int(x), (ctrl), 0xf, 0xf, true)))
__device__ __forceinline__ float red8(float x) { x = DPP_ADD(x, 0xB1); x = DPP_ADD(x, 0x4E); x = DPP_ADD(x, 0x141); return x; }
__device__ __forceinline__ float red16(float x) { x = red8(x); x = DPP_ADD(x, 0x140); return x; }

struct Sh8 { uint4 x, l, r, u, d; };
__device__ __forceinline__ void sh8_load(Sh8& q, const bf16_t* U, size_t row0, int tok, int T, bool grid, int c0) {
    const char* Ub = (const char*)(U + row0 * UW);
    const int off = (tok * UW + c0) * 2; const uint4 z = make_uint4(0u, 0u, 0u, 0u);
    const bool hl = grid ? (tok & 63) != 0 : tok > 0, hr = grid ? (tok & 63) != 63 : tok < T - 1;
    q.x = *(const uint4*)(Ub + off);
    q.l = hl ? *(const uint4*)(Ub + (off - UW * 2)) : z; q.r = hr ? *(const uint4*)(Ub + (off + UW * 2)) : z;
    q.u = (grid && tok >= 64) ? *(const uint4*)(Ub + (off - 64 * UW * 2)) : z; q.d = (grid && tok < T - 64) ? *(const uint4*)(Ub + (off + 64 * UW * 2)) : z;
}
__device__ __forceinline__ void sh8_mix(const Sh8& q, bool grid, const float* mu4, int mustride, float* o) {
    float x[8], t[8], m[8], ms[8];
    unpack8(q.x, x);
    { const float4 a = *(const float4*)mu4, b = *(const float4*)(mu4 + 4); m[0] = a.x; m[1] = a.y; m[2] = a.z; m[3] = a.w; m[4] = b.x; m[5] = b.y; m[6] = b.z; m[7] = b.w; }
    unpack8(q.l, t);
#pragma unroll
    for (int i = 0; i < 8; ++i) { o[i] = m[i] * t[i]; ms[i] = m[i]; }
    { const float4 a = *(const float4*)(mu4 + mustride), b = *(const float4*)(mu4 + mustride + 4); m[0] = a.x; m[1] = a.y; m[2] = a.z; m[3] = a.w; m[4] = b.x; m[5] = b.y; m[6] = b.z; m[7] = b.w; }
    unpack8(q.r, t);
#pragma unroll
    for (int i = 0; i < 8; ++i) { o[i] += m[i] * t[i]; ms[i] += m[i]; }
    if (grid) {
        { const float4 a = *(const float4*)(mu4 + 2 * mustride), b = *(const float4*)(mu4 + 2 * mustride + 4); m[0] = a.x; m[1] = a.y; m[2] = a.z; m[3] = a.w; m[4] = b.x; m[5] = b.y; m[6] = b.z; m[7] = b.w; }
        unpack8(q.u, t);
#pragma unroll
        for (int i = 0; i < 8; ++i) { o[i] += m[i] * t[i]; ms[i] += m[i]; }
        { const float4 a = *(const float4*)(mu4 + 3 * mustride), b = *(const float4*)(mu4 + 3 * mustride + 4); m[0] = a.x; m[1] = a.y; m[2] = a.z; m[3] = a.w; m[4] = b.x; m[5] = b.y; m[6] = b.z; m[7] = b.w; }
        unpack8(q.d, t);
#pragma unroll
        for (int i = 0; i < 8; ++i) { o[i] += m[i] * t[i]; ms[i] += m[i]; }
    }
#pragma unroll
    for (int i = 0; i < 8; ++i) o[i] += x[i] * (1.f - ms[i]);
}
__device__ __forceinline__ void shifted8(const bf16_t* U, size_t row0, int tok, int T, bool grid, int c0, const float* mu4, int mustride, float* o) {
    Sh8 q; sh8_load(q, U, row0, tok, T, grid, c0); sh8_mix(q, grid, mu4, mustride, o);
}
typedef float f32x2 __attribute__((ext_vector_type(2)));

__device__ __forceinline__ void rwkv_task(const P& p, unsigned char* lds, int bg, int h, int rh) {
    const int wv = __builtin_amdgcn_readfirstlane((int)threadIdx.x >> 6), dir = wv >> 2, lw = wv & 3;
    const bool ctx = bg < 32; const int T = ctx ? 256 : 2048, nc = T / RW_TC; const size_t row0 = ctx ? (size_t)bg * 256 : (size_t)NCTX + (size_t)(bg - 32) * 2048;
    const bool grid = !ctx;
    unsigned char* L = lds + dir * RW_DIR;
    float* sVec = (float*)(L + RW_VEC); float* sV = (float*)(L + RW_V); float* sKr = (float*)(L + RW_KR); bf16_t* sXw = (bf16_t*)(L + RW_XW); bf16_t* sXa = (bf16_t*)(L + RW_XA);
    float* sY = (float*)(L + RW_Y); float* sMu = (float*)(L + RW_MU);
    const bf16_t* U = (const bf16_t*)(p.ws + WS_U); bf16_t* HB = (bf16_t*)(p.ws + WS_A);
    const int hc = h * 64;
    float st[8]; bf16x8 wfrag[2], afrag[2]; float w0v, a0v, kav;
    {
        const int tid = opaque_tid(), ltid = tid & 255, ri = ltid >> 3, jq = ltid & 7, fr = tid & 15, fq = (tid >> 4) & 3;
        __syncthreads();
        if (ctx) {
#pragma unroll
            for (int q = 0; q < 8; ++q) st[q] = 0.f;
        } else { const float* S0 = p.sS + ((size_t)(((bg - 32) * 2 + dir) * 8 + h)) * 4096 + (32 * rh + ri) * 64 + jq * 8;
#pragma unroll
            for (int q = 0; q < 8; ++q) st[q] = S0[q]; }
        const int jcol = hc + 16 * lw + fr;
#pragma unroll
        for (int ks = 0; ks < 2; ++ks) { float wf[8], af[8];
#pragma unroll
            for (int i = 0; i < 8; ++i) { const int l = 32 * ks + 8 * fq + i; wf[i] = p.w2[(size_t)(dir * 64 + l) * 512 + jcol]; af[i] = p.a2[(size_t)(dir * 64 + l) * 512 + jcol]; }
            union { uint4 u; bf16x8 v; } c1, c2; c1.u = make_uint4(pk2(wf[0], wf[1]), pk2(wf[2], wf[3]), pk2(wf[4], wf[5]), pk2(wf[6], wf[7])); c2.u = make_uint4(pk2(af[0], af[1]), pk2(af[2], af[3]), pk2(af[4], af[5]), pk2(af[6], af[7]));
            wfrag[ks] = c1.v; afrag[ks] = c2.v; }
        w0v = p.w0[dir * 512 + jcol]; a0v = p.a0[dir * 512 + jcol]; kav = p.ka[jcol];
    }
    uint4 q1, q2, q3 = make_uint4(0u, 0u, 0u, 0u);
    const char* Ub = (const char*)(U + row0 * UW);
    { const int tid = opaque_tid(), ltid = tid & 255; const int c = dir ? nc - 1 : 0, tok0 = c * RW_TC; const int tl = (ltid & 127) >> 3, g = ltid & 7;
      q1 = *(const uint4*)(Ub + ((tok0 + tl) * UW + (lw < 2 ? 2048 : 2048 + 512) + hc + 8 * g) * 2);
      q2 = *(const uint4*)(Ub + ((tok0 + tl) * UW + (lw < 2 ? 2048 + 1536 : 2048 + 1664) + dir * 64 + 8 * g) * 2);
      if (lw == 0) q3 = *(const uint4*)(Ub + ((tok0 + (ltid >> 2)) * UW + 2048 + 1024 + hc + 32 * rh + 8 * (ltid & 3)) * 2); }
    f32x2 st2[4];
#pragma unroll
    for (int q = 0; q < 4; ++q) st2[q] = (f32x2){st[2 * q], st[2 * q + 1]};
#pragma unroll 1
    for (int s = 0; s < nc; ++s) {
        const int c = dir ? nc - 1 - s : s; const int tok0 = c * RW_TC;
        const bool second = s >= (nc >> 1);
        const int tid = opaque_tid(), ltid = tid & 255, ri = ltid >> 3, jq = ltid & 7, fr = tid & 15, fq = (tid >> 4) & 3;
        { const int tl = (ltid & 127) >> 3, g = ltid & 7; float o[8];
          if (lw < 2) {
              unpack8(q1, o);
              *(float4*)(sVec + tl * 320 + 8 * g) = make_float4(o[0], o[1], o[2], o[3]); *(float4*)(sVec + tl * 320 + 8 * g + 4) = make_float4(o[4], o[5], o[6], o[7]);
              *(uint4*)(sXw + tl * 72 + 8 * g) = q2;
          } else {
              unpack8(q1, o);
              float kkr[8]; float ss = 0.f;
#pragma unroll
              for (int i = 0; i < 8; ++i) { kkr[i] = o[i] * p.kk[hc + 8 * g + i]; ss += kkr[i] * kkr[i]; }
              ss = red8(ss); const float rn = __builtin_amdgcn_rsqf(fmaxf(ss, 1e-24f));
              *(float4*)(sKr + tl * 64 + 8 * g) = make_float4(o[0], o[1], o[2], o[3]); *(float4*)(sKr + tl * 64 + 8 * g + 4) = make_float4(o[4], o[5], o[6], o[7]);
              *(float4*)(sVec + tl * 320 + 192 + 8 * g) = make_float4(kkr[0] * rn, kkr[1] * rn, kkr[2] * rn, kkr[3] * rn); *(float4*)(sVec + tl * 320 + 192 + 8 * g + 4) = make_float4(kkr[4] * rn, kkr[5] * rn, kkr[6] * rn, kkr[7] * rn);
              *(uint4*)(sXa + tl * 72 + 8 * g) = q2;
          }
          if (lw == 0) {
              const int tl2 = ltid >> 2, g2 = ltid & 3;
              unpack8(q3, o);
              *(float4*)(sV + tl2 * 32 + 8 * g2) = make_float4(o[0], o[1], o[2], o[3]); *(float4*)(sV + tl2 * 32 + 8 * g2 + 4) = make_float4(o[4], o[5], o[6], o[7]);
          } }
        __syncthreads();
        { f32x4 aw = (f32x4){0.f, 0.f, 0.f, 0.f}, aa = (f32x4){0.f, 0.f, 0.f, 0.f};
#pragma unroll
          for (int ks = 0; ks < 2; ++ks) { const bf16x8 xw = *(const bf16x8*)(sXw + fr * 72 + 32 * ks + 8 * fq), xa = *(const bf16x8*)(sXa + fr * 72 + 32 * ks + 8 * fq);
              aw = mfma16(xw, wfrag[ks], aw); aa = mfma16(xa, afrag[ks], aa); }
          const int j = 16 * lw + fr;
#pragma unroll
          for (int jj = 0; jj < 4; ++jj) { const int tl = 4 * fq + jj;
              const float dec = fexp(-fexp(-softplus_fast(-(w0v + aw[jj])) - 0.5f));
              const float a = sigmf(a0v + aa[jj]); const float k = sKr[tl * 64 + j], kn = sVec[tl * 320 + 192 + j];
              float* V = sVec + tl * 320 + j; V[64] = dec; V[128] = k * (1.f + (a - 1.f) * kav); V[256] = kn * a; } }
        const int otl = ltid >> 4, opr = ltid & 15; unsigned* hb = (unsigned*)(HB + (row0 + tok0 + otl) * DM + 512 + hc + 32 * rh + 2 * opr);
        unsigned ov = 0u;
        if (second) ov = __hip_atomic_load(hb, __ATOMIC_RELAXED, __HIP_MEMORY_SCOPE_AGENT);
        if (s + 1 < nc) { const int cn = dir ? nc - 2 - s : s + 1, tokn = cn * RW_TC; const int tl = (ltid & 127) >> 3, g = ltid & 7;
            q1 = *(const uint4*)(Ub + ((tokn + tl) * UW + (lw < 2 ? 2048 : 2048 + 512) + hc + 8 * g) * 2);
            q2 = *(const uint4*)(Ub + ((tokn + tl) * UW + (lw < 2 ? 2048 + 1536 : 2048 + 1664) + dir * 64 + 8 * g) * 2);
            if (lw == 0) q3 = *(const uint4*)(Ub + ((tokn + (ltid >> 2)) * UW + 2048 + 1024 + hc + 32 * rh + 8 * (ltid & 3)) * 2); }
        LDS_BARRIER();
        f32x2 sv_[4];
#pragma unroll
        for (int q = 0; q < 4; ++q) sv_[q] = st2[q];
#pragma unroll 1
        for (int rep = 0; rep < (PROBE_DUP == 102 ? 2 : 1); ++rep) {
        if (PROBE_DUP == 102) {
#pragma unroll
            for (int q = 0; q < 4; ++q) st2[q] = sv_[q]; }
float ys[RW_TC];
#pragma unroll
        for (int step = 0; step < RW_TC; ++step) { const int tl = dir ? RW_TC - 1 - step : step; const float* V = sVec + tl * 320 + jq * 8;
            const float4 ka4 = *(const float4*)(V + 192), kb4 = *(const float4*)(V + 196);
            f32x2 acc = st2[0] * (f32x2){ka4.x, ka4.y}; acc = st2[1] * (f32x2){ka4.z, ka4.w} + acc; acc = st2[2] * (f32x2){kb4.x, kb4.y} + acc; acc = st2[3] * (f32x2){kb4.z, kb4.w} + acc;
            const float sa = -red8(acc.x + acc.y);
            const float vi = sV[tl * 32 + ri];
            const float4 wa = *(const float4*)(V + 64), wb = *(const float4*)(V + 68), ba = *(const float4*)(V + 256), bb = *(const float4*)(V + 260),
                         da = *(const float4*)(V + 128), db = *(const float4*)(V + 132), ra = *(const float4*)(V), rb = *(const float4*)(V + 4);
            const f32x2 sa2 = (f32x2){sa, sa}, vi2 = (f32x2){vi, vi};
            st2[0] = st2[0] * (f32x2){wa.x, wa.y} + (sa2 * (f32x2){ba.x, ba.y} + vi2 * (f32x2){da.x, da.y});
            st2[1] = st2[1] * (f32x2){wa.z, wa.w} + (sa2 * (f32x2){ba.z, ba.w} + vi2 * (f32x2){da.z, da.w});
            st2[2] = st2[2] * (f32x2){wb.x, wb.y} + (sa2 * (f32x2){bb.x, bb.y} + vi2 * (f32x2){db.x, db.y});
            st2[3] = st2[3] * (f32x2){wb.z, wb.w} + (sa2 * (f32x2){bb.z, bb.w} + vi2 * (f32x2){db.z, db.w});
            f32x2 ya = st2[0] * (f32x2){ra.x, ra.y}; ya = st2[1] * (f32x2){ra.z, ra.w} + ya; ya = st2[2] * (f32x2){rb.x, rb.y} + ya; ya = st2[3] * (f32x2){rb.z, rb.w} + ya;
            const float y = red8(ya.x + ya.y);
            ys[step] = y; }
        if (jq == 0) {
#pragma unroll
            for (int step = 0; step < RW_TC; ++step) sY[(dir ? RW_TC - 1 - step : step) * 32 + ri] = ys[step]; }
        }
        LDS_BARRIER();
        { float y0 = sY[otl * 32 + 2 * opr], y1 = sY[otl * 32 + 2 * opr + 1];
          if (second) { y0 += __uint_as_float(ov << 16); y1 += __uint_as_float(ov & 0xffff0000u); }
          *hb = pk2(y0, y1); }
    }
#pragma unroll
    for (int q = 0; q < 4; ++q) { st[2 * q] = st2[q].x; st[2 * q + 1] = st2[q].y; }
    if (ctx) { const int tid = opaque_tid(), ltid = tid & 255, ri = ltid >> 3, jq = ltid & 7;
        float* So = p.out + OUT_S + ((size_t)((bg * 2 + dir) * 8 + h)) * 4096 + (32 * rh + ri) * 64 + jq * 8;
#pragma unroll
        for (int q = 0; q < 8; ++q) So[q] = st[q]; }
    __syncthreads();
}

constexpr int RX_VEC = 0,
              RX_KR = RX_VEC + 16 * 320 * 4,
              RX_XW = RX_KR + 4096, RX_XA = RX_XW + 2304,
              RX_Y = RX_XA + 2304,
              RX_KT = RX_Y + 4096, RX_KTN = RX_KT + 2304, RX_RT = RX_KTN + 2304, RX_RTN = RX_RT + 2304, RX_BN = RX_RTN + 2304, RX_DN = RX_BN + 2304,
              RX_BTS = RX_DN + 2304, RX_DT = RX_BTS + 5120, RX_VT = RX_DT + 5120,
              RX_ADK = RX_VT + 5120, RX_ABR = RX_ADK + 1280, RX_ADR = RX_ABR + 1280, RX_TM = RX_ADR + 1280,
              RX_N = RX_TM + 1280,
              RX_PL = RX_N + 1088,
              RX_VT2 = RX_PL + 256,
              RX_DIR = RX_VT2 + 5120;
static_assert(2 * RX_DIR <= LDS_BYTES - 64 && RX_DIR % 16 == 0, "rwkv (chunked) lds");
__device__ __forceinline__ int perm_pi(int j) { const int jj = j & 31; return (j & 32) + 8 * ((jj & 15) >> 2) + (jj & 3) + 4 * (jj >> 4); }
__device__ __forceinline__ int perm_sg(int c) { return 8 * (c >> 2) + (c & 3); }
__device__ __forceinline__ bf16x8 pack_acc_lo(const f32x4 v) { union { uint4 u; bf16x8 b; } c; c.u = make_uint4(pk2(v[0], v[1]), pk2(v[2], v[3]), 0u, 0u); return c.b; }
__device__ __forceinline__ bf16x8 pack_acc2(const f32x4 a, const f32x4 b) { union { uint4 u; bf16x8 v; } c; c.u = make_uint4(pk2(a[0], a[1]), pk2(a[2], a[3]), pk2(b[0], b[1]), pk2(b[2], b[3])); return c.v; }

__device__ __forceinline__ void rwkv_task_w(const P& p, unsigned char* lds, int bg, int h) {
    const int wv = __builtin_amdgcn_readfirstlane((int)threadIdx.x >> 6), dir = wv >> 2, lw = wv & 3;
    const bool ctx = bg < 32; const int T = ctx ? 256 : 2048, nc = T / 16; const size_t row0 = ctx ? (size_t)bg * 256 : (size_t)NCTX + (size_t)(bg - 32) * 2048;
    unsigned char* L = lds + dir * RX_DIR;
    float* sVec = (float*)(L + RX_VEC); float* sKr = (float*)(L + RX_KR); bf16_t* sXw = (bf16_t*)(L + RX_XW); bf16_t* sXa = (bf16_t*)(L + RX_XA); float* sY = (float*)(L + RX_Y);
    bf16_t* sKT = (bf16_t*)(L + RX_KT); bf16_t* sKTn = (bf16_t*)(L + RX_KTN); bf16_t* sRT = (bf16_t*)(L + RX_RT); bf16_t* sRTn = (bf16_t*)(L + RX_RTN); bf16_t* sBn = (bf16_t*)(L + RX_BN); bf16_t* sDn = (bf16_t*)(L + RX_DN);
    bf16_t* sBts = (bf16_t*)(L + RX_BTS); bf16_t* sDt = (bf16_t*)(L + RX_DT); bf16_t* sVT0 = (bf16_t*)(L + RX_VT); bf16_t* sVT1 = (bf16_t*)(L + RX_VT2);
    bf16_t* sAdk = (bf16_t*)(L + RX_ADK); bf16_t* sAbr = (bf16_t*)(L + RX_ABR); bf16_t* sAdr = (bf16_t*)(L + RX_ADR); bf16_t* sTm = (bf16_t*)(L + RX_TM);
    float* sN = (float*)(L + RX_N); float* sPL = (float*)(L + RX_PL);
    const bf16_t* U = (const bf16_t*)(p.ws + WS_U); bf16_t* HB = (bf16_t*)(p.ws + WS_A);
    const int hc = h * 64;
    f32x4 ST[4]; bf16x8 wfrag[2], afrag[2]; float w0v, a0v, kav, kkc[8];
    {
        const int tid = opaque_tid(), ltid = tid & 255, fr = tid & 15, fq = (tid >> 4) & 3;
        __syncthreads();
        for (int i = ltid; i < (RX_N - RX_BTS) / 4; i += 256) ((unsigned*)(L + RX_BTS))[i] = 0u;
        for (int i = ltid; i < 5120 / 4; i += 256) ((unsigned*)(L + RX_VT2))[i] = 0u;
        __syncthreads();
        if (ctx) {
#pragma unroll
            for (int jt = 0; jt < 4; ++jt) ST[jt] = (f32x4){0.f, 0.f, 0.f, 0.f};
        } else { const float* S0 = p.sS + ((size_t)(((bg - 32) * 2 + dir) * 8 + h)) * 4096 + (16 * lw + fr) * 64 + 4 * fq;
#pragma unroll
            for (int jt = 0; jt < 4; ++jt) { const float4 t = *(const float4*)(S0 + 16 * jt); ST[jt] = (f32x4){t.x, t.y, t.z, t.w}; } }
        const int jcol = hc + 16 * lw + fr;
#pragma unroll
        for (int ks = 0; ks < 2; ++ks) { float wf[8], af[8];
#pragma unroll
            for (int i = 0; i < 8; ++i) { const int l = 32 * ks + 8 * fq + i; wf[i] = p.w2[(size_t)(dir * 64 + l) * 512 + jcol]; af[i] = p.a2[(size_t)(dir * 64 + l) * 512 + jcol]; }
            union { uint4 u; bf16x8 v; } c1, c2; c1.u = make_uint4(pk2(wf[0], wf[1]), pk2(wf[2], wf[3]), pk2(wf[4], wf[5]), pk2(wf[6], wf[7])); c2.u = make_uint4(pk2(af[0], af[1]), pk2(af[2], af[3]), pk2(af[4], af[5]), pk2(af[6], af[7]));
            wfrag[ks] = c1.v; afrag[ks] = c2.v; }
        w0v = p.w0[dir * 512 + jcol]; a0v = p.a0[dir * 512 + jcol]; kav = p.ka[jcol];
#pragma unroll
        for (int i = 0; i < 8; ++i) kkc[i] = p.kk[hc + 8 * (ltid & 7) + i];
    }
    uint4 q1, q2, q3, n1a, n2a, n3a, n1b, n2b, n3b;
    const char* Ub = (const char*)(U + row0 * UW);
#define RX_LOAD(d1, d2, d3, sidx) do { const int s_ = (sidx) < nc ? (sidx) : nc - 1; const int c_ = dir ? nc - 1 - s_ : s_; const int tok_ = c_ * 16 + ((ltid_ & 127) >> 3); const int g_ = ltid_ & 7; \
        d1 = *(const uint4*)(Ub + (tok_ * UW + (lw < 2 ? 2048 : 2048 + 512) + hc + 8 * g_) * 2); \
        d2 = *(const uint4*)(Ub + (tok_ * UW + (lw < 2 ? 2048 + 1536 : 2048 + 1664) + dir * 64 + 8 * g_) * 2); \
        d3 = *(const uint4*)(Ub + (tok_ * UW + 2048 + 1024 + hc + 8 * g_) * 2); } while (0)
    { const int ltid_ = opaque_tid() & 255; RX_LOAD(q1, q2, q3, 0); RX_LOAD(n1a, n2a, n3a, 1); RX_LOAD(n1b, n2b, n3b, 2); }
    { const int tid = opaque_tid(), ltid = tid & 255; const int SPAR = 0;
        { bf16_t* sVTw = (SPAR) ? sVT1 : sVT0; const int tl = (ltid & 127) >> 3, g = ltid & 7, q = dir ? 15 - tl : tl; float o[8];
          if (lw < 2) {
              unpack8(q1, o);
              *(float4*)(sVec + q * 320 + 8 * g) = make_float4(o[0], o[1], o[2], o[3]); *(float4*)(sVec + q * 320 + 8 * g + 4) = make_float4(o[4], o[5], o[6], o[7]);
              *(uint4*)(sXw + q * 72 + 8 * g) = q2;
              const unsigned vw[4] = {q3.x, q3.y, q3.z, q3.w};
#pragma unroll
              for (int i = 0; i < 8; ++i) sVTw[(8 * g + i) * 40 + q] = (bf16_t)((vw[i >> 1] >> ((i & 1) * 16)) & 0xffffu);
          } else {
              unpack8(q1, o);
              float kkr[8]; float ss = 0.f;
#pragma unroll
              for (int i = 0; i < 8; ++i) { kkr[i] = o[i] * kkc[i]; ss += kkr[i] * kkr[i]; }
              ss = red8(ss); const float rn = __builtin_amdgcn_rsqf(fmaxf(ss, 1e-24f));
              *(float4*)(sKr + q * 64 + 8 * g) = make_float4(o[0], o[1], o[2], o[3]); *(float4*)(sKr + q * 64 + 8 * g + 4) = make_float4(o[4], o[5], o[6], o[7]);
              *(float4*)(sVec + q * 320 + 192 + 8 * g) = make_float4(kkr[0] * rn, kkr[1] * rn, kkr[2] * rn, kkr[3] * rn); *(float4*)(sVec + q * 320 + 192 + 8 * g + 4) = make_float4(kkr[4] * rn, kkr[5] * rn, kkr[6] * rn, kkr[7] * rn);
              *(uint4*)(sXa + q * 72 + 8 * g) = q2;
          } }
    }
    LDS_BARRIER();
#pragma unroll 1
    for (int s = 0; s < nc; ++s) {
        const int c = dir ? nc - 1 - s : s; const int tok0 = c * 16;
        const bool second = s >= (nc >> 1);
        const int tid = opaque_tid(), ltid = tid & 255, fr = tid & 15, fq = (tid >> 4) & 3;
        { f32x4 aw = (f32x4){0.f, 0.f, 0.f, 0.f}, aa = (f32x4){0.f, 0.f, 0.f, 0.f};
#pragma unroll
          for (int ks = 0; ks < 2; ++ks) { const bf16x8 xw = *(const bf16x8*)(sXw + fr * 72 + 32 * ks + 8 * fq), xa = *(const bf16x8*)(sXa + fr * 72 + 32 * ks + 8 * fq);
              aw = mfma16(xw, wfrag[ks], aw); aa = mfma16(xa, afrag[ks], aa); }
          const int j = 16 * lw + fr;
          float lg[4], av[4]; float run = 0.f;
#pragma unroll
          for (int e = 0; e < 4; ++e) { const float lw_ = -0.6065306597126334f * sigmf(w0v + aw[e])  ; run += lw_; lg[e] = run; av[e] = sigmf(a0v + aa[e]); }
          float x = run; { const float y1 = __shfl_up(x, 16); if (fq >= 1) x += y1; const float y2 = __shfl_up(x, 32); if (fq >= 2) x += y2; }
          const float excl = x - run;
          const int pj = perm_pi(j); bf16_t btv[4], dtv[4];
          float Pp = fexp(excl);
#pragma unroll
          for (int e = 0; e < 4; ++e) { const int q = 4 * fq + e; const float Lq = excl + lg[e];
              const float Pq = fexp(Lq), iP = __builtin_amdgcn_rcpf(Pq);
              const float k = sKr[q * 64 + j], kn = sVec[q * 320 + 192 + j], r = sVec[q * 320 + j];
              const float kd = k * (1.f + (av[e] - 1.f) * kav), b = kn * av[e];
              const bf16_t kt = f2bf(Pp * kn), rt = f2bf(Pq * r), bt = f2bf(b * iP), dt = f2bf(kd * iP);
              sKT[q * 72 + pj] = kt; sRT[q * 72 + pj] = rt; sBn[q * 72 + pj] = bt; sDn[q * 72 + pj] = dt;
              btv[e] = bt; dtv[e] = dt;
              if (q == 15) sPL[j] = Pq;
              Pp = Pq; }
          *(uint2*)(sBts + j * 40 + 8 * fq) = make_uint2((unsigned)btv[0] | ((unsigned)btv[1] << 16), (unsigned)btv[2] | ((unsigned)btv[3] << 16));
          *(uint2*)(sDt + j * 40 + 4 * fq) = make_uint2((unsigned)dtv[0] | ((unsigned)dtv[1] << 16), (unsigned)dtv[2] | ((unsigned)dtv[3] << 16)); }
        if (s == (nc >> 1)) asm volatile("s_waitcnt vmcnt(0)" ::: "memory"); else asm volatile("s_waitcnt vmcnt(6)" ::: "memory");
        LDS_BARRIER();
        { const int role = (lw - dir) & 3;
          f32x4 gacc = (f32x4){0.f, 0.f, 0.f, 0.f}; const bf16_t* Ap = (role < 2) ? sKT : sRT; const bf16_t* Bp = (role & 1) ? sDn : sBn;
#pragma unroll
          for (int ks = 0; ks < 2; ++ks) gacc = mfma16(*(const bf16x8*)(Ap + fr * 72 + 32 * ks + 8 * fq), *(const bf16x8*)(Bp + fr * 72 + 32 * ks + 8 * fq), gacc);
          const int sidx = fr;
          float gm[4];
#pragma unroll
          for (int e = 0; e < 4; ++e) { const int q = 4 * fq + e; const bool keep = (role < 2) ? (sidx < q) : (sidx <= q); gm[e] = keep ? gacc[e] : 0.f; }
          if (role == 0) {
              const int r = tid & 15; float Tr[16];
#pragma unroll
              for (int q = 0; q < 16; ++q) Tr[q] = (r == q) ? 1.f : 0.f;
#pragma unroll
              for (int q = 0; q < 15; ++q) { const float tq = Tr[q];
#pragma unroll
                  for (int q2 = q + 1; q2 < 16; ++q2) { const float nv = __int_as_float(__builtin_amdgcn_readlane(__float_as_int(gm[q2 & 3]), q + 16 * (q2 >> 2))); Tr[q2] -= tq * nv; } }
              if ((tid & 63) < 16) { const int ps = perm_sg(r);
#pragma unroll
                  for (int q = 0; q < 16; ++q) sTm[q * 40 + ps] = f2bf(Tr[q]); }
          } else {
#pragma unroll
              for (int e = 0; e < 4; ++e) { const int q = 4 * fq + e;
                  if (role == 1) sAdk[q * 40 + sidx] = f2bf(gm[e]);
                  else if (role == 2) sAbr[q * 40 + perm_sg(sidx)] = f2bf(gm[e]);
                  else sAdr[q * 40 + sidx] = f2bf(gm[e]); } } }
        const int oq = ltid >> 4, otl = dir ? 15 - oq : oq; unsigned long long* hb = (unsigned long long*)(HB + (row0 + tok0 + otl) * DM + 512 + hc + 4 * (ltid & 15));
        const unsigned long long ov = __hip_atomic_load(hb, __ATOMIC_RELAXED, __HIP_MEMORY_SCOPE_AGENT);
        q1 = n1a; q2 = n2a; q3 = n3a; n1a = n1b; n2a = n2b; n3a = n3b;
        { const int ltid_ = ltid; RX_LOAD(n1b, n2b, n3b, s + 3); }
        LDS_BARRIER();
        { const bf16x8 Sb0 = pack_acc2(ST[0], ST[1]), Sb1 = pack_acc2(ST[2], ST[3]);
          const bf16x8 vtf = *(const bf16x8*)(((s & 1) ? sVT1 : sVT0) + (16 * lw + fr) * 40 + 8 * fq);
          f32x4 XT = (f32x4){0.f, 0.f, 0.f, 0.f};
          XT = mfma16(*(const bf16x8*)(sKT + fr * 72 + 8 * fq), Sb0, XT); XT = mfma16(*(const bf16x8*)(sKT + fr * 72 + 32 + 8 * fq), Sb1, XT);
          XT = mfma16(*(const bf16x8*)(sAdk + fr * 40 + 8 * fq), vtf, XT);
          f32x4 SAT = mfma16(*(const bf16x8*)(sTm + fr * 40 + 8 * fq), pack_acc_lo(XT), (f32x4){0.f, 0.f, 0.f, 0.f});
          SAT = -SAT;
          const bf16x8 SAb = pack_acc_lo(SAT);
          f32x4 YT = (f32x4){0.f, 0.f, 0.f, 0.f};
          YT = mfma16(*(const bf16x8*)(sRT + fr * 72 + 8 * fq), Sb0, YT); YT = mfma16(*(const bf16x8*)(sRT + fr * 72 + 32 + 8 * fq), Sb1, YT);
          YT = mfma16(*(const bf16x8*)(sAbr + fr * 40 + 8 * fq), SAb, YT); YT = mfma16(*(const bf16x8*)(sAdr + fr * 40 + 8 * fq), vtf, YT);
#pragma unroll
          for (int jt = 0; jt < 4; ++jt) { ST[jt] = mfma16(*(const bf16x8*)(sBts + (16 * jt + fr) * 40 + 8 * fq), SAb, ST[jt]); ST[jt] = mfma16(*(const bf16x8*)(sDt + (16 * jt + fr) * 40 + 8 * fq), vtf, ST[jt]);
              const float4 pl = *(const float4*)(sPL + 16 * jt + 4 * fq); ST[jt][0] *= pl.x; ST[jt][1] *= pl.y; ST[jt][2] *= pl.z; ST[jt][3] *= pl.w; }
#pragma unroll
          for (int e = 0; e < 4; ++e) sY[(4 * fq + e) * 64 + 16 * lw + fr] = YT[e]; }
        if (s + 1 < nc) { const int SPAR = (s + 1) & 1;
        { bf16_t* sVTw = (SPAR) ? sVT1 : sVT0; const int tl = (ltid & 127) >> 3, g = ltid & 7, q = dir ? 15 - tl : tl; float o[8];
          if (lw < 2) {
              unpack8(q1, o);
              *(float4*)(sVec + q * 320 + 8 * g) = make_float4(o[0], o[1], o[2], o[3]); *(float4*)(sVec + q * 320 + 8 * g + 4) = make_float4(o[4], o[5], o[6], o[7]);
              *(uint4*)(sXw + q * 72 + 8 * g) = q2;
              const unsigned vw[4] = {q3.x, q3.y, q3.z, q3.w};
#pragma unroll
              for (int i = 0; i < 8; ++i) sVTw[(8 * g + i) * 40 + q] = (bf16_t)((vw[i >> 1] >> ((i & 1) * 16)) & 0xffffu);
          } else {
              unpack8(q1, o);
              float kkr[8]; float ss = 0.f;
#pragma unroll
              for (int i = 0; i < 8; ++i) { kkr[i] = o[i] * kkc[i]; ss += kkr[i] * kkr[i]; }
              ss = red8(ss); const float rn = __builtin_amdgcn_rsqf(fmaxf(ss, 1e-24f));
              *(float4*)(sKr + q * 64 + 8 * g) = make_float4(o[0], o[1], o[2], o[3]); *(float4*)(sKr + q * 64 + 8 * g + 4) = make_float4(o[4], o[5], o[6], o[7]);
              *(float4*)(sVec + q * 320 + 192 + 8 * g) = make_float4(kkr[0] * rn, kkr[1] * rn, kkr[2] * rn, kkr[3] * rn); *(float4*)(sVec + q * 320 + 192 + 8 * g + 4) = make_float4(kkr[4] * rn, kkr[5] * rn, kkr[6] * rn, kkr[7] * rn);
              *(uint4*)(sXa + q * 72 + 8 * g) = q2;
          } }
        }
        LDS_BARRIER();
        { const float4 y4 = *(const float4*)(sY + oq * 64 + 4 * (ltid & 15)); float y0 = y4.x, y1 = y4.y, y2 = y4.z, y3 = y4.w;
          if (second) { const unsigned lo = (unsigned)ov, hi = (unsigned)(ov >> 32); y0 += __uint_as_float(lo << 16); y1 += __uint_as_float(lo & 0xffff0000u); y2 += __uint_as_float(hi << 16); y3 += __uint_as_float(hi & 0xffff0000u); }
          *hb = (unsigned long long)pk2(y0, y1) | ((unsigned long long)pk2(y2, y3) << 32); }
    }
#undef RX_LOAD
    if (ctx) { const int tid = opaque_tid(), fr = tid & 15, fq = (tid >> 4) & 3;
        float* So = p.out + OUT_S + ((size_t)((bg * 2 + dir) * 8 + h)) * 4096 + (16 * lw + fr) * 64 + 4 * fq;
#pragma unroll
        for (int jt = 0; jt < 4; ++jt) *(float4*)(So + 16 * jt) = make_float4(ST[jt][0], ST[jt][1], ST[jt][2], ST[jt][3]); }
    __syncthreads();
}

constexpr int FZ_ROW = 1800;
constexpr int FZ_X = 0, FZ_MU = 32 * FZ_ROW * 2, FZ_END = FZ_MU + 4 * 1792 * 4;
static_assert(FZ_END <= LDS_BYTES && FZ_MU % 16 == 0, "finalize lds");

__device__ __forceinline__ void phase_rwkv_finalize(const P& p, unsigned char* lds) {
    bf16_t* sX = (bf16_t*)(lds + FZ_X); float* sMu = (float*)(lds + FZ_MU);
    const bf16_t* U = (const bf16_t*)(p.ws + WS_U); bf16_t* HB = (bf16_t*)(p.ws + WS_A);
    { const bf16_t* HB2 = (const bf16_t*)(p.ws + WS_HB2); const int tid0 = opaque_tid(), lane = tid0 & 63, wave = (int)threadIdx.x >> 6;
#pragma unroll 1
      for (int row = NCTX + blockIdx.x * 8 + wave; row < MT; row += gridDim.x * 8) {
          float hf[8], hb[8], og[8], v[8]; float ss = 0.f;
          unpack8(*(const uint4*)(HB + (size_t)row * DM + lane * 8), hf); unpack8(*(const uint4*)(HB2 + (size_t)(row - NCTX) * 512 + lane * 8), hb); unpack8(*(const uint4*)(U + (size_t)row * UW + 1536 + lane * 8), og);
#pragma unroll
          for (int i = 0; i < 8; ++i) { v[i] = sigmf(og[i]) * (hf[i] + hb[i]); ss += v[i] * v[i]; }
          ss = red16(ss); const float rms = rsqrtf(ss * (1.f / 128.f) + 1e-6f);
          const float4 g0 = *(const float4*)(p.hg + lane * 8), g1 = *(const float4*)(p.hg + lane * 8 + 4);
          *(uint4*)(HB + (size_t)row * DM + lane * 8) = make_uint4(pk2(v[0] * rms * g0.x, v[1] * rms * g0.y), pk2(v[2] * rms * g0.z, v[3] * rms * g0.w), pk2(v[4] * rms * g1.x, v[5] * rms * g1.y), pk2(v[6] * rms * g1.z, v[7] * rms * g1.w)); } }
    const bf16_t* A2 = (const bf16_t*)(p.ws + WS_A2BF); const bf16_t* G2 = (const bf16_t*)(p.ws + WS_G2BF);
    const int wv = __builtin_amdgcn_readfirstlane((int)threadIdx.x >> 6), hc = wv * 64;
    bf16x8 wAf[2][4], wAb[2][4], wG[4][4];
    { const int t0 = opaque_tid(), fr0 = t0 & 15, fq0 = (t0 >> 4) & 3;
#pragma unroll
      for (int ct = 0; ct < 4; ++ct) { const int n = hc + 16 * ct + fr0;
#pragma unroll
          for (int ks = 0; ks < 2; ++ks) { wAf[ks][ct] = *(const bf16x8*)(A2 + (size_t)n * 64 + 32 * ks + 8 * fq0); wAb[ks][ct] = *(const bf16x8*)(A2 + (size_t)(512 + n) * 64 + 32 * ks + 8 * fq0); }
#pragma unroll
          for (int ks = 0; ks < 4; ++ks) wG[ks][ct] = *(const bf16x8*)(G2 + (size_t)n * 128 + 32 * ks + 8 * fq0); } }
#pragma unroll 1
    for (int tile = blockIdx.x; tile < MT / 32; tile += gridDim.x) {
        const int tid = opaque_tid(), fr = tid & 15, fq = (tid >> 4) & 3;
        const int rowt = tile * 32; const bool ctx = rowt < NCTX; const int T = ctx ? 256 : 2048; const size_t row0 = ctx ? (size_t)(rowt & ~255) : (size_t)NCTX + (size_t)((rowt - NCTX) & ~2047);
        const int tokt = rowt - (int)row0;
        __syncthreads();
#pragma unroll 2
        for (int it = 0; it < 14; ++it) { const int item = it * NTHR + tid, tl = item / 224, gi = item % 224;
            const int c0 = gi < 192 ? 2048 + 8 * gi : 2048 + 1664 + 8 * (gi - 192);
            *(uint4*)(sX + tl * FZ_ROW + 8 * gi) = *(const uint4*)(U + (row0 + tokt + tl) * UW + c0); }
        __syncthreads();
#pragma unroll 1
        for (int rt = 0; rt < 2; ++rt) {
            f32x4 af[4], ab[4], gg[4];
#pragma unroll
            for (int ct = 0; ct < 4; ++ct) { af[ct] = (f32x4){0.f, 0.f, 0.f, 0.f}; ab[ct] = af[ct]; gg[ct] = af[ct]; }
            const bf16_t* xr = sX + (16 * rt + fr) * FZ_ROW;
#pragma unroll
            for (int ks = 0; ks < 2; ++ks) { const bf16x8 xf = *(const bf16x8*)(xr + 1536 + 32 * ks + 8 * fq), xb = *(const bf16x8*)(xr + 1600 + 32 * ks + 8 * fq);
#pragma unroll
                for (int ct = 0; ct < 4; ++ct) { af[ct] = mfma16(xf, wAf[ks][ct], af[ct]); ab[ct] = mfma16(xb, wAb[ks][ct], ab[ct]); } }
#pragma unroll
            for (int ks = 0; ks < 4; ++ks) { const bf16x8 xg = *(const bf16x8*)(xr + 1664 + 32 * ks + 8 * fq);
#pragma unroll
                for (int ct = 0; ct < 4; ++ct) gg[ct] = mfma16(xg, wG[ks][ct], gg[ct]); }
#pragma unroll
            for (int jj = 0; jj < 4; ++jj) { const int tl = 16 * rt + 4 * fq + jj; const size_t row = (size_t)rowt + tl; const bf16_t* xt = sX + tl * FZ_ROW;
                bf16_t* hb = HB + row * DM + 512 + hc;
                float y[4], vv[4]; float sy = 0.f, sb = 0.f;
#pragma unroll
                for (int ct = 0; ct < 4; ++ct) { const int ch = hc + 16 * ct + fr;
                    const float am = 0.5f * (sigmf(p.a0[ch] + af[ct][jj]) + sigmf(p.a0[512 + ch] + ab[ct][jj]));
                    const float r = bf2f(xt[ch]), k = bf2f(xt[512 + ch]); vv[ct] = bf2f(xt[1024 + ch]);
                    sb += r * k * (1.f + (am - 1.f) * p.ka[ch]) * p.rk[ch];
                    y[ct] = bf2f(hb[16 * ct + fr]); sy += y[ct]; }
                sy = red16(sy); sb = red16(sb);
                const float mean = sy * (1.f / 64.f); float vs = 0.f;
#pragma unroll
                for (int ct = 0; ct < 4; ++ct) { const float d = y[ct] - mean; vs += d * d; }
                vs = red16(vs); const float rstd = rsqrtf(vs * (1.f / 64.f) + 64e-5f);
#pragma unroll
                for (int ct = 0; ct < 4; ++ct) { const int ch = hc + 16 * ct + fr; const float yn = (y[ct] - mean) * rstd * p.lng[ch] + p.lnb[ch];
                    hb[16 * ct + fr] = f2bf((yn + sb * vv[ct]) * gg[ct][jj]); } }
        }
    }
}

__device__ __forceinline__ void phase_scan(const P& p, unsigned char* lds, int round = 0) {
    unsigned* ctr = (unsigned*)(p.ws + WS_CTR) + round;
    volatile int* sTask = (volatile int*)(lds + LDS_BYTES - 16);
#pragma unroll 1
    for (;;) {
        __syncthreads();
        if (threadIdx.x == 0) *sTask = (int)atomicAdd(ctr, 1u);
        __syncthreads();
        const int t = __builtin_amdgcn_readfirstlane(*sTask);
        if (t >= 512) break;
#pragma unroll 1
        for (int rep = 0; rep < ((PROBE_DUP == 100 && (t < 64 || (t >= 128 && t < 256))) || (PROBE_DUP == 101 && !(t < 64 || (t >= 128 && t < 256))) ? 2 : 1); ++rep) {
        if (t < 64) mlstm_task(p, lds, 32 + (t >> 3), (t >> 1) & 3, t & 1);
        else if (t < 128) { const int q = t - 64; rwkv_task_w(p, lds, 32 + (q >> 3), q & 7); }
        else if (t < 256) { const int q = t - 128; mlstm_task(p, lds, q >> 2, q & 3, -1); }
        else { const int q = t - 256; rwkv_task_w(p, lds, q >> 3, q & 7); }
        }
    }
}

__device__ void phase_convert_w2(const P& p, unsigned char* lds) {
    float* tile = (float*)lds;
    const int t1 = 16 * 88, t2 = 44 * 16;
    const int nb = gridDim.x, lo = nb > 128 ? 128 : 0;
    if ((int)blockIdx.x < lo) return;
    for (int it = blockIdx.x - lo; it < t1 + t2; it += nb - lo) {
        if (it < t1) do_convert(p.w2in, (bf16_t*)(p.ws + WS_W1), 1024, 5632, 5632, 1, it, tile);
        else do_convert(p.w2out, (bf16_t*)(p.ws + WS_W1B), 2816, 1024, 1024, 0, it - t1, tile);
    }
}

#define XB_TMO      128
#define XB_XCNT(j)  (256  + 64 * (j))
#define XB_XSUB(j)  (1280 + 64 * (j))
#define XB_XGEN(j)  (2304 + 64 * (j))
#define XB_TOP      3328
#define XB_TOPGEN   3392
#define XCD_BAR_WORDS 3456
#define XB_SPIN_CAP (1u << 18)
__device__ __forceinline__ unsigned xb_ld(unsigned* p)              { return __hip_atomic_load(p, __ATOMIC_RELAXED, __HIP_MEMORY_SCOPE_AGENT); }
__device__ __forceinline__ unsigned xb_add(unsigned* p, unsigned v) { return __hip_atomic_fetch_add(p, v, __ATOMIC_RELAXED, __HIP_MEMORY_SCOPE_AGENT); }
__device__ __forceinline__ unsigned xb_xcc_id() { return (unsigned)__builtin_amdgcn_s_getreg((3 << 11) | 20) & 0xFu; }
#define XB_SPIN(cond, bar) do { unsigned _sp = 0; while (cond) { __builtin_amdgcn_s_sleep(1); \
    if ((++_sp & 255u) == 0u) { if (xb_ld(&(bar)[XB_TMO])) break; if (_sp > XB_SPIN_CAP) { atomicAdd(&(bar)[XB_TMO], 1u); break; } } } } while (0)
struct XcdBarrier { unsigned* bar; unsigned x; volatile unsigned* st; };
__device__ __forceinline__ XcdBarrier xcd_barrier_post(unsigned* bar, volatile unsigned* st) {
    XcdBarrier b; b.bar = bar; b.x = xb_xcc_id(); b.st = st;
    if (threadIdx.x == 0) (void)xb_add(&bar[XB_XCNT(b.x)], 1u);
    return b;
}
__device__ __forceinline__ void xcd_barrier_complete(unsigned* bar, unsigned x, unsigned& nloc, unsigned& nx) {
    const unsigned G = gridDim.x * gridDim.y * gridDim.z;
    unsigned sum, cnt, mine, sp = 0u;
    for (;;) {
        sum = 0u; cnt = 0u; mine = 0u;
#pragma unroll
        for (unsigned j = 0; j < 16; ++j) { const unsigned c = xb_ld(&bar[XB_XCNT(j)]); sum += c; cnt += (c > 0u) ? 1u : 0u; mine = (j == x) ? c : mine; }
        if (sum == G) break;
        __builtin_amdgcn_s_sleep(1);
        if ((++sp & 255u) == 0u) { if (xb_ld(&bar[XB_TMO])) break; if (sp > XB_SPIN_CAP) { atomicAdd(&bar[XB_TMO], 1u); break; } }
    }
    nloc = mine > 0u ? mine : 1u; nx = cnt > 0u ? cnt : 1u;
}
__device__ __forceinline__ void xcd_barrier(const XcdBarrier& b) {
    asm volatile("s_waitcnt vmcnt(0)" ::: "memory");
    __syncthreads();
    if (threadIdx.x == 0) {
        unsigned* bar = b.bar;
        __builtin_amdgcn_s_waitcnt(0);
        unsigned nloc = b.st[0], nx = b.st[1];
        if (nloc == 0u) { xcd_barrier_complete(bar, b.x, nloc, nx); b.st[0] = nloc; b.st[1] = nx; }
        const unsigned old = xb_add(&bar[XB_XSUB(b.x)], 1u);
        const unsigned gen = old / nloc;
        if (old + 1u == (gen + 1u) * nloc) {
            __builtin_amdgcn_fence(__ATOMIC_RELEASE, "agent");
            asm volatile("s_waitcnt vmcnt(0)" ::: "memory");
            const unsigned og = xb_add(&bar[XB_TOP], 1u);
            const unsigned tg = og / nx;
            if (og + 1u == (tg + 1u) * nx) xb_add(&bar[XB_TOPGEN], 1u);
            else XB_SPIN(xb_ld(&bar[XB_TOPGEN]) == tg, bar);
            __builtin_amdgcn_fence(__ATOMIC_ACQUIRE, "agent");
            xb_add(&bar[XB_XGEN(b.x)], 1u);
            asm volatile("s_waitcnt vmcnt(0)" ::: "memory");
        } else {
            XB_SPIN(xb_ld(&bar[XB_XGEN(b.x)]) == gen, bar);
            __builtin_amdgcn_fence(__ATOMIC_ACQUIRE, "agent");
            asm volatile("s_waitcnt vmcnt(0)" ::: "memory");
        }
    }
    __syncthreads();
}

constexpr int NPHASE = 12;
template <int PH>
__device__ __forceinline__ void run_phase(const P& p, unsigned char* lds) {
    const float* mod = (const float*)(p.ws + WS_MOD);
    if constexpr (PH == 0) phase0(p, lds);
    if constexpr (PH == 1) phase_normmod(p, 0);
    if constexpr (PH == 2) { EpiSwiglu E{(bf16_t*)(p.ws + WS_U)}; run_gemm(lds, (const bf16_t*)(p.ws + WS_A), (const bf16_t*)(p.ws + WS_W1), 5632, 1024, E); }
    if constexpr (PH == 3) { EpiResid E{p.xp, p.xs, p.out, mod + 2048, 0.5f, 0}; run_gemm(lds, (const bf16_t*)(p.ws + WS_U), (const bf16_t*)(p.ws + WS_W1B), 1024, 2816, E); }
    if constexpr (PH == 4) phase_normmod(p, 1);
    if constexpr (PH == 5) { EpiU E{(bf16_t*)(p.ws + WS_U), (float*)(p.ws + WS_GATES)}; run_gemm(lds, (const bf16_t*)(p.ws + WS_A), (const bf16_t*)(p.ws + WS_BT3), 4096, 1024, E); }
    if constexpr (PH == 6) phase_scan(p, lds);
    if constexpr (PH == 12) phase_rwkv_finalize(p, lds);
    if constexpr (PH == 13) phase_shift((bf16_t*)(p.ws + WS_U), p.mu, (uint4*)lds);
    if constexpr (PH == 7) { EpiResid E{p.xp, p.xs, p.out, mod + 5120, 1.0f, 1}; run_gemm(lds, (const bf16_t*)(p.ws + WS_A), (const bf16_t*)(p.ws + WS_BT4), 1024, 1024, E); phase_convert_w2(p, lds); }
    if constexpr (PH == 8) phase_normmod(p, 2);
    if constexpr (PH == 9) { EpiSwiglu E{(bf16_t*)(p.ws + WS_U)}; run_gemm(lds, (const bf16_t*)(p.ws + WS_A), (const bf16_t*)(p.ws + WS_W1), 5632, 1024, E); }
    if constexpr (PH == 10) { EpiResid E{p.xp, p.xs, p.out, mod + 8192, 0.5f, 1}; run_gemm(lds, (const bf16_t*)(p.ws + WS_U), (const bf16_t*)(p.ws + WS_W1B), 1024, 2816, E); }
    if constexpr (PH == 11) phase_finalnorm(p);
}

#if !ONE_LAUNCH
template <int PH>
__global__ void __launch_bounds__(NTHR, 2) k_phase(P p) {
    extern __shared__ __attribute__((aligned(16))) unsigned char lds[];
    run_phase<PH>(p, lds);
}
#endif

#if ONE_LAUNCH
__global__ void __launch_bounds__(NTHR, 2) k_mega(P p) {
    extern __shared__ __attribute__((aligned(16))) unsigned char lds[];
    cg::grid_group grid = cg::this_grid();
    volatile unsigned* xst = (volatile unsigned*)(lds + LDS_BYTES - 32);
    if (threadIdx.x == 0) { xst[0] = 0u; xst[1] = 0u; }
    __syncthreads();
    const XcdBarrier xbar = xcd_barrier_post((unsigned*)(p.ws + WS_BAR), xst);
#define GSYNC() xcd_barrier(xbar)
    if (p.ws == nullptr) grid.sync();
    run_phase<0>(p, lds); GSYNC();
    if (PROBE_DUP == 0) { run_phase<0>(p, lds); GSYNC(); }
    run_phase<1>(p, lds); GSYNC();
    if (PROBE_DUP == 1) { run_phase<1>(p, lds); GSYNC(); }
    run_phase<2>(p, lds); GSYNC();
    if (PROBE_DUP == 2 || PROBE_DUP == 235) { run_phase<2>(p, lds); GSYNC(); }
    run_phase<3>(p, lds); GSYNC();
    if (PROBE_DUP == 3 || PROBE_DUP == 235) { run_phase<3>(p, lds); GSYNC(); }
    run_phase<4>(p, lds); GSYNC();
    if (PROBE_DUP == 4) { run_phase<4>(p, lds); GSYNC(); }
    run_phase<5>(p, lds); GSYNC();
    if (PROBE_DUP == 5 || PROBE_DUP == 235) { run_phase<5>(p, lds); GSYNC(); }
    run_phase<13>(p, lds); GSYNC();
    run_phase<6>(p, lds); GSYNC();
    if (PROBE_DUP == 6) { phase_scan(p, lds, 1); GSYNC(); }
    run_phase<12>(p, lds); GSYNC();
    run_phase<7>(p, lds); GSYNC();
    if (PROBE_DUP == 7) { run_phase<7>(p, lds); GSYNC(); }
    run_phase<8>(p, lds); GSYNC();
    if (PROBE_DUP == 8) { run_phase<8>(p, lds); GSYNC(); }
    run_phase<9>(p, lds); GSYNC();
    if (PROBE_DUP == 9) { run_phase<9>(p, lds); GSYNC(); }
    run_phase<10>(p, lds); GSYNC();
    if (PROBE_DUP == 10) { run_phase<10>(p, lds); GSYNC(); }
    run_phase<11>(p, lds);
    if (PROBE_DUP == 200) { for (int i = 0; i < 20; ++i) GSYNC(); }
}
#endif

#if !ONE_LAUNCH
template <int PH> static void launch_phase(const P& p, int grid, hipStream_t stream) {
    static bool attr = false;
    if (!attr) { (void)hipFuncSetAttribute((const void*)k_phase<PH>, hipFuncAttributeMaxDynamicSharedMemorySize, LDS_BYTES); attr = true; }
    hipLaunchKernelGGL(k_phase<PH>, dim3(grid), dim3(NTHR), LDS_BYTES, stream, p);
}
#endif

extern "C" void kernel_launch(void* const* d_in, const int* in_sizes, int n_in, void* d_out, int out_size, void* d_ws, size_t ws_size, hipStream_t stream) {
    (void)in_sizes; (void)n_in; (void)out_size; (void)ws_size;
    static int grid = 0;
    if (grid == 0) {
        int dev = 0, cus = 0;
        if (hipGetDevice(&dev) != hipSuccess || hipDeviceGetAttribute(&cus, hipDeviceAttributeMultiprocessorCount, dev) != hipSuccess || cus <= 0) cus = 256;
#if ONE_LAUNCH
        (void)hipFuncSetAttribute((const void*)k_mega, hipFuncAttributeMaxDynamicSharedMemorySize, LDS_BYTES);
        int per_cu = 0;
        if (hipOccupancyMaxActiveBlocksPerMultiprocessor(&per_cu, (const void*)k_mega, NTHR, LDS_BYTES) != hipSuccess || per_cu < 1) per_cu = 1;
        (void)hipGetLastError();
#endif
        grid = cus;
    }
    P p{};
    const float** f = (const float**)&p;
    for (int i = 0; i < 35; ++i) f[i] = (const float*)d_in[i];
    p.out = (float*)d_out; p.ws = (unsigned char*)d_ws;
    (void)hipMemsetAsync((char*)d_ws + WS_MOD, 0, NCOND * MODW * sizeof(float) + 256 + 3456 * 4, stream);
#if ONE_LAUNCH
    void* args[] = {&p};
    hipError_t e = hipLaunchCooperativeKernel((const void*)k_mega, dim3(grid), dim3(NTHR), args, LDS_BYTES, stream);
    if (e != hipSuccess) fprintf(stderr, "cooperative launch failed: %s (grid %d)\n", hipGetErrorString(e), grid);
#else
    launch_phase<0>(p, grid, stream); launch_phase<1>(p, grid, stream); launch_phase<2>(p, grid, stream); launch_phase<3>(p, grid, stream);
    launch_phase<4>(p, grid, stream); launch_phase<5>(p, grid, stream); launch_phase<13>(p, grid, stream); launch_phase<6>(p, grid, stream); launch_phase<12>(p, grid, stream); launch_phase<7>(p, grid, stream);
    launch_phase<8>(p, grid, stream); launch_phase<9>(p, grid, stream); launch_phase<10>(p, grid, stream); launch_phase<11>(p, grid, stream);
#endif
}
```
